# Optimizing an MI355X kernel written in HIP

```python
import numpy as np
import jax
import jax.numpy as jnp
from jax import lax

D_MODEL = 1024
BATCH = 8
SEQ = 2048
DEPTH = 2

PLE_DIM = 256
HEAD_DIM = 64
N_HEADS_A = 8
N_HEADS_B = 8
N_KV_B = 2
GQA_REP = N_HEADS_B // N_KV_B
N_HEADS_TOTAL = N_HEADS_A + N_HEADS_B
D_MIX = N_HEADS_TOTAL * HEAD_DIM
DILATED_PATTERNS = ((128, 1), (512, 4), (2048, 16))
Q_BLOCK_A = 128
CMP_BLOCK = 32
CMP_STRIDE = 16
CMP_HIDDEN = 256
SEL_BLOCK = 64
SEL_TOP = 16
N_LOCAL_BLOCKS = 2
WINDOW = 512
Q_BLOCK_B = 64
N_GROUPS = 4
EXPERTS_PER_GROUP = 4
N_EXPERTS = N_GROUPS * EXPERTS_PER_GROUP
D_EXPERT = 512
TOP_K_IN_GROUP = 2
RMS_EPS = 1e-6
NEG = -1e30
FORCE_BONUS = 1e4
A_W = N_HEADS_A * HEAD_DIM
B_Q = N_HEADS_B * HEAD_DIM
B_KV = N_KV_B * HEAD_DIM
B_GATE = N_HEADS_B * 3
SPLITS = (A_W, A_W, A_W, B_Q, B_KV, B_KV, B_KV, B_KV, B_KV, B_KV, B_GATE)
N_IN = sum(SPLITS)

kernel_name = "hybrid_dilated_nsa_hmoe_block"


def rms_norm(x, g):
    xf = x.astype(jnp.float32)
    y = xf * lax.rsqrt(jnp.mean(xf * xf, axis=-1, keepdims=True) + RMS_EPS)
    return (y * g.astype(jnp.float32)).astype(x.dtype)


def alibi_slopes():
    s = 2.0 ** (-8.0 * np.arange(1, N_HEADS_TOTAL + 1) / N_HEADS_TOTAL)
    return jnp.asarray(s[0::2], jnp.float32), jnp.asarray(s[1::2].reshape(N_KV_B, GQA_REP), jnp.float32)


def dilated_attention(q, k, v, slopes):
    B, H, S, dh = q.shape
    scale = dh ** -0.5
    m = slopes[None, :, None, None]

    def block(t0):
        qb = lax.dynamic_slice_in_dim(q, t0, Q_BLOCK_A, axis=2)
        t = t0 + jnp.arange(Q_BLOCK_A)
        nums, dens, maxs = [], [], []
        for window, dil in DILATED_PATTERNS:
            dist = jnp.arange(window // dil + 1) * dil
            pos = t[:, None] - dist[None, :]
            valid = pos >= 0
            posc = jnp.maximum(pos, 0)
            kg = k[:, :, posc]
            vg = v[:, :, posc]
            s = jnp.einsum('bhqd,bhqjd->bhqj', qb, kg).astype(jnp.float32) * scale - m * dist.astype(jnp.float32)
            s = jnp.where(valid, s, NEG)
            mx = jnp.max(s, axis=-1, keepdims=True)
            e = jnp.exp(s - mx)
            dens.append(jnp.sum(e, axis=-1, keepdims=True))
            nums.append(jnp.einsum('bhqj,bhqjd->bhqd', e.astype(v.dtype), vg).astype(jnp.float32))
            maxs.append(mx)
        M = maxs[0]
        for mx in maxs[1:]:
            M = jnp.maximum(M, mx)
        ws = [jnp.exp(mx - M) for mx in maxs]
        num = sum(w * n for w, n in zip(ws, nums))
        den = sum(w * d for w, d in zip(ws, dens))
        return (num / den).astype(q.dtype)

    outs = lax.map(block, jnp.arange(S // Q_BLOCK_A) * Q_BLOCK_A)
    return jnp.moveaxis(outs, 0, 2).reshape(B, H, S, dh)


def nsa_attention(q, k_c, v_c, k_s, v_s, k_w, v_w, gates, m, w_ck1, w_ck2, w_cv1, w_cv2, cmp_pos):
    B, G, R, S, dh = q.shape
    scale = dh ** -0.5
    t = jnp.arange(S)
    n_cmp = (S - CMP_BLOCK) // CMP_STRIDE + 1
    cidx = np.arange(n_cmp)[:, None] * CMP_STRIDE + np.arange(CMP_BLOCK)[None, :]

    def compress(kv, pos, w1, w2):
        blk = (kv[:, :, cidx] + pos).reshape(B, G, n_cmp, CMP_BLOCK * dh)
        return jax.nn.gelu(blk @ w1) @ w2

    k_cmp = compress(k_c, cmp_pos[0], w_ck1, w_ck2)
    v_cmp = compress(v_c, cmp_pos[1], w_cv1, w_cv2)
    cmp_end = jnp.asarray(cidx[:, -1])
    dist_c = (t[:, None] - cmp_end[None, :]).astype(jnp.float32)
    valid_c = dist_c >= 0
    s = jnp.einsum('bgrqd,bgcd->bgrqc', q, k_cmp).astype(jnp.float32) * scale - m * dist_c
    p_cmp = jax.nn.softmax(jnp.where(valid_c, s, NEG), axis=-1) * valid_c
    o_cmp = jnp.einsum('bgrqc,bgcd->bgrqd', p_cmp.astype(v_cmp.dtype), v_cmp)

    nb = S // SEL_BLOCK
    cs = cidx[:, 0]
    bs = np.arange(nb) * SEL_BLOCK
    ov = np.clip(np.minimum(cs[:, None] + CMP_BLOCK, bs[None, :] + SEL_BLOCK) - np.maximum(cs[:, None], bs[None, :]), 0, None) / CMP_BLOCK
    ov = jnp.asarray(ov, jnp.float32)
    imp = jnp.einsum('bgrqc,cn->bgqn', p_cmp, ov)
    back = (t // SEL_BLOCK)[:, None] - jnp.arange(nb)[None, :]
    valid_s = back >= 0
    forced = (jnp.arange(nb)[None, :] == 0) | (valid_s & (back < N_LOCAL_BLOCKS))
    score = jnp.where(valid_s, imp + jnp.where(forced, FORCE_BONUS, 0.0), NEG)
    n_top = min(SEL_TOP, nb)
    top_val, top_idx = lax.top_k(score, n_top)
    top_ok = top_val > 0.5 * NEG

    kb = k_s.reshape(B, G, nb, SEL_BLOCK, dh)
    vb = v_s.reshape(B, G, nb, SEL_BLOCK, dh)
    kw_pad = jnp.pad(k_w, ((0, 0), (0, 0), (WINDOW, 0), (0, 0)))
    vw_pad = jnp.pad(v_w, ((0, 0), (0, 0), (WINDOW, 0), (0, 0)))
    bi = jnp.arange(B)[:, None, None, None]
    gi = jnp.arange(G)[None, :, None, None]
    n_keys = n_top * SEL_BLOCK

    def block(t0):
        qb = lax.dynamic_slice_in_dim(q, t0, Q_BLOCK_B, axis=3)
        tq = t0 + jnp.arange(Q_BLOCK_B)
        idx = lax.dynamic_slice_in_dim(top_idx, t0, Q_BLOCK_B, axis=2)
        ok = lax.dynamic_slice_in_dim(top_ok, t0, Q_BLOCK_B, axis=2)
        ks = kb[bi, gi, idx].reshape(B, G, Q_BLOCK_B, n_keys, dh)
        vs = vb[bi, gi, idx].reshape(B, G, Q_BLOCK_B, n_keys, dh)
        spos = (idx[..., None] * SEL_BLOCK + jnp.arange(SEL_BLOCK)).reshape(B, G, Q_BLOCK_B, n_keys)
        dist = (tq[:, None] - spos).astype(jnp.float32)
        okk = jnp.broadcast_to(ok[..., None], ok.shape + (SEL_BLOCK,)).reshape(B, G, Q_BLOCK_B, n_keys) & (dist >= 0)
        s = jnp.einsum('bgrqd,bgqkd->bgrqk', qb, ks).astype(jnp.float32) * scale - m * dist[:, :, None]
        p = jax.nn.softmax(jnp.where(okk[:, :, None], s, NEG), axis=-1)
        o_s = jnp.einsum('bgrqk,bgqkd->bgrqd', p.astype(vs.dtype), vs)
        kw = lax.dynamic_slice_in_dim(kw_pad, t0, WINDOW + Q_BLOCK_B, axis=2)
        vw = lax.dynamic_slice_in_dim(vw_pad, t0, WINDOW + Q_BLOCK_B, axis=2)
        wpos = t0 - WINDOW + jnp.arange(WINDOW + Q_BLOCK_B)
        wdist = tq[:, None] - wpos[None, :]
        wok = (wdist >= 0) & (wdist < WINDOW) & (wpos[None, :] >= 0)
        s = jnp.einsum('bgrqd,bgkd->bgrqk', qb, kw).astype(jnp.float32) * scale - m * wdist.astype(jnp.float32)
        p = jax.nn.softmax(jnp.where(wok, s, NEG), axis=-1)
        o_w = jnp.einsum('bgrqk,bgkd->bgrqd', p.astype(vw.dtype), vw)
        return o_s, o_w

    o_s, o_w = lax.map(block, jnp.arange(S // Q_BLOCK_B) * Q_BLOCK_B)
    unblock = lambda o: jnp.moveaxis(o, 0, 3).reshape(B, G, R, S, dh)
    g = gates.astype(q.dtype)
    return g[..., 0:1] * o_cmp + g[..., 1:2] * unblock(o_s) + g[..., 2:3] * unblock(o_w)


def mixing_layer(h, w_in, w_out, w_ck1, w_ck2, w_cv1, w_cv2, cmp_pos):
    B, S, _ = h.shape
    proj = h @ w_in
    qa, ka, va, qb, kc, vc, ks, vs, kw, vw, gl = jnp.split(proj, list(np.cumsum(SPLITS)[:-1]), axis=-1)
    heads = lambda z, n: z.reshape(B, S, n, HEAD_DIM).transpose(0, 2, 1, 3)
    slopes_a, slopes_b = alibi_slopes()
    oa = dilated_attention(heads(qa, N_HEADS_A), heads(ka, N_HEADS_A), heads(va, N_HEADS_A), slopes_a)
    qB = heads(qb, N_HEADS_B).reshape(B, N_KV_B, GQA_REP, S, HEAD_DIM)
    gates = jax.nn.sigmoid(gl.astype(jnp.float32)).reshape(B, S, N_KV_B, GQA_REP, 3).transpose(0, 2, 3, 1, 4)
    ob = nsa_attention(qB, heads(kc, N_KV_B), heads(vc, N_KV_B), heads(ks, N_KV_B), heads(vs, N_KV_B),
                       heads(kw, N_KV_B), heads(vw, N_KV_B), gates, slopes_b[None, :, :, None, None],
                       w_ck1, w_ck2, w_cv1, w_cv2, cmp_pos)
    ob = ob.reshape(B, N_HEADS_B, S, HEAD_DIM)
    o = jnp.concatenate([oa, ob], axis=1).transpose(0, 2, 1, 3).reshape(B, S, D_MIX)
    return o @ w_out


def hierarchical_moe(h, w_rg, b_rg, w_re, b_re, w_gate, w_up, w_down):
    B, S, D = h.shape
    tok = h.reshape(-1, D)
    glog = (tok @ w_rg).astype(jnp.float32) + b_rg.astype(jnp.float32)
    gprob = jax.nn.softmax(glog, axis=-1)
    gsel = jnp.argmax(glog, axis=-1)
    gw = jnp.take_along_axis(gprob, gsel[:, None], axis=-1)
    elog = ((tok @ w_re).astype(jnp.float32) + b_re.astype(jnp.float32)).reshape(-1, N_GROUPS, EXPERTS_PER_GROUP)
    within = jnp.take_along_axis(elog, gsel[:, None, None], axis=1)[:, 0]
    tv, ti = lax.top_k(within, TOP_K_IN_GROUP)
    ew = jax.nn.softmax(tv, axis=-1) * gw
    local = jnp.sum(jax.nn.one_hot(ti, EXPERTS_PER_GROUP, dtype=jnp.float32) * ew[..., None], axis=1)
    y = jnp.zeros_like(tok)
    for g in range(N_GROUPS):
        gate_g = jnp.where((gsel == g)[:, None], local, 0.0).astype(tok.dtype)
        sl = slice(g * EXPERTS_PER_GROUP, (g + 1) * EXPERTS_PER_GROUP)
        a = jax.nn.silu(jnp.einsum('td,edh->teh', tok, w_gate[sl])) * jnp.einsum('td,edh->teh', tok, w_up[sl])
        y = y + jnp.einsum('teh,ehd->td', a * gate_g[..., None], w_down[sl])
    return y.reshape(B, S, D)


def setup_inputs(seed: int = 0) -> dict:
    key = jax.random.key(seed)
    ks = jax.random.split(key, 22)
    f32 = jnp.float32
    nrm = lambda k, shape, fan_in: jax.random.normal(k, shape, f32) * fan_in ** -0.5
    gain = lambda k, shape: 1.0 + 0.02 * jax.random.normal(k, shape, f32)
    return {
        "x": jax.random.normal(ks[0], (BATCH, SEQ, D_MODEL), f32),
        "p": jax.random.normal(ks[1], (DEPTH, BATCH, SEQ, PLE_DIM), f32),
        "attn_norm": gain(ks[2], (DEPTH, D_MODEL)),
        "w_in": nrm(ks[3], (DEPTH, D_MODEL, N_IN), D_MODEL),
        "w_out": nrm(ks[4], (DEPTH, D_MIX, D_MODEL), D_MIX),
        "w_cmp_k1": nrm(ks[5], (DEPTH, CMP_BLOCK * HEAD_DIM, CMP_HIDDEN), CMP_BLOCK * HEAD_DIM),
        "w_cmp_k2": nrm(ks[6], (DEPTH, CMP_HIDDEN, HEAD_DIM), CMP_HIDDEN),
        "w_cmp_v1": nrm(ks[7], (DEPTH, CMP_BLOCK * HEAD_DIM, CMP_HIDDEN), CMP_BLOCK * HEAD_DIM),
        "w_cmp_v2": nrm(ks[8], (DEPTH, CMP_HIDDEN, HEAD_DIM), CMP_HIDDEN),
        "cmp_pos": 0.02 * jax.random.normal(ks[9], (DEPTH, 2, CMP_BLOCK, HEAD_DIM), f32),
        "ffn_norm": gain(ks[10], (DEPTH, D_MODEL)),
        "w_route_group": nrm(ks[11], (DEPTH, D_MODEL, N_GROUPS), D_MODEL),
        "b_route_group": 0.01 * jax.random.normal(ks[12], (DEPTH, N_GROUPS), f32),
        "w_route_expert": nrm(ks[13], (DEPTH, D_MODEL, N_EXPERTS), D_MODEL),
        "b_route_expert": 0.01 * jax.random.normal(ks[14], (DEPTH, N_EXPERTS), f32),
        "w_expert_gate": nrm(ks[15], (DEPTH, N_EXPERTS, D_MODEL, D_EXPERT), D_MODEL),
        "w_expert_up": nrm(ks[16], (DEPTH, N_EXPERTS, D_MODEL, D_EXPERT), D_MODEL),
        "w_expert_down": nrm(ks[17], (DEPTH, N_EXPERTS, D_EXPERT, D_MODEL), D_EXPERT),
        "ple_norm": gain(ks[18], (DEPTH, D_MODEL)),
        "w_ple_gate": nrm(ks[19], (DEPTH, D_MODEL, D_MODEL), D_MODEL),
        "w_ple_proj": nrm(ks[20], (DEPTH, PLE_DIM, D_MODEL), PLE_DIM),
        "final_norm": gain(ks[21], (D_MODEL,)),
    }


def reference(x, p, attn_norm, w_in, w_out, w_cmp_k1, w_cmp_k2, w_cmp_v1, w_cmp_v2, cmp_pos,
              ffn_norm, w_route_group, b_route_group, w_route_expert, b_route_expert,
              w_expert_gate, w_expert_up, w_expert_down, ple_norm, w_ple_gate, w_ple_proj, final_norm):
    for i in range(DEPTH):
        h = rms_norm(x, attn_norm[i])
        x = x + mixing_layer(h, w_in[i], w_out[i], w_cmp_k1[i], w_cmp_k2[i], w_cmp_v1[i], w_cmp_v2[i], cmp_pos[i])
        h = rms_norm(x, ffn_norm[i])
        x = x + hierarchical_moe(h, w_route_group[i], b_route_group[i], w_route_expert[i], b_route_expert[i],
                                 w_expert_gate[i], w_expert_up[i], w_expert_down[i])
        gate = jax.nn.sigmoid(rms_norm(x, ple_norm[i]) @ w_ple_gate[i])
        x = x + gate * (p[i] @ w_ple_proj[i])
    return rms_norm(x, final_norm)
```

```cpp
#include <hip/hip_runtime.h>
#include <cstdio>
#include <cstdint>

#ifndef NAIVE_GEMM
#define NAIVE_GEMM 0
#endif
#ifndef NAIVE_ATTN
#define NAIVE_ATTN 0
#endif
#define REP_CONV 1
#define REP_INPROJ 1
#define REP_ATTN 1
#define REP_GU 1
#define REP_NORM 1
#define REP_ROUTE 1
#define REP_DOWN 1
#define REP_OUTPROJ 1
#define REP_PG 1
#define REP_CMP 1
#define REP_MISC 1

#define LAS __attribute__((address_space(3)))
typedef unsigned short bf16_t;
typedef short bf16x8 __attribute__((ext_vector_type(8)));
typedef float f32x4 __attribute__((ext_vector_type(4)));
typedef unsigned u32x4 __attribute__((ext_vector_type(4)));
typedef unsigned u32x2 __attribute__((ext_vector_type(2)));
typedef float f32x16 __attribute__((ext_vector_type(16)));
typedef short s16x4 __attribute__((ext_vector_type(4)));
typedef float f32x2_t __attribute__((ext_vector_type(2)));
typedef __bf16 bf16x2_t __attribute__((ext_vector_type(2)));

constexpr int NB = 8, NS = 2048, ND = 1024, NT = NB * NS;
constexpr int NIN = 2840, NINP = 2944;
constexpr size_t MiB = (size_t)1 << 20;
constexpr size_t WL_IN = 0;
constexpr size_t WL_OUT = WL_IN + (size_t)NINP * 1024 * 2;
constexpr size_t WL_C1 = WL_OUT + (size_t)1024 * 1024 * 2;
constexpr size_t WL_C2 = WL_C1 + (size_t)2 * 256 * 2048 * 2;
constexpr size_t WL_GU = WL_C2 + (size_t)2 * 128 * 256 * 2;
constexpr size_t WL_DN = WL_GU + (size_t)16 * 1024 * 1024 * 2;
constexpr size_t WL_PG = WL_DN + (size_t)16 * 1024 * 512 * 2;
constexpr size_t WL_PP = WL_PG + (size_t)1024 * 1024 * 2;
constexpr size_t WL_BC1 = WL_PP + (size_t)1024 * 256 * 2;
constexpr size_t WL_RT = WL_BC1 + 2048;
constexpr size_t WL_SIZE = 64 * MiB;
static_assert(WL_RT + 131072 <= WL_SIZE, "weight block");
constexpr size_t WS_CTL = 0;
constexpr size_t WS_W = 1 * MiB;
constexpr size_t WS_XN = WS_W + 2 * WL_SIZE;
constexpr size_t WS_PROJ = WS_XN + 32 * MiB;
constexpr size_t WS_QA = WS_PROJ, WS_KA = WS_QA + 16 * MiB, WS_VA = WS_KA + 16 * MiB, WS_QB = WS_VA + 16 * MiB;
constexpr size_t WS_KV6 = WS_QB + 16 * MiB;
constexpr size_t WS_GATES = WS_KV6 + 24 * MiB;
constexpr size_t WS_PROJ_END = WS_GATES + 2 * MiB;
constexpr size_t WS_HID = WS_PROJ;
constexpr size_t WS_P2 = WS_PROJ + 40 * MiB;
constexpr size_t WS_PB = WS_PROJ + 72 * MiB;
constexpr size_t WS_HC = WS_PROJ_END;
constexpr size_t WS_KCMP = WS_HC + 2 * MiB;
constexpr size_t WS_MASK = WS_KCMP + 512 * 1024;
constexpr size_t WS_ROUTE = WS_MASK + 128 * 1024;
constexpr size_t WS_LIST = WS_ROUTE + 128 * 1024;
constexpr size_t WS_O = WS_LIST + 1536 * 1024 + 256 * 1024;
constexpr size_t WS_IMPH = WS_O + 32 * MiB;
constexpr size_t WS_OPA01 = WS_XN;
constexpr size_t WS_OPA2 = WS_IMPH;
constexpr size_t WS_STA = WS_IMPH + 16 * MiB;
constexpr size_t WS_PBALL = WS_IMPH + 20 * MiB;
constexpr size_t WS_SSP = WS_PBALL + 16 * MiB;
constexpr size_t WS_RINV = WS_MASK;
constexpr size_t WS_BC1P = WS_SSP + 2 * MiB;
constexpr size_t WS_END = WS_BC1P + 64 * 1024;
static_assert(WS_PB + 8 * MiB <= WS_PROJ_END, "alias map");
static_assert(WS_END <= 330 * MiB, "workspace");
constexpr int HID_ROWS = NT + 24 * 128;
constexpr int CW_BAR = 1024;
constexpr int CW_Q = 256;
constexpr int CW_CNTP = 4608;
constexpr int CW_CNT = 64;

struct Params {
    const float* in[22];
    float* out;
    unsigned char* ws;
};

__device__ __forceinline__ unsigned f2bf(float f) { unsigned u = __float_as_uint(f); return (u + 0x7fffu + ((u >> 16) & 1u)) >> 16; }
__device__ __forceinline__ unsigned pk2(float lo, float hi) { return f2bf(lo) | (f2bf(hi) << 16); }
__device__ __forceinline__ float bflo(unsigned v) { return __uint_as_float(v << 16); }
__device__ __forceinline__ float bfhi(unsigned v) { return __uint_as_float(v & 0xffff0000u); }
__device__ __forceinline__ float wave_sum(float v) {
#pragma unroll
    for (int o = 1; o < 64; o <<= 1) v += __shfl_xor(v, o);
    return v;
}
__device__ __forceinline__ int TID() { int t = threadIdx.x; asm volatile("" : "+v"(t)); return t; }
__device__ __forceinline__ int BID() { int t = blockIdx.x; asm volatile("" : "+s"(t)); return t; }
__device__ __forceinline__ float sigmoidf_(float x) { return 1.0f / (1.0f + __expf(-x)); }
__device__ __forceinline__ float gelu_tanh(float x) {
    const float u = 0.7978845608028654f * (x + 0.044715f * x * x * x);
    const float e = __expf(2.0f * u);
    const float th = 1.0f - 2.0f / (e + 1.0f);
    return 0.5f * x * (1.0f + th);
}

struct ConvJob { const float* src; bf16_t* dst; const float* gain; int K, N, NP, map, per; size_t dst_bstride; };
__device__ __forceinline__ int conv_job_tiles(int j) { return j == 0 ? 736 : (j == 1 || j == 9) ? 256 : (j == 2 || j == 3) ? 128 : (j == 4 || j == 5) ? 8 : j == 10 ? 64 : 2048; }
__device__ __forceinline__ ConvJob conv_job(const Params& p, int l, int j) {
    unsigned char* wl = p.ws + WS_W + (size_t)l * WL_SIZE;
    ConvJob c; c.map = 0; c.dst_bstride = 0; c.gain = nullptr;
    switch (j) {
    case 0: c.src = p.in[3] + (size_t)l * 1024 * NIN; c.K = 1024; c.N = NIN; c.NP = NINP; c.dst = (bf16_t*)(wl + WL_IN); c.gain = p.in[2] + l * ND; break;
    case 1: c.src = p.in[4] + (size_t)l * 1024 * 1024; c.K = 1024; c.N = 1024; c.NP = 1024; c.dst = (bf16_t*)(wl + WL_OUT); break;
    case 2: c.src = p.in[5] + (size_t)l * 2048 * 256; c.K = 2048; c.N = 256; c.NP = 256; c.dst = (bf16_t*)(wl + WL_C1); break;
    case 3: c.src = p.in[7] + (size_t)l * 2048 * 256; c.K = 2048; c.N = 256; c.NP = 256; c.dst = (bf16_t*)(wl + WL_C1) + (size_t)256 * 2048; break;
    case 4: c.src = p.in[6] + (size_t)l * 256 * 64; c.K = 256; c.N = 64; c.NP = 128; c.dst = (bf16_t*)(wl + WL_C2); break;
    case 5: c.src = p.in[8] + (size_t)l * 256 * 64; c.K = 256; c.N = 64; c.NP = 128; c.dst = (bf16_t*)(wl + WL_C2) + (size_t)128 * 256; break;
    case 6: c.src = p.in[15] + (size_t)l * 16 * 1024 * 512; c.K = 1024; c.N = 512; c.NP = 512; c.dst = (bf16_t*)(wl + WL_GU); c.map = 1; c.dst_bstride = (size_t)1024 * 1024; c.gain = p.in[10] + l * ND; break;
    case 7: c.src = p.in[16] + (size_t)l * 16 * 1024 * 512; c.K = 1024; c.N = 512; c.NP = 512; c.dst = (bf16_t*)(wl + WL_GU); c.map = 2; c.dst_bstride = (size_t)1024 * 1024; c.gain = p.in[10] + l * ND; break;
    case 8: c.src = p.in[17] + (size_t)l * 16 * 512 * 1024; c.K = 512; c.N = 1024; c.NP = 1024; c.dst = (bf16_t*)(wl + WL_DN); c.dst_bstride = (size_t)1024 * 512; break;
    case 9: c.src = p.in[19] + (size_t)l * 1024 * 1024; c.K = 1024; c.N = 1024; c.NP = 1024; c.dst = (bf16_t*)(wl + WL_PG); c.gain = p.in[18] + l * ND; break;
    default: c.src = p.in[20] + (size_t)l * 256 * 1024; c.K = 256; c.N = 1024; c.NP = 1024; c.dst = (bf16_t*)(wl + WL_PP); break;
    }
    c.per = (c.K / 64) * (c.NP / 64);
    return c;
}
__device__ __forceinline__ void convert_tiles(const ConvJob& c, int t0, int t1, LAS float* tl) {
    const int tid = TID();
    const int ntiles = c.NP / 64;
    const int kr = tid >> 4, c4 = (tid & 15) * 4;
    f32x4 v[4]; float gv[4];
#define CT_LOAD(it_) do { const int _bi = (it_) / c.per, _r = (it_) - _bi * c.per, _kt = _r / ntiles, _nt = _r - _kt * ntiles; \
        const int _n = _nt * 64 + c4; const bool _ok = _n < c.N; \
        const float* _sp = c.src + (size_t)_bi * c.K * c.N + (size_t)(_kt * 64 + kr) * c.N + (_ok ? _n : 0); \
        _Pragma("unroll") for (int _i = 0; _i < 4; ++_i) v[_i] = *(const f32x4*)(_sp + (size_t)(16 * _i) * c.N); \
        if (c.gain) { _Pragma("unroll") for (int _i = 0; _i < 4; ++_i) gv[_i] = c.gain[_kt * 64 + kr + 16 * _i]; } \
        else { _Pragma("unroll") for (int _i = 0; _i < 4; ++_i) gv[_i] = 1.0f; } \
        if (!_ok) { _Pragma("unroll") for (int _i = 0; _i < 4; ++_i) gv[_i] = 0.f; } } while (0)
    CT_LOAD(t0);
    for (int it = t0; it < t1; ++it) {
        const int bi = it / c.per, r = it - bi * c.per, kt = r / ntiles, nt = r - kt * ntiles;
        bf16_t* d = c.dst + (size_t)bi * c.dst_bstride;
        const int k0 = kt * 64, n0 = nt * 64;
        __syncthreads();
#pragma unroll
        for (int i = 0; i < 4; ++i) {
            LAS float* tp = tl + (kr + 16 * i) * 65 + c4;
            tp[0] = v[i].x * gv[i]; tp[1] = v[i].y * gv[i]; tp[2] = v[i].z * gv[i]; tp[3] = v[i].w * gv[i];
        }
        if (it + 1 < t1) CT_LOAD(it + 1);
        __syncthreads();
        const int n = tid >> 2, kc = (tid & 3) * 16;
        const int nsrc = n0 + n;
        const int row = (c.map == 0) ? nsrc : ((nsrc >> 4) * 32 + (nsrc & 15) + (c.map == 2 ? 16 : 0));
        float w[16];
#pragma unroll
        for (int j = 0; j < 16; ++j) w[j] = tl[(kc + j) * 65 + n];
        u32x4 o0, o1;
        o0.x = pk2(w[0], w[1]); o0.y = pk2(w[2], w[3]); o0.z = pk2(w[4], w[5]); o0.w = pk2(w[6], w[7]);
        o1.x = pk2(w[8], w[9]); o1.y = pk2(w[10], w[11]); o1.z = pk2(w[12], w[13]); o1.w = pk2(w[14], w[15]);
        bf16_t* dp = d + (size_t)row * c.K + k0 + kc;
        *(u32x4*)dp = o0; *(u32x4*)(dp + 8) = o1;
    }
#undef CT_LOAD
}
__device__ __forceinline__ int conv_list(int q, int i) {
    if (q == 0) return i == 0 ? 6 : (i == 1 ? 7 : -1);
    if (q == 1) return i == 0 ? 8 : i == 1 ? 9 : i == 2 ? 10 : i == 3 ? 16 : i == 4 ? 18 : i == 5 ? 19 : i == 6 ? 20 : i == 7 ? 21 : -1;
    if (q == 2) return i == 0 ? 17 : i == 1 ? 22 : i == 2 ? 23 : -1;
    return i == 0 ? 24 : i == 1 ? 25 : i == 2 ? 26 : -1;
}
__device__ __forceinline__ int conv_queue_strips(int q) {
    int n = 0;
    for (int i = 0; i < 8; ++i) { const int e = conv_list(q, i); if (e < 0) break; n += conv_job_tiles(e & 15) >> 3; }
    return n;
}
__device__ __forceinline__ void conv_strip(const Params& p, int q, int c, LAS float* tl) {
    for (int i = 0; i < 8; ++i) {
        const int e = conv_list(q, i);
        if (e < 0) return;
        const int ns = conv_job_tiles(e & 15) >> 3;
        if (c < ns) { const ConvJob job = conv_job(p, e >> 4, e & 15); convert_tiles(job, c * 8, c * 8 + 8, tl); return; }
        c -= ns;
    }
}

__device__ __forceinline__ void convert_p(const Params& p) {
    const f32x4* pl = (const f32x4*)p.in[1]; u32x2* pb = (u32x2*)(p.ws + WS_PBALL);
    for (int i = BID() * 256 + TID(); i < 2 * NT * 256 / 4; i += gridDim.x * 256) {
        const f32x4 v = pl[i]; u32x2 w; w.x = pk2(v.x, v.y); w.y = pk2(v.z, v.w); pb[i] = w;
    }
}
__device__ __forceinline__ void phase_convert(const Params& p, LAS float* tl) {
    {
        int base = 0;
        for (int j = 0; j < 6; ++j) {
            const ConvJob job = conv_job(p, 0, j);
            const int nt = conv_job_tiles(j);
            const int g = gridDim.x, b = BID();
            int first = (b - base % g + g) % g;
            for (int s = first; s < nt; s += g) convert_tiles(job, s, s + 1, tl);
            base += nt;
        }
    }
    {
        const int tid_ = TID(); const int lane = tid_ & 63, gw = BID() * 4 + (tid_ >> 6), ngw = gridDim.x * 4;
        for (int row = gw; row < NT; row += ngw) {
            const f32x4* xr = (const f32x4*)(p.in[0] + (size_t)row * ND) + lane;
            u32x2* o = (u32x2*)((bf16_t*)(p.ws + WS_XN) + (size_t)row * ND) + lane;
            float ss = 0.f;
#pragma unroll
            for (int j = 0; j < 4; ++j) { const f32x4 v = xr[64 * j]; ss += (v.x * v.x + v.y * v.y) + (v.z * v.z + v.w * v.w); u32x2 w; w.x = pk2(v.x, v.y); w.y = pk2(v.z, v.w); o[64 * j] = w; }
            ss = wave_sum(ss);
            if (lane < 16) ((float*)(p.ws + WS_SSP) + (size_t)NT * 16)[(size_t)row * 16 + lane] = lane == 0 ? ss : 0.f;
        }
    }
    for (int i = BID() * 256 + TID(); i < 2 * 1024 * 32; i += gridDim.x * 256) {
        const int l = i >> 15, k = (i >> 5) & 1023, j = i & 31;
        const float gk = p.in[10][l * ND + k];
        const float wv = j < 4 ? p.in[11][(size_t)(l * ND + k) * 4 + j] : (j < 20 ? p.in[13][(size_t)(l * ND + k) * 16 + (j - 4)] : 0.f);
        ((float*)(p.ws + WS_W + (size_t)l * WL_SIZE + WL_RT))[k * 32 + j] = gk * wv;
    }
    for (int i = BID() * 256 + TID(); i < 16 * 1024; i += gridDim.x * 256) {
        const int part = i >> 10, o = i & 1023, l = o >> 9, kv = (o >> 8) & 1, n = o & 255;
        const float* pos = p.in[9] + (size_t)(l * 2 + kv) * 2048 + part * 128;
        const float* w1 = p.in[kv ? 7 : 5] + (size_t)l * 2048 * 256 + (size_t)part * 128 * 256 + n;
        float s = 0.f;
#pragma unroll 16
        for (int k = 0; k < 128; ++k) s += pos[k] * w1[(size_t)k * 256];
        ((float*)(p.ws + WS_BC1P))[i] = s;
    }
}

__device__ __forceinline__ void phase_norm(const float* x, const float* g, bf16_t* xn) {
    const int tid_ = TID(); const int lane = tid_ & 63, gw = BID() * 4 + (tid_ >> 6), ngw = gridDim.x * 4;
    for (int row = gw; row < NT; row += ngw) {
        const f32x4* xr = (const f32x4*)(x + (size_t)row * ND) + lane;
        f32x4 v[4]; float ss = 0.f;
#pragma unroll
        for (int j = 0; j < 4; ++j) { v[j] = xr[64 * j]; ss += (v[j].x * v[j].x + v[j].y * v[j].y) + (v[j].z * v[j].z + v[j].w * v[j].w); }
        ss = wave_sum(ss);
        const float r = 1.0f / sqrtf(ss * (1.0f / ND) + 1e-6f);
        u32x2* o = (u32x2*)(xn + (size_t)row * ND) + lane;
#pragma unroll
        for (int j = 0; j < 4; ++j) {
            const f32x4 gg = ((const f32x4*)g)[lane + 64 * j];
            u32x2 w; w.x = pk2(v[j].x * r * gg.x, v[j].y * r * gg.y); w.y = pk2(v[j].z * r * gg.z, v[j].w * r * gg.w);
            o[64 * j] = w;
        }
    }
}
__device__ __forceinline__ void phase_final_norm(float* x, const float* g) {
    const int tid_ = TID(); const int lane = tid_ & 63, gw = BID() * 4 + (tid_ >> 6), ngw = gridDim.x * 4;
    for (int row = gw; row < NT; row += ngw) {
        f32x4* xr = (f32x4*)(x + (size_t)row * ND) + lane;
        f32x4 v[4]; float ss = 0.f;
#pragma unroll
        for (int j = 0; j < 4; ++j) { v[j] = xr[64 * j]; ss += (v[j].x * v[j].x + v[j].y * v[j].y) + (v[j].z * v[j].z + v[j].w * v[j].w); }
        ss = wave_sum(ss);
        const float r = 1.0f / sqrtf(ss * (1.0f / ND) + 1e-6f);
#pragma unroll
        for (int j = 0; j < 4; ++j) {
            const f32x4 gg = ((const f32x4*)g)[lane + 64 * j];
            f32x4 o; o.x = v[j].x * r * gg.x; o.y = v[j].y * r * gg.y; o.z = v[j].z * r * gg.z; o.w = v[j].w * r * gg.w;
            xr[64 * j] = o;
        }
    }
}
typedef float f32x16r __attribute__((ext_vector_type(16)));
__device__ __forceinline__ void phase_route(const float* x, const float* wr, const float* brg, const float* bre, int* cnt, int* list, float* route, float* rinv, LAS unsigned char* lds) {
    const int tid_ = TID(); const int lane = tid_ & 63, wv = tid_ >> 6;
    const int i = lane & 31, hk = lane >> 5;
    LAS float* tl = (LAS float*)lds + wv * (32 * 33);
    LAS float* ssl = (LAS float*)(lds + 4 * 32 * 33 * 4);
    for (int task = BID(); task < NT / 32; task += gridDim.x) {
        const int row0 = task * 32;
        const float* xr = x + (size_t)(row0 + i) * ND + wv * 256;
        const float* wp = wr + (size_t)(wv * 256) * 32 + hk * 32 + i;
        f32x16r acc;
#pragma unroll
        for (int q = 0; q < 16; ++q) acc[q] = 0.f;
        float ss = 0.f;
#pragma unroll 16
        for (int k4 = 0; k4 < 64; ++k4) {
            const f32x4 xa = *(const f32x4*)(xr + 4 * k4);
            const float w0 = wp[(4 * k4) * 32], w1 = wp[(4 * k4 + 2) * 32];
            const float a0 = hk ? xa.y : xa.x, a1 = hk ? xa.w : xa.z;
            acc = __builtin_amdgcn_mfma_f32_32x32x2f32(a0, w0, acc, 0, 0, 0);
            acc = __builtin_amdgcn_mfma_f32_32x32x2f32(a1, w1, acc, 0, 0, 0);
            ss += a0 * a0 + a1 * a1;
        }
        ss += __shfl_xor(ss, 32);
#pragma unroll
        for (int q = 0; q < 16; ++q) tl[((q & 3) + 8 * (q >> 2) + 4 * hk) * 33 + i] = acc[q];
        if (hk == 0) ssl[wv * 32 + i] = ss;
        __syncthreads();
        if (wv == 0 && hk == 0) {
            LAS const float* tp0 = (LAS const float*)lds;
            const float sst = (ssl[i] + ssl[32 + i]) + (ssl[64 + i] + ssl[96 + i]);
            const float r = 1.0f / sqrtf(sst * (1.0f / ND) + 1e-6f);
#define RT_SUM(e_) ((tp0[i * 33 + (e_)] + tp0[32 * 33 + i * 33 + (e_)]) + (tp0[2 * 32 * 33 + i * 33 + (e_)] + tp0[3 * 32 * 33 + i * 33 + (e_)]))
            float gl[4], el[16];
#pragma unroll
            for (int e = 0; e < 4; ++e) gl[e] = RT_SUM(e) * r + brg[e];
#pragma unroll
            for (int e = 0; e < 16; ++e) el[e] = RT_SUM(4 + e) * r + bre[e];
#undef RT_SUM
            int gsel = 0; float gmax = gl[0];
#pragma unroll
            for (int e = 1; e < 4; ++e) if (gl[e] > gmax) { gmax = gl[e]; gsel = e; }
            float gden = 0.f;
#pragma unroll
            for (int e = 0; e < 4; ++e) gden += __expf(gl[e] - gmax);
            const float gw_ = 1.0f / gden;
            float wi[4];
#pragma unroll
            for (int e = 0; e < 4; ++e) wi[e] = gsel == 0 ? el[e] : (gsel == 1 ? el[4 + e] : (gsel == 2 ? el[8 + e] : el[12 + e]));
            int i0 = 0; float t0 = wi[0];
#pragma unroll
            for (int e = 1; e < 4; ++e) if (wi[e] > t0) { t0 = wi[e]; i0 = e; }
            int i1 = -1; float t1 = -3.0e38f;
#pragma unroll
            for (int e = 0; e < 4; ++e) if (e != i0 && wi[e] > t1) { t1 = wi[e]; i1 = e; }
            const float ex = __expf(t1 - t0);
            const float ew0 = gw_ / (1.0f + ex), ew1 = gw_ * ex / (1.0f + ex);
            const int lo = i0 < i1 ? i0 : i1, hi = i0 < i1 ? i1 : i0;
            const float wlo = i0 < i1 ? ew0 : ew1, whi = i0 < i1 ? ew1 : ew0;
            const int pidx = lo == 0 ? hi - 1 : (lo == 1 ? hi + 1 : 5);
            const int bucket = gsel * 6 + pidx;
            const int row = row0 + i;
            const int pos = atomicAdd(cnt + 64 * bucket, 1);
            list[(size_t)bucket * NT + pos] = row;
            route[2 * row] = wlo; route[2 * row + 1] = whi;
            rinv[row] = r;
        }
        __syncthreads();
    }
}

struct APlain { const bf16_t* base; int ld; __device__ __forceinline__ const bf16_t* operator()(int r) const { return base + (size_t)r * ld; } };
struct ACmp { const bf16_t* base; __device__ __forceinline__ const bf16_t* operator()(int r) const { return base + (size_t)(r < 126 ? r : 126) * 1024; } };
struct AGather { const bf16_t* xn; const int* list; int cnt; __device__ __forceinline__ const bf16_t* operator()(int r) const { return xn + (size_t)(r < cnt ? list[r] : 0) * ND; } };
struct BPlain { const bf16_t* base; int ld; __device__ __forceinline__ const bf16_t* operator()(int r, int k0) const { return base + (size_t)r * ld + k0; } };
struct BSplit { const bf16_t* b0; const bf16_t* b1; __device__ __forceinline__ const bf16_t* operator()(int r, int k0) const { return k0 < 512 ? b0 + (size_t)r * 512 + k0 : b1 + (size_t)r * 512 + (k0 - 512); } };

template <class AP, class BP, class APN, class BPN>
__device__ __forceinline__ void gemm_kloop(f32x4 (&acc)[4][4], const AP& ap, const BP& bp, int K, LAS unsigned char* lds, bool prefetched, bool has_next, const APN& apn, const BPN& bpn) {
    const int tid = TID(), wid = tid >> 6, lane = tid & 63, wr = wid >> 1, wc = wid & 1, fr = lane & 15, fq = lane >> 4;
#if NAIVE_GEMM
    for (int k0 = 0; k0 < K; k0 += 32) {
#pragma unroll
        for (int m = 0; m < 4; ++m) {
            const bf16_t* arow = ap(wr * 64 + m * 16 + fr) + k0;
            u32x4 av[4];
#pragma unroll
            for (int c = 0; c < 4; ++c) av[c] = ((const u32x4*)arow)[c];
#pragma unroll
            for (int n = 0; n < 4; ++n)
#pragma unroll
                for (int j = 0; j < 4; ++j) {
                    const bf16_t* brow = bp(wc * 64 + n * 16 + 4 * fq + j, k0);
                    float s = 0.f;
#pragma unroll
                    for (int c = 0; c < 4; ++c) {
                        const u32x4 bv = ((const u32x4*)brow)[c];
                        s += bflo(av[c].x) * bflo(bv.x) + bfhi(av[c].x) * bfhi(bv.x) + bflo(av[c].y) * bflo(bv.y) + bfhi(av[c].y) * bfhi(bv.y)
                           + bflo(av[c].z) * bflo(bv.z) + bfhi(av[c].z) * bfhi(bv.z) + bflo(av[c].w) * bflo(bv.w) + bfhi(av[c].w) * bfhi(bv.w);
                    }
                    acc[m][n][j] += s;
                }
        }
    }
#else
    const unsigned woff = (unsigned)wid * 1024u;
    const bf16_t* aptr[4]; int brow[4], bcol;
    {
        const int sb = lane * 16, swz = sb ^ (((sb >> 9) & 1) << 5);
        const int rl = swz >> 6, cc = (wid & 1) * 32 + ((swz & 63) >> 1);
        bcol = cc;
#pragma unroll
        for (int i = 0; i < 4; ++i) { const int R = ((wid >> 1) + 2 * i) * 16 + rl; aptr[i] = ap(R) + cc; brow[i] = R; }
    }
    int aoff[4], boff[4];
#pragma unroll
    for (int m = 0; m < 4; ++m) {
        { const int r = wr * 64 + m * 16 + fr, c = fq * 8, st = (r >> 4) * 2, ob = (r & 15) * 64 + c * 2; aoff[m] = st * 1024 + (ob ^ (((ob >> 9) & 1) << 5)); }
        { const int r = wc * 64 + m * 16 + fr, c = fq * 8, st = (r >> 4) * 2, ob = (r & 15) * 64 + c * 2; boff[m] = st * 1024 + (ob ^ (((ob >> 9) & 1) << 5)); }
    }
    const int nk = K / 64;
#define GT_STAGE(buf, t) do { const int _k0 = (t) * 64; LAS unsigned char* _ba = lds + (buf) * 32768 + woff; \
        _Pragma("unroll") for (int _i = 0; _i < 4; ++_i) { \
            __builtin_amdgcn_global_load_lds((const unsigned*)(aptr[_i] + _k0), (LAS unsigned*)(_ba + _i * 4096), 16, 0, 0); \
            __builtin_amdgcn_global_load_lds((const unsigned*)(bp(brow[_i], _k0) + bcol), (LAS unsigned*)(_ba + 16384 + _i * 4096), 16, 0, 0); } } while (0)
    if (!prefetched) GT_STAGE(0, 0);
#pragma unroll 1
    for (int t = 0; t < nk; ++t) {
        asm volatile("s_waitcnt vmcnt(0)" ::: "memory");
        __syncthreads();
        if (t + 1 < nk) GT_STAGE((t + 1) & 1, t + 1);
        else if (has_next) {
            LAS unsigned char* _ba = lds + woff;
#pragma unroll
            for (int _i = 0; _i < 4; ++_i) {
                __builtin_amdgcn_global_load_lds((const unsigned*)(apn(brow[_i]) + bcol), (LAS unsigned*)(_ba + _i * 4096), 16, 0, 0);
                __builtin_amdgcn_global_load_lds((const unsigned*)(bpn(brow[_i], 0) + bcol), (LAS unsigned*)(_ba + 16384 + _i * 4096), 16, 0, 0);
            }
        }
        LAS const unsigned char* la = lds + (t & 1) * 32768;
        LAS const unsigned char* lb = la + 16384;
#pragma unroll
        for (int kh = 0; kh < 2; ++kh) {
            bf16x8 At[4], Bt[4];
#pragma unroll
            for (int m = 0; m < 4; ++m) At[m] = *(const LAS bf16x8*)(la + aoff[m] + kh * 1024);
#pragma unroll
            for (int n = 0; n < 4; ++n) Bt[n] = *(const LAS bf16x8*)(lb + boff[n] + kh * 1024);
#pragma unroll
            for (int m = 0; m < 4; ++m)
#pragma unroll
                for (int n = 0; n < 4; ++n) acc[m][n] = __builtin_amdgcn_mfma_f32_16x16x32_bf16(Bt[n], At[m], acc[m][n], 0, 0, 0);
        }
    }
#undef GT_STAGE
#endif
}
__device__ __forceinline__ void zero_acc(f32x4 (&acc)[4][4]) {
#pragma unroll
    for (int m = 0; m < 4; ++m)
#pragma unroll
        for (int n = 0; n < 4; ++n) acc[m][n] = (f32x4){0.f, 0.f, 0.f, 0.f};
}
template <class AP, class BP, class EPI>
__device__ __forceinline__ void gemm_tile(const AP& ap, const BP& bp, int K, const EPI& epi, LAS unsigned char* lds, bool prefetched, bool has_next, const AP& apn, const BP& bpn) {
    const int tid = TID(), wid = tid >> 6, lane = tid & 63, wr = wid >> 1, wc = wid & 1, fr = lane & 15, fq = lane >> 4;
    f32x4 acc[4][4]; zero_acc(acc);
    gemm_kloop(acc, ap, bp, K, lds, prefetched, has_next, apn, bpn);
    epi(acc, wr, wc, fr, fq);
}

__device__ __forceinline__ float rinv_from_ssp(const float* ssp, int row) {
    const f32x4* q = (const f32x4*)(ssp + (size_t)row * 16);
    const f32x4 a = q[0], b = q[1], c = q[2], d = q[3];
    const float s = ((a.x + a.y) + (a.z + a.w)) + ((b.x + b.y) + (b.z + b.w)) + ((c.x + c.y) + (c.z + c.w)) + ((d.x + d.y) + (d.z + d.w));
    return 1.0f / sqrtf(s * (1.0f / ND) + 1e-6f);
}
__device__ __forceinline__ float row_ss64(const f32x4& a, const f32x4& b, const f32x4& c, const f32x4& d) {
    float s = ((a.x * a.x + a.y * a.y) + (a.z * a.z + a.w * a.w)) + ((b.x * b.x + b.y * b.y) + (b.z * b.z + b.w * b.w))
            + ((c.x * c.x + c.y * c.y) + (c.z * c.z + c.w * c.w)) + ((d.x * d.x + d.y * d.y) + (d.z * d.z + d.w * d.w));
    s += __shfl_xor(s, 16); s += __shfl_xor(s, 32);
    return s;
}
struct EpiInProj {
    int mt, nt; unsigned char* ws; const float* ssp;
    __device__ __forceinline__ void operator()(const f32x4 (&acc)[4][4], int wr, int wc, int fr, int fq) const {
#pragma unroll
        for (int m = 0; m < 4; ++m) {
            const int row = mt * 128 + wr * 64 + m * 16 + fr, b = row >> 11, s = row & 2047;
            const float rr = rinv_from_ssp(ssp, row);
#pragma unroll
            for (int n = 0; n < 4; ++n) {
                const int col = wc * 64 + n * 16 + 4 * fq;
                const f32x4 v = acc[m][n] * rr;
                if (nt < 16) {
                    const int reg = nt >> 2, c = (nt & 3) * 128 + col, head = c >> 6, d = c & 63;
                    const float sc = (reg == 0 || reg == 3) ? 0.125f * 1.4426950408889634f : 1.0f;
                    bf16_t* dst = (bf16_t*)(ws + WS_QA + (size_t)reg * 16 * MiB) + ((size_t)((b * 8 + head) * NS + s) * 64 + d);
                    u32x2 w; w.x = pk2(v.x * sc, v.y * sc); w.y = pk2(v.z * sc, v.w * sc);
                    *(u32x2*)dst = w;
                } else if (nt < 22) {
                    const int g = col >> 6, d = col & 63;
                    bf16_t* dst = (bf16_t*)(ws + WS_KV6 + (size_t)(nt - 16) * 4 * MiB) + ((size_t)((b * 2 + g) * NS + s) * 64 + d);
                    u32x2 w; w.x = pk2(v.x, v.y); w.y = pk2(v.z, v.w);
                    *(u32x2*)dst = w;
                } else {
                    if (col < 24) {
                        f32x4 o; o.x = sigmoidf_(v.x); o.y = sigmoidf_(v.y); o.z = sigmoidf_(v.z); o.w = sigmoidf_(v.w);
                        *(f32x4*)((float*)(ws + WS_GATES) + (size_t)row * 24 + col) = o;
                    }
                }
            }
        }
    }
};
struct EpiCmp1 {
    bf16_t* hc; const float* bc1; int row0, col0;
    __device__ __forceinline__ void operator()(const f32x4 (&acc)[4][4], int wr, int wc, int fr, int fq) const {
#pragma unroll
        for (int m = 0; m < 4; ++m) {
            const int row = row0 + wr * 64 + m * 16 + fr;
#pragma unroll
            for (int n = 0; n < 4; ++n) {
                const int col = col0 + wc * 64 + n * 16 + 4 * fq;
                f32x4 bb = *(const f32x4*)(bc1 + col);
#pragma unroll
                for (int pp = 1; pp < 16; ++pp) bb += *(const f32x4*)(bc1 + pp * 1024 + col);
                const f32x4 v = acc[m][n];
                u32x2 w; w.x = pk2(gelu_tanh(v.x + bb.x), gelu_tanh(v.y + bb.y)); w.y = pk2(gelu_tanh(v.z + bb.z), gelu_tanh(v.w + bb.w));
                *(u32x2*)(hc + (size_t)row * 256 + col) = w;
            }
        }
    }
};
struct EpiCmp2 {
    bf16_t* dst; int row0;
    __device__ __forceinline__ void operator()(const f32x4 (&acc)[4][4], int wr, int wc, int fr, int fq) const {
        if (wc != 0) return;
#pragma unroll
        for (int m = 0; m < 4; ++m) {
            const int row = row0 + wr * 64 + m * 16 + fr;
#pragma unroll
            for (int n = 0; n < 4; ++n) {
                const int col = n * 16 + 4 * fq;
                const f32x4 v = acc[m][n];
                u32x2 w; w.x = pk2(v.x, v.y); w.y = pk2(v.z, v.w);
                *(u32x2*)(dst + (size_t)row * 64 + col) = w;
            }
        }
    }
};
struct EpiResAdd {
    const float* base; float* out; bf16_t* xb; int row0, col0; float sc;
    __device__ __forceinline__ void operator()(const f32x4 (&acc)[4][4], int wr, int wc, int fr, int fq) const {
#pragma unroll
        for (int m = 0; m < 4; ++m) {
            const int row = row0 + wr * 64 + m * 16 + fr;
#pragma unroll
            for (int n = 0; n < 4; ++n) {
                const int col = col0 + wc * 64 + n * 16 + 4 * fq;
                const size_t off = (size_t)row * ND + col;
                const f32x4 bs = *(const f32x4*)(base + off);
                const f32x4 nv = bs + acc[m][n] * sc;
                *(f32x4*)(out + off) = nv;
                u32x2 w; w.x = pk2(nv.x, nv.y); w.y = pk2(nv.z, nv.w);
                *(u32x2*)(xb + off) = w;
            }
        }
    }
};
struct EpiMoeGU {
    bf16_t* hid; const int* list; const float* route; const float* rinv; int cnt, hrow0, nt16;
    __device__ __forceinline__ void operator()(const f32x4 (&acc)[4][4], int wr, int wc, int fr, int fq) const {
        const int half = nt16 >> 3, nte = nt16 & 7;
#pragma unroll
        for (int m = 0; m < 4; ++m) {
            const int r = wr * 64 + m * 16 + fr;
            const int tok = r < cnt ? list[r] : 0;
            const float w = r < cnt ? route[2 * tok + half] : 0.f;
            const float rt = rinv[tok];
#pragma unroll
            for (int pr = 0; pr < 2; ++pr) {
                const f32x4 gv = acc[m][2 * pr], uv = acc[m][2 * pr + 1];
                const int hc = half * 512 + (4 * nte + 2 * wc + pr) * 16 + 4 * fq;
                float h[4];
#pragma unroll
                for (int j = 0; j < 4; ++j) { const float gg = gv[j] * rt; h[j] = gg / (1.0f + __expf(-gg)) * (uv[j] * rt) * w; }
                u32x2 o; o.x = pk2(h[0], h[1]); o.y = pk2(h[2], h[3]);
                *(u32x2*)(hid + (size_t)(hrow0 + r) * 1024 + hc) = o;
            }
        }
    }
};
struct EpiMoeDown {
    float* out; const int* list; bf16_t* xb; float* ssp; int cnt, col0;
    __device__ __forceinline__ void operator()(const f32x4 (&acc)[4][4], int wr, int wc, int fr, int fq) const {
#pragma unroll
        for (int m = 0; m < 4; ++m) {
            const int r = wr * 64 + m * 16 + fr;
            const bool ok = r < cnt;
            const int tok = ok ? list[r] : 0;
            f32x4 nv[4];
#pragma unroll
            for (int n = 0; n < 4; ++n) {
                const int col = col0 + wc * 64 + n * 16 + 4 * fq;
                const size_t off = (size_t)tok * ND + col;
                nv[n] = *(const f32x4*)(out + off) + acc[m][n];
                if (ok) {
                    *(f32x4*)(out + off) = nv[n];
                    u32x2 w; w.x = pk2(nv[n].x, nv[n].y); w.y = pk2(nv[n].z, nv[n].w);
                    *(u32x2*)(xb + off) = w;
                }
            }
            const float ps = row_ss64(nv[0], nv[1], nv[2], nv[3]);
            if (ok && fq == 0) ssp[(size_t)tok * 16 + (col0 >> 6) + wc] = ps;
        }
    }
};
struct EpiBf16 {
    bf16_t* dst; int ld, row0, col0;
    __device__ __forceinline__ void operator()(const f32x4 (&acc)[4][4], int wr, int wc, int fr, int fq) const {
#pragma unroll
        for (int m = 0; m < 4; ++m) {
            const int row = row0 + wr * 64 + m * 16 + fr;
#pragma unroll
            for (int n = 0; n < 4; ++n) {
                const int col = col0 + wc * 64 + n * 16 + 4 * fq;
                const f32x4 v = acc[m][n];
                u32x2 w; w.x = pk2(v.x, v.y); w.y = pk2(v.z, v.w);
                *(u32x2*)(dst + (size_t)row * ld + col) = w;
            }
        }
    }
};
struct EpiPleFused {
    float* out; const float* ssp_in; bf16_t* xbo; float* ssp_out; int row0, col0;
    __device__ __forceinline__ void operator()(const f32x4 (&acc)[4][4], const f32x4 (&acc2)[4][4], int wr, int wc, int fr, int fq) const {
#pragma unroll
        for (int m = 0; m < 4; ++m) {
            const int row = row0 + wr * 64 + m * 16 + fr;
            const float rr = rinv_from_ssp(ssp_in, row);
            f32x4 nv[4];
#pragma unroll
            for (int n = 0; n < 4; ++n) {
                const int col = col0 + wc * 64 + n * 16 + 4 * fq;
                const size_t off = (size_t)row * ND + col;
                const f32x4 v = acc[m][n] * rr, q = acc2[m][n];
                f32x4 o = *(const f32x4*)(out + off);
                o.x += sigmoidf_(v.x) * q.x; o.y += sigmoidf_(v.y) * q.y; o.z += sigmoidf_(v.z) * q.z; o.w += sigmoidf_(v.w) * q.w;
                *(f32x4*)(out + off) = o;
                u32x2 w; w.x = pk2(o.x, o.y); w.y = pk2(o.z, o.w);
                *(u32x2*)(xbo + off) = w;
                nv[n] = o;
            }
            const float ps = row_ss64(nv[0], nv[1], nv[2], nv[3]);
            if (fq == 0) ssp_out[(size_t)row * 16 + (col0 >> 6) + wc] = ps;
            asm volatile("" ::: "memory");
        }
    }
};
struct EpiPleGate {
    float* out; const bf16_t* p2; int row0, col0; float sc;
    __device__ __forceinline__ void operator()(const f32x4 (&acc)[4][4], int wr, int wc, int fr, int fq) const {
#pragma unroll
        for (int m = 0; m < 4; ++m) {
            const int row = row0 + wr * 64 + m * 16 + fr;
#pragma unroll
            for (int n = 0; n < 4; ++n) {
                const int col = col0 + wc * 64 + n * 16 + 4 * fq;
                const size_t off = (size_t)row * ND + col;
                const u32x2 pv = *(const u32x2*)(p2 + off);
                const f32x4 v = acc[m][n];
                f32x4 o = *(const f32x4*)(out + off);
                o.x += sc * sigmoidf_(v.x) * bflo(pv.x); o.y += sc * sigmoidf_(v.y) * bfhi(pv.x); o.z += sc * sigmoidf_(v.z) * bflo(pv.y); o.w += sc * sigmoidf_(v.w) * bfhi(pv.y);
                *(f32x4*)(out + off) = o;
            }
        }
    }
};

template <class PH, class AP, class BP, class EPI>
__device__ __forceinline__ void gemm_stream(const PH& ph, int first, int step, int count, int K, LAS unsigned char* lds) {
    int q = first;
    if (q >= count) return;
    AP ap, apn; BP bp, bpn; EPI ep, epn;
    ph.make(q, ap, bp, ep);
    bool pref = false;
    for (;;) {
        const int qn = q + step; const bool hn = qn < count;
        if (hn) ph.make(qn, apn, bpn, epn); else { apn = ap; bpn = bp; epn = ep; }
        gemm_tile(ap, bp, K, ep, lds, pref, hn, apn, bpn);
        if (!hn) break;
        ap = apn; bp = bpn; ep = epn; q = qn; pref = true;
    }
}

__device__ __forceinline__ void load_q32(const bf16_t* p, float* q) {
#pragma unroll
    for (int c = 0; c < 4; ++c) {
        const u32x4 v = ((const u32x4*)p)[c];
        q[8 * c] = bflo(v.x); q[8 * c + 1] = bfhi(v.x); q[8 * c + 2] = bflo(v.y); q[8 * c + 3] = bfhi(v.y);
        q[8 * c + 4] = bflo(v.z); q[8 * c + 5] = bfhi(v.z); q[8 * c + 6] = bflo(v.w); q[8 * c + 7] = bfhi(v.w);
    }
}
__device__ __forceinline__ float dot32p(const float* q, const bf16_t* k) {
    float s0 = 0.f, s1 = 0.f;
#pragma unroll
    for (int c = 0; c < 4; ++c) {
        const u32x4 v = ((const u32x4*)k)[c];
        s0 += q[8 * c] * bflo(v.x); s1 += q[8 * c + 1] * bfhi(v.x); s0 += q[8 * c + 2] * bflo(v.y); s1 += q[8 * c + 3] * bfhi(v.y);
        s0 += q[8 * c + 4] * bflo(v.z); s1 += q[8 * c + 5] * bfhi(v.z); s0 += q[8 * c + 6] * bflo(v.w); s1 += q[8 * c + 7] * bfhi(v.w);
    }
    const float s = s0 + s1;
    return s + __shfl_xor(s, 1);
}
__device__ __forceinline__ void axpy32(float* a, float p, const bf16_t* vr) {
#pragma unroll
    for (int c = 0; c < 4; ++c) {
        const u32x4 v = ((const u32x4*)vr)[c];
        a[8 * c] += p * bflo(v.x); a[8 * c + 1] += p * bfhi(v.x); a[8 * c + 2] += p * bflo(v.y); a[8 * c + 3] += p * bfhi(v.y);
        a[8 * c + 4] += p * bflo(v.z); a[8 * c + 5] += p * bfhi(v.z); a[8 * c + 6] += p * bflo(v.w); a[8 * c + 7] += p * bfhi(v.w);
    }
}
#define ONLINE_STEP(s_, vrow_) do { const float _s = (s_); if (_s > mx) { const float _c = __expf(mx - _s); l *= _c; _Pragma("unroll") for (int _i = 0; _i < 32; ++_i) acc[_i] *= _c; mx = _s; } \
    const float _p = __expf(_s - mx); l += _p; axpy32(acc, _p, (vrow_)); } while (0)

__device__ __forceinline__ void store_o32(bf16_t* dst, const float* a, float sc) {
#pragma unroll
    for (int c = 0; c < 4; ++c) {
        u32x4 w; w.x = pk2(a[8 * c] * sc, a[8 * c + 1] * sc); w.y = pk2(a[8 * c + 2] * sc, a[8 * c + 3] * sc);
        w.z = pk2(a[8 * c + 4] * sc, a[8 * c + 5] * sc); w.w = pk2(a[8 * c + 6] * sc, a[8 * c + 7] * sc);
        ((u32x4*)dst)[c] = w;
    }
}

__device__ __forceinline__ void attn_dilated_naive(const unsigned char* ws, int gtid, int gthreads) {
    asm volatile("" : "+v"(gtid));
    const bf16_t* qa = (const bf16_t*)(ws + WS_QA); const bf16_t* ka = (const bf16_t*)(ws + WS_KA); const bf16_t* va = (const bf16_t*)(ws + WS_VA);
    bf16_t* ob = (bf16_t*)(ws + WS_O);
    for (int id2 = gtid; id2 < NB * 8 * NS * 2; id2 += gthreads) {
        const int idx = id2 >> 1, hf = (id2 & 1) * 32;
        const int t = idx & 2047, bh = idx >> 11, h = bh & 7, b = bh >> 3;
        float q[32]; load_q32(qa + (size_t)idx * 64 + hf, q);
        const bf16_t* kb = ka + (size_t)bh * NS * 64 + hf; const bf16_t* vb = va + (size_t)bh * NS * 64 + hf;
        const float slope = exp2f(-((float)h + 0.5f));
        float mx = -1e30f, l = 0.f; float acc[32];
#pragma unroll
        for (int i = 0; i < 32; ++i) acc[i] = 0.f;
#pragma unroll 1
        for (int pat = 0; pat < 3; ++pat) {
            const int dil = pat == 0 ? 1 : (pat == 1 ? 4 : 16);
#pragma unroll 1
            for (int j = 0; j <= 128; ++j) {
                const int dist = j * dil, pos = t - dist;
                if (pos < 0) break;
                const float s = dot32p(q, kb + (size_t)pos * 64) - slope * (float)dist;
                ONLINE_STEP(s, vb + (size_t)pos * 64);
            }
        }
        store_o32(ob + ((size_t)(b * NS + t) * ND + h * 64 + hf), acc, 1.0f / l);
    }
}

__device__ __forceinline__ void nsa_imp_naive(const unsigned char* ws, int gtid, int gthreads) {
    asm volatile("" : "+v"(gtid));
    const bf16_t* qb = (const bf16_t*)(ws + WS_QB); const bf16_t* kcmp = (const bf16_t*)(ws + WS_KCMP);
    float* imph = (float*)(ws + WS_IMPH);
    for (int id2 = gtid; id2 < NB * 8 * NS * 2; id2 += gthreads) {
        const int idx = id2 >> 1, hf = (id2 & 1) * 32;
        const int t = idx & 2047, bh = idx >> 11, hb = bh & 7, b = bh >> 3, g = hb >> 2;
        float q[32]; load_q32(qb + (size_t)idx * 64 + hf, q);
        const bf16_t* kc = kcmp + (size_t)(b * 2 + g) * 128 * 64 + hf;
        const float slope = exp2f(-(float)(hb + 1));
        const int ncv = t >= 31 ? ((t - 31) >> 4) + 1 : 0;
        float mx = -1e30f;
#pragma unroll 1
        for (int c = 0; c < ncv; ++c) { const float s = dot32p(q, kc + c * 64) - slope * (float)(t - (16 * c + 31)); mx = fmaxf(mx, s); }
        float den = 0.f;
#pragma unroll 1
        for (int c = 0; c < ncv; ++c) { const float s = dot32p(q, kc + c * 64) - slope * (float)(t - (16 * c + 31)); den += __expf(s - mx); }
        const float inv = ncv > 0 ? 1.0f / den : 0.f;
#pragma unroll 1
        for (int n = 0; n < 32; ++n) {
            float imp = 0.f;
#pragma unroll 1
            for (int j = -1; j <= 3; ++j) {
                const int c = 4 * n + j;
                if (c >= 0 && c < ncv) {
                    const float s = dot32p(q, kc + c * 64) - slope * (float)(t - (16 * c + 31));
                    const float pp = __expf(s - mx) * inv;
                    imp += (j == -1 || j == 3) ? 0.5f * pp : pp;
                }
            }
            if (hf == 0) imph[(size_t)idx * 32 + n] = imp;
        }
    }
}
__device__ __forceinline__ void nsa_select(const unsigned char* ws, unsigned* maskbuf) {
    const float* imph = (const float*)(ws + WS_IMPH);
    const int tid_ = TID(); const int lane = tid_ & 63, gw = BID() * 4 + (tid_ >> 6), ngw = gridDim.x * 4;
    for (int it = gw; it < NB * 2 * NS / 2; it += ngw) {
        const int item = it * 2 + (lane >> 5), t = item & 2047, bg = item >> 11, n = lane & 31;
        float imp = 0.f;
#pragma unroll
        for (int r = 0; r < 4; ++r) imp += imph[((size_t)(bg * 4 + r) * NS + t) * 32 + n];
        const int cur = t >> 6;
        const bool valid = n <= cur;
        const bool forced = (n == 0) || (cur - n < 2);
        const float score = valid ? imp + (forced ? 1e4f : 0.f) : -1e30f;
        int rank = 0;
        for (int m = 0; m < 32; ++m) {
            const float sm = __shfl(score, (lane & 32) | m);
            rank += (sm > score || (sm == score && m < n)) ? 1 : 0;
        }
        const bool sel = valid && rank < 16;
        const unsigned long long bal = __ballot(sel);
        if (n == 0) maskbuf[item] = (lane >> 5) ? (unsigned)(bal >> 32) : (unsigned)bal;
    }
}
__device__ __forceinline__ void nsa_attn_naive(const unsigned char* ws, int gtid, int gthreads) {
    asm volatile("" : "+v"(gtid));
    const bf16_t* qb = (const bf16_t*)(ws + WS_QB);
    const bf16_t* kcmp = (const bf16_t*)(ws + WS_KCMP); const bf16_t* vcmp = kcmp + (size_t)16 * 128 * 64;
    const bf16_t* ksb = (const bf16_t*)(ws + WS_KV6 + 2 * 4 * MiB); const bf16_t* vsb = (const bf16_t*)(ws + WS_KV6 + 3 * 4 * MiB);
    const bf16_t* kwb = (const bf16_t*)(ws + WS_KV6 + 4 * 4 * MiB); const bf16_t* vwb = (const bf16_t*)(ws + WS_KV6 + 5 * 4 * MiB);
    const float* gates = (const float*)(ws + WS_GATES);
    const unsigned* maskbuf = (const unsigned*)(ws + WS_MASK);
    bf16_t* ob = (bf16_t*)(ws + WS_O);
    for (int id2 = gtid; id2 < NB * 8 * NS * 2; id2 += gthreads) {
        const int idx = id2 >> 1, hf = (id2 & 1) * 32;
        const int t = idx & 2047, bh = idx >> 11, hb = bh & 7, b = bh >> 3, g = hb >> 2, bg = b * 2 + g;
        float q[32]; load_q32(qb + (size_t)idx * 64 + hf, q);
        const float slope = exp2f(-(float)(hb + 1));
        const float* gt = gates + (size_t)(b * NS + t) * 24 + hb * 3;
        float tot[32], acc[32];
#pragma unroll
        for (int i = 0; i < 32; ++i) tot[i] = 0.f;
        {
            const bf16_t* kc = kcmp + (size_t)bg * 128 * 64 + hf; const bf16_t* vc = vcmp + (size_t)bg * 128 * 64 + hf;
            const int ncv = t >= 31 ? ((t - 31) >> 4) + 1 : 0;
            if (ncv > 0) {
                float mx = -1e30f, l = 0.f;
#pragma unroll
                for (int i = 0; i < 32; ++i) acc[i] = 0.f;
#pragma unroll 1
                for (int c = 0; c < ncv; ++c) { const float s = dot32p(q, kc + c * 64) - slope * (float)(t - (16 * c + 31)); ONLINE_STEP(s, vc + c * 64); }
                const float sc = gt[0] / l;
#pragma unroll
                for (int i = 0; i < 32; ++i) tot[i] += sc * acc[i];
            }
        }
        {
            const bf16_t* kb = ksb + (size_t)bg * NS * 64 + hf; const bf16_t* vb = vsb + (size_t)bg * NS * 64 + hf;
            const unsigned mask = maskbuf[bg * NS + t];
            float mx = -1e30f, l = 0.f;
#pragma unroll
            for (int i = 0; i < 32; ++i) acc[i] = 0.f;
#pragma unroll 1
            for (int n = 0; n < 32; ++n) {
                if (!((mask >> n) & 1u)) continue;
#pragma unroll 1
                for (int i = 0; i < 64; ++i) {
                    const int pos = n * 64 + i;
                    if (pos > t) break;
                    const float s = dot32p(q, kb + (size_t)pos * 64) - slope * (float)(t - pos);
                    ONLINE_STEP(s, vb + (size_t)pos * 64);
                }
            }
            const float sc = gt[1] / l;
#pragma unroll
            for (int i = 0; i < 32; ++i) tot[i] += sc * acc[i];
        }
        {
            const bf16_t* kb = kwb + (size_t)bg * NS * 64 + hf; const bf16_t* vb = vwb + (size_t)bg * NS * 64 + hf;
            float mx = -1e30f, l = 0.f;
#pragma unroll
            for (int i = 0; i < 32; ++i) acc[i] = 0.f;
#pragma unroll 1
            for (int dist = 0; dist < 512; ++dist) {
                const int pos = t - dist;
                if (pos < 0) break;
                const float s = dot32p(q, kb + (size_t)pos * 64) - slope * (float)dist;
                ONLINE_STEP(s, vb + (size_t)pos * 64);
            }
            const float sc = gt[2] / l;
#pragma unroll
            for (int i = 0; i < 32; ++i) tot[i] += sc * acc[i];
        }
        store_o32(ob + ((size_t)(b * NS + t) * ND + 512 + hb * 64 + hf), tot, 1.0f);
    }
}

constexpr int KVS = 144;
constexpr int KVT = 64 * KVS;
#define LOG2E_F 1.4426950408889634f
__device__ __forceinline__ unsigned cvtpk(float lo, float hi) { f32x2_t v = {lo, hi}; bf16x2_t b = __builtin_convertvector(v, bf16x2_t); return __builtin_bit_cast(unsigned, b); }
__device__ __forceinline__ s16x4 vtr(LAS const unsigned char* p) { return __builtin_bit_cast(s16x4, __builtin_amdgcn_ds_read_tr16_b64_v4i16((LAS s16x4*)p)); }
__device__ __forceinline__ f32x16 zero16() { f32x16 z;
#pragma unroll
    for (int i = 0; i < 16; ++i) z[i] = 0.f;
    return z; }

__device__ __forceinline__ void load_kv_tile(LAS unsigned char* Kt, LAS unsigned char* Vt, const bf16_t* kbase, const bf16_t* vbase, int row0, int rstride, int rmin, int rmax, int tid) {
    const int j = tid >> 2, ch = tid & 3;
    int tok = row0 + j * rstride; tok = tok < rmin ? rmin : (tok > rmax ? rmax : tok);
    const u32x4* kp = (const u32x4*)(kbase + (size_t)tok * 64);
    const u32x4* vp = (const u32x4*)(vbase + (size_t)tok * 64);
    const u32x4 k0 = kp[ch], k1 = kp[ch + 4], v0 = vp[ch], v1 = vp[ch + 4];
    *(LAS u32x4*)(Kt + j * KVS + ch * 16) = k0; *(LAS u32x4*)(Kt + j * KVS + (ch + 4) * 16) = k1;
    *(LAS u32x4*)(Vt + j * KVS + ch * 16) = v0; *(LAS u32x4*)(Vt + j * KVS + (ch + 4) * 16) = v1;
}

struct KVRegs { u32x4 k0, k1, v0, v1; };
__device__ __forceinline__ void kv_fetch(KVRegs& r, const bf16_t* kbase, const bf16_t* vbase, int row0, int rstride, int rmin, int rmax, int tid) {
    const int j = tid >> 2, ch = tid & 3;
    int tok = row0 + j * rstride; tok = tok < rmin ? rmin : (tok > rmax ? rmax : tok);
    const u32x4* kp = (const u32x4*)(kbase + (size_t)tok * 64);
    const u32x4* vp = (const u32x4*)(vbase + (size_t)tok * 64);
    r.k0 = kp[ch]; r.k1 = kp[ch + 4]; r.v0 = vp[ch]; r.v1 = vp[ch + 4];
}
__device__ __forceinline__ void kv_commit(const KVRegs& r, LAS unsigned char* Kt, LAS unsigned char* Vt, int tid) {
    const int j = tid >> 2, ch = tid & 3;
    *(LAS u32x4*)(Kt + j * KVS + ch * 16) = r.k0; *(LAS u32x4*)(Kt + j * KVS + (ch + 4) * 16) = r.k1;
    *(LAS u32x4*)(Vt + j * KVS + ch * 16) = r.v0; *(LAS u32x4*)(Vt + j * KVS + (ch + 4) * 16) = r.v1;
}
__device__ __forceinline__ void pv32(f32x16& o0, f32x16& o1, const f32x16& sv, LAS const unsigned char* vp  ) {
#pragma unroll
    for (int s16 = 0; s16 < 2; ++s16) {
        u32x4 pw;
        pw.x = cvtpk(sv[8 * s16 + 0], sv[8 * s16 + 1]); pw.y = cvtpk(sv[8 * s16 + 2], sv[8 * s16 + 3]);
        pw.z = cvtpk(sv[8 * s16 + 4], sv[8 * s16 + 5]); pw.w = cvtpk(sv[8 * s16 + 6], sv[8 * s16 + 7]);
        const bf16x8 pf = __builtin_bit_cast(bf16x8, pw);
        LAS const unsigned char* vr = vp + s16 * 16 * KVS;
        const s16x4 a0 = vtr(vr), b0 = vtr(vr + 8 * KVS), a1 = vtr(vr + 64), b1 = vtr(vr + 8 * KVS + 64);
        const bf16x8 vf0 = {a0[0], a0[1], a0[2], a0[3], b0[0], b0[1], b0[2], b0[3]};
        const bf16x8 vf1 = {a1[0], a1[1], a1[2], a1[3], b1[0], b1[1], b1[2], b1[3]};
        o0 = __builtin_amdgcn_mfma_f32_32x32x16_bf16(vf0, pf, o0, 0, 0, 0);
        o1 = __builtin_amdgcn_mfma_f32_32x32x16_bf16(vf1, pf, o1, 0, 0, 0);
    }
}
__device__ __forceinline__ f32x16 qk32(const bf16x8* qf, LAS const unsigned char* kp  , f32x16 s  ) {
#pragma unroll
    for (int k = 0; k < 4; ++k) {
        const bf16x8 kf = *(const LAS bf16x8*)(kp + 32 * k);
        s = __builtin_amdgcn_mfma_f32_32x32x16_bf16(kf, qf[k], s, 0, 0, 0);
    }
    return s;
}
template <int KS, bool TRY_FULL>
__device__ __forceinline__ void fa_tile64(f32x16& o0, f32x16& o1, float& m, float& l, const bf16x8* qf, LAS const unsigned char* Kt, LAS const unsigned char* Vt, int lane, float dA, float wmax, float ns2) {
    const int r = lane & 31, h = lane >> 5;
    LAS const unsigned char* kp = Kt + r * KVS + 16 * h;
    const float dAh = dA - (float)(KS * 4 * h);
    const float hi = dAh, lo = dAh - wmax, base = ns2 * dAh;
    f32x16 s0, s1;
#pragma unroll
    for (int i = 0; i < 16; ++i) {
        const float c0 = (float)(KS * ((i & 3) + 8 * (i >> 2))), c1 = c0 + (float)(32 * KS);
        s0[i] = fmaf(-c0, ns2, base); s1[i] = fmaf(-c1, ns2, base);
    }
    s0 = qk32(qf, kp, s0); s1 = qk32(qf, kp + 32 * KVS, s1);
    float tmax = -1e30f;
    if (TRY_FULL && __all(lo <= 0.f && hi >= (float)(59 * KS))) {
#pragma unroll
        for (int i = 0; i < 16; ++i) tmax = fmaxf(tmax, fmaxf(s0[i], s1[i]));
    } else {
#pragma unroll
        for (int i = 0; i < 16; ++i) {
            const float c0 = (float)(KS * ((i & 3) + 8 * (i >> 2))), c1 = c0 + (float)(32 * KS);
            const float t0 = (c0 >= lo && c0 <= hi) ? s0[i] : -1e30f;
            const float t1 = (c1 >= lo && c1 <= hi) ? s1[i] : -1e30f;
            s0[i] = t0; s1[i] = t1;
            tmax = fmaxf(tmax, fmaxf(t0, t1));
        }
    }
    tmax = fmaxf(tmax, __shfl_xor(tmax, 32));
    const float mn = fmaxf(m, tmax);
    const float corr = __builtin_amdgcn_exp2f(m - mn);
    m = mn;
    const float mu = fmaxf(mn, -1e29f);
    float ps = 0.f;
#pragma unroll
    for (int i = 0; i < 16; ++i) {
        s0[i] = __builtin_amdgcn_exp2f(s0[i] - mu); s1[i] = __builtin_amdgcn_exp2f(s1[i] - mu);
        ps += s0[i] + s1[i];
    }
    l = l * corr + ps;
    if (!__all(corr == 1.0f)) {
#pragma unroll
        for (int i = 0; i < 16; ++i) { o0[i] *= corr; o1[i] *= corr; }
    }
    LAS const unsigned char* vp = Vt + (4 * h + ((lane & 15) >> 2)) * KVS + (16 * ((lane >> 4) & 1) + 4 * (lane & 3)) * 2;
    pv32(o0, o1, s0, vp);
    pv32(o0, o1, s1, vp + 32 * KVS);
}
__device__ __forceinline__ void acc_scaled(f32x16& t0, f32x16& t1, const f32x16& o0, const f32x16& o1, float sc) {
#pragma unroll
    for (int i = 0; i < 16; ++i) { t0[i] += sc * o0[i]; t1[i] += sc * o1[i]; }
}
__device__ __forceinline__ void store_ot(bf16_t* orow, const f32x16& o0, const f32x16& o1, float sc, int h) {
#pragma unroll
    for (int u = 0; u < 4; ++u) {
        u32x2 w0, w1;
        w0.x = cvtpk(o0[4 * u] * sc, o0[4 * u + 1] * sc); w0.y = cvtpk(o0[4 * u + 2] * sc, o0[4 * u + 3] * sc);
        w1.x = cvtpk(o1[4 * u] * sc, o1[4 * u + 1] * sc); w1.y = cvtpk(o1[4 * u + 2] * sc, o1[4 * u + 3] * sc);
        *(u32x2*)(orow + 8 * u + 4 * h) = w0;
        *(u32x2*)(orow + 32 + 8 * u + 4 * h) = w1;
    }
}
__device__ __forceinline__ void load_qf(bf16x8* qf, const bf16_t* qrow, int h) {
#pragma unroll
    for (int k = 0; k < 4; ++k) qf[k] = *(const bf16x8*)(qrow + 16 * k + 8 * h);
}

__device__ __forceinline__ void dil_item(unsigned char* ws, int item, LAS unsigned char* lds) {
    const int tid = TID(), lane = tid & 63, w = tid >> 6, c = lane & 31, h = lane >> 5;
    const int bh = item / 48, rem = item % 48, pat = rem >> 4, idx = rem & 15;
    const int dil = pat == 0 ? 1 : (pat == 1 ? 4 : 16), nqt = 16 / dil, res = idx / nqt, qt = idx % nqt;
    const int hd = bh & 7, b = bh >> 3;
    const int q0 = qt * 128 + 32 * w, iq = q0 + c, t = res + iq * dil;
    const bf16_t* qa = (const bf16_t*)(ws + WS_QA) + (size_t)bh * NS * 64;
    const bf16_t* ka = (const bf16_t*)(ws + WS_KA) + (size_t)bh * NS * 64;
    const bf16_t* va = (const bf16_t*)(ws + WS_VA) + (size_t)bh * NS * 64;
    bf16x8 qf[4]; load_qf(qf, qa + (size_t)t * 64, h);
    const float ns2 = -exp2f(-((float)hd + 0.5f)) * (float)dil * LOG2E_F;
    f32x16 o0 = zero16(), o1 = zero16(); float m = -1e30f, l = 0.f;
    {
        const int T0 = qt == 0 ? 2 : 0;
        KVRegs kr; kv_fetch(kr, ka, va, res + (qt * 128 - 128 + 64 * T0) * dil, dil, 0, NS - 1, tid);
        int buf = 0;
        for (int T = T0; T < 4; ++T) {
            const int kb = qt * 128 - 128 + 64 * T;
            LAS unsigned char* Kt = lds + buf * KVT; LAS unsigned char* Vt = lds + 2 * KVT + buf * KVT;
            kv_commit(kr, Kt, Vt, tid);
            __syncthreads();
            if (T + 1 < 4) kv_fetch(kr, ka, va, res + (kb + 64) * dil, dil, 0, NS - 1, tid);
            if (kb <= q0 + 31 && kb + 63 >= q0 - 128)
                fa_tile64<1, true>(o0, o1, m, l, qf, Kt, Vt, lane, (float)(iq - kb), 128.f, ns2);
            buf ^= 1;
        }
    }
    const float lt = l + __shfl_xor(l, 32);
    bf16_t* op = (bf16_t*)(pat < 2 ? ws + WS_OPA01 + (size_t)pat * 16 * MiB : ws + WS_OPA2);
    store_ot(op + ((size_t)(b * NS + t) * 512 + hd * 64), o0, o1, 1.0f / lt, h);
    if (h == 0) { float* st = (float*)(ws + WS_STA) + ((size_t)pat * NB * 8 * NS + (size_t)bh * NS + t) * 2; st[0] = m; st[1] = lt; }
}
__device__ __forceinline__ void dil_merge(unsigned char* ws, int gtid, int gthreads) {
    asm volatile("" : "+v"(gtid));
    const float* sta = (const float*)(ws + WS_STA);
    bf16_t* ob = (bf16_t*)(ws + WS_O);
    for (int it = gtid; it < NT * 8 * 8; it += gthreads) {
        const int ch = it & 7, hd = (it >> 3) & 7, tk = it >> 6, b = tk >> 11, t = tk & 2047;
        float mm[3], ll[3];
#pragma unroll
        for (int p = 0; p < 3; ++p) { const float* s = sta + ((size_t)p * NB * 8 * NS + (size_t)(b * 8 + hd) * NS + t) * 2; mm[p] = s[0]; ll[p] = s[1]; }
        const float M = fmaxf(mm[0], fmaxf(mm[1], mm[2]));
        float wgt[3], den = 0.f;
#pragma unroll
        for (int p = 0; p < 3; ++p) { wgt[p] = __builtin_amdgcn_exp2f(mm[p] - M) * ll[p]; den += wgt[p]; }
        const float inv = 1.0f / den;
        float a[8];
#pragma unroll
        for (int i = 0; i < 8; ++i) a[i] = 0.f;
#pragma unroll
        for (int p = 0; p < 3; ++p) {
            const bf16_t* op = (const bf16_t*)(p < 2 ? ws + WS_OPA01 + (size_t)p * 16 * MiB : ws + WS_OPA2);
            const u32x4 v = *(const u32x4*)(op + (size_t)tk * 512 + hd * 64 + ch * 8);
            const float wp = wgt[p] * inv;
            a[0] += wp * bflo(v.x); a[1] += wp * bfhi(v.x); a[2] += wp * bflo(v.y); a[3] += wp * bfhi(v.y);
            a[4] += wp * bflo(v.z); a[5] += wp * bfhi(v.z); a[6] += wp * bflo(v.w); a[7] += wp * bfhi(v.w);
        }
        u32x4 o; o.x = pk2(a[0], a[1]); o.y = pk2(a[2], a[3]); o.z = pk2(a[4], a[5]); o.w = pk2(a[6], a[7]);
        *(u32x4*)(ob + (size_t)tk * ND + hd * 64 + ch * 8) = o;
    }
}

constexpr int LDS_IMP = 4 * KVT;
constexpr int LDS_UNI = LDS_IMP + 4096;
__device__ __forceinline__ void nsa_item(unsigned char* ws, int item, LAS unsigned char* lds) {
    const int tid = TID(), lane = tid & 63, w = tid >> 6, c = lane & 31, h = lane >> 5;
    const int bg = item & 15, tt = item >> 4, b = bg >> 1, g = bg & 1;
    const int t0 = tt * 32, tok8 = c & 7, hh = c >> 3, hb = g * 4 + hh, t = t0 + 8 * w + tok8;
    const bf16_t* qrow = (const bf16_t*)(ws + WS_QB) + ((size_t)(b * 8 + hb) * NS + t) * 64;
    bf16x8 qf[4]; load_qf(qf, qrow, h);
    const float ns2 = -exp2f(-(float)(hb + 1)) * LOG2E_F;
    const float* gt = (const float*)(ws + WS_GATES) + (size_t)(b * NS + t) * 24 + hb * 3;
    const float g0 = gt[0], g1 = gt[1], g2 = gt[2];
    f32x16 tot0 = zero16(), tot1 = zero16();
    LAS unsigned char* Kt = lds; LAS unsigned char* Vt = lds + 2 * KVT;
    LAS float* impL = (LAS float*)(lds + LDS_IMP) + w * 256;
    LAS unsigned* uni = (LAS unsigned*)(lds + LDS_UNI);
    const int cur = t0 >> 6;
    unsigned selmask;
    {
        const bf16_t* kc = (const bf16_t*)(ws + WS_KCMP) + (size_t)bg * 128 * 64;
        const bf16_t* vc = kc + (size_t)16 * 128 * 64;
        __syncthreads();
        load_kv_tile(Kt, Vt, kc, vc, 0, 1, 0, 127, tid);
        load_kv_tile(Kt + KVT, Vt + KVT, kc, vc, 64, 1, 0, 127, tid);
        if (tid == 0) uni[0] = 0u;
        __syncthreads();
        LAS const unsigned char* kp = Kt + c * KVS + 16 * h;
        f32x16 sT[4];
#pragma unroll
        for (int T = 0; T < 4; ++T) sT[T] = qk32(qf, kp + T * 32 * KVS, zero16());
        const float dAh = (float)(t - 31) - (float)(64 * h);
        float tmax = -1e30f;
#pragma unroll
        for (int T = 0; T < 4; ++T)
#pragma unroll
            for (int i = 0; i < 16; ++i) {
                const float d = dAh - (float)(16 * (32 * T + (i & 3) + 8 * (i >> 2)));
                float tv = sT[T][i] + ns2 * d;
                tv = d >= 0.f ? tv : -1e30f;
                sT[T][i] = tv; tmax = fmaxf(tmax, tv);
            }
        tmax = fmaxf(tmax, __shfl_xor(tmax, 32));
        const float mu = fmaxf(tmax, -1e29f);
        float ps = 0.f;
#pragma unroll
        for (int T = 0; T < 4; ++T)
#pragma unroll
            for (int i = 0; i < 16; ++i) { sT[T][i] = __builtin_amdgcn_exp2f(sT[T][i] - mu); ps += sT[T][i]; }
        ps += __shfl_xor(ps, 32);
        const float inv = ps > 0.f ? 1.0f / ps : 0.f;
#pragma unroll
        for (int T = 0; T < 4; ++T)
#pragma unroll
            for (int i = 0; i < 16; ++i) sT[T][i] *= inv;
        f32x16 o0 = zero16(), o1 = zero16();
        LAS const unsigned char* vp = Vt + (4 * h + ((lane & 15) >> 2)) * KVS + (16 * ((lane >> 4) & 1) + 4 * (lane & 3)) * 2;
#pragma unroll
        for (int T = 0; T < 4; ++T) pv32(o0, o1, sT[T], vp + T * 32 * KVS);
        acc_scaled(tot0, tot1, o0, o1, g0);
        float mainv[16], spill[16];
#pragma unroll
        for (int T = 0; T < 4; ++T)
#pragma unroll
            for (int u = 0; u < 4; ++u) {
                const float p3 = 0.5f * sT[T][4 * u + 3];
                mainv[4 * T + u] = sT[T][4 * u] + sT[T][4 * u + 1] + sT[T][4 * u + 2] + p3;
                spill[4 * T + u] = p3;
            }
#pragma unroll
        for (int f = 0; f < 16; ++f) {
            mainv[f] += __shfl_xor(mainv[f], 8); mainv[f] += __shfl_xor(mainv[f], 16);
            spill[f] += __shfl_xor(spill[f], 8); spill[f] += __shfl_xor(spill[f], 16);
        }
#pragma unroll
        for (int f = 0; f < 16; ++f) {
            const float snd = h ? (f > 0 ? spill[f > 0 ? f - 1 : 0] : 0.f) : spill[f];
            const float rcv = __shfl_xor(snd, 32);
            mainv[f] += rcv;
        }
        if (hh == 0) {
#pragma unroll
            for (int f = 0; f < 16; ++f) impL[tok8 * 32 + 2 * f + h] = mainv[f];
        }
        asm volatile("s_waitcnt lgkmcnt(0)" ::: "memory");
        {
            const int tk = lane >> 3, tq = t0 + 8 * w + tk, cq = tq >> 6, n0 = 4 * (lane & 7);
            float sc[32];
#pragma unroll
            for (int q4 = 0; q4 < 8; ++q4) {
                const f32x4 v = *(const LAS f32x4*)(impL + tk * 32 + 4 * q4);
                sc[4 * q4] = v.x; sc[4 * q4 + 1] = v.y; sc[4 * q4 + 2] = v.z; sc[4 * q4 + 3] = v.w;
            }
#pragma unroll
            for (int n = 0; n < 32; ++n) {
                const bool valid = n <= cq, forced = (n == 0) || (cq - n < 2);
                sc[n] = valid ? sc[n] + (forced ? 1e4f : 0.f) : -1e30f;
            }
            unsigned bits = 0u;
#pragma unroll
            for (int k = 0; k < 4; ++k) {
                const int n = n0 + k;
                float mine = 0.f;
#pragma unroll
                for (int q = 0; q < 32; ++q) mine = (q == n) ? sc[q] : mine;
                int rank = 0;
#pragma unroll
                for (int q = 0; q < 32; ++q) rank += (sc[q] > mine || (sc[q] == mine && q < n)) ? 1 : 0;
                if (n <= cq && rank < 16) bits |= 1u << n;
            }
            bits |= __shfl_xor(bits, 1); bits |= __shfl_xor(bits, 2); bits |= __shfl_xor(bits, 4);
            selmask = __shfl(bits, tok8 * 8);
        }
        {
            unsigned um = selmask;
#pragma unroll
            for (int o = 1; o < 64; o <<= 1) um |= __shfl_xor(um, o);
            if (lane == 0) atomicOr((unsigned*)uni, um);
        }
        __syncthreads();
    }
    const unsigned ublk = uni[0];
    unsigned wsel = selmask;
#pragma unroll
    for (int o = 1; o < 64; o <<= 1) wsel |= __shfl_xor(wsel, o);
    int buf = 0;
    {
        const bf16_t* kb = (const bf16_t*)(ws + WS_KV6 + 2 * 4 * MiB) + (size_t)bg * NS * 64;
        const bf16_t* vb = (const bf16_t*)(ws + WS_KV6 + 3 * 4 * MiB) + (size_t)bg * NS * 64;
        f32x16 o0 = zero16(), o1 = zero16(); float m = -1e30f, l = 0.f;
        unsigned rem = ublk & (cur >= 31 ? 0xffffffffu : ((2u << cur) - 1u));
        while (rem) {
            const int n = __builtin_ctz(rem);
            rem &= rem - 1u;
            LAS unsigned char* Kc = lds + buf * KVT; LAS unsigned char* Vc = lds + 2 * KVT + buf * KVT;
            load_kv_tile(Kc, Vc, kb, vb, 64 * n, 1, 0, NS - 1, tid);
            __syncthreads();
            if ((wsel >> n) & 1u)
                fa_tile64<1, false>(o0, o1, m, l, qf, Kc, Vc, lane, (float)(t - 64 * n), ((selmask >> n) & 1u) ? 1e30f : -1.f, ns2);
            buf ^= 1;
        }
        const float lt = l + __shfl_xor(l, 32);
        acc_scaled(tot0, tot1, o0, o1, g1 / lt);
    }
    {
        const bf16_t* kb = (const bf16_t*)(ws + WS_KV6 + 4 * 4 * MiB) + (size_t)bg * NS * 64;
        const bf16_t* vb = (const bf16_t*)(ws + WS_KV6 + 5 * 4 * MiB) + (size_t)bg * NS * 64;
        f32x16 o0 = zero16(), o1 = zero16(); float m = -1e30f, l = 0.f;
        const int nlo = t0 >= 511 ? (t0 - 511) >> 6 : 0;
        for (int n = nlo; n <= cur; ++n) {
            LAS unsigned char* Kc = lds + buf * KVT; LAS unsigned char* Vc = lds + 2 * KVT + buf * KVT;
            load_kv_tile(Kc, Vc, kb, vb, 64 * n, 1, 0, NS - 1, tid);
            __syncthreads();
            fa_tile64<1, true>(o0, o1, m, l, qf, Kc, Vc, lane, (float)(t - 64 * n), 511.f, ns2);
            buf ^= 1;
        }
        const float lt = l + __shfl_xor(l, 32);
        acc_scaled(tot0, tot1, o0, o1, g2 / lt);
    }
    store_ot((bf16_t*)(ws + WS_O) + ((size_t)(b * NS + t) * ND + 512 + hb * 64), tot0, tot1, 1.0f, h);
}

#define XB_TMO      128
#define XB_XCNT(j)  (256  + 64 * (j))
#define XB_XSUB(j)  (1280 + 64 * (j))
#define XB_XGEN(j)  (2304 + 64 * (j))
#define XB_TOP      3328
#define XB_TOPGEN   3392
#define XCD_BAR_WORDS 3456
#define XB_SPIN_CAP (1u << 18)
__device__ __forceinline__ unsigned xb_ld(unsigned* p)              { return __hip_atomic_load(p, __ATOMIC_RELAXED, __HIP_MEMORY_SCOPE_AGENT); }
__device__ __forceinline__ unsigned xb_add(unsigned* p, unsigned v) { return __hip_atomic_fetch_add(p, v, __ATOMIC_RELAXED, __HIP_MEMORY_SCOPE_AGENT); }
__device__ __forceinline__ unsigned xb_xcc_id() { return (unsigned)__builtin_amdgcn_s_getreg((3 << 11) | 20) & 0xFu; }
#define XB_SPIN(cond, bar) do { unsigned _sp = 0; while (cond) { __builtin_amdgcn_s_sleep(1); \
    if ((++_sp & 255u) == 0u) { if (xb_ld(&(bar)[XB_TMO])) break; if (_sp > XB_SPIN_CAP) { atomicAdd(&(bar)[XB_TMO], 1u); break; } } } } while (0)
struct XcdBarrier { unsigned* bar; unsigned x; volatile LAS unsigned* st; };
__device__ __forceinline__ XcdBarrier xcd_barrier_post(unsigned* bar, volatile LAS unsigned* st) {
    XcdBarrier b; b.bar = bar; b.x = xb_xcc_id(); b.st = st;
    if (threadIdx.x == 0) (void)xb_add(&bar[XB_XCNT(b.x)], 1u);
    return b;
}
__device__ __forceinline__ void xcd_barrier_complete(unsigned* bar, unsigned x, unsigned& nloc, unsigned& nx) {
    const unsigned G = gridDim.x * gridDim.y * gridDim.z;
    unsigned sum, cnt, mine, sp = 0u;
    for (;;) {
        sum = 0u; cnt = 0u; mine = 0u;
#pragma unroll
        for (unsigned j = 0; j < 16; ++j) { const unsigned c = xb_ld(&bar[XB_XCNT(j)]); sum += c; cnt += (c > 0u) ? 1u : 0u; mine = (j == x) ? c : mine; }
        if (sum == G) break;
        __builtin_amdgcn_s_sleep(1);
        if ((++sp & 255u) == 0u) { if (xb_ld(&bar[XB_TMO])) break; if (sp > XB_SPIN_CAP) { atomicAdd(&bar[XB_TMO], 1u); break; } }
    }
    nloc = mine > 0u ? mine : 1u; nx = cnt > 0u ? cnt : 1u;
}
__device__ __forceinline__ void xcd_barrier(const XcdBarrier& b) {
    asm volatile("s_waitcnt vmcnt(0)" ::: "memory");
    __syncthreads();
    if (threadIdx.x == 0) {
        unsigned* bar = b.bar;
        __builtin_amdgcn_s_waitcnt(0);
        unsigned nloc = b.st[0], nx = b.st[1];
        if (nloc == 0u) { xcd_barrier_complete(bar, b.x, nloc, nx); b.st[0] = nloc; b.st[1] = nx; }
        const unsigned old = xb_add(&bar[XB_XSUB(b.x)], 1u);
        const unsigned gen = old / nloc;
        if (old + 1u == (gen + 1u) * nloc) {
            __builtin_amdgcn_fence(__ATOMIC_RELEASE, "agent");
            asm volatile("s_waitcnt vmcnt(0)" ::: "memory");
            const unsigned og = xb_add(&bar[XB_TOP], 1u);
            const unsigned tg = og / nx;
            if (og + 1u == (tg + 1u) * nx) xb_add(&bar[XB_TOPGEN], 1u);
            else XB_SPIN(xb_ld(&bar[XB_TOPGEN]) == tg, bar);
            __builtin_amdgcn_fence(__ATOMIC_ACQUIRE, "agent");
            xb_add(&bar[XB_XGEN(b.x)], 1u);
            asm volatile("s_waitcnt vmcnt(0)" ::: "memory");
        } else {
            XB_SPIN(xb_ld(&bar[XB_XGEN(b.x)]) == gen, bar);
            __builtin_amdgcn_fence(__ATOMIC_ACQUIRE, "agent");
            asm volatile("s_waitcnt vmcnt(0)" ::: "memory");
        }
    }
    __syncthreads();
}

struct XcdTiles {
    int m_lo, cnt_m, nN, loc, nloc, tiles;
    __device__ __forceinline__ XcdTiles(int nM, int nN_) {
        const int b = BID(), g = gridDim.x;
        int x, nx;
        if ((g & 7) == 0) { x = b & 7; nx = 8; loc = b >> 3; nloc = g >> 3; } else { x = 0; nx = 1; loc = b; nloc = g; }
        m_lo = (int)((long)nM * x / nx); cnt_m = (int)((long)nM * (x + 1) / nx) - m_lo; nN = nN_; tiles = cnt_m * nN;
    }
    __device__ __forceinline__ void get(int q, int& mt, int& nt) const {
        const int mg = q / (8 * nN), rem_m = cnt_m - 8 * mg, mig = rem_m < 8 ? rem_m : 8, r = q - mg * 8 * nN;
        nt = r / mig; mt = m_lo + 8 * mg + (r - nt * mig);
    }
};
struct PhInProj { const bf16_t* xn; const unsigned char* wl; unsigned char* ws; const float* ssp; XcdTiles xt;
    __device__ __forceinline__ void make(int q, APlain& ap, BPlain& bp, EpiInProj& ep) const { int mt, nt; xt.get(q, mt, nt);
        ap = APlain{xn + (size_t)mt * 128 * ND, ND}; bp = BPlain{(const bf16_t*)(wl + WL_IN) + (size_t)nt * 128 * ND, ND}; ep = EpiInProj{mt, nt, ws, ssp}; } };
struct PhCmp1 { const unsigned char* wl; unsigned char* ws; int l;
    __device__ __forceinline__ void make(int tile, ACmp& ap, BPlain& bp, EpiCmp1& ep) const { const int nt = tile & 1, bg = (tile >> 1) & 15, kv = tile >> 5;
        ap = ACmp{(const bf16_t*)(ws + WS_KV6 + (size_t)kv * 4 * MiB) + (size_t)bg * NS * 64};
        bp = BPlain{(const bf16_t*)(wl + WL_C1) + (size_t)kv * 256 * 2048 + (size_t)nt * 128 * 2048, 2048};
        ep = EpiCmp1{(bf16_t*)(ws + WS_HC) + (size_t)kv * 2048 * 256, (const float*)(ws + WS_BC1P) + l * 512 + kv * 256, bg * 128, nt * 128}; } };
struct PhCmp2 { const unsigned char* wl; unsigned char* ws;
    __device__ __forceinline__ void make(int tile, APlain& ap, BPlain& bp, EpiCmp2& ep) const { const int bg = tile & 15, kv = tile >> 4;
        ap = APlain{(const bf16_t*)(ws + WS_HC) + (size_t)kv * 2048 * 256 + (size_t)bg * 128 * 256, 256};
        bp = BPlain{(const bf16_t*)(wl + WL_C2) + (size_t)kv * 128 * 256, 256};
        ep = EpiCmp2{(bf16_t*)(ws + WS_KCMP) + (size_t)kv * 16 * 128 * 64, bg * 128}; } };
struct PhOutProj { const unsigned char* wl; unsigned char* ws; const float* base; float* out; bf16_t* xb; float sc; XcdTiles xt;
    __device__ __forceinline__ void make(int q, APlain& ap, BPlain& bp, EpiResAdd& ep) const { int mt, nt; xt.get(q, mt, nt);
        ap = APlain{(const bf16_t*)(ws + WS_O) + (size_t)mt * 128 * ND, ND}; bp = BPlain{(const bf16_t*)(wl + WL_OUT) + (size_t)nt * 128 * ND, ND};
        ep = EpiResAdd{base, out, xb, mt * 128, nt * 128, sc}; } };
struct PhMoe {
    LAS const int* sm; const int* list;
    __device__ __forceinline__ void decode(int gmt, int& bk, int& mt, int& rem, int& hrow0, int& elo, int& ehi) const {
        bk = 0;
        for (int k = 1; k < 24; ++k) if (gmt >= sm[32 + k]) bk = k;
        mt = gmt - sm[32 + bk]; rem = sm[bk] - mt * 128; hrow0 = sm[64 + bk] + mt * 128;
        const int grp = bk / 6, pi = bk % 6;
        elo = grp * 4 + (pi < 3 ? 0 : (pi < 5 ? 1 : 2)); ehi = grp * 4 + (pi < 3 ? pi + 1 : (pi < 5 ? pi - 1 : 3));
    } };
struct PhMoeGU { PhMoe m; const bf16_t* xn; const unsigned char* wl; unsigned char* ws; const float* route; const float* rinv; XcdTiles xt;
    __device__ __forceinline__ void make(int q, AGather& ap, BPlain& bp, EpiMoeGU& ep) const { int gmt, nt16; xt.get(q, gmt, nt16);
        int bk, mt, rem, hrow0, elo, ehi; m.decode(gmt, bk, mt, rem, hrow0, elo, ehi);
        const int* lst = m.list + (size_t)bk * NT + mt * 128; const int e = (nt16 >> 3) ? ehi : elo;
        ap = AGather{xn, lst, rem}; bp = BPlain{(const bf16_t*)(wl + WL_GU) + (size_t)e * 1024 * 1024 + (size_t)(nt16 & 7) * 128 * 1024, 1024};
        ep = EpiMoeGU{(bf16_t*)(ws + WS_HID), lst, route, rinv, rem, hrow0, nt16}; } };
struct PhMoeDown { PhMoe m; const unsigned char* wl; unsigned char* ws; float* out; bf16_t* xb; float* ssp; XcdTiles xt;
    __device__ __forceinline__ void make(int q, APlain& ap, BSplit& bp, EpiMoeDown& ep) const { int gmt, nt; xt.get(q, gmt, nt);
        int bk, mt, rem, hrow0, elo, ehi; m.decode(gmt, bk, mt, rem, hrow0, elo, ehi);
        const int* lst = m.list + (size_t)bk * NT + mt * 128;
        ap = APlain{(const bf16_t*)(ws + WS_HID) + (size_t)hrow0 * 1024, 1024};
        bp = BSplit{(const bf16_t*)(wl + WL_DN) + (size_t)elo * 1024 * 512 + (size_t)nt * 128 * 512, (const bf16_t*)(wl + WL_DN) + (size_t)ehi * 1024 * 512 + (size_t)nt * 128 * 512};
        ep = EpiMoeDown{out, lst, xb, ssp, rem, nt * 128}; } };
struct PhPleProj { const unsigned char* wl; unsigned char* ws; XcdTiles xt;
    __device__ __forceinline__ void make(int q, APlain& ap, BPlain& bp, EpiBf16& ep) const { int mt, nt; xt.get(q, mt, nt);
        ap = APlain{(const bf16_t*)(ws + WS_PB) + (size_t)mt * 128 * 256, 256}; bp = BPlain{(const bf16_t*)(wl + WL_PP) + (size_t)nt * 128 * 256, 256};
        ep = EpiBf16{(bf16_t*)(ws + WS_P2), ND, mt * 128, nt * 128}; } };
struct PhPleGate { const bf16_t* xn; const unsigned char* wl; unsigned char* ws; float* out; float sc; XcdTiles xt;
    __device__ __forceinline__ void make(int q, APlain& ap, BPlain& bp, EpiPleGate& ep) const { int mt, nt; xt.get(q, mt, nt);
        ap = APlain{xn + (size_t)mt * 128 * ND, ND}; bp = BPlain{(const bf16_t*)(wl + WL_PG) + (size_t)nt * 128 * ND, ND};
        ep = EpiPleGate{out, (const bf16_t*)(ws + WS_P2), mt * 128, nt * 128, sc}; } };

constexpr int LDS_QSLOT = 65536 + 16 + 448;
__device__ __forceinline__ int wq_next(int* head, LAS unsigned char* lds) {
    LAS int* slot = (LAS int*)(lds + LDS_QSLOT);
    __syncthreads();
    if (threadIdx.x == 0) *slot = atomicAdd(head, 1);
    __syncthreads();
    return *slot;
}
__device__ __forceinline__ void ple_stream(const bf16_t* xn, const bf16_t* pb, const unsigned char* wl, float* out, const float* ssp_in, bf16_t* xbo, float* ssp_out, LAS unsigned char* lds) {
    const XcdTiles xt(128, 8);
    int q = xt.loc;
    if (q >= xt.tiles) return;
    const int tid = TID(), wid = tid >> 6, lane = tid & 63, wr = wid >> 1, wc = wid & 1, fr = lane & 15, fq = lane >> 4;
    int mt, nt; xt.get(q, mt, nt);
    bool pref = false;
    for (;;) {
        const int qn = q + xt.nloc; const bool hn = qn < xt.tiles;
        int mtn = mt, ntn = nt; if (hn) xt.get(qn, mtn, ntn);
        const APlain ap1{pb + (size_t)mt * 128 * 256, 256}; const BPlain bp1{(const bf16_t*)(wl + WL_PP) + (size_t)nt * 128 * 256, 256};
        const APlain ap2{xn + (size_t)mt * 128 * ND, ND};   const BPlain bp2{(const bf16_t*)(wl + WL_PG) + (size_t)nt * 128 * ND, ND};
        const APlain apn{pb + (size_t)mtn * 128 * 256, 256}; const BPlain bpn{(const bf16_t*)(wl + WL_PP) + (size_t)ntn * 128 * 256, 256};
        f32x4 acc[4][4], acc2[4][4]; zero_acc(acc); zero_acc(acc2);
        gemm_kloop(acc2, ap1, bp1, 256, lds, pref, true, ap2, bp2);
        gemm_kloop(acc, ap2, bp2, ND, lds, true, hn, apn, bpn);
        const EpiPleFused ep{out, ssp_in, xbo, ssp_out, mt * 128, nt * 128};
        ep(acc, acc2, wr, wc, fr, fq);
        if (!hn) break;
        q = qn; mt = mtn; nt = ntn; pref = true;
    }
}

constexpr int LDS_BAR = 65536;
constexpr int LDS_SM = LDS_BAR + 16;
constexpr int LDS_BYTES = LDS_SM + 512;
static_assert(LDS_QSLOT == LDS_SM + 448, "queue slot");
static_assert(4 * KVT + 4096 + 64 <= LDS_BAR, "attention LDS fits");

__global__ void __launch_bounds__(256, 2) mega_fwd(Params p) {
    extern __shared__ __attribute__((aligned(16))) unsigned char lds_raw[];
    LAS unsigned char* lds = (LAS unsigned char*)lds_raw;
    unsigned char* ws = p.ws;
    const int tid = threadIdx.x;
    const int gtid = blockIdx.x * 256 + tid, gthreads = gridDim.x * 256;
    int* ctl = (int*)(ws + WS_CTL);
    {
        volatile LAS unsigned* st = (volatile LAS unsigned*)(lds + LDS_BAR);
        if (tid < 4) st[tid] = 0u;
        __syncthreads();
    }
    const XcdBarrier gbar = xcd_barrier_post((unsigned*)ctl + CW_BAR, (volatile LAS unsigned*)(lds + LDS_BAR));

    phase_convert(p, (LAS float*)lds);
    xcd_barrier(gbar);

    float* sspA = (float*)(ws + WS_SSP);
    float* sspB = sspA + (size_t)NT * 16;
    float* rinv = (float*)(ws + WS_RINV);
    for (int l = 0; l < 2; ++l) {
        const unsigned char* wl = ws + WS_W + (size_t)l * WL_SIZE;
        const float* xin = l == 0 ? p.in[0] : p.out;
        bf16_t* xn = (bf16_t*)(ws + WS_XN);
        const bf16_t* xb_in = l == 0 ? xn : (const bf16_t*)(ws + WS_O);
        {
            const PhInProj ph{xb_in, wl, ws, sspB, XcdTiles(128, 23)};
            gemm_stream<PhInProj, APlain, BPlain, EpiInProj>(ph, ph.xt.loc, ph.xt.nloc, ph.xt.tiles, ND, lds);
        }
        xcd_barrier(gbar);
        {
            int* qh = ctl + CW_Q + l * 4 + 0;
            int* ch = ctl + CW_Q + l * 4 + 2;
            const int nconv = conv_queue_strips(2 * l);
            const PhCmp1 ph{wl, ws, l};
            bool conv_left = nconv > 0, att_left = true;
            for (int k = 0; conv_left || att_left; ++k) {
                const bool want_conv = conv_left && (!att_left || (k % 7) == 6);
                if (want_conv) {
                    const int c = wq_next(ch, lds);
                    if (c < nconv) conv_strip(p, 2 * l, c, (LAS float*)lds); else conv_left = false;
                } else {
                    const int it = wq_next(qh, lds);
                    if (it >= 64 + 1536) att_left = false;
                    else if (it < 64) { ACmp ap; BPlain bp; EpiCmp1 ep; ph.make(it, ap, bp, ep); gemm_tile(ap, bp, 2048, ep, lds, false, false, ap, bp); }
                    else { dil_item(ws, 2 * (it - 64), lds); __syncthreads(); dil_item(ws, 2 * (it - 64) + 1, lds); }
                }
            }
        }
        xcd_barrier(gbar);
        { const PhCmp2 ph{wl, ws}; gemm_stream<PhCmp2, APlain, BPlain, EpiCmp2>(ph, BID(), gridDim.x, 32, 256, lds); }
        dil_merge(ws, gtid, gthreads);
        if (l == 0) convert_p(p);
        xcd_barrier(gbar);
        {
            int* qh = ctl + CW_Q + l * 4 + 1;
            int* ch = ctl + CW_Q + l * 4 + 3;
            const int nconv = conv_queue_strips(2 * l + 1);
            bool conv_left = nconv > 0, att_left = true;
            for (int k = 0; conv_left || att_left; ++k) {
                const bool want_conv = conv_left && (!att_left || (k % 4) == 3);
                if (want_conv) {
                    const int c = wq_next(ch, lds);
                    if (c < nconv) conv_strip(p, 2 * l + 1, c, (LAS float*)lds); else conv_left = false;
                } else {
                    const int it = wq_next(qh, lds);
                    if (it >= 1024) att_left = false;
                    else nsa_item(ws, ((63 - (it >> 4)) << 4) | (it & 15), lds);
                }
            }
        }
        xcd_barrier(gbar);
        { const PhOutProj ph{wl, ws, xin, p.out, xn, 1.f, XcdTiles(128, 8)};
          gemm_stream<PhOutProj, APlain, BPlain, EpiResAdd>(ph, ph.xt.loc, ph.xt.nloc, ph.xt.tiles, ND, lds); }
        xcd_barrier(gbar);
        int* cnt = ctl + CW_CNTP + l * 1536;
        int* list = (int*)(ws + WS_LIST);
        float* route = (float*)(ws + WS_ROUTE);
        phase_route(p.out, (const float*)(wl + WL_RT), p.in[12] + l * 4, p.in[14] + l * 16, cnt, list, route, rinv, lds);
        xcd_barrier(gbar);
        LAS int* sm = (LAS int*)(lds + LDS_SM);
        __syncthreads();
        if (tid < 24) sm[tid] = __hip_atomic_load(cnt + 64 * tid, __ATOMIC_RELAXED, __HIP_MEMORY_SCOPE_AGENT);
        __syncthreads();
        if (tid == 0) {
            int tp = 0, hb = 0;
            for (int k = 0; k < 24; ++k) {
                const int c = sm[k];
                sm[32 + k] = tp; sm[64 + k] = hb;
                const int nt_ = (c + 127) >> 7; tp += nt_; hb += nt_ * 128;
            }
            sm[32 + 24] = tp;
        }
        __syncthreads();
        const int total_mt = sm[32 + 24];
        { const PhMoeGU ph{PhMoe{sm, list}, xn, wl, ws, route, rinv, XcdTiles(total_mt, 16)};
          gemm_stream<PhMoeGU, AGather, BPlain, EpiMoeGU>(ph, ph.xt.loc, ph.xt.nloc, ph.xt.tiles, ND, lds); }
        xcd_barrier(gbar);
        { const PhMoeDown ph{PhMoe{sm, list}, wl, ws, p.out, xn, sspA, XcdTiles(total_mt, 8)};
          gemm_stream<PhMoeDown, APlain, BSplit, EpiMoeDown>(ph, ph.xt.loc, ph.xt.nloc, ph.xt.tiles, ND, lds); }
        xcd_barrier(gbar);
        ple_stream(xn, (const bf16_t*)(ws + WS_PBALL) + (size_t)l * NT * 256, wl, p.out, sspA, (bf16_t*)(ws + WS_O), sspB, lds);
        xcd_barrier(gbar);
    }
    phase_final_norm(p.out, p.in[21]);
}

extern "C" void kernel_launch(void* const* d_in, const int* in_sizes, int n_in, void* d_out, int out_size, void* d_ws, size_t ws_size, hipStream_t stream) {
    static int grid = 0;
    if (grid == 0) {
        if (n_in != 22 || out_size != NT * ND || ws_size < WS_END) { fprintf(stderr, "kernel_launch: unexpected shapes (n_in %d out %d ws %zu)\n", n_in, out_size, ws_size); grid = -1; return; }
        int dev = 0, cus = 0, per_cu = 0;
        hipGetDevice(&dev);
        hipDeviceGetAttribute(&cus, hipDeviceAttributeMultiprocessorCount, dev);
        if (hipFuncSetAttribute((const void*)mega_fwd, hipFuncAttributeMaxDynamicSharedMemorySize, LDS_BYTES) != hipSuccess) { fprintf(stderr, "kernel_launch: hipFuncSetAttribute failed\n"); grid = -1; return; }
        hipOccupancyMaxActiveBlocksPerMultiprocessor(&per_cu, (const void*)mega_fwd, 256, LDS_BYTES);
        if (per_cu < 1) { fprintf(stderr, "kernel_launch: occupancy query says %d\n", per_cu); grid = -1; return; }
        if (per_cu > 2) per_cu = 2;
        grid = cus * per_cu;
    }
    if (grid < 0) return;
    hipMemsetAsync((char*)d_ws + WS_CTL, 0, 32768, stream);
    Params p{};
    for (int i = 0; i < 22; ++i) p.in[i] = (const float*)d_in[i];
    p.out = (float*)d_out; p.ws = (unsigned char*)d_ws;
    hipLaunchKernelGGL(mega_fwd, dim3(grid), dim3(256), LDS_BYTES, stream, p);
    const hipError_t e = hipPeekAtLastError();
    if (e != hipSuccess) fprintf(stderr, "launch failed: %s (grid %d)\n", hipGetErrorString(e), grid);
}
```

```cpp
#include <hip/hip_runtime.h>
#include <cstdio>
#include <cstdint>

#ifndef NAIVE_GEMM
#define NAIVE_GEMM 0
#endif
#ifndef NAIVE_ATTN
#define NAIVE_ATTN 0
#endif
#define REP_CONV 1
#define REP_INPROJ 1
#define REP_ATTN 1
#define REP_GU 1
#define REP_NORM 1
#define REP_ROUTE 1
#define REP_DOWN 1
#define REP_OUTPROJ 1
#define REP_PG 1
#define REP_CMP 1
#define REP_MISC 1

#define LAS __attribute__((address_space(3)))
typedef unsigned short bf16_t;
typedef short bf16x8 __attribute__((ext_vector_type(8)));
typedef float f32x4 __attribute__((ext_vector_type(4)));
typedef unsigned u32x4 __attribute__((ext_vector_type(4)));
typedef unsigned u32x2 __attribute__((ext_vector_type(2)));
typedef float f32x16 __attribute__((ext_vector_type(16)));
typedef short s16x4 __attribute__((ext_vector_type(4)));
typedef float f32x2_t __attribute__((ext_vector_type(2)));
typedef __bf16 bf16x2_t __attribute__((ext_vector_type(2)));

constexpr int NB = 8, NS = 2048, ND = 1024, NT = NB * NS;
constexpr int NIN = 2840, NINP = 2944;
constexpr size_t MiB = (size_t)1 << 20;
constexpr size_t WL_IN = 0;
constexpr size_t WL_OUT = WL_IN + (size_t)NINP * 1024 * 2;
constexpr size_t WL_C1 = WL_OUT + (size_t)1024 * 1024 * 2;
constexpr size_t WL_C2 = WL_C1 + (size_t)2 * 256 * 2048 * 2;
constexpr size_t WL_GU = WL_C2 + (size_t)2 * 128 * 256 * 2;
constexpr size_t WL_DN = WL_GU + (size_t)16 * 1024 * 1024 * 2;
constexpr size_t WL_PG = WL_DN + (size_t)16 * 1024 * 512 * 2;
constexpr size_t WL_PP = WL_PG + (size_t)1024 * 1024 * 2;
constexpr size_t WL_BC1 = WL_PP + (size_t)1024 * 256 * 2;
constexpr size_t WL_RT = WL_BC1 + 2048;
constexpr size_t WL_SIZE = 64 * MiB;
static_assert(WL_RT + 131072 <= WL_SIZE, "weight block");
constexpr size_t WS_CTL = 0;
constexpr size_t WS_W = 1 * MiB;
constexpr size_t WS_XN = WS_W + 2 * WL_SIZE;
constexpr size_t WS_PROJ = WS_XN + 32 * MiB;
constexpr size_t WS_QA = WS_PROJ, WS_KA = WS_QA + 16 * MiB, WS_VA = WS_KA + 16 * MiB, WS_QB = WS_VA + 16 * MiB;
constexpr size_t WS_KV6 = WS_QB + 16 * MiB;
constexpr size_t WS_GATES = WS_KV6 + 24 * MiB;
constexpr size_t WS_PROJ_END = WS_GATES + 2 * MiB;
constexpr size_t WS_HID = WS_PROJ;
constexpr size_t WS_P2 = WS_PROJ + 40 * MiB;
constexpr size_t WS_PB = WS_PROJ + 72 * MiB;
constexpr size_t WS_HC = WS_PROJ_END;
constexpr size_t WS_KCMP = WS_HC + 2 * MiB;
constexpr size_t WS_MASK = WS_KCMP + 512 * 1024;
constexpr size_t WS_ROUTE = WS_MASK + 128 * 1024;
constexpr size_t WS_LIST = WS_ROUTE + 128 * 1024;
constexpr size_t WS_O = WS_LIST + 1536 * 1024 + 256 * 1024;
constexpr size_t WS_IMPH = WS_O + 32 * MiB;
constexpr size_t WS_OPA01 = WS_XN;
constexpr size_t WS_OPA2 = WS_IMPH;
constexpr size_t WS_STA = WS_IMPH + 16 * MiB;
constexpr size_t WS_PBALL = WS_IMPH + 20 * MiB;
constexpr size_t WS_SSP = WS_PBALL + 16 * MiB;
constexpr size_t WS_RINV = WS_MASK;
constexpr size_t WS_BC1P = WS_SSP + 2 * MiB;
constexpr size_t WS_END = WS_BC1P + 64 * 1024;
static_assert(WS_PB + 8 * MiB <= WS_PROJ_END, "alias map");
static_assert(WS_END <= 330 * MiB, "workspace");
constexpr int HID_ROWS = NT + 24 * 128;
constexpr int CW_BAR = 1024;
constexpr int CW_Q = 256;
constexpr int CW_CNTP = 4608;
constexpr int CW_CNT = 64;

struct Params {
    const float* in[22];
    float* out;
    unsigned char* ws;
};

__device__ __forceinline__ unsigned f2bf(float f) { unsigned u = __float_as_uint(f); return (u + 0x7fffu + ((u >> 16) & 1u)) >> 16; }
__device__ __forceinline__ unsigned pk2(float lo, float hi) { return f2bf(lo) | (f2bf(hi) << 16); }
__device__ __forceinline__ float bflo(unsigned v) { return __uint_as_float(v << 16); }
__device__ __forceinline__ float bfhi(unsigned v) { return __uint_as_float(v & 0xffff0000u); }
__device__ __forceinline__ float wave_sum(float v) {
#pragma unroll
    for (int o = 1; o < 64; o <<= 1) v += __shfl_xor(v, o);
    return v;
}
__device__ __forceinline__ int TID() { int t = threadIdx.x; asm volatile("" : "+v"(t)); return t; }
__device__ __forceinline__ int BID() { int t = blockIdx.x; asm volatile("" : "+s"(t)); return t; }
__device__ __forceinline__ float sigmoidf_(float x) { return 1.0f / (1.0f + __expf(-x)); }
__device__ __forceinline__ float gelu_tanh(float x) {
    const float u = 0.7978845608028654f * (x + 0.044715f * x * x * x);
    const float e = __expf(2.0f * u);
    const float th = 1.0f - 2.0f / (e + 1.0f);
    return 0.5f * x * (1.0f + th);
}

struct ConvJob { const float* src; bf16_t* dst; const float* gain; int K, N, NP, map, per; size_t dst_bstride; };
__device__ __forceinline__ int conv_job_tiles(int j) { return j == 0 ? 736 : (j == 1 || j == 9) ? 256 : (j == 2 || j == 3) ? 128 : (j == 4 || j == 5) ? 8 : j == 10 ? 64 : 2048; }
__device__ __forceinline__ ConvJob conv_job(const Params& p, int l, int j) {
    unsigned char* wl = p.ws + WS_W + (size_t)l * WL_SIZE;
    ConvJob c; c.map = 0; c.dst_bstride = 0; c.gain = nullptr;
    switch (j) {
    case 0: c.src = p.in[3] + (size_t)l * 1024 * NIN; c.K = 1024; c.N = NIN; c.NP = NINP; c.dst = (bf16_t*)(wl + WL_IN); c.gain = p.in[2] + l * ND; break;
    case 1: c.src = p.in[4] + (size_t)l * 1024 * 1024; c.K = 1024; c.N = 1024; c.NP = 1024; c.dst = (bf16_t*)(wl + WL_OUT); break;
    case 2: c.src = p.in[5] + (size_t)l * 2048 * 256; c.K = 2048; c.N = 256; c.NP = 256; c.dst = (bf16_t*)(wl + WL_C1); break;
    case 3: c.src = p.in[7] + (size_t)l * 2048 * 256; c.K = 2048; c.N = 256; c.NP = 256; c.dst = (bf16_t*)(wl + WL_C1) + (size_t)256 * 2048; break;
    case 4: c.src = p.in[6] + (size_t)l * 256 * 64; c.K = 256; c.N = 64; c.NP = 128; c.dst = (bf16_t*)(wl + WL_C2); break;
    case 5: c.src = p.in[8] + (size_t)l * 256 * 64; c.K = 256; c.N = 64; c.NP = 128; c.dst = (bf16_t*)(wl + WL_C2) + (size_t)128 * 256; break;
    case 6: c.src = p.in[15] + (size_t)l * 16 * 1024 * 512; c.K = 1024; c.N = 512; c.NP = 512; c.dst = (bf16_t*)(wl + WL_GU); c.map = 1; c.dst_bstride = (size_t)1024 * 1024; c.gain = p.in[10] + l * ND; break;
    case 7: c.src = p.in[16] + (size_t)l * 16 * 1024 * 512; c.K = 1024; c.N = 512; c.NP = 512; c.dst = (bf16_t*)(wl + WL_GU); c.map = 2; c.dst_bstride = (size_t)1024 * 1024; c.gain = p.in[10] + l * ND; break;
    case 8: c.src = p.in[17] + (size_t)l * 16 * 512 * 1024; c.K = 512; c.N = 1024; c.NP = 1024; c.dst = (bf16_t*)(wl + WL_DN); c.dst_bstride = (size_t)1024 * 512; break;
    case 9: c.src = p.in[19] + (size_t)l * 1024 * 1024; c.K = 1024; c.N = 1024; c.NP = 1024; c.dst = (bf16_t*)(wl + WL_PG); c.gain = p.in[18] + l * ND; break;
    default: c.src = p.in[20] + (size_t)l * 256 * 1024; c.K = 256; c.N = 1024; c.NP = 1024; c.dst = (bf16_t*)(wl + WL_PP); break;
    }
    c.per = (c.K / 64) * (c.NP / 64);
    return c;
}
__device__ __forceinline__ void convert_tiles(const ConvJob& c, int t0, int t1, LAS float* tl) {
    const int tid = TID();
    const int ntiles = c.NP / 64;
    const int kr = tid >> 4, c4 = (tid & 15) * 4;
    f32x4 v[4]; float gv[4];
#define CT_LOAD(it_) do { const int _bi = (it_) / c.per, _r = (it_) - _bi * c.per, _kt = _r / ntiles, _nt = _r - _kt * ntiles; \
        const int _n = _nt * 64 + c4; const bool _ok = _n < c.N; \
        const float* _sp = c.src + (size_t)_bi * c.K * c.N + (size_t)(_kt * 64 + kr) * c.N + (_ok ? _n : 0); \
        _Pragma("unroll") for (int _i = 0; _i < 4; ++_i) v[_i] = *(const f32x4*)(_sp + (size_t)(16 * _i) * c.N); \
        if (c.gain) { _Pragma("unroll") for (int _i = 0; _i < 4; ++_i) gv[_i] = c.gain[_kt * 64 + kr + 16 * _i]; } \
        else { _Pragma("unroll") for (int _i = 0; _i < 4; ++_i) gv[_i] = 1.0f; } \
        if (!_ok) { _Pragma("unroll") for (int _i = 0; _i < 4; ++_i) gv[_i] = 0.f; } } while (0)
    CT_LOAD(t0);
    for (int it = t0; it < t1; ++it) {
        const int bi = it / c.per, r = it - bi * c.per, kt = r / ntiles, nt = r - kt * ntiles;
        bf16_t* d = c.dst + (size_t)bi * c.dst_bstride;
        const int k0 = kt * 64, n0 = nt * 64;
        __syncthreads();
#pragma unroll
        for (int i = 0; i < 4; ++i) {
            LAS float* tp = tl + (kr + 16 * i) * 65 + c4;
            tp[0] = v[i].x * gv[i]; tp[1] = v[i].y * gv[i]; tp[2] = v[i].z * gv[i]; tp[3] = v[i].w * gv[i];
        }
        if (it + 1 < t1) CT_LOAD(it + 1);
        __syncthreads();
        const int n = tid >> 2, kc = (tid & 3) * 16;
        const int nsrc = n0 + n;
        const int row = (c.map == 0) ? nsrc : ((nsrc >> 4) * 32 + (nsrc & 15) + (c.map == 2 ? 16 : 0));
        float w[16];
#pragma unroll
        for (int j = 0; j < 16; ++j) w[j] = tl[(kc + j) * 65 + n];
        u32x4 o0, o1;
        o0.x = pk2(w[0], w[1]); o0.y = pk2(w[2], w[3]); o0.z = pk2(w[4], w[5]); o0.w = pk2(w[6], w[7]);
        o1.x = pk2(w[8], w[9]); o1.y = pk2(w[10], w[11]); o1.z = pk2(w[12], w[13]); o1.w = pk2(w[14], w[15]);
        bf16_t* dp = d + (size_t)row * c.K + k0 + kc;
        *(u32x4*)dp = o0; *(u32x4*)(dp + 8) = o1;
    }
#undef CT_LOAD
}
__device__ __forceinline__ int conv_list(int q, int i) {
    if (q == 0) return i == 0 ? 6 : (i == 1 ? 7 : -1);
    if (q == 1) return i == 0 ? 8 : i == 1 ? 9 : i == 2 ? 10 : i == 3 ? 16 : i == 4 ? 18 : i == 5 ? 19 : i == 6 ? 20 : i == 7 ? 21 : -1;
    if (q == 2) return i == 0 ? 17 : i == 1 ? 22 : i == 2 ? 23 : -1;
    return i == 0 ? 24 : i == 1 ? 25 : i == 2 ? 26 : -1;
}
__device__ __forceinline__ int conv_queue_strips(int q) {
    int n = 0;
    for (int i = 0; i < 8; ++i) { const int e = conv_list(q, i); if (e < 0) break; n += conv_job_tiles(e & 15) >> 3; }
    return n;
}
__device__ __forceinline__ void conv_strip(const Params& p, int q, int c, LAS float* tl) {
    for (int i = 0; i < 8; ++i) {
        const int e = conv_list(q, i);
        if (e < 0) return;
        const int ns = conv_job_tiles(e & 15) >> 3;
        if (c < ns) { const ConvJob job = conv_job(p, e >> 4, e & 15); convert_tiles(job, c * 8, c * 8 + 8, tl); return; }
        c -= ns;
    }
}

__device__ __forceinline__ void convert_p(const Params& p) {
    const f32x4* pl = (const f32x4*)p.in[1]; u32x2* pb = (u32x2*)(p.ws + WS_PBALL);
    for (int i = BID() * 256 + TID(); i < 2 * NT * 256 / 4; i += gridDim.x * 256) {
        const f32x4 v = pl[i]; u32x2 w; w.x = pk2(v.x, v.y); w.y = pk2(v.z, v.w); pb[i] = w;
    }
}
__device__ __forceinline__ void phase_convert(const Params& p, LAS float* tl) {
    {
        int base = 0;
        for (int j = 0; j < 6; ++j) {
            const ConvJob job = conv_job(p, 0, j);
            const int nt = conv_job_tiles(j);
            const int g = gridDim.x, b = BID();
            int first = (b - base % g + g) % g;
            for (int s = first; s < nt; s += g) convert_tiles(job, s, s + 1, tl);
            base += nt;
        }
    }
    {
        const int tid_ = TID(); const int lane = tid_ & 63, gw = BID() * 4 + (tid_ >> 6), ngw = gridDim.x * 4;
        for (int row = gw; row < NT; row += ngw) {
            const f32x4* xr = (const f32x4*)(p.in[0] + (size_t)row * ND) + lane;
            u32x2* o = (u32x2*)((bf16_t*)(p.ws + WS_XN) + (size_t)row * ND) + lane;
            float ss = 0.f;
#pragma unroll
            for (int j = 0; j < 4; ++j) { const f32x4 v = xr[64 * j]; ss += (v.x * v.x + v.y * v.y) + (v.z * v.z + v.w * v.w); u32x2 w; w.x = pk2(v.x, v.y); w.y = pk2(v.z, v.w); o[64 * j] = w; }
            ss = wave_sum(ss);
            if (lane < 16) ((float*)(p.ws + WS_SSP) + (size_t)NT * 16)[(size_t)row * 16 + lane] = lane == 0 ? ss : 0.f;
        }
    }
    for (int i = BID() * 256 + TID(); i < 2 * 1024 * 32; i += gridDim.x * 256) {
        const int l = i >> 15, k = (i >> 5) & 1023, j = i & 31;
        const float gk = p.in[10][l * ND + k];
        const float wv = j < 4 ? p.in[11][(size_t)(l * ND + k) * 4 + j] : (j < 20 ? p.in[13][(size_t)(l * ND + k) * 16 + (j - 4)] : 0.f);
        ((float*)(p.ws + WS_W + (size_t)l * WL_SIZE + WL_RT))[k * 32 + j] = gk * wv;
    }
    for (int i = BID() * 256 + TID(); i < 16 * 1024; i += gridDim.x * 256) {
        const int part = i >> 10, o = i & 1023, l = o >> 9, kv = (o >> 8) & 1, n = o & 255;
        const float* pos = p.in[9] + (size_t)(l * 2 + kv) * 2048 + part * 128;
        const float* w1 = p.in[kv ? 7 : 5] + (size_t)l * 2048 * 256 + (size_t)part * 128 * 256 + n;
        float s = 0.f;
#pragma unroll 16
        for (int k = 0; k < 128; ++k) s += pos[k] * w1[(size_t)k * 256];
        ((float*)(p.ws + WS_BC1P))[i] = s;
    }
}

__device__ __forceinline__ void phase_norm(const float* x, const float* g, bf16_t* xn) {
    const int tid_ = TID(); const int lane = tid_ & 63, gw = BID() * 4 + (tid_ >> 6), ngw = gridDim.x * 4;
    for (int row = gw; row < NT; row += ngw) {
        const f32x4* xr = (const f32x4*)(x + (size_t)row * ND) + lane;
        f32x4 v[4]; float ss = 0.f;
#pragma unroll
        for (int j = 0; j < 4; ++j) { v[j] = xr[64 * j]; ss += (v[j].x * v[j].x + v[j].y * v[j].y) + (v[j].z * v[j].z + v[j].w * v[j].w); }
        ss = wave_sum(ss);
        const float r = 1.0f / sqrtf(ss * (1.0f / ND) + 1e-6f);
        u32x2* o = (u32x2*)(xn + (size_t)row * ND) + lane;
#pragma unroll
        for (int j = 0; j < 4; ++j) {
            const f32x4 gg = ((const f32x4*)g)[lane + 64 * j];
            u32x2 w; w.x = pk2(v[j].x * r * gg.x, v[j].y * r * gg.y); w.y = pk2(v[j].z * r * gg.z, v[j].w * r * gg.w);
            o[64 * j] = w;
        }
    }
}
__device__ __forceinline__ void phase_final_norm(float* x, const float* g) {
    const int tid_ = TID(); const int lane = tid_ & 63, gw = BID() * 4 + (tid_ >> 6), ngw = gridDim.x * 4;
    for (int row = gw; row < NT; row += ngw) {
        f32x4* xr = (f32x4*)(x + (size_t)row * ND) + lane;
        f32x4 v[4]; float ss = 0.f;
#pragma unroll
        for (int j = 0; j < 4; ++j) { v[j] = xr[64 * j]; ss += (v[j].x * v[j].x + v[j].y * v[j].y) + (v[j].z * v[j].z + v[j].w * v[j].w); }
        ss = wave_sum(ss);
        const float r = 1.0f / sqrtf(ss * (1.0f / ND) + 1e-6f);
#pragma unroll
        for (int j = 0; j < 4; ++j) {
            const f32x4 gg = ((const f32x4*)g)[lane + 64 * j];
            f32x4 o; o.x = v[j].x * r * gg.x; o.y = v[j].y * r * gg.y; o.z = v[j].z * r * gg.z; o.w = v[j].w * r * gg.w;
            xr[64 * j] = o;
        }
    }
}
typedef float f32x16r __attribute__((ext_vector_type(16)));
__device__ __forceinline__ void phase_route(const float* x, const float* wr, const float* brg, const float* bre, int* cnt, int* list, float* route, float* rinv, LAS unsigned char* lds) {
    const int tid_ = TID(); const int lane = tid_ & 63, wv = tid_ >> 6;
    const int i = lane & 31, hk = lane >> 5;
    LAS float* tl = (LAS float*)lds + wv * (32 * 33);
    LAS float* ssl = (LAS float*)(lds + 4 * 32 * 33 * 4);
    for (int task = BID(); task < NT / 32; task += gridDim.x) {
        const int row0 = task * 32;
        const float* xr = x + (size_t)(row0 + i) * ND + wv * 256;
        const float* wp = wr + (size_t)(wv * 256) * 32 + hk * 32 + i;
        f32x16r acc;
#pragma unroll
        for (int q = 0; q < 16; ++q) acc[q] = 0.f;
        float ss = 0.f;
#pragma unroll 16
        for (int k4 = 0; k4 < 64; ++k4) {
            const f32x4 xa = *(const f32x4*)(xr + 4 * k4);
            const float w0 = wp[(4 * k4) * 32], w1 = wp[(4 * k4 + 2) * 32];
            const float a0 = hk ? xa.y : xa.x, a1 = hk ? xa.w : xa.z;
            acc = __builtin_amdgcn_mfma_f32_32x32x2f32(a0, w0, acc, 0, 0, 0);
            acc = __builtin_amdgcn_mfma_f32_32x32x2f32(a1, w1, acc, 0, 0, 0);
            ss += a0 * a0 + a1 * a1;
        }
        ss += __shfl_xor(ss, 32);
#pragma unroll
        for (int q = 0; q < 16; ++q) tl[((q & 3) + 8 * (q >> 2) + 4 * hk) * 33 + i] = acc[q];
        if (hk == 0) ssl[wv * 32 + i] = ss;
        __syncthreads();
        if (wv == 0 && hk == 0) {
            LAS const float* tp0 = (LAS const float*)lds;
            const float sst = (ssl[i] + ssl[32 + i]) + (ssl[64 + i] + ssl[96 + i]);
            const float r = 1.0f / sqrtf(sst * (1.0f / ND) + 1e-6f);
#define RT_SUM(e_) ((tp0[i * 33 + (e_)] + tp0[32 * 33 + i * 33 + (e_)]) + (tp0[2 * 32 * 33 + i * 33 + (e_)] + tp0[3 * 32 * 33 + i * 33 + (e_)]))
            float gl[4], el[16];
#pragma unroll
            for (int e = 0; e < 4; ++e) gl[e] = RT_SUM(e) * r + brg[e];
#pragma unroll
            for (int e = 0; e < 16; ++e) el[e] = RT_SUM(4 + e) * r + bre[e];
#undef RT_SUM
            int gsel = 0; float gmax = gl[0];
#pragma unroll
            for (int e = 1; e < 4; ++e) if (gl[e] > gmax) { gmax = gl[e]; gsel = e; }
            float gden = 0.f;
#pragma unroll
            for (int e = 0; e < 4; ++e) gden += __expf(gl[e] - gmax);
            const float gw_ = 1.0f / gden;
            float wi[4];
#pragma unroll
            for (int e = 0; e < 4; ++e) wi[e] = gsel == 0 ? el[e] : (gsel == 1 ? el[4 + e] : (gsel == 2 ? el[8 + e] : el[12 + e]));
            int i0 = 0; float t0 = wi[0];
#pragma unroll
            for (int e = 1; e < 4; ++e) if (wi[e] > t0) { t0 = wi[e]; i0 = e; }
            int i1 = -1; float t1 = -3.0e38f;
#pragma unroll
            for (int e = 0; e < 4; ++e) if (e != i0 && wi[e] > t1) { t1 = wi[e]; i1 = e; }
            const float ex = __expf(t1 - t0);
            const float ew0 = gw_ / (1.0f + ex), ew1 = gw_ * ex / (1.0f + ex);
            const int lo = i0 < i1 ? i0 : i1, hi = i0 < i1 ? i1 : i0;
            const float wlo = i0 < i1 ? ew0 : ew1, whi = i0 < i1 ? ew1 : ew0;
            const int pidx = lo == 0 ? hi - 1 : (lo == 1 ? hi + 1 : 5);
            const int bucket = gsel * 6 + pidx;
            const int row = row0 + i;
            const int pos = atomicAdd(cnt + 64 * bucket, 1);
            list[(size_t)bucket * NT + pos] = row;
            route[2 * row] = wlo; route[2 * row + 1] = whi;
            rinv[row] = r;
        }
        __syncthreads();
    }
}

struct APlain { const bf16_t* base; int ld; __device__ __forceinline__ const bf16_t* operator()(int r) const { return base + (size_t)r * ld; } };
struct ACmp { const bf16_t* base; __device__ __forceinline__ const bf16_t* operator()(int r) const { return base + (size_t)(r < 126 ? r : 126) * 1024; } };
struct AGather { const bf16_t* xn; const int* list; int cnt; __device__ __forceinline__ const bf16_t* operator()(int r) const { return xn + (size_t)(r < cnt ? list[r] : 0) * ND; } };
struct BPlain { const bf16_t* base; int ld; __device__ __forceinline__ const bf16_t* operator()(int r, int k0) const { return base + (size_t)r * ld + k0; } };
struct BSplit { const bf16_t* b0; const bf16_t* b1; __device__ __forceinline__ const bf16_t* operator()(int r, int k0) const { return k0 < 512 ? b0 + (size_t)r * 512 + k0 : b1 + (size_t)r * 512 + (k0 - 512); } };

template <class AP, class BP, class APN, class BPN>
__device__ __forceinline__ void gemm_kloop(f32x4 (&acc)[4][4], const AP& ap, const BP& bp, int K, LAS unsigned char* lds, bool prefetched, bool has_next, const APN& apn, const BPN& bpn) {
    const int tid = TID(), wid = tid >> 6, lane = tid & 63, wr = wid >> 1, wc = wid & 1, fr = lane & 15, fq = lane >> 4;
#if NAIVE_GEMM
    for (int k0 = 0; k0 < K; k0 += 32) {
#pragma unroll
        for (int m = 0; m < 4; ++m) {
            const bf16_t* arow = ap(wr * 64 + m * 16 + fr) + k0;
            u32x4 av[4];
#pragma unroll
            for (int c = 0; c < 4; ++c) av[c] = ((const u32x4*)arow)[c];
#pragma unroll
            for (int n = 0; n < 4; ++n)
#pragma unroll
                for (int j = 0; j < 4; ++j) {
                    const bf16_t* brow = bp(wc * 64 + n * 16 + 4 * fq + j, k0);
                    float s = 0.f;
#pragma unroll
                    for (int c = 0; c < 4; ++c) {
                        const u32x4 bv = ((const u32x4*)brow)[c];
                        s += bflo(av[c].x) * bflo(bv.x) + bfhi(av[c].x) * bfhi(bv.x) + bflo(av[c].y) * bflo(bv.y) + bfhi(av[c].y) * bfhi(bv.y)
                           + bflo(av[c].z) * bflo(bv.z) + bfhi(av[c].z) * bfhi(bv.z) + bflo(av[c].w) * bflo(bv.w) + bfhi(av[c].w) * bfhi(bv.w);
                    }
                    acc[m][n][j] += s;
                }
        }
    }
#else
    const unsigned woff = (unsigned)wid * 1024u;
    const bf16_t* aptr[4]; int brow[4], bcol;
    {
        const int sb = lane * 16, swz = sb ^ (((sb >> 9) & 1) << 5);
        const int rl = swz >> 6, cc = (wid & 1) * 32 + ((swz & 63) >> 1);
        bcol = cc;
#pragma unroll
        for (int i = 0; i < 4; ++i) { const int R = ((wid >> 1) + 2 * i) * 16 + rl; aptr[i] = ap(R) + cc; brow[i] = R; }
    }
    int aoff[4], boff[4];
#pragma unroll
    for (int m = 0; m < 4; ++m) {
        { const int r = wr * 64 + m * 16 + fr, c = fq * 8, st = (r >> 4) * 2, ob = (r & 15) * 64 + c * 2; aoff[m] = st * 1024 + (ob ^ (((ob >> 9) & 1) << 5)); }
        { const int r = wc * 64 + m * 16 + fr, c = fq * 8, st = (r >> 4) * 2, ob = (r & 15) * 64 + c * 2; boff[m] = st * 1024 + (ob ^ (((ob >> 9) & 1) << 5)); }
    }
    const int nk = K / 64;
#define GT_STAGE(buf, t) do { const int _k0 = (t) * 64; LAS unsigned char* _ba = lds + (buf) * 32768 + woff; \
        _Pragma("unroll") for (int _i = 0; _i < 4; ++_i) { \
            __builtin_amdgcn_global_load_lds((const unsigned*)(aptr[_i] + _k0), (LAS unsigned*)(_ba + _i * 4096), 16, 0, 0); \
            __builtin_amdgcn_global_load_lds((const unsigned*)(bp(brow[_i], _k0) + bcol), (LAS unsigned*)(_ba + 16384 + _i * 4096), 16, 0, 0); } } while (0)
    if (!prefetched) GT_STAGE(0, 0);
#pragma unroll 1
    for (int t = 0; t < nk; ++t) {
        asm volatile("s_waitcnt vmcnt(0)" ::: "memory");
        __syncthreads();
        if (t + 1 < nk) GT_STAGE((t + 1) & 1, t + 1);
        else if (has_next) {
            LAS unsigned char* _ba = lds + woff;
#pragma unroll
            for (int _i = 0; _i < 4; ++_i) {
                __builtin_amdgcn_global_load_lds((const unsigned*)(apn(brow[_i]) + bcol), (LAS unsigned*)(_ba + _i * 4096), 16, 0, 0);
                __builtin_amdgcn_global_load_lds((const unsigned*)(bpn(brow[_i], 0) + bcol), (LAS unsigned*)(_ba + 16384 + _i * 4096), 16, 0, 0);
            }
        }
        LAS const unsigned char* la = lds + (t & 1) * 32768;
        LAS const unsigned char* lb = la + 16384;
#pragma unroll
        for (int kh = 0; kh < 2; ++kh) {
            bf16x8 At[4], Bt[4];
#pragma unroll
            for (int m = 0; m < 4; ++m) At[m] = *(const LAS bf16x8*)(la + aoff[m] + kh * 1024);
#pragma unroll
            for (int n = 0; n < 4; ++n) Bt[n] = *(const LAS bf16x8*)(lb + boff[n] + kh * 1024);
#pragma unroll
            for (int m = 0; m < 4; ++m)
#pragma unroll
                for (int n = 0; n < 4; ++n) acc[m][n] = __builtin_amdgcn_mfma_f32_16x16x32_bf16(Bt[n], At[m], acc[m][n], 0, 0, 0);
        }
    }
#undef GT_STAGE
#endif
}
__device__ __forceinline__ void zero_acc(f32x4 (&acc)[4][4]) {
#pragma unroll
    for (int m = 0; m < 4; ++m)
#pragma unroll
        for (int n = 0; n < 4; ++n) acc[m][n] = (f32x4){0.f, 0.f, 0.f, 0.f};
}
template <class AP, class BP, class EPI>
__device__ __forceinline__ void gemm_tile(const AP& ap, const BP& bp, int K, const EPI& epi, LAS unsigned char* lds, bool prefetched, bool has_next, const AP& apn, const BP& bpn) {
    const int tid = TID(), wid = tid >> 6, lane = tid & 63, wr = wid >> 1, wc = wid & 1, fr = lane & 15, fq = lane >> 4;
    f32x4 acc[4][4]; zero_acc(acc);
    gemm_kloop(acc, ap, bp, K, lds, prefetched, has_next, apn, bpn);
    epi(acc, wr, wc, fr, fq);
}

__device__ __forceinline__ float rinv_from_ssp(const float* ssp, int row) {
    const f32x4* q = (const f32x4*)(ssp + (size_t)row * 16);
    const f32x4 a = q[0], b = q[1], c = q[2], d = q[3];
    const float s = ((a.x + a.y) + (a.z + a.w)) + ((b.x + b.y) + (b.z + b.w)) + ((c.x + c.y) + (c.z + c.w)) + ((d.x + d.y) + (d.z + d.w));
    return 1.0f / sqrtf(s * (1.0f / ND) + 1e-6f);
}
__device__ __forceinline__ float row_ss64(const f32x4& a, const f32x4& b, const f32x4& c, const f32x4& d) {
    float s = ((a.x * a.x + a.y * a.y) + (a.z * a.z + a.w * a.w)) + ((b.x * b.x + b.y * b.y) + (b.z * b.z + b.w * b.w))
            + ((c.x * c.x + c.y * c.y) + (c.z * c.z + c.w * c.w)) + ((d.x * d.x + d.y * d.y) + (d.z * d.z + d.w * d.w));
    s += __shfl_xor(s, 16); s += __shfl_xor(s, 32);
    return s;
}
struct EpiInProj {
    int mt, nt; unsigned char* ws; const float* ssp;
    __device__ __forceinline__ void operator()(const f32x4 (&acc)[4][4], int wr, int wc, int fr, int fq) const {
#pragma unroll
        for (int m = 0; m < 4; ++m) {
            const int row = mt * 128 + wr * 64 + m * 16 + fr, b = row >> 11, s = row & 2047;
            const float rr = rinv_from_ssp(ssp, row);
#pragma unroll
            for (int n = 0; n < 4; ++n) {
                const int col = wc * 64 + n * 16 + 4 * fq;
                const f32x4 v = acc[m][n] * rr;
                if (nt < 16) {
                    const int reg = nt >> 2, c = (nt & 3) * 128 + col, head = c >> 6, d = c & 63;
                    const float sc = (reg == 0 || reg == 3) ? 0.125f * 1.4426950408889634f : 1.0f;
                    bf16_t* dst = (bf16_t*)(ws + WS_QA + (size_t)reg * 16 * MiB) + ((size_t)((b * 8 + head) * NS + s) * 64 + d);
                    u32x2 w; w.x = pk2(v.x * sc, v.y * sc); w.y = pk2(v.z * sc, v.w * sc);
                    *(u32x2*)dst = w;
                } else if (nt < 22) {
                    const int g = col >> 6, d = col & 63;
                    bf16_t* dst = (bf16_t*)(ws + WS_KV6 + (size_t)(nt - 16) * 4 * MiB) + ((size_t)((b * 2 + g) * NS + s) * 64 + d);
                    u32x2 w; w.x = pk2(v.x, v.y); w.y = pk2(v.z, v.w);
                    *(u32x2*)dst = w;
                } else {
                    if (col < 24) {
                        f32x4 o; o.x = sigmoidf_(v.x); o.y = sigmoidf_(v.y); o.z = sigmoidf_(v.z); o.w = sigmoidf_(v.w);
                        *(f32x4*)((float*)(ws + WS_GATES) + (size_t)row * 24 + col) = o;
                    }
                }
            }
        }
    }
};
struct EpiCmp1 {
    bf16_t* hc; const float* bc1; int row0, col0;
    __device__ __forceinline__ void operator()(const f32x4 (&acc)[4][4], int wr, int wc, int fr, int fq) const {
#pragma unroll
        for (int m = 0; m < 4; ++m) {
            const int row = row0 + wr * 64 + m * 16 + fr;
#pragma unroll
            for (int n = 0; n < 4; ++n) {
                const int col = col0 + wc * 64 + n * 16 + 4 * fq;
                f32x4 bb = *(const f32x4*)(bc1 + col);
#pragma unroll
                for (int pp = 1; pp < 16; ++pp) bb += *(const f32x4*)(bc1 + pp * 1024 + col);
                const f32x4 v = acc[m][n];
                u32x2 w; w.x = pk2(gelu_tanh(v.x + bb.x), gelu_tanh(v.y + bb.y)); w.y = pk2(gelu_tanh(v.z + bb.z), gelu_tanh(v.w + bb.w));
                *(u32x2*)(hc + (size_t)row * 256 + col) = w;
            }
        }
    }
};
struct EpiCmp2 {
    bf16_t* dst; int row0;
    __device__ __forceinline__ void operator()(const f32x4 (&acc)[4][4], int wr, int wc, int fr, int fq) const {
        if (wc != 0) return;
#pragma unroll
        for (int m = 0; m < 4; ++m) {
            const int row = row0 + wr * 64 + m * 16 + fr;
#pragma unroll
            for (int n = 0; n < 4; ++n) {
                const int col = n * 16 + 4 * fq;
                const f32x4 v = acc[m][n];
                u32x2 w; w.x = pk2(v.x, v.y); w.y = pk2(v.z, v.w);
                *(u32x2*)(dst + (size_t)row * 64 + col) = w;
            }
        }
    }
};
struct EpiResAdd {
    const float* base; float* out; bf16_t* xb; int row0, col0; float sc;
    __device__ __forceinline__ void operator()(const f32x4 (&acc)[4][4], int wr, int wc, int fr, int fq) const {
#pragma unroll
        for (int m = 0; m < 4; ++m) {
            const int row = row0 + wr * 64 + m * 16 + fr;
#pragma unroll
            for (int n = 0; n < 4; ++n) {
                const int col = col0 + wc * 64 + n * 16 + 4 * fq;
                const size_t off = (size_t)row * ND + col;
                const f32x4 bs = *(const f32x4*)(base + off);
                const f32x4 nv = bs + acc[m][n] * sc;
                *(f32x4*)(out + off) = nv;
                u32x2 w; w.x = pk2(nv.x, nv.y); w.y = pk2(nv.z, nv.w);
                *(u32x2*)(xb + off) = w;
            }
        }
    }
};
struct EpiMoeGU {
    bf16_t* hid; const int* list; const float* route; const float* rinv; int cnt, hrow0, nt16;
    __device__ __forceinline__ void operator()(const f32x4 (&acc)[4][4], int wr, int wc, int fr, int fq) const {
        const int half = nt16 >> 3, nte = nt16 & 7;
#pragma unroll
        for (int m = 0; m < 4; ++m) {
            const int r = wr * 64 + m * 16 + fr;
            const int tok = r < cnt ? list[r] : 0;
            const float w = r < cnt ? route[2 * tok + half] : 0.f;
            const float rt = rinv[tok];
#pragma unroll
            for (int pr = 0; pr < 2; ++pr) {
                const f32x4 gv = acc[m][2 * pr], uv = acc[m][2 * pr + 1];
                const int hc = half * 512 + (4 * nte + 2 * wc + pr) * 16 + 4 * fq;
                float h[4];
#pragma unroll
                for (int j = 0; j < 4; ++j) { const float gg = gv[j] * rt; h[j] = gg / (1.0f + __expf(-gg)) * (uv[j] * rt) * w; }
                u32x2 o; o.x = pk2(h[0], h[1]); o.y = pk2(h[2], h[3]);
                *(u32x2*)(hid + (size_t)(hrow0 + r) * 1024 + hc) = o;
            }
        }
    }
};
struct EpiMoeDown {
    float* out; const int* list; bf16_t* xb; float* ssp; int cnt, col0;
    __device__ __forceinline__ void operator()(const f32x4 (&acc)[4][4], int wr, int wc, int fr, int fq) const {
#pragma unroll
        for (int m = 0; m < 4; ++m) {
            const int r = wr * 64 + m * 16 + fr;
            const bool ok = r < cnt;
            const int tok = ok ? list[r] : 0;
            f32x4 nv[4];
#pragma unroll
            for (int n = 0; n < 4; ++n) {
                const int col = col0 + wc * 64 + n * 16 + 4 * fq;
                const size_t off = (size_t)tok * ND + col;
                nv[n] = *(const f32x4*)(out + off) + acc[m][n];
                if (ok) {
                    *(f32x4*)(out + off) = nv[n];
                    u32x2 w; w.x = pk2(nv[n].x, nv[n].y); w.y = pk2(nv[n].z, nv[n].w);
                    *(u32x2*)(xb + off) = w;
                }
            }
            const float ps = row_ss64(nv[0], nv[1], nv[2], nv[3]);
            if (ok && fq == 0) ssp[(size_t)tok * 16 + (col0 >> 6) + wc] = ps;
        }
    }
};
struct EpiBf16 {
    bf16_t* dst; int ld, row0, col0;
    __device__ __forceinline__ void operator()(const f32x4 (&acc)[4][4], int wr, int wc, int fr, int fq) const {
#pragma unroll
        for (int m = 0; m < 4; ++m) {
            const int row = row0 + wr * 64 + m * 16 + fr;
#pragma unroll
            for (int n = 0; n < 4; ++n) {
                const int col = col0 + wc * 64 + n * 16 + 4 * fq;
                const f32x4 v = acc[m][n];
                u32x2 w; w.x = pk2(v.x, v.y); w.y = pk2(v.z, v.w);
                *(u32x2*)(dst + (size_t)row * ld + col) = w;
            }
        }
    }
};
struct EpiPleFused {
    float* out; const float* ssp_in; bf16_t* xbo; float* ssp_out; int row0, col0;
    __device__ __forceinline__ void operator()(const f32x4 (&acc)[4][4], const f32x4 (&acc2)[4][4], int wr, int wc, int fr, int fq) const {
#pragma unroll
        for (int m = 0; m < 4; ++m) {
            const int row = row0 + wr * 64 + m * 16 + fr;
            const float rr = rinv_from_ssp(ssp_in, row);
            f32x4 nv[4];
#pragma unroll
            for (int n = 0; n < 4; ++n) {
                const int col = col0 + wc * 64 + n * 16 + 4 * fq;
                const size_t off = (size_t)row * ND + col;
                const f32x4 v = acc[m][n] * rr, q = acc2[m][n];
                f32x4 o = *(const f32x4*)(out + off);
                o.x += sigmoidf_(v.x) * q.x; o.y += sigmoidf_(v.y) * q.y; o.z += sigmoidf_(v.z) * q.z; o.w += sigmoidf_(v.w) * q.w;
                *(f32x4*)(out + off) = o;
                u32x2 w; w.x = pk2(o.x, o.y); w.y = pk2(o.z, o.w);
                *(u32x2*)(xbo + off) = w;
                nv[n] = o;
            }
            const float ps = row_ss64(nv[0], nv[1], nv[2], nv[3]);
            if (fq == 0) ssp_out[(size_t)row * 16 + (col0 >> 6) + wc] = ps;
            asm volatile("" ::: "memory");
        }
    }
};
struct EpiPleGate {
    float* out; const bf16_t* p2; int row0, col0; float sc;
    __device__ __forceinline__ void operator()(const f32x4 (&acc)[4][4], int wr, int wc, int fr, int fq) const {
#pragma unroll
        for (int m = 0; m < 4; ++m) {
            const int row = row0 + wr * 64 + m * 16 + fr;
#pragma unroll
            for (int n = 0; n < 4; ++n) {
                const int col = col0 + wc * 64 + n * 16 + 4 * fq;
                const size_t off = (size_t)row * ND + col;
                const u32x2 pv = *(const u32x2*)(p2 + off);
                const f32x4 v = acc[m][n];
                f32x4 o = *(const f32x4*)(out + off);
                o.x += sc * sigmoidf_(v.x) * bflo(pv.x); o.y += sc * sigmoidf_(v.y) * bfhi(pv.x); o.z += sc * sigmoidf_(v.z) * bflo(pv.y); o.w += sc * sigmoidf_(v.w) * bfhi(pv.y);
                *(f32x4*)(out + off) = o;
            }
        }
    }
};

template <class PH, class AP, class BP, class EPI>
__device__ __forceinline__ void gemm_stream(const PH& ph, int first, int step, int count, int K, LAS unsigned char* lds) {
    int q = first;
    if (q >= count) return;
    AP ap, apn; BP bp, bpn; EPI ep, epn;
    ph.make(q, ap, bp, ep);
    bool pref = false;
    for (;;) {
        const int qn = q + step; const bool hn = qn < count;
        if (hn) ph.make(qn, apn, bpn, epn); else { apn = ap; bpn = bp; epn = ep; }
        gemm_tile(ap, bp, K, ep, lds, pref, hn, apn, bpn);
        if (!hn) break;
        ap = apn; bp = bpn; ep = epn; q = qn; pref = true;
    }
}

__device__ __forceinline__ void load_q32(const bf16_t* p, float* q) {
#pragma unroll
    for (int c = 0; c < 4; ++c) {
        const u32x4 v = ((const u32x4*)p)[c];
        q[8 * c] = bflo(v.x); q[8 * c + 1] = bfhi(v.x); q[8 * c + 2] = bflo(v.y); q[8 * c + 3] = bfhi(v.y);
        q[8 * c + 4] = bflo(v.z); q[8 * c + 5] = bfhi(v.z); q[8 * c + 6] = bflo(v.w); q[8 * c + 7] = bfhi(v.w);
    }
}
__device__ __forceinline__ float dot32p(const float* q, const bf16_t* k) {
    float s0 = 0.f, s1 = 0.f;
#pragma unroll
    for (int c = 0; c < 4; ++c) {
        const u32x4 v = ((const u32x4*)k)[c];
        s0 += q[8 * c] * bflo(v.x); s1 += q[8 * c + 1] * bfhi(v.x); s0 += q[8 * c + 2] * bflo(v.y); s1 += q[8 * c + 3] * bfhi(v.y);
        s0 += q[8 * c + 4] * bflo(v.z); s1 += q[8 * c + 5] * bfhi(v.z); s0 += q[8 * c + 6] * bflo(v.w); s1 += q[8 * c + 7] * bfhi(v.w);
    }
    const float s = s0 + s1;
    return s + __shfl_xor(s, 1);
}
__device__ __forceinline__ void axpy32(float* a, float p, const bf16_t* vr) {
#pragma unroll
    for (int c = 0; c < 4; ++c) {
        const u32x4 v = ((const u32x4*)vr)[c];
        a[8 * c] += p * bflo(v.x); a[8 * c + 1] += p * bfhi(v.x); a[8 * c + 2] += p * bflo(v.y); a[8 * c + 3] += p * bfhi(v.y);
        a[8 * c + 4] += p * bflo(v.z); a[8 * c + 5] += p * bfhi(v.z); a[8 * c + 6] += p * bflo(v.w); a[8 * c + 7] += p * bfhi(v.w);
    }
}
#define ONLINE_STEP(s_, vrow_) do { const float _s = (s_); if (_s > mx) { const float _c = __expf(mx - _s); l *= _c; _Pragma("unroll") for (int _i = 0; _i < 32; ++_i) acc[_i] *= _c; mx = _s; } \
    const float _p = __expf(_s - mx); l += _p; axpy32(acc, _p, (vrow_)); } while (0)

__device__ __forceinline__ void store_o32(bf16_t* dst, const float* a, float sc) {
#pragma unroll
    for (int c = 0; c < 4; ++c) {
        u32x4 w; w.x = pk2(a[8 * c] * sc, a[8 * c + 1] * sc); w.y = pk2(a[8 * c + 2] * sc, a[8 * c + 3] * sc);
        w.z = pk2(a[8 * c + 4] * sc, a[8 * c + 5] * sc); w.w = pk2(a[8 * c + 6] * sc, a[8 * c + 7] * sc);
        ((u32x4*)dst)[c] = w;
    }
}

__device__ __forceinline__ void attn_dilated_naive(const unsigned char* ws, int gtid, int gthreads) {
    asm volatile("" : "+v"(gtid));
    const bf16_t* qa = (const bf16_t*)(ws + WS_QA); const bf16_t* ka = (const bf16_t*)(ws + WS_KA); const bf16_t* va = (const bf16_t*)(ws + WS_VA);
    bf16_t* ob = (bf16_t*)(ws + WS_O);
    for (int id2 = gtid; id2 < NB * 8 * NS * 2; id2 += gthreads) {
        const int idx = id2 >> 1, hf = (id2 & 1) * 32;
        const int t = idx & 2047, bh = idx >> 11, h = bh & 7, b = bh >> 3;
        float q[32]; load_q32(qa + (size_t)idx * 64 + hf, q);
        const bf16_t* kb = ka + (size_t)bh * NS * 64 + hf; const bf16_t* vb = va + (size_t)bh * NS * 64 + hf;
        const float slope = exp2f(-((float)h + 0.5f));
        float mx = -1e30f, l = 0.f; float acc[32];
#pragma unroll
        for (int i = 0; i < 32; ++i) acc[i] = 0.f;
#pragma unroll 1
        for (int pat = 0; pat < 3; ++pat) {
            const int dil = pat == 0 ? 1 : (pat == 1 ? 4 : 16);
#pragma unroll 1
            for (int j = 0; j <= 128; ++j) {
                const int dist = j * dil, pos = t - dist;
                if (pos < 0) break;
                const float s = dot32p(q, kb + (size_t)pos * 64) - slope * (float)dist;
                ONLINE_STEP(s, vb + (size_t)pos * 64);
            }
        }
        store_o32(ob + ((size_t)(b * NS + t) * ND + h * 64 + hf), acc, 1.0f / l);
    }
}

__device__ __forceinline__ void nsa_imp_naive(const unsigned char* ws, int gtid, int gthreads) {
    asm volatile("" : "+v"(gtid));
    const bf16_t* qb = (const bf16_t*)(ws + WS_QB); const bf16_t* kcmp = (const bf16_t*)(ws + WS_KCMP);
    float* imph = (float*)(ws + WS_IMPH);
    for (int id2 = gtid; id2 < NB * 8 * NS * 2; id2 += gthreads) {
        const int idx = id2 >> 1, hf = (id2 & 1) * 32;
        const int t = idx & 2047, bh = idx >> 11, hb = bh & 7, b = bh >> 3, g = hb >> 2;
        float q[32]; load_q32(qb + (size_t)idx * 64 + hf, q);
        const bf16_t* kc = kcmp + (size_t)(b * 2 + g) * 128 * 64 + hf;
        const float slope = exp2f(-(float)(hb + 1));
        const int ncv = t >= 31 ? ((t - 31) >> 4) + 1 : 0;
        float mx = -1e30f;
#pragma unroll 1
        for (int c = 0; c < ncv; ++c) { const float s = dot32p(q, kc + c * 64) - slope * (float)(t - (16 * c + 31)); mx = fmaxf(mx, s); }
        float den = 0.f;
#pragma unroll 1
        for (int c = 0; c < ncv; ++c) { const float s = dot32p(q, kc + c * 64) - slope * (float)(t - (16 * c + 31)); den += __expf(s - mx); }
        const float inv = ncv > 0 ? 1.0f / den : 0.f;
#pragma unroll 1
        for (int n = 0; n < 32; ++n) {
            float imp = 0.f;
#pragma unroll 1
            for (int j = -1; j <= 3; ++j) {
                const int c = 4 * n + j;
                if (c >= 0 && c < ncv) {
                    const float s = dot32p(q, kc + c * 64) - slope * (float)(t - (16 * c + 31));
                    const float pp = __expf(s - mx) * inv;
                    imp += (j == -1 || j == 3) ? 0.5f * pp : pp;
                }
            }
            if (hf == 0) imph[(size_t)idx * 32 + n] = imp;
        }
    }
}
__device__ __forceinline__ void nsa_select(const unsigned char* ws, unsigned* maskbuf) {
    const float* imph = (const float*)(ws + WS_IMPH);
    const int tid_ = TID(); const int lane = tid_ & 63, gw = BID() * 4 + (tid_ >> 6), ngw = gridDim.x * 4;
    for (int it = gw; it < NB * 2 * NS / 2; it += ngw) {
        const int item = it * 2 + (lane >> 5), t = item & 2047, bg = item >> 11, n = lane & 31;
        float imp = 0.f;
#pragma unroll
        for (int r = 0; r < 4; ++r) imp += imph[((size_t)(bg * 4 + r) * NS + t) * 32 + n];
        const int cur = t >> 6;
        const bool valid = n <= cur;
        const bool forced = (n == 0) || (cur - n < 2);
        const float score = valid ? imp + (forced ? 1e4f : 0.f) : -1e30f;
        int rank = 0;
        for (int m = 0; m < 32; ++m) {
            const float sm = __shfl(score, (lane & 32) | m);
            rank += (sm > score || (sm == score && m < n)) ? 1 : 0;
        }
        const bool sel = valid && rank < 16;
        const unsigned long long bal = __ballot(sel);
        if (n == 0) maskbuf[item] = (lane >> 5) ? (unsigned)(bal >> 32) : (unsigned)bal;
    }
}
__device__ __forceinline__ void nsa_attn_naive(const unsigned char* ws, int gtid, int gthreads) {
    asm volatile("" : "+v"(gtid));
    const bf16_t* qb = (const bf16_t*)(ws + WS_QB);
    const bf16_t* kcmp = (const bf16_t*)(ws + WS_KCMP); const bf16_t* vcmp = kcmp + (size_t)16 * 128 * 64;
    const bf16_t* ksb = (const bf16_t*)(ws + WS_KV6 + 2 * 4 * MiB); const bf16_t* vsb = (const bf16_t*)(ws + WS_KV6 + 3 * 4 * MiB);
    const bf16_t* kwb = (const bf16_t*)(ws + WS_KV6 + 4 * 4 * MiB); const bf16_t* vwb = (const bf16_t*)(ws + WS_KV6 + 5 * 4 * MiB);
    const float* gates = (const float*)(ws + WS_GATES);
    const unsigned* maskbuf = (const unsigned*)(ws + WS_MASK);
    bf16_t* ob = (bf16_t*)(ws + WS_O);
    for (int id2 = gtid; id2 < NB * 8 * NS * 2; id2 += gthreads) {
        const int idx = id2 >> 1, hf = (id2 & 1) * 32;
        const int t = idx & 2047, bh = idx >> 11, hb = bh & 7, b = bh >> 3, g = hb >> 2, bg = b * 2 + g;
        float q[32]; load_q32(qb + (size_t)idx * 64 + hf, q);
        const float slope = exp2f(-(float)(hb + 1));
        const float* gt = gates + (size_t)(b * NS + t) * 24 + hb * 3;
        float tot[32], acc[32];
#pragma unroll
        for (int i = 0; i < 32; ++i) tot[i] = 0.f;
        {
            const bf16_t* kc = kcmp + (size_t)bg * 128 * 64 + hf; const bf16_t* vc = vcmp + (size_t)bg * 128 * 64 + hf;
            const int ncv = t >= 31 ? ((t - 31) >> 4) + 1 : 0;
            if (ncv > 0) {
                float mx = -1e30f, l = 0.f;
#pragma unroll
                for (int i = 0; i < 32; ++i) acc[i] = 0.f;
#pragma unroll 1
                for (int c = 0; c < ncv; ++c) { const float s = dot32p(q, kc + c * 64) - slope * (float)(t - (16 * c + 31)); ONLINE_STEP(s, vc + c * 64); }
                const float sc = gt[0] / l;
#pragma unroll
                for (int i = 0; i < 32; ++i) tot[i] += sc * acc[i];
            }
        }
        {
            const bf16_t* kb = ksb + (size_t)bg * NS * 64 + hf; const bf16_t* vb = vsb + (size_t)bg * NS * 64 + hf;
            const unsigned mask = maskbuf[bg * NS + t];
            float mx = -1e30f, l = 0.f;
#pragma unroll
            for (int i = 0; i < 32; ++i) acc[i] = 0.f;
#pragma unroll 1
            for (int n = 0; n < 32; ++n) {
                if (!((mask >> n) & 1u)) continue;
#pragma unroll 1
                for (int i = 0; i < 64; ++i) {
                    const int pos = n * 64 + i;
                    if (pos > t) break;
                    const float s = dot32p(q, kb + (size_t)pos * 64) - slope * (float)(t - pos);
                    ONLINE_STEP(s, vb + (size_t)pos * 64);
                }
            }
            const float sc = gt[1] / l;
#pragma unroll
            for (int i = 0; i < 32; ++i) tot[i] += sc * acc[i];
        }
        {
            const bf16_t* kb = kwb + (size_t)bg * NS * 64 + hf; const bf16_t* vb = vwb + (size_t)bg * NS * 64 + hf;
            float mx = -1e30f, l = 0.f;
#pragma unroll
            for (int i = 0; i < 32; ++i) acc[i] = 0.f;
#pragma unroll 1
            for (int dist = 0; dist < 512; ++dist) {
                const int pos = t - dist;
                if (pos < 0) break;
                const float s = dot32p(q, kb + (size_t)pos * 64) - slope * (float)dist;
                ONLINE_STEP(s, vb + (size_t)pos * 64);
            }
            const float sc = gt[2] / l;
#pragma unroll
            for (int i = 0; i < 32; ++i) tot[i] += sc * acc[i];
        }
        store_o32(ob + ((size_t)(b * NS + t) * ND + 512 + hb * 64 + hf), tot, 1.0f);
    }
}

constexpr int KVS = 144;
constexpr int KVT = 64 * KVS;
#define LOG2E_F 1.4426950408889634f
__device__ __forceinline__ unsigned cvtpk(float lo, float hi) { f32x2_t v = {lo, hi}; bf16x2_t b = __builtin_convertvector(v, bf16x2_t); return __builtin_bit_cast(unsigned, b); }
__device__ __forceinline__ s16x4 vtr(LAS const unsigned char* p) { return __builtin_bit_cast(s16x4, __builtin_amdgcn_ds_read_tr16_b64_v4i16((LAS s16x4*)p)); }
__device__ __forceinline__ f32x16 zero16() { f32x16 z;
#pragma unroll
    for (int i = 0; i < 16; ++i) z[i] = 0.f;
    return z; }

__device__ __forceinline__ void load_kv_tile(LAS unsigned char* Kt, LAS unsigned char* Vt, const bf16_t* kbase, const bf16_t* vbase, int row0, int rstride, int rmin, int rmax, int tid) {
    const int j = tid >> 2, ch = tid & 3;
    int tok = row0 + j * rstride; tok = tok < rmin ? rmin : (tok > rmax ? rmax : tok);
    const u32x4* kp = (const u32x4*)(kbase + (size_t)tok * 64);
    const u32x4* vp = (const u32x4*)(vbase + (size_t)tok * 64);
    const u32x4 k0 = kp[ch], k1 = kp[ch + 4], v0 = vp[ch], v1 = vp[ch + 4];
    *(LAS u32x4*)(Kt + j * KVS + ch * 16) = k0; *(LAS u32x4*)(Kt + j * KVS + (ch + 4) * 16) = k1;
    *(LAS u32x4*)(Vt + j * KVS + ch * 16) = v0; *(LAS u32x4*)(Vt + j * KVS + (ch + 4) * 16) = v1;
}

struct KVRegs { u32x4 k0, k1, v0, v1; };
__device__ __forceinline__ void kv_fetch(KVRegs& r, const bf16_t* kbase, const bf16_t* vbase, int row0, int rstride, int rmin, int rmax, int tid) {
    const int j = tid >> 2, ch = tid & 3;
    int tok = row0 + j * rstride; tok = tok < rmin ? rmin : (tok > rmax ? rmax : tok);
    const u32x4* kp = (const u32x4*)(kbase + (size_t)tok * 64);
    const u32x4* vp = (const u32x4*)(vbase + (size_t)tok * 64);
    r.k0 = kp[ch]; r.k1 = kp[ch + 4]; r.v0 = vp[ch]; r.v1 = vp[ch + 4];
}
__device__ __forceinline__ void kv_commit(const KVRegs& r, LAS unsigned char* Kt, LAS unsigned char* Vt, int tid) {
    const int j = tid >> 2, ch = tid & 3;
    *(LAS u32x4*)(Kt + j * KVS + ch * 16) = r.k0; *(LAS u32x4*)(Kt + j * KVS + (ch + 4) * 16) = r.k1;
    *(LAS u32x4*)(Vt + j * KVS + ch * 16) = r.v0; *(LAS u32x4*)(Vt + j * KVS + (ch + 4) * 16) = r.v1;
}
__device__ __forceinline__ void pv32(f32x16& o0, f32x16& o1, const f32x16& sv, LAS const unsigned char* vp  ) {
#pragma unroll
    for (int s16 = 0; s16 < 2; ++s16) {
        u32x4 pw;
        pw.x = cvtpk(sv[8 * s16 + 0], sv[8 * s16 + 1]); pw.y = cvtpk(sv[8 * s16 + 2], sv[8 * s16 + 3]);
        pw.z = cvtpk(sv[8 * s16 + 4], sv[8 * s16 + 5]); pw.w = cvtpk(sv[8 * s16 + 6], sv[8 * s16 + 7]);
        const bf16x8 pf = __builtin_bit_cast(bf16x8, pw);
        LAS const unsigned char* vr = vp + s16 * 16 * KVS;
        const s16x4 a0 = vtr(vr), b0 = vtr(vr + 8 * KVS), a1 = vtr(vr + 64), b1 = vtr(vr + 8 * KVS + 64);
        const bf16x8 vf0 = {a0[0], a0[1], a0[2], a0[3], b0[0], b0[1], b0[2], b0[3]};
        const bf16x8 vf1 = {a1[0], a1[1], a1[2], a1[3], b1[0], b1[1], b1[2], b1[3]};
        o0 = __builtin_amdgcn_mfma_f32_32x32x16_bf16(vf0, pf, o0, 0, 0, 0);
        o1 = __builtin_amdgcn_mfma_f32_32x32x16_bf16(vf1, pf, o1, 0, 0, 0);
    }
}
__device__ __forceinline__ f32x16 qk32(const bf16x8* qf, LAS const unsigned char* kp  , f32x16 s  ) {
#pragma unroll
    for (int k = 0; k < 4; ++k) {
        const bf16x8 kf = *(const LAS bf16x8*)(kp + 32 * k);
        s = __builtin_amdgcn_mfma_f32_32x32x16_bf16(kf, qf[k], s, 0, 0, 0);
    }
    return s;
}
template <int KS, bool TRY_FULL>
__device__ __forceinline__ void fa_tile64(f32x16& o0, f32x16& o1, float& m, float& l, const bf16x8* qf, LAS const unsigned char* Kt, LAS const unsigned char* Vt, int lane, float dA, float wmax, float ns2) {
    const int r = lane & 31, h = lane >> 5;
    LAS const unsigned char* kp = Kt + r * KVS + 16 * h;
    const float dAh = dA - (float)(KS * 4 * h);
    const float hi = dAh, lo = dAh - wmax, base = ns2 * dAh;
    f32x16 s0, s1;
#pragma unroll
    for (int i = 0; i < 16; ++i) {
        const float c0 = (float)(KS * ((i & 3) + 8 * (i >> 2))), c1 = c0 + (float)(32 * KS);
        s0[i] = fmaf(-c0, ns2, base); s1[i] = fmaf(-c1, ns2, base);
    }
    s0 = qk32(qf, kp, s0); s1 = qk32(qf, kp + 32 * KVS, s1);
    float tmax = -1e30f;
    if (TRY_FULL && __all(lo <= 0.f && hi >= (float)(59 * KS))) {
#pragma unroll
        for (int i = 0; i < 16; ++i) tmax = fmaxf(tmax, fmaxf(s0[i], s1[i]));
    } else {
#pragma unroll
        for (int i = 0; i < 16; ++i) {
            const float c0 = (float)(KS * ((i & 3) + 8 * (i >> 2))), c1 = c0 + (float)(32 * KS);
            const float t0 = (c0 >= lo && c0 <= hi) ? s0[i] : -1e30f;
            const float t1 = (c1 >= lo && c1 <= hi) ? s1[i] : -1e30f;
            s0[i] = t0; s1[i] = t1;
            tmax = fmaxf(tmax, fmaxf(t0, t1));
        }
    }
    tmax = fmaxf(tmax, __shfl_xor(tmax, 32));
    const float mn = fmaxf(m, tmax);
    const float corr = __builtin_amdgcn_exp2f(m - mn);
    m = mn;
    const float mu = fmaxf(mn, -1e29f);
    float ps = 0.f;
#pragma unroll
    for (int i = 0; i < 16; ++i) {
        s0[i] = __builtin_amdgcn_exp2f(s0[i] - mu); s1[i] = __builtin_amdgcn_exp2f(s1[i] - mu);
        ps += s0[i] + s1[i];
    }
    l = l * corr + ps;
    if (!__all(corr == 1.0f)) {
#pragma unroll
        for (int i = 0; i < 16; ++i) { o0[i] *= corr; o1[i] *= corr; }
    }
    LAS const unsigned char* vp = Vt + (4 * h + ((lane & 15) >> 2)) * KVS + (16 * ((lane >> 4) & 1) + 4 * (lane & 3)) * 2;
    pv32(o0, o1, s0, vp);
    pv32(o0, o1, s1, vp + 32 * KVS);
}
__device__ __forceinline__ void acc_scaled(f32x16& t0, f32x16& t1, const f32x16& o0, const f32x16& o1, float sc) {
#pragma unroll
    for (int i = 0; i < 16; ++i) { t0[i] += sc * o0[i]; t1[i] += sc * o1[i]; }
}
__device__ __forceinline__ void store_ot(bf16_t* orow, const f32x16& o0, const f32x16& o1, float sc, int h) {
#pragma unroll
    for (int u = 0; u < 4; ++u) {
        u32x2 w0, w1;
        w0.x = cvtpk(o0[4 * u] * sc, o0[4 * u + 1] * sc); w0.y = cvtpk(o0[4 * u + 2] * sc, o0[4 * u + 3] * sc);
        w1.x = cvtpk(o1[4 * u] * sc, o1[4 * u + 1] * sc); w1.y = cvtpk(o1[4 * u + 2] * sc, o1[4 * u + 3] * sc);
        *(u32x2*)(orow + 8 * u + 4 * h) = w0;
        *(u32x2*)(orow + 32 + 8 * u + 4 * h) = w1;
    }
}
__device__ __forceinline__ void load_qf(bf16x8* qf, const bf16_t* qrow, int h) {
#pragma unroll
    for (int k = 0; k < 4; ++k) qf[k] = *(const bf16x8*)(qrow + 16 * k + 8 * h);
}

__device__ __forceinline__ void dil_item(unsigned char* ws, int item, LAS unsigned char* lds) {
    const int tid = TID(), lane = tid & 63, w = tid >> 6, c = lane & 31, h = lane >> 5;
    const int bh = item / 48, rem = item % 48, pat = rem >> 4, idx = rem & 15;
    const int dil = pat == 0 ? 1 : (pat == 1 ? 4 : 16), nqt = 16 / dil, res = idx / nqt, qt = idx % nqt;
    const int hd = bh & 7, b = bh >> 3;
    const int q0 = qt * 128 + 32 * w, iq = q0 + c, t = res + iq * dil;
    const bf16_t* qa = (const bf16_t*)(ws + WS_QA) + (size_t)bh * NS * 64;
    const bf16_t* ka = (const bf16_t*)(ws + WS_KA) + (size_t)bh * NS * 64;
    const bf16_t* va = (const bf16_t*)(ws + WS_VA) + (size_t)bh * NS * 64;
    bf16x8 qf[4]; load_qf(qf, qa + (size_t)t * 64, h);
    const float ns2 = -exp2f(-((float)hd + 0.5f)) * (float)dil * LOG2E_F;
    f32x16 o0 = zero16(), o1 = zero16(); float m = -1e30f, l = 0.f;
    {
        const int T0 = qt == 0 ? 2 : 0;
        KVRegs kr; kv_fetch(kr, ka, va, res + (qt * 128 - 128 + 64 * T0) * dil, dil, 0, NS - 1, tid);
        int buf = 0;
        for (int T = T0; T < 4; ++T) {
            const int kb = qt * 128 - 128 + 64 * T;
            LAS unsigned char* Kt = lds + buf * KVT; LAS unsigned char* Vt = lds + 2 * KVT + buf * KVT;
            kv_commit(kr, Kt, Vt, tid);
            __syncthreads();
            if (T + 1 < 4) kv_fetch(kr, ka, va, res + (kb + 64) * dil, dil, 0, NS - 1, tid);
            if (kb <= q0 + 31 && kb + 63 >= q0 - 128)
                fa_tile64<1, true>(o0, o1, m, l, qf, Kt, Vt, lane, (float)(iq - kb), 128.f, ns2);
            buf ^= 1;
        }
    }
    const float lt = l + __shfl_xor(l, 32);
    bf16_t* op = (bf16_t*)(pat < 2 ? ws + WS_OPA01 + (size_t)pat * 16 * MiB : ws + WS_OPA2);
    store_ot(op + ((size_t)(b * NS + t) * 512 + hd * 64), o0, o1, 1.0f / lt, h);
    if (h == 0) { float* st = (float*)(ws + WS_STA) + ((size_t)pat * NB * 8 * NS + (size_t)bh * NS + t) * 2; st[0] = m; st[1] = lt; }
}
__device__ __forceinline__ void dil_merge(unsigned char* ws, int gtid, int gthreads) {
    asm volatile("" : "+v"(gtid));
    const float* sta = (const float*)(ws + WS_STA);
    bf16_t* ob = (bf16_t*)(ws + WS_O);
    for (int it = gtid; it < NT * 8 * 8; it += gthreads) {
        const int ch = it & 7, hd = (it >> 3) & 7, tk = it >> 6, b = tk >> 11, t = tk & 2047;
        float mm[3], ll[3];
#pragma unroll
        for (int p = 0; p < 3; ++p) { const float* s = sta + ((size_t)p * NB * 8 * NS + (size_t)(b * 8 + hd) * NS + t) * 2; mm[p] = s[0]; ll[p] = s[1]; }
        const float M = fmaxf(mm[0], fmaxf(mm[1], mm[2]));
        float wgt[3], den = 0.f;
#pragma unroll
        for (int p = 0; p < 3; ++p) { wgt[p] = __builtin_amdgcn_exp2f(mm[p] - M) * ll[p]; den += wgt[p]; }
        const float inv = 1.0f / den;
        float a[8];
#pragma unroll
        for (int i = 0; i < 8; ++i) a[i] = 0.f;
#pragma unroll
        for (int p = 0; p < 3; ++p) {
            const bf16_t* op = (const bf16_t*)(p < 2 ? ws + WS_OPA01 + (size_t)p * 16 * MiB : ws + WS_OPA2);
            const u32x4 v = *(const u32x4*)(op + (size_t)tk * 512 + hd * 64 + ch * 8);
            const float wp = wgt[p] * inv;
            a[0] += wp * bflo(v.x); a[1] += wp * bfhi(v.x); a[2] += wp * bflo(v.y); a[3] += wp * bfhi(v.y);
            a[4] += wp * bflo(v.z); a[5] += wp * bfhi(v.z); a[6] += wp * bflo(v.w); a[7] += wp * bfhi(v.w);
        }
        u32x4 o; o.x = pk2(a[0], a[1]); o.y = pk2(a[2], a[3]); o.z = pk2(a[4], a[5]); o.w = pk2(a[6], a[7]);
        *(u32x4*)(ob + (size_t)tk * ND + hd * 64 + ch * 8) = o;
    }
}

constexpr int LDS_IMP = 4 * KVT;
constexpr int LDS_UNI = LDS_IMP + 4096;
__device__ __forceinline__ void nsa_item(unsigned char* ws, int item, LAS unsigned char* lds) {
    const int tid = TID(), lane = tid & 63, w = tid >> 6, c = lane & 31, h = lane >> 5;
    const int bg = item & 15, tt = item >> 4, b = bg >> 1, g = bg & 1;
    const int t0 = tt * 32, tok8 = c & 7, hh = c >> 3, hb = g * 4 + hh, t = t0 + 8 * w + tok8;
    const bf16_t* qrow = (const bf16_t*)(ws + WS_QB) + ((size_t)(b * 8 + hb) * NS + t) * 64;
    bf16x8 qf[4]; load_qf(qf, qrow, h);
    const float ns2 = -exp2f(-(float)(hb + 1)) * LOG2E_F;
    const float* gt = (const float*)(ws + WS_GATES) + (size_t)(b * NS + t) * 24 + hb * 3;
    const float g0 = gt[0], g1 = gt[1], g2 = gt[2];
    f32x16 tot0 = zero16(), tot1 = zero16();
    LAS unsigned char* Kt = lds; LAS unsigned char* Vt = lds + 2 * KVT;
    LAS float* impL = (LAS float*)(lds + LDS_IMP) + w * 256;
    LAS unsigned* uni = (LAS unsigned*)(lds + LDS_UNI);
    const int cur = t0 >> 6;
    unsigned selmask;
    {
        const bf16_t* kc = (const bf16_t*)(ws + WS_KCMP) + (size_t)bg * 128 * 64;
        const bf16_t* vc = kc + (size_t)16 * 128 * 64;
        __syncthreads();
        load_kv_tile(Kt, Vt, kc, vc, 0, 1, 0, 127, tid);
        load_kv_tile(Kt + KVT, Vt + KVT, kc, vc, 64, 1, 0, 127, tid);
        if (tid == 0) uni[0] = 0u;
        __syncthreads();
        LAS const unsigned char* kp = Kt + c * KVS + 16 * h;
        f32x16 sT[4];
#pragma unroll
        for (int T = 0; T < 4; ++T) sT[T] = qk32(qf, kp + T * 32 * KVS, zero16());
        const float dAh = (float)(t - 31) - (float)(64 * h);
        float tmax = -1e30f;
#pragma unroll
        for (int T = 0; T < 4; ++T)
#pragma unroll
            for (int i = 0; i < 16; ++i) {
                const float d = dAh - (float)(16 * (32 * T + (i & 3) + 8 * (i >> 2)));
                float tv = sT[T][i] + ns2 * d;
                tv = d >= 0.f ? tv : -1e30f;
                sT[T][i] = tv; tmax = fmaxf(tmax, tv);
            }
        tmax = fmaxf(tmax, __shfl_xor(tmax, 32));
        const float mu = fmaxf(tmax, -1e29f);
        float ps = 0.f;
#pragma unroll
        for (int T = 0; T < 4; ++T)
#pragma unroll
            for (int i = 0; i < 16; ++i) { sT[T][i] = __builtin_amdgcn_exp2f(sT[T][i] - mu); ps += sT[T][i]; }
        ps += __shfl_xor(ps, 32);
        const float inv = ps > 0.f ? 1.0f / ps : 0.f;
#pragma unroll
        for (int T = 0; T < 4; ++T)
#pragma unroll
            for (int i = 0; i < 16; ++i) sT[T][i] *= inv;
        f32x16 o0 = zero16(), o1 = zero16();
        LAS const unsigned char* vp = Vt + (4 * h + ((lane & 15) >> 2)) * KVS + (16 * ((lane >> 4) & 1) + 4 * (lane & 3)) * 2;
#pragma unroll
        for (int T = 0; T < 4; ++T) pv32(o0, o1, sT[T], vp + T * 32 * KVS);
        acc_scaled(tot0, tot1, o0, o1, g0);
        float mainv[16], spill[16];
#pragma unroll
        for (int T = 0; T < 4; ++T)
#pragma unroll
            for (int u = 0; u < 4; ++u) {
                const float p3 = 0.5f * sT[T][4 * u + 3];
                mainv[4 * T + u] = sT[T][4 * u] + sT[T][4 * u + 1] + sT[T][4 * u + 2] + p3;
                spill[4 * T + u] = p3;
            }
#pragma unroll
        for (int f = 0; f < 16; ++f) {
            mainv[f] += __shfl_xor(mainv[f], 8); mainv[f] += __shfl_xor(mainv[f], 16);
            spill[f] += __shfl_xor(spill[f], 8); spill[f] += __shfl_xor(spill[f], 16);
        }
#pragma unroll
        for (int f = 0; f < 16; ++f) {
            const float snd = h ? (f > 0 ? spill[f > 0 ? f - 1 : 0] : 0.f) : spill[f];
            const float rcv = __shfl_xor(snd, 32);
            mainv[f] += rcv;
        }
        if (hh == 0) {
#pragma unroll
            for (int f = 0; f < 16; ++f) impL[tok8 * 32 + 2 * f + h] = mainv[f];
        }
        asm volatile("s_waitcnt lgkmcnt(0)" ::: "memory");
        {
            const int tk = lane >> 3, tq = t0 + 8 * w + tk, cq = tq >> 6, n0 = 4 * (lane & 7);
            float sc[32];
#pragma unroll
            for (int q4 = 0; q4 < 8; ++q4) {
                const f32x4 v = *(const LAS f32x4*)(impL + tk * 32 + 4 * q4);
                sc[4 * q4] = v.x; sc[4 * q4 + 1] = v.y; sc[4 * q4 + 2] = v.z; sc[4 * q4 + 3] = v.w;
            }
#pragma unroll
            for (int n = 0; n < 32; ++n) {
                const bool valid = n <= cq, forced = (n == 0) || (cq - n < 2);
                sc[n] = valid ? sc[n] + (forced ? 1e4f : 0.f) : -1e30f;
            }
            unsigned bits = 0u;
#pragma unroll
            for (int k = 0; k < 4; ++k) {
                const int n = n0 + k;
                float mine = 0.f;
#pragma unroll
                for (int q = 0; q < 32; ++q) mine = (q == n) ? sc[q] : mine;
                int rank = 0;
#pragma unroll
                for (int q = 0; q < 32; ++q) rank += (sc[q] > mine || (sc[q] == mine && q < n)) ? 1 : 0;
                if (n <= cq && rank < 16) bits |= 1u << n;
            }
            bits |= __shfl_xor(bits, 1); bits |= __shfl_xor(bits, 2); bits |= __shfl_xor(bits, 4);
            selmask = __shfl(bits, tok8 * 8);
        }
        {
            unsigned um = selmask;
#pragma unroll
            for (int o = 1; o < 64; o <<= 1) um |= __shfl_xor(um, o);
            if (lane == 0) atomicOr((unsigned*)uni, um);
        }
        __syncthreads();
    }
    const unsigned ublk = uni[0];
    unsigned wsel = selmask;
#pragma unroll
    for (int o = 1; o < 64; o <<= 1) wsel |= __shfl_xor(wsel, o);
    int buf = 0;
    {
        const bf16_t* kb = (const bf16_t*)(ws + WS_KV6 + 2 * 4 * MiB) + (size_t)bg * NS * 64;
        const bf16_t* vb = (const bf16_t*)(ws + WS_KV6 + 3 * 4 * MiB) + (size_t)bg * NS * 64;
        f32x16 o0 = zero16(), o1 = zero16(); float m = -1e30f, l = 0.f;
        unsigned rem = ublk & (cur >= 31 ? 0xffffffffu : ((2u << cur) - 1u));
        while (rem) {
            const int n = __builtin_ctz(rem);
            rem &= rem - 1u;
            LAS unsigned char* Kc = lds + buf * KVT; LAS unsigned char* Vc = lds + 2 * KVT + buf * KVT;
            load_kv_tile(Kc, Vc, kb, vb, 64 * n, 1, 0, NS - 1, tid);
            __syncthreads();
            if ((wsel >> n) & 1u)
                fa_tile64<1, true>(o0, o1, m, l, qf, Kc, Vc, lane, (float)(t - 64 * n), ((selmask >> n) & 1u) ? 1e30f : -1.f, ns2);
            buf ^= 1;
        }
        const float lt = l + __shfl_xor(l, 32);
        acc_scaled(tot0, tot1, o0, o1, g1 / lt);
    }
    {
        const bf16_t* kb = (const bf16_t*)(ws + WS_KV6 + 4 * 4 * MiB) + (size_t)bg * NS * 64;
        const bf16_t* vb = (const bf16_t*)(ws + WS_KV6 + 5 * 4 * MiB) + (size_t)bg * NS * 64;
        f32x16 o0 = zero16(), o1 = zero16(); float m = -1e30f, l = 0.f;
        const int nlo = t0 >= 511 ? (t0 - 511) >> 6 : 0;
        for (int n = nlo; n <= cur; ++n) {
            LAS unsigned char* Kc = lds + buf * KVT; LAS unsigned char* Vc = lds + 2 * KVT + buf * KVT;
            load_kv_tile(Kc, Vc, kb, vb, 64 * n, 1, 0, NS - 1, tid);
            __syncthreads();
            fa_tile64<1, true>(o0, o1, m, l, qf, Kc, Vc, lane, (float)(t - 64 * n), 511.f, ns2);
            buf ^= 1;
        }
        const float lt = l + __shfl_xor(l, 32);
        acc_scaled(tot0, tot1, o0, o1, g2 / lt);
    }
    store_ot((bf16_t*)(ws + WS_O) + ((size_t)(b * NS + t) * ND + 512 + hb * 64), tot0, tot1, 1.0f, h);
}

#define XB_TMO      128
#define XB_XCNT(j)  (256  + 64 * (j))
#define XB_XSUB(j)  (1280 + 64 * (j))
#define XB_XGEN(j)  (2304 + 64 * (j))
#define XB_TOP      3328
#define XB_TOPGEN   3392
#define XCD_BAR_WORDS 3456
#define XB_SPIN_CAP (1u << 18)
__device__ __forceinline__ unsigned xb_ld(unsigned* p)              { return __hip_atomic_load(p, __ATOMIC_RELAXED, __HIP_MEMORY_SCOPE_AGENT); }
__device__ __forceinline__ unsigned xb_add(unsigned* p, unsigned v) { return __hip_atomic_fetch_add(p, v, __ATOMIC_RELAXED, __HIP_MEMORY_SCOPE_AGENT); }
__device__ __forceinline__ unsigned xb_xcc_id() { return (unsigned)__builtin_amdgcn_s_getreg((3 << 11) | 20) & 0xFu; }
#define XB_SPIN(cond, bar) do { unsigned _sp = 0; while (cond) { __builtin_amdgcn_s_sleep(1); \
    if ((++_sp & 255u) == 0u) { if (xb_ld(&(bar)[XB_TMO])) break; if (_sp > XB_SPIN_CAP) { atomicAdd(&(bar)[XB_TMO], 1u); break; } } } } while (0)
struct XcdBarrier { unsigned* bar; unsigned x; volatile LAS unsigned* st; };
__device__ __forceinline__ XcdBarrier xcd_barrier_post(unsigned* bar, volatile LAS unsigned* st) {
    XcdBarrier b; b.bar = bar; b.x = xb_xcc_id(); b.st = st;
    if (threadIdx.x == 0) (void)xb_add(&bar[XB_XCNT(b.x)], 1u);
    return b;
}
__device__ __forceinline__ void xcd_barrier_complete(unsigned* bar, unsigned x, unsigned& nloc, unsigned& nx) {
    const unsigned G = gridDim.x * gridDim.y * gridDim.z;
    unsigned sum, cnt, mine, sp = 0u;
    for (;;) {
        sum = 0u; cnt = 0u; mine = 0u;
#pragma unroll
        for (unsigned j = 0; j < 16; ++j) { const unsigned c = xb_ld(&bar[XB_XCNT(j)]); sum += c; cnt += (c > 0u) ? 1u : 0u; mine = (j == x) ? c : mine; }
        if (sum == G) break;
        __builtin_amdgcn_s_sleep(1);
        if ((++sp & 255u) == 0u) { if (xb_ld(&bar[XB_TMO])) break; if (sp > XB_SPIN_CAP) { atomicAdd(&bar[XB_TMO], 1u); break; } }
    }
    nloc = mine > 0u ? mine : 1u; nx = cnt > 0u ? cnt : 1u;
}
__device__ __forceinline__ void xcd_barrier(const XcdBarrier& b) {
    asm volatile("s_waitcnt vmcnt(0)" ::: "memory");
    __syncthreads();
    if (threadIdx.x == 0) {
        unsigned* bar = b.bar;
        __builtin_amdgcn_s_waitcnt(0);
        unsigned nloc = b.st[0], nx = b.st[1];
        if (nloc == 0u) { xcd_barrier_complete(bar, b.x, nloc, nx); b.st[0] = nloc; b.st[1] = nx; }
        const unsigned old = xb_add(&bar[XB_XSUB(b.x)], 1u);
        const unsigned gen = old / nloc;
        if (old + 1u == (gen + 1u) * nloc) {
            __builtin_amdgcn_fence(__ATOMIC_RELEASE, "agent");
            asm volatile("s_waitcnt vmcnt(0)" ::: "memory");
            const unsigned og = xb_add(&bar[XB_TOP], 1u);
            const unsigned tg = og / nx;
            if (og + 1u == (tg + 1u) * nx) xb_add(&bar[XB_TOPGEN], 1u);
            else XB_SPIN(xb_ld(&bar[XB_TOPGEN]) == tg, bar);
            __builtin_amdgcn_fence(__ATOMIC_ACQUIRE, "agent");
            xb_add(&bar[XB_XGEN(b.x)], 1u);
            asm volatile("s_waitcnt vmcnt(0)" ::: "memory");
        } else {
            XB_SPIN(xb_ld(&bar[XB_XGEN(b.x)]) == gen, bar);
            __builtin_amdgcn_fence(__ATOMIC_ACQUIRE, "agent");
            asm volatile("s_waitcnt vmcnt(0)" ::: "memory");
        }
    }
    __syncthreads();
}

struct XcdTiles {
    int m_lo, cnt_m, nN, loc, nloc, tiles;
    __device__ __forceinline__ XcdTiles(int nM, int nN_) {
        const int b = BID(), g = gridDim.x;
        int x, nx;
        if ((g & 7) == 0) { x = b & 7; nx = 8; loc = b >> 3; nloc = g >> 3; } else { x = 0; nx = 1; loc = b; nloc = g; }
        m_lo = (int)((long)nM * x / nx); cnt_m = (int)((long)nM * (x + 1) / nx) - m_lo; nN = nN_; tiles = cnt_m * nN;
    }
    __device__ __forceinline__ void get(int q, int& mt, int& nt) const {
        const int mg = q / (8 * nN), rem_m = cnt_m - 8 * mg, mig = rem_m < 8 ? rem_m : 8, r = q - mg * 8 * nN;
        nt = r / mig; mt = m_lo + 8 * mg + (r - nt * mig);
    }
};
struct PhInProj { const bf16_t* xn; const unsigned char* wl; unsigned char* ws; const float* ssp; XcdTiles xt;
    __device__ __forceinline__ void make(int q, APlain& ap, BPlain& bp, EpiInProj& ep) const { int mt, nt; xt.get(q, mt, nt);
        ap = APlain{xn + (size_t)mt * 128 * ND, ND}; bp = BPlain{(const bf16_t*)(wl + WL_IN) + (size_t)nt * 128 * ND, ND}; ep = EpiInProj{mt, nt, ws, ssp}; } };
struct PhCmp1 { const unsigned char* wl; unsigned char* ws; int l;
    __device__ __forceinline__ void make(int tile, ACmp& ap, BPlain& bp, EpiCmp1& ep) const { const int nt = tile & 1, bg = (tile >> 1) & 15, kv = tile >> 5;
        ap = ACmp{(const bf16_t*)(ws + WS_KV6 + (size_t)kv * 4 * MiB) + (size_t)bg * NS * 64};
        bp = BPlain{(const bf16_t*)(wl + WL_C1) + (size_t)kv * 256 * 2048 + (size_t)nt * 128 * 2048, 2048};
        ep = EpiCmp1{(bf16_t*)(ws + WS_HC) + (size_t)kv * 2048 * 256, (const float*)(ws + WS_BC1P) + l * 512 + kv * 256, bg * 128, nt * 128}; } };
struct PhCmp2 { const unsigned char* wl; unsigned char* ws;
    __device__ __forceinline__ void make(int tile, APlain& ap, BPlain& bp, EpiCmp2& ep) const { const int bg = tile & 15, kv = tile >> 4;
        ap = APlain{(const bf16_t*)(ws + WS_HC) + (size_t)kv * 2048 * 256 + (size_t)bg * 128 * 256, 256};
        bp = BPlain{(const bf16_t*)(wl + WL_C2) + (size_t)kv * 128 * 256, 256};
        ep = EpiCmp2{(bf16_t*)(ws + WS_KCMP) + (size_t)kv * 16 * 128 * 64, bg * 128}; } };
struct PhOutProj { const unsigned char* wl; unsigned char* ws; const float* base; float* out; bf16_t* xb; float sc; XcdTiles xt;
    __device__ __forceinline__ void make(int q, APlain& ap, BPlain& bp, EpiResAdd& ep) const { int mt, nt; xt.get(q, mt, nt);
        ap = APlain{(const bf16_t*)(ws + WS_O) + (size_t)mt * 128 * ND, ND}; bp = BPlain{(const bf16_t*)(wl + WL_OUT) + (size_t)nt * 128 * ND, ND};
        ep = EpiResAdd{base, out, xb, mt * 128, nt * 128, sc}; } };
struct PhMoe {
    LAS const int* sm; const int* list;
    __device__ __forceinline__ void decode(int gmt, int& bk, int& mt, int& rem, int& hrow0, int& elo, int& ehi) const {
        bk = 0;
        for (int k = 1; k < 24; ++k) if (gmt >= sm[32 + k]) bk = k;
        mt = gmt - sm[32 + bk]; rem = sm[bk] - mt * 128; hrow0 = sm[64 + bk] + mt * 128;
        const int grp = bk / 6, pi = bk % 6;
        elo = grp * 4 + (pi < 3 ? 0 : (pi < 5 ? 1 : 2)); ehi = grp * 4 + (pi < 3 ? pi + 1 : (pi < 5 ? pi - 1 : 3));
    } };
struct PhMoeGU { PhMoe m; const bf16_t* xn; const unsigned char* wl; unsigned char* ws; const float* route; const float* rinv; XcdTiles xt;
    __device__ __forceinline__ void make(int q, AGather& ap, BPlain& bp, EpiMoeGU& ep) const { int gmt, nt16; xt.get(q, gmt, nt16);
        int bk, mt, rem, hrow0, elo, ehi; m.decode(gmt, bk, mt, rem, hrow0, elo, ehi);
        const int* lst = m.list + (size_t)bk * NT + mt * 128; const int e = (nt16 >> 3) ? ehi : elo;
        ap = AGather{xn, lst, rem}; bp = BPlain{(const bf16_t*)(wl + WL_GU) + (size_t)e * 1024 * 1024 + (size_t)(nt16 & 7) * 128 * 1024, 1024};
        ep = EpiMoeGU{(bf16_t*)(ws + WS_HID), lst, route, rinv, rem, hrow0, nt16}; } };
struct PhMoeDown { PhMoe m; const unsigned char* wl; unsigned char* ws; float* out; bf16_t* xb; float* ssp; XcdTiles xt;
    __device__ __forceinline__ void make(int q, APlain& ap, BSplit& bp, EpiMoeDown& ep) const { int gmt, nt; xt.get(q, gmt, nt);
        int bk, mt, rem, hrow0, elo, ehi; m.decode(gmt, bk, mt, rem, hrow0, elo, ehi);
        const int* lst = m.list + (size_t)bk * NT + mt * 128;
        ap = APlain{(const bf16_t*)(ws + WS_HID) + (size_t)hrow0 * 1024, 1024};
        bp = BSplit{(const bf16_t*)(wl + WL_DN) + (size_t)elo * 1024 * 512 + (size_t)nt * 128 * 512, (const bf16_t*)(wl + WL_DN) + (size_t)ehi * 1024 * 512 + (size_t)nt * 128 * 512};
        ep = EpiMoeDown{out, lst, xb, ssp, rem, nt * 128}; } };
struct PhPleProj { const unsigned char* wl; unsigned char* ws; XcdTiles xt;
    __device__ __forceinline__ void make(int q, APlain& ap, BPlain& bp, EpiBf16& ep) const { int mt, nt; xt.get(q, mt, nt);
        ap = APlain{(const bf16_t*)(ws + WS_PB) + (size_t)mt * 128 * 256, 256}; bp = BPlain{(const bf16_t*)(wl + WL_PP) + (size_t)nt * 128 * 256, 256};
        ep = EpiBf16{(bf16_t*)(ws + WS_P2), ND, mt * 128, nt * 128}; } };
struct PhPleGate { const bf16_t* xn; const unsigned char* wl; unsigned char* ws; float* out; float sc; XcdTiles xt;
    __device__ __forceinline__ void make(int q, APlain& ap, BPlain& bp, EpiPleGate& ep) const { int mt, nt; xt.get(q, mt, nt);
        ap = APlain{xn + (size_t)mt * 128 * ND, ND}; bp = BPlain{(const bf16_t*)(wl + WL_PG) + (size_t)nt * 128 * ND, ND};
        ep = EpiPleGate{out, (const bf16_t*)(ws + WS_P2), mt * 128, nt * 128, sc}; } };

constexpr int LDS_QSLOT = 65536 + 16 + 448;
__device__ __forceinline__ int wq_next(int* head, LAS unsigned char* lds) {
    LAS int* slot = (LAS int*)(lds + LDS_QSLOT);
    __syncthreads();
    if (threadIdx.x == 0) *slot = atomicAdd(head, 1);
    __syncthreads();
    return *slot;
}
__device__ __forceinline__ void ple_stream(const bf16_t* xn, const bf16_t* pb, const unsigned char* wl, float* out, const float* ssp_in, bf16_t* xbo, float* ssp_out, LAS unsigned char* lds) {
    const XcdTiles xt(128, 8);
    int q = xt.loc;
    if (q >= xt.tiles) return;
    const int tid = TID(), wid = tid >> 6, lane = tid & 63, wr = wid >> 1, wc = wid & 1, fr = lane & 15, fq = lane >> 4;
    int mt, nt; xt.get(q, mt, nt);
    bool pref = false;
    for (;;) {
        const int qn = q + xt.nloc; const bool hn = qn < xt.tiles;
        int mtn = mt, ntn = nt; if (hn) xt.get(qn, mtn, ntn);
        const APlain ap1{pb + (size_t)mt * 128 * 256, 256}; const BPlain bp1{(const bf16_t*)(wl + WL_PP) + (size_t)nt * 128 * 256, 256};
        const APlain ap2{xn + (size_t)mt * 128 * ND, ND};   const BPlain bp2{(const bf16_t*)(wl + WL_PG) + (size_t)nt * 128 * ND, ND};
        const APlain apn{pb + (size_t)mtn * 128 * 256, 256}; const BPlain bpn{(const bf16_t*)(wl + WL_PP) + (size_t)ntn * 128 * 256, 256};
        f32x4 acc[4][4], acc2[4][4]; zero_acc(acc); zero_acc(acc2);
        gemm_kloop(acc2, ap1, bp1, 256, lds, pref, true, ap2, bp2);
        gemm_kloop(acc, ap2, bp2, ND, lds, true, hn, apn, bpn);
        const EpiPleFused ep{out, ssp_in, xbo, ssp_out, mt * 128, nt * 128};
        ep(acc, acc2, wr, wc, fr, fq);
        if (!hn) break;
        q = qn; mt = mtn; nt = ntn; pref = true;
    }
}

constexpr int LDS_BAR = 65536;
constexpr int LDS_SM = LDS_BAR + 16;
constexpr int LDS_BYTES = LDS_SM + 512;
static_assert(LDS_QSLOT == LDS_SM + 448, "queue slot");
static_assert(4 * KVT + 4096 + 64 <= LDS_BAR, "attention LDS fits");

__global__ void __launch_bounds__(256, 2) mega_fwd(Params p) {
    extern __shared__ __attribute__((aligned(16))) unsigned char lds_raw[];
    LAS unsigned char* lds = (LAS unsigned char*)lds_raw;
    unsigned char* ws = p.ws;
    const int tid = threadIdx.x;
    const int gtid = blockIdx.x * 256 + tid, gthreads = gridDim.x * 256;
    int* ctl = (int*)(ws + WS_CTL);
    {
        volatile LAS unsigned* st = (volatile LAS unsigned*)(lds + LDS_BAR);
        if (tid < 4) st[tid] = 0u;
        __syncthreads();
    }
    const XcdBarrier gbar = xcd_barrier_post((unsigned*)ctl + CW_BAR, (volatile LAS unsigned*)(lds + LDS_BAR));

    phase_convert(p, (LAS float*)lds);
    xcd_barrier(gbar);

    float* sspA = (float*)(ws + WS_SSP);
    float* sspB = sspA + (size_t)NT * 16;
    float* rinv = (float*)(ws + WS_RINV);
    for (int l = 0; l < 2; ++l) {
        const unsigned char* wl = ws + WS_W + (size_t)l * WL_SIZE;
        const float* xin = l == 0 ? p.in[0] : p.out;
        bf16_t* xn = (bf16_t*)(ws + WS_XN);
        const bf16_t* xb_in = l == 0 ? xn : (const bf16_t*)(ws + WS_O);
        {
            const PhInProj ph{xb_in, wl, ws, sspB, XcdTiles(128, 23)};
            gemm_stream<PhInProj, APlain, BPlain, EpiInProj>(ph, ph.xt.loc, ph.xt.nloc, ph.xt.tiles, ND, lds);
        }
        xcd_barrier(gbar);
        {
            int* qh = ctl + CW_Q + l * 4 + 0;
            int* ch = ctl + CW_Q + l * 4 + 2;
            const int nconv = conv_queue_strips(2 * l);
            const PhCmp1 ph{wl, ws, l};
            bool conv_left = nconv > 0, att_left = true;
            for (int k = 0; conv_left || att_left; ++k) {
                const bool want_conv = conv_left && (!att_left || (k % 7) == 6);
                if (want_conv) {
                    const int c = wq_next(ch, lds);
                    if (c < nconv) conv_strip(p, 2 * l, c, (LAS float*)lds); else conv_left = false;
                } else {
                    const int it = wq_next(qh, lds);
                    if (it >= 64 + 1536) att_left = false;
                    else if (it < 64) { ACmp ap; BPlain bp; EpiCmp1 ep; ph.make(it, ap, bp, ep); gemm_tile(ap, bp, 2048, ep, lds, false, false, ap, bp); }
                    else { dil_item(ws, 2 * (it - 64), lds); __syncthreads(); dil_item(ws, 2 * (it - 64) + 1, lds); }
                }
            }
        }
        xcd_barrier(gbar);
        { const PhCmp2 ph{wl, ws}; gemm_stream<PhCmp2, APlain, BPlain, EpiCmp2>(ph, BID(), gridDim.x, 32, 256, lds); }
        dil_merge(ws, gtid, gthreads);
        if (l == 0) convert_p(p);
        xcd_barrier(gbar);
        {
            int* qh = ctl + CW_Q + l * 4 + 1;
            int* ch = ctl + CW_Q + l * 4 + 3;
            const int nconv = conv_queue_strips(2 * l + 1);
            bool conv_left = nconv > 0, att_left = true;
            for (int k = 0; conv_left || att_left; ++k) {
                const bool want_conv = conv_left && (!att_left || (k % 4) == 3);
                if (want_conv) {
                    const int c = wq_next(ch, lds);
                    if (c < nconv) conv_strip(p, 2 * l + 1, c, (LAS float*)lds); else conv_left = false;
                } else {
                    const int it = wq_next(qh, lds);
                    if (it >= 1024) att_left = false;
                    else nsa_item(ws, ((63 - (it >> 4)) << 4) | (it & 15), lds);
                }
            }
        }
        xcd_barrier(gbar);
        { const PhOutProj ph{wl, ws, xin, p.out, xn, 1.f, XcdTiles(128, 8)};
          gemm_stream<PhOutProj, APlain, BPlain, EpiResAdd>(ph, ph.xt.loc, ph.xt.nloc, ph.xt.tiles, ND, lds); }
        xcd_barrier(gbar);
        int* cnt = ctl + CW_CNTP + l * 1536;
        int* list = (int*)(ws + WS_LIST);
        float* route = (float*)(ws + WS_ROUTE);
        phase_route(p.out, (const float*)(wl + WL_RT), p.in[12] + l * 4, p.in[14] + l * 16, cnt, list, route, rinv, lds);
        xcd_barrier(gbar);
        LAS int* sm = (LAS int*)(lds + LDS_SM);
        __syncthreads();
        if (tid < 24) sm[tid] = __hip_atomic_load(cnt + 64 * tid, __ATOMIC_RELAXED, __HIP_MEMORY_SCOPE_AGENT);
        __syncthreads();
        if (tid == 0) {
            int tp = 0, hb = 0;
            for (int k = 0; k < 24; ++k) {
                const int c = sm[k];
                sm[32 + k] = tp; sm[64 + k] = hb;
                const int nt_ = (c + 127) >> 7; tp += nt_; hb += nt_ * 128;
            }
            sm[32 + 24] = tp;
        }
        __syncthreads();
        const int total_mt = sm[32 + 24];
        { const PhMoeGU ph{PhMoe{sm, list}, xn, wl, ws, route, rinv, XcdTiles(total_mt, 16)};
          gemm_stream<PhMoeGU, AGather, BPlain, EpiMoeGU>(ph, ph.xt.loc, ph.xt.nloc, ph.xt.tiles, ND, lds); }
        xcd_barrier(gbar);
        { const PhMoeDown ph{PhMoe{sm, list}, wl, ws, p.out, xn, sspA, XcdTiles(total_mt, 8)};
          gemm_stream<PhMoeDown, APlain, BSplit, EpiMoeDown>(ph, ph.xt.loc, ph.xt.nloc, ph.xt.tiles, ND, lds); }
        xcd_barrier(gbar);
        ple_stream(xn, (const bf16_t*)(ws + WS_PBALL) + (size_t)l * NT * 256, wl, p.out, sspA, (bf16_t*)(ws + WS_O), sspB, lds);
        xcd_barrier(gbar);
    }
    phase_final_norm(p.out, p.in[21]);
}

extern "C" void kernel_launch(void* const* d_in, const int* in_sizes, int n_in, void* d_out, int out_size, void* d_ws, size_t ws_size, hipStream_t stream) {
    static int grid = 0;
    if (grid == 0) {
        if (n_in != 22 || out_size != NT * ND || ws_size < WS_END) { fprintf(stderr, "kernel_launch: unexpected shapes (n_in %d out %d ws %zu)\n", n_in, out_size, ws_size); grid = -1; return; }
        int dev = 0, cus = 0, per_cu = 0;
        hipGetDevice(&dev);
        hipDeviceGetAttribute(&cus, hipDeviceAttributeMultiprocessorCount, dev);
        if (hipFuncSetAttribute((const void*)mega_fwd, hipFuncAttributeMaxDynamicSharedMemorySize, LDS_BYTES) != hipSuccess) { fprintf(stderr, "kernel_launch: hipFuncSetAttribute failed\n"); grid = -1; return; }
        hipOccupancyMaxActiveBlocksPerMultiprocessor(&per_cu, (const void*)mega_fwd, 256, LDS_BYTES);
        if (per_cu < 1) { fprintf(stderr, "kernel_launch: occupancy query says %d\n", per_cu); grid = -1; return; }
        if (per_cu > 2) per_cu = 2;
        grid = cus * per_cu;
    }
    if (grid < 0) return;
    hipMemsetAsync((char*)d_ws + WS_CTL, 0, 32768, stream);
    Params p{};
    for (int i = 0; i < 22; ++i) p.in[i] = (const float*)d_in[i];
    p.out = (float*)d_out; p.ws = (unsigned char*)d_ws;
    hipLaunchKernelGGL(mega_fwd, dim3(grid), dim3(256), LDS_BYTES, stream, p);
    const hipError_t e = hipPeekAtLastError();
    if (e != hipSuccess) fprintf(stderr, "launch failed: %s (grid %d)\n", hipGetErrorString(e), grid);
}
```

```cpp
#include <hip/hip_runtime.h>
#include <cstdio>
#include <cstdint>

#ifndef NAIVE_GEMM
#define NAIVE_GEMM 0
#endif
#ifndef NAIVE_ATTN
#define NAIVE_ATTN 0
#endif
#define REP_CONV 1
#define REP_INPROJ 1
#define REP_ATTN 1
#define REP_GU 1
#define REP_NORM 1
#define REP_ROUTE 1
#define REP_DOWN 1
#define REP_OUTPROJ 1
#define REP_PG 1
#define REP_CMP 1
#define REP_MISC 1

#define LAS __attribute__((address_space(3)))
typedef unsigned short bf16_t;
typedef short bf16x8 __attribute__((ext_vector_type(8)));
typedef float f32x4 __attribute__((ext_vector_type(4)));
typedef unsigned u32x4 __attribute__((ext_vector_type(4)));
typedef unsigned u32x2 __attribute__((ext_vector_type(2)));
typedef float f32x16 __attribute__((ext_vector_type(16)));
typedef short s16x4 __attribute__((ext_vector_type(4)));
typedef float f32x2_t __attribute__((ext_vector_type(2)));
typedef __bf16 bf16x2_t __attribute__((ext_vector_type(2)));

constexpr int NB = 8, NS = 2048, ND = 1024, NT = NB * NS;
constexpr int NIN = 2840, NINP = 2944;
constexpr size_t MiB = (size_t)1 << 20;
constexpr size_t WL_IN = 0;
constexpr size_t WL_OUT = WL_IN + (size_t)NINP * 1024 * 2;
constexpr size_t WL_C1 = WL_OUT + (size_t)1024 * 1024 * 2;
constexpr size_t WL_C2 = WL_C1 + (size_t)2 * 256 * 2048 * 2;
constexpr size_t WL_GU = WL_C2 + (size_t)2 * 128 * 256 * 2;
constexpr size_t WL_DN = WL_GU + (size_t)16 * 1024 * 1024 * 2;
constexpr size_t WL_PG = WL_DN + (size_t)16 * 1024 * 512 * 2;
constexpr size_t WL_PP = WL_PG + (size_t)1024 * 1024 * 2;
constexpr size_t WL_BC1 = WL_PP + (size_t)1024 * 256 * 2;
constexpr size_t WL_RT = WL_BC1 + 2048;
constexpr size_t WL_SIZE = 64 * MiB;
static_assert(WL_RT + 131072 <= WL_SIZE, "weight block");
constexpr size_t WS_CTL = 0;
constexpr size_t WS_W = 1 * MiB;
constexpr size_t WS_XN = WS_W + 2 * WL_SIZE;
constexpr size_t WS_PROJ = WS_XN + 32 * MiB;
constexpr size_t WS_QA = WS_PROJ, WS_KA = WS_QA + 16 * MiB, WS_VA = WS_KA + 16 * MiB, WS_QB = WS_VA + 16 * MiB;
constexpr size_t WS_KV6 = WS_QB + 16 * MiB;
constexpr size_t WS_GATES = WS_KV6 + 24 * MiB;
constexpr size_t WS_PROJ_END = WS_GATES + 2 * MiB;
constexpr size_t WS_HID = WS_PROJ;
constexpr size_t WS_P2 = WS_PROJ + 40 * MiB;
constexpr size_t WS_PB = WS_PROJ + 72 * MiB;
constexpr size_t WS_HC = WS_PROJ_END;
constexpr size_t WS_KCMP = WS_HC + 2 * MiB;
constexpr size_t WS_MASK = WS_KCMP + 512 * 1024;
constexpr size_t WS_ROUTE = WS_MASK + 128 * 1024;
constexpr size_t WS_LIST = WS_ROUTE + 128 * 1024;
constexpr size_t WS_O = WS_LIST + 1536 * 1024 + 256 * 1024;
constexpr size_t WS_IMPH = WS_O + 32 * MiB;
constexpr size_t WS_OPA01 = WS_XN;
constexpr size_t WS_OPA2 = WS_IMPH;
constexpr size_t WS_STA = WS_IMPH + 16 * MiB;
constexpr size_t WS_PBALL = WS_IMPH + 20 * MiB;
constexpr size_t WS_SSP = WS_PBALL + 16 * MiB;
constexpr size_t WS_RINV = WS_MASK;
constexpr size_t WS_BC1P = WS_SSP + 2 * MiB;
constexpr size_t WS_END = WS_BC1P + 64 * 1024;
static_assert(WS_PB + 8 * MiB <= WS_PROJ_END, "alias map");
static_assert(WS_END <= 330 * MiB, "workspace");
constexpr int HID_ROWS = NT + 24 * 128;
constexpr int CW_BAR = 1024;
constexpr int CW_Q = 256;
constexpr int CW_CNTP = 4608;
constexpr int CW_CNT = 64;

struct Params {
    const float* in[22];
    float* out;
    unsigned char* ws;
};

__device__ __forceinline__ unsigned f2bf(float f) { unsigned u = __float_as_uint(f); return (u + 0x7fffu + ((u >> 16) & 1u)) >> 16; }
__device__ __forceinline__ unsigned pk2(float lo, float hi) { return f2bf(lo) | (f2bf(hi) << 16); }
__device__ __forceinline__ float bflo(unsigned v) { return __uint_as_float(v << 16); }
__device__ __forceinline__ float bfhi(unsigned v) { return __uint_as_float(v & 0xffff0000u); }
__device__ __forceinline__ float wave_sum(float v) {
#pragma unroll
    for (int o = 1; o < 64; o <<= 1) v += __shfl_xor(v, o);
    return v;
}
__device__ __forceinline__ int TID() { int t = threadIdx.x; asm volatile("" : "+v"(t)); return t; }
__device__ __forceinline__ int BID() { int t = blockIdx.x; asm volatile("" : "+s"(t)); return t; }
__device__ __forceinline__ float sigmoidf_(float x) { return 1.0f / (1.0f + __expf(-x)); }
__device__ __forceinline__ float gelu_tanh(float x) {
    const float u = 0.7978845608028654f * (x + 0.044715f * x * x * x);
    const float e = __expf(2.0f * u);
    const float th = 1.0f - 2.0f / (e + 1.0f);
    return 0.5f * x * (1.0f + th);
}

struct ConvJob { const float* src; bf16_t* dst; const float* gain; int K, N, NP, map, per; size_t dst_bstride; };
__device__ __forceinline__ int conv_job_tiles(int j) { return j == 0 ? 736 : (j == 1 || j == 9) ? 256 : (j == 2 || j == 3) ? 128 : (j == 4 || j == 5) ? 8 : j == 10 ? 64 : 2048; }
__device__ __forceinline__ ConvJob conv_job(const Params& p, int l, int j) {
    unsigned char* wl = p.ws + WS_W + (size_t)l * WL_SIZE;
    ConvJob c; c.map = 0; c.dst_bstride = 0; c.gain = nullptr;
    switch (j) {
    case 0: c.src = p.in[3] + (size_t)l * 1024 * NIN; c.K = 1024; c.N = NIN; c.NP = NINP; c.dst = (bf16_t*)(wl + WL_IN); c.gain = p.in[2] + l * ND; break;
    case 1: c.src = p.in[4] + (size_t)l * 1024 * 1024; c.K = 1024; c.N = 1024; c.NP = 1024; c.dst = (bf16_t*)(wl + WL_OUT); break;
    case 2: c.src = p.in[5] + (size_t)l * 2048 * 256; c.K = 2048; c.N = 256; c.NP = 256; c.dst = (bf16_t*)(wl + WL_C1); break;
    case 3: c.src = p.in[7] + (size_t)l * 2048 * 256; c.K = 2048; c.N = 256; c.NP = 256; c.dst = (bf16_t*)(wl + WL_C1) + (size_t)256 * 2048; break;
    case 4: c.src = p.in[6] + (size_t)l * 256 * 64; c.K = 256; c.N = 64; c.NP = 128; c.dst = (bf16_t*)(wl + WL_C2); break;
    case 5: c.src = p.in[8] + (size_t)l * 256 * 64; c.K = 256; c.N = 64; c.NP = 128; c.dst = (bf16_t*)(wl + WL_C2) + (size_t)128 * 256; break;
    case 6: c.src = p.in[15] + (size_t)l * 16 * 1024 * 512; c.K = 1024; c.N = 512; c.NP = 512; c.dst = (bf16_t*)(wl + WL_GU); c.map = 1; c.dst_bstride = (size_t)1024 * 1024; c.gain = p.in[10] + l * ND; break;
    case 7: c.src = p.in[16] + (size_t)l * 16 * 1024 * 512; c.K = 1024; c.N = 512; c.NP = 512; c.dst = (bf16_t*)(wl + WL_GU); c.map = 2; c.dst_bstride = (size_t)1024 * 1024; c.gain = p.in[10] + l * ND; break;
    case 8: c.src = p.in[17] + (size_t)l * 16 * 512 * 1024; c.K = 512; c.N = 1024; c.NP = 1024; c.dst = (bf16_t*)(wl + WL_DN); c.dst_bstride = (size_t)1024 * 512; break;
    case 9: c.src = p.in[19] + (size_t)l * 1024 * 1024; c.K = 1024; c.N = 1024; c.NP = 1024; c.dst = (bf16_t*)(wl + WL_PG); c.gain = p.in[18] + l * ND; break;
    default: c.src = p.in[20] + (size_t)l * 256 * 1024; c.K = 256; c.N = 1024; c.NP = 1024; c.dst = (bf16_t*)(wl + WL_PP); break;
    }
    c.per = (c.K / 64) * (c.NP / 64);
    return c;
}
__device__ __forceinline__ void convert_tiles(const ConvJob& c, int t0, int t1, LAS float* tl) {
    const int tid = TID();
    const int ntiles = c.NP / 64;
    const int kr = tid >> 4, c4 = (tid & 15) * 4;
    f32x4 v[4]; float gv[4];
#define CT_LOAD(it_) do { const int _bi = (it_) / c.per, _r = (it_) - _bi * c.per, _kt = _r / ntiles, _nt = _r - _kt * ntiles; \
        const int _n = _nt * 64 + c4; const bool _ok = _n < c.N; \
        const float* _sp = c.src + (size_t)_bi * c.K * c.N + (size_t)(_kt * 64 + kr) * c.N + (_ok ? _n : 0); \
        _Pragma("unroll") for (int _i = 0; _i < 4; ++_i) v[_i] = *(const f32x4*)(_sp + (size_t)(16 * _i) * c.N); \
        if (c.gain) { _Pragma("unroll") for (int _i = 0; _i < 4; ++_i) gv[_i] = c.gain[_kt * 64 + kr + 16 * _i]; } \
        else { _Pragma("unroll") for (int _i = 0; _i < 4; ++_i) gv[_i] = 1.0f; } \
        if (!_ok) { _Pragma("unroll") for (int _i = 0; _i < 4; ++_i) gv[_i] = 0.f; } } while (0)
    CT_LOAD(t0);
    for (int it = t0; it < t1; ++it) {
        const int bi = it / c.per, r = it - bi * c.per, kt = r / ntiles, nt = r - kt * ntiles;
        bf16_t* d = c.dst + (size_t)bi * c.dst_bstride;
        const int k0 = kt * 64, n0 = nt * 64;
        __syncthreads();
#pragma unroll
        for (int i = 0; i < 4; ++i) {
            LAS float* tp = tl + (kr + 16 * i) * 65 + c4;
            tp[0] = v[i].x * gv[i]; tp[1] = v[i].y * gv[i]; tp[2] = v[i].z * gv[i]; tp[3] = v[i].w * gv[i];
        }
        if (it + 1 < t1) CT_LOAD(it + 1);
        __syncthreads();
        const int n = tid >> 2, kc = (tid & 3) * 16;
        const int nsrc = n0 + n;
        const int row = (c.map == 0) ? nsrc : ((nsrc >> 4) * 32 + (nsrc & 15) + (c.map == 2 ? 16 : 0));
        float w[16];
#pragma unroll
        for (int j = 0; j < 16; ++j) w[j] = tl[(kc + j) * 65 + n];
        u32x4 o0, o1;
        o0.x = pk2(w[0], w[1]); o0.y = pk2(w[2], w[3]); o0.z = pk2(w[4], w[5]); o0.w = pk2(w[6], w[7]);
        o1.x = pk2(w[8], w[9]); o1.y = pk2(w[10], w[11]); o1.z = pk2(w[12], w[13]); o1.w = pk2(w[14], w[15]);
        bf16_t* dp = d + (size_t)row * c.K + k0 + kc;
        *(u32x4*)dp = o0; *(u32x4*)(dp + 8) = o1;
    }
#undef CT_LOAD
}
__device__ __forceinline__ int conv_list(int q, int i) {
    if (q == 0) return i == 0 ? 6 : (i == 1 ? 7 : -1);
    if (q == 1) return i == 0 ? 8 : i == 1 ? 9 : i == 2 ? 10 : i == 3 ? 16 : i == 4 ? 18 : i == 5 ? 19 : i == 6 ? 20 : i == 7 ? 21 : -1;
    if (q == 2) return i == 0 ? 17 : i == 1 ? 22 : i == 2 ? 23 : -1;
    return i == 0 ? 24 : i == 1 ? 25 : i == 2 ? 26 : -1;
}
__device__ __forceinline__ int conv_queue_strips(int q) {
    int n = 0;
    for (int i = 0; i < 8; ++i) { const int e = conv_list(q, i); if (e < 0) break; n += conv_job_tiles(e & 15) >> 3; }
    return n;
}
__device__ __forceinline__ void conv_strip(const Params& p, int q, int c, LAS float* tl) {
    for (int i = 0; i < 8; ++i) {
        const int e = conv_list(q, i);
        if (e < 0) return;
        const int ns = conv_job_tiles(e & 15) >> 3;
        if (c < ns) { const ConvJob job = conv_job(p, e >> 4, e & 15); convert_tiles(job, c * 8, c * 8 + 8, tl); return; }
        c -= ns;
    }
}

__device__ __forceinline__ void convert_p(const Params& p) {
    const f32x4* pl = (const f32x4*)p.in[1]; u32x2* pb = (u32x2*)(p.ws + WS_PBALL);
    for (int i = BID() * 256 + TID(); i < 2 * NT * 256 / 4; i += gridDim.x * 256) {
        const f32x4 v = pl[i]; u32x2 w; w.x = pk2(v.x, v.y); w.y = pk2(v.z, v.w); pb[i] = w;
    }
}
__device__ __forceinline__ void phase_convert(const Params& p, LAS float* tl) {
    {
        int base = 0;
        for (int j = 0; j < 6; ++j) {
            const ConvJob job = conv_job(p, 0, j);
            const int nt = conv_job_tiles(j);
            const int g = gridDim.x, b = BID();
            int first = (b - base % g + g) % g;
            for (int s = first; s < nt; s += g) convert_tiles(job, s, s + 1, tl);
            base += nt;
        }
    }
    {
        const int tid_ = TID(); const int lane = tid_ & 63, gw = BID() * 4 + (tid_ >> 6), ngw = gridDim.x * 4;
        for (int row = gw; row < NT; row += ngw) {
            const f32x4* xr = (const f32x4*)(p.in[0] + (size_t)row * ND) + lane;
            u32x2* o = (u32x2*)((bf16_t*)p.out + (size_t)row * ND) + lane;
            float ss = 0.f;
#pragma unroll
            for (int j = 0; j < 4; ++j) { const f32x4 v = xr[64 * j]; ss += (v.x * v.x + v.y * v.y) + (v.z * v.z + v.w * v.w); u32x2 w; w.x = pk2(v.x, v.y); w.y = pk2(v.z, v.w); o[64 * j] = w; }
            ss = wave_sum(ss);
            if (lane < 16) ((float*)(p.ws + WS_SSP) + (size_t)NT * 16)[(size_t)row * 16 + lane] = lane == 0 ? ss : 0.f;
        }
    }
    for (int i = BID() * 256 + TID(); i < 2 * 1024 * 32; i += gridDim.x * 256) {
        const int l = i >> 15, k = (i >> 5) & 1023, j = i & 31;
        const float gk = p.in[10][l * ND + k];
        const float wv = j < 4 ? p.in[11][(size_t)(l * ND + k) * 4 + j] : (j < 20 ? p.in[13][(size_t)(l * ND + k) * 16 + (j - 4)] : 0.f);
        ((float*)(p.ws + WS_W + (size_t)l * WL_SIZE + WL_RT))[k * 32 + j] = gk * wv;
    }
    for (int i = BID() * 256 + TID(); i < 16 * 1024; i += gridDim.x * 256) {
        const int part = i >> 10, o = i & 1023, l = o >> 9, kv = (o >> 8) & 1, n = o & 255;
        const float* pos = p.in[9] + (size_t)(l * 2 + kv) * 2048 + part * 128;
        const float* w1 = p.in[kv ? 7 : 5] + (size_t)l * 2048 * 256 + (size_t)part * 128 * 256 + n;
        float s = 0.f;
#pragma unroll 16
        for (int k = 0; k < 128; ++k) s += pos[k] * w1[(size_t)k * 256];
        ((float*)(p.ws + WS_BC1P))[i] = s;
    }
}

__device__ __forceinline__ void phase_norm(const float* x, const float* g, bf16_t* xn) {
    const int tid_ = TID(); const int lane = tid_ & 63, gw = BID() * 4 + (tid_ >> 6), ngw = gridDim.x * 4;
    for (int row = gw; row < NT; row += ngw) {
        const f32x4* xr = (const f32x4*)(x + (size_t)row * ND) + lane;
        f32x4 v[4]; float ss = 0.f;
#pragma unroll
        for (int j = 0; j < 4; ++j) { v[j] = xr[64 * j]; ss += (v[j].x * v[j].x + v[j].y * v[j].y) + (v[j].z * v[j].z + v[j].w * v[j].w); }
        ss = wave_sum(ss);
        const float r = 1.0f / sqrtf(ss * (1.0f / ND) + 1e-6f);
        u32x2* o = (u32x2*)(xn + (size_t)row * ND) + lane;
#pragma unroll
        for (int j = 0; j < 4; ++j) {
            const f32x4 gg = ((const f32x4*)g)[lane + 64 * j];
            u32x2 w; w.x = pk2(v[j].x * r * gg.x, v[j].y * r * gg.y); w.y = pk2(v[j].z * r * gg.z, v[j].w * r * gg.w);
            o[64 * j] = w;
        }
    }
}
__device__ __forceinline__ void phase_final_norm(const bf16_t* xb, float* out, const float* g) {
    const int tid_ = TID(); const int lane = tid_ & 63, gw = BID() * 4 + (tid_ >> 6), ngw = gridDim.x * 4;
    for (int row = gw; row < NT; row += ngw) {
        const u32x2* xr = (const u32x2*)(xb + (size_t)row * ND) + lane;
        f32x4* orow = (f32x4*)(out + (size_t)row * ND) + lane;
        f32x4 v[4]; float ss = 0.f;
#pragma unroll
        for (int j = 0; j < 4; ++j) { const u32x2 w = xr[64 * j]; v[j] = (f32x4){bflo(w.x), bfhi(w.x), bflo(w.y), bfhi(w.y)}; ss += (v[j].x * v[j].x + v[j].y * v[j].y) + (v[j].z * v[j].z + v[j].w * v[j].w); }
        ss = wave_sum(ss);
        const float r = 1.0f / sqrtf(ss * (1.0f / ND) + 1e-6f);
#pragma unroll
        for (int j = 0; j < 4; ++j) {
            const f32x4 gg = ((const f32x4*)g)[lane + 64 * j];
            f32x4 o; o.x = v[j].x * r * gg.x; o.y = v[j].y * r * gg.y; o.z = v[j].z * r * gg.z; o.w = v[j].w * r * gg.w;
            orow[64 * j] = o;
        }
    }
}
typedef float f32x16r __attribute__((ext_vector_type(16)));
__device__ __forceinline__ void phase_route(const bf16_t* x, const float* wr, const float* brg, const float* bre, int* cnt, int* list, float* route, float* rinv, LAS unsigned char* lds) {
    const int tid_ = TID(); const int lane = tid_ & 63, wv = tid_ >> 6;
    const int i = lane & 31, hk = lane >> 5;
    LAS float* tl = (LAS float*)lds + wv * (32 * 33);
    LAS float* ssl = (LAS float*)(lds + 4 * 32 * 33 * 4);
    for (int task = BID(); task < NT / 32; task += gridDim.x) {
        const int row0 = task * 32;
        const bf16_t* xr = x + (size_t)(row0 + i) * ND + wv * 256;
        const float* wp = wr + (size_t)(wv * 256) * 32 + hk * 32 + i;
        f32x16r acc;
#pragma unroll
        for (int q = 0; q < 16; ++q) acc[q] = 0.f;
        float ss = 0.f;
#pragma unroll 8
        for (int k8 = 0; k8 < 32; ++k8) {
            const u32x4 xa = *(const u32x4*)(xr + 8 * k8);
            const float a0 = hk ? bfhi(xa.x) : bflo(xa.x), a1 = hk ? bfhi(xa.y) : bflo(xa.y), a2 = hk ? bfhi(xa.z) : bflo(xa.z), a3 = hk ? bfhi(xa.w) : bflo(xa.w);
            const float* wq = wp + (size_t)(8 * k8) * 32;
            acc = __builtin_amdgcn_mfma_f32_32x32x2f32(a0, wq[0], acc, 0, 0, 0);
            acc = __builtin_amdgcn_mfma_f32_32x32x2f32(a1, wq[2 * 32], acc, 0, 0, 0);
            acc = __builtin_amdgcn_mfma_f32_32x32x2f32(a2, wq[4 * 32], acc, 0, 0, 0);
            acc = __builtin_amdgcn_mfma_f32_32x32x2f32(a3, wq[6 * 32], acc, 0, 0, 0);
            ss += (a0 * a0 + a1 * a1) + (a2 * a2 + a3 * a3);
        }
        ss += __shfl_xor(ss, 32);
#pragma unroll
        for (int q = 0; q < 16; ++q) tl[((q & 3) + 8 * (q >> 2) + 4 * hk) * 33 + i] = acc[q];
        if (hk == 0) ssl[wv * 32 + i] = ss;
        __syncthreads();
        if (wv == 0 && hk == 0) {
            LAS const float* tp0 = (LAS const float*)lds;
            const float sst = (ssl[i] + ssl[32 + i]) + (ssl[64 + i] + ssl[96 + i]);
            const float r = 1.0f / sqrtf(sst * (1.0f / ND) + 1e-6f);
#define RT_SUM(e_) ((tp0[i * 33 + (e_)] + tp0[32 * 33 + i * 33 + (e_)]) + (tp0[2 * 32 * 33 + i * 33 + (e_)] + tp0[3 * 32 * 33 + i * 33 + (e_)]))
            float gl[4], el[16];
#pragma unroll
            for (int e = 0; e < 4; ++e) gl[e] = RT_SUM(e) * r + brg[e];
#pragma unroll
            for (int e = 0; e < 16; ++e) el[e] = RT_SUM(4 + e) * r + bre[e];
#undef RT_SUM
            int gsel = 0; float gmax = gl[0];
#pragma unroll
            for (int e = 1; e < 4; ++e) if (gl[e] > gmax) { gmax = gl[e]; gsel = e; }
            float gden = 0.f;
#pragma unroll
            for (int e = 0; e < 4; ++e) gden += __expf(gl[e] - gmax);
            const float gw_ = 1.0f / gden;
            float wi[4];
#pragma unroll
            for (int e = 0; e < 4; ++e) wi[e] = gsel == 0 ? el[e] : (gsel == 1 ? el[4 + e] : (gsel == 2 ? el[8 + e] : el[12 + e]));
            int i0 = 0; float t0 = wi[0];
#pragma unroll
            for (int e = 1; e < 4; ++e) if (wi[e] > t0) { t0 = wi[e]; i0 = e; }
            int i1 = -1; float t1 = -3.0e38f;
#pragma unroll
            for (int e = 0; e < 4; ++e) if (e != i0 && wi[e] > t1) { t1 = wi[e]; i1 = e; }
            const float ex = __expf(t1 - t0);
            const float ew0 = gw_ / (1.0f + ex), ew1 = gw_ * ex / (1.0f + ex);
            const int lo = i0 < i1 ? i0 : i1, hi = i0 < i1 ? i1 : i0;
            const float wlo = i0 < i1 ? ew0 : ew1, whi = i0 < i1 ? ew1 : ew0;
            const int pidx = lo == 0 ? hi - 1 : (lo == 1 ? hi + 1 : 5);
            const int bucket = gsel * 6 + pidx;
            const int row = row0 + i;
            const int pos = atomicAdd(cnt + 64 * bucket, 1);
            list[(size_t)bucket * NT + pos] = row;
            route[2 * row] = wlo; route[2 * row + 1] = whi;
            rinv[row] = r;
        }
        __syncthreads();
    }
}

struct APlain { const bf16_t* base; int ld; __device__ __forceinline__ const bf16_t* operator()(int r) const { return base + (size_t)r * ld; } };
struct ACmp { const bf16_t* base; __device__ __forceinline__ const bf16_t* operator()(int r) const { return base + (size_t)(r < 126 ? r : 126) * 1024; } };
struct AGather { const bf16_t* xn; const int* list; int cnt; __device__ __forceinline__ const bf16_t* operator()(int r) const { return xn + (size_t)(r < cnt ? list[r] : 0) * ND; } };
struct BPlain { const bf16_t* base; int ld; __device__ __forceinline__ const bf16_t* operator()(int r, int k0) const { return base + (size_t)r * ld + k0; } };
struct BSplit { const bf16_t* b0; const bf16_t* b1; __device__ __forceinline__ const bf16_t* operator()(int r, int k0) const { return k0 < 512 ? b0 + (size_t)r * 512 + k0 : b1 + (size_t)r * 512 + (k0 - 512); } };

template <class AP, class BP, class APN, class BPN>
__device__ __forceinline__ void gemm_kloop(f32x4 (&acc)[4][4], const AP& ap, const BP& bp, int K, LAS unsigned char* lds, bool prefetched, bool has_next, const APN& apn, const BPN& bpn) {
    const int tid = TID(), wid = tid >> 6, lane = tid & 63, wr = wid >> 1, wc = wid & 1, fr = lane & 15, fq = lane >> 4;
#if NAIVE_GEMM
    for (int k0 = 0; k0 < K; k0 += 32) {
#pragma unroll
        for (int m = 0; m < 4; ++m) {
            const bf16_t* arow = ap(wr * 64 + m * 16 + fr) + k0;
            u32x4 av[4];
#pragma unroll
            for (int c = 0; c < 4; ++c) av[c] = ((const u32x4*)arow)[c];
#pragma unroll
            for (int n = 0; n < 4; ++n)
#pragma unroll
                for (int j = 0; j < 4; ++j) {
                    const bf16_t* brow = bp(wc * 64 + n * 16 + 4 * fq + j, k0);
                    float s = 0.f;
#pragma unroll
                    for (int c = 0; c < 4; ++c) {
                        const u32x4 bv = ((const u32x4*)brow)[c];
                        s += bflo(av[c].x) * bflo(bv.x) + bfhi(av[c].x) * bfhi(bv.x) + bflo(av[c].y) * bflo(bv.y) + bfhi(av[c].y) * bfhi(bv.y)
                           + bflo(av[c].z) * bflo(bv.z) + bfhi(av[c].z) * bfhi(bv.z) + bflo(av[c].w) * bflo(bv.w) + bfhi(av[c].w) * bfhi(bv.w);
                    }
                    acc[m][n][j] += s;
                }
        }
    }
#else
    const unsigned woff = (unsigned)wid * 1024u;
    const bf16_t* aptr[4]; int brow[4], bcol;
    {
        const int sb = lane * 16, swz = sb ^ (((sb >> 9) & 1) << 5);
        const int rl = swz >> 6, cc = (wid & 1) * 32 + ((swz & 63) >> 1);
        bcol = cc;
#pragma unroll
        for (int i = 0; i < 4; ++i) { const int R = ((wid >> 1) + 2 * i) * 16 + rl; aptr[i] = ap(R) + cc; brow[i] = R; }
    }
    int aoff[4], boff[4];
#pragma unroll
    for (int m = 0; m < 4; ++m) {
        { const int r = wr * 64 + m * 16 + fr, c = fq * 8, st = (r >> 4) * 2, ob = (r & 15) * 64 + c * 2; aoff[m] = st * 1024 + (ob ^ (((ob >> 9) & 1) << 5)); }
        { const int r = wc * 64 + m * 16 + fr, c = fq * 8, st = (r >> 4) * 2, ob = (r & 15) * 64 + c * 2; boff[m] = st * 1024 + (ob ^ (((ob >> 9) & 1) << 5)); }
    }
    const int nk = K / 64;
#define GT_STAGE(buf, t) do { const int _k0 = (t) * 64; LAS unsigned char* _ba = lds + (buf) * 32768 + woff; \
        _Pragma("unroll") for (int _i = 0; _i < 4; ++_i) { \
            __builtin_amdgcn_global_load_lds((const unsigned*)(aptr[_i] + _k0), (LAS unsigned*)(_ba + _i * 4096), 16, 0, 0); \
            __builtin_amdgcn_global_load_lds((const unsigned*)(bp(brow[_i], _k0) + bcol), (LAS unsigned*)(_ba + 16384 + _i * 4096), 16, 0, 0); } } while (0)
    if (!prefetched) GT_STAGE(0, 0);
#pragma unroll 1
    for (int t = 0; t < nk; ++t) {
        asm volatile("s_waitcnt vmcnt(0)" ::: "memory");
        __syncthreads();
        if (t + 1 < nk) GT_STAGE((t + 1) & 1, t + 1);
        else if (has_next) {
            LAS unsigned char* _ba = lds + woff;
#pragma unroll
            for (int _i = 0; _i < 4; ++_i) {
                __builtin_amdgcn_global_load_lds((const unsigned*)(apn(brow[_i]) + bcol), (LAS unsigned*)(_ba + _i * 4096), 16, 0, 0);
                __builtin_amdgcn_global_load_lds((const unsigned*)(bpn(brow[_i], 0) + bcol), (LAS unsigned*)(_ba + 16384 + _i * 4096), 16, 0, 0);
            }
        }
        LAS const unsigned char* la = lds + (t & 1) * 32768;
        LAS const unsigned char* lb = la + 16384;
#pragma unroll
        for (int kh = 0; kh < 2; ++kh) {
            bf16x8 At[4], Bt[4];
#pragma unroll
            for (int m = 0; m < 4; ++m) At[m] = *(const LAS bf16x8*)(la + aoff[m] + kh * 1024);
#pragma unroll
            for (int n = 0; n < 4; ++n) Bt[n] = *(const LAS bf16x8*)(lb + boff[n] + kh * 1024);
#pragma unroll
            for (int m = 0; m < 4; ++m)
#pragma unroll
                for (int n = 0; n < 4; ++n) acc[m][n] = __builtin_amdgcn_mfma_f32_16x16x32_bf16(Bt[n], At[m], acc[m][n], 0, 0, 0);
        }
    }
#undef GT_STAGE
#endif
}
__device__ __forceinline__ void zero_acc(f32x4 (&acc)[4][4]) {
#pragma unroll
    for (int m = 0; m < 4; ++m)
#pragma unroll
        for (int n = 0; n < 4; ++n) acc[m][n] = (f32x4){0.f, 0.f, 0.f, 0.f};
}
template <class AP, class BP, class EPI>
__device__ __forceinline__ void gemm_tile(const AP& ap, const BP& bp, int K, const EPI& epi, LAS unsigned char* lds, bool prefetched, bool has_next, const AP& apn, const BP& bpn) {
    const int tid = TID(), wid = tid >> 6, lane = tid & 63, wr = wid >> 1, wc = wid & 1, fr = lane & 15, fq = lane >> 4;
    f32x4 acc[4][4]; zero_acc(acc);
    gemm_kloop(acc, ap, bp, K, lds, prefetched, has_next, apn, bpn);
    epi(acc, wr, wc, fr, fq);
}

__device__ __forceinline__ float rinv_from_ssp(const float* ssp, int row) {
    const f32x4* q = (const f32x4*)(ssp + (size_t)row * 16);
    const f32x4 a = q[0], b = q[1], c = q[2], d = q[3];
    const float s = ((a.x + a.y) + (a.z + a.w)) + ((b.x + b.y) + (b.z + b.w)) + ((c.x + c.y) + (c.z + c.w)) + ((d.x + d.y) + (d.z + d.w));
    return 1.0f / sqrtf(s * (1.0f / ND) + 1e-6f);
}
__device__ __forceinline__ float row_ss64(const f32x4& a, const f32x4& b, const f32x4& c, const f32x4& d) {
    float s = ((a.x * a.x + a.y * a.y) + (a.z * a.z + a.w * a.w)) + ((b.x * b.x + b.y * b.y) + (b.z * b.z + b.w * b.w))
            + ((c.x * c.x + c.y * c.y) + (c.z * c.z + c.w * c.w)) + ((d.x * d.x + d.y * d.y) + (d.z * d.z + d.w * d.w));
    s += __shfl_xor(s, 16); s += __shfl_xor(s, 32);
    return s;
}
struct EpiInProj {
    int mt, nt; unsigned char* ws; const float* ssp;
    __device__ __forceinline__ void operator()(const f32x4 (&acc)[4][4], int wr, int wc, int fr, int fq) const {
#pragma unroll
        for (int m = 0; m < 4; ++m) {
            const int row = mt * 128 + wr * 64 + m * 16 + fr, b = row >> 11, s = row & 2047;
            const float rr = rinv_from_ssp(ssp, row);
#pragma unroll
            for (int n = 0; n < 4; ++n) {
                const int col = wc * 64 + n * 16 + 4 * fq;
                const f32x4 v = acc[m][n] * rr;
                if (nt < 16) {
                    const int reg = nt >> 2, c = (nt & 3) * 128 + col, head = c >> 6, d = c & 63;
                    const float sc = (reg == 0 || reg == 3) ? 0.125f * 1.4426950408889634f : 1.0f;
                    bf16_t* dst = (bf16_t*)(ws + WS_QA + (size_t)reg * 16 * MiB) + ((size_t)((b * 8 + head) * NS + s) * 64 + d);
                    u32x2 w; w.x = pk2(v.x * sc, v.y * sc); w.y = pk2(v.z * sc, v.w * sc);
                    *(u32x2*)dst = w;
                } else if (nt < 22) {
                    const int g = col >> 6, d = col & 63;
                    bf16_t* dst = (bf16_t*)(ws + WS_KV6 + (size_t)(nt - 16) * 4 * MiB) + ((size_t)((b * 2 + g) * NS + s) * 64 + d);
                    u32x2 w; w.x = pk2(v.x, v.y); w.y = pk2(v.z, v.w);
                    *(u32x2*)dst = w;
                } else {
                    if (col < 24) {
                        f32x4 o; o.x = sigmoidf_(v.x); o.y = sigmoidf_(v.y); o.z = sigmoidf_(v.z); o.w = sigmoidf_(v.w);
                        *(f32x4*)((float*)(ws + WS_GATES) + (size_t)row * 24 + col) = o;
                    }
                }
            }
        }
    }
};
struct EpiCmp1 {
    bf16_t* hc; const float* bc1; int row0, col0;
    __device__ __forceinline__ void operator()(const f32x4 (&acc)[4][4], int wr, int wc, int fr, int fq) const {
#pragma unroll
        for (int m = 0; m < 4; ++m) {
            const int row = row0 + wr * 64 + m * 16 + fr;
#pragma unroll
            for (int n = 0; n < 4; ++n) {
                const int col = col0 + wc * 64 + n * 16 + 4 * fq;
                f32x4 bb = *(const f32x4*)(bc1 + col);
#pragma unroll
                for (int pp = 1; pp < 16; ++pp) bb += *(const f32x4*)(bc1 + pp * 1024 + col);
                const f32x4 v = acc[m][n];
                u32x2 w; w.x = pk2(gelu_tanh(v.x + bb.x), gelu_tanh(v.y + bb.y)); w.y = pk2(gelu_tanh(v.z + bb.z), gelu_tanh(v.w + bb.w));
                *(u32x2*)(hc + (size_t)row * 256 + col) = w;
            }
        }
    }
};
struct EpiCmp2 {
    bf16_t* dst; int row0;
    __device__ __forceinline__ void operator()(const f32x4 (&acc)[4][4], int wr, int wc, int fr, int fq) const {
        if (wc != 0) return;
#pragma unroll
        for (int m = 0; m < 4; ++m) {
            const int row = row0 + wr * 64 + m * 16 + fr;
#pragma unroll
            for (int n = 0; n < 4; ++n) {
                const int col = n * 16 + 4 * fq;
                const f32x4 v = acc[m][n];
                u32x2 w; w.x = pk2(v.x, v.y); w.y = pk2(v.z, v.w);
                *(u32x2*)(dst + (size_t)row * 64 + col) = w;
            }
        }
    }
};
struct EpiResAdd {
    bf16_t* res; int row0, col0;
    __device__ __forceinline__ void operator()(const f32x4 (&acc)[4][4], int wr, int wc, int fr, int fq) const {
#pragma unroll
        for (int m = 0; m < 4; ++m) {
            const int row = row0 + wr * 64 + m * 16 + fr;
#pragma unroll
            for (int n = 0; n < 4; ++n) {
                const int col = col0 + wc * 64 + n * 16 + 4 * fq;
                u32x2* pp = (u32x2*)(res + (size_t)row * ND + col);
                const u32x2 b = *pp; const f32x4 a = acc[m][n];
                u32x2 w; w.x = pk2(bflo(b.x) + a.x, bfhi(b.x) + a.y); w.y = pk2(bflo(b.y) + a.z, bfhi(b.y) + a.w);
                *pp = w;
            }
        }
    }
};
struct EpiMoeGU {
    bf16_t* hid; const int* list; const float* route; const float* rinv; int cnt, hrow0, nt16;
    __device__ __forceinline__ void operator()(const f32x4 (&acc)[4][4], int wr, int wc, int fr, int fq) const {
        const int half = nt16 >> 3, nte = nt16 & 7;
#pragma unroll
        for (int m = 0; m < 4; ++m) {
            const int r = wr * 64 + m * 16 + fr;
            const int tok = r < cnt ? list[r] : 0;
            const float w = r < cnt ? route[2 * tok + half] : 0.f;
            const float rt = rinv[tok];
#pragma unroll
            for (int pr = 0; pr < 2; ++pr) {
                const f32x4 gv = acc[m][2 * pr], uv = acc[m][2 * pr + 1];
                const int hc = half * 512 + (4 * nte + 2 * wc + pr) * 16 + 4 * fq;
                float h[4];
#pragma unroll
                for (int j = 0; j < 4; ++j) { const float gg = gv[j] * rt; h[j] = gg / (1.0f + __expf(-gg)) * (uv[j] * rt) * w; }
                u32x2 o; o.x = pk2(h[0], h[1]); o.y = pk2(h[2], h[3]);
                *(u32x2*)(hid + (size_t)(hrow0 + r) * 1024 + hc) = o;
            }
        }
    }
};
struct EpiMoeDown {
    bf16_t* res; const int* list; float* ssp; int cnt, col0;
    __device__ __forceinline__ void operator()(const f32x4 (&acc)[4][4], int wr, int wc, int fr, int fq) const {
#pragma unroll
        for (int m = 0; m < 4; ++m) {
            const int r = wr * 64 + m * 16 + fr;
            const bool ok = r < cnt;
            const int tok = ok ? list[r] : 0;
            f32x4 nv[4];
#pragma unroll
            for (int n = 0; n < 4; ++n) {
                const int col = col0 + wc * 64 + n * 16 + 4 * fq;
                u32x2* pp = (u32x2*)(res + (size_t)tok * ND + col);
                const u32x2 b = *pp; const f32x4 a = acc[m][n];
                nv[n] = (f32x4){bflo(b.x) + a.x, bfhi(b.x) + a.y, bflo(b.y) + a.z, bfhi(b.y) + a.w};
                if (ok) { u32x2 w; w.x = pk2(nv[n].x, nv[n].y); w.y = pk2(nv[n].z, nv[n].w); *pp = w; }
            }
            const float ps = row_ss64(nv[0], nv[1], nv[2], nv[3]);
            if (ok && fq == 0) ssp[(size_t)tok * 16 + (col0 >> 6) + wc] = ps;
        }
    }
};
struct EpiBf16 {
    bf16_t* dst; int ld, row0, col0;
    __device__ __forceinline__ void operator()(const f32x4 (&acc)[4][4], int wr, int wc, int fr, int fq) const {
#pragma unroll
        for (int m = 0; m < 4; ++m) {
            const int row = row0 + wr * 64 + m * 16 + fr;
#pragma unroll
            for (int n = 0; n < 4; ++n) {
                const int col = col0 + wc * 64 + n * 16 + 4 * fq;
                const f32x4 v = acc[m][n];
                u32x2 w; w.x = pk2(v.x, v.y); w.y = pk2(v.z, v.w);
                *(u32x2*)(dst + (size_t)row * ld + col) = w;
            }
        }
    }
};
struct EpiPleFused {
    const bf16_t* rin; const float* ssp_in; bf16_t* rout; float* ssp_out; int row0, col0;
    __device__ __forceinline__ void operator()(const f32x4 (&acc)[4][4], const f32x4 (&acc2)[4][4], int wr, int wc, int fr, int fq) const {
#pragma unroll
        for (int m = 0; m < 4; ++m) {
            const int row = row0 + wr * 64 + m * 16 + fr;
            const float rr = rinv_from_ssp(ssp_in, row);
            f32x4 nv[4];
#pragma unroll
            for (int n = 0; n < 4; ++n) {
                const int col = col0 + wc * 64 + n * 16 + 4 * fq;
                const size_t off = (size_t)row * ND + col;
                const f32x4 v = acc[m][n] * rr, q = acc2[m][n];
                const u32x2 b = *(const u32x2*)(rin + off);
                f32x4 o = (f32x4){bflo(b.x), bfhi(b.x), bflo(b.y), bfhi(b.y)};
                o.x += sigmoidf_(v.x) * q.x; o.y += sigmoidf_(v.y) * q.y; o.z += sigmoidf_(v.z) * q.z; o.w += sigmoidf_(v.w) * q.w;
                u32x2 w; w.x = pk2(o.x, o.y); w.y = pk2(o.z, o.w);
                *(u32x2*)(rout + off) = w;
                nv[n] = o;
            }
            const float ps = row_ss64(nv[0], nv[1], nv[2], nv[3]);
            if (fq == 0) ssp_out[(size_t)row * 16 + (col0 >> 6) + wc] = ps;
        }
    }
};
struct EpiPleGate {
    float* out; const bf16_t* p2; int row0, col0; float sc;
    __device__ __forceinline__ void operator()(const f32x4 (&acc)[4][4], int wr, int wc, int fr, int fq) const {
#pragma unroll
        for (int m = 0; m < 4; ++m) {
            const int row = row0 + wr * 64 + m * 16 + fr;
#pragma unroll
            for (int n = 0; n < 4; ++n) {
                const int col = col0 + wc * 64 + n * 16 + 4 * fq;
                const size_t off = (size_t)row * ND + col;
                const u32x2 pv = *(const u32x2*)(p2 + off);
                const f32x4 v = acc[m][n];
                f32x4 o = *(const f32x4*)(out + off);
                o.x += sc * sigmoidf_(v.x) * bflo(pv.x); o.y += sc * sigmoidf_(v.y) * bfhi(pv.x); o.z += sc * sigmoidf_(v.z) * bflo(pv.y); o.w += sc * sigmoidf_(v.w) * bfhi(pv.y);
                *(f32x4*)(out + off) = o;
            }
        }
    }
};

template <class PH, class AP, class BP, class EPI>
__device__ __forceinline__ void gemm_stream(const PH& ph, int first, int step, int count, int K, LAS unsigned char* lds) {
    int q = first;
    if (q >= count) return;
    AP ap, apn; BP bp, bpn; EPI ep, epn;
    ph.make(q, ap, bp, ep);
    bool pref = false;
    for (;;) {
        const int qn = q + step; const bool hn = qn < count;
        if (hn) ph.make(qn, apn, bpn, epn); else { apn = ap; bpn = bp; epn = ep; }
        gemm_tile(ap, bp, K, ep, lds, pref, hn, apn, bpn);
        if (!hn) break;
        ap = apn; bp = bpn; ep = epn; q = qn; pref = true;
    }
}

__device__ __forceinline__ void load_q32(const bf16_t* p, float* q) {
#pragma unroll
    for (int c = 0; c < 4; ++c) {
        const u32x4 v = ((const u32x4*)p)[c];
        q[8 * c] = bflo(v.x); q[8 * c + 1] = bfhi(v.x); q[8 * c + 2] = bflo(v.y); q[8 * c + 3] = bfhi(v.y);
        q[8 * c + 4] = bflo(v.z); q[8 * c + 5] = bfhi(v.z); q[8 * c + 6] = bflo(v.w); q[8 * c + 7] = bfhi(v.w);
    }
}
__device__ __forceinline__ float dot32p(const float* q, const bf16_t* k) {
    float s0 = 0.f, s1 = 0.f;
#pragma unroll
    for (int c = 0; c < 4; ++c) {
        const u32x4 v = ((const u32x4*)k)[c];
        s0 += q[8 * c] * bflo(v.x); s1 += q[8 * c + 1] * bfhi(v.x); s0 += q[8 * c + 2] * bflo(v.y); s1 += q[8 * c + 3] * bfhi(v.y);
        s0 += q[8 * c + 4] * bflo(v.z); s1 += q[8 * c + 5] * bfhi(v.z); s0 += q[8 * c + 6] * bflo(v.w); s1 += q[8 * c + 7] * bfhi(v.w);
    }
    const float s = s0 + s1;
    return s + __shfl_xor(s, 1);
}
__device__ __forceinline__ void axpy32(float* a, float p, const bf16_t* vr) {
#pragma unroll
    for (int c = 0; c < 4; ++c) {
        const u32x4 v = ((const u32x4*)vr)[c];
        a[8 * c] += p * bflo(v.x); a[8 * c + 1] += p * bfhi(v.x); a[8 * c + 2] += p * bflo(v.y); a[8 * c + 3] += p * bfhi(v.y);
        a[8 * c + 4] += p * bflo(v.z); a[8 * c + 5] += p * bfhi(v.z); a[8 * c + 6] += p * bflo(v.w); a[8 * c + 7] += p * bfhi(v.w);
    }
}
#define ONLINE_STEP(s_, vrow_) do { const float _s = (s_); if (_s > mx) { const float _c = __expf(mx - _s); l *= _c; _Pragma("unroll") for (int _i = 0; _i < 32; ++_i) acc[_i] *= _c; mx = _s; } \
    const float _p = __expf(_s - mx); l += _p; axpy32(acc, _p, (vrow_)); } while (0)

__device__ __forceinline__ void store_o32(bf16_t* dst, const float* a, float sc) {
#pragma unroll
    for (int c = 0; c < 4; ++c) {
        u32x4 w; w.x = pk2(a[8 * c] * sc, a[8 * c + 1] * sc); w.y = pk2(a[8 * c + 2] * sc, a[8 * c + 3] * sc);
        w.z = pk2(a[8 * c + 4] * sc, a[8 * c + 5] * sc); w.w = pk2(a[8 * c + 6] * sc, a[8 * c + 7] * sc);
        ((u32x4*)dst)[c] = w;
    }
}

__device__ __forceinline__ void attn_dilated_naive(const unsigned char* ws, int gtid, int gthreads) {
    asm volatile("" : "+v"(gtid));
    const bf16_t* qa = (const bf16_t*)(ws + WS_QA); const bf16_t* ka = (const bf16_t*)(ws + WS_KA); const bf16_t* va = (const bf16_t*)(ws + WS_VA);
    bf16_t* ob = (bf16_t*)(ws + WS_O);
    for (int id2 = gtid; id2 < NB * 8 * NS * 2; id2 += gthreads) {
        const int idx = id2 >> 1, hf = (id2 & 1) * 32;
        const int t = idx & 2047, bh = idx >> 11, h = bh & 7, b = bh >> 3;
        float q[32]; load_q32(qa + (size_t)idx * 64 + hf, q);
        const bf16_t* kb = ka + (size_t)bh * NS * 64 + hf; const bf16_t* vb = va + (size_t)bh * NS * 64 + hf;
        const float slope = exp2f(-((float)h + 0.5f));
        float mx = -1e30f, l = 0.f; float acc[32];
#pragma unroll
        for (int i = 0; i < 32; ++i) acc[i] = 0.f;
#pragma unroll 1
        for (int pat = 0; pat < 3; ++pat) {
            const int dil = pat == 0 ? 1 : (pat == 1 ? 4 : 16);
#pragma unroll 1
            for (int j = 0; j <= 128; ++j) {
                const int dist = j * dil, pos = t - dist;
                if (pos < 0) break;
                const float s = dot32p(q, kb + (size_t)pos * 64) - slope * (float)dist;
                ONLINE_STEP(s, vb + (size_t)pos * 64);
            }
        }
        store_o32(ob + ((size_t)(b * NS + t) * ND + h * 64 + hf), acc, 1.0f / l);
    }
}

__device__ __forceinline__ void nsa_imp_naive(const unsigned char* ws, int gtid, int gthreads) {
    asm volatile("" : "+v"(gtid));
    const bf16_t* qb = (const bf16_t*)(ws + WS_QB); const bf16_t* kcmp = (const bf16_t*)(ws + WS_KCMP);
    float* imph = (float*)(ws + WS_IMPH);
    for (int id2 = gtid; id2 < NB * 8 * NS * 2; id2 += gthreads) {
        const int idx = id2 >> 1, hf = (id2 & 1) * 32;
        const int t = idx & 2047, bh = idx >> 11, hb = bh & 7, b = bh >> 3, g = hb >> 2;
        float q[32]; load_q32(qb + (size_t)idx * 64 + hf, q);
        const bf16_t* kc = kcmp + (size_t)(b * 2 + g) * 128 * 64 + hf;
        const float slope = exp2f(-(float)(hb + 1));
        const int ncv = t >= 31 ? ((t - 31) >> 4) + 1 : 0;
        float mx = -1e30f;
#pragma unroll 1
        for (int c = 0; c < ncv; ++c) { const float s = dot32p(q, kc + c * 64) - slope * (float)(t - (16 * c + 31)); mx = fmaxf(mx, s); }
        float den = 0.f;
#pragma unroll 1
        for (int c = 0; c < ncv; ++c) { const float s = dot32p(q, kc + c * 64) - slope * (float)(t - (16 * c + 31)); den += __expf(s - mx); }
        const float inv = ncv > 0 ? 1.0f / den : 0.f;
#pragma unroll 1
        for (int n = 0; n < 32; ++n) {
            float imp = 0.f;
#pragma unroll 1
            for (int j = -1; j <= 3; ++j) {
                const int c = 4 * n + j;
                if (c >= 0 && c < ncv) {
                    const float s = dot32p(q, kc + c * 64) - slope * (float)(t - (16 * c + 31));
                    const float pp = __expf(s - mx) * inv;
                    imp += (j == -1 || j == 3) ? 0.5f * pp : pp;
                }
            }
            if (hf == 0) imph[(size_t)idx * 32 + n] = imp;
        }
    }
}
__device__ __forceinline__ void nsa_select(const unsigned char* ws, unsigned* maskbuf) {
    const float* imph = (const float*)(ws + WS_IMPH);
    const int tid_ = TID(); const int lane = tid_ & 63, gw = BID() * 4 + (tid_ >> 6), ngw = gridDim.x * 4;
    for (int it = gw; it < NB * 2 * NS / 2; it += ngw) {
        const int item = it * 2 + (lane >> 5), t = item & 2047, bg = item >> 11, n = lane & 31;
        float imp = 0.f;
#pragma unroll
        for (int r = 0; r < 4; ++r) imp += imph[((size_t)(bg * 4 + r) * NS + t) * 32 + n];
        const int cur = t >> 6;
        const bool valid = n <= cur;
        const bool forced = (n == 0) || (cur - n < 2);
        const float score = valid ? imp + (forced ? 1e4f : 0.f) : -1e30f;
        int rank = 0;
        for (int m = 0; m < 32; ++m) {
            const float sm = __shfl(score, (lane & 32) | m);
            rank += (sm > score || (sm == score && m < n)) ? 1 : 0;
        }
        const bool sel = valid && rank < 16;
        const unsigned long long bal = __ballot(sel);
        if (n == 0) maskbuf[item] = (lane >> 5) ? (unsigned)(bal >> 32) : (unsigned)bal;
    }
}
__device__ __forceinline__ void nsa_attn_naive(const unsigned char* ws, int gtid, int gthreads) {
    asm volatile("" : "+v"(gtid));
    const bf16_t* qb = (const bf16_t*)(ws + WS_QB);
    const bf16_t* kcmp = (const bf16_t*)(ws + WS_KCMP); const bf16_t* vcmp = kcmp + (size_t)16 * 128 * 64;
    const bf16_t* ksb = (const bf16_t*)(ws + WS_KV6 + 2 * 4 * MiB); const bf16_t* vsb = (const bf16_t*)(ws + WS_KV6 + 3 * 4 * MiB);
    const bf16_t* kwb = (const bf16_t*)(ws + WS_KV6 + 4 * 4 * MiB); const bf16_t* vwb = (const bf16_t*)(ws + WS_KV6 + 5 * 4 * MiB);
    const float* gates = (const float*)(ws + WS_GATES);
    const unsigned* maskbuf = (const unsigned*)(ws + WS_MASK);
    bf16_t* ob = (bf16_t*)(ws + WS_O);
    for (int id2 = gtid; id2 < NB * 8 * NS * 2; id2 += gthreads) {
        const int idx = id2 >> 1, hf = (id2 & 1) * 32;
        const int t = idx & 2047, bh = idx >> 11, hb = bh & 7, b = bh >> 3, g = hb >> 2, bg = b * 2 + g;
        float q[32]; load_q32(qb + (size_t)idx * 64 + hf, q);
        const float slope = exp2f(-(float)(hb + 1));
        const float* gt = gates + (size_t)(b * NS + t) * 24 + hb * 3;
        float tot[32], acc[32];
#pragma unroll
        for (int i = 0; i < 32; ++i) tot[i] = 0.f;
        {
            const bf16_t* kc = kcmp + (size_t)bg * 128 * 64 + hf; const bf16_t* vc = vcmp + (size_t)bg * 128 * 64 + hf;
            const int ncv = t >= 31 ? ((t - 31) >> 4) + 1 : 0;
            if (ncv > 0) {
                float mx = -1e30f, l = 0.f;
#pragma unroll
                for (int i = 0; i < 32; ++i) acc[i] = 0.f;
#pragma unroll 1
                for (int c = 0; c < ncv; ++c) { const float s = dot32p(q, kc + c * 64) - slope * (float)(t - (16 * c + 31)); ONLINE_STEP(s, vc + c * 64); }
                const float sc = gt[0] / l;
#pragma unroll
                for (int i = 0; i < 32; ++i) tot[i] += sc * acc[i];
            }
        }
        {
            const bf16_t* kb = ksb + (size_t)bg * NS * 64 + hf; const bf16_t* vb = vsb + (size_t)bg * NS * 64 + hf;
            const unsigned mask = maskbuf[bg * NS + t];
            float mx = -1e30f, l = 0.f;
#pragma unroll
            for (int i = 0; i < 32; ++i) acc[i] = 0.f;
#pragma unroll 1
            for (int n = 0; n < 32; ++n) {
                if (!((mask >> n) & 1u)) continue;
#pragma unroll 1
                for (int i = 0; i < 64; ++i) {
                    const int pos = n * 64 + i;
                    if (pos > t) break;
                    const float s = dot32p(q, kb + (size_t)pos * 64) - slope * (float)(t - pos);
                    ONLINE_STEP(s, vb + (size_t)pos * 64);
                }
            }
            const float sc = gt[1] / l;
#pragma unroll
            for (int i = 0; i < 32; ++i) tot[i] += sc * acc[i];
        }
        {
            const bf16_t* kb = kwb + (size_t)bg * NS * 64 + hf; const bf16_t* vb = vwb + (size_t)bg * NS * 64 + hf;
            float mx = -1e30f, l = 0.f;
#pragma unroll
            for (int i = 0; i < 32; ++i) acc[i] = 0.f;
#pragma unroll 1
            for (int dist = 0; dist < 512; ++dist) {
                const int pos = t - dist;
                if (pos < 0) break;
                const float s = dot32p(q, kb + (size_t)pos * 64) - slope * (float)dist;
                ONLINE_STEP(s, vb + (size_t)pos * 64);
            }
            const float sc = gt[2] / l;
#pragma unroll
            for (int i = 0; i < 32; ++i) tot[i] += sc * acc[i];
        }
        store_o32(ob + ((size_t)(b * NS + t) * ND + 512 + hb * 64 + hf), tot, 1.0f);
    }
}

constexpr int KVS = 144;
constexpr int KVT = 64 * KVS;
#define LOG2E_F 1.4426950408889634f
__device__ __forceinline__ unsigned cvtpk(float lo, float hi) { f32x2_t v = {lo, hi}; bf16x2_t b = __builtin_convertvector(v, bf16x2_t); return __builtin_bit_cast(unsigned, b); }
__device__ __forceinline__ s16x4 vtr(LAS const unsigned char* p) { return __builtin_bit_cast(s16x4, __builtin_amdgcn_ds_read_tr16_b64_v4i16((LAS s16x4*)p)); }
__device__ __forceinline__ f32x16 zero16() { f32x16 z;
#pragma unroll
    for (int i = 0; i < 16; ++i) z[i] = 0.f;
    return z; }

__device__ __forceinline__ void load_kv_tile(LAS unsigned char* Kt, LAS unsigned char* Vt, const bf16_t* kbase, const bf16_t* vbase, int row0, int rstride, int rmin, int rmax, int tid) {
    const int j = tid >> 2, ch = tid & 3;
    int tok = row0 + j * rstride; tok = tok < rmin ? rmin : (tok > rmax ? rmax : tok);
    const u32x4* kp = (const u32x4*)(kbase + (size_t)tok * 64);
    const u32x4* vp = (const u32x4*)(vbase + (size_t)tok * 64);
    const u32x4 k0 = kp[ch], k1 = kp[ch + 4], v0 = vp[ch], v1 = vp[ch + 4];
    *(LAS u32x4*)(Kt + j * KVS + ch * 16) = k0; *(LAS u32x4*)(Kt + j * KVS + (ch + 4) * 16) = k1;
    *(LAS u32x4*)(Vt + j * KVS + ch * 16) = v0; *(LAS u32x4*)(Vt + j * KVS + (ch + 4) * 16) = v1;
}

struct KVRegs { u32x4 k0, k1, v0, v1; };
__device__ __forceinline__ void kv_fetch(KVRegs& r, const bf16_t* kbase, const bf16_t* vbase, int row0, int rstride, int rmin, int rmax, int tid) {
    const int j = tid >> 2, ch = tid & 3;
    int tok = row0 + j * rstride; tok = tok < rmin ? rmin : (tok > rmax ? rmax : tok);
    const u32x4* kp = (const u32x4*)(kbase + (size_t)tok * 64);
    const u32x4* vp = (const u32x4*)(vbase + (size_t)tok * 64);
    r.k0 = kp[ch]; r.k1 = kp[ch + 4]; r.v0 = vp[ch]; r.v1 = vp[ch + 4];
}
__device__ __forceinline__ void kv_commit(const KVRegs& r, LAS unsigned char* Kt, LAS unsigned char* Vt, int tid) {
    const int j = tid >> 2, ch = tid & 3;
    *(LAS u32x4*)(Kt + j * KVS + ch * 16) = r.k0; *(LAS u32x4*)(Kt + j * KVS + (ch + 4) * 16) = r.k1;
    *(LAS u32x4*)(Vt + j * KVS + ch * 16) = r.v0; *(LAS u32x4*)(Vt + j * KVS + (ch + 4) * 16) = r.v1;
}
__device__ __forceinline__ void pv32(f32x16& o0, f32x16& o1, const f32x16& sv, LAS const unsigned char* vp  ) {
#pragma unroll
    for (int s16 = 0; s16 < 2; ++s16) {
        u32x4 pw;
        pw.x = cvtpk(sv[8 * s16 + 0], sv[8 * s16 + 1]); pw.y = cvtpk(sv[8 * s16 + 2], sv[8 * s16 + 3]);
        pw.z = cvtpk(sv[8 * s16 + 4], sv[8 * s16 + 5]); pw.w = cvtpk(sv[8 * s16 + 6], sv[8 * s16 + 7]);
        const bf16x8 pf = __builtin_bit_cast(bf16x8, pw);
        LAS const unsigned char* vr = vp + s16 * 16 * KVS;
        const s16x4 a0 = vtr(vr), b0 = vtr(vr + 8 * KVS), a1 = vtr(vr + 64), b1 = vtr(vr + 8 * KVS + 64);
        const bf16x8 vf0 = {a0[0], a0[1], a0[2], a0[3], b0[0], b0[1], b0[2], b0[3]};
        const bf16x8 vf1 = {a1[0], a1[1], a1[2], a1[3], b1[0], b1[1], b1[2], b1[3]};
        o0 = __builtin_amdgcn_mfma_f32_32x32x16_bf16(vf0, pf, o0, 0, 0, 0);
        o1 = __builtin_amdgcn_mfma_f32_32x32x16_bf16(vf1, pf, o1, 0, 0, 0);
    }
}
__device__ __forceinline__ f32x16 qk32(const bf16x8* qf, LAS const unsigned char* kp  , f32x16 s  ) {
#pragma unroll
    for (int k = 0; k < 4; ++k) {
        const bf16x8 kf = *(const LAS bf16x8*)(kp + 32 * k);
        s = __builtin_amdgcn_mfma_f32_32x32x16_bf16(kf, qf[k], s, 0, 0, 0);
    }
    return s;
}
template <int KS, bool TRY_FULL>
__device__ __forceinline__ void fa_tile64(f32x16& o0, f32x16& o1, float& m, float& l, const bf16x8* qf, LAS const unsigned char* Kt, LAS const unsigned char* Vt, int lane, float dA, float wmax, float ns2) {
    const int r = lane & 31, h = lane >> 5;
    LAS const unsigned char* kp = Kt + r * KVS + 16 * h;
    const float dAh = dA - (float)(KS * 4 * h);
    const float hi = dAh, lo = dAh - wmax, base = ns2 * dAh;
    f32x16 s0, s1;
#pragma unroll
    for (int i = 0; i < 16; ++i) {
        const float c0 = (float)(KS * ((i & 3) + 8 * (i >> 2))), c1 = c0 + (float)(32 * KS);
        s0[i] = fmaf(-c0, ns2, base); s1[i] = fmaf(-c1, ns2, base);
    }
    s0 = qk32(qf, kp, s0); s1 = qk32(qf, kp + 32 * KVS, s1);
    float tmax = -1e30f;
    if (TRY_FULL && __all(lo <= 0.f && hi >= (float)(59 * KS))) {
#pragma unroll
        for (int i = 0; i < 16; ++i) tmax = fmaxf(tmax, fmaxf(s0[i], s1[i]));
    } else {
#pragma unroll
        for (int i = 0; i < 16; ++i) {
            const float c0 = (float)(KS * ((i & 3) + 8 * (i >> 2))), c1 = c0 + (float)(32 * KS);
            const float t0 = (c0 >= lo && c0 <= hi) ? s0[i] : -1e30f;
            const float t1 = (c1 >= lo && c1 <= hi) ? s1[i] : -1e30f;
            s0[i] = t0; s1[i] = t1;
            tmax = fmaxf(tmax, fmaxf(t0, t1));
        }
    }
    tmax = fmaxf(tmax, __shfl_xor(tmax, 32));
    const float mn = fmaxf(m, tmax);
    const float corr = __builtin_amdgcn_exp2f(m - mn);
    m = mn;
    const float mu = fmaxf(mn, -1e29f);
    float ps = 0.f;
#pragma unroll
    for (int i = 0; i < 16; ++i) {
        s0[i] = __builtin_amdgcn_exp2f(s0[i] - mu); s1[i] = __builtin_amdgcn_exp2f(s1[i] - mu);
        ps += s0[i] + s1[i];
    }
    l = l * corr + ps;
    if (!__all(corr == 1.0f)) {
#pragma unroll
        for (int i = 0; i < 16; ++i) { o0[i] *= corr; o1[i] *= corr; }
    }
    LAS const unsigned char* vp = Vt + (4 * h + ((lane & 15) >> 2)) * KVS + (16 * ((lane >> 4) & 1) + 4 * (lane & 3)) * 2;
    pv32(o0, o1, s0, vp);
    pv32(o0, o1, s1, vp + 32 * KVS);
}
__device__ __forceinline__ void acc_scaled(f32x16& t0, f32x16& t1, const f32x16& o0, const f32x16& o1, float sc) {
#pragma unroll
    for (int i = 0; i < 16; ++i) { t0[i] += sc * o0[i]; t1[i] += sc * o1[i]; }
}
__device__ __forceinline__ void store_ot(bf16_t* orow, const f32x16& o0, const f32x16& o1, float sc, int h) {
#pragma unroll
    for (int u = 0; u < 4; ++u) {
        u32x2 w0, w1;
        w0.x = cvtpk(o0[4 * u] * sc, o0[4 * u + 1] * sc); w0.y = cvtpk(o0[4 * u + 2] * sc, o0[4 * u + 3] * sc);
        w1.x = cvtpk(o1[4 * u] * sc, o1[4 * u + 1] * sc); w1.y = cvtpk(o1[4 * u + 2] * sc, o1[4 * u + 3] * sc);
        *(u32x2*)(orow + 8 * u + 4 * h) = w0;
        *(u32x2*)(orow + 32 + 8 * u + 4 * h) = w1;
    }
}
__device__ __forceinline__ void load_qf(bf16x8* qf, const bf16_t* qrow, int h) {
#pragma unroll
    for (int k = 0; k < 4; ++k) qf[k] = *(const bf16x8*)(qrow + 16 * k + 8 * h);
}

__device__ __forceinline__ void dil_item(unsigned char* ws, int item, LAS unsigned char* lds) {
    const int tid = TID(), lane = tid & 63, w = tid >> 6, c = lane & 31, h = lane >> 5;
    const int bh = item / 48, rem = item % 48, pat = rem >> 4, idx = rem & 15;
    const int dil = pat == 0 ? 1 : (pat == 1 ? 4 : 16), nqt = 16 / dil, res = idx / nqt, qt = idx % nqt;
    const int hd = bh & 7, b = bh >> 3;
    const int q0 = qt * 128 + 32 * w, iq = q0 + c, t = res + iq * dil;
    const bf16_t* qa = (const bf16_t*)(ws + WS_QA) + (size_t)bh * NS * 64;
    const bf16_t* ka = (const bf16_t*)(ws + WS_KA) + (size_t)bh * NS * 64;
    const bf16_t* va = (const bf16_t*)(ws + WS_VA) + (size_t)bh * NS * 64;
    bf16x8 qf[4]; load_qf(qf, qa + (size_t)t * 64, h);
    const float ns2 = -exp2f(-((float)hd + 0.5f)) * (float)dil * LOG2E_F;
    f32x16 o0 = zero16(), o1 = zero16(); float m = -1e30f, l = 0.f;
    {
        const int T0 = qt == 0 ? 2 : 0;
        KVRegs kr; kv_fetch(kr, ka, va, res + (qt * 128 - 128 + 64 * T0) * dil, dil, 0, NS - 1, tid);
        int buf = 0;
        for (int T = T0; T < 4; ++T) {
            const int kb = qt * 128 - 128 + 64 * T;
            LAS unsigned char* Kt = lds + buf * KVT; LAS unsigned char* Vt = lds + 2 * KVT + buf * KVT;
            kv_commit(kr, Kt, Vt, tid);
            __syncthreads();
            if (T + 1 < 4) kv_fetch(kr, ka, va, res + (kb + 64) * dil, dil, 0, NS - 1, tid);
            if (kb <= q0 + 31 && kb + 63 >= q0 - 128)
                fa_tile64<1, true>(o0, o1, m, l, qf, Kt, Vt, lane, (float)(iq - kb), 128.f, ns2);
            buf ^= 1;
        }
    }
    const float lt = l + __shfl_xor(l, 32);
    bf16_t* op = (bf16_t*)(pat < 2 ? ws + WS_OPA01 + (size_t)pat * 16 * MiB : ws + WS_OPA2);
    store_ot(op + ((size_t)(b * NS + t) * 512 + hd * 64), o0, o1, 1.0f / lt, h);
    if (h == 0) { float* st = (float*)(ws + WS_STA) + ((size_t)pat * NB * 8 * NS + (size_t)bh * NS + t) * 2; st[0] = m; st[1] = lt; }
}
__device__ __forceinline__ void dil_merge(unsigned char* ws, int gtid, int gthreads) {
    asm volatile("" : "+v"(gtid));
    const float* sta = (const float*)(ws + WS_STA);
    bf16_t* ob = (bf16_t*)(ws + WS_O);
    for (int it = gtid; it < NT * 8 * 8; it += gthreads) {
        const int ch = it & 7, hd = (it >> 3) & 7, tk = it >> 6, b = tk >> 11, t = tk & 2047;
        float mm[3], ll[3];
#pragma unroll
        for (int p = 0; p < 3; ++p) { const float* s = sta + ((size_t)p * NB * 8 * NS + (size_t)(b * 8 + hd) * NS + t) * 2; mm[p] = s[0]; ll[p] = s[1]; }
        const float M = fmaxf(mm[0], fmaxf(mm[1], mm[2]));
        float wgt[3], den = 0.f;
#pragma unroll
        for (int p = 0; p < 3; ++p) { wgt[p] = __builtin_amdgcn_exp2f(mm[p] - M) * ll[p]; den += wgt[p]; }
        const float inv = 1.0f / den;
        float a[8];
#pragma unroll
        for (int i = 0; i < 8; ++i) a[i] = 0.f;
#pragma unroll
        for (int p = 0; p < 3; ++p) {
            const bf16_t* op = (const bf16_t*)(p < 2 ? ws + WS_OPA01 + (size_t)p * 16 * MiB : ws + WS_OPA2);
            const u32x4 v = *(const u32x4*)(op + (size_t)tk * 512 + hd * 64 + ch * 8);
            const float wp = wgt[p] * inv;
            a[0] += wp * bflo(v.x); a[1] += wp * bfhi(v.x); a[2] += wp * bflo(v.y); a[3] += wp * bfhi(v.y);
            a[4] += wp * bflo(v.z); a[5] += wp * bfhi(v.z); a[6] += wp * bflo(v.w); a[7] += wp * bfhi(v.w);
        }
        u32x4 o; o.x = pk2(a[0], a[1]); o.y = pk2(a[2], a[3]); o.z = pk2(a[4], a[5]); o.w = pk2(a[6], a[7]);
        *(u32x4*)(ob + (size_t)tk * ND + hd * 64 + ch * 8) = o;
    }
}

constexpr int LDS_IMP = 4 * KVT;
constexpr int LDS_UNI = LDS_IMP + 4096;
__device__ __forceinline__ void nsa_item(unsigned char* ws, int item, LAS unsigned char* lds) {
    const int tid = TID(), lane = tid & 63, w = tid >> 6, c = lane & 31, h = lane >> 5;
    const int bg = item & 15, tt = item >> 4, b = bg >> 1, g = bg & 1;
    const int t0 = tt * 32, tok8 = c & 7, hh = c >> 3, hb = g * 4 + hh, t = t0 + 8 * w + tok8;
    const bf16_t* qrow = (const bf16_t*)(ws + WS_QB) + ((size_t)(b * 8 + hb) * NS + t) * 64;
    bf16x8 qf[4]; load_qf(qf, qrow, h);
    const float ns2 = -exp2f(-(float)(hb + 1)) * LOG2E_F;
    const float* gt = (const float*)(ws + WS_GATES) + (size_t)(b * NS + t) * 24 + hb * 3;
    const float g0 = gt[0], g1 = gt[1], g2 = gt[2];
    f32x16 tot0 = zero16(), tot1 = zero16();
    LAS unsigned char* Kt = lds; LAS unsigned char* Vt = lds + 2 * KVT;
    LAS float* impL = (LAS float*)(lds + LDS_IMP) + w * 256;
    LAS unsigned* uni = (LAS unsigned*)(lds + LDS_UNI);
    const int cur = t0 >> 6;
    unsigned selmask;
    {
        const bf16_t* kc = (const bf16_t*)(ws + WS_KCMP) + (size_t)bg * 128 * 64;
        const bf16_t* vc = kc + (size_t)16 * 128 * 64;
        __syncthreads();
        load_kv_tile(Kt, Vt, kc, vc, 0, 1, 0, 127, tid);
        load_kv_tile(Kt + KVT, Vt + KVT, kc, vc, 64, 1, 0, 127, tid);
        if (tid == 0) uni[0] = 0u;
        __syncthreads();
        LAS const unsigned char* kp = Kt + c * KVS + 16 * h;
        f32x16 sT[4];
#pragma unroll
        for (int T = 0; T < 4; ++T) sT[T] = qk32(qf, kp + T * 32 * KVS, zero16());
        const float dAh = (float)(t - 31) - (float)(64 * h);
        float tmax = -1e30f;
#pragma unroll
        for (int T = 0; T < 4; ++T)
#pragma unroll
            for (int i = 0; i < 16; ++i) {
                const float d = dAh - (float)(16 * (32 * T + (i & 3) + 8 * (i >> 2)));
                float tv = sT[T][i] + ns2 * d;
                tv = d >= 0.f ? tv : -1e30f;
                sT[T][i] = tv; tmax = fmaxf(tmax, tv);
            }
        tmax = fmaxf(tmax, __shfl_xor(tmax, 32));
        const float mu = fmaxf(tmax, -1e29f);
        float ps = 0.f;
#pragma unroll
        for (int T = 0; T < 4; ++T)
#pragma unroll
            for (int i = 0; i < 16; ++i) { sT[T][i] = __builtin_amdgcn_exp2f(sT[T][i] - mu); ps += sT[T][i]; }
        ps += __shfl_xor(ps, 32);
        const float inv = ps > 0.f ? 1.0f / ps : 0.f;
#pragma unroll
        for (int T = 0; T < 4; ++T)
#pragma unroll
            for (int i = 0; i < 16; ++i) sT[T][i] *= inv;
        f32x16 o0 = zero16(), o1 = zero16();
        LAS const unsigned char* vp = Vt + (4 * h + ((lane & 15) >> 2)) * KVS + (16 * ((lane >> 4) & 1) + 4 * (lane & 3)) * 2;
#pragma unroll
        for (int T = 0; T < 4; ++T) pv32(o0, o1, sT[T], vp + T * 32 * KVS);
        acc_scaled(tot0, tot1, o0, o1, g0);
        float mainv[16], spill[16];
#pragma unroll
        for (int T = 0; T < 4; ++T)
#pragma unroll
            for (int u = 0; u < 4; ++u) {
                const float p3 = 0.5f * sT[T][4 * u + 3];
                mainv[4 * T + u] = sT[T][4 * u] + sT[T][4 * u + 1] + sT[T][4 * u + 2] + p3;
                spill[4 * T + u] = p3;
            }
#pragma unroll
        for (int f = 0; f < 16; ++f) {
            mainv[f] += __shfl_xor(mainv[f], 8); mainv[f] += __shfl_xor(mainv[f], 16);
            spill[f] += __shfl_xor(spill[f], 8); spill[f] += __shfl_xor(spill[f], 16);
        }
#pragma unroll
        for (int f = 0; f < 16; ++f) {
            const float snd = h ? (f > 0 ? spill[f > 0 ? f - 1 : 0] : 0.f) : spill[f];
            const float rcv = __shfl_xor(snd, 32);
            mainv[f] += rcv;
        }
        if (hh == 0) {
#pragma unroll
            for (int f = 0; f < 16; ++f) impL[tok8 * 32 + 2 * f + h] = mainv[f];
        }
        asm volatile("s_waitcnt lgkmcnt(0)" ::: "memory");
        {
            const int tk = lane >> 3, tq = t0 + 8 * w + tk, cq = tq >> 6, n0 = 4 * (lane & 7);
            float sc[32];
#pragma unroll
            for (int q4 = 0; q4 < 8; ++q4) {
                const f32x4 v = *(const LAS f32x4*)(impL + tk * 32 + 4 * q4);
                sc[4 * q4] = v.x; sc[4 * q4 + 1] = v.y; sc[4 * q4 + 2] = v.z; sc[4 * q4 + 3] = v.w;
            }
#pragma unroll
            for (int n = 0; n < 32; ++n) {
                const bool valid = n <= cq, forced = (n == 0) || (cq - n < 2);
                sc[n] = valid ? sc[n] + (forced ? 1e4f : 0.f) : -1e30f;
            }
            unsigned bits = 0u;
#pragma unroll
            for (int k = 0; k < 4; ++k) {
                const int n = n0 + k;
                float mine = 0.f;
#pragma unroll
                for (int q = 0; q < 32; ++q) mine = (q == n) ? sc[q] : mine;
                int rank = 0;
#pragma unroll
                for (int q = 0; q < 32; ++q) rank += (sc[q] > mine || (sc[q] == mine && q < n)) ? 1 : 0;
                if (n <= cq && rank < 16) bits |= 1u << n;
            }
            bits |= __shfl_xor(bits, 1); bits |= __shfl_xor(bits, 2); bits |= __shfl_xor(bits, 4);
            selmask = __shfl(bits, tok8 * 8);
        }
        {
            unsigned um = selmask;
#pragma unroll
            for (int o = 1; o < 64; o <<= 1) um |= __shfl_xor(um, o);
            if (lane == 0) atomicOr((unsigned*)uni, um);
        }
        __syncthreads();
    }
    const unsigned ublk = uni[0];
    unsigned wsel = selmask;
#pragma unroll
    for (int o = 1; o < 64; o <<= 1) wsel |= __shfl_xor(wsel, o);
    int buf = 0;
    {
        const bf16_t* kb = (const bf16_t*)(ws + WS_KV6 + 2 * 4 * MiB) + (size_t)bg * NS * 64;
        const bf16_t* vb = (const bf16_t*)(ws + WS_KV6 + 3 * 4 * MiB) + (size_t)bg * NS * 64;
        f32x16 o0 = zero16(), o1 = zero16(); float m = -1e30f, l = 0.f;
        unsigned rem = ublk & (cur >= 31 ? 0xffffffffu : ((2u << cur) - 1u));
        while (rem) {
            const int n = __builtin_ctz(rem);
            rem &= rem - 1u;
            LAS unsigned char* Kc = lds + buf * KVT; LAS unsigned char* Vc = lds + 2 * KVT + buf * KVT;
            load_kv_tile(Kc, Vc, kb, vb, 64 * n, 1, 0, NS - 1, tid);
            __syncthreads();
            if ((wsel >> n) & 1u)
                fa_tile64<1, true>(o0, o1, m, l, qf, Kc, Vc, lane, (float)(t - 64 * n), ((selmask >> n) & 1u) ? 1e30f : -1.f, ns2);
            buf ^= 1;
        }
        const float lt = l + __shfl_xor(l, 32);
        acc_scaled(tot0, tot1, o0, o1, g1 / lt);
    }
    {
        const bf16_t* kb = (const bf16_t*)(ws + WS_KV6 + 4 * 4 * MiB) + (size_t)bg * NS * 64;
        const bf16_t* vb = (const bf16_t*)(ws + WS_KV6 + 5 * 4 * MiB) + (size_t)bg * NS * 64;
        f32x16 o0 = zero16(), o1 = zero16(); float m = -1e30f, l = 0.f;
        const int nlo = t0 >= 511 ? (t0 - 511) >> 6 : 0;
        for (int n = nlo; n <= cur; ++n) {
            LAS unsigned char* Kc = lds + buf * KVT; LAS unsigned char* Vc = lds + 2 * KVT + buf * KVT;
            load_kv_tile(Kc, Vc, kb, vb, 64 * n, 1, 0, NS - 1, tid);
            __syncthreads();
            fa_tile64<1, true>(o0, o1, m, l, qf, Kc, Vc, lane, (float)(t - 64 * n), 511.f, ns2);
            buf ^= 1;
        }
        const float lt = l + __shfl_xor(l, 32);
        acc_scaled(tot0, tot1, o0, o1, g2 / lt);
    }
    store_ot((bf16_t*)(ws + WS_O) + ((size_t)(b * NS + t) * ND + 512 + hb * 64), tot0, tot1, 1.0f, h);
}

#define XB_TMO      128
#define XB_XCNT(j)  (256  + 64 * (j))
#define XB_XSUB(j)  (1280 + 64 * (j))
#define XB_XGEN(j)  (2304 + 64 * (j))
#define XB_TOP      3328
#define XB_TOPGEN   3392
#define XCD_BAR_WORDS 3456
#define XB_SPIN_CAP (1u << 18)
__device__ __forceinline__ unsigned xb_ld(unsigned* p)              { return __hip_atomic_load(p, __ATOMIC_RELAXED, __HIP_MEMORY_SCOPE_AGENT); }
__device__ __forceinline__ unsigned xb_add(unsigned* p, unsigned v) { return __hip_atomic_fetch_add(p, v, __ATOMIC_RELAXED, __HIP_MEMORY_SCOPE_AGENT); }
__device__ __forceinline__ unsigned xb_xcc_id() { return (unsigned)__builtin_amdgcn_s_getreg((3 << 11) | 20) & 0xFu; }
#define XB_SPIN(cond, bar) do { unsigned _sp = 0; while (cond) { __builtin_amdgcn_s_sleep(1); \
    if ((++_sp & 255u) == 0u) { if (xb_ld(&(bar)[XB_TMO])) break; if (_sp > XB_SPIN_CAP) { atomicAdd(&(bar)[XB_TMO], 1u); break; } } } } while (0)
struct XcdBarrier { unsigned* bar; unsigned x; volatile LAS unsigned* st; };
__device__ __forceinline__ XcdBarrier xcd_barrier_post(unsigned* bar, volatile LAS unsigned* st) {
    XcdBarrier b; b.bar = bar; b.x = xb_xcc_id(); b.st = st;
    if (threadIdx.x == 0) (void)xb_add(&bar[XB_XCNT(b.x)], 1u);
    return b;
}
__device__ __forceinline__ void xcd_barrier_complete(unsigned* bar, unsigned x, unsigned& nloc, unsigned& nx) {
    const unsigned G = gridDim.x * gridDim.y * gridDim.z;
    unsigned sum, cnt, mine, sp = 0u;
    for (;;) {
        sum = 0u; cnt = 0u; mine = 0u;
#pragma unroll
        for (unsigned j = 0; j < 16; ++j) { const unsigned c = xb_ld(&bar[XB_XCNT(j)]); sum += c; cnt += (c > 0u) ? 1u : 0u; mine = (j == x) ? c : mine; }
        if (sum == G) break;
        __builtin_amdgcn_s_sleep(1);
        if ((++sp & 255u) == 0u) { if (xb_ld(&bar[XB_TMO])) break; if (sp > XB_SPIN_CAP) { atomicAdd(&bar[XB_TMO], 1u); break; } }
    }
    nloc = mine > 0u ? mine : 1u; nx = cnt > 0u ? cnt : 1u;
}
__device__ __forceinline__ void xcd_barrier(const XcdBarrier& b) {
    asm volatile("s_waitcnt vmcnt(0)" ::: "memory");
    __syncthreads();
    if (threadIdx.x == 0) {
        unsigned* bar = b.bar;
        __builtin_amdgcn_s_waitcnt(0);
        unsigned nloc = b.st[0], nx = b.st[1];
        if (nloc == 0u) { xcd_barrier_complete(bar, b.x, nloc, nx); b.st[0] = nloc; b.st[1] = nx; }
        const unsigned old = xb_add(&bar[XB_XSUB(b.x)], 1u);
        const unsigned gen = old / nloc;
        if (old + 1u == (gen + 1u) * nloc) {
            __builtin_amdgcn_fence(__ATOMIC_RELEASE, "agent");
            asm volatile("s_waitcnt vmcnt(0)" ::: "memory");
            const unsigned og = xb_add(&bar[XB_TOP], 1u);
            const unsigned tg = og / nx;
            if (og + 1u == (tg + 1u) * nx) xb_add(&bar[XB_TOPGEN], 1u);
            else XB_SPIN(xb_ld(&bar[XB_TOPGEN]) == tg, bar);
            __builtin_amdgcn_fence(__ATOMIC_ACQUIRE, "agent");
            xb_add(&bar[XB_XGEN(b.x)], 1u);
            asm volatile("s_waitcnt vmcnt(0)" ::: "memory");
        } else {
            XB_SPIN(xb_ld(&bar[XB_XGEN(b.x)]) == gen, bar);
            __builtin_amdgcn_fence(__ATOMIC_ACQUIRE, "agent");
            asm volatile("s_waitcnt vmcnt(0)" ::: "memory");
        }
    }
    __syncthreads();
}

struct XcdTiles {
    int m_lo, cnt_m, nN, loc, nloc, tiles;
    __device__ __forceinline__ XcdTiles(int nM, int nN_) {
        const int b = BID(), g = gridDim.x;
        int x, nx;
        if ((g & 7) == 0) { x = b & 7; nx = 8; loc = b >> 3; nloc = g >> 3; } else { x = 0; nx = 1; loc = b; nloc = g; }
        m_lo = (int)((long)nM * x / nx); cnt_m = (int)((long)nM * (x + 1) / nx) - m_lo; nN = nN_; tiles = cnt_m * nN;
    }
    __device__ __forceinline__ void get(int q, int& mt, int& nt) const {
        const int mg = q / (8 * nN), rem_m = cnt_m - 8 * mg, mig = rem_m < 8 ? rem_m : 8, r = q - mg * 8 * nN;
        nt = r / mig; mt = m_lo + 8 * mg + (r - nt * mig);
    }
};
struct PhInProj { const bf16_t* xn; const unsigned char* wl; unsigned char* ws; const float* ssp; XcdTiles xt;
    __device__ __forceinline__ void make(int q, APlain& ap, BPlain& bp, EpiInProj& ep) const { int mt, nt; xt.get(q, mt, nt);
        ap = APlain{xn + (size_t)mt * 128 * ND, ND}; bp = BPlain{(const bf16_t*)(wl + WL_IN) + (size_t)nt * 128 * ND, ND}; ep = EpiInProj{mt, nt, ws, ssp}; } };
struct PhCmp1 { const unsigned char* wl; unsigned char* ws; int l;
    __device__ __forceinline__ void make(int tile, ACmp& ap, BPlain& bp, EpiCmp1& ep) const { const int nt = tile & 1, bg = (tile >> 1) & 15, kv = tile >> 5;
        ap = ACmp{(const bf16_t*)(ws + WS_KV6 + (size_t)kv * 4 * MiB) + (size_t)bg * NS * 64};
        bp = BPlain{(const bf16_t*)(wl + WL_C1) + (size_t)kv * 256 * 2048 + (size_t)nt * 128 * 2048, 2048};
        ep = EpiCmp1{(bf16_t*)(ws + WS_HC) + (size_t)kv * 2048 * 256, (const float*)(ws + WS_BC1P) + l * 512 + kv * 256, bg * 128, nt * 128}; } };
struct PhCmp2 { const unsigned char* wl; unsigned char* ws;
    __device__ __forceinline__ void make(int tile, APlain& ap, BPlain& bp, EpiCmp2& ep) const { const int bg = tile & 15, kv = tile >> 4;
        ap = APlain{(const bf16_t*)(ws + WS_HC) + (size_t)kv * 2048 * 256 + (size_t)bg * 128 * 256, 256};
        bp = BPlain{(const bf16_t*)(wl + WL_C2) + (size_t)kv * 128 * 256, 256};
        ep = EpiCmp2{(bf16_t*)(ws + WS_KCMP) + (size_t)kv * 16 * 128 * 64, bg * 128}; } };
struct PhOutProj { const unsigned char* wl; unsigned char* ws; bf16_t* res; XcdTiles xt;
    __device__ __forceinline__ void make(int q, APlain& ap, BPlain& bp, EpiResAdd& ep) const { int mt, nt; xt.get(q, mt, nt);
        ap = APlain{(const bf16_t*)(ws + WS_O) + (size_t)mt * 128 * ND, ND}; bp = BPlain{(const bf16_t*)(wl + WL_OUT) + (size_t)nt * 128 * ND, ND};
        ep = EpiResAdd{res, mt * 128, nt * 128}; } };
struct PhMoe {
    LAS const int* sm; const int* list;
    __device__ __forceinline__ void decode(int gmt, int& bk, int& mt, int& rem, int& hrow0, int& elo, int& ehi) const {
        bk = 0;
        for (int k = 1; k < 24; ++k) if (gmt >= sm[32 + k]) bk = k;
        mt = gmt - sm[32 + bk]; rem = sm[bk] - mt * 128; hrow0 = sm[64 + bk] + mt * 128;
        const int grp = bk / 6, pi = bk % 6;
        elo = grp * 4 + (pi < 3 ? 0 : (pi < 5 ? 1 : 2)); ehi = grp * 4 + (pi < 3 ? pi + 1 : (pi < 5 ? pi - 1 : 3));
    } };
struct PhMoeGU { PhMoe m; const bf16_t* xn; const unsigned char* wl; unsigned char* ws; const float* route; const float* rinv; XcdTiles xt;
    __device__ __forceinline__ void make(int q, AGather& ap, BPlain& bp, EpiMoeGU& ep) const { int gmt, nt16; xt.get(q, gmt, nt16);
        int bk, mt, rem, hrow0, elo, ehi; m.decode(gmt, bk, mt, rem, hrow0, elo, ehi);
        const int* lst = m.list + (size_t)bk * NT + mt * 128; const int e = (nt16 >> 3) ? ehi : elo;
        ap = AGather{xn, lst, rem}; bp = BPlain{(const bf16_t*)(wl + WL_GU) + (size_t)e * 1024 * 1024 + (size_t)(nt16 & 7) * 128 * 1024, 1024};
        ep = EpiMoeGU{(bf16_t*)(ws + WS_HID), lst, route, rinv, rem, hrow0, nt16}; } };
struct PhMoeDown { PhMoe m; const unsigned char* wl; unsigned char* ws; bf16_t* res; float* ssp; XcdTiles xt;
    __device__ __forceinline__ void make(int q, APlain& ap, BSplit& bp, EpiMoeDown& ep) const { int gmt, nt; xt.get(q, gmt, nt);
        int bk, mt, rem, hrow0, elo, ehi; m.decode(gmt, bk, mt, rem, hrow0, elo, ehi);
        const int* lst = m.list + (size_t)bk * NT + mt * 128;
        ap = APlain{(const bf16_t*)(ws + WS_HID) + (size_t)hrow0 * 1024, 1024};
        bp = BSplit{(const bf16_t*)(wl + WL_DN) + (size_t)elo * 1024 * 512 + (size_t)nt * 128 * 512, (const bf16_t*)(wl + WL_DN) + (size_t)ehi * 1024 * 512 + (size_t)nt * 128 * 512};
        ep = EpiMoeDown{res, lst, ssp, rem, nt * 128}; } };
struct PhPleProj { const unsigned char* wl; unsigned char* ws; XcdTiles xt;
    __device__ __forceinline__ void make(int q, APlain& ap, BPlain& bp, EpiBf16& ep) const { int mt, nt; xt.get(q, mt, nt);
        ap = APlain{(const bf16_t*)(ws + WS_PB) + (size_t)mt * 128 * 256, 256}; bp = BPlain{(const bf16_t*)(wl + WL_PP) + (size_t)nt * 128 * 256, 256};
        ep = EpiBf16{(bf16_t*)(ws + WS_P2), ND, mt * 128, nt * 128}; } };
struct PhPleGate { const bf16_t* xn; const unsigned char* wl; unsigned char* ws; float* out; float sc; XcdTiles xt;
    __device__ __forceinline__ void make(int q, APlain& ap, BPlain& bp, EpiPleGate& ep) const { int mt, nt; xt.get(q, mt, nt);
        ap = APlain{xn + (size_t)mt * 128 * ND, ND}; bp = BPlain{(const bf16_t*)(wl + WL_PG) + (size_t)nt * 128 * ND, ND};
        ep = EpiPleGate{out, (const bf16_t*)(ws + WS_P2), mt * 128, nt * 128, sc}; } };

constexpr int LDS_QSLOT = 65536 + 16 + 448;
__device__ __forceinline__ int wq_next(int* head, LAS unsigned char* lds) {
    LAS int* slot = (LAS int*)(lds + LDS_QSLOT);
    __syncthreads();
    if (threadIdx.x == 0) *slot = atomicAdd(head, 1);
    __syncthreads();
    return *slot;
}
__device__ __forceinline__ void ple_stream(const bf16_t* xn, const bf16_t* pb, const unsigned char* wl, const float* ssp_in, bf16_t* rout, float* ssp_out, LAS unsigned char* lds) {
    const XcdTiles xt(128, 8);
    int q = xt.loc;
    if (q >= xt.tiles) return;
    const int tid = TID(), wid = tid >> 6, lane = tid & 63, wr = wid >> 1, wc = wid & 1, fr = lane & 15, fq = lane >> 4;
    int mt, nt; xt.get(q, mt, nt);
    bool pref = false;
    for (;;) {
        const int qn = q + xt.nloc; const bool hn = qn < xt.tiles;
        int mtn = mt, ntn = nt; if (hn) xt.get(qn, mtn, ntn);
        const APlain ap1{pb + (size_t)mt * 128 * 256, 256}; const BPlain bp1{(const bf16_t*)(wl + WL_PP) + (size_t)nt * 128 * 256, 256};
        const APlain ap2{xn + (size_t)mt * 128 * ND, ND};   const BPlain bp2{(const bf16_t*)(wl + WL_PG) + (size_t)nt * 128 * ND, ND};
        const APlain apn{pb + (size_t)mtn * 128 * 256, 256}; const BPlain bpn{(const bf16_t*)(wl + WL_PP) + (size_t)ntn * 128 * 256, 256};
        f32x4 acc[4][4], acc2[4][4]; zero_acc(acc); zero_acc(acc2);
        gemm_kloop(acc2, ap1, bp1, 256, lds, pref, true, ap2, bp2);
        gemm_kloop(acc, ap2, bp2, ND, lds, true, hn, apn, bpn);
        const EpiPleFused ep{xn, ssp_in, rout, ssp_out, mt * 128, nt * 128};
        ep(acc, acc2, wr, wc, fr, fq);
        if (!hn) break;
        q = qn; mt = mtn; nt = ntn; pref = true;
    }
}

constexpr int LDS_BAR = 65536;
constexpr int LDS_SM = LDS_BAR + 16;
constexpr int LDS_BYTES = LDS_SM + 512;
static_assert(LDS_QSLOT == LDS_SM + 448, "queue slot");
static_assert(4 * KVT + 4096 + 64 <= LDS_BAR, "attention LDS fits");

__global__ void __launch_bounds__(256, 2) mega_fwd(Params p) {
    extern __shared__ __attribute__((aligned(16))) unsigned char lds_raw[];
    LAS unsigned char* lds = (LAS unsigned char*)lds_raw;
    unsigned char* ws = p.ws;
    const int tid = threadIdx.x;
    const int gtid = blockIdx.x * 256 + tid, gthreads = gridDim.x * 256;
    int* ctl = (int*)(ws + WS_CTL);
    {
        volatile LAS unsigned* st = (volatile LAS unsigned*)(lds + LDS_BAR);
        if (tid < 4) st[tid] = 0u;
        __syncthreads();
    }
    const XcdBarrier gbar = xcd_barrier_post((unsigned*)ctl + CW_BAR, (volatile LAS unsigned*)(lds + LDS_BAR));

    phase_convert(p, (LAS float*)lds);
    xcd_barrier(gbar);

    float* sspA = (float*)(ws + WS_SSP);
    float* sspB = sspA + (size_t)NT * 16;
    float* rinv = (float*)(ws + WS_RINV);
    for (int l = 0; l < 2; ++l) {
        const unsigned char* wl = ws + WS_W + (size_t)l * WL_SIZE;
        bf16_t* xn = (bf16_t*)p.out + (size_t)(l & 1) * NT * ND;
        bf16_t* rnext = l == 1 ? (bf16_t*)(ws + WS_XN) : (bf16_t*)p.out + (size_t)((l + 1) & 1) * NT * ND;
        const bf16_t* xb_in = xn;
        {
            const PhInProj ph{xb_in, wl, ws, sspB, XcdTiles(128, 23)};
            gemm_stream<PhInProj, APlain, BPlain, EpiInProj>(ph, ph.xt.loc, ph.xt.nloc, ph.xt.tiles, ND, lds);
        }
        xcd_barrier(gbar);
        {
            int* qh = ctl + CW_Q + l * 4 + 0;
            int* ch = ctl + CW_Q + l * 4 + 2;
            const int nconv = conv_queue_strips(2 * l);
            const PhCmp1 ph{wl, ws, l};
            bool conv_left = nconv > 0, att_left = true;
            for (int k = 0; conv_left || att_left; ++k) {
                const bool want_conv = conv_left && (!att_left || (k % 7) == 6);
                if (want_conv) {
                    const int c = wq_next(ch, lds);
                    if (c < nconv) conv_strip(p, 2 * l, c, (LAS float*)lds); else conv_left = false;
                } else {
                    const int it = wq_next(qh, lds);
                    if (it >= 64 + 1536) att_left = false;
                    else if (it < 64) { ACmp ap; BPlain bp; EpiCmp1 ep; ph.make(it, ap, bp, ep); gemm_tile(ap, bp, 2048, ep, lds, false, false, ap, bp); }
                    else { dil_item(ws, 2 * (it - 64), lds); __syncthreads(); dil_item(ws, 2 * (it - 64) + 1, lds); }
                }
            }
        }
        xcd_barrier(gbar);
        { const PhCmp2 ph{wl, ws}; gemm_stream<PhCmp2, APlain, BPlain, EpiCmp2>(ph, BID(), gridDim.x, 32, 256, lds); }
        dil_merge(ws, gtid, gthreads);
        if (l == 0) convert_p(p);
        xcd_barrier(gbar);
        {
            int* qh = ctl + CW_Q + l * 4 + 1;
            int* ch = ctl + CW_Q + l * 4 + 3;
            const int nconv = conv_queue_strips(2 * l + 1);
            bool conv_left = nconv > 0, att_left = true;
            for (int k = 0; conv_left || att_left; ++k) {
                const bool want_conv = conv_left && (!att_left || (k % 4) == 3);
                if (want_conv) {
                    const int c = wq_next(ch, lds);
                    if (c < nconv) conv_strip(p, 2 * l + 1, c, (LAS float*)lds); else conv_left = false;
                } else {
                    const int it = wq_next(qh, lds);
                    if (it >= 1024) att_left = false;
                    else nsa_item(ws, ((63 - (it >> 4)) << 4) | (it & 15), lds);
                }
            }
        }
        xcd_barrier(gbar);
        { const PhOutProj ph{wl, ws, xn, XcdTiles(128, 8)};
          gemm_stream<PhOutProj, APlain, BPlain, EpiResAdd>(ph, ph.xt.loc, ph.xt.nloc, ph.xt.tiles, ND, lds); }
        xcd_barrier(gbar);
        int* cnt = ctl + CW_CNTP + l * 1536;
        int* list = (int*)(ws + WS_LIST);
        float* route = (float*)(ws + WS_ROUTE);
        phase_route(xn, (const float*)(wl + WL_RT), p.in[12] + l * 4, p.in[14] + l * 16, cnt, list, route, rinv, lds);
        xcd_barrier(gbar);
        LAS int* sm = (LAS int*)(lds + LDS_SM);
        __syncthreads();
        if (tid < 24) sm[tid] = __hip_atomic_load(cnt + 64 * tid, __ATOMIC_RELAXED, __HIP_MEMORY_SCOPE_AGENT);
        __syncthreads();
        if (tid == 0) {
            int tp = 0, hb = 0;
            for (int k = 0; k < 24; ++k) {
                const int c = sm[k];
                sm[32 + k] = tp; sm[64 + k] = hb;
                const int nt_ = (c + 127) >> 7; tp += nt_; hb += nt_ * 128;
            }
            sm[32 + 24] = tp;
        }
        __syncthreads();
        const int total_mt = sm[32 + 24];
        { const PhMoeGU ph{PhMoe{sm, list}, xn, wl, ws, route, rinv, XcdTiles(total_mt, 16)};
          gemm_stream<PhMoeGU, AGather, BPlain, EpiMoeGU>(ph, ph.xt.loc, ph.xt.nloc, ph.xt.tiles, ND, lds); }
        xcd_barrier(gbar);
        { const PhMoeDown ph{PhMoe{sm, list}, wl, ws, xn, sspA, XcdTiles(total_mt, 8)};
          gemm_stream<PhMoeDown, APlain, BSplit, EpiMoeDown>(ph, ph.xt.loc, ph.xt.nloc, ph.xt.tiles, ND, lds); }
        xcd_barrier(gbar);
        ple_stream(xn, (const bf16_t*)(ws + WS_PBALL) + (size_t)l * NT * 256, wl, sspA, rnext, sspB, lds);
        xcd_barrier(gbar);
    }
    phase_final_norm((const bf16_t*)(ws + WS_XN), p.out, p.in[21]);
}

extern "C" void kernel_launch(void* const* d_in, const int* in_sizes, int n_in, void* d_out, int out_size, void* d_ws, size_t ws_size, hipStream_t stream) {
    static int grid = 0;
    if (grid == 0) {
        if (n_in != 22 || out_size != NT * ND || ws_size < WS_END) { fprintf(stderr, "kernel_launch: unexpected shapes (n_in %d out %d ws %zu)\n", n_in, out_size, ws_size); grid = -1; return; }
        int dev = 0, cus = 0, per_cu = 0;
        hipGetDevice(&dev);
        hipDeviceGetAttribute(&cus, hipDeviceAttributeMultiprocessorCount, dev);
        if (hipFuncSetAttribute((const void*)mega_fwd, hipFuncAttributeMaxDynamicSharedMemorySize, LDS_BYTES) != hipSuccess) { fprintf(stderr, "kernel_launch: hipFuncSetAttribute failed\n"); grid = -1; return; }
        hipOccupancyMaxActiveBlocksPerMultiprocessor(&per_cu, (const void*)mega_fwd, 256, LDS_BYTES);
        if (per_cu < 1) { fprintf(stderr, "kernel_launch: occupancy query says %d\n", per_cu); grid = -1; return; }
        if (per_cu > 2) per_cu = 2;
        grid = cus * per_cu;
    }
    if (grid < 0) return;
    hipMemsetAsync((char*)d_ws + WS_CTL, 0, 32768, stream);
    Params p{};
    for (int i = 0; i < 22; ++i) p.in[i] = (const float*)d_in[i];
    p.out = (float*)d_out; p.ws = (unsigned char*)d_ws;
    hipLaunchKernelGGL(mega_fwd, dim3(grid), dim3(256), LDS_BYTES, stream, p);
    const hipError_t e = hipPeekAtLastError();
    if (e != hipSuccess) fprintf(stderr, "launch failed: %s (grid %d)\n", hipGetErrorString(e), grid);
}
```

```cpp
#include <hip/hip_runtime.h>
#include <cstdio>
#include <cstdint>

#ifndef NAIVE_GEMM
#define NAIVE_GEMM 0
#endif
#ifndef NAIVE_ATTN
#define NAIVE_ATTN 0
#endif
#define REP_CONV 1
#define REP_INPROJ 1
#define REP_ATTN 1
#define REP_GU 1
#define REP_NORM 1
#define REP_ROUTE 1
#define REP_DOWN 1
#define REP_OUTPROJ 1
#define REP_PG 1
#define REP_CMP 1
#define REP_MISC 1

#define LAS __attribute__((address_space(3)))
typedef unsigned short bf16_t;
typedef short bf16x8 __attribute__((ext_vector_type(8)));
typedef float f32x4 __attribute__((ext_vector_type(4)));
typedef unsigned u32x4 __attribute__((ext_vector_type(4)));
typedef unsigned u32x2 __attribute__((ext_vector_type(2)));
typedef float f32x16 __attribute__((ext_vector_type(16)));
typedef short s16x4 __attribute__((ext_vector_type(4)));
typedef float f32x2_t __attribute__((ext_vector_type(2)));
typedef __bf16 bf16x2_t __attribute__((ext_vector_type(2)));

constexpr int NB = 8, NS = 2048, ND = 1024, NT = NB * NS;
constexpr int NIN = 2840, NINP = 2944;
constexpr size_t MiB = (size_t)1 << 20;
constexpr size_t WL_IN = 0;
constexpr size_t WL_OUT = WL_IN + (size_t)NINP * 1024 * 2;
constexpr size_t WL_C1 = WL_OUT + (size_t)1024 * 1024 * 2;
constexpr size_t WL_C2 = WL_C1 + (size_t)2 * 256 * 2048 * 2;
constexpr size_t WL_GU = WL_C2 + (size_t)2 * 128 * 256 * 2;
constexpr size_t WL_DN = WL_GU + (size_t)16 * 1024 * 1024 * 2;
constexpr size_t WL_PG = WL_DN + (size_t)16 * 1024 * 512 * 2;
constexpr size_t WL_PP = WL_PG + (size_t)1024 * 1024 * 2;
constexpr size_t WL_BC1 = WL_PP + (size_t)1024 * 256 * 2;
constexpr size_t WL_RT = WL_BC1 + 2048;
constexpr size_t WL_SIZE = 64 * MiB;
static_assert(WL_RT + 131072 <= WL_SIZE, "weight block");
constexpr size_t WS_CTL = 0;
constexpr size_t WS_W = 1 * MiB;
constexpr size_t WS_XN = WS_W + 2 * WL_SIZE;
constexpr size_t WS_PROJ = WS_XN + 32 * MiB;
constexpr size_t WS_QA = WS_PROJ, WS_KA = WS_QA + 16 * MiB, WS_VA = WS_KA + 16 * MiB, WS_QB = WS_VA + 16 * MiB;
constexpr size_t WS_KV6 = WS_QB + 16 * MiB;
constexpr size_t WS_GATES = WS_KV6 + 24 * MiB;
constexpr size_t WS_PROJ_END = WS_GATES + 2 * MiB;
constexpr size_t WS_HID = WS_PROJ;
constexpr size_t WS_P2 = WS_PROJ + 40 * MiB;
constexpr size_t WS_PB = WS_PROJ + 72 * MiB;
constexpr size_t WS_HC = WS_PROJ_END;
constexpr size_t WS_KCMP = WS_HC + 2 * MiB;
constexpr size_t WS_MASK = WS_KCMP + 512 * 1024;
constexpr size_t WS_ROUTE = WS_MASK + 128 * 1024;
constexpr size_t WS_LIST = WS_ROUTE + 128 * 1024;
constexpr size_t WS_O = WS_LIST + 1536 * 1024 + 256 * 1024;
constexpr size_t WS_IMPH = WS_O + 32 * MiB;
constexpr size_t WS_OPA01 = WS_XN;
constexpr size_t WS_OPA2 = WS_IMPH;
constexpr size_t WS_STA = WS_IMPH + 16 * MiB;
constexpr size_t WS_PBALL = WS_IMPH + 20 * MiB;
constexpr size_t WS_SSP = WS_PBALL + 16 * MiB;
constexpr size_t WS_RINV = WS_MASK;
constexpr size_t WS_BC1P = WS_SSP + 2 * MiB;
constexpr size_t WS_END = WS_BC1P + 64 * 1024;
static_assert(WS_PB + 8 * MiB <= WS_PROJ_END, "alias map");
static_assert(WS_END <= 330 * MiB, "workspace");
constexpr int HID_ROWS = NT + 24 * 128;
constexpr int CW_BAR = 1024;
constexpr int CW_Q = 256;
constexpr int CW_CNTP = 4608;
constexpr int CW_CNT = 64;

struct Params {
    const float* in[22];
    float* out;
    unsigned char* ws;
};

__device__ __forceinline__ unsigned f2bf(float f) { unsigned u = __float_as_uint(f); return (u + 0x7fffu + ((u >> 16) & 1u)) >> 16; }
__device__ __forceinline__ unsigned pk2(float lo, float hi) { return f2bf(lo) | (f2bf(hi) << 16); }
__device__ __forceinline__ float bflo(unsigned v) { return __uint_as_float(v << 16); }
__device__ __forceinline__ float bfhi(unsigned v) { return __uint_as_float(v & 0xffff0000u); }
__device__ __forceinline__ float wave_sum(float v) {
#pragma unroll
    for (int o = 1; o < 64; o <<= 1) v += __shfl_xor(v, o);
    return v;
}
__device__ __forceinline__ int TID() { int t = threadIdx.x; asm volatile("" : "+v"(t)); return t; }
__device__ __forceinline__ int BID() { int t = blockIdx.x; asm volatile("" : "+s"(t)); return t; }
__device__ __forceinline__ float sigmoidf_(float x) { return 1.0f / (1.0f + __expf(-x)); }
__device__ __forceinline__ float gelu_tanh(float x) {
    const float u = 0.7978845608028654f * (x + 0.044715f * x * x * x);
    const float e = __expf(2.0f * u);
    const float th = 1.0f - 2.0f / (e + 1.0f);
    return 0.5f * x * (1.0f + th);
}

struct ConvJob { const float* src; bf16_t* dst; const float* gain; int K, N, NP, map, per; size_t dst_bstride; };
__device__ __forceinline__ int conv_job_tiles(int j) { return j == 0 ? 736 : (j == 1 || j == 9) ? 256 : (j == 2 || j == 3) ? 128 : (j == 4 || j == 5) ? 8 : j == 10 ? 64 : 2048; }
__device__ __forceinline__ ConvJob conv_job(const Params& p, int l, int j) {
    unsigned char* wl = p.ws + WS_W + (size_t)l * WL_SIZE;
    ConvJob c; c.map = 0; c.dst_bstride = 0; c.gain = nullptr;
    switch (j) {
    case 0: c.src = p.in[3] + (size_t)l * 1024 * NIN; c.K = 1024; c.N = NIN; c.NP = NINP; c.dst = (bf16_t*)(wl + WL_IN); c.gain = p.in[2] + l * ND; break;
    case 1: c.src = p.in[4] + (size_t)l * 1024 * 1024; c.K = 1024; c.N = 1024; c.NP = 1024; c.dst = (bf16_t*)(wl + WL_OUT); break;
    case 2: c.src = p.in[5] + (size_t)l * 2048 * 256; c.K = 2048; c.N = 256; c.NP = 256; c.dst = (bf16_t*)(wl + WL_C1); break;
    case 3: c.src = p.in[7] + (size_t)l * 2048 * 256; c.K = 2048; c.N = 256; c.NP = 256; c.dst = (bf16_t*)(wl + WL_C1) + (size_t)256 * 2048; break;
    case 4: c.src = p.in[6] + (size_t)l * 256 * 64; c.K = 256; c.N = 64; c.NP = 128; c.dst = (bf16_t*)(wl + WL_C2); break;
    case 5: c.src = p.in[8] + (size_t)l * 256 * 64; c.K = 256; c.N = 64; c.NP = 128; c.dst = (bf16_t*)(wl + WL_C2) + (size_t)128 * 256; break;
    case 6: c.src = p.in[15] + (size_t)l * 16 * 1024 * 512; c.K = 1024; c.N = 512; c.NP = 512; c.dst = (bf16_t*)(wl + WL_GU); c.map = 1; c.dst_bstride = (size_t)1024 * 1024; c.gain = p.in[10] + l * ND; break;
    case 7: c.src = p.in[16] + (size_t)l * 16 * 1024 * 512; c.K = 1024; c.N = 512; c.NP = 512; c.dst = (bf16_t*)(wl + WL_GU); c.map = 2; c.dst_bstride = (size_t)1024 * 1024; c.gain = p.in[10] + l * ND; break;
    case 8: c.src = p.in[17] + (size_t)l * 16 * 512 * 1024; c.K = 512; c.N = 1024; c.NP = 1024; c.dst = (bf16_t*)(wl + WL_DN); c.dst_bstride = (size_t)1024 * 512; break;
    case 9: c.src = p.in[19] + (size_t)l * 1024 * 1024; c.K = 1024; c.N = 1024; c.NP = 1024; c.dst = (bf16_t*)(wl + WL_PG); c.gain = p.in[18] + l * ND; break;
    default: c.src = p.in[20] + (size_t)l * 256 * 1024; c.K = 256; c.N = 1024; c.NP = 1024; c.dst = (bf16_t*)(wl + WL_PP); break;
    }
    c.per = (c.K / 64) * (c.NP / 64);
    return c;
}
__device__ __forceinline__ void convert_tiles(const ConvJob& c, int t0, int t1, LAS float* tl) {
    const int tid = TID();
    const int ntiles = c.NP / 64;
    const int kr = tid >> 4, c4 = (tid & 15) * 4;
    f32x4 v[4]; float gv[4];
#define CT_LOAD(it_) do { const int _bi = (it_) / c.per, _r = (it_) - _bi * c.per, _kt = _r / ntiles, _nt = _r - _kt * ntiles; \
        const int _n = _nt * 64 + c4; const bool _ok = _n < c.N; \
        const float* _sp = c.src + (size_t)_bi * c.K * c.N + (size_t)(_kt * 64 + kr) * c.N + (_ok ? _n : 0); \
        _Pragma("unroll") for (int _i = 0; _i < 4; ++_i) v[_i] = *(const f32x4*)(_sp + (size_t)(16 * _i) * c.N); \
        if (c.gain) { _Pragma("unroll") for (int _i = 0; _i < 4; ++_i) gv[_i] = c.gain[_kt * 64 + kr + 16 * _i]; } \
        else { _Pragma("unroll") for (int _i = 0; _i < 4; ++_i) gv[_i] = 1.0f; } \
        if (!_ok) { _Pragma("unroll") for (int _i = 0; _i < 4; ++_i) gv[_i] = 0.f; } } while (0)
    CT_LOAD(t0);
    for (int it = t0; it < t1; ++it) {
        const int bi = it / c.per, r = it - bi * c.per, kt = r / ntiles, nt = r - kt * ntiles;
        bf16_t* d = c.dst + (size_t)bi * c.dst_bstride;
        const int k0 = kt * 64, n0 = nt * 64;
        __syncthreads();
#pragma unroll
        for (int i = 0; i < 4; ++i) {
            LAS float* tp = tl + (kr + 16 * i) * 65 + c4;
            tp[0] = v[i].x * gv[i]; tp[1] = v[i].y * gv[i]; tp[2] = v[i].z * gv[i]; tp[3] = v[i].w * gv[i];
        }
        if (it + 1 < t1) CT_LOAD(it + 1);
        __syncthreads();
        const int n = tid >> 2, kc = (tid & 3) * 16;
        const int nsrc = n0 + n;
        const int row = (c.map == 0) ? nsrc : ((nsrc >> 4) * 32 + (nsrc & 15) + (c.map == 2 ? 16 : 0));
        float w[16];
#pragma unroll
        for (int j = 0; j < 16; ++j) w[j] = tl[(kc + j) * 65 + n];
        u32x4 o0, o1;
        o0.x = pk2(w[0], w[1]); o0.y = pk2(w[2], w[3]); o0.z = pk2(w[4], w[5]); o0.w = pk2(w[6], w[7]);
        o1.x = pk2(w[8], w[9]); o1.y = pk2(w[10], w[11]); o1.z = pk2(w[12], w[13]); o1.w = pk2(w[14], w[15]);
        bf16_t* dp = d + (size_t)row * c.K + k0 + kc;
        *(u32x4*)dp = o0; *(u32x4*)(dp + 8) = o1;
    }
#undef CT_LOAD
}
__device__ __forceinline__ int conv_list(int q, int i) {
    if (q == 0) return i == 0 ? 6 : (i == 1 ? 7 : -1);
    if (q == 1) return i == 0 ? 8 : i == 1 ? 9 : i == 2 ? 10 : i == 3 ? 16 : i == 4 ? 18 : i == 5 ? 19 : i == 6 ? 20 : i == 7 ? 21 : -1;
    if (q == 2) return i == 0 ? 17 : i == 1 ? 22 : i == 2 ? 23 : -1;
    return i == 0 ? 24 : i == 1 ? 25 : i == 2 ? 26 : -1;
}
__device__ __forceinline__ int conv_queue_strips(int q) {
    int n = 0;
    for (int i = 0; i < 8; ++i) { const int e = conv_list(q, i); if (e < 0) break; n += conv_job_tiles(e & 15) >> 3; }
    return n;
}
__device__ __forceinline__ void conv_strip(const Params& p, int q, int c, LAS float* tl) {
    for (int i = 0; i < 8; ++i) {
        const int e = conv_list(q, i);
        if (e < 0) return;
        const int ns = conv_job_tiles(e & 15) >> 3;
        if (c < ns) { const ConvJob job = conv_job(p, e >> 4, e & 15); convert_tiles(job, c * 8, c * 8 + 8, tl); return; }
        c -= ns;
    }
}

__device__ __forceinline__ void convert_p(const Params& p) {
    const f32x4* pl = (const f32x4*)p.in[1]; u32x2* pb = (u32x2*)(p.ws + WS_PBALL);
    for (int i = BID() * 256 + TID(); i < 2 * NT * 256 / 4; i += gridDim.x * 256) {
        const f32x4 v = pl[i]; u32x2 w; w.x = pk2(v.x, v.y); w.y = pk2(v.z, v.w); pb[i] = w;
    }
}
__device__ __forceinline__ void phase_convert(const Params& p, LAS float* tl) {
    {
        int base = 0;
        for (int j = 0; j < 6; ++j) {
            const ConvJob job = conv_job(p, 0, j);
            const int nt = conv_job_tiles(j);
            const int g = gridDim.x, b = BID();
            int first = (b - base % g + g) % g;
            for (int s = first; s < nt; s += g) convert_tiles(job, s, s + 1, tl);
            base += nt;
        }
    }
    {
        const int tid_ = TID(); const int lane = tid_ & 63, gw = BID() * 4 + (tid_ >> 6), ngw = gridDim.x * 4;
        for (int row = gw; row < NT; row += ngw) {
            const f32x4* xr = (const f32x4*)(p.in[0] + (size_t)row * ND) + lane;
            u32x2* o = (u32x2*)((bf16_t*)p.out + (size_t)row * ND) + lane;
            float ss = 0.f;
#pragma unroll
            for (int j = 0; j < 4; ++j) { const f32x4 v = xr[64 * j]; ss += (v.x * v.x + v.y * v.y) + (v.z * v.z + v.w * v.w); u32x2 w; w.x = pk2(v.x, v.y); w.y = pk2(v.z, v.w); o[64 * j] = w; }
            ss = wave_sum(ss);
            if (lane < 16) ((float*)(p.ws + WS_SSP) + (size_t)NT * 16)[(size_t)row * 16 + lane] = lane == 0 ? ss : 0.f;
        }
    }
    for (int i = BID() * 256 + TID(); i < 2 * 1024 * 32; i += gridDim.x * 256) {
        const int l = i >> 15, k = (i >> 5) & 1023, j = i & 31;
        const float gk = p.in[10][l * ND + k];
        const float wv = j < 4 ? p.in[11][(size_t)(l * ND + k) * 4 + j] : (j < 20 ? p.in[13][(size_t)(l * ND + k) * 16 + (j - 4)] : 0.f);
        ((float*)(p.ws + WS_W + (size_t)l * WL_SIZE + WL_RT))[k * 32 + j] = gk * wv;
    }
    for (int i = BID() * 256 + TID(); i < 16 * 1024; i += gridDim.x * 256) {
        const int part = i >> 10, o = i & 1023, l = o >> 9, kv = (o >> 8) & 1, n = o & 255;
        const float* pos = p.in[9] + (size_t)(l * 2 + kv) * 2048 + part * 128;
        const float* w1 = p.in[kv ? 7 : 5] + (size_t)l * 2048 * 256 + (size_t)part * 128 * 256 + n;
        float s = 0.f;
#pragma unroll 16
        for (int k = 0; k < 128; ++k) s += pos[k] * w1[(size_t)k * 256];
        ((float*)(p.ws + WS_BC1P))[i] = s;
    }
}

__device__ __forceinline__ void phase_norm(const float* x, const float* g, bf16_t* xn) {
    const int tid_ = TID(); const int lane = tid_ & 63, gw = BID() * 4 + (tid_ >> 6), ngw = gridDim.x * 4;
    for (int row = gw; row < NT; row += ngw) {
        const f32x4* xr = (const f32x4*)(x + (size_t)row * ND) + lane;
        f32x4 v[4]; float ss = 0.f;
#pragma unroll
        for (int j = 0; j < 4; ++j) { v[j] = xr[64 * j]; ss += (v[j].x * v[j].x + v[j].y * v[j].y) + (v[j].z * v[j].z + v[j].w * v[j].w); }
        ss = wave_sum(ss);
        const float r = 1.0f / sqrtf(ss * (1.0f / ND) + 1e-6f);
        u32x2* o = (u32x2*)(xn + (size_t)row * ND) + lane;
#pragma unroll
        for (int j = 0; j < 4; ++j) {
            const f32x4 gg = ((const f32x4*)g)[lane + 64 * j];
            u32x2 w; w.x = pk2(v[j].x * r * gg.x, v[j].y * r * gg.y); w.y = pk2(v[j].z * r * gg.z, v[j].w * r * gg.w);
            o[64 * j] = w;
        }
    }
}
__device__ __forceinline__ void phase_final_norm(const bf16_t* xb, float* out, const float* g) {
    const int tid_ = TID(); const int lane = tid_ & 63, gw = BID() * 4 + (tid_ >> 6), ngw = gridDim.x * 4;
    for (int row = gw; row < NT; row += ngw) {
        const u32x2* xr = (const u32x2*)(xb + (size_t)row * ND) + lane;
        f32x4* orow = (f32x4*)(out + (size_t)row * ND) + lane;
        f32x4 v[4]; float ss = 0.f;
#pragma unroll
        for (int j = 0; j < 4; ++j) { const u32x2 w = xr[64 * j]; v[j] = (f32x4){bflo(w.x), bfhi(w.x), bflo(w.y), bfhi(w.y)}; ss += (v[j].x * v[j].x + v[j].y * v[j].y) + (v[j].z * v[j].z + v[j].w * v[j].w); }
        ss = wave_sum(ss);
        const float r = 1.0f / sqrtf(ss * (1.0f / ND) + 1e-6f);
#pragma unroll
        for (int j = 0; j < 4; ++j) {
            const f32x4 gg = ((const f32x4*)g)[lane + 64 * j];
            f32x4 o; o.x = v[j].x * r * gg.x; o.y = v[j].y * r * gg.y; o.z = v[j].z * r * gg.z; o.w = v[j].w * r * gg.w;
            orow[64 * j] = o;
        }
    }
}
typedef float f32x16r __attribute__((ext_vector_type(16)));
__device__ __forceinline__ void phase_route(const bf16_t* x, const float* wr, const float* brg, const float* bre, int* cnt, int* list, float* route, float* rinv, LAS unsigned char* lds) {
    const int tid_ = TID(); const int lane = tid_ & 63, wv = tid_ >> 6;
    const int i = lane & 31, hk = lane >> 5;
    LAS float* tl = (LAS float*)lds + wv * (32 * 33);
    LAS float* ssl = (LAS float*)(lds + 4 * 32 * 33 * 4);
    for (int task = BID(); task < NT / 32; task += gridDim.x) {
        const int row0 = task * 32;
        const bf16_t* xr = x + (size_t)(row0 + i) * ND + wv * 256;
        const float* wp = wr + (size_t)(wv * 256) * 32 + hk * 32 + i;
        f32x16r acc;
#pragma unroll
        for (int q = 0; q < 16; ++q) acc[q] = 0.f;
        float ss = 0.f;
#pragma unroll 8
        for (int k8 = 0; k8 < 32; ++k8) {
            const u32x4 xa = *(const u32x4*)(xr + 8 * k8);
            const float a0 = hk ? bfhi(xa.x) : bflo(xa.x), a1 = hk ? bfhi(xa.y) : bflo(xa.y), a2 = hk ? bfhi(xa.z) : bflo(xa.z), a3 = hk ? bfhi(xa.w) : bflo(xa.w);
            const float* wq = wp + (size_t)(8 * k8) * 32;
            acc = __builtin_amdgcn_mfma_f32_32x32x2f32(a0, wq[0], acc, 0, 0, 0);
            acc = __builtin_amdgcn_mfma_f32_32x32x2f32(a1, wq[2 * 32], acc, 0, 0, 0);
            acc = __builtin_amdgcn_mfma_f32_32x32x2f32(a2, wq[4 * 32], acc, 0, 0, 0);
            acc = __builtin_amdgcn_mfma_f32_32x32x2f32(a3, wq[6 * 32], acc, 0, 0, 0);
            ss += (a0 * a0 + a1 * a1) + (a2 * a2 + a3 * a3);
        }
        ss += __shfl_xor(ss, 32);
#pragma unroll
        for (int q = 0; q < 16; ++q) tl[((q & 3) + 8 * (q >> 2) + 4 * hk) * 33 + i] = acc[q];
        if (hk == 0) ssl[wv * 32 + i] = ss;
        __syncthreads();
        if (wv == 0 && hk == 0) {
            LAS const float* tp0 = (LAS const float*)lds;
            const float sst = (ssl[i] + ssl[32 + i]) + (ssl[64 + i] + ssl[96 + i]);
            const float r = 1.0f / sqrtf(sst * (1.0f / ND) + 1e-6f);
#define RT_SUM(e_) ((tp0[i * 33 + (e_)] + tp0[32 * 33 + i * 33 + (e_)]) + (tp0[2 * 32 * 33 + i * 33 + (e_)] + tp0[3 * 32 * 33 + i * 33 + (e_)]))
            float gl[4], el[16];
#pragma unroll
            for (int e = 0; e < 4; ++e) gl[e] = RT_SUM(e) * r + brg[e];
#pragma unroll
            for (int e = 0; e < 16; ++e) el[e] = RT_SUM(4 + e) * r + bre[e];
#undef RT_SUM
            int gsel = 0; float gmax = gl[0];
#pragma unroll
            for (int e = 1; e < 4; ++e) if (gl[e] > gmax) { gmax = gl[e]; gsel = e; }
            float gden = 0.f;
#pragma unroll
            for (int e = 0; e < 4; ++e) gden += __expf(gl[e] - gmax);
            const float gw_ = 1.0f / gden;
            float wi[4];
#pragma unroll
            for (int e = 0; e < 4; ++e) wi[e] = gsel == 0 ? el[e] : (gsel == 1 ? el[4 + e] : (gsel == 2 ? el[8 + e] : el[12 + e]));
            int i0 = 0; float t0 = wi[0];
#pragma unroll
            for (int e = 1; e < 4; ++e) if (wi[e] > t0) { t0 = wi[e]; i0 = e; }
            int i1 = -1; float t1 = -3.0e38f;
#pragma unroll
            for (int e = 0; e < 4; ++e) if (e != i0 && wi[e] > t1) { t1 = wi[e]; i1 = e; }
            const float ex = __expf(t1 - t0);
            const float ew0 = gw_ / (1.0f + ex), ew1 = gw_ * ex / (1.0f + ex);
            const int lo = i0 < i1 ? i0 : i1, hi = i0 < i1 ? i1 : i0;
            const float wlo = i0 < i1 ? ew0 : ew1, whi = i0 < i1 ? ew1 : ew0;
            const int pidx = lo == 0 ? hi - 1 : (lo == 1 ? hi + 1 : 5);
            const int bucket = gsel * 6 + pidx;
            const int row = row0 + i;
            const int pos = atomicAdd(cnt + 64 * bucket, 1);
            list[(size_t)bucket * NT + pos] = row;
            route[2 * row] = wlo; route[2 * row + 1] = whi;
            rinv[row] = r;
        }
        __syncthreads();
    }
}

struct APlain { const bf16_t* base; int ld; __device__ __forceinline__ const bf16_t* operator()(int r) const { return base + (size_t)r * ld; } };
struct ACmp { const bf16_t* base; __device__ __forceinline__ const bf16_t* operator()(int r) const { return base + (size_t)(r < 126 ? r : 126) * 1024; } };
struct AGather { const bf16_t* xn; const int* list; int cnt; __device__ __forceinline__ const bf16_t* operator()(int r) const { return xn + (size_t)(r < cnt ? list[r] : 0) * ND; } };
struct BPlain { const bf16_t* base; int ld; __device__ __forceinline__ const bf16_t* operator()(int r, int k0) const { return base + (size_t)r * ld + k0; } };
struct BSplit { const bf16_t* b0; const bf16_t* b1; __device__ __forceinline__ const bf16_t* operator()(int r, int k0) const { return k0 < 512 ? b0 + (size_t)r * 512 + k0 : b1 + (size_t)r * 512 + (k0 - 512); } };

template <class AP, class BP, class APN, class BPN>
__device__ __forceinline__ void gemm_kloop(f32x4 (&acc)[4][4], const AP& ap, const BP& bp, int K, LAS unsigned char* lds, bool prefetched, bool has_next, const APN& apn, const BPN& bpn) {
    const int tid = TID(), wid = tid >> 6, lane = tid & 63, wr = wid >> 1, wc = wid & 1, fr = lane & 15, fq = lane >> 4;
#if NAIVE_GEMM
    for (int k0 = 0; k0 < K; k0 += 32) {
#pragma unroll
        for (int m = 0; m < 4; ++m) {
            const bf16_t* arow = ap(wr * 64 + m * 16 + fr) + k0;
            u32x4 av[4];
#pragma unroll
            for (int c = 0; c < 4; ++c) av[c] = ((const u32x4*)arow)[c];
#pragma unroll
            for (int n = 0; n < 4; ++n)
#pragma unroll
                for (int j = 0; j < 4; ++j) {
                    const bf16_t* brow = bp(wc * 64 + n * 16 + 4 * fq + j, k0);
                    float s = 0.f;
#pragma unroll
                    for (int c = 0; c < 4; ++c) {
                        const u32x4 bv = ((const u32x4*)brow)[c];
                        s += bflo(av[c].x) * bflo(bv.x) + bfhi(av[c].x) * bfhi(bv.x) + bflo(av[c].y) * bflo(bv.y) + bfhi(av[c].y) * bfhi(bv.y)
                           + bflo(av[c].z) * bflo(bv.z) + bfhi(av[c].z) * bfhi(bv.z) + bflo(av[c].w) * bflo(bv.w) + bfhi(av[c].w) * bfhi(bv.w);
                    }
                    acc[m][n][j] += s;
                }
        }
    }
#else
    const unsigned woff = (unsigned)wid * 1024u;
    const bf16_t* aptr[4]; int brow[4], bcol;
    {
        const int sb = lane * 16, swz = sb ^ (((sb >> 9) & 1) << 5);
        const int rl = swz >> 6, cc = (wid & 1) * 32 + ((swz & 63) >> 1);
        bcol = cc;
#pragma unroll
        for (int i = 0; i < 4; ++i) { const int R = ((wid >> 1) + 2 * i) * 16 + rl; aptr[i] = ap(R) + cc; brow[i] = R; }
    }
    int aoff[4], boff[4];
#pragma unroll
    for (int m = 0; m < 4; ++m) {
        { const int r = wr * 64 + m * 16 + fr, c = fq * 8, st = (r >> 4) * 2, ob = (r & 15) * 64 + c * 2; aoff[m] = st * 1024 + (ob ^ (((ob >> 9) & 1) << 5)); }
        { const int r = wc * 64 + m * 16 + fr, c = fq * 8, st = (r >> 4) * 2, ob = (r & 15) * 64 + c * 2; boff[m] = st * 1024 + (ob ^ (((ob >> 9) & 1) << 5)); }
    }
    const int nk = K / 64;
#define GT_STAGE(buf, t) do { const int _k0 = (t) * 64; LAS unsigned char* _ba = lds + (buf) * 32768 + woff; \
        _Pragma("unroll") for (int _i = 0; _i < 4; ++_i) { \
            __builtin_amdgcn_global_load_lds((const unsigned*)(aptr[_i] + _k0), (LAS unsigned*)(_ba + _i * 4096), 16, 0, 0); \
            __builtin_amdgcn_global_load_lds((const unsigned*)(bp(brow[_i], _k0) + bcol), (LAS unsigned*)(_ba + 16384 + _i * 4096), 16, 0, 0); } } while (0)
    if (!prefetched) GT_STAGE(0, 0);
#pragma unroll 1
    for (int t = 0; t < nk; ++t) {
        asm volatile("s_waitcnt vmcnt(0)" ::: "memory");
        __syncthreads();
        if (t + 1 < nk) GT_STAGE((t + 1) & 1, t + 1);
        else if (has_next) {
            LAS unsigned char* _ba = lds + woff;
#pragma unroll
            for (int _i = 0; _i < 4; ++_i) {
                __builtin_amdgcn_global_load_lds((const unsigned*)(apn(brow[_i]) + bcol), (LAS unsigned*)(_ba + _i * 4096), 16, 0, 0);
                __builtin_amdgcn_global_load_lds((const unsigned*)(bpn(brow[_i], 0) + bcol), (LAS unsigned*)(_ba + 16384 + _i * 4096), 16, 0, 0);
            }
        }
        LAS const unsigned char* la = lds + (t & 1) * 32768;
        LAS const unsigned char* lb = la + 16384;
#pragma unroll
        for (int kh = 0; kh < 2; ++kh) {
            bf16x8 At[4], Bt[4];
#pragma unroll
            for (int m = 0; m < 4; ++m) At[m] = *(const LAS bf16x8*)(la + aoff[m] + kh * 1024);
#pragma unroll
            for (int n = 0; n < 4; ++n) Bt[n] = *(const LAS bf16x8*)(lb + boff[n] + kh * 1024);
#pragma unroll
            for (int m = 0; m < 4; ++m)
#pragma unroll
                for (int n = 0; n < 4; ++n) acc[m][n] = __builtin_amdgcn_mfma_f32_16x16x32_bf16(Bt[n], At[m], acc[m][n], 0, 0, 0);
        }
    }
#undef GT_STAGE
#endif
}
__device__ __forceinline__ void zero_acc(f32x4 (&acc)[4][4]) {
#pragma unroll
    for (int m = 0; m < 4; ++m)
#pragma unroll
        for (int n = 0; n < 4; ++n) acc[m][n] = (f32x4){0.f, 0.f, 0.f, 0.f};
}
template <class AP, class BP, class EPI>
__device__ __forceinline__ void gemm_tile(const AP& ap, const BP& bp, int K, const EPI& epi, LAS unsigned char* lds, bool prefetched, bool has_next, const AP& apn, const BP& bpn) {
    const int tid = TID(), wid = tid >> 6, lane = tid & 63, wr = wid >> 1, wc = wid & 1, fr = lane & 15, fq = lane >> 4;
    f32x4 acc[4][4]; zero_acc(acc);
    gemm_kloop(acc, ap, bp, K, lds, prefetched, has_next, apn, bpn);
    epi(acc, wr, wc, fr, fq);
}

__device__ __forceinline__ float rinv_from_ssp(const float* ssp, int row) {
    const f32x4* q = (const f32x4*)(ssp + (size_t)row * 16);
    const f32x4 a = q[0], b = q[1], c = q[2], d = q[3];
    const float s = ((a.x + a.y) + (a.z + a.w)) + ((b.x + b.y) + (b.z + b.w)) + ((c.x + c.y) + (c.z + c.w)) + ((d.x + d.y) + (d.z + d.w));
    return 1.0f / sqrtf(s * (1.0f / ND) + 1e-6f);
}
__device__ __forceinline__ float row_ss64(const f32x4& a, const f32x4& b, const f32x4& c, const f32x4& d) {
    float s = ((a.x * a.x + a.y * a.y) + (a.z * a.z + a.w * a.w)) + ((b.x * b.x + b.y * b.y) + (b.z * b.z + b.w * b.w))
            + ((c.x * c.x + c.y * c.y) + (c.z * c.z + c.w * c.w)) + ((d.x * d.x + d.y * d.y) + (d.z * d.z + d.w * d.w));
    s += __shfl_xor(s, 16); s += __shfl_xor(s, 32);
    return s;
}
struct EpiInProj {
    int mt, nt; unsigned char* ws; const float* ssp;
    __device__ __forceinline__ void operator()(const f32x4 (&acc)[4][4], int wr, int wc, int fr, int fq) const {
#pragma unroll
        for (int m = 0; m < 4; ++m) {
            const int row = mt * 128 + wr * 64 + m * 16 + fr, b = row >> 11, s = row & 2047;
            const float rr = rinv_from_ssp(ssp, row);
#pragma unroll
            for (int n = 0; n < 4; ++n) {
                const int col = wc * 64 + n * 16 + 4 * fq;
                const f32x4 v = acc[m][n] * rr;
                if (nt < 16) {
                    const int reg = nt >> 2, c = (nt & 3) * 128 + col, head = c >> 6, d = c & 63;
                    const float sc = (reg == 0 || reg == 3) ? 0.125f * 1.4426950408889634f : 1.0f;
                    bf16_t* dst = (bf16_t*)(ws + WS_QA + (size_t)reg * 16 * MiB) + ((size_t)((b * 8 + head) * NS + s) * 64 + d);
                    u32x2 w; w.x = pk2(v.x * sc, v.y * sc); w.y = pk2(v.z * sc, v.w * sc);
                    *(u32x2*)dst = w;
                } else if (nt < 22) {
                    const int g = col >> 6, d = col & 63;
                    bf16_t* dst = (bf16_t*)(ws + WS_KV6 + (size_t)(nt - 16) * 4 * MiB) + ((size_t)((b * 2 + g) * NS + s) * 64 + d);
                    u32x2 w; w.x = pk2(v.x, v.y); w.y = pk2(v.z, v.w);
                    *(u32x2*)dst = w;
                } else {
                    if (col < 24) {
                        f32x4 o; o.x = sigmoidf_(v.x); o.y = sigmoidf_(v.y); o.z = sigmoidf_(v.z); o.w = sigmoidf_(v.w);
                        *(f32x4*)((float*)(ws + WS_GATES) + (size_t)row * 24 + col) = o;
                    }
                }
            }
        }
    }
};
struct EpiCmp1 {
    bf16_t* hc; const float* bc1; int row0, col0;
    __device__ __forceinline__ void operator()(const f32x4 (&acc)[4][4], int wr, int wc, int fr, int fq) const {
#pragma unroll
        for (int m = 0; m < 4; ++m) {
            const int row = row0 + wr * 64 + m * 16 + fr;
#pragma unroll
            for (int n = 0; n < 4; ++n) {
                const int col = col0 + wc * 64 + n * 16 + 4 * fq;
                f32x4 bb = *(const f32x4*)(bc1 + col);
#pragma unroll
                for (int pp = 1; pp < 16; ++pp) bb += *(const f32x4*)(bc1 + pp * 1024 + col);
                const f32x4 v = acc[m][n];
                u32x2 w; w.x = pk2(gelu_tanh(v.x + bb.x), gelu_tanh(v.y + bb.y)); w.y = pk2(gelu_tanh(v.z + bb.z), gelu_tanh(v.w + bb.w));
                *(u32x2*)(hc + (size_t)row * 256 + col) = w;
            }
        }
    }
};
struct EpiCmp2 {
    bf16_t* dst; int row0;
    __device__ __forceinline__ void operator()(const f32x4 (&acc)[4][4], int wr, int wc, int fr, int fq) const {
        if (wc != 0) return;
#pragma unroll
        for (int m = 0; m < 4; ++m) {
            const int row = row0 + wr * 64 + m * 16 + fr;
#pragma unroll
            for (int n = 0; n < 4; ++n) {
                const int col = n * 16 + 4 * fq;
                const f32x4 v = acc[m][n];
                u32x2 w; w.x = pk2(v.x, v.y); w.y = pk2(v.z, v.w);
                *(u32x2*)(dst + (size_t)row * 64 + col) = w;
            }
        }
    }
};
struct EpiResAdd {
    bf16_t* res; int row0, col0;
    __device__ __forceinline__ void operator()(const f32x4 (&acc)[4][4], int wr, int wc, int fr, int fq) const {
#pragma unroll
        for (int m = 0; m < 4; ++m) {
            const int row = row0 + wr * 64 + m * 16 + fr;
#pragma unroll
            for (int n = 0; n < 4; ++n) {
                const int col = col0 + wc * 64 + n * 16 + 4 * fq;
                u32x2* pp = (u32x2*)(res + (size_t)row * ND + col);
                const u32x2 b = *pp; const f32x4 a = acc[m][n];
                u32x2 w; w.x = pk2(bflo(b.x) + a.x, bfhi(b.x) + a.y); w.y = pk2(bflo(b.y) + a.z, bfhi(b.y) + a.w);
                *pp = w;
            }
        }
    }
};
struct EpiMoeGU {
    bf16_t* hid; const int* list; const float* route; const float* rinv; int cnt, hrow0, nt16;
    __device__ __forceinline__ void operator()(const f32x4 (&acc)[4][4], int wr, int wc, int fr, int fq) const {
        const int half = nt16 >> 3, nte = nt16 & 7;
#pragma unroll
        for (int m = 0; m < 4; ++m) {
            const int r = wr * 64 + m * 16 + fr;
            const int tok = r < cnt ? list[r] : 0;
            const float w = r < cnt ? route[2 * tok + half] : 0.f;
            const float rt = rinv[tok];
#pragma unroll
            for (int pr = 0; pr < 2; ++pr) {
                const f32x4 gv = acc[m][2 * pr], uv = acc[m][2 * pr + 1];
                const int hc = half * 512 + (4 * nte + 2 * wc + pr) * 16 + 4 * fq;
                float h[4];
#pragma unroll
                for (int j = 0; j < 4; ++j) { const float gg = gv[j] * rt; h[j] = gg / (1.0f + __expf(-gg)) * (uv[j] * rt) * w; }
                u32x2 o; o.x = pk2(h[0], h[1]); o.y = pk2(h[2], h[3]);
                *(u32x2*)(hid + (size_t)(hrow0 + r) * 1024 + hc) = o;
            }
        }
    }
};
struct EpiMoeDown {
    bf16_t* res; const int* list; float* ssp; int cnt, col0;
    __device__ __forceinline__ void operator()(const f32x4 (&acc)[4][4], int wr, int wc, int fr, int fq) const {
#pragma unroll
        for (int m = 0; m < 4; ++m) {
            const int r = wr * 64 + m * 16 + fr;
            const bool ok = r < cnt;
            const int tok = ok ? list[r] : 0;
            f32x4 nv[4];
#pragma unroll
            for (int n = 0; n < 4; ++n) {
                const int col = col0 + wc * 64 + n * 16 + 4 * fq;
                u32x2* pp = (u32x2*)(res + (size_t)tok * ND + col);
                const u32x2 b = *pp; const f32x4 a = acc[m][n];
                nv[n] = (f32x4){bflo(b.x) + a.x, bfhi(b.x) + a.y, bflo(b.y) + a.z, bfhi(b.y) + a.w};
                if (ok) { u32x2 w; w.x = pk2(nv[n].x, nv[n].y); w.y = pk2(nv[n].z, nv[n].w); *pp = w; }
            }
            const float ps = row_ss64(nv[0], nv[1], nv[2], nv[3]);
            if (ok && fq == 0) ssp[(size_t)tok * 16 + (col0 >> 6) + wc] = ps;
        }
    }
};
struct EpiBf16 {
    bf16_t* dst; int ld, row0, col0;
    __device__ __forceinline__ void operator()(const f32x4 (&acc)[4][4], int wr, int wc, int fr, int fq) const {
#pragma unroll
        for (int m = 0; m < 4; ++m) {
            const int row = row0 + wr * 64 + m * 16 + fr;
#pragma unroll
            for (int n = 0; n < 4; ++n) {
                const int col = col0 + wc * 64 + n * 16 + 4 * fq;
                const f32x4 v = acc[m][n];
                u32x2 w; w.x = pk2(v.x, v.y); w.y = pk2(v.z, v.w);
                *(u32x2*)(dst + (size_t)row * ld + col) = w;
            }
        }
    }
};
struct EpiPleFused {
    const bf16_t* rin; const float* ssp_in; bf16_t* rout; float* ssp_out; int row0, col0;
    __device__ __forceinline__ void operator()(const f32x4 (&acc)[4][4], const f32x4 (&acc2)[4][4], int wr, int wc, int fr, int fq) const {
#pragma unroll
        for (int m = 0; m < 4; ++m) {
            const int row = row0 + wr * 64 + m * 16 + fr;
            const float rr = rinv_from_ssp(ssp_in, row);
            f32x4 nv[4];
#pragma unroll
            for (int n = 0; n < 4; ++n) {
                const int col = col0 + wc * 64 + n * 16 + 4 * fq;
                const size_t off = (size_t)row * ND + col;
                const f32x4 v = acc[m][n] * rr, q = acc2[m][n];
                const u32x2 b = *(const u32x2*)(rin + off);
                f32x4 o = (f32x4){bflo(b.x), bfhi(b.x), bflo(b.y), bfhi(b.y)};
                o.x += sigmoidf_(v.x) * q.x; o.y += sigmoidf_(v.y) * q.y; o.z += sigmoidf_(v.z) * q.z; o.w += sigmoidf_(v.w) * q.w;
                u32x2 w; w.x = pk2(o.x, o.y); w.y = pk2(o.z, o.w);
                *(u32x2*)(rout + off) = w;
                nv[n] = o;
            }
            const float ps = row_ss64(nv[0], nv[1], nv[2], nv[3]);
            if (fq == 0) ssp_out[(size_t)row * 16 + (col0 >> 6) + wc] = ps;
        }
    }
};
struct EpiPleGate {
    float* out; const bf16_t* p2; int row0, col0; float sc;
    __device__ __forceinline__ void operator()(const f32x4 (&acc)[4][4], int wr, int wc, int fr, int fq) const {
#pragma unroll
        for (int m = 0; m < 4; ++m) {
            const int row = row0 + wr * 64 + m * 16 + fr;
#pragma unroll
            for (int n = 0; n < 4; ++n) {
                const int col = col0 + wc * 64 + n * 16 + 4 * fq;
                const size_t off = (size_t)row * ND + col;
                const u32x2 pv = *(const u32x2*)(p2 + off);
                const f32x4 v = acc[m][n];
                f32x4 o = *(const f32x4*)(out + off);
                o.x += sc * sigmoidf_(v.x) * bflo(pv.x); o.y += sc * sigmoidf_(v.y) * bfhi(pv.x); o.z += sc * sigmoidf_(v.z) * bflo(pv.y); o.w += sc * sigmoidf_(v.w) * bfhi(pv.y);
                *(f32x4*)(out + off) = o;
            }
        }
    }
};

template <class PH, class AP, class BP, class EPI>
__device__ __forceinline__ void gemm_stream(const PH& ph, int first, int step, int count, int K, LAS unsigned char* lds) {
    int q = first;
    if (q >= count) return;
    AP ap, apn; BP bp, bpn; EPI ep, epn;
    ph.make(q, ap, bp, ep);
    bool pref = false;
    for (;;) {
        const int qn = q + step; const bool hn = qn < count;
        if (hn) ph.make(qn, apn, bpn, epn); else { apn = ap; bpn = bp; epn = ep; }
        gemm_tile(ap, bp, K, ep, lds, pref, hn, apn, bpn);
        if (!hn) break;
        ap = apn; bp = bpn; ep = epn; q = qn; pref = true;
    }
}

__device__ __forceinline__ void load_q32(const bf16_t* p, float* q) {
#pragma unroll
    for (int c = 0; c < 4; ++c) {
        const u32x4 v = ((const u32x4*)p)[c];
        q[8 * c] = bflo(v.x); q[8 * c + 1] = bfhi(v.x); q[8 * c + 2] = bflo(v.y); q[8 * c + 3] = bfhi(v.y);
        q[8 * c + 4] = bflo(v.z); q[8 * c + 5] = bfhi(v.z); q[8 * c + 6] = bflo(v.w); q[8 * c + 7] = bfhi(v.w);
    }
}
__device__ __forceinline__ float dot32p(const float* q, const bf16_t* k) {
    float s0 = 0.f, s1 = 0.f;
#pragma unroll
    for (int c = 0; c < 4; ++c) {
        const u32x4 v = ((const u32x4*)k)[c];
        s0 += q[8 * c] * bflo(v.x); s1 += q[8 * c + 1] * bfhi(v.x); s0 += q[8 * c + 2] * bflo(v.y); s1 += q[8 * c + 3] * bfhi(v.y);
        s0 += q[8 * c + 4] * bflo(v.z); s1 += q[8 * c + 5] * bfhi(v.z); s0 += q[8 * c + 6] * bflo(v.w); s1 += q[8 * c + 7] * bfhi(v.w);
    }
    const float s = s0 + s1;
    return s + __shfl_xor(s, 1);
}
__device__ __forceinline__ void axpy32(float* a, float p, const bf16_t* vr) {
#pragma unroll
    for (int c = 0; c < 4; ++c) {
        const u32x4 v = ((const u32x4*)vr)[c];
        a[8 * c] += p * bflo(v.x); a[8 * c + 1] += p * bfhi(v.x); a[8 * c + 2] += p * bflo(v.y); a[8 * c + 3] += p * bfhi(v.y);
        a[8 * c + 4] += p * bflo(v.z); a[8 * c + 5] += p * bfhi(v.z); a[8 * c + 6] += p * bflo(v.w); a[8 * c + 7] += p * bfhi(v.w);
    }
}
#define ONLINE_STEP(s_, vrow_) do { const float _s = (s_); if (_s > mx) { const float _c = __expf(mx - _s); l *= _c; _Pragma("unroll") for (int _i = 0; _i < 32; ++_i) acc[_i] *= _c; mx = _s; } \
    const float _p = __expf(_s - mx); l += _p; axpy32(acc, _p, (vrow_)); } while (0)

__device__ __forceinline__ void store_o32(bf16_t* dst, const float* a, float sc) {
#pragma unroll
    for (int c = 0; c < 4; ++c) {
        u32x4 w; w.x = pk2(a[8 * c] * sc, a[8 * c + 1] * sc); w.y = pk2(a[8 * c + 2] * sc, a[8 * c + 3] * sc);
        w.z = pk2(a[8 * c + 4] * sc, a[8 * c + 5] * sc); w.w = pk2(a[8 * c + 6] * sc, a[8 * c + 7] * sc);
        ((u32x4*)dst)[c] = w;
    }
}

__device__ __forceinline__ void attn_dilated_naive(const unsigned char* ws, int gtid, int gthreads) {
    asm volatile("" : "+v"(gtid));
    const bf16_t* qa = (const bf16_t*)(ws + WS_QA); const bf16_t* ka = (const bf16_t*)(ws + WS_KA); const bf16_t* va = (const bf16_t*)(ws + WS_VA);
    bf16_t* ob = (bf16_t*)(ws + WS_O);
    for (int id2 = gtid; id2 < NB * 8 * NS * 2; id2 += gthreads) {
        const int idx = id2 >> 1, hf = (id2 & 1) * 32;
        const int t = idx & 2047, bh = idx >> 11, h = bh & 7, b = bh >> 3;
        float q[32]; load_q32(qa + (size_t)idx * 64 + hf, q);
        const bf16_t* kb = ka + (size_t)bh * NS * 64 + hf; const bf16_t* vb = va + (size_t)bh * NS * 64 + hf;
        const float slope = exp2f(-((float)h + 0.5f));
        float mx = -1e30f, l = 0.f; float acc[32];
#pragma unroll
        for (int i = 0; i < 32; ++i) acc[i] = 0.f;
#pragma unroll 1
        for (int pat = 0; pat < 3; ++pat) {
            const int dil = pat == 0 ? 1 : (pat == 1 ? 4 : 16);
#pragma unroll 1
            for (int j = 0; j <= 128; ++j) {
                const int dist = j * dil, pos = t - dist;
                if (pos < 0) break;
                const float s = dot32p(q, kb + (size_t)pos * 64) - slope * (float)dist;
                ONLINE_STEP(s, vb + (size_t)pos * 64);
            }
        }
        store_o32(ob + ((size_t)(b * NS + t) * ND + h * 64 + hf), acc, 1.0f / l);
    }
}

__device__ __forceinline__ void nsa_imp_naive(const unsigned char* ws, int gtid, int gthreads) {
    asm volatile("" : "+v"(gtid));
    const bf16_t* qb = (const bf16_t*)(ws + WS_QB); const bf16_t* kcmp = (const bf16_t*)(ws + WS_KCMP);
    float* imph = (float*)(ws + WS_IMPH);
    for (int id2 = gtid; id2 < NB * 8 * NS * 2; id2 += gthreads) {
        const int idx = id2 >> 1, hf = (id2 & 1) * 32;
        const int t = idx & 2047, bh = idx >> 11, hb = bh & 7, b = bh >> 3, g = hb >> 2;
        float q[32]; load_q32(qb + (size_t)idx * 64 + hf, q);
        const bf16_t* kc = kcmp + (size_t)(b * 2 + g) * 128 * 64 + hf;
        const float slope = exp2f(-(float)(hb + 1));
        const int ncv = t >= 31 ? ((t - 31) >> 4) + 1 : 0;
        float mx = -1e30f;
#pragma unroll 1
        for (int c = 0; c < ncv; ++c) { const float s = dot32p(q, kc + c * 64) - slope * (float)(t - (16 * c + 31)); mx = fmaxf(mx, s); }
        float den = 0.f;
#pragma unroll 1
        for (int c = 0; c < ncv; ++c) { const float s = dot32p(q, kc + c * 64) - slope * (float)(t - (16 * c + 31)); den += __expf(s - mx); }
        const float inv = ncv > 0 ? 1.0f / den : 0.f;
#pragma unroll 1
        for (int n = 0; n < 32; ++n) {
            float imp = 0.f;
#pragma unroll 1
            for (int j = -1; j <= 3; ++j) {
                const int c = 4 * n + j;
                if (c >= 0 && c < ncv) {
                    const float s = dot32p(q, kc + c * 64) - slope * (float)(t - (16 * c + 31));
                    const float pp = __expf(s - mx) * inv;
                    imp += (j == -1 || j == 3) ? 0.5f * pp : pp;
                }
            }
            if (hf == 0) imph[(size_t)idx * 32 + n] = imp;
        }
    }
}
__device__ __forceinline__ void nsa_select(const unsigned char* ws, unsigned* maskbuf) {
    const float* imph = (const float*)(ws + WS_IMPH);
    const int tid_ = TID(); const int lane = tid_ & 63, gw = BID() * 4 + (tid_ >> 6), ngw = gridDim.x * 4;
    for (int it = gw; it < NB * 2 * NS / 2; it += ngw) {
        const int item = it * 2 + (lane >> 5), t = item & 2047, bg = item >> 11, n = lane & 31;
        float imp = 0.f;
#pragma unroll
        for (int r = 0; r < 4; ++r) imp += imph[((size_t)(bg * 4 + r) * NS + t) * 32 + n];
        const int cur = t >> 6;
        const bool valid = n <= cur;
        const bool forced = (n == 0) || (cur - n < 2);
        const float score = valid ? imp + (forced ? 1e4f : 0.f) : -1e30f;
        int rank = 0;
        for (int m = 0; m < 32; ++m) {
            const float sm = __shfl(score, (lane & 32) | m);
            rank += (sm > score || (sm == score && m < n)) ? 1 : 0;
        }
        const bool sel = valid && rank < 16;
        const unsigned long long bal = __ballot(sel);
        if (n == 0) maskbuf[item] = (lane >> 5) ? (unsigned)(bal >> 32) : (unsigned)bal;
    }
}
__device__ __forceinline__ void nsa_attn_naive(const unsigned char* ws, int gtid, int gthreads) {
    asm volatile("" : "+v"(gtid));
    const bf16_t* qb = (const bf16_t*)(ws + WS_QB);
    const bf16_t* kcmp = (const bf16_t*)(ws + WS_KCMP); const bf16_t* vcmp = kcmp + (size_t)16 * 128 * 64;
    const bf16_t* ksb = (const bf16_t*)(ws + WS_KV6 + 2 * 4 * MiB); const bf16_t* vsb = (const bf16_t*)(ws + WS_KV6 + 3 * 4 * MiB);
    const bf16_t* kwb = (const bf16_t*)(ws + WS_KV6 + 4 * 4 * MiB); const bf16_t* vwb = (const bf16_t*)(ws + WS_KV6 + 5 * 4 * MiB);
    const float* gates = (const float*)(ws + WS_GATES);
    const unsigned* maskbuf = (const unsigned*)(ws + WS_MASK);
    bf16_t* ob = (bf16_t*)(ws + WS_O);
    for (int id2 = gtid; id2 < NB * 8 * NS * 2; id2 += gthreads) {
        const int idx = id2 >> 1, hf = (id2 & 1) * 32;
        const int t = idx & 2047, bh = idx >> 11, hb = bh & 7, b = bh >> 3, g = hb >> 2, bg = b * 2 + g;
        float q[32]; load_q32(qb + (size_t)idx * 64 + hf, q);
        const float slope = exp2f(-(float)(hb + 1));
        const float* gt = gates + (size_t)(b * NS + t) * 24 + hb * 3;
        float tot[32], acc[32];
#pragma unroll
        for (int i = 0; i < 32; ++i) tot[i] = 0.f;
        {
            const bf16_t* kc = kcmp + (size_t)bg * 128 * 64 + hf; const bf16_t* vc = vcmp + (size_t)bg * 128 * 64 + hf;
            const int ncv = t >= 31 ? ((t - 31) >> 4) + 1 : 0;
            if (ncv > 0) {
                float mx = -1e30f, l = 0.f;
#pragma unroll
                for (int i = 0; i < 32; ++i) acc[i] = 0.f;
#pragma unroll 1
                for (int c = 0; c < ncv; ++c) { const float s = dot32p(q, kc + c * 64) - slope * (float)(t - (16 * c + 31)); ONLINE_STEP(s, vc + c * 64); }
                const float sc = gt[0] / l;
#pragma unroll
                for (int i = 0; i < 32; ++i) tot[i] += sc * acc[i];
            }
        }
        {
            const bf16_t* kb = ksb + (size_t)bg * NS * 64 + hf; const bf16_t* vb = vsb + (size_t)bg * NS * 64 + hf;
            const unsigned mask = maskbuf[bg * NS + t];
            float mx = -1e30f, l = 0.f;
#pragma unroll
            for (int i = 0; i < 32; ++i) acc[i] = 0.f;
#pragma unroll 1
            for (int n = 0; n < 32; ++n) {
                if (!((mask >> n) & 1u)) continue;
#pragma unroll 1
                for (int i = 0; i < 64; ++i) {
                    const int pos = n * 64 + i;
                    if (pos > t) break;
                    const float s = dot32p(q, kb + (size_t)pos * 64) - slope * (float)(t - pos);
                    ONLINE_STEP(s, vb + (size_t)pos * 64);
                }
            }
            const float sc = gt[1] / l;
#pragma unroll
            for (int i = 0; i < 32; ++i) tot[i] += sc * acc[i];
        }
        {
            const bf16_t* kb = kwb + (size_t)bg * NS * 64 + hf; const bf16_t* vb = vwb + (size_t)bg * NS * 64 + hf;
            float mx = -1e30f, l = 0.f;
#pragma unroll
            for (int i = 0; i < 32; ++i) acc[i] = 0.f;
#pragma unroll 1
            for (int dist = 0; dist < 512; ++dist) {
                const int pos = t - dist;
                if (pos < 0) break;
                const float s = dot32p(q, kb + (size_t)pos * 64) - slope * (float)dist;
                ONLINE_STEP(s, vb + (size_t)pos * 64);
            }
            const float sc = gt[2] / l;
#pragma unroll
            for (int i = 0; i < 32; ++i) tot[i] += sc * acc[i];
        }
        store_o32(ob + ((size_t)(b * NS + t) * ND + 512 + hb * 64 + hf), tot, 1.0f);
    }
}

constexpr int KVS = 144;
constexpr int KVT = 64 * KVS;
constexpr int VS = 128;
constexpr int VT = 64 * VS;
#define LOG2E_F 1.4426950408889634f
__device__ __forceinline__ unsigned cvtpk(float lo, float hi) { f32x2_t v = {lo, hi}; bf16x2_t b = __builtin_convertvector(v, bf16x2_t); return __builtin_bit_cast(unsigned, b); }
__device__ __forceinline__ s16x4 vtr(LAS const unsigned char* p) { return __builtin_bit_cast(s16x4, __builtin_amdgcn_ds_read_tr16_b64_v4i16((LAS s16x4*)p)); }
__device__ __forceinline__ f32x16 zero16() { f32x16 z;
#pragma unroll
    for (int i = 0; i < 16; ++i) z[i] = 0.f;
    return z; }

__device__ __forceinline__ void load_kv_tile(LAS unsigned char* Kt, LAS unsigned char* Vt, const bf16_t* kbase, const bf16_t* vbase, int row0, int rstride, int rmin, int rmax, int tid) {
    const int j = tid >> 2, ch = tid & 3;
    int tok = row0 + j * rstride; tok = tok < rmin ? rmin : (tok > rmax ? rmax : tok);
    const u32x4* kp = (const u32x4*)(kbase + (size_t)tok * 64);
    const u32x4* vp = (const u32x4*)(vbase + (size_t)tok * 64);
    const u32x4 k0 = kp[ch], k1 = kp[ch + 4], v0 = vp[ch], v1 = vp[ch + 4];
    *(LAS u32x4*)(Kt + j * KVS + ch * 16) = k0; *(LAS u32x4*)(Kt + j * KVS + (ch + 4) * 16) = k1;
    { const int sx = 2 * (j & 3); *(LAS u32x4*)(Vt + j * VS + ((ch ^ sx) * 16)) = v0; *(LAS u32x4*)(Vt + j * VS + (((ch + 4) ^ sx) * 16)) = v1; }
}

struct KVRegs { u32x4 k0, k1, v0, v1; };
__device__ __forceinline__ void kv_fetch(KVRegs& r, const bf16_t* kbase, const bf16_t* vbase, int row0, int rstride, int rmin, int rmax, int tid) {
    const int j = tid >> 2, ch = tid & 3;
    int tok = row0 + j * rstride; tok = tok < rmin ? rmin : (tok > rmax ? rmax : tok);
    const u32x4* kp = (const u32x4*)(kbase + (size_t)tok * 64);
    const u32x4* vp = (const u32x4*)(vbase + (size_t)tok * 64);
    r.k0 = kp[ch]; r.k1 = kp[ch + 4]; r.v0 = vp[ch]; r.v1 = vp[ch + 4];
}
__device__ __forceinline__ void kv_commit(const KVRegs& r, LAS unsigned char* Kt, LAS unsigned char* Vt, int tid) {
    const int j = tid >> 2, ch = tid & 3;
    *(LAS u32x4*)(Kt + j * KVS + ch * 16) = r.k0; *(LAS u32x4*)(Kt + j * KVS + (ch + 4) * 16) = r.k1;
    { const int sx = 2 * (j & 3); *(LAS u32x4*)(Vt + j * VS + ((ch ^ sx) * 16)) = r.v0; *(LAS u32x4*)(Vt + j * VS + (((ch + 4) ^ sx) * 16)) = r.v1; }
}
__device__ __forceinline__ void pv32(f32x16& o0, f32x16& o1, const f32x16& sv, LAS const unsigned char* vp0, LAS const unsigned char* vp1  ) {
#pragma unroll
    for (int s16 = 0; s16 < 2; ++s16) {
        u32x4 pw;
        pw.x = cvtpk(sv[8 * s16 + 0], sv[8 * s16 + 1]); pw.y = cvtpk(sv[8 * s16 + 2], sv[8 * s16 + 3]);
        pw.z = cvtpk(sv[8 * s16 + 4], sv[8 * s16 + 5]); pw.w = cvtpk(sv[8 * s16 + 6], sv[8 * s16 + 7]);
        const bf16x8 pf = __builtin_bit_cast(bf16x8, pw);
        const s16x4 a0 = vtr(vp0 + s16 * 16 * VS), b0 = vtr(vp0 + s16 * 16 * VS + 8 * VS), a1 = vtr(vp1 + s16 * 16 * VS), b1 = vtr(vp1 + s16 * 16 * VS + 8 * VS);
        const bf16x8 vf0 = {a0[0], a0[1], a0[2], a0[3], b0[0], b0[1], b0[2], b0[3]};
        const bf16x8 vf1 = {a1[0], a1[1], a1[2], a1[3], b1[0], b1[1], b1[2], b1[3]};
        o0 = __builtin_amdgcn_mfma_f32_32x32x16_bf16(vf0, pf, o0, 0, 0, 0);
        o1 = __builtin_amdgcn_mfma_f32_32x32x16_bf16(vf1, pf, o1, 0, 0, 0);
    }
}
__device__ __forceinline__ f32x16 qk32(const bf16x8* qf, LAS const unsigned char* kp  , f32x16 s  ) {
#pragma unroll
    for (int k = 0; k < 4; ++k) {
        const bf16x8 kf = *(const LAS bf16x8*)(kp + 32 * k);
        s = __builtin_amdgcn_mfma_f32_32x32x16_bf16(kf, qf[k], s, 0, 0, 0);
    }
    return s;
}
template <int KS, bool TRY_FULL>
__device__ __forceinline__ void fa_tile64(f32x16& o0, f32x16& o1, float& m, float& l, const bf16x8* qf, LAS const unsigned char* Kt, LAS const unsigned char* Vt, int lane, float dA, float wmax, float ns2) {
    const int r = lane & 31, h = lane >> 5;
    LAS const unsigned char* kp = Kt + r * KVS + 16 * h;
    const float dAh = dA - (float)(KS * 4 * h);
    const float hi = dAh, lo = dAh - wmax, base = ns2 * dAh;
    f32x16 s0, s1;
#pragma unroll
    for (int i = 0; i < 16; ++i) {
        const float c0 = (float)(KS * ((i & 3) + 8 * (i >> 2))), c1 = c0 + (float)(32 * KS);
        s0[i] = fmaf(-c0, ns2, base); s1[i] = fmaf(-c1, ns2, base);
    }
    s0 = qk32(qf, kp, s0); s1 = qk32(qf, kp + 32 * KVS, s1);
    float tmax = -1e30f;
    if (TRY_FULL && __all(lo <= 0.f && hi >= (float)(59 * KS))) {
#pragma unroll
        for (int i = 0; i < 16; ++i) tmax = fmaxf(tmax, fmaxf(s0[i], s1[i]));
    } else {
#pragma unroll
        for (int i = 0; i < 16; ++i) {
            const float c0 = (float)(KS * ((i & 3) + 8 * (i >> 2))), c1 = c0 + (float)(32 * KS);
            const float t0 = (c0 >= lo && c0 <= hi) ? s0[i] : -1e30f;
            const float t1 = (c1 >= lo && c1 <= hi) ? s1[i] : -1e30f;
            s0[i] = t0; s1[i] = t1;
            tmax = fmaxf(tmax, fmaxf(t0, t1));
        }
    }
    tmax = fmaxf(tmax, __shfl_xor(tmax, 32));
    const float mn = fmaxf(m, tmax);
    const float corr = __builtin_amdgcn_exp2f(m - mn);
    m = mn;
    const float mu = fmaxf(mn, -1e29f);
    float ps = 0.f;
#pragma unroll
    for (int i = 0; i < 16; ++i) {
        s0[i] = __builtin_amdgcn_exp2f(s0[i] - mu); s1[i] = __builtin_amdgcn_exp2f(s1[i] - mu);
        ps += s0[i] + s1[i];
    }
    l = l * corr + ps;
    if (!__all(corr == 1.0f)) {
#pragma unroll
        for (int i = 0; i < 16; ++i) { o0[i] *= corr; o1[i] *= corr; }
    }
    const int vq = (lane & 15) >> 2, vc0 = 2 * ((lane >> 4) & 1) + ((lane & 3) >> 1), vsx = 2 * vq;
    LAS const unsigned char* vp0 = Vt + (4 * h + vq) * VS + ((vc0 ^ vsx) * 16) + 8 * (lane & 1);
    LAS const unsigned char* vp1 = Vt + (4 * h + vq) * VS + (((vc0 + 4) ^ vsx) * 16) + 8 * (lane & 1);
    pv32(o0, o1, s0, vp0, vp1);
    pv32(o0, o1, s1, vp0 + 32 * VS, vp1 + 32 * VS);
}
__device__ __forceinline__ void acc_scaled(f32x16& t0, f32x16& t1, const f32x16& o0, const f32x16& o1, float sc) {
#pragma unroll
    for (int i = 0; i < 16; ++i) { t0[i] += sc * o0[i]; t1[i] += sc * o1[i]; }
}
__device__ __forceinline__ void store_ot(bf16_t* orow, const f32x16& o0, const f32x16& o1, float sc, int h) {
#pragma unroll
    for (int u = 0; u < 4; ++u) {
        u32x2 w0, w1;
        w0.x = cvtpk(o0[4 * u] * sc, o0[4 * u + 1] * sc); w0.y = cvtpk(o0[4 * u + 2] * sc, o0[4 * u + 3] * sc);
        w1.x = cvtpk(o1[4 * u] * sc, o1[4 * u + 1] * sc); w1.y = cvtpk(o1[4 * u + 2] * sc, o1[4 * u + 3] * sc);
        *(u32x2*)(orow + 8 * u + 4 * h) = w0;
        *(u32x2*)(orow + 32 + 8 * u + 4 * h) = w1;
    }
}
__device__ __forceinline__ void load_qf(bf16x8* qf, const bf16_t* qrow, int h) {
#pragma unroll
    for (int k = 0; k < 4; ++k) qf[k] = *(const bf16x8*)(qrow + 16 * k + 8 * h);
}

__device__ __forceinline__ void dil_item(unsigned char* ws, int item, LAS unsigned char* lds) {
    const int tid = TID(), lane = tid & 63, w = tid >> 6, c = lane & 31, h = lane >> 5;
    const int bh = item / 48, rem = item % 48, pat = rem >> 4, idx = rem & 15;
    const int dil = pat == 0 ? 1 : (pat == 1 ? 4 : 16), nqt = 16 / dil, res = idx / nqt, qt = idx % nqt;
    const int hd = bh & 7, b = bh >> 3;
    const int q0 = qt * 128 + 32 * w, iq = q0 + c, t = res + iq * dil;
    const bf16_t* qa = (const bf16_t*)(ws + WS_QA) + (size_t)bh * NS * 64;
    const bf16_t* ka = (const bf16_t*)(ws + WS_KA) + (size_t)bh * NS * 64;
    const bf16_t* va = (const bf16_t*)(ws + WS_VA) + (size_t)bh * NS * 64;
    bf16x8 qf[4]; load_qf(qf, qa + (size_t)t * 64, h);
    const float ns2 = -exp2f(-((float)hd + 0.5f)) * (float)dil * LOG2E_F;
    f32x16 o0 = zero16(), o1 = zero16(); float m = -1e30f, l = 0.f;
    {
        const int T0 = qt == 0 ? 2 : 0;
        KVRegs kr; kv_fetch(kr, ka, va, res + (qt * 128 - 128 + 64 * T0) * dil, dil, 0, NS - 1, tid);
        int buf = 0;
        for (int T = T0; T < 4; ++T) {
            const int kb = qt * 128 - 128 + 64 * T;
            LAS unsigned char* Kt = lds + buf * KVT; LAS unsigned char* Vt = lds + 2 * KVT + buf * VT;
            kv_commit(kr, Kt, Vt, tid);
            __syncthreads();
            if (T + 1 < 4) kv_fetch(kr, ka, va, res + (kb + 64) * dil, dil, 0, NS - 1, tid);
            if (kb <= q0 + 31 && kb + 63 >= q0 - 128)
                fa_tile64<1, true>(o0, o1, m, l, qf, Kt, Vt, lane, (float)(iq - kb), 128.f, ns2);
            buf ^= 1;
        }
    }
    const float lt = l + __shfl_xor(l, 32);
    bf16_t* op = (bf16_t*)(pat < 2 ? ws + WS_OPA01 + (size_t)pat * 16 * MiB : ws + WS_OPA2);
    store_ot(op + ((size_t)(b * NS + t) * 512 + hd * 64), o0, o1, 1.0f / lt, h);
    if (h == 0) { float* st = (float*)(ws + WS_STA) + ((size_t)pat * NB * 8 * NS + (size_t)bh * NS + t) * 2; st[0] = m; st[1] = lt; }
}
__device__ __forceinline__ void dil_merge(unsigned char* ws, int gtid, int gthreads) {
    asm volatile("" : "+v"(gtid));
    const float* sta = (const float*)(ws + WS_STA);
    bf16_t* ob = (bf16_t*)(ws + WS_O);
    for (int it = gtid; it < NT * 8 * 8; it += gthreads) {
        const int ch = it & 7, hd = (it >> 3) & 7, tk = it >> 6, b = tk >> 11, t = tk & 2047;
        float mm[3], ll[3];
#pragma unroll
        for (int p = 0; p < 3; ++p) { const float* s = sta + ((size_t)p * NB * 8 * NS + (size_t)(b * 8 + hd) * NS + t) * 2; mm[p] = s[0]; ll[p] = s[1]; }
        const float M = fmaxf(mm[0], fmaxf(mm[1], mm[2]));
        float wgt[3], den = 0.f;
#pragma unroll
        for (int p = 0; p < 3; ++p) { wgt[p] = __builtin_amdgcn_exp2f(mm[p] - M) * ll[p]; den += wgt[p]; }
        const float inv = 1.0f / den;
        float a[8];
#pragma unroll
        for (int i = 0; i < 8; ++i) a[i] = 0.f;
#pragma unroll
        for (int p = 0; p < 3; ++p) {
            const bf16_t* op = (const bf16_t*)(p < 2 ? ws + WS_OPA01 + (size_t)p * 16 * MiB : ws + WS_OPA2);
            const u32x4 v = *(const u32x4*)(op + (size_t)tk * 512 + hd * 64 + ch * 8);
            const float wp = wgt[p] * inv;
            a[0] += wp * bflo(v.x); a[1] += wp * bfhi(v.x); a[2] += wp * bflo(v.y); a[3] += wp * bfhi(v.y);
            a[4] += wp * bflo(v.z); a[5] += wp * bfhi(v.z); a[6] += wp * bflo(v.w); a[7] += wp * bfhi(v.w);
        }
        u32x4 o; o.x = pk2(a[0], a[1]); o.y = pk2(a[2], a[3]); o.z = pk2(a[4], a[5]); o.w = pk2(a[6], a[7]);
        *(u32x4*)(ob + (size_t)tk * ND + hd * 64 + ch * 8) = o;
    }
}

constexpr int LDS_IMP = 4 * KVT;
constexpr int LDS_UNI = LDS_IMP + 4096;
constexpr int LDS_TOT = 41088;
__device__ __forceinline__ void nsa_item(unsigned char* ws, int item, LAS unsigned char* lds) {
    const int tid = TID(), lane = tid & 63, w = tid >> 6, c = lane & 31, h = lane >> 5;
    const int bg = item & 15, tt = item >> 4, b = bg >> 1, g = bg & 1;
    const int t0 = tt * 32, tok8 = c & 7, hh = c >> 3, hb = g * 4 + hh, t = t0 + 8 * w + tok8;
    const bf16_t* qrow = (const bf16_t*)(ws + WS_QB) + ((size_t)(b * 8 + hb) * NS + t) * 64;
    bf16x8 qf[4]; load_qf(qf, qrow, h);
    const float ns2 = -exp2f(-(float)(hb + 1)) * LOG2E_F;
    const float* gt = (const float*)(ws + WS_GATES) + (size_t)(b * NS + t) * 24 + hb * 3;
    const float g0 = gt[0], g1 = gt[1], g2 = gt[2];
    LAS float* totL = (LAS float*)(lds + LDS_TOT) + tid;
    LAS unsigned char* Kt = lds; LAS unsigned char* Vt = lds + 2 * KVT;
    LAS float* impL = (LAS float*)(lds + LDS_IMP) + w * 256;
    LAS unsigned* uni = (LAS unsigned*)(lds + LDS_UNI);
    const int cur = t0 >> 6;
    unsigned selmask;
    {
        const bf16_t* kc = (const bf16_t*)(ws + WS_KCMP) + (size_t)bg * 128 * 64;
        const bf16_t* vc = kc + (size_t)16 * 128 * 64;
        __syncthreads();
        load_kv_tile(Kt, Vt, kc, vc, 0, 1, 0, 127, tid);
        load_kv_tile(Kt + KVT, Vt + VT, kc, vc, 64, 1, 0, 127, tid);
        if (tid == 0) uni[0] = 0u;
        __syncthreads();
        LAS const unsigned char* kp = Kt + c * KVS + 16 * h;
        f32x16 sT[4];
#pragma unroll
        for (int T = 0; T < 4; ++T) sT[T] = qk32(qf, kp + T * 32 * KVS, zero16());
        const float dAh = (float)(t - 31) - (float)(64 * h);
        float tmax = -1e30f;
#pragma unroll
        for (int T = 0; T < 4; ++T)
#pragma unroll
            for (int i = 0; i < 16; ++i) {
                const float d = dAh - (float)(16 * (32 * T + (i & 3) + 8 * (i >> 2)));
                float tv = sT[T][i] + ns2 * d;
                tv = d >= 0.f ? tv : -1e30f;
                sT[T][i] = tv; tmax = fmaxf(tmax, tv);
            }
        tmax = fmaxf(tmax, __shfl_xor(tmax, 32));
        const float mu = fmaxf(tmax, -1e29f);
        float ps = 0.f;
#pragma unroll
        for (int T = 0; T < 4; ++T)
#pragma unroll
            for (int i = 0; i < 16; ++i) { sT[T][i] = __builtin_amdgcn_exp2f(sT[T][i] - mu); ps += sT[T][i]; }
        ps += __shfl_xor(ps, 32);
        const float inv = ps > 0.f ? 1.0f / ps : 0.f;
#pragma unroll
        for (int T = 0; T < 4; ++T)
#pragma unroll
            for (int i = 0; i < 16; ++i) sT[T][i] *= inv;
        f32x16 o0 = zero16(), o1 = zero16();
        const int vq = (lane & 15) >> 2, vc0 = 2 * ((lane >> 4) & 1) + ((lane & 3) >> 1), vsx = 2 * vq;
        LAS const unsigned char* vp0 = Vt + (4 * h + vq) * VS + ((vc0 ^ vsx) * 16) + 8 * (lane & 1);
        LAS const unsigned char* vp1 = Vt + (4 * h + vq) * VS + (((vc0 + 4) ^ vsx) * 16) + 8 * (lane & 1);
#pragma unroll
        for (int T = 0; T < 4; ++T) pv32(o0, o1, sT[T], vp0 + T * 32 * VS, vp1 + T * 32 * VS);
#pragma unroll
        for (int i = 0; i < 16; ++i) { totL[i * 256] = g0 * o0[i]; totL[(16 + i) * 256] = g0 * o1[i]; }
        float mainv[16], spill[16];
#pragma unroll
        for (int T = 0; T < 4; ++T)
#pragma unroll
            for (int u = 0; u < 4; ++u) {
                const float p3 = 0.5f * sT[T][4 * u + 3];
                mainv[4 * T + u] = sT[T][4 * u] + sT[T][4 * u + 1] + sT[T][4 * u + 2] + p3;
                spill[4 * T + u] = p3;
            }
#pragma unroll
        for (int f = 0; f < 16; ++f) {
            mainv[f] += __shfl_xor(mainv[f], 8); mainv[f] += __shfl_xor(mainv[f], 16);
            spill[f] += __shfl_xor(spill[f], 8); spill[f] += __shfl_xor(spill[f], 16);
        }
#pragma unroll
        for (int f = 0; f < 16; ++f) {
            const float snd = h ? (f > 0 ? spill[f > 0 ? f - 1 : 0] : 0.f) : spill[f];
            const float rcv = __shfl_xor(snd, 32);
            mainv[f] += rcv;
        }
        if (hh == 0) {
#pragma unroll
            for (int f = 0; f < 16; ++f) impL[tok8 * 32 + 2 * f + h] = mainv[f];
        }
        asm volatile("s_waitcnt lgkmcnt(0)" ::: "memory");
        {
            const int tk = lane >> 3, tq = t0 + 8 * w + tk, cq = tq >> 6, n0 = 4 * (lane & 7);
            float sc[32];
#pragma unroll
            for (int q4 = 0; q4 < 8; ++q4) {
                const f32x4 v = *(const LAS f32x4*)(impL + tk * 32 + 4 * q4);
                sc[4 * q4] = v.x; sc[4 * q4 + 1] = v.y; sc[4 * q4 + 2] = v.z; sc[4 * q4 + 3] = v.w;
            }
#pragma unroll
            for (int n = 0; n < 32; ++n) {
                const bool valid = n <= cq, forced = (n == 0) || (cq - n < 2);
                sc[n] = valid ? sc[n] + (forced ? 1e4f : 0.f) : -1e30f;
            }
            unsigned bits = 0u;
#pragma unroll
            for (int k = 0; k < 4; ++k) {
                const int n = n0 + k;
                float mine = 0.f;
#pragma unroll
                for (int q = 0; q < 32; ++q) mine = (q == n) ? sc[q] : mine;
                int rank = 0;
#pragma unroll
                for (int q = 0; q < 32; ++q) rank += (sc[q] > mine || (sc[q] == mine && q < n)) ? 1 : 0;
                if (n <= cq && rank < 16) bits |= 1u << n;
            }
            bits |= __shfl_xor(bits, 1); bits |= __shfl_xor(bits, 2); bits |= __shfl_xor(bits, 4);
            selmask = __shfl(bits, tok8 * 8);
        }
        {
            unsigned um = selmask;
#pragma unroll
            for (int o = 1; o < 64; o <<= 1) um |= __shfl_xor(um, o);
            if (lane == 0) atomicOr((unsigned*)uni, um);
        }
        __syncthreads();
    }
    const unsigned ublk = uni[0];
    unsigned wsel = selmask;
#pragma unroll
    for (int o = 1; o < 64; o <<= 1) wsel |= __shfl_xor(wsel, o);
    int buf = 0;
    KVRegs kr;
    {
        const bf16_t* kb = (const bf16_t*)(ws + WS_KV6 + 2 * 4 * MiB) + (size_t)bg * NS * 64;
        const bf16_t* vb = (const bf16_t*)(ws + WS_KV6 + 3 * 4 * MiB) + (size_t)bg * NS * 64;
        f32x16 o0 = zero16(), o1 = zero16(); float m = -1e30f, l = 0.f;
        unsigned rem = ublk & (cur >= 31 ? 0xffffffffu : ((2u << cur) - 1u));
        int n = __builtin_ctz(rem);
        kv_fetch(kr, kb, vb, 64 * n, 1, 0, NS - 1, tid);
        while (rem) {
            rem &= rem - 1u;
            LAS unsigned char* Kc = lds + buf * KVT; LAS unsigned char* Vc = lds + 2 * KVT + buf * VT;
            kv_commit(kr, Kc, Vc, tid);
            __syncthreads();
            const int ncur = n;
            if (rem) { n = __builtin_ctz(rem); kv_fetch(kr, kb, vb, 64 * n, 1, 0, NS - 1, tid); }
            if ((wsel >> ncur) & 1u)
                fa_tile64<1, true>(o0, o1, m, l, qf, Kc, Vc, lane, (float)(t - 64 * ncur), ((selmask >> ncur) & 1u) ? 1e30f : -1.f, ns2);
            buf ^= 1;
        }
        const float lt = l + __shfl_xor(l, 32);
        { const float sc = g1 / lt;
#pragma unroll
          for (int i = 0; i < 16; ++i) { totL[i * 256] += sc * o0[i]; totL[(16 + i) * 256] += sc * o1[i]; } }
    }
    {
        const bf16_t* kb = (const bf16_t*)(ws + WS_KV6 + 4 * 4 * MiB) + (size_t)bg * NS * 64;
        const bf16_t* vb = (const bf16_t*)(ws + WS_KV6 + 5 * 4 * MiB) + (size_t)bg * NS * 64;
        f32x16 o0 = zero16(), o1 = zero16(); float m = -1e30f, l = 0.f;
        const int nlo = t0 >= 511 ? (t0 - 511) >> 6 : 0;
        kv_fetch(kr, kb, vb, 64 * nlo, 1, 0, NS - 1, tid);
        for (int n = nlo; n <= cur; ++n) {
            LAS unsigned char* Kc = lds + buf * KVT; LAS unsigned char* Vc = lds + 2 * KVT + buf * VT;
            kv_commit(kr, Kc, Vc, tid);
            __syncthreads();
            if (n < cur) kv_fetch(kr, kb, vb, 64 * (n + 1), 1, 0, NS - 1, tid);
            fa_tile64<1, true>(o0, o1, m, l, qf, Kc, Vc, lane, (float)(t - 64 * n), 511.f, ns2);
            buf ^= 1;
        }
        const float lt = l + __shfl_xor(l, 32);
        { const float sc = g2 / lt;
#pragma unroll
          for (int i = 0; i < 16; ++i) { o0[i] = totL[i * 256] + sc * o0[i]; o1[i] = totL[(16 + i) * 256] + sc * o1[i]; } }
        store_ot((bf16_t*)(ws + WS_O) + ((size_t)(b * NS + t) * ND + 512 + hb * 64), o0, o1, 1.0f, h);
    }
}

#define XB_TMO      128
#define XB_XCNT(j)  (256  + 64 * (j))
#define XB_XSUB(j)  (1280 + 64 * (j))
#define XB_XGEN(j)  (2304 + 64 * (j))
#define XB_TOP      3328
#define XB_TOPGEN   3392
#define XCD_BAR_WORDS 3456
#define XB_SPIN_CAP (1u << 18)
__device__ __forceinline__ unsigned xb_ld(unsigned* p)              { return __hip_atomic_load(p, __ATOMIC_RELAXED, __HIP_MEMORY_SCOPE_AGENT); }
__device__ __forceinline__ unsigned xb_add(unsigned* p, unsigned v) { return __hip_atomic_fetch_add(p, v, __ATOMIC_RELAXED, __HIP_MEMORY_SCOPE_AGENT); }
__device__ __forceinline__ unsigned xb_xcc_id() { return (unsigned)__builtin_amdgcn_s_getreg((3 << 11) | 20) & 0xFu; }
#define XB_SPIN(cond, bar) do { unsigned _sp = 0; while (cond) { __builtin_amdgcn_s_sleep(1); \
    if ((++_sp & 255u) == 0u) { if (xb_ld(&(bar)[XB_TMO])) break; if (_sp > XB_SPIN_CAP) { atomicAdd(&(bar)[XB_TMO], 1u); break; } } } } while (0)
struct XcdBarrier { unsigned* bar; unsigned x; volatile LAS unsigned* st; };
__device__ __forceinline__ XcdBarrier xcd_barrier_post(unsigned* bar, volatile LAS unsigned* st) {
    XcdBarrier b; b.bar = bar; b.x = xb_xcc_id(); b.st = st;
    if (threadIdx.x == 0) (void)xb_add(&bar[XB_XCNT(b.x)], 1u);
    return b;
}
__device__ __forceinline__ void xcd_barrier_complete(unsigned* bar, unsigned x, unsigned& nloc, unsigned& nx) {
    const unsigned G = gridDim.x * gridDim.y * gridDim.z;
    unsigned sum, cnt, mine, sp = 0u;
    for (;;) {
        sum = 0u; cnt = 0u; mine = 0u;
#pragma unroll
        for (unsigned j = 0; j < 16; ++j) { const unsigned c = xb_ld(&bar[XB_XCNT(j)]); sum += c; cnt += (c > 0u) ? 1u : 0u; mine = (j == x) ? c : mine; }
        if (sum == G) break;
        __builtin_amdgcn_s_sleep(1);
        if ((++sp & 255u) == 0u) { if (xb_ld(&bar[XB_TMO])) break; if (sp > XB_SPIN_CAP) { atomicAdd(&bar[XB_TMO], 1u); break; } }
    }
    nloc = mine > 0u ? mine : 1u; nx = cnt > 0u ? cnt : 1u;
}
__device__ __forceinline__ void xcd_barrier(const XcdBarrier& b) {
    asm volatile("s_waitcnt vmcnt(0)" ::: "memory");
    __syncthreads();
    if (threadIdx.x == 0) {
        unsigned* bar = b.bar;
        __builtin_amdgcn_s_waitcnt(0);
        unsigned nloc = b.st[0], nx = b.st[1];
        if (nloc == 0u) { xcd_barrier_complete(bar, b.x, nloc, nx); b.st[0] = nloc; b.st[1] = nx; }
        const unsigned old = xb_add(&bar[XB_XSUB(b.x)], 1u);
        const unsigned gen = old / nloc;
        if (old + 1u == (gen + 1u) * nloc) {
            __builtin_amdgcn_fence(__ATOMIC_RELEASE, "agent");
            asm volatile("s_waitcnt vmcnt(0)" ::: "memory");
            const unsigned og = xb_add(&bar[XB_TOP], 1u);
            const unsigned tg = og / nx;
            if (og + 1u == (tg + 1u) * nx) xb_add(&bar[XB_TOPGEN], 1u);
            else XB_SPIN(xb_ld(&bar[XB_TOPGEN]) == tg, bar);
            __builtin_amdgcn_fence(__ATOMIC_ACQUIRE, "agent");
            xb_add(&bar[XB_XGEN(b.x)], 1u);
            asm volatile("s_waitcnt vmcnt(0)" ::: "memory");
        } else {
            XB_SPIN(xb_ld(&bar[XB_XGEN(b.x)]) == gen, bar);
            __builtin_amdgcn_fence(__ATOMIC_ACQUIRE, "agent");
            asm volatile("s_waitcnt vmcnt(0)" ::: "memory");
        }
    }
    __syncthreads();
}

struct XcdTiles {
    int m_lo, cnt_m, nN, loc, nloc, tiles;
    __device__ __forceinline__ XcdTiles(int nM, int nN_) {
        const int b = BID(), g = gridDim.x;
        int x, nx;
        if ((g & 7) == 0) { x = b & 7; nx = 8; loc = b >> 3; nloc = g >> 3; } else { x = 0; nx = 1; loc = b; nloc = g; }
        m_lo = (int)((long)nM * x / nx); cnt_m = (int)((long)nM * (x + 1) / nx) - m_lo; nN = nN_; tiles = cnt_m * nN;
    }
    __device__ __forceinline__ void get(int q, int& mt, int& nt) const {
        const int mg = q / (8 * nN), rem_m = cnt_m - 8 * mg, mig = rem_m < 8 ? rem_m : 8, r = q - mg * 8 * nN;
        nt = r / mig; mt = m_lo + 8 * mg + (r - nt * mig);
    }
};
struct PhInProj { const bf16_t* xn; const unsigned char* wl; unsigned char* ws; const float* ssp; XcdTiles xt;
    __device__ __forceinline__ void make(int q, APlain& ap, BPlain& bp, EpiInProj& ep) const { int mt, nt; xt.get(q, mt, nt);
        ap = APlain{xn + (size_t)mt * 128 * ND, ND}; bp = BPlain{(const bf16_t*)(wl + WL_IN) + (size_t)nt * 128 * ND, ND}; ep = EpiInProj{mt, nt, ws, ssp}; } };
struct PhCmp1 { const unsigned char* wl; unsigned char* ws; int l;
    __device__ __forceinline__ void make(int tile, ACmp& ap, BPlain& bp, EpiCmp1& ep) const { const int nt = tile & 1, bg = (tile >> 1) & 15, kv = tile >> 5;
        ap = ACmp{(const bf16_t*)(ws + WS_KV6 + (size_t)kv * 4 * MiB) + (size_t)bg * NS * 64};
        bp = BPlain{(const bf16_t*)(wl + WL_C1) + (size_t)kv * 256 * 2048 + (size_t)nt * 128 * 2048, 2048};
        ep = EpiCmp1{(bf16_t*)(ws + WS_HC) + (size_t)kv * 2048 * 256, (const float*)(ws + WS_BC1P) + l * 512 + kv * 256, bg * 128, nt * 128}; } };
struct PhCmp2 { const unsigned char* wl; unsigned char* ws;
    __device__ __forceinline__ void make(int tile, APlain& ap, BPlain& bp, EpiCmp2& ep) const { const int bg = tile & 15, kv = tile >> 4;
        ap = APlain{(const bf16_t*)(ws + WS_HC) + (size_t)kv * 2048 * 256 + (size_t)bg * 128 * 256, 256};
        bp = BPlain{(const bf16_t*)(wl + WL_C2) + (size_t)kv * 128 * 256, 256};
        ep = EpiCmp2{(bf16_t*)(ws + WS_KCMP) + (size_t)kv * 16 * 128 * 64, bg * 128}; } };
struct PhOutProj { const unsigned char* wl; unsigned char* ws; bf16_t* res; XcdTiles xt;
    __device__ __forceinline__ void make(int q, APlain& ap, BPlain& bp, EpiResAdd& ep) const { int mt, nt; xt.get(q, mt, nt);
        ap = APlain{(const bf16_t*)(ws + WS_O) + (size_t)mt * 128 * ND, ND}; bp = BPlain{(const bf16_t*)(wl + WL_OUT) + (size_t)nt * 128 * ND, ND};
        ep = EpiResAdd{res, mt * 128, nt * 128}; } };
struct PhMoe {
    LAS const int* sm; const int* list;
    __device__ __forceinline__ void decode(int gmt, int& bk, int& mt, int& rem, int& hrow0, int& elo, int& ehi) const {
        bk = 0;
        for (int k = 1; k < 24; ++k) if (gmt >= sm[32 + k]) bk = k;
        mt = gmt - sm[32 + bk]; rem = sm[bk] - mt * 128; hrow0 = sm[64 + bk] + mt * 128;
        const int grp = bk / 6, pi = bk % 6;
        elo = grp * 4 + (pi < 3 ? 0 : (pi < 5 ? 1 : 2)); ehi = grp * 4 + (pi < 3 ? pi + 1 : (pi < 5 ? pi - 1 : 3));
    } };
struct PhMoeGU { PhMoe m; const bf16_t* xn; const unsigned char* wl; unsigned char* ws; const float* route; const float* rinv; XcdTiles xt;
    __device__ __forceinline__ void make(int q, AGather& ap, BPlain& bp, EpiMoeGU& ep) const { int gmt, nt16; xt.get(q, gmt, nt16);
        int bk, mt, rem, hrow0, elo, ehi; m.decode(gmt, bk, mt, rem, hrow0, elo, ehi);
        const int* lst = m.list + (size_t)bk * NT + mt * 128; const int e = (nt16 >> 3) ? ehi : elo;
        ap = AGather{xn, lst, rem}; bp = BPlain{(const bf16_t*)(wl + WL_GU) + (size_t)e * 1024 * 1024 + (size_t)(nt16 & 7) * 128 * 1024, 1024};
        ep = EpiMoeGU{(bf16_t*)(ws + WS_HID), lst, route, rinv, rem, hrow0, nt16}; } };
struct PhMoeDown { PhMoe m; const unsigned char* wl; unsigned char* ws; bf16_t* res; float* ssp; XcdTiles xt;
    __device__ __forceinline__ void make(int q, APlain& ap, BSplit& bp, EpiMoeDown& ep) const { int gmt, nt; xt.get(q, gmt, nt);
        int bk, mt, rem, hrow0, elo, ehi; m.decode(gmt, bk, mt, rem, hrow0, elo, ehi);
        const int* lst = m.list + (size_t)bk * NT + mt * 128;
        ap = APlain{(const bf16_t*)(ws + WS_HID) + (size_t)hrow0 * 1024, 1024};
        bp = BSplit{(const bf16_t*)(wl + WL_DN) + (size_t)elo * 1024 * 512 + (size_t)nt * 128 * 512, (const bf16_t*)(wl + WL_DN) + (size_t)ehi * 1024 * 512 + (size_t)nt * 128 * 512};
        ep = EpiMoeDown{res, lst, ssp, rem, nt * 128}; } };
struct PhPleProj { const unsigned char* wl; unsigned char* ws; XcdTiles xt;
    __device__ __forceinline__ void make(int q, APlain& ap, BPlain& bp, EpiBf16& ep) const { int mt, nt; xt.get(q, mt, nt);
        ap = APlain{(const bf16_t*)(ws + WS_PB) + (size_t)mt * 128 * 256, 256}; bp = BPlain{(const bf16_t*)(wl + WL_PP) + (size_t)nt * 128 * 256, 256};
        ep = EpiBf16{(bf16_t*)(ws + WS_P2), ND, mt * 128, nt * 128}; } };
struct PhPleGate { const bf16_t* xn; const unsigned char* wl; unsigned char* ws; float* out; float sc; XcdTiles xt;
    __device__ __forceinline__ void make(int q, APlain& ap, BPlain& bp, EpiPleGate& ep) const { int mt, nt; xt.get(q, mt, nt);
        ap = APlain{xn + (size_t)mt * 128 * ND, ND}; bp = BPlain{(const bf16_t*)(wl + WL_PG) + (size_t)nt * 128 * ND, ND};
        ep = EpiPleGate{out, (const bf16_t*)(ws + WS_P2), mt * 128, nt * 128, sc}; } };

constexpr int LDS_QSLOT = 73856 + 16 + 448;
__device__ __forceinline__ int wq_next(int* head, LAS unsigned char* lds) {
    LAS int* slot = (LAS int*)(lds + LDS_QSLOT);
    __syncthreads();
    if (threadIdx.x == 0) *slot = atomicAdd(head, 1);
    __syncthreads();
    return *slot;
}
__device__ __forceinline__ void ple_stream(const bf16_t* xn, const bf16_t* pb, const unsigned char* wl, const float* ssp_in, bf16_t* rout, float* ssp_out, LAS unsigned char* lds) {
    const XcdTiles xt(128, 8);
    int q = xt.loc;
    if (q >= xt.tiles) return;
    const int tid = TID(), wid = tid >> 6, lane = tid & 63, wr = wid >> 1, wc = wid & 1, fr = lane & 15, fq = lane >> 4;
    int mt, nt; xt.get(q, mt, nt);
    bool pref = false;
    for (;;) {
        const int qn = q + xt.nloc; const bool hn = qn < xt.tiles;
        int mtn = mt, ntn = nt; if (hn) xt.get(qn, mtn, ntn);
        const APlain ap1{pb + (size_t)mt * 128 * 256, 256}; const BPlain bp1{(const bf16_t*)(wl + WL_PP) + (size_t)nt * 128 * 256, 256};
        const APlain ap2{xn + (size_t)mt * 128 * ND, ND};   const BPlain bp2{(const bf16_t*)(wl + WL_PG) + (size_t)nt * 128 * ND, ND};
        const APlain apn{pb + (size_t)mtn * 128 * 256, 256}; const BPlain bpn{(const bf16_t*)(wl + WL_PP) + (size_t)ntn * 128 * 256, 256};
        f32x4 acc[4][4], acc2[4][4]; zero_acc(acc); zero_acc(acc2);
        gemm_kloop(acc2, ap1, bp1, 256, lds, pref, true, ap2, bp2);
        gemm_kloop(acc, ap2, bp2, ND, lds, true, hn, apn, bpn);
        const EpiPleFused ep{xn, ssp_in, rout, ssp_out, mt * 128, nt * 128};
        ep(acc, acc2, wr, wc, fr, fq);
        if (!hn) break;
        q = qn; mt = mtn; nt = ntn; pref = true;
    }
}

constexpr int LDS_BAR = 73856;
constexpr int LDS_SM = LDS_BAR + 16;
constexpr int LDS_BYTES = LDS_SM + 512;
static_assert(LDS_QSLOT == LDS_SM + 448, "queue slot");
static_assert(4 * KVT + 4096 + 64 <= LDS_TOT && LDS_TOT + 32768 <= LDS_BAR && 65536 <= LDS_BAR, "LDS map");

__global__ void __launch_bounds__(256, 2) mega_fwd(Params p) {
    extern __shared__ __attribute__((aligned(16))) unsigned char lds_raw[];
    LAS unsigned char* lds = (LAS unsigned char*)lds_raw;
    unsigned char* ws = p.ws;
    const int tid = threadIdx.x;
    const int gtid = blockIdx.x * 256 + tid, gthreads = gridDim.x * 256;
    int* ctl = (int*)(ws + WS_CTL);
    {
        volatile LAS unsigned* st = (volatile LAS unsigned*)(lds + LDS_BAR);
        if (tid < 4) st[tid] = 0u;
        __syncthreads();
    }
    const XcdBarrier gbar = xcd_barrier_post((unsigned*)ctl + CW_BAR, (volatile LAS unsigned*)(lds + LDS_BAR));

    phase_convert(p, (LAS float*)lds);
    xcd_barrier(gbar);

    float* sspA = (float*)(ws + WS_SSP);
    float* sspB = sspA + (size_t)NT * 16;
    float* rinv = (float*)(ws + WS_RINV);
    for (int l = 0; l < 2; ++l) {
        const unsigned char* wl = ws + WS_W + (size_t)l * WL_SIZE;
        bf16_t* xn = (bf16_t*)p.out + (size_t)(l & 1) * NT * ND;
        bf16_t* rnext = l == 1 ? (bf16_t*)(ws + WS_XN) : (bf16_t*)p.out + (size_t)((l + 1) & 1) * NT * ND;
        const bf16_t* xb_in = xn;
        {
            const PhInProj ph{xb_in, wl, ws, sspB, XcdTiles(128, 23)};
            gemm_stream<PhInProj, APlain, BPlain, EpiInProj>(ph, ph.xt.loc, ph.xt.nloc, ph.xt.tiles, ND, lds);
        }
        xcd_barrier(gbar);
        {
            int* qh = ctl + CW_Q + l * 4 + 0;
            int* ch = ctl + CW_Q + l * 4 + 2;
            const int nconv = conv_queue_strips(2 * l);
            const PhCmp1 ph{wl, ws, l};
            bool conv_left = nconv > 0, att_left = true;
            for (int k = 0; conv_left || att_left; ++k) {
                const bool want_conv = conv_left && (!att_left || (k % 7) == 6);
                if (want_conv) {
                    const int c = wq_next(ch, lds);
                    if (c < nconv) conv_strip(p, 2 * l, c, (LAS float*)lds); else conv_left = false;
                } else {
                    const int it = wq_next(qh, lds);
                    if (it >= 64 + 1536) att_left = false;
                    else if (it < 64) { ACmp ap; BPlain bp; EpiCmp1 ep; ph.make(it, ap, bp, ep); gemm_tile(ap, bp, 2048, ep, lds, false, false, ap, bp); }
                    else { dil_item(ws, 2 * (it - 64), lds); __syncthreads(); dil_item(ws, 2 * (it - 64) + 1, lds); }
                }
            }
        }
        xcd_barrier(gbar);
        { const PhCmp2 ph{wl, ws}; gemm_stream<PhCmp2, APlain, BPlain, EpiCmp2>(ph, BID(), gridDim.x, 32, 256, lds); }
        dil_merge(ws, gtid, gthreads);
        if (l == 0) convert_p(p);
        xcd_barrier(gbar);
        {
            int* qh = ctl + CW_Q + l * 4 + 1;
            int* ch = ctl + CW_Q + l * 4 + 3;
            const int nconv = conv_queue_strips(2 * l + 1);
            bool conv_left = nconv > 0, att_left = true;
            for (int k = 0; conv_left || att_left; ++k) {
                const bool want_conv = conv_left && (!att_left || (k % 4) == 3);
                if (want_conv) {
                    const int c = wq_next(ch, lds);
                    if (c < nconv) conv_strip(p, 2 * l + 1, c, (LAS float*)lds); else conv_left = false;
                } else {
                    const int it = wq_next(qh, lds);
                    if (it >= 1024) att_left = false;
                    else nsa_item(ws, ((63 - (it >> 4)) << 4) | (it & 15), lds);
                }
            }
        }
        xcd_barrier(gbar);
        { const PhOutProj ph{wl, ws, xn, XcdTiles(128, 8)};
          gemm_stream<PhOutProj, APlain, BPlain, EpiResAdd>(ph, ph.xt.loc, ph.xt.nloc, ph.xt.tiles, ND, lds); }
        xcd_barrier(gbar);
        int* cnt = ctl + CW_CNTP + l * 1536;
        int* list = (int*)(ws + WS_LIST);
        float* route = (float*)(ws + WS_ROUTE);
        phase_route(xn, (const float*)(wl + WL_RT), p.in[12] + l * 4, p.in[14] + l * 16, cnt, list, route, rinv, lds);
        xcd_barrier(gbar);
        LAS int* sm = (LAS int*)(lds + LDS_SM);
        __syncthreads();
        if (tid < 24) sm[tid] = __hip_atomic_load(cnt + 64 * tid, __ATOMIC_RELAXED, __HIP_MEMORY_SCOPE_AGENT);
        __syncthreads();
        if (tid == 0) {
            int tp = 0, hb = 0;
            for (int k = 0; k < 24; ++k) {
                const int c = sm[k];
                sm[32 + k] = tp; sm[64 + k] = hb;
                const int nt_ = (c + 127) >> 7; tp += nt_; hb += nt_ * 128;
            }
            sm[32 + 24] = tp;
        }
        __syncthreads();
        const int total_mt = sm[32 + 24];
        { const PhMoeGU ph{PhMoe{sm, list}, xn, wl, ws, route, rinv, XcdTiles(total_mt, 16)};
          gemm_stream<PhMoeGU, AGather, BPlain, EpiMoeGU>(ph, ph.xt.loc, ph.xt.nloc, ph.xt.tiles, ND, lds); }
        xcd_barrier(gbar);
        { const PhMoeDown ph{PhMoe{sm, list}, wl, ws, xn, sspA, XcdTiles(total_mt, 8)};
          gemm_stream<PhMoeDown, APlain, BSplit, EpiMoeDown>(ph, ph.xt.loc, ph.xt.nloc, ph.xt.tiles, ND, lds); }
        xcd_barrier(gbar);
        ple_stream(xn, (const bf16_t*)(ws + WS_PBALL) + (size_t)l * NT * 256, wl, sspA, rnext, sspB, lds);
        xcd_barrier(gbar);
    }
    phase_final_norm((const bf16_t*)(ws + WS_XN), p.out, p.in[21]);
}

extern "C" void kernel_launch(void* const* d_in, const int* in_sizes, int n_in, void* d_out, int out_size, void* d_ws, size_t ws_size, hipStream_t stream) {
    static int grid = 0;
    if (grid == 0) {
        if (n_in != 22 || out_size != NT * ND || ws_size < WS_END) { fprintf(stderr, "kernel_launch: unexpected shapes (n_in %d out %d ws %zu)\n", n_in, out_size, ws_size); grid = -1; return; }
        int dev = 0, cus = 0, per_cu = 0;
        hipGetDevice(&dev);
        hipDeviceGetAttribute(&cus, hipDeviceAttributeMultiprocessorCount, dev);
        if (hipFuncSetAttribute((const void*)mega_fwd, hipFuncAttributeMaxDynamicSharedMemorySize, LDS_BYTES) != hipSuccess) { fprintf(stderr, "kernel_launch: hipFuncSetAttribute failed\n"); grid = -1; return; }
        hipOccupancyMaxActiveBlocksPerMultiprocessor(&per_cu, (const void*)mega_fwd, 256, LDS_BYTES);
        if (per_cu < 1) { fprintf(stderr, "kernel_launch: occupancy query says %d\n", per_cu); grid = -1; return; }
        if (per_cu > 2) per_cu = 2;
        grid = cus * per_cu;
    }
    if (grid < 0) return;
    hipMemsetAsync((char*)d_ws + WS_CTL, 0, 32768, stream);
    Params p{};
    for (int i = 0; i < 22; ++i) p.in[i] = (const float*)d_in[i];
    p.out = (float*)d_out; p.ws = (unsigned char*)d_ws;
    hipLaunchKernelGGL(mega_fwd, dim3(grid), dim3(256), LDS_BYTES, stream, p);
    const hipError_t e = hipPeekAtLastError();
    if (e != hipSuccess) fprintf(stderr, "launch failed: %s (grid %d)\n", hipGetErrorString(e), grid);
}
```

```cpp
#include <hip/hip_runtime.h>
#include <cstdio>
#include <cstdint>

#ifndef NAIVE_GEMM
#define NAIVE_GEMM 0
#endif
#ifndef NAIVE_ATTN
#define NAIVE_ATTN 0
#endif
#define REP_CONV 1
#define REP_INPROJ 1
#define REP_ATTN 1
#define REP_GU 1
#define REP_NORM 1
#define REP_ROUTE 1
#define REP_DOWN 1
#define REP_OUTPROJ 1
#define REP_PG 1
#define REP_CMP 1
#define REP_MISC 1

#define LAS __attribute__((address_space(3)))
typedef unsigned short bf16_t;
typedef short bf16x8 __attribute__((ext_vector_type(8)));
typedef float f32x4 __attribute__((ext_vector_type(4)));
typedef unsigned u32x4 __attribute__((ext_vector_type(4)));
typedef unsigned u32x2 __attribute__((ext_vector_type(2)));
typedef float f32x16 __attribute__((ext_vector_type(16)));
typedef short s16x4 __attribute__((ext_vector_type(4)));
typedef float f32x2_t __attribute__((ext_vector_type(2)));
typedef __bf16 bf16x2_t __attribute__((ext_vector_type(2)));

constexpr int NB = 8, NS = 2048, ND = 1024, NT = NB * NS;
constexpr int NIN = 2840, NINP = 2944;
constexpr size_t MiB = (size_t)1 << 20;
constexpr size_t WL_IN = 0;
constexpr size_t WL_OUT = WL_IN + (size_t)NINP * 1024 * 2;
constexpr size_t WL_C1 = WL_OUT + (size_t)1024 * 1024 * 2;
constexpr size_t WL_C2 = WL_C1 + (size_t)2 * 256 * 2048 * 2;
constexpr size_t WL_GU = WL_C2 + (size_t)2 * 128 * 256 * 2;
constexpr size_t WL_DN = WL_GU + (size_t)16 * 1024 * 1024 * 2;
constexpr size_t WL_PG = WL_DN + (size_t)16 * 1024 * 512 * 2;
constexpr size_t WL_PP = WL_PG + (size_t)1024 * 1024 * 2;
constexpr size_t WL_BC1 = WL_PP + (size_t)1024 * 256 * 2;
constexpr size_t WL_RT = WL_BC1 + 2048;
constexpr size_t WL_SIZE = 64 * MiB;
static_assert(WL_RT + 131072 <= WL_SIZE, "weight block");
constexpr size_t WS_CTL = 0;
constexpr size_t WS_W = 1 * MiB;
constexpr size_t WS_XN = WS_W + 2 * WL_SIZE;
constexpr size_t WS_PROJ = WS_XN + 32 * MiB;
constexpr size_t WS_QA = WS_PROJ, WS_KA = WS_QA + 16 * MiB, WS_VA = WS_KA + 16 * MiB, WS_QB = WS_VA + 16 * MiB;
constexpr size_t WS_KV6 = WS_QB + 16 * MiB;
constexpr size_t WS_GATES = WS_KV6 + 24 * MiB;
constexpr size_t WS_PROJ_END = WS_GATES + 2 * MiB;
constexpr size_t WS_HID = WS_PROJ;
constexpr size_t WS_P2 = WS_PROJ + 40 * MiB;
constexpr size_t WS_PB = WS_PROJ + 72 * MiB;
constexpr size_t WS_HC = WS_PROJ_END;
constexpr size_t WS_KCMP = WS_HC + 2 * MiB;
constexpr size_t WS_MASK = WS_KCMP + 512 * 1024;
constexpr size_t WS_ROUTE = WS_MASK + 128 * 1024;
constexpr size_t WS_LIST = WS_ROUTE + 128 * 1024;
constexpr size_t WS_O = WS_LIST + 1536 * 1024 + 256 * 1024;
constexpr size_t WS_IMPH = WS_O + 32 * MiB;
constexpr size_t WS_OPA01 = WS_XN;
constexpr size_t WS_OPA2 = WS_IMPH;
constexpr size_t WS_STA = WS_IMPH + 16 * MiB;
constexpr size_t WS_PBALL = WS_IMPH + 20 * MiB;
constexpr size_t WS_SSP = WS_PBALL + 16 * MiB;
constexpr size_t WS_RINV = WS_MASK;
constexpr size_t WS_BC1P = WS_SSP + 2 * MiB;
constexpr size_t WS_END = WS_BC1P + 64 * 1024;
static_assert(WS_PB + 8 * MiB <= WS_PROJ_END, "alias map");
static_assert(WS_END <= 330 * MiB, "workspace");
constexpr int HID_ROWS = NT + 24 * 128;
constexpr int CW_BAR = 1024;
constexpr int CW_Q = 256;
constexpr int CW_CNTP = 4608;
constexpr int CW_CNT = 64;

struct Params {
    const float* in[22];
    float* out;
    unsigned char* ws;
};

__device__ __forceinline__ unsigned f2bf(float f) { unsigned u = __float_as_uint(f); return (u + 0x7fffu + ((u >> 16) & 1u)) >> 16; }
__device__ __forceinline__ unsigned pk2(float lo, float hi) { return f2bf(lo) | (f2bf(hi) << 16); }
__device__ __forceinline__ float bflo(unsigned v) { return __uint_as_float(v << 16); }
__device__ __forceinline__ float bfhi(unsigned v) { return __uint_as_float(v & 0xffff0000u); }
__device__ __forceinline__ float wave_sum(float v) {
#pragma unroll
    for (int o = 1; o < 64; o <<= 1) v += __shfl_xor(v, o);
    return v;
}
__device__ __forceinline__ int TID() { int t = threadIdx.x; asm volatile("" : "+v"(t)); return t; }
__device__ __forceinline__ int BID() { int t = blockIdx.x; asm volatile("" : "+s"(t)); return t; }
__device__ __forceinline__ float sigmoidf_(float x) { return 1.0f / (1.0f + __expf(-x)); }
__device__ __forceinline__ float gelu_tanh(float x) {
    const float u = 0.7978845608028654f * (x + 0.044715f * x * x * x);
    const float e = __expf(2.0f * u);
    const float th = 1.0f - 2.0f / (e + 1.0f);
    return 0.5f * x * (1.0f + th);
}

struct ConvJob { const float* src; bf16_t* dst; const float* gain; int K, N, NP, map, per; size_t dst_bstride; };
__device__ __forceinline__ int conv_job_tiles(int j) { return j == 0 ? 736 : (j == 1 || j == 9) ? 256 : (j == 2 || j == 3) ? 128 : (j == 4 || j == 5) ? 8 : j == 10 ? 64 : 2048; }
__device__ __forceinline__ ConvJob conv_job(const Params& p, int l, int j) {
    unsigned char* wl = p.ws + WS_W + (size_t)l * WL_SIZE;
    ConvJob c; c.map = 0; c.dst_bstride = 0; c.gain = nullptr;
    switch (j) {
    case 0: c.src = p.in[3] + (size_t)l * 1024 * NIN; c.K = 1024; c.N = NIN; c.NP = NINP; c.dst = (bf16_t*)(wl + WL_IN); c.gain = p.in[2] + l * ND; break;
    case 1: c.src = p.in[4] + (size_t)l * 1024 * 1024; c.K = 1024; c.N = 1024; c.NP = 1024; c.dst = (bf16_t*)(wl + WL_OUT); break;
    case 2: c.src = p.in[5] + (size_t)l * 2048 * 256; c.K = 2048; c.N = 256; c.NP = 256; c.dst = (bf16_t*)(wl + WL_C1); break;
    case 3: c.src = p.in[7] + (size_t)l * 2048 * 256; c.K = 2048; c.N = 256; c.NP = 256; c.dst = (bf16_t*)(wl + WL_C1) + (size_t)256 * 2048; break;
    case 4: c.src = p.in[6] + (size_t)l * 256 * 64; c.K = 256; c.N = 64; c.NP = 128; c.dst = (bf16_t*)(wl + WL_C2); break;
    case 5: c.src = p.in[8] + (size_t)l * 256 * 64; c.K = 256; c.N = 64; c.NP = 128; c.dst = (bf16_t*)(wl + WL_C2) + (size_t)128 * 256; break;
    case 6: c.src = p.in[15] + (size_t)l * 16 * 1024 * 512; c.K = 1024; c.N = 512; c.NP = 512; c.dst = (bf16_t*)(wl + WL_GU); c.map = 1; c.dst_bstride = (size_t)1024 * 1024; c.gain = p.in[10] + l * ND; break;
    case 7: c.src = p.in[16] + (size_t)l * 16 * 1024 * 512; c.K = 1024; c.N = 512; c.NP = 512; c.dst = (bf16_t*)(wl + WL_GU); c.map = 2; c.dst_bstride = (size_t)1024 * 1024; c.gain = p.in[10] + l * ND; break;
    case 8: c.src = p.in[17] + (size_t)l * 16 * 512 * 1024; c.K = 512; c.N = 1024; c.NP = 1024; c.dst = (bf16_t*)(wl + WL_DN); c.dst_bstride = (size_t)1024 * 512; break;
    case 9: c.src = p.in[19] + (size_t)l * 1024 * 1024; c.K = 1024; c.N = 1024; c.NP = 1024; c.dst = (bf16_t*)(wl + WL_PG); c.gain = p.in[18] + l * ND; break;
    default: c.src = p.in[20] + (size_t)l * 256 * 1024; c.K = 256; c.N = 1024; c.NP = 1024; c.dst = (bf16_t*)(wl + WL_PP); break;
    }
    c.per = (c.K / 64) * (c.NP / 64);
    return c;
}
__device__ __forceinline__ void convert_tiles(const ConvJob& c, int t0, int t1, LAS float* tl) {
    const int tid = TID();
    const int ntiles = c.NP / 64;
    const int kr = tid >> 4, c4 = (tid & 15) * 4;
    f32x4 v[4]; float gv[4];
#define CT_LOAD(it_) do { const int _bi = (it_) / c.per, _r = (it_) - _bi * c.per, _kt = _r / ntiles, _nt = _r - _kt * ntiles; \
        const int _n = _nt * 64 + c4; const bool _ok = _n < c.N; \
        const float* _sp = c.src + (size_t)_bi * c.K * c.N + (size_t)(_kt * 64 + kr) * c.N + (_ok ? _n : 0); \
        _Pragma("unroll") for (int _i = 0; _i < 4; ++_i) v[_i] = *(const f32x4*)(_sp + (size_t)(16 * _i) * c.N); \
        if (c.gain) { _Pragma("unroll") for (int _i = 0; _i < 4; ++_i) gv[_i] = c.gain[_kt * 64 + kr + 16 * _i]; } \
        else { _Pragma("unroll") for (int _i = 0; _i < 4; ++_i) gv[_i] = 1.0f; } \
        if (!_ok) { _Pragma("unroll") for (int _i = 0; _i < 4; ++_i) gv[_i] = 0.f; } } while (0)
    CT_LOAD(t0);
    for (int it = t0; it < t1; ++it) {
        const int bi = it / c.per, r = it - bi * c.per, kt = r / ntiles, nt = r - kt * ntiles;
        bf16_t* d = c.dst + (size_t)bi * c.dst_bstride;
        const int k0 = kt * 64, n0 = nt * 64;
        __syncthreads();
#pragma unroll
        for (int i = 0; i < 4; ++i) {
            LAS float* tp = tl + (kr + 16 * i) * 65 + c4;
            tp[0] = v[i].x * gv[i]; tp[1] = v[i].y * gv[i]; tp[2] = v[i].z * gv[i]; tp[3] = v[i].w * gv[i];
        }
        if (it + 1 < t1) CT_LOAD(it + 1);
        __syncthreads();
        const int n = tid >> 2, kc = (tid & 3) * 16;
        const int nsrc = n0 + n;
        const int row = (c.map == 0) ? nsrc : ((nsrc >> 4) * 32 + (nsrc & 15) + (c.map == 2 ? 16 : 0));
        float w[16];
#pragma unroll
        for (int j = 0; j < 16; ++j) w[j] = tl[(kc + j) * 65 + n];
        u32x4 o0, o1;
        o0.x = pk2(w[0], w[1]); o0.y = pk2(w[2], w[3]); o0.z = pk2(w[4], w[5]); o0.w = pk2(w[6], w[7]);
        o1.x = pk2(w[8], w[9]); o1.y = pk2(w[10], w[11]); o1.z = pk2(w[12], w[13]); o1.w = pk2(w[14], w[15]);
        bf16_t* dp = d + (size_t)row * c.K + k0 + kc;
        *(u32x4*)dp = o0; *(u32x4*)(dp + 8) = o1;
    }
#undef CT_LOAD
}
__device__ __forceinline__ int conv_list(int q, int i) {
    if (q == 0) return i == 0 ? 6 : (i == 1 ? 7 : -1);
    if (q == 1) return i == 0 ? 8 : i == 1 ? 9 : i == 2 ? 10 : i == 3 ? 16 : i == 4 ? 18 : i == 5 ? 19 : i == 6 ? 20 : i == 7 ? 21 : -1;
    if (q == 2) return i == 0 ? 17 : i == 1 ? 22 : i == 2 ? 23 : -1;
    return i == 0 ? 24 : i == 1 ? 25 : i == 2 ? 26 : -1;
}
__device__ __forceinline__ int conv_queue_strips(int q) {
    int n = 0;
    for (int i = 0; i < 8; ++i) { const int e = conv_list(q, i); if (e < 0) break; n += conv_job_tiles(e & 15) >> 3; }
    return n;
}
__device__ __forceinline__ void conv_strip(const Params& p, int q, int c, LAS float* tl) {
    for (int i = 0; i < 8; ++i) {
        const int e = conv_list(q, i);
        if (e < 0) return;
        const int ns = conv_job_tiles(e & 15) >> 3;
        if (c < ns) { const ConvJob job = conv_job(p, e >> 4, e & 15); convert_tiles(job, c * 8, c * 8 + 8, tl); return; }
        c -= ns;
    }
}

__device__ __forceinline__ void convert_p(const Params& p) {
    const f32x4* pl = (const f32x4*)p.in[1]; u32x2* pb = (u32x2*)(p.ws + WS_PBALL);
    for (int i = BID() * 256 + TID(); i < 2 * NT * 256 / 4; i += gridDim.x * 256) {
        const f32x4 v = pl[i]; u32x2 w; w.x = pk2(v.x, v.y); w.y = pk2(v.z, v.w); pb[i] = w;
    }
}
__device__ __forceinline__ void phase_convert(const Params& p, LAS float* tl) {
    {
        int base = 0;
        for (int j = 0; j < 6; ++j) {
            const ConvJob job = conv_job(p, 0, j);
            const int nt = conv_job_tiles(j);
            const int g = gridDim.x, b = BID();
            int first = (b - base % g + g) % g;
            for (int s = first; s < nt; s += g) convert_tiles(job, s, s + 1, tl);
            base += nt;
        }
    }
    {
        const int skip = gridDim.x >= 128 ? 64 : 0;
        const int tid_ = TID(); const int lane = tid_ & 63, gw = (BID() - skip) * 4 + (tid_ >> 6), ngw = (gridDim.x - skip) * 4;
        for (int row = gw >= 0 ? gw : NT; row < NT; row += ngw) {
            const f32x4* xr = (const f32x4*)(p.in[0] + (size_t)row * ND) + lane;
            u32x2* o = (u32x2*)((bf16_t*)p.out + (size_t)row * ND) + lane;
            float ss = 0.f;
#pragma unroll
            for (int j = 0; j < 4; ++j) { const f32x4 v = xr[64 * j]; ss += (v.x * v.x + v.y * v.y) + (v.z * v.z + v.w * v.w); u32x2 w; w.x = pk2(v.x, v.y); w.y = pk2(v.z, v.w); o[64 * j] = w; }
            ss = wave_sum(ss);
            if (lane < 16) ((float*)(p.ws + WS_SSP) + (size_t)NT * 16)[(size_t)row * 16 + lane] = lane == 0 ? ss : 0.f;
        }
    }
    for (int i = BID() * 256 + TID(); i < 2 * 1024 * 32; i += gridDim.x * 256) {
        const int l = i >> 15, k = (i >> 5) & 1023, j = i & 31;
        const float gk = p.in[10][l * ND + k];
        const float wv = j < 4 ? p.in[11][(size_t)(l * ND + k) * 4 + j] : (j < 20 ? p.in[13][(size_t)(l * ND + k) * 16 + (j - 4)] : 0.f);
        ((float*)(p.ws + WS_W + (size_t)l * WL_SIZE + WL_RT))[k * 32 + j] = gk * wv;
    }
    for (int i = BID() * 256 + TID(); i < 16 * 1024; i += gridDim.x * 256) {
        const int part = i >> 10, o = i & 1023, l = o >> 9, kv = (o >> 8) & 1, n = o & 255;
        const float* pos = p.in[9] + (size_t)(l * 2 + kv) * 2048 + part * 128;
        const float* w1 = p.in[kv ? 7 : 5] + (size_t)l * 2048 * 256 + (size_t)part * 128 * 256 + n;
        float s = 0.f;
#pragma unroll 16
        for (int k = 0; k < 128; ++k) s += pos[k] * w1[(size_t)k * 256];
        ((float*)(p.ws + WS_BC1P))[i] = s;
    }
}

__device__ __forceinline__ void phase_norm(const float* x, const float* g, bf16_t* xn) {
    const int tid_ = TID(); const int lane = tid_ & 63, gw = BID() * 4 + (tid_ >> 6), ngw = gridDim.x * 4;
    for (int row = gw; row < NT; row += ngw) {
        const f32x4* xr = (const f32x4*)(x + (size_t)row * ND) + lane;
        f32x4 v[4]; float ss = 0.f;
#pragma unroll
        for (int j = 0; j < 4; ++j) { v[j] = xr[64 * j]; ss += (v[j].x * v[j].x + v[j].y * v[j].y) + (v[j].z * v[j].z + v[j].w * v[j].w); }
        ss = wave_sum(ss);
        const float r = 1.0f / sqrtf(ss * (1.0f / ND) + 1e-6f);
        u32x2* o = (u32x2*)(xn + (size_t)row * ND) + lane;
#pragma unroll
        for (int j = 0; j < 4; ++j) {
            const f32x4 gg = ((const f32x4*)g)[lane + 64 * j];
            u32x2 w; w.x = pk2(v[j].x * r * gg.x, v[j].y * r * gg.y); w.y = pk2(v[j].z * r * gg.z, v[j].w * r * gg.w);
            o[64 * j] = w;
        }
    }
}
__device__ __forceinline__ void phase_final_norm(const bf16_t* xb, float* out, const float* g) {
    const int tid_ = TID(); const int lane = tid_ & 63, gw = BID() * 4 + (tid_ >> 6), ngw = gridDim.x * 4;
    for (int row = gw; row < NT; row += ngw) {
        const u32x2* xr = (const u32x2*)(xb + (size_t)row * ND) + lane;
        f32x4* orow = (f32x4*)(out + (size_t)row * ND) + lane;
        f32x4 v[4]; float ss = 0.f;
#pragma unroll
        for (int j = 0; j < 4; ++j) { const u32x2 w = xr[64 * j]; v[j] = (f32x4){bflo(w.x), bfhi(w.x), bflo(w.y), bfhi(w.y)}; ss += (v[j].x * v[j].x + v[j].y * v[j].y) + (v[j].z * v[j].z + v[j].w * v[j].w); }
        ss = wave_sum(ss);
        const float r = 1.0f / sqrtf(ss * (1.0f / ND) + 1e-6f);
#pragma unroll
        for (int j = 0; j < 4; ++j) {
            const f32x4 gg = ((const f32x4*)g)[lane + 64 * j];
            f32x4 o; o.x = v[j].x * r * gg.x; o.y = v[j].y * r * gg.y; o.z = v[j].z * r * gg.z; o.w = v[j].w * r * gg.w;
            orow[64 * j] = o;
        }
    }
}
typedef float f32x16r __attribute__((ext_vector_type(16)));
__device__ __forceinline__ void phase_route(const bf16_t* x, const float* wr, const float* brg, const float* bre, int* cnt, int* list, float* route, float* rinv, LAS unsigned char* lds) {
    const int tid_ = TID(); const int lane = tid_ & 63, wv = tid_ >> 6;
    const int i = lane & 31, hk = lane >> 5;
    LAS float* tl = (LAS float*)lds + wv * (32 * 33);
    LAS float* ssl = (LAS float*)(lds + 4 * 32 * 33 * 4);
    for (int task = BID(); task < NT / 32; task += gridDim.x) {
        const int row0 = task * 32;
        const bf16_t* xr = x + (size_t)(row0 + i) * ND + wv * 256;
        const float* wp = wr + (size_t)(wv * 256) * 32 + hk * 32 + i;
        f32x16r acc;
#pragma unroll
        for (int q = 0; q < 16; ++q) acc[q] = 0.f;
        float ss = 0.f;
#pragma unroll 8
        for (int k8 = 0; k8 < 32; ++k8) {
            const u32x4 xa = *(const u32x4*)(xr + 8 * k8);
            const float a0 = hk ? bfhi(xa.x) : bflo(xa.x), a1 = hk ? bfhi(xa.y) : bflo(xa.y), a2 = hk ? bfhi(xa.z) : bflo(xa.z), a3 = hk ? bfhi(xa.w) : bflo(xa.w);
            const float* wq = wp + (size_t)(8 * k8) * 32;
            acc = __builtin_amdgcn_mfma_f32_32x32x2f32(a0, wq[0], acc, 0, 0, 0);
            acc = __builtin_amdgcn_mfma_f32_32x32x2f32(a1, wq[2 * 32], acc, 0, 0, 0);
            acc = __builtin_amdgcn_mfma_f32_32x32x2f32(a2, wq[4 * 32], acc, 0, 0, 0);
            acc = __builtin_amdgcn_mfma_f32_32x32x2f32(a3, wq[6 * 32], acc, 0, 0, 0);
            ss += (a0 * a0 + a1 * a1) + (a2 * a2 + a3 * a3);
        }
        ss += __shfl_xor(ss, 32);
#pragma unroll
        for (int q = 0; q < 16; ++q) tl[((q & 3) + 8 * (q >> 2) + 4 * hk) * 33 + i] = acc[q];
        if (hk == 0) ssl[wv * 32 + i] = ss;
        __syncthreads();
        if (wv == 0 && hk == 0) {
            LAS const float* tp0 = (LAS const float*)lds;
            const float sst = (ssl[i] + ssl[32 + i]) + (ssl[64 + i] + ssl[96 + i]);
            const float r = 1.0f / sqrtf(sst * (1.0f / ND) + 1e-6f);
#define RT_SUM(e_) ((tp0[i * 33 + (e_)] + tp0[32 * 33 + i * 33 + (e_)]) + (tp0[2 * 32 * 33 + i * 33 + (e_)] + tp0[3 * 32 * 33 + i * 33 + (e_)]))
            float gl[4], el[16];
#pragma unroll
            for (int e = 0; e < 4; ++e) gl[e] = RT_SUM(e) * r + brg[e];
#pragma unroll
            for (int e = 0; e < 16; ++e) el[e] = RT_SUM(4 + e) * r + bre[e];
#undef RT_SUM
            int gsel = 0; float gmax = gl[0];
#pragma unroll
            for (int e = 1; e < 4; ++e) if (gl[e] > gmax) { gmax = gl[e]; gsel = e; }
            float gden = 0.f;
#pragma unroll
            for (int e = 0; e < 4; ++e) gden += __expf(gl[e] - gmax);
            const float gw_ = 1.0f / gden;
            float wi[4];
#pragma unroll
            for (int e = 0; e < 4; ++e) wi[e] = gsel == 0 ? el[e] : (gsel == 1 ? el[4 + e] : (gsel == 2 ? el[8 + e] : el[12 + e]));
            int i0 = 0; float t0 = wi[0];
#pragma unroll
            for (int e = 1; e < 4; ++e) if (wi[e] > t0) { t0 = wi[e]; i0 = e; }
            int i1 = -1; float t1 = -3.0e38f;
#pragma unroll
            for (int e = 0; e < 4; ++e) if (e != i0 && wi[e] > t1) { t1 = wi[e]; i1 = e; }
            const float ex = __expf(t1 - t0);
            const float ew0 = gw_ / (1.0f + ex), ew1 = gw_ * ex / (1.0f + ex);
            const int lo = i0 < i1 ? i0 : i1, hi = i0 < i1 ? i1 : i0;
            const float wlo = i0 < i1 ? ew0 : ew1, whi = i0 < i1 ? ew1 : ew0;
            const int pidx = lo == 0 ? hi - 1 : (lo == 1 ? hi + 1 : 5);
            const int bucket = gsel * 6 + pidx;
            const int row = row0 + i;
            const int pos = atomicAdd(cnt + 64 * bucket, 1);
            list[(size_t)bucket * NT + pos] = row;
            route[2 * row] = wlo; route[2 * row + 1] = whi;
            rinv[row] = r;
        }
        __syncthreads();
    }
}

struct APlain { const bf16_t* base; int ld; __device__ __forceinline__ const bf16_t* operator()(int r) const { return base + (size_t)r * ld; } };
struct ACmp { const bf16_t* base; __device__ __forceinline__ const bf16_t* operator()(int r) const { return base + (size_t)(r < 126 ? r : 126) * 1024; } };
struct AGather { const bf16_t* xn; const int* list; int cnt; __device__ __forceinline__ const bf16_t* operator()(int r) const { return xn + (size_t)(r < cnt ? list[r] : 0) * ND; } };
struct BPlain { const bf16_t* base; int ld; __device__ __forceinline__ const bf16_t* operator()(int r, int k0) const { return base + (size_t)r * ld + k0; } };
struct BSplit { const bf16_t* b0; const bf16_t* b1; __device__ __forceinline__ const bf16_t* operator()(int r, int k0) const { return k0 < 512 ? b0 + (size_t)r * 512 + k0 : b1 + (size_t)r * 512 + (k0 - 512); } };

template <class AP, class BP, class APN, class BPN>
__device__ __forceinline__ void gemm_kloop(f32x4 (&acc)[4][4], const AP& ap, const BP& bp, int K, LAS unsigned char* lds, bool prefetched, bool has_next, const APN& apn, const BPN& bpn) {
    const int tid = TID(), wid = tid >> 6, lane = tid & 63, wr = wid >> 1, wc = wid & 1, fr = lane & 15, fq = lane >> 4;
#if NAIVE_GEMM
    for (int k0 = 0; k0 < K; k0 += 32) {
#pragma unroll
        for (int m = 0; m < 4; ++m) {
            const bf16_t* arow = ap(wr * 64 + m * 16 + fr) + k0;
            u32x4 av[4];
#pragma unroll
            for (int c = 0; c < 4; ++c) av[c] = ((const u32x4*)arow)[c];
#pragma unroll
            for (int n = 0; n < 4; ++n)
#pragma unroll
                for (int j = 0; j < 4; ++j) {
                    const bf16_t* brow = bp(wc * 64 + n * 16 + 4 * fq + j, k0);
                    float s = 0.f;
#pragma unroll
                    for (int c = 0; c < 4; ++c) {
                        const u32x4 bv = ((const u32x4*)brow)[c];
                        s += bflo(av[c].x) * bflo(bv.x) + bfhi(av[c].x) * bfhi(bv.x) + bflo(av[c].y) * bflo(bv.y) + bfhi(av[c].y) * bfhi(bv.y)
                           + bflo(av[c].z) * bflo(bv.z) + bfhi(av[c].z) * bfhi(bv.z) + bflo(av[c].w) * bflo(bv.w) + bfhi(av[c].w) * bfhi(bv.w);
                    }
                    acc[m][n][j] += s;
                }
        }
    }
#else
    const unsigned woff = (unsigned)wid * 1024u;
    const bf16_t* aptr[4]; int brow[4], bcol;
    {
        const int sb = lane * 16, swz = sb ^ (((sb >> 9) & 1) << 5);
        const int rl = swz >> 6, cc = (wid & 1) * 32 + ((swz & 63) >> 1);
        bcol = cc;
#pragma unroll
        for (int i = 0; i < 4; ++i) { const int R = ((wid >> 1) + 2 * i) * 16 + rl; aptr[i] = ap(R) + cc; brow[i] = R; }
    }
    int aoff[4], boff[4];
#pragma unroll
    for (int m = 0; m < 4; ++m) {
        { const int r = wr * 64 + m * 16 + fr, c = fq * 8, st = (r >> 4) * 2, ob = (r & 15) * 64 + c * 2; aoff[m] = st * 1024 + (ob ^ (((ob >> 9) & 1) << 5)); }
        { const int r = wc * 64 + m * 16 + fr, c = fq * 8, st = (r >> 4) * 2, ob = (r & 15) * 64 + c * 2; boff[m] = st * 1024 + (ob ^ (((ob >> 9) & 1) << 5)); }
    }
    const int nk = K / 64;
#define GT_STAGE(buf, t) do { const int _k0 = (t) * 64; LAS unsigned char* _ba = lds + (buf) * 32768 + woff; \
        _Pragma("unroll") for (int _i = 0; _i < 4; ++_i) { \
            __builtin_amdgcn_global_load_lds((const unsigned*)(aptr[_i] + _k0), (LAS unsigned*)(_ba + _i * 4096), 16, 0, 0); \
            __builtin_amdgcn_global_load_lds((const unsigned*)(bp(brow[_i], _k0) + bcol), (LAS unsigned*)(_ba + 16384 + _i * 4096), 16, 0, 0); } } while (0)
    if (!prefetched) GT_STAGE(0, 0);
#pragma unroll 1
    for (int t = 0; t < nk; ++t) {
        asm volatile("s_waitcnt vmcnt(0)" ::: "memory");
        __syncthreads();
        if (t + 1 < nk) GT_STAGE((t + 1) & 1, t + 1);
        else if (has_next) {
            LAS unsigned char* _ba = lds + woff;
#pragma unroll
            for (int _i = 0; _i < 4; ++_i) {
                __builtin_amdgcn_global_load_lds((const unsigned*)(apn(brow[_i]) + bcol), (LAS unsigned*)(_ba + _i * 4096), 16, 0, 0);
                __builtin_amdgcn_global_load_lds((const unsigned*)(bpn(brow[_i], 0) + bcol), (LAS unsigned*)(_ba + 16384 + _i * 4096), 16, 0, 0);
            }
        }
        LAS const unsigned char* la = lds + (t & 1) * 32768;
        LAS const unsigned char* lb = la + 16384;
#pragma unroll
        for (int kh = 0; kh < 2; ++kh) {
            bf16x8 At[4], Bt[4];
#pragma unroll
            for (int m = 0; m < 4; ++m) At[m] = *(const LAS bf16x8*)(la + aoff[m] + kh * 1024);
#pragma unroll
            for (int n = 0; n < 4; ++n) Bt[n] = *(const LAS bf16x8*)(lb + boff[n] + kh * 1024);
#pragma unroll
            for (int m = 0; m < 4; ++m)
#pragma unroll
                for (int n = 0; n < 4; ++n) acc[m][n] = __builtin_amdgcn_mfma_f32_16x16x32_bf16(Bt[n], At[m], acc[m][n], 0, 0, 0);
        }
    }
#undef GT_STAGE
#endif
}
__device__ __forceinline__ void zero_acc(f32x4 (&acc)[4][4]) {
#pragma unroll
    for (int m = 0; m < 4; ++m)
#pragma unroll
        for (int n = 0; n < 4; ++n) acc[m][n] = (f32x4){0.f, 0.f, 0.f, 0.f};
}
template <class AP, class BP, class EPI>
__device__ __forceinline__ void gemm_tile(const AP& ap, const BP& bp, int K, const EPI& epi, LAS unsigned char* lds, bool prefetched, bool has_next, const AP& apn, const BP& bpn) {
    const int tid = TID(), wid = tid >> 6, lane = tid & 63, wr = wid >> 1, wc = wid & 1, fr = lane & 15, fq = lane >> 4;
    f32x4 acc[4][4]; zero_acc(acc);
    gemm_kloop(acc, ap, bp, K, lds, prefetched, has_next, apn, bpn);
    epi(acc, wr, wc, fr, fq);
}

__device__ __forceinline__ float rinv_from_ssp(const float* ssp, int row) {
    const f32x4* q = (const f32x4*)(ssp + (size_t)row * 16);
    const f32x4 a = q[0], b = q[1], c = q[2], d = q[3];
    const float s = ((a.x + a.y) + (a.z + a.w)) + ((b.x + b.y) + (b.z + b.w)) + ((c.x + c.y) + (c.z + c.w)) + ((d.x + d.y) + (d.z + d.w));
    return 1.0f / sqrtf(s * (1.0f / ND) + 1e-6f);
}
__device__ __forceinline__ float row_ss64(const f32x4& a, const f32x4& b, const f32x4& c, const f32x4& d) {
    float s = ((a.x * a.x + a.y * a.y) + (a.z * a.z + a.w * a.w)) + ((b.x * b.x + b.y * b.y) + (b.z * b.z + b.w * b.w))
            + ((c.x * c.x + c.y * c.y) + (c.z * c.z + c.w * c.w)) + ((d.x * d.x + d.y * d.y) + (d.z * d.z + d.w * d.w));
    s += __shfl_xor(s, 16); s += __shfl_xor(s, 32);
    return s;
}
struct EpiInProj {
    int mt, nt; unsigned char* ws; const float* ssp;
    __device__ __forceinline__ void operator()(const f32x4 (&acc)[4][4], int wr, int wc, int fr, int fq) const {
#pragma unroll
        for (int m = 0; m < 4; ++m) {
            const int row = mt * 128 + wr * 64 + m * 16 + fr, b = row >> 11, s = row & 2047;
            const float rr = rinv_from_ssp(ssp, row);
#pragma unroll
            for (int n = 0; n < 4; ++n) {
                const int col = wc * 64 + n * 16 + 4 * fq;
                const f32x4 v = acc[m][n] * rr;
                if (nt < 16) {
                    const int reg = nt >> 2, c = (nt & 3) * 128 + col, head = c >> 6, d = c & 63;
                    const float sc = (reg == 0 || reg == 3) ? 0.125f * 1.4426950408889634f : 1.0f;
                    bf16_t* dst = (bf16_t*)(ws + WS_QA + (size_t)reg * 16 * MiB) + ((size_t)((b * 8 + head) * NS + s) * 64 + d);
                    u32x2 w; w.x = pk2(v.x * sc, v.y * sc); w.y = pk2(v.z * sc, v.w * sc);
                    *(u32x2*)dst = w;
                } else if (nt < 22) {
                    const int g = col >> 6, d = col & 63;
                    bf16_t* dst = (bf16_t*)(ws + WS_KV6 + (size_t)(nt - 16) * 4 * MiB) + ((size_t)((b * 2 + g) * NS + s) * 64 + d);
                    u32x2 w; w.x = pk2(v.x, v.y); w.y = pk2(v.z, v.w);
                    *(u32x2*)dst = w;
                } else {
                    if (col < 24) {
                        f32x4 o; o.x = sigmoidf_(v.x); o.y = sigmoidf_(v.y); o.z = sigmoidf_(v.z); o.w = sigmoidf_(v.w);
                        *(f32x4*)((float*)(ws + WS_GATES) + (size_t)row * 24 + col) = o;
                    }
                }
            }
        }
    }
};
struct EpiCmp1 {
    bf16_t* hc; const float* bc1; int row0, col0;
    __device__ __forceinline__ void operator()(const f32x4 (&acc)[4][4], int wr, int wc, int fr, int fq) const {
#pragma unroll
        for (int m = 0; m < 4; ++m) {
            const int row = row0 + wr * 64 + m * 16 + fr;
#pragma unroll
            for (int n = 0; n < 4; ++n) {
                const int col = col0 + wc * 64 + n * 16 + 4 * fq;
                f32x4 bb = *(const f32x4*)(bc1 + col);
#pragma unroll
                for (int pp = 1; pp < 16; ++pp) bb += *(const f32x4*)(bc1 + pp * 1024 + col);
                const f32x4 v = acc[m][n];
                u32x2 w; w.x = pk2(gelu_tanh(v.x + bb.x), gelu_tanh(v.y + bb.y)); w.y = pk2(gelu_tanh(v.z + bb.z), gelu_tanh(v.w + bb.w));
                *(u32x2*)(hc + (size_t)row * 256 + col) = w;
            }
        }
    }
};
struct EpiCmp2 {
    bf16_t* dst; int row0;
    __device__ __forceinline__ void operator()(const f32x4 (&acc)[4][4], int wr, int wc, int fr, int fq) const {
        if (wc != 0) return;
#pragma unroll
        for (int m = 0; m < 4; ++m) {
            const int row = row0 + wr * 64 + m * 16 + fr;
#pragma unroll
            for (int n = 0; n < 4; ++n) {
                const int col = n * 16 + 4 * fq;
                const f32x4 v = acc[m][n];
                u32x2 w; w.x = pk2(v.x, v.y); w.y = pk2(v.z, v.w);
                *(u32x2*)(dst + (size_t)row * 64 + col) = w;
            }
        }
    }
};
struct EpiResAdd {
    bf16_t* res; int row0, col0;
    __device__ __forceinline__ void operator()(const f32x4 (&acc)[4][4], int wr, int wc, int fr, int fq) const {
#pragma unroll
        for (int m = 0; m < 4; ++m) {
            const int row = row0 + wr * 64 + m * 16 + fr;
#pragma unroll
            for (int n = 0; n < 4; ++n) {
                const int col = col0 + wc * 64 + n * 16 + 4 * fq;
                u32x2* pp = (u32x2*)(res + (size_t)row * ND + col);
                const u32x2 b = *pp; const f32x4 a = acc[m][n];
                u32x2 w; w.x = pk2(bflo(b.x) + a.x, bfhi(b.x) + a.y); w.y = pk2(bflo(b.y) + a.z, bfhi(b.y) + a.w);
                *pp = w;
            }
        }
    }
};
struct EpiMoeGU {
    bf16_t* hid; const int* list; const float* route; const float* rinv; int cnt, hrow0, nt16;
    __device__ __forceinline__ void operator()(const f32x4 (&acc)[4][4], int wr, int wc, int fr, int fq) const {
        const int half = nt16 >> 3, nte = nt16 & 7;
#pragma unroll
        for (int m = 0; m < 4; ++m) {
            const int r = wr * 64 + m * 16 + fr;
            const int tok = r < cnt ? list[r] : 0;
            const float w = r < cnt ? route[2 * tok + half] : 0.f;
            const float rt = rinv[tok];
#pragma unroll
            for (int pr = 0; pr < 2; ++pr) {
                const f32x4 gv = acc[m][2 * pr], uv = acc[m][2 * pr + 1];
                const int hc = half * 512 + (4 * nte + 2 * wc + pr) * 16 + 4 * fq;
                float h[4];
#pragma unroll
                for (int j = 0; j < 4; ++j) { const float gg = gv[j] * rt; h[j] = gg / (1.0f + __expf(-gg)) * (uv[j] * rt) * w; }
                u32x2 o; o.x = pk2(h[0], h[1]); o.y = pk2(h[2], h[3]);
                *(u32x2*)(hid + (size_t)(hrow0 + r) * 1024 + hc) = o;
            }
        }
    }
};
struct EpiMoeDown {
    bf16_t* res; const int* list; float* ssp; int cnt, col0;
    __device__ __forceinline__ void operator()(const f32x4 (&acc)[4][4], int wr, int wc, int fr, int fq) const {
#pragma unroll
        for (int m = 0; m < 4; ++m) {
            const int r = wr * 64 + m * 16 + fr;
            const bool ok = r < cnt;
            const int tok = ok ? list[r] : 0;
            f32x4 nv[4];
#pragma unroll
            for (int n = 0; n < 4; ++n) {
                const int col = col0 + wc * 64 + n * 16 + 4 * fq;
                u32x2* pp = (u32x2*)(res + (size_t)tok * ND + col);
                const u32x2 b = *pp; const f32x4 a = acc[m][n];
                nv[n] = (f32x4){bflo(b.x) + a.x, bfhi(b.x) + a.y, bflo(b.y) + a.z, bfhi(b.y) + a.w};
                if (ok) { u32x2 w; w.x = pk2(nv[n].x, nv[n].y); w.y = pk2(nv[n].z, nv[n].w); *pp = w; }
            }
            const float ps = row_ss64(nv[0], nv[1], nv[2], nv[3]);
            if (ok && fq == 0) ssp[(size_t)tok * 16 + (col0 >> 6) + wc] = ps;
        }
    }
};
struct EpiBf16 {
    bf16_t* dst; int ld, row0, col0;
    __device__ __forceinline__ void operator()(const f32x4 (&acc)[4][4], int wr, int wc, int fr, int fq) const {
#pragma unroll
        for (int m = 0; m < 4; ++m) {
            const int row = row0 + wr * 64 + m * 16 + fr;
#pragma unroll
            for (int n = 0; n < 4; ++n) {
                const int col = col0 + wc * 64 + n * 16 + 4 * fq;
                const f32x4 v = acc[m][n];
                u32x2 w; w.x = pk2(v.x, v.y); w.y = pk2(v.z, v.w);
                *(u32x2*)(dst + (size_t)row * ld + col) = w;
            }
        }
    }
};
struct EpiPleFused {
    const bf16_t* rin; const float* ssp_in; bf16_t* rout; float* ssp_out; int row0, col0;
    __device__ __forceinline__ void operator()(const f32x4 (&acc)[4][4], const f32x4 (&acc2)[4][4], int wr, int wc, int fr, int fq) const {
#pragma unroll
        for (int m = 0; m < 4; ++m) {
            const int row = row0 + wr * 64 + m * 16 + fr;
            const float rr = rinv_from_ssp(ssp_in, row);
            f32x4 nv[4];
#pragma unroll
            for (int n = 0; n < 4; ++n) {
                const int col = col0 + wc * 64 + n * 16 + 4 * fq;
                const size_t off = (size_t)row * ND + col;
                const f32x4 v = acc[m][n] * rr, q = acc2[m][n];
                const u32x2 b = *(const u32x2*)(rin + off);
                f32x4 o = (f32x4){bflo(b.x), bfhi(b.x), bflo(b.y), bfhi(b.y)};
                o.x += sigmoidf_(v.x) * q.x; o.y += sigmoidf_(v.y) * q.y; o.z += sigmoidf_(v.z) * q.z; o.w += sigmoidf_(v.w) * q.w;
                u32x2 w; w.x = pk2(o.x, o.y); w.y = pk2(o.z, o.w);
                *(u32x2*)(rout + off) = w;
                nv[n] = o;
            }
            const float ps = row_ss64(nv[0], nv[1], nv[2], nv[3]);
            if (fq == 0) ssp_out[(size_t)row * 16 + (col0 >> 6) + wc] = ps;
        }
    }
};
struct EpiPleGate {
    float* out; const bf16_t* p2; int row0, col0; float sc;
    __device__ __forceinline__ void operator()(const f32x4 (&acc)[4][4], int wr, int wc, int fr, int fq) const {
#pragma unroll
        for (int m = 0; m < 4; ++m) {
            const int row = row0 + wr * 64 + m * 16 + fr;
#pragma unroll
            for (int n = 0; n < 4; ++n) {
                const int col = col0 + wc * 64 + n * 16 + 4 * fq;
                const size_t off = (size_t)row * ND + col;
                const u32x2 pv = *(const u32x2*)(p2 + off);
                const f32x4 v = acc[m][n];
                f32x4 o = *(const f32x4*)(out + off);
                o.x += sc * sigmoidf_(v.x) * bflo(pv.x); o.y += sc * sigmoidf_(v.y) * bfhi(pv.x); o.z += sc * sigmoidf_(v.z) * bflo(pv.y); o.w += sc * sigmoidf_(v.w) * bfhi(pv.y);
                *(f32x4*)(out + off) = o;
            }
        }
    }
};

template <class PH, class AP, class BP, class EPI>
__device__ __forceinline__ void gemm_stream(const PH& ph, int first, int step, int count, int K, LAS unsigned char* lds) {
    int q = first;
    if (q >= count) return;
    AP ap, apn; BP bp, bpn; EPI ep, epn;
    ph.make(q, ap, bp, ep);
    bool pref = false;
    for (;;) {
        const int qn = q + step; const bool hn = qn < count;
        if (hn) ph.make(qn, apn, bpn, epn); else { apn = ap; bpn = bp; epn = ep; }
        gemm_tile(ap, bp, K, ep, lds, pref, hn, apn, bpn);
        if (!hn) break;
        ap = apn; bp = bpn; ep = epn; q = qn; pref = true;
    }
}

__device__ __forceinline__ void load_q32(const bf16_t* p, float* q) {
#pragma unroll
    for (int c = 0; c < 4; ++c) {
        const u32x4 v = ((const u32x4*)p)[c];
        q[8 * c] = bflo(v.x); q[8 * c + 1] = bfhi(v.x); q[8 * c + 2] = bflo(v.y); q[8 * c + 3] = bfhi(v.y);
        q[8 * c + 4] = bflo(v.z); q[8 * c + 5] = bfhi(v.z); q[8 * c + 6] = bflo(v.w); q[8 * c + 7] = bfhi(v.w);
    }
}
__device__ __forceinline__ float dot32p(const float* q, const bf16_t* k) {
    float s0 = 0.f, s1 = 0.f;
#pragma unroll
    for (int c = 0; c < 4; ++c) {
        const u32x4 v = ((const u32x4*)k)[c];
        s0 += q[8 * c] * bflo(v.x); s1 += q[8 * c + 1] * bfhi(v.x); s0 += q[8 * c + 2] * bflo(v.y); s1 += q[8 * c + 3] * bfhi(v.y);
        s0 += q[8 * c + 4] * bflo(v.z); s1 += q[8 * c + 5] * bfhi(v.z); s0 += q[8 * c + 6] * bflo(v.w); s1 += q[8 * c + 7] * bfhi(v.w);
    }
    const float s = s0 + s1;
    return s + __shfl_xor(s, 1);
}
__device__ __forceinline__ void axpy32(float* a, float p, const bf16_t* vr) {
#pragma unroll
    for (int c = 0; c < 4; ++c) {
        const u32x4 v = ((const u32x4*)vr)[c];
        a[8 * c] += p * bflo(v.x); a[8 * c + 1] += p * bfhi(v.x); a[8 * c + 2] += p * bflo(v.y); a[8 * c + 3] += p * bfhi(v.y);
        a[8 * c + 4] += p * bflo(v.z); a[8 * c + 5] += p * bfhi(v.z); a[8 * c + 6] += p * bflo(v.w); a[8 * c + 7] += p * bfhi(v.w);
    }
}
#define ONLINE_STEP(s_, vrow_) do { const float _s = (s_); if (_s > mx) { const float _c = __expf(mx - _s); l *= _c; _Pragma("unroll") for (int _i = 0; _i < 32; ++_i) acc[_i] *= _c; mx = _s; } \
    const float _p = __expf(_s - mx); l += _p; axpy32(acc, _p, (vrow_)); } while (0)

__device__ __forceinline__ void store_o32(bf16_t* dst, const float* a, float sc) {
#pragma unroll
    for (int c = 0; c < 4; ++c) {
        u32x4 w; w.x = pk2(a[8 * c] * sc, a[8 * c + 1] * sc); w.y = pk2(a[8 * c + 2] * sc, a[8 * c + 3] * sc);
        w.z = pk2(a[8 * c + 4] * sc, a[8 * c + 5] * sc); w.w = pk2(a[8 * c + 6] * sc, a[8 * c + 7] * sc);
        ((u32x4*)dst)[c] = w;
    }
}

__device__ __forceinline__ void attn_dilated_naive(const unsigned char* ws, int gtid, int gthreads) {
    asm volatile("" : "+v"(gtid));
    const bf16_t* qa = (const bf16_t*)(ws + WS_QA); const bf16_t* ka = (const bf16_t*)(ws + WS_KA); const bf16_t* va = (const bf16_t*)(ws + WS_VA);
    bf16_t* ob = (bf16_t*)(ws + WS_O);
    for (int id2 = gtid; id2 < NB * 8 * NS * 2; id2 += gthreads) {
        const int idx = id2 >> 1, hf = (id2 & 1) * 32;
        const int t = idx & 2047, bh = idx >> 11, h = bh & 7, b = bh >> 3;
        float q[32]; load_q32(qa + (size_t)idx * 64 + hf, q);
        const bf16_t* kb = ka + (size_t)bh * NS * 64 + hf; const bf16_t* vb = va + (size_t)bh * NS * 64 + hf;
        const float slope = exp2f(-((float)h + 0.5f));
        float mx = -1e30f, l = 0.f; float acc[32];
#pragma unroll
        for (int i = 0; i < 32; ++i) acc[i] = 0.f;
#pragma unroll 1
        for (int pat = 0; pat < 3; ++pat) {
            const int dil = pat == 0 ? 1 : (pat == 1 ? 4 : 16);
#pragma unroll 1
            for (int j = 0; j <= 128; ++j) {
                const int dist = j * dil, pos = t - dist;
                if (pos < 0) break;
                const float s = dot32p(q, kb + (size_t)pos * 64) - slope * (float)dist;
                ONLINE_STEP(s, vb + (size_t)pos * 64);
            }
        }
        store_o32(ob + ((size_t)(b * NS + t) * ND + h * 64 + hf), acc, 1.0f / l);
    }
}

__device__ __forceinline__ void nsa_imp_naive(const unsigned char* ws, int gtid, int gthreads) {
    asm volatile("" : "+v"(gtid));
    const bf16_t* qb = (const bf16_t*)(ws + WS_QB); const bf16_t* kcmp = (const bf16_t*)(ws + WS_KCMP);
    float* imph = (float*)(ws + WS_IMPH);
    for (int id2 = gtid; id2 < NB * 8 * NS * 2; id2 += gthreads) {
        const int idx = id2 >> 1, hf = (id2 & 1) * 32;
        const int t = idx & 2047, bh = idx >> 11, hb = bh & 7, b = bh >> 3, g = hb >> 2;
        float q[32]; load_q32(qb + (size_t)idx * 64 + hf, q);
        const bf16_t* kc = kcmp + (size_t)(b * 2 + g) * 128 * 64 + hf;
        const float slope = exp2f(-(float)(hb + 1));
        const int ncv = t >= 31 ? ((t - 31) >> 4) + 1 : 0;
        float mx = -1e30f;
#pragma unroll 1
        for (int c = 0; c < ncv; ++c) { const float s = dot32p(q, kc + c * 64) - slope * (float)(t - (16 * c + 31)); mx = fmaxf(mx, s); }
        float den = 0.f;
#pragma unroll 1
        for (int c = 0; c < ncv; ++c) { const float s = dot32p(q, kc + c * 64) - slope * (float)(t - (16 * c + 31)); den += __expf(s - mx); }
        const float inv = ncv > 0 ? 1.0f / den : 0.f;
#pragma unroll 1
        for (int n = 0; n < 32; ++n) {
            float imp = 0.f;
#pragma unroll 1
            for (int j = -1; j <= 3; ++j) {
                const int c = 4 * n + j;
                if (c >= 0 && c < ncv) {
                    const float s = dot32p(q, kc + c * 64) - slope * (float)(t - (16 * c + 31));
                    const float pp = __expf(s - mx) * inv;
                    imp += (j == -1 || j == 3) ? 0.5f * pp : pp;
                }
            }
            if (hf == 0) imph[(size_t)idx * 32 + n] = imp;
        }
    }
}
__device__ __forceinline__ void nsa_select(const unsigned char* ws, unsigned* maskbuf) {
    const float* imph = (const float*)(ws + WS_IMPH);
    const int tid_ = TID(); const int lane = tid_ & 63, gw = BID() * 4 + (tid_ >> 6), ngw = gridDim.x * 4;
    for (int it = gw; it < NB * 2 * NS / 2; it += ngw) {
        const int item = it * 2 + (lane >> 5), t = item & 2047, bg = item >> 11, n = lane & 31;
        float imp = 0.f;
#pragma unroll
        for (int r = 0; r < 4; ++r) imp += imph[((size_t)(bg * 4 + r) * NS + t) * 32 + n];
        const int cur = t >> 6;
        const bool valid = n <= cur;
        const bool forced = (n == 0) || (cur - n < 2);
        const float score = valid ? imp + (forced ? 1e4f : 0.f) : -1e30f;
        int rank = 0;
        for (int m = 0; m < 32; ++m) {
            const float sm = __shfl(score, (lane & 32) | m);
            rank += (sm > score || (sm == score && m < n)) ? 1 : 0;
        }
        const bool sel = valid && rank < 16;
        const unsigned long long bal = __ballot(sel);
        if (n == 0) maskbuf[item] = (lane >> 5) ? (unsigned)(bal >> 32) : (unsigned)bal;
    }
}
__device__ __forceinline__ void nsa_attn_naive(const unsigned char* ws, int gtid, int gthreads) {
    asm volatile("" : "+v"(gtid));
    const bf16_t* qb = (const bf16_t*)(ws + WS_QB);
    const bf16_t* kcmp = (const bf16_t*)(ws + WS_KCMP); const bf16_t* vcmp = kcmp + (size_t)16 * 128 * 64;
    const bf16_t* ksb = (const bf16_t*)(ws + WS_KV6 + 2 * 4 * MiB); const bf16_t* vsb = (const bf16_t*)(ws + WS_KV6 + 3 * 4 * MiB);
    const bf16_t* kwb = (const bf16_t*)(ws + WS_KV6 + 4 * 4 * MiB); const bf16_t* vwb = (const bf16_t*)(ws + WS_KV6 + 5 * 4 * MiB);
    const float* gates = (const float*)(ws + WS_GATES);
    const unsigned* maskbuf = (const unsigned*)(ws + WS_MASK);
    bf16_t* ob = (bf16_t*)(ws + WS_O);
    for (int id2 = gtid; id2 < NB * 8 * NS * 2; id2 += gthreads) {
        const int idx = id2 >> 1, hf = (id2 & 1) * 32;
        const int t = idx & 2047, bh = idx >> 11, hb = bh & 7, b = bh >> 3, g = hb >> 2, bg = b * 2 + g;
        float q[32]; load_q32(qb + (size_t)idx * 64 + hf, q);
        const float slope = exp2f(-(float)(hb + 1));
        const float* gt = gates + (size_t)(b * NS + t) * 24 + hb * 3;
        float tot[32], acc[32];
#pragma unroll
        for (int i = 0; i < 32; ++i) tot[i] = 0.f;
        {
            const bf16_t* kc = kcmp + (size_t)bg * 128 * 64 + hf; const bf16_t* vc = vcmp + (size_t)bg * 128 * 64 + hf;
            const int ncv = t >= 31 ? ((t - 31) >> 4) + 1 : 0;
            if (ncv > 0) {
                float mx = -1e30f, l = 0.f;
#pragma unroll
                for (int i = 0; i < 32; ++i) acc[i] = 0.f;
#pragma unroll 1
                for (int c = 0; c < ncv; ++c) { const float s = dot32p(q, kc + c * 64) - slope * (float)(t - (16 * c + 31)); ONLINE_STEP(s, vc + c * 64); }
                const float sc = gt[0] / l;
#pragma unroll
                for (int i = 0; i < 32; ++i) tot[i] += sc * acc[i];
            }
        }
        {
            const bf16_t* kb = ksb + (size_t)bg * NS * 64 + hf; const bf16_t* vb = vsb + (size_t)bg * NS * 64 + hf;
            const unsigned mask = maskbuf[bg * NS + t];
            float mx = -1e30f, l = 0.f;
#pragma unroll
            for (int i = 0; i < 32; ++i) acc[i] = 0.f;
#pragma unroll 1
            for (int n = 0; n < 32; ++n) {
                if (!((mask >> n) & 1u)) continue;
#pragma unroll 1
                for (int i = 0; i < 64; ++i) {
                    const int pos = n * 64 + i;
                    if (pos > t) break;
                    const float s = dot32p(q, kb + (size_t)pos * 64) - slope * (float)(t - pos);
                    ONLINE_STEP(s, vb + (size_t)pos * 64);
                }
            }
            const float sc = gt[1] / l;
#pragma unroll
            for (int i = 0; i < 32; ++i) tot[i] += sc * acc[i];
        }
        {
            const bf16_t* kb = kwb + (size_t)bg * NS * 64 + hf; const bf16_t* vb = vwb + (size_t)bg * NS * 64 + hf;
            float mx = -1e30f, l = 0.f;
#pragma unroll
            for (int i = 0; i < 32; ++i) acc[i] = 0.f;
#pragma unroll 1
            for (int dist = 0; dist < 512; ++dist) {
                const int pos = t - dist;
                if (pos < 0) break;
                const float s = dot32p(q, kb + (size_t)pos * 64) - slope * (float)dist;
                ONLINE_STEP(s, vb + (size_t)pos * 64);
            }
            const float sc = gt[2] / l;
#pragma unroll
            for (int i = 0; i < 32; ++i) tot[i] += sc * acc[i];
        }
        store_o32(ob + ((size_t)(b * NS + t) * ND + 512 + hb * 64 + hf), tot, 1.0f);
    }
}

constexpr int KVS = 144;
constexpr int KVT = 64 * KVS;
constexpr int VS = 128;
constexpr int VT = 64 * VS;
#define LOG2E_F 1.4426950408889634f
__device__ __forceinline__ unsigned cvtpk(float lo, float hi) { f32x2_t v = {lo, hi}; bf16x2_t b = __builtin_convertvector(v, bf16x2_t); return __builtin_bit_cast(unsigned, b); }
__device__ __forceinline__ s16x4 vtr(LAS const unsigned char* p) { return __builtin_bit_cast(s16x4, __builtin_amdgcn_ds_read_tr16_b64_v4i16((LAS s16x4*)p)); }
__device__ __forceinline__ f32x16 zero16() { f32x16 z;
#pragma unroll
    for (int i = 0; i < 16; ++i) z[i] = 0.f;
    return z; }

__device__ __forceinline__ void load_kv_tile(LAS unsigned char* Kt, LAS unsigned char* Vt, const bf16_t* kbase, const bf16_t* vbase, int row0, int rstride, int rmin, int rmax, int tid) {
    const int j = tid >> 2, ch = tid & 3;
    int tok = row0 + j * rstride; tok = tok < rmin ? rmin : (tok > rmax ? rmax : tok);
    const u32x4* kp = (const u32x4*)(kbase + (size_t)tok * 64);
    const u32x4* vp = (const u32x4*)(vbase + (size_t)tok * 64);
    const u32x4 k0 = kp[ch], k1 = kp[ch + 4], v0 = vp[ch], v1 = vp[ch + 4];
    *(LAS u32x4*)(Kt + j * KVS + ch * 16) = k0; *(LAS u32x4*)(Kt + j * KVS + (ch + 4) * 16) = k1;
    { const int sx = 2 * (j & 3); *(LAS u32x4*)(Vt + j * VS + ((ch ^ sx) * 16)) = v0; *(LAS u32x4*)(Vt + j * VS + (((ch + 4) ^ sx) * 16)) = v1; }
}

struct KVRegs { u32x4 k0, k1, v0, v1; };
__device__ __forceinline__ void kv_fetch(KVRegs& r, const bf16_t* kbase, const bf16_t* vbase, int row0, int rstride, int rmin, int rmax, int tid) {
    const int j = tid >> 2, ch = tid & 3;
    int tok = row0 + j * rstride; tok = tok < rmin ? rmin : (tok > rmax ? rmax : tok);
    const u32x4* kp = (const u32x4*)(kbase + (size_t)tok * 64);
    const u32x4* vp = (const u32x4*)(vbase + (size_t)tok * 64);
    r.k0 = kp[ch]; r.k1 = kp[ch + 4]; r.v0 = vp[ch]; r.v1 = vp[ch + 4];
}
__device__ __forceinline__ void kv_commit(const KVRegs& r, LAS unsigned char* Kt, LAS unsigned char* Vt, int tid) {
    const int j = tid >> 2, ch = tid & 3;
    *(LAS u32x4*)(Kt + j * KVS + ch * 16) = r.k0; *(LAS u32x4*)(Kt + j * KVS + (ch + 4) * 16) = r.k1;
    { const int sx = 2 * (j & 3); *(LAS u32x4*)(Vt + j * VS + ((ch ^ sx) * 16)) = r.v0; *(LAS u32x4*)(Vt + j * VS + (((ch + 4) ^ sx) * 16)) = r.v1; }
}
__device__ __forceinline__ void pv32(f32x16& o0, f32x16& o1, const f32x16& sv, LAS const unsigned char* vp0, LAS const unsigned char* vp1  ) {
#pragma unroll
    for (int s16 = 0; s16 < 2; ++s16) {
        u32x4 pw;
        pw.x = cvtpk(sv[8 * s16 + 0], sv[8 * s16 + 1]); pw.y = cvtpk(sv[8 * s16 + 2], sv[8 * s16 + 3]);
        pw.z = cvtpk(sv[8 * s16 + 4], sv[8 * s16 + 5]); pw.w = cvtpk(sv[8 * s16 + 6], sv[8 * s16 + 7]);
        const bf16x8 pf = __builtin_bit_cast(bf16x8, pw);
        const s16x4 a0 = vtr(vp0 + s16 * 16 * VS), b0 = vtr(vp0 + s16 * 16 * VS + 8 * VS), a1 = vtr(vp1 + s16 * 16 * VS), b1 = vtr(vp1 + s16 * 16 * VS + 8 * VS);
        const bf16x8 vf0 = {a0[0], a0[1], a0[2], a0[3], b0[0], b0[1], b0[2], b0[3]};
        const bf16x8 vf1 = {a1[0], a1[1], a1[2], a1[3], b1[0], b1[1], b1[2], b1[3]};
        o0 = __builtin_amdgcn_mfma_f32_32x32x16_bf16(vf0, pf, o0, 0, 0, 0);
        o1 = __builtin_amdgcn_mfma_f32_32x32x16_bf16(vf1, pf, o1, 0, 0, 0);
    }
}
__device__ __forceinline__ f32x16 qk32(const bf16x8* qf, LAS const unsigned char* kp  , f32x16 s  ) {
#pragma unroll
    for (int k = 0; k < 4; ++k) {
        const bf16x8 kf = *(const LAS bf16x8*)(kp + 32 * k);
        s = __builtin_amdgcn_mfma_f32_32x32x16_bf16(kf, qf[k], s, 0, 0, 0);
    }
    return s;
}
template <int KS, bool TRY_FULL>
__device__ __forceinline__ void fa_tile64(f32x16& o0, f32x16& o1, float& m, float& l, const bf16x8* qf, LAS const unsigned char* Kt, LAS const unsigned char* Vt, int lane, float dA, float wmax, float ns2) {
    const int r = lane & 31, h = lane >> 5;
    LAS const unsigned char* kp = Kt + r * KVS + 16 * h;
    const float dAh = dA - (float)(KS * 4 * h);
    const float hi = dAh, lo = dAh - wmax, base = ns2 * dAh;
    f32x16 s0, s1;
#pragma unroll
    for (int i = 0; i < 16; ++i) {
        const float c0 = (float)(KS * ((i & 3) + 8 * (i >> 2))), c1 = c0 + (float)(32 * KS);
        s0[i] = fmaf(-c0, ns2, base); s1[i] = fmaf(-c1, ns2, base);
    }
    s0 = qk32(qf, kp, s0); s1 = qk32(qf, kp + 32 * KVS, s1);
    float tmax = -1e30f;
    if (TRY_FULL && __all(lo <= 0.f && hi >= (float)(59 * KS))) {
#pragma unroll
        for (int i = 0; i < 16; ++i) tmax = fmaxf(tmax, fmaxf(s0[i], s1[i]));
    } else {
#pragma unroll
        for (int i = 0; i < 16; ++i) {
            const float c0 = (float)(KS * ((i & 3) + 8 * (i >> 2))), c1 = c0 + (float)(32 * KS);
            const float t0 = (c0 >= lo && c0 <= hi) ? s0[i] : -1e30f;
            const float t1 = (c1 >= lo && c1 <= hi) ? s1[i] : -1e30f;
            s0[i] = t0; s1[i] = t1;
            tmax = fmaxf(tmax, fmaxf(t0, t1));
        }
    }
    tmax = fmaxf(tmax, __shfl_xor(tmax, 32));
    const float mn = fmaxf(m, tmax);
    const float corr = __builtin_amdgcn_exp2f(m - mn);
    m = mn;
    const float mu = fmaxf(mn, -1e29f);
    float ps = 0.f;
#pragma unroll
    for (int i = 0; i < 16; ++i) {
        s0[i] = __builtin_amdgcn_exp2f(s0[i] - mu); s1[i] = __builtin_amdgcn_exp2f(s1[i] - mu);
        ps += s0[i] + s1[i];
    }
    l = l * corr + ps;
    if (!__all(corr == 1.0f)) {
#pragma unroll
        for (int i = 0; i < 16; ++i) { o0[i] *= corr; o1[i] *= corr; }
    }
    const int vq = (lane & 15) >> 2, vc0 = 2 * ((lane >> 4) & 1) + ((lane & 3) >> 1), vsx = 2 * vq;
    LAS const unsigned char* vp0 = Vt + (4 * h + vq) * VS + ((vc0 ^ vsx) * 16) + 8 * (lane & 1);
    LAS const unsigned char* vp1 = Vt + (4 * h + vq) * VS + (((vc0 + 4) ^ vsx) * 16) + 8 * (lane & 1);
    pv32(o0, o1, s0, vp0, vp1);
    pv32(o0, o1, s1, vp0 + 32 * VS, vp1 + 32 * VS);
}
__device__ __forceinline__ void acc_scaled(f32x16& t0, f32x16& t1, const f32x16& o0, const f32x16& o1, float sc) {
#pragma unroll
    for (int i = 0; i < 16; ++i) { t0[i] += sc * o0[i]; t1[i] += sc * o1[i]; }
}
__device__ __forceinline__ void store_ot(bf16_t* orow, const f32x16& o0, const f32x16& o1, float sc, int h) {
#pragma unroll
    for (int u = 0; u < 4; ++u) {
        u32x2 w0, w1;
        w0.x = cvtpk(o0[4 * u] * sc, o0[4 * u + 1] * sc); w0.y = cvtpk(o0[4 * u + 2] * sc, o0[4 * u + 3] * sc);
        w1.x = cvtpk(o1[4 * u] * sc, o1[4 * u + 1] * sc); w1.y = cvtpk(o1[4 * u + 2] * sc, o1[4 * u + 3] * sc);
        *(u32x2*)(orow + 8 * u + 4 * h) = w0;
        *(u32x2*)(orow + 32 + 8 * u + 4 * h) = w1;
    }
}
__device__ __forceinline__ void load_qf(bf16x8* qf, const bf16_t* qrow, int h) {
#pragma unroll
    for (int k = 0; k < 4; ++k) qf[k] = *(const bf16x8*)(qrow + 16 * k + 8 * h);
}

__device__ __forceinline__ void dil_item(unsigned char* ws, int item, LAS unsigned char* lds) {
    const int tid = TID(), lane = tid & 63, w = tid >> 6, c = lane & 31, h = lane >> 5;
    const int bh = item / 48, rem = item % 48, pat = rem >> 4, idx = rem & 15;
    const int dil = pat == 0 ? 1 : (pat == 1 ? 4 : 16), nqt = 16 / dil, res = idx / nqt, qt = idx % nqt;
    const int hd = bh & 7, b = bh >> 3;
    const int q0 = qt * 128 + 32 * w, iq = q0 + c, t = res + iq * dil;
    const bf16_t* qa = (const bf16_t*)(ws + WS_QA) + (size_t)bh * NS * 64;
    const bf16_t* ka = (const bf16_t*)(ws + WS_KA) + (size_t)bh * NS * 64;
    const bf16_t* va = (const bf16_t*)(ws + WS_VA) + (size_t)bh * NS * 64;
    bf16x8 qf[4]; load_qf(qf, qa + (size_t)t * 64, h);
    const float ns2 = -exp2f(-((float)hd + 0.5f)) * (float)dil * LOG2E_F;
    f32x16 o0 = zero16(), o1 = zero16(); float m = -1e30f, l = 0.f;
    {
        const int T0 = qt == 0 ? 2 : 0;
        KVRegs kr; kv_fetch(kr, ka, va, res + (qt * 128 - 128 + 64 * T0) * dil, dil, 0, NS - 1, tid);
        int buf = 0;
        for (int T = T0; T < 4; ++T) {
            const int kb = qt * 128 - 128 + 64 * T;
            LAS unsigned char* Kt = lds + buf * KVT; LAS unsigned char* Vt = lds + 2 * KVT + buf * VT;
            kv_commit(kr, Kt, Vt, tid);
            __syncthreads();
            if (T + 1 < 4) kv_fetch(kr, ka, va, res + (kb + 64) * dil, dil, 0, NS - 1, tid);
            if (kb <= q0 + 31 && kb + 63 >= q0 - 128)
                fa_tile64<1, true>(o0, o1, m, l, qf, Kt, Vt, lane, (float)(iq - kb), 128.f, ns2);
            buf ^= 1;
        }
    }
    const float lt = l + __shfl_xor(l, 32);
    bf16_t* op = (bf16_t*)(pat < 2 ? ws + WS_OPA01 + (size_t)pat * 16 * MiB : ws + WS_OPA2);
    store_ot(op + ((size_t)(b * NS + t) * 512 + hd * 64), o0, o1, 1.0f / lt, h);
    if (h == 0) { float* st = (float*)(ws + WS_STA) + ((size_t)pat * NB * 8 * NS + (size_t)bh * NS + t) * 2; st[0] = m; st[1] = lt; }
}
__device__ __forceinline__ void dil_merge(unsigned char* ws, int gtid, int gthreads) {
    asm volatile("" : "+v"(gtid));
    const float* sta = (const float*)(ws + WS_STA);
    bf16_t* ob = (bf16_t*)(ws + WS_O);
    for (int it = gtid; it < NT * 8 * 8; it += gthreads) {
        const int ch = it & 7, hd = (it >> 3) & 7, tk = it >> 6, b = tk >> 11, t = tk & 2047;
        float mm[3], ll[3];
#pragma unroll
        for (int p = 0; p < 3; ++p) { const float* s = sta + ((size_t)p * NB * 8 * NS + (size_t)(b * 8 + hd) * NS + t) * 2; mm[p] = s[0]; ll[p] = s[1]; }
        const float M = fmaxf(mm[0], fmaxf(mm[1], mm[2]));
        float wgt[3], den = 0.f;
#pragma unroll
        for (int p = 0; p < 3; ++p) { wgt[p] = __builtin_amdgcn_exp2f(mm[p] - M) * ll[p]; den += wgt[p]; }
        const float inv = 1.0f / den;
        float a[8];
#pragma unroll
        for (int i = 0; i < 8; ++i) a[i] = 0.f;
#pragma unroll
        for (int p = 0; p < 3; ++p) {
            const bf16_t* op = (const bf16_t*)(p < 2 ? ws + WS_OPA01 + (size_t)p * 16 * MiB : ws + WS_OPA2);
            const u32x4 v = *(const u32x4*)(op + (size_t)tk * 512 + hd * 64 + ch * 8);
            const float wp = wgt[p] * inv;
            a[0] += wp * bflo(v.x); a[1] += wp * bfhi(v.x); a[2] += wp * bflo(v.y); a[3] += wp * bfhi(v.y);
            a[4] += wp * bflo(v.z); a[5] += wp * bfhi(v.z); a[6] += wp * bflo(v.w); a[7] += wp * bfhi(v.w);
        }
        u32x4 o; o.x = pk2(a[0], a[1]); o.y = pk2(a[2], a[3]); o.z = pk2(a[4], a[5]); o.w = pk2(a[6], a[7]);
        *(u32x4*)(ob + (size_t)tk * ND + hd * 64 + ch * 8) = o;
    }
}

constexpr int LDS_IMP = 4 * KVT;
constexpr int LDS_UNI = LDS_IMP + 4096;
constexpr int LDS_TOT = 41088;
__device__ __forceinline__ void nsa_item(unsigned char* ws, int item, LAS unsigned char* lds) {
    const int tid = TID(), lane = tid & 63, w = tid >> 6, c = lane & 31, h = lane >> 5;
    const int bg = item & 15, tt = item >> 4, b = bg >> 1, g = bg & 1;
    const int t0 = tt * 32, tok8 = c & 7, hh = c >> 3, hb = g * 4 + hh, t = t0 + 8 * w + tok8;
    const bf16_t* qrow = (const bf16_t*)(ws + WS_QB) + ((size_t)(b * 8 + hb) * NS + t) * 64;
    bf16x8 qf[4]; load_qf(qf, qrow, h);
    const float ns2 = -exp2f(-(float)(hb + 1)) * LOG2E_F;
    const float* gt = (const float*)(ws + WS_GATES) + (size_t)(b * NS + t) * 24 + hb * 3;
    const float g0 = gt[0], g1 = gt[1], g2 = gt[2];
    LAS float* totL = (LAS float*)(lds + LDS_TOT) + tid;
    LAS unsigned char* Kt = lds; LAS unsigned char* Vt = lds + 2 * KVT;
    LAS float* impL = (LAS float*)(lds + LDS_IMP) + w * 256;
    LAS unsigned* uni = (LAS unsigned*)(lds + LDS_UNI);
    const int cur = t0 >> 6;
    unsigned selmask;
    {
        const bf16_t* kc = (const bf16_t*)(ws + WS_KCMP) + (size_t)bg * 128 * 64;
        const bf16_t* vc = kc + (size_t)16 * 128 * 64;
        __syncthreads();
        load_kv_tile(Kt, Vt, kc, vc, 0, 1, 0, 127, tid);
        load_kv_tile(Kt + KVT, Vt + VT, kc, vc, 64, 1, 0, 127, tid);
        if (tid == 0) uni[0] = 0u;
        __syncthreads();
        LAS const unsigned char* kp = Kt + c * KVS + 16 * h;
        f32x16 sT[4];
#pragma unroll
        for (int T = 0; T < 4; ++T) sT[T] = qk32(qf, kp + T * 32 * KVS, zero16());
        const float dAh = (float)(t - 31) - (float)(64 * h);
        float tmax = -1e30f;
#pragma unroll
        for (int T = 0; T < 4; ++T)
#pragma unroll
            for (int i = 0; i < 16; ++i) {
                const float d = dAh - (float)(16 * (32 * T + (i & 3) + 8 * (i >> 2)));
                float tv = sT[T][i] + ns2 * d;
                tv = d >= 0.f ? tv : -1e30f;
                sT[T][i] = tv; tmax = fmaxf(tmax, tv);
            }
        tmax = fmaxf(tmax, __shfl_xor(tmax, 32));
        const float mu = fmaxf(tmax, -1e29f);
        float ps = 0.f;
#pragma unroll
        for (int T = 0; T < 4; ++T)
#pragma unroll
            for (int i = 0; i < 16; ++i) { sT[T][i] = __builtin_amdgcn_exp2f(sT[T][i] - mu); ps += sT[T][i]; }
        ps += __shfl_xor(ps, 32);
        const float inv = ps > 0.f ? 1.0f / ps : 0.f;
#pragma unroll
        for (int T = 0; T < 4; ++T)
#pragma unroll
            for (int i = 0; i < 16; ++i) sT[T][i] *= inv;
        f32x16 o0 = zero16(), o1 = zero16();
        const int vq = (lane & 15) >> 2, vc0 = 2 * ((lane >> 4) & 1) + ((lane & 3) >> 1), vsx = 2 * vq;
        LAS const unsigned char* vp0 = Vt + (4 * h + vq) * VS + ((vc0 ^ vsx) * 16) + 8 * (lane & 1);
        LAS const unsigned char* vp1 = Vt + (4 * h + vq) * VS + (((vc0 + 4) ^ vsx) * 16) + 8 * (lane & 1);
#pragma unroll
        for (int T = 0; T < 4; ++T) pv32(o0, o1, sT[T], vp0 + T * 32 * VS, vp1 + T * 32 * VS);
#pragma unroll
        for (int i = 0; i < 16; ++i) { totL[i * 256] = g0 * o0[i]; totL[(16 + i) * 256] = g0 * o1[i]; }
        float mainv[16], spill[16];
#pragma unroll
        for (int T = 0; T < 4; ++T)
#pragma unroll
            for (int u = 0; u < 4; ++u) {
                const float p3 = 0.5f * sT[T][4 * u + 3];
                mainv[4 * T + u] = sT[T][4 * u] + sT[T][4 * u + 1] + sT[T][4 * u + 2] + p3;
                spill[4 * T + u] = p3;
            }
#pragma unroll
        for (int f = 0; f < 16; ++f) {
            mainv[f] += __shfl_xor(mainv[f], 8); mainv[f] += __shfl_xor(mainv[f], 16);
            spill[f] += __shfl_xor(spill[f], 8); spill[f] += __shfl_xor(spill[f], 16);
        }
#pragma unroll
        for (int f = 0; f < 16; ++f) {
            const float snd = h ? (f > 0 ? spill[f > 0 ? f - 1 : 0] : 0.f) : spill[f];
            const float rcv = __shfl_xor(snd, 32);
            mainv[f] += rcv;
        }
        if (hh == 0) {
#pragma unroll
            for (int f = 0; f < 16; ++f) impL[tok8 * 32 + 2 * f + h] = mainv[f];
        }
        asm volatile("s_waitcnt lgkmcnt(0)" ::: "memory");
        {
            const int tk = lane >> 3, tq = t0 + 8 * w + tk, cq = tq >> 6, n0 = 4 * (lane & 7);
            float sc[32];
#pragma unroll
            for (int q4 = 0; q4 < 8; ++q4) {
                const f32x4 v = *(const LAS f32x4*)(impL + tk * 32 + 4 * q4);
                sc[4 * q4] = v.x; sc[4 * q4 + 1] = v.y; sc[4 * q4 + 2] = v.z; sc[4 * q4 + 3] = v.w;
            }
#pragma unroll
            for (int n = 0; n < 32; ++n) {
                const bool valid = n <= cq, forced = (n == 0) || (cq - n < 2);
                sc[n] = valid ? sc[n] + (forced ? 1e4f : 0.f) : -1e30f;
            }
            unsigned bits = 0u;
#pragma unroll
            for (int k = 0; k < 4; ++k) {
                const int n = n0 + k;
                float mine = 0.f;
#pragma unroll
                for (int q = 0; q < 32; ++q) mine = (q == n) ? sc[q] : mine;
                int rank = 0;
#pragma unroll
                for (int q = 0; q < 32; ++q) rank += (sc[q] > mine || (sc[q] == mine && q < n)) ? 1 : 0;
                if (n <= cq && rank < 16) bits |= 1u << n;
            }
            bits |= __shfl_xor(bits, 1); bits |= __shfl_xor(bits, 2); bits |= __shfl_xor(bits, 4);
            selmask = __shfl(bits, tok8 * 8);
        }
        {
            unsigned um = selmask;
#pragma unroll
            for (int o = 1; o < 64; o <<= 1) um |= __shfl_xor(um, o);
            if (lane == 0) atomicOr((unsigned*)uni, um);
        }
        __syncthreads();
    }
    const unsigned ublk = uni[0];
    unsigned wsel = selmask;
#pragma unroll
    for (int o = 1; o < 64; o <<= 1) wsel |= __shfl_xor(wsel, o);
    int buf = 0;
    KVRegs kr;
    {
        const bf16_t* kb = (const bf16_t*)(ws + WS_KV6 + 2 * 4 * MiB) + (size_t)bg * NS * 64;
        const bf16_t* vb = (const bf16_t*)(ws + WS_KV6 + 3 * 4 * MiB) + (size_t)bg * NS * 64;
        f32x16 o0 = zero16(), o1 = zero16(); float m = -1e30f, l = 0.f;
        unsigned rem = ublk & (cur >= 31 ? 0xffffffffu : ((2u << cur) - 1u));
        int n = __builtin_ctz(rem);
        kv_fetch(kr, kb, vb, 64 * n, 1, 0, NS - 1, tid);
        while (rem) {
            rem &= rem - 1u;
            LAS unsigned char* Kc = lds + buf * KVT; LAS unsigned char* Vc = lds + 2 * KVT + buf * VT;
            kv_commit(kr, Kc, Vc, tid);
            __syncthreads();
            const int ncur = n;
            if (rem) { n = __builtin_ctz(rem); kv_fetch(kr, kb, vb, 64 * n, 1, 0, NS - 1, tid); }
            if ((wsel >> ncur) & 1u)
                fa_tile64<1, true>(o0, o1, m, l, qf, Kc, Vc, lane, (float)(t - 64 * ncur), ((selmask >> ncur) & 1u) ? 1e30f : -1.f, ns2);
            buf ^= 1;
        }
        const float lt = l + __shfl_xor(l, 32);
        { const float sc = g1 / lt;
#pragma unroll
          for (int i = 0; i < 16; ++i) { totL[i * 256] += sc * o0[i]; totL[(16 + i) * 256] += sc * o1[i]; } }
    }
    {
        const bf16_t* kb = (const bf16_t*)(ws + WS_KV6 + 4 * 4 * MiB) + (size_t)bg * NS * 64;
        const bf16_t* vb = (const bf16_t*)(ws + WS_KV6 + 5 * 4 * MiB) + (size_t)bg * NS * 64;
        f32x16 o0 = zero16(), o1 = zero16(); float m = -1e30f, l = 0.f;
        const int nlo = t0 >= 511 ? (t0 - 511) >> 6 : 0;
        kv_fetch(kr, kb, vb, 64 * nlo, 1, 0, NS - 1, tid);
        for (int n = nlo; n <= cur; ++n) {
            LAS unsigned char* Kc = lds + buf * KVT; LAS unsigned char* Vc = lds + 2 * KVT + buf * VT;
            kv_commit(kr, Kc, Vc, tid);
            __syncthreads();
            if (n < cur) kv_fetch(kr, kb, vb, 64 * (n + 1), 1, 0, NS - 1, tid);
            fa_tile64<1, true>(o0, o1, m, l, qf, Kc, Vc, lane, (float)(t - 64 * n), 511.f, ns2);
            buf ^= 1;
        }
        const float lt = l + __shfl_xor(l, 32);
        { const float sc = g2 / lt;
#pragma unroll
          for (int i = 0; i < 16; ++i) { o0[i] = totL[i * 256] + sc * o0[i]; o1[i] = totL[(16 + i) * 256] + sc * o1[i]; } }
        store_ot((bf16_t*)(ws + WS_O) + ((size_t)(b * NS + t) * ND + 512 + hb * 64), o0, o1, 1.0f, h);
    }
}

#define XB_TMO      128
#define XB_XCNT(j)  (256  + 64 * (j))
#define XB_XSUB(j)  (1280 + 64 * (j))
#define XB_XGEN(j)  (2304 + 64 * (j))
#define XB_TOP      3328
#define XB_TOPGEN   3392
#define XCD_BAR_WORDS 3456
#define XB_SPIN_CAP (1u << 18)
__device__ __forceinline__ unsigned xb_ld(unsigned* p)              { return __hip_atomic_load(p, __ATOMIC_RELAXED, __HIP_MEMORY_SCOPE_AGENT); }
__device__ __forceinline__ unsigned xb_add(unsigned* p, unsigned v) { return __hip_atomic_fetch_add(p, v, __ATOMIC_RELAXED, __HIP_MEMORY_SCOPE_AGENT); }
__device__ __forceinline__ unsigned xb_xcc_id() { return (unsigned)__builtin_amdgcn_s_getreg((3 << 11) | 20) & 0xFu; }
#define XB_SPIN(cond, bar) do { unsigned _sp = 0; while (cond) { __builtin_amdgcn_s_sleep(1); \
    if ((++_sp & 255u) == 0u) { if (xb_ld(&(bar)[XB_TMO])) break; if (_sp > XB_SPIN_CAP) { atomicAdd(&(bar)[XB_TMO], 1u); break; } } } } while (0)
struct XcdBarrier { unsigned* bar; unsigned x; volatile LAS unsigned* st; };
__device__ __forceinline__ XcdBarrier xcd_barrier_post(unsigned* bar, volatile LAS unsigned* st) {
    XcdBarrier b; b.bar = bar; b.x = xb_xcc_id(); b.st = st;
    if (threadIdx.x == 0) (void)xb_add(&bar[XB_XCNT(b.x)], 1u);
    return b;
}
__device__ __forceinline__ void xcd_barrier_complete(unsigned* bar, unsigned x, unsigned& nloc, unsigned& nx) {
    const unsigned G = gridDim.x * gridDim.y * gridDim.z;
    unsigned sum, cnt, mine, sp = 0u;
    for (;;) {
        sum = 0u; cnt = 0u; mine = 0u;
#pragma unroll
        for (unsigned j = 0; j < 16; ++j) { const unsigned c = xb_ld(&bar[XB_XCNT(j)]); sum += c; cnt += (c > 0u) ? 1u : 0u; mine = (j == x) ? c : mine; }
        if (sum == G) break;
        __builtin_amdgcn_s_sleep(1);
        if ((++sp & 255u) == 0u) { if (xb_ld(&bar[XB_TMO])) break; if (sp > XB_SPIN_CAP) { atomicAdd(&bar[XB_TMO], 1u); break; } }
    }
    nloc = mine > 0u ? mine : 1u; nx = cnt > 0u ? cnt : 1u;
}
__device__ __forceinline__ void xcd_barrier(const XcdBarrier& b) {
    asm volatile("s_waitcnt vmcnt(0)" ::: "memory");
    __syncthreads();
    if (threadIdx.x == 0) {
        unsigned* bar = b.bar;
        __builtin_amdgcn_s_waitcnt(0);
        unsigned nloc = b.st[0], nx = b.st[1];
        if (nloc == 0u) { xcd_barrier_complete(bar, b.x, nloc, nx); b.st[0] = nloc; b.st[1] = nx; }
        const unsigned old = xb_add(&bar[XB_XSUB(b.x)], 1u);
        const unsigned gen = old / nloc;
        if (old + 1u == (gen + 1u) * nloc) {
            __builtin_amdgcn_fence(__ATOMIC_RELEASE, "agent");
            asm volatile("s_waitcnt vmcnt(0)" ::: "memory");
            const unsigned og = xb_add(&bar[XB_TOP], 1u);
            const unsigned tg = og / nx;
            if (og + 1u == (tg + 1u) * nx) xb_add(&bar[XB_TOPGEN], 1u);
            else XB_SPIN(xb_ld(&bar[XB_TOPGEN]) == tg, bar);
            __builtin_amdgcn_fence(__ATOMIC_ACQUIRE, "agent");
            xb_add(&bar[XB_XGEN(b.x)], 1u);
            asm volatile("s_waitcnt vmcnt(0)" ::: "memory");
        } else {
            XB_SPIN(xb_ld(&bar[XB_XGEN(b.x)]) == gen, bar);
            __builtin_amdgcn_fence(__ATOMIC_ACQUIRE, "agent");
            asm volatile("s_waitcnt vmcnt(0)" ::: "memory");
        }
    }
    __syncthreads();
}

struct XcdTiles {
    int m_lo, cnt_m, nN, loc, nloc, tiles;
    __device__ __forceinline__ XcdTiles(int nM, int nN_) {
        const int b = BID(), g = gridDim.x;
        int x, nx;
        if ((g & 7) == 0) { x = b & 7; nx = 8; loc = b >> 3; nloc = g >> 3; } else { x = 0; nx = 1; loc = b; nloc = g; }
        m_lo = (int)((long)nM * x / nx); cnt_m = (int)((long)nM * (x + 1) / nx) - m_lo; nN = nN_; tiles = cnt_m * nN;
    }
    __device__ __forceinline__ void get(int q, int& mt, int& nt) const {
        const int mg = q / (8 * nN), rem_m = cnt_m - 8 * mg, mig = rem_m < 8 ? rem_m : 8, r = q - mg * 8 * nN;
        nt = r / mig; mt = m_lo + 8 * mg + (r - nt * mig);
    }
};
struct PhInProj { const bf16_t* xn; const unsigned char* wl; unsigned char* ws; const float* ssp; XcdTiles xt;
    __device__ __forceinline__ void make(int q, APlain& ap, BPlain& bp, EpiInProj& ep) const { int mt, nt; xt.get(q, mt, nt);
        ap = APlain{xn + (size_t)mt * 128 * ND, ND}; bp = BPlain{(const bf16_t*)(wl + WL_IN) + (size_t)nt * 128 * ND, ND}; ep = EpiInProj{mt, nt, ws, ssp}; } };
struct PhCmp1 { const unsigned char* wl; unsigned char* ws; int l;
    __device__ __forceinline__ void make(int tile, ACmp& ap, BPlain& bp, EpiCmp1& ep) const { const int nt = tile & 1, bg = (tile >> 1) & 15, kv = tile >> 5;
        ap = ACmp{(const bf16_t*)(ws + WS_KV6 + (size_t)kv * 4 * MiB) + (size_t)bg * NS * 64};
        bp = BPlain{(const bf16_t*)(wl + WL_C1) + (size_t)kv * 256 * 2048 + (size_t)nt * 128 * 2048, 2048};
        ep = EpiCmp1{(bf16_t*)(ws + WS_HC) + (size_t)kv * 2048 * 256, (const float*)(ws + WS_BC1P) + l * 512 + kv * 256, bg * 128, nt * 128}; } };
struct PhCmp2 { const unsigned char* wl; unsigned char* ws;
    __device__ __forceinline__ void make(int tile, APlain& ap, BPlain& bp, EpiCmp2& ep) const { const int bg = tile & 15, kv = tile >> 4;
        ap = APlain{(const bf16_t*)(ws + WS_HC) + (size_t)kv * 2048 * 256 + (size_t)bg * 128 * 256, 256};
        bp = BPlain{(const bf16_t*)(wl + WL_C2) + (size_t)kv * 128 * 256, 256};
        ep = EpiCmp2{(bf16_t*)(ws + WS_KCMP) + (size_t)kv * 16 * 128 * 64, bg * 128}; } };
struct PhOutProj { const unsigned char* wl; unsigned char* ws; bf16_t* res; XcdTiles xt;
    __device__ __forceinline__ void make(int q, APlain& ap, BPlain& bp, EpiResAdd& ep) const { int mt, nt; xt.get(q, mt, nt);
        ap = APlain{(const bf16_t*)(ws + WS_O) + (size_t)mt * 128 * ND, ND}; bp = BPlain{(const bf16_t*)(wl + WL_OUT) + (size_t)nt * 128 * ND, ND};
        ep = EpiResAdd{res, mt * 128, nt * 128}; } };
struct PhMoe {
    LAS const int* sm; const int* list;
    __device__ __forceinline__ void decode(int gmt, int& bk, int& mt, int& rem, int& hrow0, int& elo, int& ehi) const {
        bk = 0;
        for (int k = 1; k < 24; ++k) if (gmt >= sm[32 + k]) bk = k;
        mt = gmt - sm[32 + bk]; rem = sm[bk] - mt * 128; hrow0 = sm[64 + bk] + mt * 128;
        const int grp = bk / 6, pi = bk % 6;
        elo = grp * 4 + (pi < 3 ? 0 : (pi < 5 ? 1 : 2)); ehi = grp * 4 + (pi < 3 ? pi + 1 : (pi < 5 ? pi - 1 : 3));
    } };
struct PhMoeGU { PhMoe m; const bf16_t* xn; const unsigned char* wl; unsigned char* ws; const float* route; const float* rinv; XcdTiles xt;
    __device__ __forceinline__ void make(int q, AGather& ap, BPlain& bp, EpiMoeGU& ep) const { int gmt, nt16; xt.get(q, gmt, nt16);
        int bk, mt, rem, hrow0, elo, ehi; m.decode(gmt, bk, mt, rem, hrow0, elo, ehi);
        const int* lst = m.list + (size_t)bk * NT + mt * 128; const int e = (nt16 >> 3) ? ehi : elo;
        ap = AGather{xn, lst, rem}; bp = BPlain{(const bf16_t*)(wl + WL_GU) + (size_t)e * 1024 * 1024 + (size_t)(nt16 & 7) * 128 * 1024, 1024};
        ep = EpiMoeGU{(bf16_t*)(ws + WS_HID), lst, route, rinv, rem, hrow0, nt16}; } };
struct PhMoeDown { PhMoe m; const unsigned char* wl; unsigned char* ws; bf16_t* res; float* ssp; XcdTiles xt;
    __device__ __forceinline__ void make(int q, APlain& ap, BSplit& bp, EpiMoeDown& ep) const { int gmt, nt; xt.get(q, gmt, nt);
        int bk, mt, rem, hrow0, elo, ehi; m.decode(gmt, bk, mt, rem, hrow0, elo, ehi);
        const int* lst = m.list + (size_t)bk * NT + mt * 128;
        ap = APlain{(const bf16_t*)(ws + WS_HID) + (size_t)hrow0 * 1024, 1024};
        bp = BSplit{(const bf16_t*)(wl + WL_DN) + (size_t)elo * 1024 * 512 + (size_t)nt * 128 * 512, (const bf16_t*)(wl + WL_DN) + (size_t)ehi * 1024 * 512 + (size_t)nt * 128 * 512};
        ep = EpiMoeDown{res, lst, ssp, rem, nt * 128}; } };
struct PhPleProj { const unsigned char* wl; unsigned char* ws; XcdTiles xt;
    __device__ __forceinline__ void make(int q, APlain& ap, BPlain& bp, EpiBf16& ep) const { int mt, nt; xt.get(q, mt, nt);
        ap = APlain{(const bf16_t*)(ws + WS_PB) + (size_t)mt * 128 * 256, 256}; bp = BPlain{(const bf16_t*)(wl + WL_PP) + (size_t)nt * 128 * 256, 256};
        ep = EpiBf16{(bf16_t*)(ws + WS_P2), ND, mt * 128, nt * 128}; } };
struct PhPleGate { const bf16_t* xn; const unsigned char* wl; unsigned char* ws; float* out; float sc; XcdTiles xt;
    __device__ __forceinline__ void make(int q, APlain& ap, BPlain& bp, EpiPleGate& ep) const { int mt, nt; xt.get(q, mt, nt);
        ap = APlain{xn + (size_t)mt * 128 * ND, ND}; bp = BPlain{(const bf16_t*)(wl + WL_PG) + (size_t)nt * 128 * ND, ND};
        ep = EpiPleGate{out, (const bf16_t*)(ws + WS_P2), mt * 128, nt * 128, sc}; } };

constexpr int LDS_QSLOT = 73856 + 16 + 448;
__device__ __forceinline__ int wq_next(int* head, LAS unsigned char* lds) {
    LAS int* slot = (LAS int*)(lds + LDS_QSLOT);
    __syncthreads();
    if (threadIdx.x == 0) *slot = atomicAdd(head, 1);
    __syncthreads();
    return *slot;
}
__device__ __forceinline__ void ple_stream(const bf16_t* xn, const bf16_t* pb, const unsigned char* wl, const float* ssp_in, bf16_t* rout, float* ssp_out, LAS unsigned char* lds) {
    const XcdTiles xt(128, 8);
    int q = xt.loc;
    if (q >= xt.tiles) return;
    const int tid = TID(), wid = tid >> 6, lane = tid & 63, wr = wid >> 1, wc = wid & 1, fr = lane & 15, fq = lane >> 4;
    int mt, nt; xt.get(q, mt, nt);
    bool pref = false;
    for (;;) {
        const int qn = q + xt.nloc; const bool hn = qn < xt.tiles;
        int mtn = mt, ntn = nt; if (hn) xt.get(qn, mtn, ntn);
        const APlain ap1{pb + (size_t)mt * 128 * 256, 256}; const BPlain bp1{(const bf16_t*)(wl + WL_PP) + (size_t)nt * 128 * 256, 256};
        const APlain ap2{xn + (size_t)mt * 128 * ND, ND};   const BPlain bp2{(const bf16_t*)(wl + WL_PG) + (size_t)nt * 128 * ND, ND};
        const APlain apn{pb + (size_t)mtn * 128 * 256, 256}; const BPlain bpn{(const bf16_t*)(wl + WL_PP) + (size_t)ntn * 128 * 256, 256};
        f32x4 acc[4][4], acc2[4][4]; zero_acc(acc); zero_acc(acc2);
        gemm_kloop(acc2, ap1, bp1, 256, lds, pref, true, ap2, bp2);
        gemm_kloop(acc, ap2, bp2, ND, lds, true, hn, apn, bpn);
        const EpiPleFused ep{xn, ssp_in, rout, ssp_out, mt * 128, nt * 128};
        ep(acc, acc2, wr, wc, fr, fq);
        if (!hn) break;
        q = qn; mt = mtn; nt = ntn; pref = true;
    }
}

constexpr int LDS_BAR = 73856;
constexpr int LDS_SM = LDS_BAR + 16;
constexpr int LDS_BYTES = LDS_SM + 512;
static_assert(LDS_QSLOT == LDS_SM + 448, "queue slot");
static_assert(4 * KVT + 4096 + 64 <= LDS_TOT && LDS_TOT + 32768 <= LDS_BAR && 65536 <= LDS_BAR, "LDS map");

__global__ void __launch_bounds__(256, 2) mega_fwd(Params p) {
    extern __shared__ __attribute__((aligned(16))) unsigned char lds_raw[];
    LAS unsigned char* lds = (LAS unsigned char*)lds_raw;
    unsigned char* ws = p.ws;
    const int tid = threadIdx.x;
    const int gtid = blockIdx.x * 256 + tid, gthreads = gridDim.x * 256;
    int* ctl = (int*)(ws + WS_CTL);
    {
        volatile LAS unsigned* st = (volatile LAS unsigned*)(lds + LDS_BAR);
        if (tid < 4) st[tid] = 0u;
        __syncthreads();
    }
    const XcdBarrier gbar = xcd_barrier_post((unsigned*)ctl + CW_BAR, (volatile LAS unsigned*)(lds + LDS_BAR));

    phase_convert(p, (LAS float*)lds);
    xcd_barrier(gbar);

    float* sspA = (float*)(ws + WS_SSP);
    float* sspB = sspA + (size_t)NT * 16;
    float* rinv = (float*)(ws + WS_RINV);
    for (int l = 0; l < 2; ++l) {
        const unsigned char* wl = ws + WS_W + (size_t)l * WL_SIZE;
        bf16_t* xn = (bf16_t*)p.out + (size_t)(l & 1) * NT * ND;
        bf16_t* rnext = l == 1 ? (bf16_t*)(ws + WS_XN) : (bf16_t*)p.out + (size_t)((l + 1) & 1) * NT * ND;
        const bf16_t* xb_in = xn;
        {
            const PhInProj ph{xb_in, wl, ws, sspB, XcdTiles(128, 23)};
            gemm_stream<PhInProj, APlain, BPlain, EpiInProj>(ph, ph.xt.loc, ph.xt.nloc, ph.xt.tiles, ND, lds);
        }
        xcd_barrier(gbar);
        {
            int* qh = ctl + CW_Q + l * 4 + 0;
            int* ch = ctl + CW_Q + l * 4 + 2;
            const int nconv = conv_queue_strips(2 * l);
            const PhCmp1 ph{wl, ws, l};
            bool conv_left = nconv > 0, att_left = true;
            for (int k = 0; conv_left || att_left; ++k) {
                const bool want_conv = conv_left && (!att_left || (k % 7) == 6);
                if (want_conv) {
                    const int c = wq_next(ch, lds);
                    if (c < nconv) conv_strip(p, 2 * l, c, (LAS float*)lds); else conv_left = false;
                } else {
                    const int it = wq_next(qh, lds);
                    if (it >= 64 + 1536) att_left = false;
                    else if (it < 64) { ACmp ap; BPlain bp; EpiCmp1 ep; ph.make(it, ap, bp, ep); gemm_tile(ap, bp, 2048, ep, lds, false, false, ap, bp); }
                    else { dil_item(ws, 2 * (it - 64), lds); __syncthreads(); dil_item(ws, 2 * (it - 64) + 1, lds); }
                }
            }
        }
        xcd_barrier(gbar);
        { const PhCmp2 ph{wl, ws}; gemm_stream<PhCmp2, APlain, BPlain, EpiCmp2>(ph, BID(), gridDim.x, 32, 256, lds); }
        dil_merge(ws, gtid, gthreads);
        if (l == 0) convert_p(p);
        xcd_barrier(gbar);
        {
            int* qh = ctl + CW_Q + l * 4 + 1;
            int* ch = ctl + CW_Q + l * 4 + 3;
            const int nconv = conv_queue_strips(2 * l + 1);
            bool conv_left = nconv > 0, att_left = true;
            for (int k = 0; conv_left || att_left; ++k) {
                const bool want_conv = conv_left && (!att_left || (k % 4) == 3);
                if (want_conv) {
                    const int c = wq_next(ch, lds);
                    if (c < nconv) conv_strip(p, 2 * l + 1, c, (LAS float*)lds); else conv_left = false;
                } else {
                    const int it = wq_next(qh, lds);
                    if (it >= 1024) att_left = false;
                    else nsa_item(ws, ((63 - (it >> 4)) << 4) | (it & 15), lds);
                }
            }
        }
        xcd_barrier(gbar);
        { const PhOutProj ph{wl, ws, xn, XcdTiles(128, 8)};
          gemm_stream<PhOutProj, APlain, BPlain, EpiResAdd>(ph, ph.xt.loc, ph.xt.nloc, ph.xt.tiles, ND, lds); }
        xcd_barrier(gbar);
        int* cnt = ctl + CW_CNTP + l * 1536;
        int* list = (int*)(ws + WS_LIST);
        float* route = (float*)(ws + WS_ROUTE);
        phase_route(xn, (const float*)(wl + WL_RT), p.in[12] + l * 4, p.in[14] + l * 16, cnt, list, route, rinv, lds);
        xcd_barrier(gbar);
        LAS int* sm = (LAS int*)(lds + LDS_SM);
        __syncthreads();
        if (tid < 24) sm[tid] = __hip_atomic_load(cnt + 64 * tid, __ATOMIC_RELAXED, __HIP_MEMORY_SCOPE_AGENT);
        __syncthreads();
        if (tid == 0) {
            int tp = 0, hb = 0;
            for (int k = 0; k < 24; ++k) {
                const int c = sm[k];
                sm[32 + k] = tp; sm[64 + k] = hb;
                const int nt_ = (c + 127) >> 7; tp += nt_; hb += nt_ * 128;
            }
            sm[32 + 24] = tp;
        }
        __syncthreads();
        const int total_mt = sm[32 + 24];
        { const PhMoeGU ph{PhMoe{sm, list}, xn, wl, ws, route, rinv, XcdTiles(total_mt, 16)};
          gemm_stream<PhMoeGU, AGather, BPlain, EpiMoeGU>(ph, ph.xt.loc, ph.xt.nloc, ph.xt.tiles, ND, lds); }
        xcd_barrier(gbar);
        { const PhMoeDown ph{PhMoe{sm, list}, wl, ws, xn, sspA, XcdTiles(total_mt, 8)};
          gemm_stream<PhMoeDown, APlain, BSplit, EpiMoeDown>(ph, ph.xt.loc, ph.xt.nloc, ph.xt.tiles, ND, lds); }
        xcd_barrier(gbar);
        ple_stream(xn, (const bf16_t*)(ws + WS_PBALL) + (size_t)l * NT * 256, wl, sspA, rnext, sspB, lds);
        xcd_barrier(gbar);
    }
    phase_final_norm((const bf16_t*)(ws + WS_XN), p.out, p.in[21]);
}

extern "C" void kernel_launch(void* const* d_in, const int* in_sizes, int n_in, void* d_out, int out_size, void* d_ws, size_t ws_size, hipStream_t stream) {
    static int grid = 0;
    if (grid == 0) {
        if (n_in != 22 || out_size != NT * ND || ws_size < WS_END) { fprintf(stderr, "kernel_launch: unexpected shapes (n_in %d out %d ws %zu)\n", n_in, out_size, ws_size); grid = -1; return; }
        int dev = 0, cus = 0, per_cu = 0;
        hipGetDevice(&dev);
        hipDeviceGetAttribute(&cus, hipDeviceAttributeMultiprocessorCount, dev);
        if (hipFuncSetAttribute((const void*)mega_fwd, hipFuncAttributeMaxDynamicSharedMemorySize, LDS_BYTES) != hipSuccess) { fprintf(stderr, "kernel_launch: hipFuncSetAttribute failed\n"); grid = -1; return; }
        hipOccupancyMaxActiveBlocksPerMultiprocessor(&per_cu, (const void*)mega_fwd, 256, LDS_BYTES);
        if (per_cu < 1) { fprintf(stderr, "kernel_launch: occupancy query says %d\n", per_cu); grid = -1; return; }
        if (per_cu > 2) per_cu = 2;
        grid = cus * per_cu;
    }
    if (grid < 0) return;
    hipMemsetAsync((char*)d_ws + WS_CTL, 0, 32768, stream);
    Params p{};
    for (int i = 0; i < 22; ++i) p.in[i] = (const float*)d_in[i];
    p.out = (float*)d_out; p.ws = (unsigned char*)d_ws;
    hipLaunchKernelGGL(mega_fwd, dim3(grid), dim3(256), LDS_BYTES, stream, p);
    const hipError_t e = hipPeekAtLastError();
    if (e != hipSuccess) fprintf(stderr, "launch failed: %s (grid %d)\n", hipGetErrorString(e), grid);
}
```

```cpp
#include <hip/hip_runtime.h>
#include <cstdio>
#include <cstdint>

#ifndef NAIVE_GEMM
#define NAIVE_GEMM 0
#endif
#ifndef NAIVE_ATTN
#define NAIVE_ATTN 0
#endif
#define REP_CONV 1
#define REP_INPROJ 1
#define REP_ATTN 1
#define REP_GU 1
#define REP_NORM 1
#define REP_ROUTE 1
#define REP_DOWN 1
#define REP_OUTPROJ 1
#define REP_PG 1
#define REP_CMP 1
#define REP_MISC 1

#define LAS __attribute__((address_space(3)))
typedef unsigned short bf16_t;
typedef short bf16x8 __attribute__((ext_vector_type(8)));
typedef float f32x4 __attribute__((ext_vector_type(4)));
typedef unsigned u32x4 __attribute__((ext_vector_type(4)));
typedef unsigned u32x2 __attribute__((ext_vector_type(2)));
typedef float f32x16 __attribute__((ext_vector_type(16)));
typedef short s16x4 __attribute__((ext_vector_type(4)));
typedef float f32x2_t __attribute__((ext_vector_type(2)));
typedef __bf16 bf16x2_t __attribute__((ext_vector_type(2)));

constexpr int NB = 8, NS = 2048, ND = 1024, NT = NB * NS;
constexpr int NIN = 2840, NINP = 2944;
constexpr size_t MiB = (size_t)1 << 20;
constexpr size_t WL_IN = 0;
constexpr size_t WL_OUT = WL_IN + (size_t)NINP * 1024 * 2;
constexpr size_t WL_C1 = WL_OUT + (size_t)1024 * 1024 * 2;
constexpr size_t WL_C2 = WL_C1 + (size_t)2 * 256 * 2048 * 2;
constexpr size_t WL_GU = WL_C2 + (size_t)2 * 128 * 256 * 2;
constexpr size_t WL_DN = WL_GU + (size_t)16 * 1024 * 1024 * 2;
constexpr size_t WL_PG = WL_DN + (size_t)16 * 1024 * 512 * 2;
constexpr size_t WL_PP = WL_PG + (size_t)1024 * 1024 * 2;
constexpr size_t WL_BC1 = WL_PP + (size_t)1024 * 256 * 2;
constexpr size_t WL_RT = WL_BC1 + 2048;
constexpr size_t WL_SIZE = 64 * MiB;
static_assert(WL_RT + 131072 <= WL_SIZE, "weight block");
constexpr size_t WS_CTL = 0;
constexpr size_t WS_W = 1 * MiB;
constexpr size_t WS_XN = WS_W + 2 * WL_SIZE;
constexpr size_t WS_PROJ = WS_XN + 32 * MiB;
constexpr size_t WS_QA = WS_PROJ, WS_KA = WS_QA + 16 * MiB, WS_VA = WS_KA + 16 * MiB, WS_QB = WS_VA + 16 * MiB;
constexpr size_t WS_KV6 = WS_QB + 16 * MiB;
constexpr size_t WS_GATES = WS_KV6 + 24 * MiB;
constexpr size_t WS_PROJ_END = WS_GATES + 2 * MiB;
constexpr size_t WS_HID = WS_PROJ;
constexpr size_t WS_P2 = WS_PROJ + 40 * MiB;
constexpr size_t WS_PB = WS_PROJ + 72 * MiB;
constexpr size_t WS_HC = WS_PROJ_END;
constexpr size_t WS_KCMP = WS_HC + 2 * MiB;
constexpr size_t WS_MASK = WS_KCMP + 512 * 1024;
constexpr size_t WS_ROUTE = WS_MASK + 128 * 1024;
constexpr size_t WS_LIST = WS_ROUTE + 128 * 1024;
constexpr size_t WS_O = WS_LIST + 1536 * 1024 + 256 * 1024;
constexpr size_t WS_IMPH = WS_O + 32 * MiB;
constexpr size_t WS_OPA01 = WS_XN;
constexpr size_t WS_OPA2 = WS_IMPH;
constexpr size_t WS_STA = WS_IMPH + 16 * MiB;
constexpr size_t WS_PBALL = WS_IMPH + 20 * MiB;
constexpr size_t WS_SSP = WS_PBALL + 16 * MiB;
constexpr size_t WS_RINV = WS_MASK;
constexpr size_t WS_BC1P = WS_SSP + 2 * MiB;
constexpr size_t WS_END = WS_BC1P + 64 * 1024;
static_assert(WS_PB + 8 * MiB <= WS_PROJ_END, "alias map");
static_assert(WS_END <= 330 * MiB, "workspace");
constexpr int HID_ROWS = NT + 24 * 128;
constexpr int CW_BAR = 1024;
constexpr int CW_Q = 256;
constexpr int CW_CNTP = 4608;
constexpr int CW_CNT = 64;

struct Params {
    const float* in[22];
    float* out;
    unsigned char* ws;
};

__device__ __forceinline__ unsigned f2bf(float f) { unsigned u = __float_as_uint(f); return (u + 0x7fffu + ((u >> 16) & 1u)) >> 16; }
__device__ __forceinline__ unsigned pk2(float lo, float hi) { return f2bf(lo) | (f2bf(hi) << 16); }
__device__ __forceinline__ float bflo(unsigned v) { return __uint_as_float(v << 16); }
__device__ __forceinline__ float bfhi(unsigned v) { return __uint_as_float(v & 0xffff0000u); }
__device__ __forceinline__ float wave_sum(float v) {
#pragma unroll
    for (int o = 1; o < 64; o <<= 1) v += __shfl_xor(v, o);
    return v;
}
__device__ __forceinline__ int TID() { int t = threadIdx.x; asm volatile("" : "+v"(t)); return t; }
__device__ __forceinline__ int BID() { int t = blockIdx.x; asm volatile("" : "+s"(t)); return t; }
__device__ __forceinline__ float sigmoidf_(float x) { return 1.0f / (1.0f + __expf(-x)); }
__device__ __forceinline__ float gelu_tanh(float x) {
    const float u = 0.7978845608028654f * (x + 0.044715f * x * x * x);
    const float e = __expf(2.0f * u);
    const float th = 1.0f - 2.0f / (e + 1.0f);
    return 0.5f * x * (1.0f + th);
}

struct ConvJob { const float* src; bf16_t* dst; const float* gain; int K, N, NP, map, per; size_t dst_bstride; };
__device__ __forceinline__ int conv_job_tiles(int j) { return j == 0 ? 736 : (j == 1 || j == 9) ? 256 : (j == 2 || j == 3) ? 128 : (j == 4 || j == 5) ? 8 : j == 10 ? 64 : 2048; }
__device__ __forceinline__ ConvJob conv_job(const Params& p, int l, int j) {
    unsigned char* wl = p.ws + WS_W + (size_t)l * WL_SIZE;
    ConvJob c; c.map = 0; c.dst_bstride = 0; c.gain = nullptr;
    switch (j) {
    case 0: c.src = p.in[3] + (size_t)l * 1024 * NIN; c.K = 1024; c.N = NIN; c.NP = NINP; c.dst = (bf16_t*)(wl + WL_IN); c.gain = p.in[2] + l * ND; break;
    case 1: c.src = p.in[4] + (size_t)l * 1024 * 1024; c.K = 1024; c.N = 1024; c.NP = 1024; c.dst = (bf16_t*)(wl + WL_OUT); break;
    case 2: c.src = p.in[5] + (size_t)l * 2048 * 256; c.K = 2048; c.N = 256; c.NP = 256; c.dst = (bf16_t*)(wl + WL_C1); break;
    case 3: c.src = p.in[7] + (size_t)l * 2048 * 256; c.K = 2048; c.N = 256; c.NP = 256; c.dst = (bf16_t*)(wl + WL_C1) + (size_t)256 * 2048; break;
    case 4: c.src = p.in[6] + (size_t)l * 256 * 64; c.K = 256; c.N = 64; c.NP = 128; c.dst = (bf16_t*)(wl + WL_C2); break;
    case 5: c.src = p.in[8] + (size_t)l * 256 * 64; c.K = 256; c.N = 64; c.NP = 128; c.dst = (bf16_t*)(wl + WL_C2) + (size_t)128 * 256; break;
    case 6: c.src = p.in[15] + (size_t)l * 16 * 1024 * 512; c.K = 1024; c.N = 512; c.NP = 512; c.dst = (bf16_t*)(wl + WL_GU); c.map = 1; c.dst_bstride = (size_t)1024 * 1024; c.gain = p.in[10] + l * ND; break;
    case 7: c.src = p.in[16] + (size_t)l * 16 * 1024 * 512; c.K = 1024; c.N = 512; c.NP = 512; c.dst = (bf16_t*)(wl + WL_GU); c.map = 2; c.dst_bstride = (size_t)1024 * 1024; c.gain = p.in[10] + l * ND; break;
    case 8: c.src = p.in[17] + (size_t)l * 16 * 512 * 1024; c.K = 512; c.N = 1024; c.NP = 1024; c.dst = (bf16_t*)(wl + WL_DN); c.dst_bstride = (size_t)1024 * 512; break;
    case 9: c.src = p.in[19] + (size_t)l * 1024 * 1024; c.K = 1024; c.N = 1024; c.NP = 1024; c.dst = (bf16_t*)(wl + WL_PG); c.gain = p.in[18] + l * ND; break;
    default: c.src = p.in[20] + (size_t)l * 256 * 1024; c.K = 256; c.N = 1024; c.NP = 1024; c.dst = (bf16_t*)(wl + WL_PP); break;
    }
    c.per = (c.K / 64) * (c.NP / 64);
    return c;
}
__device__ __forceinline__ void convert_tiles(const ConvJob& c, int t0, int t1, LAS float* tl) {
    const int tid = TID();
    const int ntiles = c.NP / 64;
    const int kr = tid >> 4, c4 = (tid & 15) * 4;
    f32x4 v[4]; float gv[4];
#define CT_LOAD(it_) do { const int _bi = (it_) / c.per, _r = (it_) - _bi * c.per, _kt = _r / ntiles, _nt = _r - _kt * ntiles; \
        const int _n = _nt * 64 + c4; const bool _ok = _n < c.N; \
        const float* _sp = c.src + (size_t)_bi * c.K * c.N + (size_t)(_kt * 64 + kr) * c.N + (_ok ? _n : 0); \
        _Pragma("unroll") for (int _i = 0; _i < 4; ++_i) v[_i] = *(const f32x4*)(_sp + (size_t)(16 * _i) * c.N); \
        if (c.gain) { _Pragma("unroll") for (int _i = 0; _i < 4; ++_i) gv[_i] = c.gain[_kt * 64 + kr + 16 * _i]; } \
        else { _Pragma("unroll") for (int _i = 0; _i < 4; ++_i) gv[_i] = 1.0f; } \
        if (!_ok) { _Pragma("unroll") for (int _i = 0; _i < 4; ++_i) gv[_i] = 0.f; } } while (0)
    CT_LOAD(t0);
    for (int it = t0; it < t1; ++it) {
        const int bi = it / c.per, r = it - bi * c.per, kt = r / ntiles, nt = r - kt * ntiles;
        bf16_t* d = c.dst + (size_t)bi * c.dst_bstride;
        const int k0 = kt * 64, n0 = nt * 64;
        __syncthreads();
#pragma unroll
        for (int i = 0; i < 4; ++i) {
            LAS float* tp = tl + (kr + 16 * i) * 65 + c4;
            tp[0] = v[i].x * gv[i]; tp[1] = v[i].y * gv[i]; tp[2] = v[i].z * gv[i]; tp[3] = v[i].w * gv[i];
        }
        if (it + 1 < t1) CT_LOAD(it + 1);
        __syncthreads();
        const int n = tid >> 2, kc = (tid & 3) * 16;
        const int nsrc = n0 + n;
        const int row = (c.map == 0) ? nsrc : ((nsrc >> 4) * 32 + (nsrc & 15) + (c.map == 2 ? 16 : 0));
        float w[16];
#pragma unroll
        for (int j = 0; j < 16; ++j) w[j] = tl[(kc + j) * 65 + n];
        u32x4 o0, o1;
        o0.x = pk2(w[0], w[1]); o0.y = pk2(w[2], w[3]); o0.z = pk2(w[4], w[5]); o0.w = pk2(w[6], w[7]);
        o1.x = pk2(w[8], w[9]); o1.y = pk2(w[10], w[11]); o1.z = pk2(w[12], w[13]); o1.w = pk2(w[14], w[15]);
        bf16_t* dp = d + (size_t)row * c.K + k0 + kc;
        *(u32x4*)dp = o0; *(u32x4*)(dp + 8) = o1;
    }
#undef CT_LOAD
}
__device__ __forceinline__ int conv_list(int q, int i) {
    if (q == 0) return i == 0 ? 6 : (i == 1 ? 7 : -1);
    if (q == 1) return i == 0 ? 8 : i == 1 ? 9 : i == 2 ? 10 : i == 3 ? 16 : i == 4 ? 18 : i == 5 ? 19 : i == 6 ? 20 : i == 7 ? 21 : -1;
    if (q == 2) return i == 0 ? 17 : i == 1 ? 22 : i == 2 ? 23 : -1;
    return i == 0 ? 24 : i == 1 ? 25 : i == 2 ? 26 : -1;
}
__device__ __forceinline__ int conv_queue_strips(int q) {
    int n = 0;
    for (int i = 0; i < 8; ++i) { const int e = conv_list(q, i); if (e < 0) break; n += conv_job_tiles(e & 15) >> 3; }
    return n;
}
__device__ __forceinline__ void conv_strip(const Params& p, int q, int c, LAS float* tl) {
    for (int i = 0; i < 8; ++i) {
        const int e = conv_list(q, i);
        if (e < 0) return;
        const int ns = conv_job_tiles(e & 15) >> 3;
        if (c < ns) { const ConvJob job = conv_job(p, e >> 4, e & 15); convert_tiles(job, c * 8, c * 8 + 8, tl); return; }
        c -= ns;
    }
}

__device__ __forceinline__ void convert_p(const Params& p) {
    const f32x4* pl = (const f32x4*)p.in[1]; u32x2* pb = (u32x2*)(p.ws + WS_PBALL);
    for (int i = BID() * 256 + TID(); i < 2 * NT * 256 / 4; i += gridDim.x * 256) {
        const f32x4 v = pl[i]; u32x2 w; w.x = pk2(v.x, v.y); w.y = pk2(v.z, v.w); pb[i] = w;
    }
}
__device__ __forceinline__ void phase_convert(const Params& p, LAS float* tl) {
    {
        int base = 0;
        for (int j = 0; j < 6; ++j) {
            const ConvJob job = conv_job(p, 0, j);
            const int nt = conv_job_tiles(j);
            const int g = gridDim.x, b = BID();
            int first = (b - base % g + g) % g;
            for (int s = first; s < nt; s += g) convert_tiles(job, s, s + 1, tl);
            base += nt;
        }
    }
    {
        const int skip = gridDim.x >= 128 ? 64 : 0;
        const int tid_ = TID(); const int lane = tid_ & 63, gw = (BID() - skip) * 4 + (tid_ >> 6), ngw = (gridDim.x - skip) * 4;
        for (int row = gw >= 0 ? gw : NT; row < NT; row += ngw) {
            const f32x4* xr = (const f32x4*)(p.in[0] + (size_t)row * ND) + lane;
            u32x2* o = (u32x2*)((bf16_t*)p.out + (size_t)row * ND) + lane;
            float ss = 0.f;
#pragma unroll
            for (int j = 0; j < 4; ++j) { const f32x4 v = xr[64 * j]; ss += (v.x * v.x + v.y * v.y) + (v.z * v.z + v.w * v.w); u32x2 w; w.x = pk2(v.x, v.y); w.y = pk2(v.z, v.w); o[64 * j] = w; }
            ss = wave_sum(ss);
            if (lane < 16) ((float*)(p.ws + WS_SSP) + (size_t)NT * 16)[(size_t)row * 16 + lane] = lane == 0 ? ss : 0.f;
        }
    }
    for (int i = BID() * 256 + TID(); i < 2 * 1024 * 32; i += gridDim.x * 256) {
        const int l = i >> 15, k = (i >> 5) & 1023, j = i & 31;
        const float gk = p.in[10][l * ND + k];
        const float wv = j < 4 ? p.in[11][(size_t)(l * ND + k) * 4 + j] : (j < 20 ? p.in[13][(size_t)(l * ND + k) * 16 + (j - 4)] : 0.f);
        ((float*)(p.ws + WS_W + (size_t)l * WL_SIZE + WL_RT))[k * 32 + j] = gk * wv;
    }
    for (int i = BID() * 256 + TID(); i < 16 * 1024; i += gridDim.x * 256) {
        const int part = i >> 10, o = i & 1023, l = o >> 9, kv = (o >> 8) & 1, n = o & 255;
        const float* pos = p.in[9] + (size_t)(l * 2 + kv) * 2048 + part * 128;
        const float* w1 = p.in[kv ? 7 : 5] + (size_t)l * 2048 * 256 + (size_t)part * 128 * 256 + n;
        float s = 0.f;
#pragma unroll 16
        for (int k = 0; k < 128; ++k) s += pos[k] * w1[(size_t)k * 256];
        ((float*)(p.ws + WS_BC1P))[i] = s;
    }
}

__device__ __forceinline__ void phase_norm(const float* x, const float* g, bf16_t* xn) {
    const int tid_ = TID(); const int lane = tid_ & 63, gw = BID() * 4 + (tid_ >> 6), ngw = gridDim.x * 4;
    for (int row = gw; row < NT; row += ngw) {
        const f32x4* xr = (const f32x4*)(x + (size_t)row * ND) + lane;
        f32x4 v[4]; float ss = 0.f;
#pragma unroll
        for (int j = 0; j < 4; ++j) { v[j] = xr[64 * j]; ss += (v[j].x * v[j].x + v[j].y * v[j].y) + (v[j].z * v[j].z + v[j].w * v[j].w); }
        ss = wave_sum(ss);
        const float r = 1.0f / sqrtf(ss * (1.0f / ND) + 1e-6f);
        u32x2* o = (u32x2*)(xn + (size_t)row * ND) + lane;
#pragma unroll
        for (int j = 0; j < 4; ++j) {
            const f32x4 gg = ((const f32x4*)g)[lane + 64 * j];
            u32x2 w; w.x = pk2(v[j].x * r * gg.x, v[j].y * r * gg.y); w.y = pk2(v[j].z * r * gg.z, v[j].w * r * gg.w);
            o[64 * j] = w;
        }
    }
}
__device__ __forceinline__ void phase_final_norm(const bf16_t* xb, float* out, const float* g) {
    const int tid_ = TID(); const int lane = tid_ & 63, gw = BID() * 4 + (tid_ >> 6), ngw = gridDim.x * 4;
    for (int row = gw; row < NT; row += ngw) {
        const u32x2* xr = (const u32x2*)(xb + (size_t)row * ND) + lane;
        f32x4* orow = (f32x4*)(out + (size_t)row * ND) + lane;
        f32x4 v[4]; float ss = 0.f;
#pragma unroll
        for (int j = 0; j < 4; ++j) { const u32x2 w = xr[64 * j]; v[j] = (f32x4){bflo(w.x), bfhi(w.x), bflo(w.y), bfhi(w.y)}; ss += (v[j].x * v[j].x + v[j].y * v[j].y) + (v[j].z * v[j].z + v[j].w * v[j].w); }
        ss = wave_sum(ss);
        const float r = 1.0f / sqrtf(ss * (1.0f / ND) + 1e-6f);
#pragma unroll
        for (int j = 0; j < 4; ++j) {
            const f32x4 gg = ((const f32x4*)g)[lane + 64 * j];
            f32x4 o; o.x = v[j].x * r * gg.x; o.y = v[j].y * r * gg.y; o.z = v[j].z * r * gg.z; o.w = v[j].w * r * gg.w;
            orow[64 * j] = o;
        }
    }
}
typedef float f32x16r __attribute__((ext_vector_type(16)));
__device__ __forceinline__ void phase_route(const bf16_t* x, const float* wr, const float* brg, const float* bre, int* cnt, int* list, float* route, float* rinv, LAS unsigned char* lds) {
    const int tid_ = TID(); const int lane = tid_ & 63, wv = tid_ >> 6;
    const int i = lane & 31, hk = lane >> 5;
    LAS float* tl = (LAS float*)lds + wv * (32 * 33);
    LAS float* ssl = (LAS float*)(lds + 4 * 32 * 33 * 4);
    for (int task = BID(); task < NT / 32; task += gridDim.x) {
        const int row0 = task * 32;
        const bf16_t* xr = x + (size_t)(row0 + i) * ND + wv * 256;
        const float* wp = wr + (size_t)(wv * 256) * 32 + hk * 32 + i;
        f32x16r acc;
#pragma unroll
        for (int q = 0; q < 16; ++q) acc[q] = 0.f;
        float ss = 0.f;
#pragma unroll 8
        for (int k8 = 0; k8 < 32; ++k8) {
            const u32x4 xa = *(const u32x4*)(xr + 8 * k8);
            const float a0 = hk ? bfhi(xa.x) : bflo(xa.x), a1 = hk ? bfhi(xa.y) : bflo(xa.y), a2 = hk ? bfhi(xa.z) : bflo(xa.z), a3 = hk ? bfhi(xa.w) : bflo(xa.w);
            const float* wq = wp + (size_t)(8 * k8) * 32;
            acc = __builtin_amdgcn_mfma_f32_32x32x2f32(a0, wq[0], acc, 0, 0, 0);
            acc = __builtin_amdgcn_mfma_f32_32x32x2f32(a1, wq[2 * 32], acc, 0, 0, 0);
            acc = __builtin_amdgcn_mfma_f32_32x32x2f32(a2, wq[4 * 32], acc, 0, 0, 0);
            acc = __builtin_amdgcn_mfma_f32_32x32x2f32(a3, wq[6 * 32], acc, 0, 0, 0);
            ss += (a0 * a0 + a1 * a1) + (a2 * a2 + a3 * a3);
        }
        ss += __shfl_xor(ss, 32);
#pragma unroll
        for (int q = 0; q < 16; ++q) tl[((q & 3) + 8 * (q >> 2) + 4 * hk) * 33 + i] = acc[q];
        if (hk == 0) ssl[wv * 32 + i] = ss;
        __syncthreads();
        if (wv == 0 && hk == 0) {
            LAS const float* tp0 = (LAS const float*)lds;
            const float sst = (ssl[i] + ssl[32 + i]) + (ssl[64 + i] + ssl[96 + i]);
            const float r = 1.0f / sqrtf(sst * (1.0f / ND) + 1e-6f);
#define RT_SUM(e_) ((tp0[i * 33 + (e_)] + tp0[32 * 33 + i * 33 + (e_)]) + (tp0[2 * 32 * 33 + i * 33 + (e_)] + tp0[3 * 32 * 33 + i * 33 + (e_)]))
            float gl[4], el[16];
#pragma unroll
            for (int e = 0; e < 4; ++e) gl[e] = RT_SUM(e) * r + brg[e];
#pragma unroll
            for (int e = 0; e < 16; ++e) el[e] = RT_SUM(4 + e) * r + bre[e];
#undef RT_SUM
            int gsel = 0; float gmax = gl[0];
#pragma unroll
            for (int e = 1; e < 4; ++e) if (gl[e] > gmax) { gmax = gl[e]; gsel = e; }
            float gden = 0.f;
#pragma unroll
            for (int e = 0; e < 4; ++e) gden += __expf(gl[e] - gmax);
            const float gw_ = 1.0f / gden;
            float wi[4];
#pragma unroll
            for (int e = 0; e < 4; ++e) wi[e] = gsel == 0 ? el[e] : (gsel == 1 ? el[4 + e] : (gsel == 2 ? el[8 + e] : el[12 + e]));
            int i0 = 0; float t0 = wi[0];
#pragma unroll
            for (int e = 1; e < 4; ++e) if (wi[e] > t0) { t0 = wi[e]; i0 = e; }
            int i1 = -1; float t1 = -3.0e38f;
#pragma unroll
            for (int e = 0; e < 4; ++e) if (e != i0 && wi[e] > t1) { t1 = wi[e]; i1 = e; }
            const float ex = __expf(t1 - t0);
            const float ew0 = gw_ / (1.0f + ex), ew1 = gw_ * ex / (1.0f + ex);
            const int lo = i0 < i1 ? i0 : i1, hi = i0 < i1 ? i1 : i0;
            const float wlo = i0 < i1 ? ew0 : ew1, whi = i0 < i1 ? ew1 : ew0;
            const int pidx = lo == 0 ? hi - 1 : (lo == 1 ? hi + 1 : 5);
            const int bucket = gsel * 6 + pidx;
            const int row = row0 + i;
            const int pos = atomicAdd(cnt + 64 * bucket, 1);
            list[(size_t)bucket * NT + pos] = row;
            route[2 * row] = wlo; route[2 * row + 1] = whi;
            rinv[row] = r;
        }
        __syncthreads();
    }
}

struct APlain { const bf16_t* base; int ld; __device__ __forceinline__ const bf16_t* operator()(int r) const { return base + (size_t)r * ld; } };
struct ACmp { const bf16_t* base; __device__ __forceinline__ const bf16_t* operator()(int r) const { return base + (size_t)(r < 126 ? r : 126) * 1024; } };
struct AGather { const bf16_t* xn; const int* list; int cnt; __device__ __forceinline__ const bf16_t* operator()(int r) const { return xn + (size_t)(r < cnt ? list[r] : 0) * ND; } };
struct BPlain { const bf16_t* base; int ld; __device__ __forceinline__ const bf16_t* operator()(int r, int k0) const { return base + (size_t)r * ld + k0; } };
struct BSplit { const bf16_t* b0; const bf16_t* b1; __device__ __forceinline__ const bf16_t* operator()(int r, int k0) const { return k0 < 512 ? b0 + (size_t)r * 512 + k0 : b1 + (size_t)r * 512 + (k0 - 512); } };

template <class AP, class BP, class APN, class BPN>
__device__ __forceinline__ void gemm_kloop(f32x4 (&acc)[4][4], const AP& ap, const BP& bp, int K, LAS unsigned char* lds, bool prefetched, bool has_next, const APN& apn, const BPN& bpn) {
    const int tid = TID(), wid = tid >> 6, lane = tid & 63, wr = wid >> 1, wc = wid & 1, fr = lane & 15, fq = lane >> 4;
#if NAIVE_GEMM
    for (int k0 = 0; k0 < K; k0 += 32) {
#pragma unroll
        for (int m = 0; m < 4; ++m) {
            const bf16_t* arow = ap(wr * 64 + m * 16 + fr) + k0;
            u32x4 av[4];
#pragma unroll
            for (int c = 0; c < 4; ++c) av[c] = ((const u32x4*)arow)[c];
#pragma unroll
            for (int n = 0; n < 4; ++n)
#pragma unroll
                for (int j = 0; j < 4; ++j) {
                    const bf16_t* brow = bp(wc * 64 + n * 16 + 4 * fq + j, k0);
                    float s = 0.f;
#pragma unroll
                    for (int c = 0; c < 4; ++c) {
                        const u32x4 bv = ((const u32x4*)brow)[c];
                        s += bflo(av[c].x) * bflo(bv.x) + bfhi(av[c].x) * bfhi(bv.x) + bflo(av[c].y) * bflo(bv.y) + bfhi(av[c].y) * bfhi(bv.y)
                           + bflo(av[c].z) * bflo(bv.z) + bfhi(av[c].z) * bfhi(bv.z) + bflo(av[c].w) * bflo(bv.w) + bfhi(av[c].w) * bfhi(bv.w);
                    }
                    acc[m][n][j] += s;
                }
        }
    }
#else
    const unsigned woff = (unsigned)wid * 1024u;
    const bf16_t* aptr[4]; int brow[4], bcol;
    {
        const int sb = lane * 16, swz = sb ^ (((sb >> 9) & 1) << 5);
        const int rl = swz >> 6, cc = (wid & 1) * 32 + ((swz & 63) >> 1);
        bcol = cc;
#pragma unroll
        for (int i = 0; i < 4; ++i) { const int R = ((wid >> 1) + 2 * i) * 16 + rl; aptr[i] = ap(R) + cc; brow[i] = R; }
    }
    int aoff[4], boff[4];
#pragma unroll
    for (int m = 0; m < 4; ++m) {
        { const int r = wr * 64 + m * 16 + fr, c = fq * 8, st = (r >> 4) * 2, ob = (r & 15) * 64 + c * 2; aoff[m] = st * 1024 + (ob ^ (((ob >> 9) & 1) << 5)); }
        { const int r = wc * 64 + m * 16 + fr, c = fq * 8, st = (r >> 4) * 2, ob = (r & 15) * 64 + c * 2; boff[m] = st * 1024 + (ob ^ (((ob >> 9) & 1) << 5)); }
    }
    const int nk = K / 64;
#define GT_STAGE(buf, t) do { const int _k0 = (t) * 64; LAS unsigned char* _ba = lds + (buf) * 32768 + woff; \
        _Pragma("unroll") for (int _i = 0; _i < 4; ++_i) { \
            __builtin_amdgcn_global_load_lds((const unsigned*)(aptr[_i] + _k0), (LAS unsigned*)(_ba + _i * 4096), 16, 0, 0); \
            __builtin_amdgcn_global_load_lds((const unsigned*)(bp(brow[_i], _k0) + bcol), (LAS unsigned*)(_ba + 16384 + _i * 4096), 16, 0, 0); } } while (0)
    if (!prefetched) GT_STAGE(0, 0);
#pragma unroll 1
    for (int t = 0; t < nk; ++t) {
        asm volatile("s_waitcnt vmcnt(0)" ::: "memory");
        __syncthreads();
        if (t + 1 < nk) GT_STAGE((t + 1) & 1, t + 1);
        else if (has_next) {
            LAS unsigned char* _ba = lds + woff;
#pragma unroll
            for (int _i = 0; _i < 4; ++_i) {
                __builtin_amdgcn_global_load_lds((const unsigned*)(apn(brow[_i]) + bcol), (LAS unsigned*)(_ba + _i * 4096), 16, 0, 0);
                __builtin_amdgcn_global_load_lds((const unsigned*)(bpn(brow[_i], 0) + bcol), (LAS unsigned*)(_ba + 16384 + _i * 4096), 16, 0, 0);
            }
        }
        LAS const unsigned char* la = lds + (t & 1) * 32768;
        LAS const unsigned char* lb = la + 16384;
        bf16x8 At[2][4], Bt[2][4];
#pragma unroll
        for (int kh = 0; kh < 2; ++kh) {
#pragma unroll
            for (int m = 0; m < 4; ++m) At[kh][m] = *(const LAS bf16x8*)(la + aoff[m] + kh * 1024);
#pragma unroll
            for (int n = 0; n < 4; ++n) Bt[kh][n] = *(const LAS bf16x8*)(lb + boff[n] + kh * 1024);
        }
#pragma unroll
        for (int kh = 0; kh < 2; ++kh)
#pragma unroll
            for (int m = 0; m < 4; ++m)
#pragma unroll
                for (int n = 0; n < 4; ++n) acc[m][n] = __builtin_amdgcn_mfma_f32_16x16x32_bf16(Bt[kh][n], At[kh][m], acc[m][n], 0, 0, 0);
    }
#undef GT_STAGE
#endif
}
__device__ __forceinline__ void zero_acc(f32x4 (&acc)[4][4]) {
#pragma unroll
    for (int m = 0; m < 4; ++m)
#pragma unroll
        for (int n = 0; n < 4; ++n) acc[m][n] = (f32x4){0.f, 0.f, 0.f, 0.f};
}
template <class AP, class BP, class EPI>
__device__ __forceinline__ void gemm_tile(const AP& ap, const BP& bp, int K, const EPI& epi, LAS unsigned char* lds, bool prefetched, bool has_next, const AP& apn, const BP& bpn) {
    const int tid = TID(), wid = tid >> 6, lane = tid & 63, wr = wid >> 1, wc = wid & 1, fr = lane & 15, fq = lane >> 4;
    f32x4 acc[4][4]; zero_acc(acc);
    gemm_kloop(acc, ap, bp, K, lds, prefetched, has_next, apn, bpn);
    epi(acc, wr, wc, fr, fq);
}

__device__ __forceinline__ float rinv_from_ssp(const float* ssp, int row) {
    const f32x4* q = (const f32x4*)(ssp + (size_t)row * 16);
    const f32x4 a = q[0], b = q[1], c = q[2], d = q[3];
    const float s = ((a.x + a.y) + (a.z + a.w)) + ((b.x + b.y) + (b.z + b.w)) + ((c.x + c.y) + (c.z + c.w)) + ((d.x + d.y) + (d.z + d.w));
    return 1.0f / sqrtf(s * (1.0f / ND) + 1e-6f);
}
__device__ __forceinline__ float row_ss64(const f32x4& a, const f32x4& b, const f32x4& c, const f32x4& d) {
    float s = ((a.x * a.x + a.y * a.y) + (a.z * a.z + a.w * a.w)) + ((b.x * b.x + b.y * b.y) + (b.z * b.z + b.w * b.w))
            + ((c.x * c.x + c.y * c.y) + (c.z * c.z + c.w * c.w)) + ((d.x * d.x + d.y * d.y) + (d.z * d.z + d.w * d.w));
    s += __shfl_xor(s, 16); s += __shfl_xor(s, 32);
    return s;
}
struct EpiInProj {
    int mt, nt; unsigned char* ws; const float* ssp;
    __device__ __forceinline__ void operator()(const f32x4 (&acc)[4][4], int wr, int wc, int fr, int fq) const {
#pragma unroll
        for (int m = 0; m < 4; ++m) {
            const int row = mt * 128 + wr * 64 + m * 16 + fr, b = row >> 11, s = row & 2047;
            const float rr = rinv_from_ssp(ssp, row);
#pragma unroll
            for (int n = 0; n < 4; ++n) {
                const int col = wc * 64 + n * 16 + 4 * fq;
                const f32x4 v = acc[m][n] * rr;
                if (nt < 16) {
                    const int reg = nt >> 2, c = (nt & 3) * 128 + col, head = c >> 6, d = c & 63;
                    const float sc = (reg == 0 || reg == 3) ? 0.125f * 1.4426950408889634f : 1.0f;
                    bf16_t* dst = (bf16_t*)(ws + WS_QA + (size_t)reg * 16 * MiB) + ((size_t)((b * 8 + head) * NS + s) * 64 + d);
                    u32x2 w; w.x = pk2(v.x * sc, v.y * sc); w.y = pk2(v.z * sc, v.w * sc);
                    *(u32x2*)dst = w;
                } else if (nt < 22) {
                    const int g = col >> 6, d = col & 63;
                    bf16_t* dst = (bf16_t*)(ws + WS_KV6 + (size_t)(nt - 16) * 4 * MiB) + ((size_t)((b * 2 + g) * NS + s) * 64 + d);
                    u32x2 w; w.x = pk2(v.x, v.y); w.y = pk2(v.z, v.w);
                    *(u32x2*)dst = w;
                } else {
                    if (col < 24) {
                        f32x4 o; o.x = sigmoidf_(v.x); o.y = sigmoidf_(v.y); o.z = sigmoidf_(v.z); o.w = sigmoidf_(v.w);
                        *(f32x4*)((float*)(ws + WS_GATES) + (size_t)row * 24 + col) = o;
                    }
                }
            }
        }
    }
};
struct EpiCmp1 {
    bf16_t* hc; const float* bc1; int row0, col0;
    __device__ __forceinline__ void operator()(const f32x4 (&acc)[4][4], int wr, int wc, int fr, int fq) const {
#pragma unroll
        for (int m = 0; m < 4; ++m) {
            const int row = row0 + wr * 64 + m * 16 + fr;
#pragma unroll
            for (int n = 0; n < 4; ++n) {
                const int col = col0 + wc * 64 + n * 16 + 4 * fq;
                f32x4 bb = *(const f32x4*)(bc1 + col);
#pragma unroll
                for (int pp = 1; pp < 16; ++pp) bb += *(const f32x4*)(bc1 + pp * 1024 + col);
                const f32x4 v = acc[m][n];
                u32x2 w; w.x = pk2(gelu_tanh(v.x + bb.x), gelu_tanh(v.y + bb.y)); w.y = pk2(gelu_tanh(v.z + bb.z), gelu_tanh(v.w + bb.w));
                *(u32x2*)(hc + (size_t)row * 256 + col) = w;
            }
        }
    }
};
struct EpiCmp2 {
    bf16_t* dst; int row0;
    __device__ __forceinline__ void operator()(const f32x4 (&acc)[4][4], int wr, int wc, int fr, int fq) const {
        if (wc != 0) return;
#pragma unroll
        for (int m = 0; m < 4; ++m) {
            const int row = row0 + wr * 64 + m * 16 + fr;
#pragma unroll
            for (int n = 0; n < 4; ++n) {
                const int col = n * 16 + 4 * fq;
                const f32x4 v = acc[m][n];
                u32x2 w; w.x = pk2(v.x, v.y); w.y = pk2(v.z, v.w);
                *(u32x2*)(dst + (size_t)row * 64 + col) = w;
            }
        }
    }
};
struct EpiResAdd {
    bf16_t* res; int row0, col0;
    __device__ __forceinline__ void operator()(const f32x4 (&acc)[4][4], int wr, int wc, int fr, int fq) const {
#pragma unroll
        for (int m = 0; m < 4; ++m) {
            const int row = row0 + wr * 64 + m * 16 + fr;
#pragma unroll
            for (int n = 0; n < 4; ++n) {
                const int col = col0 + wc * 64 + n * 16 + 4 * fq;
                u32x2* pp = (u32x2*)(res + (size_t)row * ND + col);
                const u32x2 b = *pp; const f32x4 a = acc[m][n];
                u32x2 w; w.x = pk2(bflo(b.x) + a.x, bfhi(b.x) + a.y); w.y = pk2(bflo(b.y) + a.z, bfhi(b.y) + a.w);
                *pp = w;
            }
        }
    }
};
struct EpiMoeGU {
    bf16_t* hid; const int* list; const float* route; const float* rinv; int cnt, hrow0, nt16;
    __device__ __forceinline__ void operator()(const f32x4 (&acc)[4][4], int wr, int wc, int fr, int fq) const {
        const int half = nt16 >> 3, nte = nt16 & 7;
#pragma unroll
        for (int m = 0; m < 4; ++m) {
            const int r = wr * 64 + m * 16 + fr;
            const int tok = r < cnt ? list[r] : 0;
            const float w = r < cnt ? route[2 * tok + half] : 0.f;
            const float rt = rinv[tok];
#pragma unroll
            for (int pr = 0; pr < 2; ++pr) {
                const f32x4 gv = acc[m][2 * pr], uv = acc[m][2 * pr + 1];
                const int hc = half * 512 + (4 * nte + 2 * wc + pr) * 16 + 4 * fq;
                float h[4];
#pragma unroll
                for (int j = 0; j < 4; ++j) { const float gg = gv[j] * rt; h[j] = gg / (1.0f + __expf(-gg)) * (uv[j] * rt) * w; }
                u32x2 o; o.x = pk2(h[0], h[1]); o.y = pk2(h[2], h[3]);
                *(u32x2*)(hid + (size_t)(hrow0 + r) * 1024 + hc) = o;
            }
        }
    }
};
struct EpiMoeDown {
    bf16_t* res; const int* list; float* ssp; int cnt, col0;
    __device__ __forceinline__ void operator()(const f32x4 (&acc)[4][4], int wr, int wc, int fr, int fq) const {
#pragma unroll
        for (int m = 0; m < 4; ++m) {
            const int r = wr * 64 + m * 16 + fr;
            const bool ok = r < cnt;
            const int tok = ok ? list[r] : 0;
            f32x4 nv[4];
#pragma unroll
            for (int n = 0; n < 4; ++n) {
                const int col = col0 + wc * 64 + n * 16 + 4 * fq;
                u32x2* pp = (u32x2*)(res + (size_t)tok * ND + col);
                const u32x2 b = *pp; const f32x4 a = acc[m][n];
                nv[n] = (f32x4){bflo(b.x) + a.x, bfhi(b.x) + a.y, bflo(b.y) + a.z, bfhi(b.y) + a.w};
                if (ok) { u32x2 w; w.x = pk2(nv[n].x, nv[n].y); w.y = pk2(nv[n].z, nv[n].w); *pp = w; }
            }
            const float ps = row_ss64(nv[0], nv[1], nv[2], nv[3]);
            if (ok && fq == 0) ssp[(size_t)tok * 16 + (col0 >> 6) + wc] = ps;
        }
    }
};
struct EpiBf16 {
    bf16_t* dst; int ld, row0, col0;
    __device__ __forceinline__ void operator()(const f32x4 (&acc)[4][4], int wr, int wc, int fr, int fq) const {
#pragma unroll
        for (int m = 0; m < 4; ++m) {
            const int row = row0 + wr * 64 + m * 16 + fr;
#pragma unroll
            for (int n = 0; n < 4; ++n) {
                const int col = col0 + wc * 64 + n * 16 + 4 * fq;
                const f32x4 v = acc[m][n];
                u32x2 w; w.x = pk2(v.x, v.y); w.y = pk2(v.z, v.w);
                *(u32x2*)(dst + (size_t)row * ld + col) = w;
            }
        }
    }
};
struct EpiPleFused {
    const bf16_t* rin; const float* ssp_in; bf16_t* rout; float* ssp_out; int row0, col0;
    __device__ __forceinline__ void operator()(const f32x4 (&acc)[4][4], const f32x4 (&acc2)[4][4], int wr, int wc, int fr, int fq) const {
#pragma unroll
        for (int m = 0; m < 4; ++m) {
            const int row = row0 + wr * 64 + m * 16 + fr;
            const float rr = rinv_from_ssp(ssp_in, row);
            f32x4 nv[4];
#pragma unroll
            for (int n = 0; n < 4; ++n) {
                const int col = col0 + wc * 64 + n * 16 + 4 * fq;
                const size_t off = (size_t)row * ND + col;
                const f32x4 v = acc[m][n] * rr, q = acc2[m][n];
                const u32x2 b = *(const u32x2*)(rin + off);
                f32x4 o = (f32x4){bflo(b.x), bfhi(b.x), bflo(b.y), bfhi(b.y)};
                o.x += sigmoidf_(v.x) * q.x; o.y += sigmoidf_(v.y) * q.y; o.z += sigmoidf_(v.z) * q.z; o.w += sigmoidf_(v.w) * q.w;
                u32x2 w; w.x = pk2(o.x, o.y); w.y = pk2(o.z, o.w);
                *(u32x2*)(rout + off) = w;
                nv[n] = o;
            }
            const float ps = row_ss64(nv[0], nv[1], nv[2], nv[3]);
            if (fq == 0) ssp_out[(size_t)row * 16 + (col0 >> 6) + wc] = ps;
        }
    }
};
struct EpiPleGate {
    float* out; const bf16_t* p2; int row0, col0; float sc;
    __device__ __forceinline__ void operator()(const f32x4 (&acc)[4][4], int wr, int wc, int fr, int fq) const {
#pragma unroll
        for (int m = 0; m < 4; ++m) {
            const int row = row0 + wr * 64 + m * 16 + fr;
#pragma unroll
            for (int n = 0; n < 4; ++n) {
                const int col = col0 + wc * 64 + n * 16 + 4 * fq;
                const size_t off = (size_t)row * ND + col;
                const u32x2 pv = *(const u32x2*)(p2 + off);
                const f32x4 v = acc[m][n];
                f32x4 o = *(const f32x4*)(out + off);
                o.x += sc * sigmoidf_(v.x) * bflo(pv.x); o.y += sc * sigmoidf_(v.y) * bfhi(pv.x); o.z += sc * sigmoidf_(v.z) * bflo(pv.y); o.w += sc * sigmoidf_(v.w) * bfhi(pv.y);
                *(f32x4*)(out + off) = o;
            }
        }
    }
};

template <class PH, class AP, class BP, class EPI>
__device__ __forceinline__ void gemm_stream(const PH& ph, int first, int step, int count, int K, LAS unsigned char* lds) {
    int q = first;
    if (q >= count) return;
    AP ap, apn; BP bp, bpn; EPI ep, epn;
    ph.make(q, ap, bp, ep);
    bool pref = false;
    for (;;) {
        const int qn = q + step; const bool hn = qn < count;
        if (hn) ph.make(qn, apn, bpn, epn); else { apn = ap; bpn = bp; epn = ep; }
        gemm_tile(ap, bp, K, ep, lds, pref, hn, apn, bpn);
        if (!hn) break;
        ap = apn; bp = bpn; ep = epn; q = qn; pref = true;
    }
}

__device__ __forceinline__ void load_q32(const bf16_t* p, float* q) {
#pragma unroll
    for (int c = 0; c < 4; ++c) {
        const u32x4 v = ((const u32x4*)p)[c];
        q[8 * c] = bflo(v.x); q[8 * c + 1] = bfhi(v.x); q[8 * c + 2] = bflo(v.y); q[8 * c + 3] = bfhi(v.y);
        q[8 * c + 4] = bflo(v.z); q[8 * c + 5] = bfhi(v.z); q[8 * c + 6] = bflo(v.w); q[8 * c + 7] = bfhi(v.w);
    }
}
__device__ __forceinline__ float dot32p(const float* q, const bf16_t* k) {
    float s0 = 0.f, s1 = 0.f;
#pragma unroll
    for (int c = 0; c < 4; ++c) {
        const u32x4 v = ((const u32x4*)k)[c];
        s0 += q[8 * c] * bflo(v.x); s1 += q[8 * c + 1] * bfhi(v.x); s0 += q[8 * c + 2] * bflo(v.y); s1 += q[8 * c + 3] * bfhi(v.y);
        s0 += q[8 * c + 4] * bflo(v.z); s1 += q[8 * c + 5] * bfhi(v.z); s0 += q[8 * c + 6] * bflo(v.w); s1 += q[8 * c + 7] * bfhi(v.w);
    }
    const float s = s0 + s1;
    return s + __shfl_xor(s, 1);
}
__device__ __forceinline__ void axpy32(float* a, float p, const bf16_t* vr) {
#pragma unroll
    for (int c = 0; c < 4; ++c) {
        const u32x4 v = ((const u32x4*)vr)[c];
        a[8 * c] += p * bflo(v.x); a[8 * c + 1] += p * bfhi(v.x); a[8 * c + 2] += p * bflo(v.y); a[8 * c + 3] += p * bfhi(v.y);
        a[8 * c + 4] += p * bflo(v.z); a[8 * c + 5] += p * bfhi(v.z); a[8 * c + 6] += p * bflo(v.w); a[8 * c + 7] += p * bfhi(v.w);
    }
}
#define ONLINE_STEP(s_, vrow_) do { const float _s = (s_); if (_s > mx) { const float _c = __expf(mx - _s); l *= _c; _Pragma("unroll") for (int _i = 0; _i < 32; ++_i) acc[_i] *= _c; mx = _s; } \
    const float _p = __expf(_s - mx); l += _p; axpy32(acc, _p, (vrow_)); } while (0)

__device__ __forceinline__ void store_o32(bf16_t* dst, const float* a, float sc) {
#pragma unroll
    for (int c = 0; c < 4; ++c) {
        u32x4 w; w.x = pk2(a[8 * c] * sc, a[8 * c + 1] * sc); w.y = pk2(a[8 * c + 2] * sc, a[8 * c + 3] * sc);
        w.z = pk2(a[8 * c + 4] * sc, a[8 * c + 5] * sc); w.w = pk2(a[8 * c + 6] * sc, a[8 * c + 7] * sc);
        ((u32x4*)dst)[c] = w;
    }
}

__device__ __forceinline__ void attn_dilated_naive(const unsigned char* ws, int gtid, int gthreads) {
    asm volatile("" : "+v"(gtid));
    const bf16_t* qa = (const bf16_t*)(ws + WS_QA); const bf16_t* ka = (const bf16_t*)(ws + WS_KA); const bf16_t* va = (const bf16_t*)(ws + WS_VA);
    bf16_t* ob = (bf16_t*)(ws + WS_O);
    for (int id2 = gtid; id2 < NB * 8 * NS * 2; id2 += gthreads) {
        const int idx = id2 >> 1, hf = (id2 & 1) * 32;
        const int t = idx & 2047, bh = idx >> 11, h = bh & 7, b = bh >> 3;
        float q[32]; load_q32(qa + (size_t)idx * 64 + hf, q);
        const bf16_t* kb = ka + (size_t)bh * NS * 64 + hf; const bf16_t* vb = va + (size_t)bh * NS * 64 + hf;
        const float slope = exp2f(-((float)h + 0.5f));
        float mx = -1e30f, l = 0.f; float acc[32];
#pragma unroll
        for (int i = 0; i < 32; ++i) acc[i] = 0.f;
#pragma unroll 1
        for (int pat = 0; pat < 3; ++pat) {
            const int dil = pat == 0 ? 1 : (pat == 1 ? 4 : 16);
#pragma unroll 1
            for (int j = 0; j <= 128; ++j) {
                const int dist = j * dil, pos = t - dist;
                if (pos < 0) break;
                const float s = dot32p(q, kb + (size_t)pos * 64) - slope * (float)dist;
                ONLINE_STEP(s, vb + (size_t)pos * 64);
            }
        }
        store_o32(ob + ((size_t)(b * NS + t) * ND + h * 64 + hf), acc, 1.0f / l);
    }
}

__device__ __forceinline__ void nsa_imp_naive(const unsigned char* ws, int gtid, int gthreads) {
    asm volatile("" : "+v"(gtid));
    const bf16_t* qb = (const bf16_t*)(ws + WS_QB); const bf16_t* kcmp = (const bf16_t*)(ws + WS_KCMP);
    float* imph = (float*)(ws + WS_IMPH);
    for (int id2 = gtid; id2 < NB * 8 * NS * 2; id2 += gthreads) {
        const int idx = id2 >> 1, hf = (id2 & 1) * 32;
        const int t = idx & 2047, bh = idx >> 11, hb = bh & 7, b = bh >> 3, g = hb >> 2;
        float q[32]; load_q32(qb + (size_t)idx * 64 + hf, q);
        const bf16_t* kc = kcmp + (size_t)(b * 2 + g) * 128 * 64 + hf;
        const float slope = exp2f(-(float)(hb + 1));
        const int ncv = t >= 31 ? ((t - 31) >> 4) + 1 : 0;
        float mx = -1e30f;
#pragma unroll 1
        for (int c = 0; c < ncv; ++c) { const float s = dot32p(q, kc + c * 64) - slope * (float)(t - (16 * c + 31)); mx = fmaxf(mx, s); }
        float den = 0.f;
#pragma unroll 1
        for (int c = 0; c < ncv; ++c) { const float s = dot32p(q, kc + c * 64) - slope * (float)(t - (16 * c + 31)); den += __expf(s - mx); }
        const float inv = ncv > 0 ? 1.0f / den : 0.f;
#pragma unroll 1
        for (int n = 0; n < 32; ++n) {
            float imp = 0.f;
#pragma unroll 1
            for (int j = -1; j <= 3; ++j) {
                const int c = 4 * n + j;
                if (c >= 0 && c < ncv) {
                    const float s = dot32p(q, kc + c * 64) - slope * (float)(t - (16 * c + 31));
                    const float pp = __expf(s - mx) * inv;
                    imp += (j == -1 || j == 3) ? 0.5f * pp : pp;
                }
            }
            if (hf == 0) imph[(size_t)idx * 32 + n] = imp;
        }
    }
}
__device__ __forceinline__ void nsa_select(const unsigned char* ws, unsigned* maskbuf) {
    const float* imph = (const float*)(ws + WS_IMPH);
    const int tid_ = TID(); const int lane = tid_ & 63, gw = BID() * 4 + (tid_ >> 6), ngw = gridDim.x * 4;
    for (int it = gw; it < NB * 2 * NS / 2; it += ngw) {
        const int item = it * 2 + (lane >> 5), t = item & 2047, bg = item >> 11, n = lane & 31;
        float imp = 0.f;
#pragma unroll
        for (int r = 0; r < 4; ++r) imp += imph[((size_t)(bg * 4 + r) * NS + t) * 32 + n];
        const int cur = t >> 6;
        const bool valid = n <= cur;
        const bool forced = (n == 0) || (cur - n < 2);
        const float score = valid ? imp + (forced ? 1e4f : 0.f) : -1e30f;
        int rank = 0;
        for (int m = 0; m < 32; ++m) {
            const float sm = __shfl(score, (lane & 32) | m);
            rank += (sm > score || (sm == score && m < n)) ? 1 : 0;
        }
        const bool sel = valid && rank < 16;
        const unsigned long long bal = __ballot(sel);
        if (n == 0) maskbuf[item] = (lane >> 5) ? (unsigned)(bal >> 32) : (unsigned)bal;
    }
}
__device__ __forceinline__ void nsa_attn_naive(const unsigned char* ws, int gtid, int gthreads) {
    asm volatile("" : "+v"(gtid));
    const bf16_t* qb = (const bf16_t*)(ws + WS_QB);
    const bf16_t* kcmp = (const bf16_t*)(ws + WS_KCMP); const bf16_t* vcmp = kcmp + (size_t)16 * 128 * 64;
    const bf16_t* ksb = (const bf16_t*)(ws + WS_KV6 + 2 * 4 * MiB); const bf16_t* vsb = (const bf16_t*)(ws + WS_KV6 + 3 * 4 * MiB);
    const bf16_t* kwb = (const bf16_t*)(ws + WS_KV6 + 4 * 4 * MiB); const bf16_t* vwb = (const bf16_t*)(ws + WS_KV6 + 5 * 4 * MiB);
    const float* gates = (const float*)(ws + WS_GATES);
    const unsigned* maskbuf = (const unsigned*)(ws + WS_MASK);
    bf16_t* ob = (bf16_t*)(ws + WS_O);
    for (int id2 = gtid; id2 < NB * 8 * NS * 2; id2 += gthreads) {
        const int idx = id2 >> 1, hf = (id2 & 1) * 32;
        const int t = idx & 2047, bh = idx >> 11, hb = bh & 7, b = bh >> 3, g = hb >> 2, bg = b * 2 + g;
        float q[32]; load_q32(qb + (size_t)idx * 64 + hf, q);
        const float slope = exp2f(-(float)(hb + 1));
        const float* gt = gates + (size_t)(b * NS + t) * 24 + hb * 3;
        float tot[32], acc[32];
#pragma unroll
        for (int i = 0; i < 32; ++i) tot[i] = 0.f;
        {
            const bf16_t* kc = kcmp + (size_t)bg * 128 * 64 + hf; const bf16_t* vc = vcmp + (size_t)bg * 128 * 64 + hf;
            const int ncv = t >= 31 ? ((t - 31) >> 4) + 1 : 0;
            if (ncv > 0) {
                float mx = -1e30f, l = 0.f;
#pragma unroll
                for (int i = 0; i < 32; ++i) acc[i] = 0.f;
#pragma unroll 1
                for (int c = 0; c < ncv; ++c) { const float s = dot32p(q, kc + c * 64) - slope * (float)(t - (16 * c + 31)); ONLINE_STEP(s, vc + c * 64); }
                const float sc = gt[0] / l;
#pragma unroll
                for (int i = 0; i < 32; ++i) tot[i] += sc * acc[i];
            }
        }
        {
            const bf16_t* kb = ksb + (size_t)bg * NS * 64 + hf; const bf16_t* vb = vsb + (size_t)bg * NS * 64 + hf;
            const unsigned mask = maskbuf[bg * NS + t];
            float mx = -1e30f, l = 0.f;
#pragma unroll
            for (int i = 0; i < 32; ++i) acc[i] = 0.f;
#pragma unroll 1
            for (int n = 0; n < 32; ++n) {
                if (!((mask >> n) & 1u)) continue;
#pragma unroll 1
                for (int i = 0; i < 64; ++i) {
                    const int pos = n * 64 + i;
                    if (pos > t) break;
                    const float s = dot32p(q, kb + (size_t)pos * 64) - slope * (float)(t - pos);
                    ONLINE_STEP(s, vb + (size_t)pos * 64);
                }
            }
            const float sc = gt[1] / l;
#pragma unroll
            for (int i = 0; i < 32; ++i) tot[i] += sc * acc[i];
        }
        {
            const bf16_t* kb = kwb + (size_t)bg * NS * 64 + hf; const bf16_t* vb = vwb + (size_t)bg * NS * 64 + hf;
            float mx = -1e30f, l = 0.f;
#pragma unroll
            for (int i = 0; i < 32; ++i) acc[i] = 0.f;
#pragma unroll 1
            for (int dist = 0; dist < 512; ++dist) {
                const int pos = t - dist;
                if (pos < 0) break;
                const float s = dot32p(q, kb + (size_t)pos * 64) - slope * (float)dist;
                ONLINE_STEP(s, vb + (size_t)pos * 64);
            }
            const float sc = gt[2] / l;
#pragma unroll
            for (int i = 0; i < 32; ++i) tot[i] += sc * acc[i];
        }
        store_o32(ob + ((size_t)(b * NS + t) * ND + 512 + hb * 64 + hf), tot, 1.0f);
    }
}

constexpr int KVS = 144;
constexpr int KVT = 64 * KVS;
constexpr int VS = 128;
constexpr int VT = 64 * VS;
#define LOG2E_F 1.4426950408889634f
__device__ __forceinline__ unsigned cvtpk(float lo, float hi) { f32x2_t v = {lo, hi}; bf16x2_t b = __builtin_convertvector(v, bf16x2_t); return __builtin_bit_cast(unsigned, b); }
__device__ __forceinline__ s16x4 vtr(LAS const unsigned char* p) { return __builtin_bit_cast(s16x4, __builtin_amdgcn_ds_read_tr16_b64_v4i16((LAS s16x4*)p)); }
__device__ __forceinline__ f32x16 zero16() { f32x16 z;
#pragma unroll
    for (int i = 0; i < 16; ++i) z[i] = 0.f;
    return z; }

__device__ __forceinline__ void load_kv_tile(LAS unsigned char* Kt, LAS unsigned char* Vt, const bf16_t* kbase, const bf16_t* vbase, int row0, int rstride, int rmin, int rmax, int tid) {
    const int j = tid >> 2, ch = tid & 3;
    int tok = row0 + j * rstride; tok = tok < rmin ? rmin : (tok > rmax ? rmax : tok);
    const u32x4* kp = (const u32x4*)(kbase + (size_t)tok * 64);
    const u32x4* vp = (const u32x4*)(vbase + (size_t)tok * 64);
    const u32x4 k0 = kp[ch], k1 = kp[ch + 4], v0 = vp[ch], v1 = vp[ch + 4];
    *(LAS u32x4*)(Kt + j * KVS + ch * 16) = k0; *(LAS u32x4*)(Kt + j * KVS + (ch + 4) * 16) = k1;
    { const int sx = 2 * (j & 3); *(LAS u32x4*)(Vt + j * VS + ((ch ^ sx) * 16)) = v0; *(LAS u32x4*)(Vt + j * VS + (((ch + 4) ^ sx) * 16)) = v1; }
}

struct KVRegs { u32x4 k0, k1, v0, v1; };
__device__ __forceinline__ void kv_fetch(KVRegs& r, const bf16_t* kbase, const bf16_t* vbase, int row0, int rstride, int rmin, int rmax, int tid) {
    const int j = tid >> 2, ch = tid & 3;
    int tok = row0 + j * rstride; tok = tok < rmin ? rmin : (tok > rmax ? rmax : tok);
    const u32x4* kp = (const u32x4*)(kbase + (size_t)tok * 64);
    const u32x4* vp = (const u32x4*)(vbase + (size_t)tok * 64);
    r.k0 = kp[ch]; r.k1 = kp[ch + 4]; r.v0 = vp[ch]; r.v1 = vp[ch + 4];
}
__device__ __forceinline__ void kv_commit(const KVRegs& r, LAS unsigned char* Kt, LAS unsigned char* Vt, int tid) {
    const int j = tid >> 2, ch = tid & 3;
    *(LAS u32x4*)(Kt + j * KVS + ch * 16) = r.k0; *(LAS u32x4*)(Kt + j * KVS + (ch + 4) * 16) = r.k1;
    { const int sx = 2 * (j & 3); *(LAS u32x4*)(Vt + j * VS + ((ch ^ sx) * 16)) = r.v0; *(LAS u32x4*)(Vt + j * VS + (((ch + 4) ^ sx) * 16)) = r.v1; }
}
__device__ __forceinline__ void pv32(f32x16& o0, f32x16& o1, const f32x16& sv, LAS const unsigned char* vp0, LAS const unsigned char* vp1  ) {
#pragma unroll
    for (int s16 = 0; s16 < 2; ++s16) {
        u32x4 pw;
        pw.x = cvtpk(sv[8 * s16 + 0], sv[8 * s16 + 1]); pw.y = cvtpk(sv[8 * s16 + 2], sv[8 * s16 + 3]);
        pw.z = cvtpk(sv[8 * s16 + 4], sv[8 * s16 + 5]); pw.w = cvtpk(sv[8 * s16 + 6], sv[8 * s16 + 7]);
        const bf16x8 pf = __builtin_bit_cast(bf16x8, pw);
        const s16x4 a0 = vtr(vp0 + s16 * 16 * VS), b0 = vtr(vp0 + s16 * 16 * VS + 8 * VS), a1 = vtr(vp1 + s16 * 16 * VS), b1 = vtr(vp1 + s16 * 16 * VS + 8 * VS);
        const bf16x8 vf0 = {a0[0], a0[1], a0[2], a0[3], b0[0], b0[1], b0[2], b0[3]};
        const bf16x8 vf1 = {a1[0], a1[1], a1[2], a1[3], b1[0], b1[1], b1[2], b1[3]};
        o0 = __builtin_amdgcn_mfma_f32_32x32x16_bf16(vf0, pf, o0, 0, 0, 0);
        o1 = __builtin_amdgcn_mfma_f32_32x32x16_bf16(vf1, pf, o1, 0, 0, 0);
    }
}
__device__ __forceinline__ f32x16 qk32(const bf16x8* qf, LAS const unsigned char* kp  , f32x16 s  ) {
#pragma unroll
    for (int k = 0; k < 4; ++k) {
        const bf16x8 kf = *(const LAS bf16x8*)(kp + 32 * k);
        s = __builtin_amdgcn_mfma_f32_32x32x16_bf16(kf, qf[k], s, 0, 0, 0);
    }
    return s;
}
template <int KS, bool TRY_FULL>
__device__ __forceinline__ void fa_tile64(f32x16& o0, f32x16& o1, float& m, float& l, const bf16x8* qf, LAS const unsigned char* Kt, LAS const unsigned char* Vt, int lane, float dA, float wmax, float ns2) {
    const int r = lane & 31, h = lane >> 5;
    LAS const unsigned char* kp = Kt + r * KVS + 16 * h;
    const float dAh = dA - (float)(KS * 4 * h);
    const float hi = dAh, lo = dAh - wmax, base = ns2 * dAh;
    f32x16 s0, s1;
#pragma unroll
    for (int i = 0; i < 16; ++i) {
        const float c0 = (float)(KS * ((i & 3) + 8 * (i >> 2))), c1 = c0 + (float)(32 * KS);
        s0[i] = fmaf(-c0, ns2, base); s1[i] = fmaf(-c1, ns2, base);
    }
    s0 = qk32(qf, kp, s0); s1 = qk32(qf, kp + 32 * KVS, s1);
    float tmax = -1e30f;
    if (TRY_FULL && __all(lo <= 0.f && hi >= (float)(59 * KS))) {
#pragma unroll
        for (int i = 0; i < 16; ++i) tmax = fmaxf(tmax, fmaxf(s0[i], s1[i]));
    } else {
#pragma unroll
        for (int i = 0; i < 16; ++i) {
            const float c0 = (float)(KS * ((i & 3) + 8 * (i >> 2))), c1 = c0 + (float)(32 * KS);
            const float t0 = (c0 >= lo && c0 <= hi) ? s0[i] : -1e30f;
            const float t1 = (c1 >= lo && c1 <= hi) ? s1[i] : -1e30f;
            s0[i] = t0; s1[i] = t1;
            tmax = fmaxf(tmax, fmaxf(t0, t1));
        }
    }
    tmax = fmaxf(tmax, __shfl_xor(tmax, 32));
    const float mn = fmaxf(m, tmax);
    const float corr = __builtin_amdgcn_exp2f(m - mn);
    m = mn;
    const float mu = fmaxf(mn, -1e29f);
    float ps = 0.f;
#pragma unroll
    for (int i = 0; i < 16; ++i) {
        s0[i] = __builtin_amdgcn_exp2f(s0[i] - mu); s1[i] = __builtin_amdgcn_exp2f(s1[i] - mu);
        ps += s0[i] + s1[i];
    }
    l = l * corr + ps;
    if (!__all(corr == 1.0f)) {
#pragma unroll
        for (int i = 0; i < 16; ++i) { o0[i] *= corr; o1[i] *= corr; }
    }
    const int vq = (lane & 15) >> 2, vc0 = 2 * ((lane >> 4) & 1) + ((lane & 3) >> 1), vsx = 2 * vq;
    LAS const unsigned char* vp0 = Vt + (4 * h + vq) * VS + ((vc0 ^ vsx) * 16) + 8 * (lane & 1);
    LAS const unsigned char* vp1 = Vt + (4 * h + vq) * VS + (((vc0 + 4) ^ vsx) * 16) + 8 * (lane & 1);
    pv32(o0, o1, s0, vp0, vp1);
    pv32(o0, o1, s1, vp0 + 32 * VS, vp1 + 32 * VS);
}
__device__ __forceinline__ void acc_scaled(f32x16& t0, f32x16& t1, const f32x16& o0, const f32x16& o1, float sc) {
#pragma unroll
    for (int i = 0; i < 16; ++i) { t0[i] += sc * o0[i]; t1[i] += sc * o1[i]; }
}
__device__ __forceinline__ void store_ot(bf16_t* orow, const f32x16& o0, const f32x16& o1, float sc, int h) {
#pragma unroll
    for (int u = 0; u < 4; ++u) {
        u32x2 w0, w1;
        w0.x = cvtpk(o0[4 * u] * sc, o0[4 * u + 1] * sc); w0.y = cvtpk(o0[4 * u + 2] * sc, o0[4 * u + 3] * sc);
        w1.x = cvtpk(o1[4 * u] * sc, o1[4 * u + 1] * sc); w1.y = cvtpk(o1[4 * u + 2] * sc, o1[4 * u + 3] * sc);
        *(u32x2*)(orow + 8 * u + 4 * h) = w0;
        *(u32x2*)(orow + 32 + 8 * u + 4 * h) = w1;
    }
}
__device__ __forceinline__ void load_qf(bf16x8* qf, const bf16_t* qrow, int h) {
#pragma unroll
    for (int k = 0; k < 4; ++k) qf[k] = *(const bf16x8*)(qrow + 16 * k + 8 * h);
}

__device__ __forceinline__ void dil_item(unsigned char* ws, int item, LAS unsigned char* lds) {
    const int tid = TID(), lane = tid & 63, w = tid >> 6, c = lane & 31, h = lane >> 5;
    const int bh = item / 48, rem = item % 48, pat = rem >> 4, idx = rem & 15;
    const int dil = pat == 0 ? 1 : (pat == 1 ? 4 : 16), nqt = 16 / dil, res = idx / nqt, qt = idx % nqt;
    const int hd = bh & 7, b = bh >> 3;
    const int q0 = qt * 128 + 32 * w, iq = q0 + c, t = res + iq * dil;
    const bf16_t* qa = (const bf16_t*)(ws + WS_QA) + (size_t)bh * NS * 64;
    const bf16_t* ka = (const bf16_t*)(ws + WS_KA) + (size_t)bh * NS * 64;
    const bf16_t* va = (const bf16_t*)(ws + WS_VA) + (size_t)bh * NS * 64;
    bf16x8 qf[4]; load_qf(qf, qa + (size_t)t * 64, h);
    const float ns2 = -exp2f(-((float)hd + 0.5f)) * (float)dil * LOG2E_F;
    f32x16 o0 = zero16(), o1 = zero16(); float m = -1e30f, l = 0.f;
    {
        const int T0 = qt == 0 ? 2 : 0;
        KVRegs kr; kv_fetch(kr, ka, va, res + (qt * 128 - 128 + 64 * T0) * dil, dil, 0, NS - 1, tid);
        int buf = 0;
        for (int T = T0; T < 4; ++T) {
            const int kb = qt * 128 - 128 + 64 * T;
            LAS unsigned char* Kt = lds + buf * KVT; LAS unsigned char* Vt = lds + 2 * KVT + buf * VT;
            kv_commit(kr, Kt, Vt, tid);
            __syncthreads();
            if (T + 1 < 4) kv_fetch(kr, ka, va, res + (kb + 64) * dil, dil, 0, NS - 1, tid);
            if (kb <= q0 + 31 && kb + 63 >= q0 - 128)
                fa_tile64<1, true>(o0, o1, m, l, qf, Kt, Vt, lane, (float)(iq - kb), 128.f, ns2);
            buf ^= 1;
        }
    }
    const float lt = l + __shfl_xor(l, 32);
    bf16_t* op = (bf16_t*)(pat < 2 ? ws + WS_OPA01 + (size_t)pat * 16 * MiB : ws + WS_OPA2);
    store_ot(op + ((size_t)(b * NS + t) * 512 + hd * 64), o0, o1, 1.0f / lt, h);
    if (h == 0) { float* st = (float*)(ws + WS_STA) + ((size_t)pat * NB * 8 * NS + (size_t)bh * NS + t) * 2; st[0] = m; st[1] = lt; }
}
__device__ __forceinline__ void dil_merge(unsigned char* ws, int gtid, int gthreads) {
    asm volatile("" : "+v"(gtid));
    const float* sta = (const float*)(ws + WS_STA);
    bf16_t* ob = (bf16_t*)(ws + WS_O);
    for (int it = gtid; it < NT * 8 * 8; it += gthreads) {
        const int ch = it & 7, hd = (it >> 3) & 7, tk = it >> 6, b = tk >> 11, t = tk & 2047;
        float mm[3], ll[3];
#pragma unroll
        for (int p = 0; p < 3; ++p) { const float* s = sta + ((size_t)p * NB * 8 * NS + (size_t)(b * 8 + hd) * NS + t) * 2; mm[p] = s[0]; ll[p] = s[1]; }
        const float M = fmaxf(mm[0], fmaxf(mm[1], mm[2]));
        float wgt[3], den = 0.f;
#pragma unroll
        for (int p = 0; p < 3; ++p) { wgt[p] = __builtin_amdgcn_exp2f(mm[p] - M) * ll[p]; den += wgt[p]; }
        const float inv = 1.0f / den;
        float a[8];
#pragma unroll
        for (int i = 0; i < 8; ++i) a[i] = 0.f;
#pragma unroll
        for (int p = 0; p < 3; ++p) {
            const bf16_t* op = (const bf16_t*)(p < 2 ? ws + WS_OPA01 + (size_t)p * 16 * MiB : ws + WS_OPA2);
            const u32x4 v = *(const u32x4*)(op + (size_t)tk * 512 + hd * 64 + ch * 8);
            const float wp = wgt[p] * inv;
            a[0] += wp * bflo(v.x); a[1] += wp * bfhi(v.x); a[2] += wp * bflo(v.y); a[3] += wp * bfhi(v.y);
            a[4] += wp * bflo(v.z); a[5] += wp * bfhi(v.z); a[6] += wp * bflo(v.w); a[7] += wp * bfhi(v.w);
        }
        u32x4 o; o.x = pk2(a[0], a[1]); o.y = pk2(a[2], a[3]); o.z = pk2(a[4], a[5]); o.w = pk2(a[6], a[7]);
        *(u32x4*)(ob + (size_t)tk * ND + hd * 64 + ch * 8) = o;
    }
}

constexpr int LDS_IMP = 4 * KVT;
constexpr int LDS_UNI = LDS_IMP + 4096;
constexpr int LDS_TOT = 41088;
__device__ __forceinline__ void nsa_item(unsigned char* ws, int item, LAS unsigned char* lds) {
    const int tid = TID(), lane = tid & 63, w = tid >> 6, c = lane & 31, h = lane >> 5;
    const int bg = item & 15, tt = item >> 4, b = bg >> 1, g = bg & 1;
    const int t0 = tt * 32, tok8 = c & 7, hh = c >> 3, hb = g * 4 + hh, t = t0 + 8 * w + tok8;
    const bf16_t* qrow = (const bf16_t*)(ws + WS_QB) + ((size_t)(b * 8 + hb) * NS + t) * 64;
    bf16x8 qf[4]; load_qf(qf, qrow, h);
    const float ns2 = -exp2f(-(float)(hb + 1)) * LOG2E_F;
    const float* gt = (const float*)(ws + WS_GATES) + (size_t)(b * NS + t) * 24 + hb * 3;
    const float g0 = gt[0], g1 = gt[1], g2 = gt[2];
    LAS float* totL = (LAS float*)(lds + LDS_TOT) + tid;
    LAS unsigned char* Kt = lds; LAS unsigned char* Vt = lds + 2 * KVT;
    LAS float* impL = (LAS float*)(lds + LDS_IMP) + w * 256;
    LAS unsigned* uni = (LAS unsigned*)(lds + LDS_UNI);
    const int cur = t0 >> 6;
    unsigned selmask;
    {
        const bf16_t* kc = (const bf16_t*)(ws + WS_KCMP) + (size_t)bg * 128 * 64;
        const bf16_t* vc = kc + (size_t)16 * 128 * 64;
        __syncthreads();
        load_kv_tile(Kt, Vt, kc, vc, 0, 1, 0, 127, tid);
        load_kv_tile(Kt + KVT, Vt + VT, kc, vc, 64, 1, 0, 127, tid);
        if (tid == 0) uni[0] = 0u;
        __syncthreads();
        LAS const unsigned char* kp = Kt + c * KVS + 16 * h;
        f32x16 sT[4];
#pragma unroll
        for (int T = 0; T < 4; ++T) sT[T] = qk32(qf, kp + T * 32 * KVS, zero16());
        const float dAh = (float)(t - 31) - (float)(64 * h);
        float tmax = -1e30f;
#pragma unroll
        for (int T = 0; T < 4; ++T)
#pragma unroll
            for (int i = 0; i < 16; ++i) {
                const float d = dAh - (float)(16 * (32 * T + (i & 3) + 8 * (i >> 2)));
                float tv = sT[T][i] + ns2 * d;
                tv = d >= 0.f ? tv : -1e30f;
                sT[T][i] = tv; tmax = fmaxf(tmax, tv);
            }
        tmax = fmaxf(tmax, __shfl_xor(tmax, 32));
        const float mu = fmaxf(tmax, -1e29f);
        float ps = 0.f;
#pragma unroll
        for (int T = 0; T < 4; ++T)
#pragma unroll
            for (int i = 0; i < 16; ++i) { sT[T][i] = __builtin_amdgcn_exp2f(sT[T][i] - mu); ps += sT[T][i]; }
        ps += __shfl_xor(ps, 32);
        const float inv = ps > 0.f ? 1.0f / ps : 0.f;
#pragma unroll
        for (int T = 0; T < 4; ++T)
#pragma unroll
            for (int i = 0; i < 16; ++i) sT[T][i] *= inv;
        f32x16 o0 = zero16(), o1 = zero16();
        const int vq = (lane & 15) >> 2, vc0 = 2 * ((lane >> 4) & 1) + ((lane & 3) >> 1), vsx = 2 * vq;
        LAS const unsigned char* vp0 = Vt + (4 * h + vq) * VS + ((vc0 ^ vsx) * 16) + 8 * (lane & 1);
        LAS const unsigned char* vp1 = Vt + (4 * h + vq) * VS + (((vc0 + 4) ^ vsx) * 16) + 8 * (lane & 1);
#pragma unroll
        for (int T = 0; T < 4; ++T) pv32(o0, o1, sT[T], vp0 + T * 32 * VS, vp1 + T * 32 * VS);
#pragma unroll
        for (int i = 0; i < 16; ++i) { totL[i * 256] = g0 * o0[i]; totL[(16 + i) * 256] = g0 * o1[i]; }
        float mainv[16], spill[16];
#pragma unroll
        for (int T = 0; T < 4; ++T)
#pragma unroll
            for (int u = 0; u < 4; ++u) {
                const float p3 = 0.5f * sT[T][4 * u + 3];
                mainv[4 * T + u] = sT[T][4 * u] + sT[T][4 * u + 1] + sT[T][4 * u + 2] + p3;
                spill[4 * T + u] = p3;
            }
#pragma unroll
        for (int f = 0; f < 16; ++f) {
            mainv[f] += __shfl_xor(mainv[f], 8); mainv[f] += __shfl_xor(mainv[f], 16);
            spill[f] += __shfl_xor(spill[f], 8); spill[f] += __shfl_xor(spill[f], 16);
        }
#pragma unroll
        for (int f = 0; f < 16; ++f) {
            const float snd = h ? (f > 0 ? spill[f > 0 ? f - 1 : 0] : 0.f) : spill[f];
            const float rcv = __shfl_xor(snd, 32);
            mainv[f] += rcv;
        }
        if (hh == 0) {
#pragma unroll
            for (int f = 0; f < 16; ++f) impL[tok8 * 32 + 2 * f + h] = mainv[f];
        }
        asm volatile("s_waitcnt lgkmcnt(0)" ::: "memory");
        {
            const int tk = lane >> 3, tq = t0 + 8 * w + tk, cq = tq >> 6, n0 = 4 * (lane & 7);
            float sc[32];
#pragma unroll
            for (int q4 = 0; q4 < 8; ++q4) {
                const f32x4 v = *(const LAS f32x4*)(impL + tk * 32 + 4 * q4);
                sc[4 * q4] = v.x; sc[4 * q4 + 1] = v.y; sc[4 * q4 + 2] = v.z; sc[4 * q4 + 3] = v.w;
            }
#pragma unroll
            for (int n = 0; n < 32; ++n) {
                const bool valid = n <= cq, forced = (n == 0) || (cq - n < 2);
                sc[n] = valid ? sc[n] + (forced ? 1e4f : 0.f) : -1e30f;
            }
            unsigned bits = 0u;
#pragma unroll
            for (int k = 0; k < 4; ++k) {
                const int n = n0 + k;
                float mine = 0.f;
#pragma unroll
                for (int q = 0; q < 32; ++q) mine = (q == n) ? sc[q] : mine;
                int rank = 0;
#pragma unroll
                for (int q = 0; q < 32; ++q) rank += (sc[q] > mine || (sc[q] == mine && q < n)) ? 1 : 0;
                if (n <= cq && rank < 16) bits |= 1u << n;
            }
            bits |= __shfl_xor(bits, 1); bits |= __shfl_xor(bits, 2); bits |= __shfl_xor(bits, 4);
            selmask = __shfl(bits, tok8 * 8);
        }
        {
            unsigned um = selmask;
#pragma unroll
            for (int o = 1; o < 64; o <<= 1) um |= __shfl_xor(um, o);
            if (lane == 0) atomicOr((unsigned*)uni, um);
        }
        __syncthreads();
    }
    const unsigned ublk = uni[0];
    unsigned wsel = selmask;
#pragma unroll
    for (int o = 1; o < 64; o <<= 1) wsel |= __shfl_xor(wsel, o);
    int buf = 0;
    KVRegs kr;
    {
        const bf16_t* kb = (const bf16_t*)(ws + WS_KV6 + 2 * 4 * MiB) + (size_t)bg * NS * 64;
        const bf16_t* vb = (const bf16_t*)(ws + WS_KV6 + 3 * 4 * MiB) + (size_t)bg * NS * 64;
        f32x16 o0 = zero16(), o1 = zero16(); float m = -1e30f, l = 0.f;
        unsigned rem = ublk & (cur >= 31 ? 0xffffffffu : ((2u << cur) - 1u));
        int n = __builtin_ctz(rem);
        kv_fetch(kr, kb, vb, 64 * n, 1, 0, NS - 1, tid);
        while (rem) {
            rem &= rem - 1u;
            LAS unsigned char* Kc = lds + buf * KVT; LAS unsigned char* Vc = lds + 2 * KVT + buf * VT;
            kv_commit(kr, Kc, Vc, tid);
            __syncthreads();
            const int ncur = n;
            if (rem) { n = __builtin_ctz(rem); kv_fetch(kr, kb, vb, 64 * n, 1, 0, NS - 1, tid); }
            if ((wsel >> ncur) & 1u)
                fa_tile64<1, true>(o0, o1, m, l, qf, Kc, Vc, lane, (float)(t - 64 * ncur), ((selmask >> ncur) & 1u) ? 1e30f : -1.f, ns2);
            buf ^= 1;
        }
        const float lt = l + __shfl_xor(l, 32);
        { const float sc = g1 / lt;
#pragma unroll
          for (int i = 0; i < 16; ++i) { totL[i * 256] += sc * o0[i]; totL[(16 + i) * 256] += sc * o1[i]; } }
    }
    {
        const bf16_t* kb = (const bf16_t*)(ws + WS_KV6 + 4 * 4 * MiB) + (size_t)bg * NS * 64;
        const bf16_t* vb = (const bf16_t*)(ws + WS_KV6 + 5 * 4 * MiB) + (size_t)bg * NS * 64;
        f32x16 o0 = zero16(), o1 = zero16(); float m = -1e30f, l = 0.f;
        const int nlo = t0 >= 511 ? (t0 - 511) >> 6 : 0;
        kv_fetch(kr, kb, vb, 64 * nlo, 1, 0, NS - 1, tid);
        for (int n = nlo; n <= cur; ++n) {
            LAS unsigned char* Kc = lds + buf * KVT; LAS unsigned char* Vc = lds + 2 * KVT + buf * VT;
            kv_commit(kr, Kc, Vc, tid);
            __syncthreads();
            if (n < cur) kv_fetch(kr, kb, vb, 64 * (n + 1), 1, 0, NS - 1, tid);
            fa_tile64<1, true>(o0, o1, m, l, qf, Kc, Vc, lane, (float)(t - 64 * n), 511.f, ns2);
            buf ^= 1;
        }
        const float lt = l + __shfl_xor(l, 32);
        { const float sc = g2 / lt;
#pragma unroll
          for (int i = 0; i < 16; ++i) { o0[i] = totL[i * 256] + sc * o0[i]; o1[i] = totL[(16 + i) * 256] + sc * o1[i]; } }
        store_ot((bf16_t*)(ws + WS_O) + ((size_t)(b * NS + t) * ND + 512 + hb * 64), o0, o1, 1.0f, h);
    }
}

#define XB_TMO      128
#define XB_XCNT(j)  (256  + 64 * (j))
#define XB_XSUB(j)  (1280 + 64 * (j))
#define XB_XGEN(j)  (2304 + 64 * (j))
#define XB_TOP      3328
#define XB_TOPGEN   3392
#define XCD_BAR_WORDS 3456
#define XB_SPIN_CAP (1u << 18)
__device__ __forceinline__ unsigned xb_ld(unsigned* p)              { return __hip_atomic_load(p, __ATOMIC_RELAXED, __HIP_MEMORY_SCOPE_AGENT); }
__device__ __forceinline__ unsigned xb_add(unsigned* p, unsigned v) { return __hip_atomic_fetch_add(p, v, __ATOMIC_RELAXED, __HIP_MEMORY_SCOPE_AGENT); }
__device__ __forceinline__ unsigned xb_xcc_id() { return (unsigned)__builtin_amdgcn_s_getreg((3 << 11) | 20) & 0xFu; }
#define XB_SPIN(cond, bar) do { unsigned _sp = 0; while (cond) { __builtin_amdgcn_s_sleep(1); \
    if ((++_sp & 255u) == 0u) { if (xb_ld(&(bar)[XB_TMO])) break; if (_sp > XB_SPIN_CAP) { atomicAdd(&(bar)[XB_TMO], 1u); break; } } } } while (0)
struct XcdBarrier { unsigned* bar; unsigned x; volatile LAS unsigned* st; };
__device__ __forceinline__ XcdBarrier xcd_barrier_post(unsigned* bar, volatile LAS unsigned* st) {
    XcdBarrier b; b.bar = bar; b.x = xb_xcc_id(); b.st = st;
    if (threadIdx.x == 0) (void)xb_add(&bar[XB_XCNT(b.x)], 1u);
    return b;
}
__device__ __forceinline__ void xcd_barrier_complete(unsigned* bar, unsigned x, unsigned& nloc, unsigned& nx) {
    const unsigned G = gridDim.x * gridDim.y * gridDim.z;
    unsigned sum, cnt, mine, sp = 0u;
    for (;;) {
        sum = 0u; cnt = 0u; mine = 0u;
#pragma unroll
        for (unsigned j = 0; j < 16; ++j) { const unsigned c = xb_ld(&bar[XB_XCNT(j)]); sum += c; cnt += (c > 0u) ? 1u : 0u; mine = (j == x) ? c : mine; }
        if (sum == G) break;
        __builtin_amdgcn_s_sleep(1);
        if ((++sp & 255u) == 0u) { if (xb_ld(&bar[XB_TMO])) break; if (sp > XB_SPIN_CAP) { atomicAdd(&bar[XB_TMO], 1u); break; } }
    }
    nloc = mine > 0u ? mine : 1u; nx = cnt > 0u ? cnt : 1u;
}
__device__ __forceinline__ void xcd_barrier(const XcdBarrier& b) {
    asm volatile("s_waitcnt vmcnt(0)" ::: "memory");
    __syncthreads();
    if (threadIdx.x == 0) {
        unsigned* bar = b.bar;
        __builtin_amdgcn_s_waitcnt(0);
        unsigned nloc = b.st[0], nx = b.st[1];
        if (nloc == 0u) { xcd_barrier_complete(bar, b.x, nloc, nx); b.st[0] = nloc; b.st[1] = nx; }
        const unsigned old = xb_add(&bar[XB_XSUB(b.x)], 1u);
        const unsigned gen = old / nloc;
        if (old + 1u == (gen + 1u) * nloc) {
            __builtin_amdgcn_fence(__ATOMIC_RELEASE, "agent");
            asm volatile("s_waitcnt vmcnt(0)" ::: "memory");
            const unsigned og = xb_add(&bar[XB_TOP], 1u);
            const unsigned tg = og / nx;
            if (og + 1u == (tg + 1u) * nx) xb_add(&bar[XB_TOPGEN], 1u);
            else XB_SPIN(xb_ld(&bar[XB_TOPGEN]) == tg, bar);
            __builtin_amdgcn_fence(__ATOMIC_ACQUIRE, "agent");
            xb_add(&bar[XB_XGEN(b.x)], 1u);
            asm volatile("s_waitcnt vmcnt(0)" ::: "memory");
        } else {
            XB_SPIN(xb_ld(&bar[XB_XGEN(b.x)]) == gen, bar);
            __builtin_amdgcn_fence(__ATOMIC_ACQUIRE, "agent");
            asm volatile("s_waitcnt vmcnt(0)" ::: "memory");
        }
    }
    __syncthreads();
}

struct XcdTiles {
    int m_lo, cnt_m, nN, loc, nloc, tiles;
    __device__ __forceinline__ XcdTiles(int nM, int nN_) {
        const int b = BID(), g = gridDim.x;
        int x, nx;
        if ((g & 7) == 0) { x = b & 7; nx = 8; loc = b >> 3; nloc = g >> 3; } else { x = 0; nx = 1; loc = b; nloc = g; }
        m_lo = (int)((long)nM * x / nx); cnt_m = (int)((long)nM * (x + 1) / nx) - m_lo; nN = nN_; tiles = cnt_m * nN;
    }
    __device__ __forceinline__ void get(int q, int& mt, int& nt) const {
        const int mg = q / (8 * nN), rem_m = cnt_m - 8 * mg, mig = rem_m < 8 ? rem_m : 8, r = q - mg * 8 * nN;
        nt = r / mig; mt = m_lo + 8 * mg + (r - nt * mig);
    }
};
struct PhInProj { const bf16_t* xn; const unsigned char* wl; unsigned char* ws; const float* ssp; XcdTiles xt;
    __device__ __forceinline__ void make(int q, APlain& ap, BPlain& bp, EpiInProj& ep) const { int mt, nt; xt.get(q, mt, nt);
        ap = APlain{xn + (size_t)mt * 128 * ND, ND}; bp = BPlain{(const bf16_t*)(wl + WL_IN) + (size_t)nt * 128 * ND, ND}; ep = EpiInProj{mt, nt, ws, ssp}; } };
struct PhCmp1 { const unsigned char* wl; unsigned char* ws; int l;
    __device__ __forceinline__ void make(int tile, ACmp& ap, BPlain& bp, EpiCmp1& ep) const { const int nt = tile & 1, bg = (tile >> 1) & 15, kv = tile >> 5;
        ap = ACmp{(const bf16_t*)(ws + WS_KV6 + (size_t)kv * 4 * MiB) + (size_t)bg * NS * 64};
        bp = BPlain{(const bf16_t*)(wl + WL_C1) + (size_t)kv * 256 * 2048 + (size_t)nt * 128 * 2048, 2048};
        ep = EpiCmp1{(bf16_t*)(ws + WS_HC) + (size_t)kv * 2048 * 256, (const float*)(ws + WS_BC1P) + l * 512 + kv * 256, bg * 128, nt * 128}; } };
struct PhCmp2 { const unsigned char* wl; unsigned char* ws;
    __device__ __forceinline__ void make(int tile, APlain& ap, BPlain& bp, EpiCmp2& ep) const { const int bg = tile & 15, kv = tile >> 4;
        ap = APlain{(const bf16_t*)(ws + WS_HC) + (size_t)kv * 2048 * 256 + (size_t)bg * 128 * 256, 256};
        bp = BPlain{(const bf16_t*)(wl + WL_C2) + (size_t)kv * 128 * 256, 256};
        ep = EpiCmp2{(bf16_t*)(ws + WS_KCMP) + (size_t)kv * 16 * 128 * 64, bg * 128}; } };
struct PhOutProj { const unsigned char* wl; unsigned char* ws; bf16_t* res; XcdTiles xt;
    __device__ __forceinline__ void make(int q, APlain& ap, BPlain& bp, EpiResAdd& ep) const { int mt, nt; xt.get(q, mt, nt);
        ap = APlain{(const bf16_t*)(ws + WS_O) + (size_t)mt * 128 * ND, ND}; bp = BPlain{(const bf16_t*)(wl + WL_OUT) + (size_t)nt * 128 * ND, ND};
        ep = EpiResAdd{res, mt * 128, nt * 128}; } };
struct PhMoe {
    LAS const int* sm; const int* list;
    __device__ __forceinline__ void decode(int gmt, int& bk, int& mt, int& rem, int& hrow0, int& elo, int& ehi) const {
        bk = 0;
        for (int k = 1; k < 24; ++k) if (gmt >= sm[32 + k]) bk = k;
        mt = gmt - sm[32 + bk]; rem = sm[bk] - mt * 128; hrow0 = sm[64 + bk] + mt * 128;
        const int grp = bk / 6, pi = bk % 6;
        elo = grp * 4 + (pi < 3 ? 0 : (pi < 5 ? 1 : 2)); ehi = grp * 4 + (pi < 3 ? pi + 1 : (pi < 5 ? pi - 1 : 3));
    } };
struct PhMoeGU { PhMoe m; const bf16_t* xn; const unsigned char* wl; unsigned char* ws; const float* route; const float* rinv; XcdTiles xt;
    __device__ __forceinline__ void make(int q, AGather& ap, BPlain& bp, EpiMoeGU& ep) const { int gmt, nt16; xt.get(q, gmt, nt16);
        int bk, mt, rem, hrow0, elo, ehi; m.decode(gmt, bk, mt, rem, hrow0, elo, ehi);
        const int* lst = m.list + (size_t)bk * NT + mt * 128; const int e = (nt16 >> 3) ? ehi : elo;
        ap = AGather{xn, lst, rem}; bp = BPlain{(const bf16_t*)(wl + WL_GU) + (size_t)e * 1024 * 1024 + (size_t)(nt16 & 7) * 128 * 1024, 1024};
        ep = EpiMoeGU{(bf16_t*)(ws + WS_HID), lst, route, rinv, rem, hrow0, nt16}; } };
struct PhMoeDown { PhMoe m; const unsigned char* wl; unsigned char* ws; bf16_t* res; float* ssp; XcdTiles xt;
    __device__ __forceinline__ void make(int q, APlain& ap, BSplit& bp, EpiMoeDown& ep) const { int gmt, nt; xt.get(q, gmt, nt);
        int bk, mt, rem, hrow0, elo, ehi; m.decode(gmt, bk, mt, rem, hrow0, elo, ehi);
        const int* lst = m.list + (size_t)bk * NT + mt * 128;
        ap = APlain{(const bf16_t*)(ws + WS_HID) + (size_t)hrow0 * 1024, 1024};
        bp = BSplit{(const bf16_t*)(wl + WL_DN) + (size_t)elo * 1024 * 512 + (size_t)nt * 128 * 512, (const bf16_t*)(wl + WL_DN) + (size_t)ehi * 1024 * 512 + (size_t)nt * 128 * 512};
        ep = EpiMoeDown{res, lst, ssp, rem, nt * 128}; } };
struct PhPleProj { const unsigned char* wl; unsigned char* ws; XcdTiles xt;
    __device__ __forceinline__ void make(int q, APlain& ap, BPlain& bp, EpiBf16& ep) const { int mt, nt; xt.get(q, mt, nt);
        ap = APlain{(const bf16_t*)(ws + WS_PB) + (size_t)mt * 128 * 256, 256}; bp = BPlain{(const bf16_t*)(wl + WL_PP) + (size_t)nt * 128 * 256, 256};
        ep = EpiBf16{(bf16_t*)(ws + WS_P2), ND, mt * 128, nt * 128}; } };
struct PhPleGate { const bf16_t* xn; const unsigned char* wl; unsigned char* ws; float* out; float sc; XcdTiles xt;
    __device__ __forceinline__ void make(int q, APlain& ap, BPlain& bp, EpiPleGate& ep) const { int mt, nt; xt.get(q, mt, nt);
        ap = APlain{xn + (size_t)mt * 128 * ND, ND}; bp = BPlain{(const bf16_t*)(wl + WL_PG) + (size_t)nt * 128 * ND, ND};
        ep = EpiPleGate{out, (const bf16_t*)(ws + WS_P2), mt * 128, nt * 128, sc}; } };

constexpr int LDS_QSLOT = 73856 + 16 + 448;
__device__ __forceinline__ int wq_next(int* head, LAS unsigned char* lds) {
    LAS int* slot = (LAS int*)(lds + LDS_QSLOT);
    __syncthreads();
    if (threadIdx.x == 0) *slot = atomicAdd(head, 1);
    __syncthreads();
    return *slot;
}
__device__ __forceinline__ void ple_stream(const bf16_t* xn, const bf16_t* pb, const unsigned char* wl, const float* ssp_in, bf16_t* rout, float* ssp_out, LAS unsigned char* lds) {
    const XcdTiles xt(128, 8);
    int q = xt.loc;
    if (q >= xt.tiles) return;
    const int tid = TID(), wid = tid >> 6, lane = tid & 63, wr = wid >> 1, wc = wid & 1, fr = lane & 15, fq = lane >> 4;
    int mt, nt; xt.get(q, mt, nt);
    bool pref = false;
    for (;;) {
        const int qn = q + xt.nloc; const bool hn = qn < xt.tiles;
        int mtn = mt, ntn = nt; if (hn) xt.get(qn, mtn, ntn);
        const APlain ap1{pb + (size_t)mt * 128 * 256, 256}; const BPlain bp1{(const bf16_t*)(wl + WL_PP) + (size_t)nt * 128 * 256, 256};
        const APlain ap2{xn + (size_t)mt * 128 * ND, ND};   const BPlain bp2{(const bf16_t*)(wl + WL_PG) + (size_t)nt * 128 * ND, ND};
        const APlain apn{pb + (size_t)mtn * 128 * 256, 256}; const BPlain bpn{(const bf16_t*)(wl + WL_PP) + (size_t)ntn * 128 * 256, 256};
        f32x4 acc[4][4], acc2[4][4]; zero_acc(acc); zero_acc(acc2);
        gemm_kloop(acc2, ap1, bp1, 256, lds, pref, true, ap2, bp2);
        gemm_kloop(acc, ap2, bp2, ND, lds, true, hn, apn, bpn);
        const EpiPleFused ep{xn, ssp_in, rout, ssp_out, mt * 128, nt * 128};
        ep(acc, acc2, wr, wc, fr, fq);
        if (!hn) break;
        q = qn; mt = mtn; nt = ntn; pref = true;
    }
}

constexpr int LDS_BAR = 73856;
constexpr int LDS_SM = LDS_BAR + 16;
constexpr int LDS_BYTES = LDS_SM + 512;
static_assert(LDS_QSLOT == LDS_SM + 448, "queue slot");
static_assert(4 * KVT + 4096 + 64 <= LDS_TOT && LDS_TOT + 32768 <= LDS_BAR && 65536 <= LDS_BAR, "LDS map");

__global__ void __launch_bounds__(256, 2) mega_fwd(Params p) {
    extern __shared__ __attribute__((aligned(16))) unsigned char lds_raw[];
    LAS unsigned char* lds = (LAS unsigned char*)lds_raw;
    unsigned char* ws = p.ws;
    const int tid = threadIdx.x;
    const int gtid = blockIdx.x * 256 + tid, gthreads = gridDim.x * 256;
    int* ctl = (int*)(ws + WS_CTL);
    {
        volatile LAS unsigned* st = (volatile LAS unsigned*)(lds + LDS_BAR);
        if (tid < 4) st[tid] = 0u;
        __syncthreads();
    }
    const XcdBarrier gbar = xcd_barrier_post((unsigned*)ctl + CW_BAR, (volatile LAS unsigned*)(lds + LDS_BAR));

    phase_convert(p, (LAS float*)lds);
    xcd_barrier(gbar);

    float* sspA = (float*)(ws + WS_SSP);
    float* sspB = sspA + (size_t)NT * 16;
    float* rinv = (float*)(ws + WS_RINV);
    for (int l = 0; l < 2; ++l) {
        const unsigned char* wl = ws + WS_W + (size_t)l * WL_SIZE;
        bf16_t* xn = (bf16_t*)p.out + (size_t)(l & 1) * NT * ND;
        bf16_t* rnext = l == 1 ? (bf16_t*)(ws + WS_XN) : (bf16_t*)p.out + (size_t)((l + 1) & 1) * NT * ND;
        const bf16_t* xb_in = xn;
        {
            const PhInProj ph{xb_in, wl, ws, sspB, XcdTiles(128, 23)};
            gemm_stream<PhInProj, APlain, BPlain, EpiInProj>(ph, ph.xt.loc, ph.xt.nloc, ph.xt.tiles, ND, lds);
        }
        xcd_barrier(gbar);
        {
            int* qh = ctl + CW_Q + l * 4 + 0;
            int* ch = ctl + CW_Q + l * 4 + 2;
            const int nconv = conv_queue_strips(2 * l);
            const PhCmp1 ph{wl, ws, l};
            bool conv_left = nconv > 0, att_left = true;
            for (int k = 0; conv_left || att_left; ++k) {
                const bool want_conv = conv_left && (!att_left || (k % 7) == 6);
                if (want_conv) {
                    const int c = wq_next(ch, lds);
                    if (c < nconv) conv_strip(p, 2 * l, c, (LAS float*)lds); else conv_left = false;
                } else {
                    const int it = wq_next(qh, lds);
                    if (it >= 64 + 1536) att_left = false;
                    else if (it < 64) { ACmp ap; BPlain bp; EpiCmp1 ep; ph.make(it, ap, bp, ep); gemm_tile(ap, bp, 2048, ep, lds, false, false, ap, bp); }
                    else { dil_item(ws, 2 * (it - 64), lds); __syncthreads(); dil_item(ws, 2 * (it - 64) + 1, lds); }
                }
            }
        }
        xcd_barrier(gbar);
        { const PhCmp2 ph{wl, ws}; gemm_stream<PhCmp2, APlain, BPlain, EpiCmp2>(ph, BID(), gridDim.x, 32, 256, lds); }
        dil_merge(ws, gtid, gthreads);
        if (l == 0) convert_p(p);
        xcd_barrier(gbar);
        {
            int* qh = ctl + CW_Q + l * 4 + 1;
            int* ch = ctl + CW_Q + l * 4 + 3;
            const int nconv = conv_queue_strips(2 * l + 1);
            bool conv_left = nconv > 0, att_left = true;
            for (int k = 0; conv_left || att_left; ++k) {
                const bool want_conv = conv_left && (!att_left || (k % 4) == 3);
                if (want_conv) {
                    const int c = wq_next(ch, lds);
                    if (c < nconv) conv_strip(p, 2 * l + 1, c, (LAS float*)lds); else conv_left = false;
                } else {
                    const int it = wq_next(qh, lds);
                    if (it >= 1024) att_left = false;
                    else nsa_item(ws, ((63 - (it >> 4)) << 4) | (it & 15), lds);
                }
            }
        }
        xcd_barrier(gbar);
        { const PhOutProj ph{wl, ws, xn, XcdTiles(128, 8)};
          gemm_stream<PhOutProj, APlain, BPlain, EpiResAdd>(ph, ph.xt.loc, ph.xt.nloc, ph.xt.tiles, ND, lds); }
        xcd_barrier(gbar);
        int* cnt = ctl + CW_CNTP + l * 1536;
        int* list = (int*)(ws + WS_LIST);
        float* route = (float*)(ws + WS_ROUTE);
        phase_route(xn, (const float*)(wl + WL_RT), p.in[12] + l * 4, p.in[14] + l * 16, cnt, list, route, rinv, lds);
        xcd_barrier(gbar);
        LAS int* sm = (LAS int*)(lds + LDS_SM);
        __syncthreads();
        if (tid < 24) sm[tid] = __hip_atomic_load(cnt + 64 * tid, __ATOMIC_RELAXED, __HIP_MEMORY_SCOPE_AGENT);
        __syncthreads();
        if (tid == 0) {
            int tp = 0, hb = 0;
            for (int k = 0; k < 24; ++k) {
                const int c = sm[k];
                sm[32 + k] = tp; sm[64 + k] = hb;
                const int nt_ = (c + 127) >> 7; tp += nt_; hb += nt_ * 128;
            }
            sm[32 + 24] = tp;
        }
        __syncthreads();
        const int total_mt = sm[32 + 24];
        { const PhMoeGU ph{PhMoe{sm, list}, xn, wl, ws, route, rinv, XcdTiles(total_mt, 16)};
          gemm_stream<PhMoeGU, AGather, BPlain, EpiMoeGU>(ph, ph.xt.loc, ph.xt.nloc, ph.xt.tiles, ND, lds); }
        xcd_barrier(gbar);
        { const PhMoeDown ph{PhMoe{sm, list}, wl, ws, xn, sspA, XcdTiles(total_mt, 8)};
          gemm_stream<PhMoeDown, APlain, BSplit, EpiMoeDown>(ph, ph.xt.loc, ph.xt.nloc, ph.xt.tiles, ND, lds); }
        xcd_barrier(gbar);
        ple_stream(xn, (const bf16_t*)(ws + WS_PBALL) + (size_t)l * NT * 256, wl, sspA, rnext, sspB, lds);
        xcd_barrier(gbar);
    }
    phase_final_norm((const bf16_t*)(ws + WS_XN), p.out, p.in[21]);
}

extern "C" void kernel_launch(void* const* d_in, const int* in_sizes, int n_in, void* d_out, int out_size, void* d_ws, size_t ws_size, hipStream_t stream) {
    static int grid = 0;
    if (grid == 0) {
        if (n_in != 22 || out_size != NT * ND || ws_size < WS_END) { fprintf(stderr, "kernel_launch: unexpected shapes (n_in %d out %d ws %zu)\n", n_in, out_size, ws_size); grid = -1; return; }
        int dev = 0, cus = 0, per_cu = 0;
        hipGetDevice(&dev);
        hipDeviceGetAttribute(&cus, hipDeviceAttributeMultiprocessorCount, dev);
        if (hipFuncSetAttribute((const void*)mega_fwd, hipFuncAttributeMaxDynamicSharedMemorySize, LDS_BYTES) != hipSuccess) { fprintf(stderr, "kernel_launch: hipFuncSetAttribute failed\n"); grid = -1; return; }
        hipOccupancyMaxActiveBlocksPerMultiprocessor(&per_cu, (const void*)mega_fwd, 256, LDS_BYTES);
        if (per_cu < 1) { fprintf(stderr, "kernel_launch: occupancy query says %d\n", per_cu); grid = -1; return; }
        if (per_cu > 2) per_cu = 2;
        grid = cus * per_cu;
    }
    if (grid < 0) return;
    hipMemsetAsync((char*)d_ws + WS_CTL, 0, 32768, stream);
    Params p{};
    for (int i = 0; i < 22; ++i) p.in[i] = (const float*)d_in[i];
    p.out = (float*)d_out; p.ws = (unsigned char*)d_ws;
    hipLaunchKernelGGL(mega_fwd, dim3(grid), dim3(256), LDS_BYTES, stream, p);
    const hipError_t e = hipPeekAtLastError();
    if (e != hipSuccess) fprintf(stderr, "launch failed: %s (grid %d)\n", hipGetErrorString(e), grid);
}
```

```cpp
#include <hip/hip_runtime.h>
#include <cstdio>
#include <cstdint>

#ifndef NAIVE_GEMM
#define NAIVE_GEMM 0
#endif
#ifndef NAIVE_ATTN
#define NAIVE_ATTN 0
#endif
#define REP_CONV 1
#define REP_INPROJ 1
#define REP_ATTN 1
#define REP_GU 1
#define REP_NORM 1
#define REP_ROUTE 1
#define REP_DOWN 1
#define REP_OUTPROJ 1
#define REP_PG 1
#define REP_CMP 1
#define REP_MISC 1

#define LAS __attribute__((address_space(3)))
typedef unsigned short bf16_t;
typedef short bf16x8 __attribute__((ext_vector_type(8)));
typedef float f32x4 __attribute__((ext_vector_type(4)));
typedef unsigned u32x4 __attribute__((ext_vector_type(4)));
typedef unsigned u32x2 __attribute__((ext_vector_type(2)));
typedef float f32x16 __attribute__((ext_vector_type(16)));
typedef short s16x4 __attribute__((ext_vector_type(4)));
typedef float f32x2_t __attribute__((ext_vector_type(2)));
typedef __bf16 bf16x2_t __attribute__((ext_vector_type(2)));

constexpr int NB = 8, NS = 2048, ND = 1024, NT = NB * NS;
constexpr int NIN = 2840, NINP = 2944;
constexpr size_t MiB = (size_t)1 << 20;
constexpr size_t WL_IN = 0;
constexpr size_t WL_OUT = WL_IN + (size_t)NINP * 1024 * 2;
constexpr size_t WL_C1 = WL_OUT + (size_t)1024 * 1024 * 2;
constexpr size_t WL_C2 = WL_C1 + (size_t)2 * 256 * 2048 * 2;
constexpr size_t WL_GU = WL_C2 + (size_t)2 * 128 * 256 * 2;
constexpr size_t WL_DN = WL_GU + (size_t)16 * 1024 * 1024 * 2;
constexpr size_t WL_PG = WL_DN + (size_t)16 * 1024 * 512 * 2;
constexpr size_t WL_PP = WL_PG + (size_t)1024 * 1024 * 2;
constexpr size_t WL_BC1 = WL_PP + (size_t)1024 * 256 * 2;
constexpr size_t WL_RT = WL_BC1 + 2048;
constexpr size_t WL_SIZE = 64 * MiB;
static_assert(WL_RT + 131072 <= WL_SIZE, "weight block");
constexpr size_t WS_CTL = 0;
constexpr size_t WS_W = 1 * MiB;
constexpr size_t WS_XN = WS_W + 2 * WL_SIZE;
constexpr size_t WS_PROJ = WS_XN + 32 * MiB;
constexpr size_t WS_QA = WS_PROJ, WS_KA = WS_QA + 16 * MiB, WS_VA = WS_KA + 16 * MiB, WS_QB = WS_VA + 16 * MiB;
constexpr size_t WS_KV6 = WS_QB + 16 * MiB;
constexpr size_t WS_GATES = WS_KV6 + 24 * MiB;
constexpr size_t WS_PROJ_END = WS_GATES + 2 * MiB;
constexpr size_t WS_HID = WS_PROJ;
constexpr size_t WS_P2 = WS_PROJ + 40 * MiB;
constexpr size_t WS_PB = WS_PROJ + 72 * MiB;
constexpr size_t WS_HC = WS_PROJ_END;
constexpr size_t WS_KCMP = WS_HC + 2 * MiB;
constexpr size_t WS_MASK = WS_KCMP + 512 * 1024;
constexpr size_t WS_ROUTE = WS_MASK + 128 * 1024;
constexpr size_t WS_LIST = WS_ROUTE + 128 * 1024;
constexpr size_t WS_O = WS_LIST + 1536 * 1024 + 256 * 1024;
constexpr size_t WS_IMPH = WS_O + 32 * MiB;
constexpr size_t WS_OPA01 = WS_XN;
constexpr size_t WS_OPA2 = WS_IMPH;
constexpr size_t WS_STA = WS_IMPH + 16 * MiB;
constexpr size_t WS_PBALL = WS_IMPH + 20 * MiB;
constexpr size_t WS_SSP = WS_PBALL + 16 * MiB;
constexpr size_t WS_RINV = WS_MASK;
constexpr size_t WS_BC1P = WS_SSP + 2 * MiB;
constexpr size_t WS_END = WS_BC1P + 64 * 1024;
static_assert(WS_PB + 8 * MiB <= WS_PROJ_END, "alias map");
static_assert(WS_END <= 330 * MiB, "workspace");
constexpr int HID_ROWS = NT + 24 * 128;
constexpr int CW_BAR = 1024;
constexpr int CW_Q = 256;
constexpr int CW_CNTP = 4608;
constexpr int CW_CNT = 64;

struct Params {
    const float* in[22];
    float* out;
    unsigned char* ws;
};

__device__ __forceinline__ unsigned f2bf(float f) { unsigned u = __float_as_uint(f); return (u + 0x7fffu + ((u >> 16) & 1u)) >> 16; }
__device__ __forceinline__ unsigned pk2(float lo, float hi) { return f2bf(lo) | (f2bf(hi) << 16); }
__device__ __forceinline__ float bflo(unsigned v) { return __uint_as_float(v << 16); }
__device__ __forceinline__ float bfhi(unsigned v) { return __uint_as_float(v & 0xffff0000u); }
__device__ __forceinline__ float wave_sum(float v) {
#pragma unroll
    for (int o = 1; o < 64; o <<= 1) v += __shfl_xor(v, o);
    return v;
}
__device__ __forceinline__ int TID() { int t = threadIdx.x; asm volatile("" : "+v"(t)); return t; }
__device__ __forceinline__ int BID() { int t = blockIdx.x; asm volatile("" : "+s"(t)); return t; }
__device__ __forceinline__ float sigmoidf_(float x) { return 1.0f / (1.0f + __expf(-x)); }
__device__ __forceinline__ float gelu_tanh(float x) {
    const float u = 0.7978845608028654f * (x + 0.044715f * x * x * x);
    const float e = __expf(2.0f * u);
    const float th = 1.0f - 2.0f / (e + 1.0f);
    return 0.5f * x * (1.0f + th);
}

struct ConvJob { const float* src; bf16_t* dst; const float* gain; int K, N, NP, map, per; size_t dst_bstride; };
__device__ __forceinline__ int conv_job_tiles(int j) { return j == 0 ? 736 : (j == 1 || j == 9) ? 256 : (j == 2 || j == 3) ? 128 : (j == 4 || j == 5) ? 8 : j == 10 ? 64 : 2048; }
__device__ __forceinline__ ConvJob conv_job(const Params& p, int l, int j) {
    unsigned char* wl = p.ws + WS_W + (size_t)l * WL_SIZE;
    ConvJob c; c.map = 0; c.dst_bstride = 0; c.gain = nullptr;
    switch (j) {
    case 0: c.src = p.in[3] + (size_t)l * 1024 * NIN; c.K = 1024; c.N = NIN; c.NP = NINP; c.dst = (bf16_t*)(wl + WL_IN); c.gain = p.in[2] + l * ND; break;
    case 1: c.src = p.in[4] + (size_t)l * 1024 * 1024; c.K = 1024; c.N = 1024; c.NP = 1024; c.dst = (bf16_t*)(wl + WL_OUT); break;
    case 2: c.src = p.in[5] + (size_t)l * 2048 * 256; c.K = 2048; c.N = 256; c.NP = 256; c.dst = (bf16_t*)(wl + WL_C1); break;
    case 3: c.src = p.in[7] + (size_t)l * 2048 * 256; c.K = 2048; c.N = 256; c.NP = 256; c.dst = (bf16_t*)(wl + WL_C1) + (size_t)256 * 2048; break;
    case 4: c.src = p.in[6] + (size_t)l * 256 * 64; c.K = 256; c.N = 64; c.NP = 128; c.dst = (bf16_t*)(wl + WL_C2); break;
    case 5: c.src = p.in[8] + (size_t)l * 256 * 64; c.K = 256; c.N = 64; c.NP = 128; c.dst = (bf16_t*)(wl + WL_C2) + (size_t)128 * 256; break;
    case 6: c.src = p.in[15] + (size_t)l * 16 * 1024 * 512; c.K = 1024; c.N = 512; c.NP = 512; c.dst = (bf16_t*)(wl + WL_GU); c.map = 1; c.dst_bstride = (size_t)1024 * 1024; c.gain = p.in[10] + l * ND; break;
    case 7: c.src = p.in[16] + (size_t)l * 16 * 1024 * 512; c.K = 1024; c.N = 512; c.NP = 512; c.dst = (bf16_t*)(wl + WL_GU); c.map = 2; c.dst_bstride = (size_t)1024 * 1024; c.gain = p.in[10] + l * ND; break;
    case 8: c.src = p.in[17] + (size_t)l * 16 * 512 * 1024; c.K = 512; c.N = 1024; c.NP = 1024; c.dst = (bf16_t*)(wl + WL_DN); c.dst_bstride = (size_t)1024 * 512; break;
    case 9: c.src = p.in[19] + (size_t)l * 1024 * 1024; c.K = 1024; c.N = 1024; c.NP = 1024; c.dst = (bf16_t*)(wl + WL_PG); c.gain = p.in[18] + l * ND; break;
    default: c.src = p.in[20] + (size_t)l * 256 * 1024; c.K = 256; c.N = 1024; c.NP = 1024; c.dst = (bf16_t*)(wl + WL_PP); break;
    }
    c.per = (c.K / 64) * (c.NP / 64);
    return c;
}
__device__ __forceinline__ void convert_tiles(const ConvJob& c, int t0, int t1, LAS float* tl) {
    const int tid = TID();
    const int ntiles = c.NP / 64;
    const int kr = tid >> 4, c4 = (tid & 15) * 4;
    f32x4 v[4]; float gv[4];
#define CT_LOAD(it_) do { const int _bi = (it_) / c.per, _r = (it_) - _bi * c.per, _kt = _r / ntiles, _nt = _r - _kt * ntiles; \
        const int _n = _nt * 64 + c4; const bool _ok = _n < c.N; \
        const float* _sp = c.src + (size_t)_bi * c.K * c.N + (size_t)(_kt * 64 + kr) * c.N + (_ok ? _n : 0); \
        _Pragma("unroll") for (int _i = 0; _i < 4; ++_i) v[_i] = *(const f32x4*)(_sp + (size_t)(16 * _i) * c.N); \
        if (c.gain) { _Pragma("unroll") for (int _i = 0; _i < 4; ++_i) gv[_i] = c.gain[_kt * 64 + kr + 16 * _i]; } \
        else { _Pragma("unroll") for (int _i = 0; _i < 4; ++_i) gv[_i] = 1.0f; } \
        if (!_ok) { _Pragma("unroll") for (int _i = 0; _i < 4; ++_i) gv[_i] = 0.f; } } while (0)
    CT_LOAD(t0);
    for (int it = t0; it < t1; ++it) {
        const int bi = it / c.per, r = it - bi * c.per, kt = r / ntiles, nt = r - kt * ntiles;
        bf16_t* d = c.dst + (size_t)bi * c.dst_bstride;
        const int k0 = kt * 64, n0 = nt * 64;
        __syncthreads();
#pragma unroll
        for (int i = 0; i < 4; ++i) {
            LAS float* tp = tl + (kr + 16 * i) * 65 + c4;
            tp[0] = v[i].x * gv[i]; tp[1] = v[i].y * gv[i]; tp[2] = v[i].z * gv[i]; tp[3] = v[i].w * gv[i];
        }
        if (it + 1 < t1) CT_LOAD(it + 1);
        __syncthreads();
        const int n = tid >> 2, kc = (tid & 3) * 16;
        const int nsrc = n0 + n;
        const int row = (c.map == 0) ? nsrc : ((nsrc >> 4) * 32 + (nsrc & 15) + (c.map == 2 ? 16 : 0));
        float w[16];
#pragma unroll
        for (int j = 0; j < 16; ++j) w[j] = tl[(kc + j) * 65 + n];
        u32x4 o0, o1;
        o0.x = pk2(w[0], w[1]); o0.y = pk2(w[2], w[3]); o0.z = pk2(w[4], w[5]); o0.w = pk2(w[6], w[7]);
        o1.x = pk2(w[8], w[9]); o1.y = pk2(w[10], w[11]); o1.z = pk2(w[12], w[13]); o1.w = pk2(w[14], w[15]);
        bf16_t* dp = d + (size_t)row * c.K + k0 + kc;
        *(u32x4*)dp = o0; *(u32x4*)(dp + 8) = o1;
    }
#undef CT_LOAD
}
__device__ __forceinline__ int conv_list(int q, int i) {
    if (q == 0) return i == 0 ? 6 : (i == 1 ? 7 : -1);
    if (q == 1) return i == 0 ? 8 : i == 1 ? 9 : i == 2 ? 10 : i == 3 ? 16 : i == 4 ? 18 : i == 5 ? 19 : i == 6 ? 20 : i == 7 ? 21 : -1;
    if (q == 2) return i == 0 ? 17 : i == 1 ? 22 : i == 2 ? 23 : -1;
    return i == 0 ? 24 : i == 1 ? 25 : i == 2 ? 26 : -1;
}
__device__ __forceinline__ int conv_queue_strips(int q) {
    int n = 0;
    for (int i = 0; i < 8; ++i) { const int e = conv_list(q, i); if (e < 0) break; n += conv_job_tiles(e & 15) >> 3; }
    return n;
}
__device__ __forceinline__ void conv_strip(const Params& p, int q, int c, LAS float* tl) {
    for (int i = 0; i < 8; ++i) {
        const int e = conv_list(q, i);
        if (e < 0) return;
        const int ns = conv_job_tiles(e & 15) >> 3;
        if (c < ns) { const ConvJob job = conv_job(p, e >> 4, e & 15); convert_tiles(job, c * 8, c * 8 + 8, tl); return; }
        c -= ns;
    }
}

__device__ __forceinline__ void convert_p(const Params& p) {
    const f32x4* pl = (const f32x4*)p.in[1]; u32x2* pb = (u32x2*)(p.ws + WS_PBALL);
    for (int i = BID() * 256 + TID(); i < 2 * NT * 256 / 4; i += gridDim.x * 256) {
        const f32x4 v = pl[i]; u32x2 w; w.x = pk2(v.x, v.y); w.y = pk2(v.z, v.w); pb[i] = w;
    }
}
__device__ __forceinline__ void phase_convert(const Params& p, LAS float* tl) {
    {
        int base = 0;
        for (int j = 0; j < 6; ++j) {
            const ConvJob job = conv_job(p, 0, j);
            const int nt = conv_job_tiles(j);
            const int g = gridDim.x, b = BID();
            int first = (b - base % g + g) % g;
            for (int s = first; s < nt; s += g) convert_tiles(job, s, s + 1, tl);
            base += nt;
        }
    }
    {
        const int skip = gridDim.x >= 128 ? 64 : 0;
        const int tid_ = TID(); const int lane = tid_ & 63, gw = (BID() - skip) * 4 + (tid_ >> 6), ngw = (gridDim.x - skip) * 4;
        for (int row = gw >= 0 ? gw : NT; row < NT; row += ngw) {
            const f32x4* xr = (const f32x4*)(p.in[0] + (size_t)row * ND) + lane;
            u32x2* o = (u32x2*)((bf16_t*)p.out + (size_t)row * ND) + lane;
            float ss = 0.f;
#pragma unroll
            for (int j = 0; j < 4; ++j) { const f32x4 v = xr[64 * j]; ss += (v.x * v.x + v.y * v.y) + (v.z * v.z + v.w * v.w); u32x2 w; w.x = pk2(v.x, v.y); w.y = pk2(v.z, v.w); o[64 * j] = w; }
            ss = wave_sum(ss);
            if (lane < 16) ((float*)(p.ws + WS_SSP) + (size_t)NT * 16)[(size_t)row * 16 + lane] = lane == 0 ? ss : 0.f;
        }
    }
    for (int i = BID() * 256 + TID(); i < 2 * 1024 * 32; i += gridDim.x * 256) {
        const int l = i >> 15, k = (i >> 5) & 1023, j = i & 31;
        const float gk = p.in[10][l * ND + k];
        const float wv = j < 4 ? p.in[11][(size_t)(l * ND + k) * 4 + j] : (j < 20 ? p.in[13][(size_t)(l * ND + k) * 16 + (j - 4)] : 0.f);
        ((float*)(p.ws + WS_W + (size_t)l * WL_SIZE + WL_RT))[k * 32 + j] = gk * wv;
    }
    for (int i = BID() * 256 + TID(); i < 16 * 1024; i += gridDim.x * 256) {
        const int part = i >> 10, o = i & 1023, l = o >> 9, kv = (o >> 8) & 1, n = o & 255;
        const float* pos = p.in[9] + (size_t)(l * 2 + kv) * 2048 + part * 128;
        const float* w1 = p.in[kv ? 7 : 5] + (size_t)l * 2048 * 256 + (size_t)part * 128 * 256 + n;
        float s = 0.f;
#pragma unroll 16
        for (int k = 0; k < 128; ++k) s += pos[k] * w1[(size_t)k * 256];
        ((float*)(p.ws + WS_BC1P))[i] = s;
    }
}

__device__ __forceinline__ void phase_norm(const float* x, const float* g, bf16_t* xn) {
    const int tid_ = TID(); const int lane = tid_ & 63, gw = BID() * 4 + (tid_ >> 6), ngw = gridDim.x * 4;
    for (int row = gw; row < NT; row += ngw) {
        const f32x4* xr = (const f32x4*)(x + (size_t)row * ND) + lane;
        f32x4 v[4]; float ss = 0.f;
#pragma unroll
        for (int j = 0; j < 4; ++j) { v[j] = xr[64 * j]; ss += (v[j].x * v[j].x + v[j].y * v[j].y) + (v[j].z * v[j].z + v[j].w * v[j].w); }
        ss = wave_sum(ss);
        const float r = 1.0f / sqrtf(ss * (1.0f / ND) + 1e-6f);
        u32x2* o = (u32x2*)(xn + (size_t)row * ND) + lane;
#pragma unroll
        for (int j = 0; j < 4; ++j) {
            const f32x4 gg = ((const f32x4*)g)[lane + 64 * j];
            u32x2 w; w.x = pk2(v[j].x * r * gg.x, v[j].y * r * gg.y); w.y = pk2(v[j].z * r * gg.z, v[j].w * r * gg.w);
            o[64 * j] = w;
        }
    }
}
__device__ __forceinline__ void phase_final_norm(const bf16_t* xb, float* out, const float* g) {
    const int tid_ = TID(); const int lane = tid_ & 63, gw = BID() * 4 + (tid_ >> 6), ngw = gridDim.x * 4;
    for (int row = gw; row < NT; row += ngw) {
        const u32x2* xr = (const u32x2*)(xb + (size_t)row * ND) + lane;
        f32x4* orow = (f32x4*)(out + (size_t)row * ND) + lane;
        f32x4 v[4]; float ss = 0.f;
#pragma unroll
        for (int j = 0; j < 4; ++j) { const u32x2 w = xr[64 * j]; v[j] = (f32x4){bflo(w.x), bfhi(w.x), bflo(w.y), bfhi(w.y)}; ss += (v[j].x * v[j].x + v[j].y * v[j].y) + (v[j].z * v[j].z + v[j].w * v[j].w); }
        ss = wave_sum(ss);
        const float r = 1.0f / sqrtf(ss * (1.0f / ND) + 1e-6f);
#pragma unroll
        for (int j = 0; j < 4; ++j) {
            const f32x4 gg = ((const f32x4*)g)[lane + 64 * j];
            f32x4 o; o.x = v[j].x * r * gg.x; o.y = v[j].y * r * gg.y; o.z = v[j].z * r * gg.z; o.w = v[j].w * r * gg.w;
            orow[64 * j] = o;
        }
    }
}
typedef float f32x16r __attribute__((ext_vector_type(16)));
__device__ __forceinline__ void phase_route(const bf16_t* x, const float* wr, const float* brg, const float* bre, int* cnt, int* list, float* route, float* rinv, LAS unsigned char* lds) {
    const int tid_ = TID(); const int lane = tid_ & 63, wv = tid_ >> 6;
    const int i = lane & 31, hk = lane >> 5;
    LAS float* tl = (LAS float*)lds + wv * (32 * 33);
    LAS float* ssl = (LAS float*)(lds + 4 * 32 * 33 * 4);
    for (int task = BID(); task < NT / 32; task += gridDim.x) {
        const int row0 = task * 32;
        const bf16_t* xr = x + (size_t)(row0 + i) * ND + wv * 256;
        const float* wp = wr + (size_t)(wv * 256) * 32 + hk * 32 + i;
        f32x16r acc;
#pragma unroll
        for (int q = 0; q < 16; ++q) acc[q] = 0.f;
        float ss = 0.f;
#pragma unroll 8
        for (int k8 = 0; k8 < 32; ++k8) {
            const u32x4 xa = *(const u32x4*)(xr + 8 * k8);
            const float a0 = hk ? bfhi(xa.x) : bflo(xa.x), a1 = hk ? bfhi(xa.y) : bflo(xa.y), a2 = hk ? bfhi(xa.z) : bflo(xa.z), a3 = hk ? bfhi(xa.w) : bflo(xa.w);
            const float* wq = wp + (size_t)(8 * k8) * 32;
            acc = __builtin_amdgcn_mfma_f32_32x32x2f32(a0, wq[0], acc, 0, 0, 0);
            acc = __builtin_amdgcn_mfma_f32_32x32x2f32(a1, wq[2 * 32], acc, 0, 0, 0);
            acc = __builtin_amdgcn_mfma_f32_32x32x2f32(a2, wq[4 * 32], acc, 0, 0, 0);
            acc = __builtin_amdgcn_mfma_f32_32x32x2f32(a3, wq[6 * 32], acc, 0, 0, 0);
            ss += (a0 * a0 + a1 * a1) + (a2 * a2 + a3 * a3);
        }
        ss += __shfl_xor(ss, 32);
#pragma unroll
        for (int q = 0; q < 16; ++q) tl[((q & 3) + 8 * (q >> 2) + 4 * hk) * 33 + i] = acc[q];
        if (hk == 0) ssl[wv * 32 + i] = ss;
        __syncthreads();
        if (wv == 0 && hk == 0) {
            LAS const float* tp0 = (LAS const float*)lds;
            const float sst = (ssl[i] + ssl[32 + i]) + (ssl[64 + i] + ssl[96 + i]);
            const float r = 1.0f / sqrtf(sst * (1.0f / ND) + 1e-6f);
#define RT_SUM(e_) ((tp0[i * 33 + (e_)] + tp0[32 * 33 + i * 33 + (e_)]) + (tp0[2 * 32 * 33 + i * 33 + (e_)] + tp0[3 * 32 * 33 + i * 33 + (e_)]))
            float gl[4], el[16];
#pragma unroll
            for (int e = 0; e < 4; ++e) gl[e] = RT_SUM(e) * r + brg[e];
#pragma unroll
            for (int e = 0; e < 16; ++e) el[e] = RT_SUM(4 + e) * r + bre[e];
#undef RT_SUM
            int gsel = 0; float gmax = gl[0];
#pragma unroll
            for (int e = 1; e < 4; ++e) if (gl[e] > gmax) { gmax = gl[e]; gsel = e; }
            float gden = 0.f;
#pragma unroll
            for (int e = 0; e < 4; ++e) gden += __expf(gl[e] - gmax);
            const float gw_ = 1.0f / gden;
            float wi[4];
#pragma unroll
            for (int e = 0; e < 4; ++e) wi[e] = gsel == 0 ? el[e] : (gsel == 1 ? el[4 + e] : (gsel == 2 ? el[8 + e] : el[12 + e]));
            int i0 = 0; float t0 = wi[0];
#pragma unroll
            for (int e = 1; e < 4; ++e) if (wi[e] > t0) { t0 = wi[e]; i0 = e; }
            int i1 = -1; float t1 = -3.0e38f;
#pragma unroll
            for (int e = 0; e < 4; ++e) if (e != i0 && wi[e] > t1) { t1 = wi[e]; i1 = e; }
            const float ex = __expf(t1 - t0);
            const float ew0 = gw_ / (1.0f + ex), ew1 = gw_ * ex / (1.0f + ex);
            const int lo = i0 < i1 ? i0 : i1, hi = i0 < i1 ? i1 : i0;
            const float wlo = i0 < i1 ? ew0 : ew1, whi = i0 < i1 ? ew1 : ew0;
            const int pidx = lo == 0 ? hi - 1 : (lo == 1 ? hi + 1 : 5);
            const int bucket = gsel * 6 + pidx;
            const int row = row0 + i;
            unsigned long long mymask = 0ull;
            for (int bb = 0; bb < 24; ++bb) { const unsigned long long mm = __ballot(bucket == bb); if (bucket == bb) mymask = mm; }
            const int leader = __builtin_ctzll(mymask);
            int base = 0;
            if (lane == leader) base = atomicAdd(cnt + 64 * bucket, __builtin_popcountll(mymask));
            base = __shfl(base, leader);
            const int pos = base + __builtin_popcountll(mymask & ((1ull << lane) - 1ull));
            list[(size_t)bucket * NT + pos] = row;
            route[2 * row] = wlo; route[2 * row + 1] = whi;
            rinv[row] = r;
        }
        __syncthreads();
    }
}

struct APlain { const bf16_t* base; int ld; __device__ __forceinline__ const bf16_t* operator()(int r) const { return base + (size_t)r * ld; } };
struct ACmp { const bf16_t* base; __device__ __forceinline__ const bf16_t* operator()(int r) const { return base + (size_t)(r < 126 ? r : 126) * 1024; } };
struct AGather { const bf16_t* xn; const int* list; int cnt; __device__ __forceinline__ const bf16_t* operator()(int r) const { return xn + (size_t)(r < cnt ? list[r] : 0) * ND; } };
struct BPlain { const bf16_t* base; int ld; __device__ __forceinline__ const bf16_t* operator()(int r, int k0) const { return base + (size_t)r * ld + k0; } };
struct BSplit { const bf16_t* b0; const bf16_t* b1; __device__ __forceinline__ const bf16_t* operator()(int r, int k0) const { return k0 < 512 ? b0 + (size_t)r * 512 + k0 : b1 + (size_t)r * 512 + (k0 - 512); } };

template <class AP, class BP, class APN, class BPN>
__device__ __forceinline__ void gemm_kloop(f32x4 (&acc)[4][4], const AP& ap, const BP& bp, int K, LAS unsigned char* lds, bool prefetched, bool has_next, const APN& apn, const BPN& bpn) {
    const int tid = TID(), wid = tid >> 6, lane = tid & 63, wr = wid >> 1, wc = wid & 1, fr = lane & 15, fq = lane >> 4;
#if NAIVE_GEMM
    for (int k0 = 0; k0 < K; k0 += 32) {
#pragma unroll
        for (int m = 0; m < 4; ++m) {
            const bf16_t* arow = ap(wr * 64 + m * 16 + fr) + k0;
            u32x4 av[4];
#pragma unroll
            for (int c = 0; c < 4; ++c) av[c] = ((const u32x4*)arow)[c];
#pragma unroll
            for (int n = 0; n < 4; ++n)
#pragma unroll
                for (int j = 0; j < 4; ++j) {
                    const bf16_t* brow = bp(wc * 64 + n * 16 + 4 * fq + j, k0);
                    float s = 0.f;
#pragma unroll
                    for (int c = 0; c < 4; ++c) {
                        const u32x4 bv = ((const u32x4*)brow)[c];
                        s += bflo(av[c].x) * bflo(bv.x) + bfhi(av[c].x) * bfhi(bv.x) + bflo(av[c].y) * bflo(bv.y) + bfhi(av[c].y) * bfhi(bv.y)
                           + bflo(av[c].z) * bflo(bv.z) + bfhi(av[c].z) * bfhi(bv.z) + bflo(av[c].w) * bflo(bv.w) + bfhi(av[c].w) * bfhi(bv.w);
                    }
                    acc[m][n][j] += s;
                }
        }
    }
#else
    const unsigned woff = (unsigned)wid * 1024u;
    const bf16_t* aptr[4]; int brow[4], bcol;
    {
        const int sb = lane * 16, swz = sb ^ (((sb >> 9) & 1) << 5);
        const int rl = swz >> 6, cc = (wid & 1) * 32 + ((swz & 63) >> 1);
        bcol = cc;
#pragma unroll
        for (int i = 0; i < 4; ++i) { const int R = ((wid >> 1) + 2 * i) * 16 + rl; aptr[i] = ap(R) + cc; brow[i] = R; }
    }
    int aoff[4], boff[4];
#pragma unroll
    for (int m = 0; m < 4; ++m) {
        { const int r = wr * 64 + m * 16 + fr, c = fq * 8, st = (r >> 4) * 2, ob = (r & 15) * 64 + c * 2; aoff[m] = st * 1024 + (ob ^ (((ob >> 9) & 1) << 5)); }
        { const int r = wc * 64 + m * 16 + fr, c = fq * 8, st = (r >> 4) * 2, ob = (r & 15) * 64 + c * 2; boff[m] = st * 1024 + (ob ^ (((ob >> 9) & 1) << 5)); }
    }
    const int nk = K / 64;
#define GT_STAGE(buf, t) do { const int _k0 = (t) * 64; LAS unsigned char* _ba = lds + (buf) * 32768 + woff; \
        _Pragma("unroll") for (int _i = 0; _i < 4; ++_i) { \
            __builtin_amdgcn_global_load_lds((const unsigned*)(aptr[_i] + _k0), (LAS unsigned*)(_ba + _i * 4096), 16, 0, 0); \
            __builtin_amdgcn_global_load_lds((const unsigned*)(bp(brow[_i], _k0) + bcol), (LAS unsigned*)(_ba + 16384 + _i * 4096), 16, 0, 0); } } while (0)
    if (!prefetched) GT_STAGE(0, 0);
#pragma unroll 1
    for (int t = 0; t < nk; ++t) {
        asm volatile("s_waitcnt vmcnt(0)" ::: "memory");
        __syncthreads();
        if (t + 1 < nk) GT_STAGE((t + 1) & 1, t + 1);
        else if (has_next) {
            LAS unsigned char* _ba = lds + woff;
#pragma unroll
            for (int _i = 0; _i < 4; ++_i) {
                __builtin_amdgcn_global_load_lds((const unsigned*)(apn(brow[_i]) + bcol), (LAS unsigned*)(_ba + _i * 4096), 16, 0, 0);
                __builtin_amdgcn_global_load_lds((const unsigned*)(bpn(brow[_i], 0) + bcol), (LAS unsigned*)(_ba + 16384 + _i * 4096), 16, 0, 0);
            }
        }
        LAS const unsigned char* la = lds + (t & 1) * 32768;
        LAS const unsigned char* lb = la + 16384;
        bf16x8 At[2][4], Bt[2][4];
#pragma unroll
        for (int kh = 0; kh < 2; ++kh) {
#pragma unroll
            for (int m = 0; m < 4; ++m) At[kh][m] = *(const LAS bf16x8*)(la + aoff[m] + kh * 1024);
#pragma unroll
            for (int n = 0; n < 4; ++n) Bt[kh][n] = *(const LAS bf16x8*)(lb + boff[n] + kh * 1024);
        }
#pragma unroll
        for (int kh = 0; kh < 2; ++kh)
#pragma unroll
            for (int m = 0; m < 4; ++m)
#pragma unroll
                for (int n = 0; n < 4; ++n) acc[m][n] = __builtin_amdgcn_mfma_f32_16x16x32_bf16(Bt[kh][n], At[kh][m], acc[m][n], 0, 0, 0);
    }
#undef GT_STAGE
#endif
}
__device__ __forceinline__ void zero_acc(f32x4 (&acc)[4][4]) {
#pragma unroll
    for (int m = 0; m < 4; ++m)
#pragma unroll
        for (int n = 0; n < 4; ++n) acc[m][n] = (f32x4){0.f, 0.f, 0.f, 0.f};
}
template <class AP, class BP, class EPI>
__device__ __forceinline__ void gemm_tile(const AP& ap, const BP& bp, int K, const EPI& epi, LAS unsigned char* lds, bool prefetched, bool has_next, const AP& apn, const BP& bpn) {
    const int tid = TID(), wid = tid >> 6, lane = tid & 63, wr = wid >> 1, wc = wid & 1, fr = lane & 15, fq = lane >> 4;
    f32x4 acc[4][4]; zero_acc(acc);
    gemm_kloop(acc, ap, bp, K, lds, prefetched, has_next, apn, bpn);
    epi(acc, wr, wc, fr, fq);
}

__device__ __forceinline__ float rinv_from_ssp(const float* ssp, int row) {
    const f32x4* q = (const f32x4*)(ssp + (size_t)row * 16);
    const f32x4 a = q[0], b = q[1], c = q[2], d = q[3];
    const float s = ((a.x + a.y) + (a.z + a.w)) + ((b.x + b.y) + (b.z + b.w)) + ((c.x + c.y) + (c.z + c.w)) + ((d.x + d.y) + (d.z + d.w));
    return 1.0f / sqrtf(s * (1.0f / ND) + 1e-6f);
}
__device__ __forceinline__ float row_ss64(const f32x4& a, const f32x4& b, const f32x4& c, const f32x4& d) {
    float s = ((a.x * a.x + a.y * a.y) + (a.z * a.z + a.w * a.w)) + ((b.x * b.x + b.y * b.y) + (b.z * b.z + b.w * b.w))
            + ((c.x * c.x + c.y * c.y) + (c.z * c.z + c.w * c.w)) + ((d.x * d.x + d.y * d.y) + (d.z * d.z + d.w * d.w));
    s += __shfl_xor(s, 16); s += __shfl_xor(s, 32);
    return s;
}
struct EpiInProj {
    int mt, nt; unsigned char* ws; const float* ssp;
    __device__ __forceinline__ void operator()(const f32x4 (&acc)[4][4], int wr, int wc, int fr, int fq) const {
#pragma unroll
        for (int m = 0; m < 4; ++m) {
            const int row = mt * 128 + wr * 64 + m * 16 + fr, b = row >> 11, s = row & 2047;
            const float rr = rinv_from_ssp(ssp, row);
#pragma unroll
            for (int n = 0; n < 4; ++n) {
                const int col = wc * 64 + n * 16 + 4 * fq;
                const f32x4 v = acc[m][n] * rr;
                if (nt < 16) {
                    const int reg = nt >> 2, c = (nt & 3) * 128 + col, head = c >> 6, d = c & 63;
                    const float sc = (reg == 0 || reg == 3) ? 0.125f * 1.4426950408889634f : 1.0f;
                    bf16_t* dst = (bf16_t*)(ws + WS_QA + (size_t)reg * 16 * MiB) + ((size_t)((b * 8 + head) * NS + s) * 64 + d);
                    u32x2 w; w.x = pk2(v.x * sc, v.y * sc); w.y = pk2(v.z * sc, v.w * sc);
                    *(u32x2*)dst = w;
                } else if (nt < 22) {
                    const int g = col >> 6, d = col & 63;
                    bf16_t* dst = (bf16_t*)(ws + WS_KV6 + (size_t)(nt - 16) * 4 * MiB) + ((size_t)((b * 2 + g) * NS + s) * 64 + d);
                    u32x2 w; w.x = pk2(v.x, v.y); w.y = pk2(v.z, v.w);
                    *(u32x2*)dst = w;
                } else {
                    if (col < 24) {
                        f32x4 o; o.x = sigmoidf_(v.x); o.y = sigmoidf_(v.y); o.z = sigmoidf_(v.z); o.w = sigmoidf_(v.w);
                        *(f32x4*)((float*)(ws + WS_GATES) + (size_t)row * 24 + col) = o;
                    }
                }
            }
        }
    }
};
struct EpiCmp1 {
    bf16_t* hc; const float* bc1; int row0, col0;
    __device__ __forceinline__ void operator()(const f32x4 (&acc)[4][4], int wr, int wc, int fr, int fq) const {
#pragma unroll
        for (int m = 0; m < 4; ++m) {
            const int row = row0 + wr * 64 + m * 16 + fr;
#pragma unroll
            for (int n = 0; n < 4; ++n) {
                const int col = col0 + wc * 64 + n * 16 + 4 * fq;
                f32x4 bb = *(const f32x4*)(bc1 + col);
#pragma unroll
                for (int pp = 1; pp < 16; ++pp) bb += *(const f32x4*)(bc1 + pp * 1024 + col);
                const f32x4 v = acc[m][n];
                u32x2 w; w.x = pk2(gelu_tanh(v.x + bb.x), gelu_tanh(v.y + bb.y)); w.y = pk2(gelu_tanh(v.z + bb.z), gelu_tanh(v.w + bb.w));
                *(u32x2*)(hc + (size_t)row * 256 + col) = w;
            }
        }
    }
};
struct EpiCmp2 {
    bf16_t* dst; int row0;
    __device__ __forceinline__ void operator()(const f32x4 (&acc)[4][4], int wr, int wc, int fr, int fq) const {
        if (wc != 0) return;
#pragma unroll
        for (int m = 0; m < 4; ++m) {
            const int row = row0 + wr * 64 + m * 16 + fr;
#pragma unroll
            for (int n = 0; n < 4; ++n) {
                const int col = n * 16 + 4 * fq;
                const f32x4 v = acc[m][n];
                u32x2 w; w.x = pk2(v.x, v.y); w.y = pk2(v.z, v.w);
                *(u32x2*)(dst + (size_t)row * 64 + col) = w;
            }
        }
    }
};
struct EpiResAdd {
    bf16_t* res; int row0, col0;
    __device__ __forceinline__ void operator()(const f32x4 (&acc)[4][4], int wr, int wc, int fr, int fq) const {
#pragma unroll
        for (int m = 0; m < 4; ++m) {
            const int row = row0 + wr * 64 + m * 16 + fr;
#pragma unroll
            for (int n = 0; n < 4; ++n) {
                const int col = col0 + wc * 64 + n * 16 + 4 * fq;
                u32x2* pp = (u32x2*)(res + (size_t)row * ND + col);
                const u32x2 b = *pp; const f32x4 a = acc[m][n];
                u32x2 w; w.x = pk2(bflo(b.x) + a.x, bfhi(b.x) + a.y); w.y = pk2(bflo(b.y) + a.z, bfhi(b.y) + a.w);
                *pp = w;
            }
        }
    }
};
struct EpiMoeGU {
    bf16_t* hid; const int* list; const float* route; const float* rinv; int cnt, hrow0, nt16;
    __device__ __forceinline__ void operator()(const f32x4 (&acc)[4][4], int wr, int wc, int fr, int fq) const {
        const int half = nt16 >> 3, nte = nt16 & 7;
#pragma unroll
        for (int m = 0; m < 4; ++m) {
            const int r = wr * 64 + m * 16 + fr;
            const int tok = r < cnt ? list[r] : 0;
            const float w = r < cnt ? route[2 * tok + half] : 0.f;
            const float rt = rinv[tok];
#pragma unroll
            for (int pr = 0; pr < 2; ++pr) {
                const f32x4 gv = acc[m][2 * pr], uv = acc[m][2 * pr + 1];
                const int hc = half * 512 + (4 * nte + 2 * wc + pr) * 16 + 4 * fq;
                float h[4];
#pragma unroll
                for (int j = 0; j < 4; ++j) { const float gg = gv[j] * rt; h[j] = gg / (1.0f + __expf(-gg)) * (uv[j] * rt) * w; }
                u32x2 o; o.x = pk2(h[0], h[1]); o.y = pk2(h[2], h[3]);
                *(u32x2*)(hid + (size_t)(hrow0 + r) * 1024 + hc) = o;
            }
        }
    }
};
struct EpiMoeDown {
    bf16_t* res; const int* list; float* ssp; int cnt, col0;
    __device__ __forceinline__ void operator()(const f32x4 (&acc)[4][4], int wr, int wc, int fr, int fq) const {
#pragma unroll
        for (int m = 0; m < 4; ++m) {
            const int r = wr * 64 + m * 16 + fr;
            const bool ok = r < cnt;
            const int tok = ok ? list[r] : 0;
            f32x4 nv[4];
#pragma unroll
            for (int n = 0; n < 4; ++n) {
                const int col = col0 + wc * 64 + n * 16 + 4 * fq;
                u32x2* pp = (u32x2*)(res + (size_t)tok * ND + col);
                const u32x2 b = *pp; const f32x4 a = acc[m][n];
                nv[n] = (f32x4){bflo(b.x) + a.x, bfhi(b.x) + a.y, bflo(b.y) + a.z, bfhi(b.y) + a.w};
                if (ok) { u32x2 w; w.x = pk2(nv[n].x, nv[n].y); w.y = pk2(nv[n].z, nv[n].w); *pp = w; }
            }
            const float ps = row_ss64(nv[0], nv[1], nv[2], nv[3]);
            if (ok && fq == 0) ssp[(size_t)tok * 16 + (col0 >> 6) + wc] = ps;
        }
    }
};
struct EpiBf16 {
    bf16_t* dst; int ld, row0, col0;
    __device__ __forceinline__ void operator()(const f32x4 (&acc)[4][4], int wr, int wc, int fr, int fq) const {
#pragma unroll
        for (int m = 0; m < 4; ++m) {
            const int row = row0 + wr * 64 + m * 16 + fr;
#pragma unroll
            for (int n = 0; n < 4; ++n) {
                const int col = col0 + wc * 64 + n * 16 + 4 * fq;
                const f32x4 v = acc[m][n];
                u32x2 w; w.x = pk2(v.x, v.y); w.y = pk2(v.z, v.w);
                *(u32x2*)(dst + (size_t)row * ld + col) = w;
            }
        }
    }
};
struct EpiPleFused {
    const bf16_t* rin; const float* ssp_in; bf16_t* rout; float* ssp_out; int row0, col0;
    __device__ __forceinline__ void operator()(const f32x4 (&acc)[4][4], const f32x4 (&acc2)[4][4], int wr, int wc, int fr, int fq) const {
#pragma unroll
        for (int m = 0; m < 4; ++m) {
            const int row = row0 + wr * 64 + m * 16 + fr;
            const float rr = rinv_from_ssp(ssp_in, row);
            f32x4 nv[4];
#pragma unroll
            for (int n = 0; n < 4; ++n) {
                const int col = col0 + wc * 64 + n * 16 + 4 * fq;
                const size_t off = (size_t)row * ND + col;
                const f32x4 v = acc[m][n] * rr, q = acc2[m][n];
                const u32x2 b = *(const u32x2*)(rin + off);
                f32x4 o = (f32x4){bflo(b.x), bfhi(b.x), bflo(b.y), bfhi(b.y)};
                o.x += sigmoidf_(v.x) * q.x; o.y += sigmoidf_(v.y) * q.y; o.z += sigmoidf_(v.z) * q.z; o.w += sigmoidf_(v.w) * q.w;
                u32x2 w; w.x = pk2(o.x, o.y); w.y = pk2(o.z, o.w);
                *(u32x2*)(rout + off) = w;
                nv[n] = o;
            }
            const float ps = row_ss64(nv[0], nv[1], nv[2], nv[3]);
            if (fq == 0) ssp_out[(size_t)row * 16 + (col0 >> 6) + wc] = ps;
        }
    }
};
struct EpiPleGate {
    float* out; const bf16_t* p2; int row0, col0; float sc;
    __device__ __forceinline__ void operator()(const f32x4 (&acc)[4][4], int wr, int wc, int fr, int fq) const {
#pragma unroll
        for (int m = 0; m < 4; ++m) {
            const int row = row0 + wr * 64 + m * 16 + fr;
#pragma unroll
            for (int n = 0; n < 4; ++n) {
                const int col = col0 + wc * 64 + n * 16 + 4 * fq;
                const size_t off = (size_t)row * ND + col;
                const u32x2 pv = *(const u32x2*)(p2 + off);
                const f32x4 v = acc[m][n];
                f32x4 o = *(const f32x4*)(out + off);
                o.x += sc * sigmoidf_(v.x) * bflo(pv.x); o.y += sc * sigmoidf_(v.y) * bfhi(pv.x); o.z += sc * sigmoidf_(v.z) * bflo(pv.y); o.w += sc * sigmoidf_(v.w) * bfhi(pv.y);
                *(f32x4*)(out + off) = o;
            }
        }
    }
};

template <class PH, class AP, class BP, class EPI>
__device__ __forceinline__ void gemm_stream(const PH& ph, int first, int step, int count, int K, LAS unsigned char* lds) {
    int q = first;
    if (q >= count) return;
    AP ap, apn; BP bp, bpn; EPI ep, epn;
    ph.make(q, ap, bp, ep);
    bool pref = false;
    for (;;) {
        const int qn = q + step; const bool hn = qn < count;
        if (hn) ph.make(qn, apn, bpn, epn); else { apn = ap; bpn = bp; epn = ep; }
        gemm_tile(ap, bp, K, ep, lds, pref, hn, apn, bpn);
        if (!hn) break;
        ap = apn; bp = bpn; ep = epn; q = qn; pref = true;
    }
}

__device__ __forceinline__ void load_q32(const bf16_t* p, float* q) {
#pragma unroll
    for (int c = 0; c < 4; ++c) {
        const u32x4 v = ((const u32x4*)p)[c];
        q[8 * c] = bflo(v.x); q[8 * c + 1] = bfhi(v.x); q[8 * c + 2] = bflo(v.y); q[8 * c + 3] = bfhi(v.y);
        q[8 * c + 4] = bflo(v.z); q[8 * c + 5] = bfhi(v.z); q[8 * c + 6] = bflo(v.w); q[8 * c + 7] = bfhi(v.w);
    }
}
__device__ __forceinline__ float dot32p(const float* q, const bf16_t* k) {
    float s0 = 0.f, s1 = 0.f;
#pragma unroll
    for (int c = 0; c < 4; ++c) {
        const u32x4 v = ((const u32x4*)k)[c];
        s0 += q[8 * c] * bflo(v.x); s1 += q[8 * c + 1] * bfhi(v.x); s0 += q[8 * c + 2] * bflo(v.y); s1 += q[8 * c + 3] * bfhi(v.y);
        s0 += q[8 * c + 4] * bflo(v.z); s1 += q[8 * c + 5] * bfhi(v.z); s0 += q[8 * c + 6] * bflo(v.w); s1 += q[8 * c + 7] * bfhi(v.w);
    }
    const float s = s0 + s1;
    return s + __shfl_xor(s, 1);
}
__device__ __forceinline__ void axpy32(float* a, float p, const bf16_t* vr) {
#pragma unroll
    for (int c = 0; c < 4; ++c) {
        const u32x4 v = ((const u32x4*)vr)[c];
        a[8 * c] += p * bflo(v.x); a[8 * c + 1] += p * bfhi(v.x); a[8 * c + 2] += p * bflo(v.y); a[8 * c + 3] += p * bfhi(v.y);
        a[8 * c + 4] += p * bflo(v.z); a[8 * c + 5] += p * bfhi(v.z); a[8 * c + 6] += p * bflo(v.w); a[8 * c + 7] += p * bfhi(v.w);
    }
}
#define ONLINE_STEP(s_, vrow_) do { const float _s = (s_); if (_s > mx) { const float _c = __expf(mx - _s); l *= _c; _Pragma("unroll") for (int _i = 0; _i < 32; ++_i) acc[_i] *= _c; mx = _s; } \
    const float _p = __expf(_s - mx); l += _p; axpy32(acc, _p, (vrow_)); } while (0)

__device__ __forceinline__ void store_o32(bf16_t* dst, const float* a, float sc) {
#pragma unroll
    for (int c = 0; c < 4; ++c) {
        u32x4 w; w.x = pk2(a[8 * c] * sc, a[8 * c + 1] * sc); w.y = pk2(a[8 * c + 2] * sc, a[8 * c + 3] * sc);
        w.z = pk2(a[8 * c + 4] * sc, a[8 * c + 5] * sc); w.w = pk2(a[8 * c + 6] * sc, a[8 * c + 7] * sc);
        ((u32x4*)dst)[c] = w;
    }
}

__device__ __forceinline__ void attn_dilated_naive(const unsigned char* ws, int gtid, int gthreads) {
    asm volatile("" : "+v"(gtid));
    const bf16_t* qa = (const bf16_t*)(ws + WS_QA); const bf16_t* ka = (const bf16_t*)(ws + WS_KA); const bf16_t* va = (const bf16_t*)(ws + WS_VA);
    bf16_t* ob = (bf16_t*)(ws + WS_O);
    for (int id2 = gtid; id2 < NB * 8 * NS * 2; id2 += gthreads) {
        const int idx = id2 >> 1, hf = (id2 & 1) * 32;
        const int t = idx & 2047, bh = idx >> 11, h = bh & 7, b = bh >> 3;
        float q[32]; load_q32(qa + (size_t)idx * 64 + hf, q);
        const bf16_t* kb = ka + (size_t)bh * NS * 64 + hf; const bf16_t* vb = va + (size_t)bh * NS * 64 + hf;
        const float slope = exp2f(-((float)h + 0.5f));
        float mx = -1e30f, l = 0.f; float acc[32];
#pragma unroll
        for (int i = 0; i < 32; ++i) acc[i] = 0.f;
#pragma unroll 1
        for (int pat = 0; pat < 3; ++pat) {
            const int dil = pat == 0 ? 1 : (pat == 1 ? 4 : 16);
#pragma unroll 1
            for (int j = 0; j <= 128; ++j) {
                const int dist = j * dil, pos = t - dist;
                if (pos < 0) break;
                const float s = dot32p(q, kb + (size_t)pos * 64) - slope * (float)dist;
                ONLINE_STEP(s, vb + (size_t)pos * 64);
            }
        }
        store_o32(ob + ((size_t)(b * NS + t) * ND + h * 64 + hf), acc, 1.0f / l);
    }
}

__device__ __forceinline__ void nsa_imp_naive(const unsigned char* ws, int gtid, int gthreads) {
    asm volatile("" : "+v"(gtid));
    const bf16_t* qb = (const bf16_t*)(ws + WS_QB); const bf16_t* kcmp = (const bf16_t*)(ws + WS_KCMP);
    float* imph = (float*)(ws + WS_IMPH);
    for (int id2 = gtid; id2 < NB * 8 * NS * 2; id2 += gthreads) {
        const int idx = id2 >> 1, hf = (id2 & 1) * 32;
        const int t = idx & 2047, bh = idx >> 11, hb = bh & 7, b = bh >> 3, g = hb >> 2;
        float q[32]; load_q32(qb + (size_t)idx * 64 + hf, q);
        const bf16_t* kc = kcmp + (size_t)(b * 2 + g) * 128 * 64 + hf;
        const float slope = exp2f(-(float)(hb + 1));
        const int ncv = t >= 31 ? ((t - 31) >> 4) + 1 : 0;
        float mx = -1e30f;
#pragma unroll 1
        for (int c = 0; c < ncv; ++c) { const float s = dot32p(q, kc + c * 64) - slope * (float)(t - (16 * c + 31)); mx = fmaxf(mx, s); }
        float den = 0.f;
#pragma unroll 1
        for (int c = 0; c < ncv; ++c) { const float s = dot32p(q, kc + c * 64) - slope * (float)(t - (16 * c + 31)); den += __expf(s - mx); }
        const float inv = ncv > 0 ? 1.0f / den : 0.f;
#pragma unroll 1
        for (int n = 0; n < 32; ++n) {
            float imp = 0.f;
#pragma unroll 1
            for (int j = -1; j <= 3; ++j) {
                const int c = 4 * n + j;
                if (c >= 0 && c < ncv) {
                    const float s = dot32p(q, kc + c * 64) - slope * (float)(t - (16 * c + 31));
                    const float pp = __expf(s - mx) * inv;
                    imp += (j == -1 || j == 3) ? 0.5f * pp : pp;
                }
            }
            if (hf == 0) imph[(size_t)idx * 32 + n] = imp;
        }
    }
}
__device__ __forceinline__ void nsa_select(const unsigned char* ws, unsigned* maskbuf) {
    const float* imph = (const float*)(ws + WS_IMPH);
    const int tid_ = TID(); const int lane = tid_ & 63, gw = BID() * 4 + (tid_ >> 6), ngw = gridDim.x * 4;
    for (int it = gw; it < NB * 2 * NS / 2; it += ngw) {
        const int item = it * 2 + (lane >> 5), t = item & 2047, bg = item >> 11, n = lane & 31;
        float imp = 0.f;
#pragma unroll
        for (int r = 0; r < 4; ++r) imp += imph[((size_t)(bg * 4 + r) * NS + t) * 32 + n];
        const int cur = t >> 6;
        const bool valid = n <= cur;
        const bool forced = (n == 0) || (cur - n < 2);
        const float score = valid ? imp + (forced ? 1e4f : 0.f) : -1e30f;
        int rank = 0;
        for (int m = 0; m < 32; ++m) {
            const float sm = __shfl(score, (lane & 32) | m);
            rank += (sm > score || (sm == score && m < n)) ? 1 : 0;
        }
        const bool sel = valid && rank < 16;
        const unsigned long long bal = __ballot(sel);
        if (n == 0) maskbuf[item] = (lane >> 5) ? (unsigned)(bal >> 32) : (unsigned)bal;
    }
}
__device__ __forceinline__ void nsa_attn_naive(const unsigned char* ws, int gtid, int gthreads) {
    asm volatile("" : "+v"(gtid));
    const bf16_t* qb = (const bf16_t*)(ws + WS_QB);
    const bf16_t* kcmp = (const bf16_t*)(ws + WS_KCMP); const bf16_t* vcmp = kcmp + (size_t)16 * 128 * 64;
    const bf16_t* ksb = (const bf16_t*)(ws + WS_KV6 + 2 * 4 * MiB); const bf16_t* vsb = (const bf16_t*)(ws + WS_KV6 + 3 * 4 * MiB);
    const bf16_t* kwb = (const bf16_t*)(ws + WS_KV6 + 4 * 4 * MiB); const bf16_t* vwb = (const bf16_t*)(ws + WS_KV6 + 5 * 4 * MiB);
    const float* gates = (const float*)(ws + WS_GATES);
    const unsigned* maskbuf = (const unsigned*)(ws + WS_MASK);
    bf16_t* ob = (bf16_t*)(ws + WS_O);
    for (int id2 = gtid; id2 < NB * 8 * NS * 2; id2 += gthreads) {
        const int idx = id2 >> 1, hf = (id2 & 1) * 32;
        const int t = idx & 2047, bh = idx >> 11, hb = bh & 7, b = bh >> 3, g = hb >> 2, bg = b * 2 + g;
        float q[32]; load_q32(qb + (size_t)idx * 64 + hf, q);
        const float slope = exp2f(-(float)(hb + 1));
        const float* gt = gates + (size_t)(b * NS + t) * 24 + hb * 3;
        float tot[32], acc[32];
#pragma unroll
        for (int i = 0; i < 32; ++i) tot[i] = 0.f;
        {
            const bf16_t* kc = kcmp + (size_t)bg * 128 * 64 + hf; const bf16_t* vc = vcmp + (size_t)bg * 128 * 64 + hf;
            const int ncv = t >= 31 ? ((t - 31) >> 4) + 1 : 0;
            if (ncv > 0) {
                float mx = -1e30f, l = 0.f;
#pragma unroll
                for (int i = 0; i < 32; ++i) acc[i] = 0.f;
#pragma unroll 1
                for (int c = 0; c < ncv; ++c) { const float s = dot32p(q, kc + c * 64) - slope * (float)(t - (16 * c + 31)); ONLINE_STEP(s, vc + c * 64); }
                const float sc = gt[0] / l;
#pragma unroll
                for (int i = 0; i < 32; ++i) tot[i] += sc * acc[i];
            }
        }
        {
            const bf16_t* kb = ksb + (size_t)bg * NS * 64 + hf; const bf16_t* vb = vsb + (size_t)bg * NS * 64 + hf;
            const unsigned mask = maskbuf[bg * NS + t];
            float mx = -1e30f, l = 0.f;
#pragma unroll
            for (int i = 0; i < 32; ++i) acc[i] = 0.f;
#pragma unroll 1
            for (int n = 0; n < 32; ++n) {
                if (!((mask >> n) & 1u)) continue;
#pragma unroll 1
                for (int i = 0; i < 64; ++i) {
                    const int pos = n * 64 + i;
                    if (pos > t) break;
                    const float s = dot32p(q, kb + (size_t)pos * 64) - slope * (float)(t - pos);
                    ONLINE_STEP(s, vb + (size_t)pos * 64);
                }
            }
            const float sc = gt[1] / l;
#pragma unroll
            for (int i = 0; i < 32; ++i) tot[i] += sc * acc[i];
        }
        {
            const bf16_t* kb = kwb + (size_t)bg * NS * 64 + hf; const bf16_t* vb = vwb + (size_t)bg * NS * 64 + hf;
            float mx = -1e30f, l = 0.f;
#pragma unroll
            for (int i = 0; i < 32; ++i) acc[i] = 0.f;
#pragma unroll 1
            for (int dist = 0; dist < 512; ++dist) {
                const int pos = t - dist;
                if (pos < 0) break;
                const float s = dot32p(q, kb + (size_t)pos * 64) - slope * (float)dist;
                ONLINE_STEP(s, vb + (size_t)pos * 64);
            }
            const float sc = gt[2] / l;
#pragma unroll
            for (int i = 0; i < 32; ++i) tot[i] += sc * acc[i];
        }
        store_o32(ob + ((size_t)(b * NS + t) * ND + 512 + hb * 64 + hf), tot, 1.0f);
    }
}

constexpr int KVS = 144;
constexpr int KVT = 64 * KVS;
constexpr int VS = 128;
constexpr int VT = 64 * VS;
#define LOG2E_F 1.4426950408889634f
__device__ __forceinline__ unsigned cvtpk(float lo, float hi) { f32x2_t v = {lo, hi}; bf16x2_t b = __builtin_convertvector(v, bf16x2_t); return __builtin_bit_cast(unsigned, b); }
__device__ __forceinline__ s16x4 vtr(LAS const unsigned char* p) { return __builtin_bit_cast(s16x4, __builtin_amdgcn_ds_read_tr16_b64_v4i16((LAS s16x4*)p)); }
__device__ __forceinline__ f32x16 zero16() { f32x16 z;
#pragma unroll
    for (int i = 0; i < 16; ++i) z[i] = 0.f;
    return z; }

__device__ __forceinline__ void load_kv_tile(LAS unsigned char* Kt, LAS unsigned char* Vt, const bf16_t* kbase, const bf16_t* vbase, int row0, int rstride, int rmin, int rmax, int tid) {
    const int j = tid >> 2, ch = tid & 3;
    int tok = row0 + j * rstride; tok = tok < rmin ? rmin : (tok > rmax ? rmax : tok);
    const u32x4* kp = (const u32x4*)(kbase + (size_t)tok * 64);
    const u32x4* vp = (const u32x4*)(vbase + (size_t)tok * 64);
    const u32x4 k0 = kp[ch], k1 = kp[ch + 4], v0 = vp[ch], v1 = vp[ch + 4];
    *(LAS u32x4*)(Kt + j * KVS + ch * 16) = k0; *(LAS u32x4*)(Kt + j * KVS + (ch + 4) * 16) = k1;
    { const int sx = 2 * (j & 3); *(LAS u32x4*)(Vt + j * VS + ((ch ^ sx) * 16)) = v0; *(LAS u32x4*)(Vt + j * VS + (((ch + 4) ^ sx) * 16)) = v1; }
}

struct KVRegs { u32x4 k0, k1, v0, v1; };
__device__ __forceinline__ void kv_fetch(KVRegs& r, const bf16_t* kbase, const bf16_t* vbase, int row0, int rstride, int rmin, int rmax, int tid) {
    const int j = tid >> 2, ch = tid & 3;
    int tok = row0 + j * rstride; tok = tok < rmin ? rmin : (tok > rmax ? rmax : tok);
    const u32x4* kp = (const u32x4*)(kbase + (size_t)tok * 64);
    const u32x4* vp = (const u32x4*)(vbase + (size_t)tok * 64);
    r.k0 = kp[ch]; r.k1 = kp[ch + 4]; r.v0 = vp[ch]; r.v1 = vp[ch + 4];
}
__device__ __forceinline__ void kv_commit(const KVRegs& r, LAS unsigned char* Kt, LAS unsigned char* Vt, int tid) {
    const int j = tid >> 2, ch = tid & 3;
    *(LAS u32x4*)(Kt + j * KVS + ch * 16) = r.k0; *(LAS u32x4*)(Kt + j * KVS + (ch + 4) * 16) = r.k1;
    { const int sx = 2 * (j & 3); *(LAS u32x4*)(Vt + j * VS + ((ch ^ sx) * 16)) = r.v0; *(LAS u32x4*)(Vt + j * VS + (((ch + 4) ^ sx) * 16)) = r.v1; }
}
__device__ __forceinline__ void pv32(f32x16& o0, f32x16& o1, const f32x16& sv, LAS const unsigned char* vp0, LAS const unsigned char* vp1  ) {
#pragma unroll
    for (int s16 = 0; s16 < 2; ++s16) {
        u32x4 pw;
        pw.x = cvtpk(sv[8 * s16 + 0], sv[8 * s16 + 1]); pw.y = cvtpk(sv[8 * s16 + 2], sv[8 * s16 + 3]);
        pw.z = cvtpk(sv[8 * s16 + 4], sv[8 * s16 + 5]); pw.w = cvtpk(sv[8 * s16 + 6], sv[8 * s16 + 7]);
        const bf16x8 pf = __builtin_bit_cast(bf16x8, pw);
        const s16x4 a0 = vtr(vp0 + s16 * 16 * VS), b0 = vtr(vp0 + s16 * 16 * VS + 8 * VS), a1 = vtr(vp1 + s16 * 16 * VS), b1 = vtr(vp1 + s16 * 16 * VS + 8 * VS);
        const bf16x8 vf0 = {a0[0], a0[1], a0[2], a0[3], b0[0], b0[1], b0[2], b0[3]};
        const bf16x8 vf1 = {a1[0], a1[1], a1[2], a1[3], b1[0], b1[1], b1[2], b1[3]};
        o0 = __builtin_amdgcn_mfma_f32_32x32x16_bf16(vf0, pf, o0, 0, 0, 0);
        o1 = __builtin_amdgcn_mfma_f32_32x32x16_bf16(vf1, pf, o1, 0, 0, 0);
    }
}
__device__ __forceinline__ f32x16 qk32(const bf16x8* qf, LAS const unsigned char* kp  , f32x16 s  ) {
#pragma unroll
    for (int k = 0; k < 4; ++k) {
        const bf16x8 kf = *(const LAS bf16x8*)(kp + 32 * k);
        s = __builtin_amdgcn_mfma_f32_32x32x16_bf16(kf, qf[k], s, 0, 0, 0);
    }
    return s;
}
template <int KS, bool TRY_FULL>
__device__ __forceinline__ void fa_tile64(f32x16& o0, f32x16& o1, float& m, float& l, const bf16x8* qf, LAS const unsigned char* Kt, LAS const unsigned char* Vt, int lane, float dA, float wmax, float ns2) {
    const int r = lane & 31, h = lane >> 5;
    LAS const unsigned char* kp = Kt + r * KVS + 16 * h;
    const float dAh = dA - (float)(KS * 4 * h);
    const float hi = dAh, lo = dAh - wmax, base = ns2 * dAh;
    f32x16 s0, s1;
#pragma unroll
    for (int i = 0; i < 16; ++i) {
        const float c0 = (float)(KS * ((i & 3) + 8 * (i >> 2))), c1 = c0 + (float)(32 * KS);
        s0[i] = fmaf(-c0, ns2, base); s1[i] = fmaf(-c1, ns2, base);
    }
    s0 = qk32(qf, kp, s0); s1 = qk32(qf, kp + 32 * KVS, s1);
    float tmax = -1e30f;
    if (TRY_FULL && __all(lo <= 0.f && hi >= (float)(59 * KS))) {
#pragma unroll
        for (int i = 0; i < 16; ++i) tmax = fmaxf(tmax, fmaxf(s0[i], s1[i]));
    } else {
#pragma unroll
        for (int i = 0; i < 16; ++i) {
            const float c0 = (float)(KS * ((i & 3) + 8 * (i >> 2))), c1 = c0 + (float)(32 * KS);
            const float t0 = (c0 >= lo && c0 <= hi) ? s0[i] : -1e30f;
            const float t1 = (c1 >= lo && c1 <= hi) ? s1[i] : -1e30f;
            s0[i] = t0; s1[i] = t1;
            tmax = fmaxf(tmax, fmaxf(t0, t1));
        }
    }
    tmax = fmaxf(tmax, __shfl_xor(tmax, 32));
    const float mn = fmaxf(m, tmax);
    const float corr = __builtin_amdgcn_exp2f(m - mn);
    m = mn;
    const float mu = fmaxf(mn, -1e29f);
    float ps = 0.f;
#pragma unroll
    for (int i = 0; i < 16; ++i) {
        s0[i] = __builtin_amdgcn_exp2f(s0[i] - mu); s1[i] = __builtin_amdgcn_exp2f(s1[i] - mu);
        ps += s0[i] + s1[i];
    }
    l = l * corr + ps;
    if (!__all(corr == 1.0f)) {
#pragma unroll
        for (int i = 0; i < 16; ++i) { o0[i] *= corr; o1[i] *= corr; }
    }
    const int vq = (lane & 15) >> 2, vc0 = 2 * ((lane >> 4) & 1) + ((lane & 3) >> 1), vsx = 2 * vq;
    LAS const unsigned char* vp0 = Vt + (4 * h + vq) * VS + ((vc0 ^ vsx) * 16) + 8 * (lane & 1);
    LAS const unsigned char* vp1 = Vt + (4 * h + vq) * VS + (((vc0 + 4) ^ vsx) * 16) + 8 * (lane & 1);
    pv32(o0, o1, s0, vp0, vp1);
    pv32(o0, o1, s1, vp0 + 32 * VS, vp1 + 32 * VS);
}
__device__ __forceinline__ void acc_scaled(f32x16& t0, f32x16& t1, const f32x16& o0, const f32x16& o1, float sc) {
#pragma unroll
    for (int i = 0; i < 16; ++i) { t0[i] += sc * o0[i]; t1[i] += sc * o1[i]; }
}
__device__ __forceinline__ void store_ot(bf16_t* orow, const f32x16& o0, const f32x16& o1, float sc, int h) {
#pragma unroll
    for (int u = 0; u < 4; ++u) {
        u32x2 w0, w1;
        w0.x = cvtpk(o0[4 * u] * sc, o0[4 * u + 1] * sc); w0.y = cvtpk(o0[4 * u + 2] * sc, o0[4 * u + 3] * sc);
        w1.x = cvtpk(o1[4 * u] * sc, o1[4 * u + 1] * sc); w1.y = cvtpk(o1[4 * u + 2] * sc, o1[4 * u + 3] * sc);
        *(u32x2*)(orow + 8 * u + 4 * h) = w0;
        *(u32x2*)(orow + 32 + 8 * u + 4 * h) = w1;
    }
}
__device__ __forceinline__ void load_qf(bf16x8* qf, const bf16_t* qrow, int h) {
#pragma unroll
    for (int k = 0; k < 4; ++k) qf[k] = *(const bf16x8*)(qrow + 16 * k + 8 * h);
}

__device__ __forceinline__ void dil_item(unsigned char* ws, int item, LAS unsigned char* lds) {
    const int tid = TID(), lane = tid & 63, w = tid >> 6, c = lane & 31, h = lane >> 5;
    const int bh = item / 48, rem = item % 48, pat = rem >> 4, idx = rem & 15;
    const int dil = pat == 0 ? 1 : (pat == 1 ? 4 : 16), nqt = 16 / dil, res = idx / nqt, qt = idx % nqt;
    const int hd = bh & 7, b = bh >> 3;
    const int q0 = qt * 128 + 32 * w, iq = q0 + c, t = res + iq * dil;
    const bf16_t* qa = (const bf16_t*)(ws + WS_QA) + (size_t)bh * NS * 64;
    const bf16_t* ka = (const bf16_t*)(ws + WS_KA) + (size_t)bh * NS * 64;
    const bf16_t* va = (const bf16_t*)(ws + WS_VA) + (size_t)bh * NS * 64;
    bf16x8 qf[4]; load_qf(qf, qa + (size_t)t * 64, h);
    const float ns2 = -exp2f(-((float)hd + 0.5f)) * (float)dil * LOG2E_F;
    f32x16 o0 = zero16(), o1 = zero16(); float m = -1e30f, l = 0.f;
    {
        const int T0 = qt == 0 ? 2 : 0;
        KVRegs kr; kv_fetch(kr, ka, va, res + (qt * 128 - 128 + 64 * T0) * dil, dil, 0, NS - 1, tid);
        int buf = 0;
        for (int T = T0; T < 4; ++T) {
            const int kb = qt * 128 - 128 + 64 * T;
            LAS unsigned char* Kt = lds + buf * KVT; LAS unsigned char* Vt = lds + 2 * KVT + buf * VT;
            kv_commit(kr, Kt, Vt, tid);
            __syncthreads();
            if (T + 1 < 4) kv_fetch(kr, ka, va, res + (kb + 64) * dil, dil, 0, NS - 1, tid);
            if (kb <= q0 + 31 && kb + 63 >= q0 - 128)
                fa_tile64<1, true>(o0, o1, m, l, qf, Kt, Vt, lane, (float)(iq - kb), 128.f, ns2);
            buf ^= 1;
        }
    }
    const float lt = l + __shfl_xor(l, 32);
    bf16_t* op = (bf16_t*)(pat < 2 ? ws + WS_OPA01 + (size_t)pat * 16 * MiB : ws + WS_OPA2);
    store_ot(op + ((size_t)(b * NS + t) * 512 + hd * 64), o0, o1, 1.0f / lt, h);
    if (h == 0) { float* st = (float*)(ws + WS_STA) + ((size_t)pat * NB * 8 * NS + (size_t)bh * NS + t) * 2; st[0] = m; st[1] = lt; }
}
__device__ __forceinline__ void dil_merge(unsigned char* ws, int gtid, int gthreads) {
    asm volatile("" : "+v"(gtid));
    const float* sta = (const float*)(ws + WS_STA);
    bf16_t* ob = (bf16_t*)(ws + WS_O);
    for (int it = gtid; it < NT * 8 * 8; it += gthreads) {
        const int ch = it & 7, hd = (it >> 3) & 7, tk = it >> 6, b = tk >> 11, t = tk & 2047;
        float mm[3], ll[3];
#pragma unroll
        for (int p = 0; p < 3; ++p) { const float* s = sta + ((size_t)p * NB * 8 * NS + (size_t)(b * 8 + hd) * NS + t) * 2; mm[p] = s[0]; ll[p] = s[1]; }
        const float M = fmaxf(mm[0], fmaxf(mm[1], mm[2]));
        float wgt[3], den = 0.f;
#pragma unroll
        for (int p = 0; p < 3; ++p) { wgt[p] = __builtin_amdgcn_exp2f(mm[p] - M) * ll[p]; den += wgt[p]; }
        const float inv = 1.0f / den;
        float a[8];
#pragma unroll
        for (int i = 0; i < 8; ++i) a[i] = 0.f;
#pragma unroll
        for (int p = 0; p < 3; ++p) {
            const bf16_t* op = (const bf16_t*)(p < 2 ? ws + WS_OPA01 + (size_t)p * 16 * MiB : ws + WS_OPA2);
            const u32x4 v = *(const u32x4*)(op + (size_t)tk * 512 + hd * 64 + ch * 8);
            const float wp = wgt[p] * inv;
            a[0] += wp * bflo(v.x); a[1] += wp * bfhi(v.x); a[2] += wp * bflo(v.y); a[3] += wp * bfhi(v.y);
            a[4] += wp * bflo(v.z); a[5] += wp * bfhi(v.z); a[6] += wp * bflo(v.w); a[7] += wp * bfhi(v.w);
        }
        u32x4 o; o.x = pk2(a[0], a[1]); o.y = pk2(a[2], a[3]); o.z = pk2(a[4], a[5]); o.w = pk2(a[6], a[7]);
        *(u32x4*)(ob + (size_t)tk * ND + hd * 64 + ch * 8) = o;
    }
}

constexpr int LDS_IMP = 4 * KVT;
constexpr int LDS_UNI = LDS_IMP + 4096;
constexpr int LDS_TOT = 41088;
__device__ __forceinline__ void nsa_item(unsigned char* ws, int item, LAS unsigned char* lds) {
    const int tid = TID(), lane = tid & 63, w = tid >> 6, c = lane & 31, h = lane >> 5;
    const int bg = item & 15, tt = item >> 4, b = bg >> 1, g = bg & 1;
    const int t0 = tt * 32, tok8 = c & 7, hh = c >> 3, hb = g * 4 + hh, t = t0 + 8 * w + tok8;
    const bf16_t* qrow = (const bf16_t*)(ws + WS_QB) + ((size_t)(b * 8 + hb) * NS + t) * 64;
    bf16x8 qf[4]; load_qf(qf, qrow, h);
    const float ns2 = -exp2f(-(float)(hb + 1)) * LOG2E_F;
    const float* gt = (const float*)(ws + WS_GATES) + (size_t)(b * NS + t) * 24 + hb * 3;
    const float g0 = gt[0], g1 = gt[1], g2 = gt[2];
    LAS float* totL = (LAS float*)(lds + LDS_TOT) + tid;
    LAS unsigned char* Kt = lds; LAS unsigned char* Vt = lds + 2 * KVT;
    LAS float* impL = (LAS float*)(lds + LDS_IMP) + w * 256;
    LAS unsigned* uni = (LAS unsigned*)(lds + LDS_UNI);
    const int cur = t0 >> 6;
    unsigned selmask;
    {
        const bf16_t* kc = (const bf16_t*)(ws + WS_KCMP) + (size_t)bg * 128 * 64;
        const bf16_t* vc = kc + (size_t)16 * 128 * 64;
        __syncthreads();
        load_kv_tile(Kt, Vt, kc, vc, 0, 1, 0, 127, tid);
        load_kv_tile(Kt + KVT, Vt + VT, kc, vc, 64, 1, 0, 127, tid);
        if (tid == 0) uni[0] = 0u;
        __syncthreads();
        LAS const unsigned char* kp = Kt + c * KVS + 16 * h;
        f32x16 sT[4];
#pragma unroll
        for (int T = 0; T < 4; ++T) sT[T] = qk32(qf, kp + T * 32 * KVS, zero16());
        const float dAh = (float)(t - 31) - (float)(64 * h);
        float tmax = -1e30f;
#pragma unroll
        for (int T = 0; T < 4; ++T)
#pragma unroll
            for (int i = 0; i < 16; ++i) {
                const float d = dAh - (float)(16 * (32 * T + (i & 3) + 8 * (i >> 2)));
                float tv = sT[T][i] + ns2 * d;
                tv = d >= 0.f ? tv : -1e30f;
                sT[T][i] = tv; tmax = fmaxf(tmax, tv);
            }
        tmax = fmaxf(tmax, __shfl_xor(tmax, 32));
        const float mu = fmaxf(tmax, -1e29f);
        float ps = 0.f;
#pragma unroll
        for (int T = 0; T < 4; ++T)
#pragma unroll
            for (int i = 0; i < 16; ++i) { sT[T][i] = __builtin_amdgcn_exp2f(sT[T][i] - mu); ps += sT[T][i]; }
        ps += __shfl_xor(ps, 32);
        const float inv = ps > 0.f ? 1.0f / ps : 0.f;
#pragma unroll
        for (int T = 0; T < 4; ++T)
#pragma unroll
            for (int i = 0; i < 16; ++i) sT[T][i] *= inv;
        f32x16 o0 = zero16(), o1 = zero16();
        const int vq = (lane & 15) >> 2, vc0 = 2 * ((lane >> 4) & 1) + ((lane & 3) >> 1), vsx = 2 * vq;
        LAS const unsigned char* vp0 = Vt + (4 * h + vq) * VS + ((vc0 ^ vsx) * 16) + 8 * (lane & 1);
        LAS const unsigned char* vp1 = Vt + (4 * h + vq) * VS + (((vc0 + 4) ^ vsx) * 16) + 8 * (lane & 1);
#pragma unroll
        for (int T = 0; T < 4; ++T) pv32(o0, o1, sT[T], vp0 + T * 32 * VS, vp1 + T * 32 * VS);
#pragma unroll
        for (int i = 0; i < 16; ++i) { totL[i * 256] = g0 * o0[i]; totL[(16 + i) * 256] = g0 * o1[i]; }
        float mainv[16], spill[16];
#pragma unroll
        for (int T = 0; T < 4; ++T)
#pragma unroll
            for (int u = 0; u < 4; ++u) {
                const float p3 = 0.5f * sT[T][4 * u + 3];
                mainv[4 * T + u] = sT[T][4 * u] + sT[T][4 * u + 1] + sT[T][4 * u + 2] + p3;
                spill[4 * T + u] = p3;
            }
#pragma unroll
        for (int f = 0; f < 16; ++f) {
            mainv[f] += __shfl_xor(mainv[f], 8); mainv[f] += __shfl_xor(mainv[f], 16);
            spill[f] += __shfl_xor(spill[f], 8); spill[f] += __shfl_xor(spill[f], 16);
        }
#pragma unroll
        for (int f = 0; f < 16; ++f) {
            const float snd = h ? (f > 0 ? spill[f > 0 ? f - 1 : 0] : 0.f) : spill[f];
            const float rcv = __shfl_xor(snd, 32);
            mainv[f] += rcv;
        }
        if (hh == 0) {
#pragma unroll
            for (int f = 0; f < 16; ++f) impL[tok8 * 32 + 2 * f + h] = mainv[f];
        }
        asm volatile("s_waitcnt lgkmcnt(0)" ::: "memory");
        {
            const int tk = lane >> 3, tq = t0 + 8 * w + tk, cq = tq >> 6, n0 = 4 * (lane & 7);
            float sc[32];
#pragma unroll
            for (int q4 = 0; q4 < 8; ++q4) {
                const f32x4 v = *(const LAS f32x4*)(impL + tk * 32 + 4 * q4);
                sc[4 * q4] = v.x; sc[4 * q4 + 1] = v.y; sc[4 * q4 + 2] = v.z; sc[4 * q4 + 3] = v.w;
            }
#pragma unroll
            for (int n = 0; n < 32; ++n) {
                const bool valid = n <= cq, forced = (n == 0) || (cq - n < 2);
                sc[n] = valid ? sc[n] + (forced ? 1e4f : 0.f) : -1e30f;
            }
            unsigned bits = 0u;
#pragma unroll
            for (int k = 0; k < 4; ++k) {
                const int n = n0 + k;
                float mine = 0.f;
#pragma unroll
                for (int q = 0; q < 32; ++q) mine = (q == n) ? sc[q] : mine;
                int rank = 0;
#pragma unroll
                for (int q = 0; q < 32; ++q) rank += (sc[q] > mine || (sc[q] == mine && q < n)) ? 1 : 0;
                if (n <= cq && rank < 16) bits |= 1u << n;
            }
            bits |= __shfl_xor(bits, 1); bits |= __shfl_xor(bits, 2); bits |= __shfl_xor(bits, 4);
            selmask = __shfl(bits, tok8 * 8);
        }
        {
            unsigned um = selmask;
#pragma unroll
            for (int o = 1; o < 64; o <<= 1) um |= __shfl_xor(um, o);
            if (lane == 0) atomicOr((unsigned*)uni, um);
        }
        __syncthreads();
    }
    const unsigned ublk = uni[0];
    unsigned wsel = selmask;
#pragma unroll
    for (int o = 1; o < 64; o <<= 1) wsel |= __shfl_xor(wsel, o);
    int buf = 0;
    KVRegs kr;
    {
        const bf16_t* kb = (const bf16_t*)(ws + WS_KV6 + 2 * 4 * MiB) + (size_t)bg * NS * 64;
        const bf16_t* vb = (const bf16_t*)(ws + WS_KV6 + 3 * 4 * MiB) + (size_t)bg * NS * 64;
        f32x16 o0 = zero16(), o1 = zero16(); float m = -1e30f, l = 0.f;
        unsigned rem = ublk & (cur >= 31 ? 0xffffffffu : ((2u << cur) - 1u));
        int n = __builtin_ctz(rem);
        kv_fetch(kr, kb, vb, 64 * n, 1, 0, NS - 1, tid);
        while (rem) {
            rem &= rem - 1u;
            LAS unsigned char* Kc = lds + buf * KVT; LAS unsigned char* Vc = lds + 2 * KVT + buf * VT;
            kv_commit(kr, Kc, Vc, tid);
            __syncthreads();
            const int ncur = n;
            if (rem) { n = __builtin_ctz(rem); kv_fetch(kr, kb, vb, 64 * n, 1, 0, NS - 1, tid); }
            if ((wsel >> ncur) & 1u)
                fa_tile64<1, true>(o0, o1, m, l, qf, Kc, Vc, lane, (float)(t - 64 * ncur), ((selmask >> ncur) & 1u) ? 1e30f : -1.f, ns2);
            buf ^= 1;
        }
        const float lt = l + __shfl_xor(l, 32);
        { const float sc = g1 / lt;
#pragma unroll
          for (int i = 0; i < 16; ++i) { totL[i * 256] += sc * o0[i]; totL[(16 + i) * 256] += sc * o1[i]; } }
    }
    {
        const bf16_t* kb = (const bf16_t*)(ws + WS_KV6 + 4 * 4 * MiB) + (size_t)bg * NS * 64;
        const bf16_t* vb = (const bf16_t*)(ws + WS_KV6 + 5 * 4 * MiB) + (size_t)bg * NS * 64;
        f32x16 o0 = zero16(), o1 = zero16(); float m = -1e30f, l = 0.f;
        const int nlo = t0 >= 511 ? (t0 - 511) >> 6 : 0;
        kv_fetch(kr, kb, vb, 64 * nlo, 1, 0, NS - 1, tid);
        for (int n = nlo; n <= cur; ++n) {
            LAS unsigned char* Kc = lds + buf * KVT; LAS unsigned char* Vc = lds + 2 * KVT + buf * VT;
            kv_commit(kr, Kc, Vc, tid);
            __syncthreads();
            if (n < cur) kv_fetch(kr, kb, vb, 64 * (n + 1), 1, 0, NS - 1, tid);
            fa_tile64<1, true>(o0, o1, m, l, qf, Kc, Vc, lane, (float)(t - 64 * n), 511.f, ns2);
            buf ^= 1;
        }
        const float lt = l + __shfl_xor(l, 32);
        { const float sc = g2 / lt;
#pragma unroll
          for (int i = 0; i < 16; ++i) { o0[i] = totL[i * 256] + sc * o0[i]; o1[i] = totL[(16 + i) * 256] + sc * o1[i]; } }
        store_ot((bf16_t*)(ws + WS_O) + ((size_t)(b * NS + t) * ND + 512 + hb * 64), o0, o1, 1.0f, h);
    }
}

#define XB_TMO      128
#define XB_XCNT(j)  (256  + 64 * (j))
#define XB_XSUB(j)  (1280 + 64 * (j))
#define XB_XGEN(j)  (2304 + 64 * (j))
#define XB_TOP      3328
#define XB_TOPGEN   3392
#define XCD_BAR_WORDS 3456
#define XB_SPIN_CAP (1u << 18)
__device__ __forceinline__ unsigned xb_ld(unsigned* p)              { return __hip_atomic_load(p, __ATOMIC_RELAXED, __HIP_MEMORY_SCOPE_AGENT); }
__device__ __forceinline__ unsigned xb_add(unsigned* p, unsigned v) { return __hip_atomic_fetch_add(p, v, __ATOMIC_RELAXED, __HIP_MEMORY_SCOPE_AGENT); }
__device__ __forceinline__ unsigned xb_xcc_id() { return (unsigned)__builtin_amdgcn_s_getreg((3 << 11) | 20) & 0xFu; }
#define XB_SPIN(cond, bar) do { unsigned _sp = 0; while (cond) { __builtin_amdgcn_s_sleep(1); \
    if ((++_sp & 255u) == 0u) { if (xb_ld(&(bar)[XB_TMO])) break; if (_sp > XB_SPIN_CAP) { atomicAdd(&(bar)[XB_TMO], 1u); break; } } } } while (0)
struct XcdBarrier { unsigned* bar; unsigned x; volatile LAS unsigned* st; };
__device__ __forceinline__ XcdBarrier xcd_barrier_post(unsigned* bar, volatile LAS unsigned* st) {
    XcdBarrier b; b.bar = bar; b.x = xb_xcc_id(); b.st = st;
    if (threadIdx.x == 0) (void)xb_add(&bar[XB_XCNT(b.x)], 1u);
    return b;
}
__device__ __forceinline__ void xcd_barrier_complete(unsigned* bar, unsigned x, unsigned& nloc, unsigned& nx) {
    const unsigned G = gridDim.x * gridDim.y * gridDim.z;
    unsigned sum, cnt, mine, sp = 0u;
    for (;;) {
        sum = 0u; cnt = 0u; mine = 0u;
#pragma unroll
        for (unsigned j = 0; j < 16; ++j) { const unsigned c = xb_ld(&bar[XB_XCNT(j)]); sum += c; cnt += (c > 0u) ? 1u : 0u; mine = (j == x) ? c : mine; }
        if (sum == G) break;
        __builtin_amdgcn_s_sleep(1);
        if ((++sp & 255u) == 0u) { if (xb_ld(&bar[XB_TMO])) break; if (sp > XB_SPIN_CAP) { atomicAdd(&bar[XB_TMO], 1u); break; } }
    }
    nloc = mine > 0u ? mine : 1u; nx = cnt > 0u ? cnt : 1u;
}
__device__ __forceinline__ void xcd_barrier(const XcdBarrier& b) {
    asm volatile("s_waitcnt vmcnt(0)" ::: "memory");
    __syncthreads();
    if (threadIdx.x == 0) {
        unsigned* bar = b.bar;
        __builtin_amdgcn_s_waitcnt(0);
        unsigned nloc = b.st[0], nx = b.st[1];
        if (nloc == 0u) { xcd_barrier_complete(bar, b.x, nloc, nx); b.st[0] = nloc; b.st[1] = nx; }
        const unsigned old = xb_add(&bar[XB_XSUB(b.x)], 1u);
        const unsigned gen = old / nloc;
        if (old + 1u == (gen + 1u) * nloc) {
            __builtin_amdgcn_fence(__ATOMIC_RELEASE, "agent");
            asm volatile("s_waitcnt vmcnt(0)" ::: "memory");
            const unsigned og = xb_add(&bar[XB_TOP], 1u);
            const unsigned tg = og / nx;
            if (og + 1u == (tg + 1u) * nx) xb_add(&bar[XB_TOPGEN], 1u);
            else XB_SPIN(xb_ld(&bar[XB_TOPGEN]) == tg, bar);
            __builtin_amdgcn_fence(__ATOMIC_ACQUIRE, "agent");
            xb_add(&bar[XB_XGEN(b.x)], 1u);
            asm volatile("s_waitcnt vmcnt(0)" ::: "memory");
        } else {
            XB_SPIN(xb_ld(&bar[XB_XGEN(b.x)]) == gen, bar);
            __builtin_amdgcn_fence(__ATOMIC_ACQUIRE, "agent");
            asm volatile("s_waitcnt vmcnt(0)" ::: "memory");
        }
    }
    __syncthreads();
}

struct XcdTiles {
    int m_lo, cnt_m, nN, loc, nloc, tiles;
    __device__ __forceinline__ XcdTiles(int nM, int nN_) {
        const int b = BID(), g = gridDim.x;
        int x, nx;
        if ((g & 7) == 0) { x = b & 7; nx = 8; loc = b >> 3; nloc = g >> 3; } else { x = 0; nx = 1; loc = b; nloc = g; }
        m_lo = (int)((long)nM * x / nx); cnt_m = (int)((long)nM * (x + 1) / nx) - m_lo; nN = nN_; tiles = cnt_m * nN;
    }
    __device__ __forceinline__ void get(int q, int& mt, int& nt) const {
        const int mg = q / (8 * nN), rem_m = cnt_m - 8 * mg, mig = rem_m < 8 ? rem_m : 8, r = q - mg * 8 * nN;
        nt = r / mig; mt = m_lo + 8 * mg + (r - nt * mig);
    }
};
struct PhInProj { const bf16_t* xn; const unsigned char* wl; unsigned char* ws; const float* ssp; XcdTiles xt;
    __device__ __forceinline__ void make(int q, APlain& ap, BPlain& bp, EpiInProj& ep) const { int mt, nt; xt.get(q, mt, nt);
        ap = APlain{xn + (size_t)mt * 128 * ND, ND}; bp = BPlain{(const bf16_t*)(wl + WL_IN) + (size_t)nt * 128 * ND, ND}; ep = EpiInProj{mt, nt, ws, ssp}; } };
struct PhCmp1 { const unsigned char* wl; unsigned char* ws; int l;
    __device__ __forceinline__ void make(int tile, ACmp& ap, BPlain& bp, EpiCmp1& ep) const { const int nt = tile & 1, bg = (tile >> 1) & 15, kv = tile >> 5;
        ap = ACmp{(const bf16_t*)(ws + WS_KV6 + (size_t)kv * 4 * MiB) + (size_t)bg * NS * 64};
        bp = BPlain{(const bf16_t*)(wl + WL_C1) + (size_t)kv * 256 * 2048 + (size_t)nt * 128 * 2048, 2048};
        ep = EpiCmp1{(bf16_t*)(ws + WS_HC) + (size_t)kv * 2048 * 256, (const float*)(ws + WS_BC1P) + l * 512 + kv * 256, bg * 128, nt * 128}; } };
struct PhCmp2 { const unsigned char* wl; unsigned char* ws;
    __device__ __forceinline__ void make(int tile, APlain& ap, BPlain& bp, EpiCmp2& ep) const { const int bg = tile & 15, kv = tile >> 4;
        ap = APlain{(const bf16_t*)(ws + WS_HC) + (size_t)kv * 2048 * 256 + (size_t)bg * 128 * 256, 256};
        bp = BPlain{(const bf16_t*)(wl + WL_C2) + (size_t)kv * 128 * 256, 256};
        ep = EpiCmp2{(bf16_t*)(ws + WS_KCMP) + (size_t)kv * 16 * 128 * 64, bg * 128}; } };
struct PhOutProj { const unsigned char* wl; unsigned char* ws; bf16_t* res; XcdTiles xt;
    __device__ __forceinline__ void make(int q, APlain& ap, BPlain& bp, EpiResAdd& ep) const { int mt, nt; xt.get(q, mt, nt);
        ap = APlain{(const bf16_t*)(ws + WS_O) + (size_t)mt * 128 * ND, ND}; bp = BPlain{(const bf16_t*)(wl + WL_OUT) + (size_t)nt * 128 * ND, ND};
        ep = EpiResAdd{res, mt * 128, nt * 128}; } };
struct PhMoe {
    LAS const int* sm; const int* list;
    __device__ __forceinline__ void decode(int gmt, int& bk, int& mt, int& rem, int& hrow0, int& elo, int& ehi) const {
        bk = 0;
        for (int k = 1; k < 24; ++k) if (gmt >= sm[32 + k]) bk = k;
        mt = gmt - sm[32 + bk]; rem = sm[bk] - mt * 128; hrow0 = sm[64 + bk] + mt * 128;
        const int grp = bk / 6, pi = bk % 6;
        elo = grp * 4 + (pi < 3 ? 0 : (pi < 5 ? 1 : 2)); ehi = grp * 4 + (pi < 3 ? pi + 1 : (pi < 5 ? pi - 1 : 3));
    } };
struct PhMoeGU { PhMoe m; const bf16_t* xn; const unsigned char* wl; unsigned char* ws; const float* route; const float* rinv; XcdTiles xt;
    __device__ __forceinline__ void make(int q, AGather& ap, BPlain& bp, EpiMoeGU& ep) const { int gmt, nt16; xt.get(q, gmt, nt16);
        int bk, mt, rem, hrow0, elo, ehi; m.decode(gmt, bk, mt, rem, hrow0, elo, ehi);
        const int* lst = m.list + (size_t)bk * NT + mt * 128; const int e = (nt16 >> 3) ? ehi : elo;
        ap = AGather{xn, lst, rem}; bp = BPlain{(const bf16_t*)(wl + WL_GU) + (size_t)e * 1024 * 1024 + (size_t)(nt16 & 7) * 128 * 1024, 1024};
        ep = EpiMoeGU{(bf16_t*)(ws + WS_HID), lst, route, rinv, rem, hrow0, nt16}; } };
struct PhMoeDown { PhMoe m; const unsigned char* wl; unsigned char* ws; bf16_t* res; float* ssp; XcdTiles xt;
    __device__ __forceinline__ void make(int q, APlain& ap, BSplit& bp, EpiMoeDown& ep) const { int gmt, nt; xt.get(q, gmt, nt);
        int bk, mt, rem, hrow0, elo, ehi; m.decode(gmt, bk, mt, rem, hrow0, elo, ehi);
        const int* lst = m.list + (size_t)bk * NT + mt * 128;
        ap = APlain{(const bf16_t*)(ws + WS_HID) + (size_t)hrow0 * 1024, 1024};
        bp = BSplit{(const bf16_t*)(wl + WL_DN) + (size_t)elo * 1024 * 512 + (size_t)nt * 128 * 512, (const bf16_t*)(wl + WL_DN) + (size_t)ehi * 1024 * 512 + (size_t)nt * 128 * 512};
        ep = EpiMoeDown{res, lst, ssp, rem, nt * 128}; } };
struct PhPleProj { const unsigned char* wl; unsigned char* ws; XcdTiles xt;
    __device__ __forceinline__ void make(int q, APlain& ap, BPlain& bp, EpiBf16& ep) const { int mt, nt; xt.get(q, mt, nt);
        ap = APlain{(const bf16_t*)(ws + WS_PB) + (size_t)mt * 128 * 256, 256}; bp = BPlain{(const bf16_t*)(wl + WL_PP) + (size_t)nt * 128 * 256, 256};
        ep = EpiBf16{(bf16_t*)(ws + WS_P2), ND, mt * 128, nt * 128}; } };
struct PhPleGate { const bf16_t* xn; const unsigned char* wl; unsigned char* ws; float* out; float sc; XcdTiles xt;
    __device__ __forceinline__ void make(int q, APlain& ap, BPlain& bp, EpiPleGate& ep) const { int mt, nt; xt.get(q, mt, nt);
        ap = APlain{xn + (size_t)mt * 128 * ND, ND}; bp = BPlain{(const bf16_t*)(wl + WL_PG) + (size_t)nt * 128 * ND, ND};
        ep = EpiPleGate{out, (const bf16_t*)(ws + WS_P2), mt * 128, nt * 128, sc}; } };

constexpr int LDS_QSLOT = 73856 + 16 + 448;
__device__ __forceinline__ int wq_next(int* head, LAS unsigned char* lds) {
    LAS int* slot = (LAS int*)(lds + LDS_QSLOT);
    __syncthreads();
    if (threadIdx.x == 0) *slot = atomicAdd(head, 1);
    __syncthreads();
    return *slot;
}
__device__ __forceinline__ void ple_stream(const bf16_t* xn, const bf16_t* pb, const unsigned char* wl, const float* ssp_in, bf16_t* rout, float* ssp_out, LAS unsigned char* lds) {
    const XcdTiles xt(128, 8);
    int q = xt.loc;
    if (q >= xt.tiles) return;
    const int tid = TID(), wid = tid >> 6, lane = tid & 63, wr = wid >> 1, wc = wid & 1, fr = lane & 15, fq = lane >> 4;
    int mt, nt; xt.get(q, mt, nt);
    bool pref = false;
    for (;;) {
        const int qn = q + xt.nloc; const bool hn = qn < xt.tiles;
        int mtn = mt, ntn = nt; if (hn) xt.get(qn, mtn, ntn);
        const APlain ap1{pb + (size_t)mt * 128 * 256, 256}; const BPlain bp1{(const bf16_t*)(wl + WL_PP) + (size_t)nt * 128 * 256, 256};
        const APlain ap2{xn + (size_t)mt * 128 * ND, ND};   const BPlain bp2{(const bf16_t*)(wl + WL_PG) + (size_t)nt * 128 * ND, ND};
        const APlain apn{pb + (size_t)mtn * 128 * 256, 256}; const BPlain bpn{(const bf16_t*)(wl + WL_PP) + (size_t)ntn * 128 * 256, 256};
        f32x4 acc[4][4], acc2[4][4]; zero_acc(acc); zero_acc(acc2);
        gemm_kloop(acc2, ap1, bp1, 256, lds, pref, true, ap2, bp2);
        gemm_kloop(acc, ap2, bp2, ND, lds, true, hn, apn, bpn);
        const EpiPleFused ep{xn, ssp_in, rout, ssp_out, mt * 128, nt * 128};
        ep(acc, acc2, wr, wc, fr, fq);
        if (!hn) break;
        q = qn; mt = mtn; nt = ntn; pref = true;
    }
}

constexpr int LDS_BAR = 73856;
constexpr int LDS_SM = LDS_BAR + 16;
constexpr int LDS_BYTES = LDS_SM + 512;
static_assert(LDS_QSLOT == LDS_SM + 448, "queue slot");
static_assert(4 * KVT + 4096 + 64 <= LDS_TOT && LDS_TOT + 32768 <= LDS_BAR && 65536 <= LDS_BAR, "LDS map");

__global__ void __launch_bounds__(256, 2) mega_fwd(Params p) {
    extern __shared__ __attribute__((aligned(16))) unsigned char lds_raw[];
    LAS unsigned char* lds = (LAS unsigned char*)lds_raw;
    unsigned char* ws = p.ws;
    const int tid = threadIdx.x;
    const int gtid = blockIdx.x * 256 + tid, gthreads = gridDim.x * 256;
    int* ctl = (int*)(ws + WS_CTL);
    {
        volatile LAS unsigned* st = (volatile LAS unsigned*)(lds + LDS_BAR);
        if (tid < 4) st[tid] = 0u;
        __syncthreads();
    }
    const XcdBarrier gbar = xcd_barrier_post((unsigned*)ctl + CW_BAR, (volatile LAS unsigned*)(lds + LDS_BAR));

    phase_convert(p, (LAS float*)lds);
    xcd_barrier(gbar);

    float* sspA = (float*)(ws + WS_SSP);
    float* sspB = sspA + (size_t)NT * 16;
    float* rinv = (float*)(ws + WS_RINV);
    for (int l = 0; l < 2; ++l) {
        const unsigned char* wl = ws + WS_W + (size_t)l * WL_SIZE;
        bf16_t* xn = (bf16_t*)p.out + (size_t)(l & 1) * NT * ND;
        bf16_t* rnext = l == 1 ? (bf16_t*)(ws + WS_XN) : (bf16_t*)p.out + (size_t)((l + 1) & 1) * NT * ND;
        const bf16_t* xb_in = xn;
        {
            const PhInProj ph{xb_in, wl, ws, sspB, XcdTiles(128, 23)};
            gemm_stream<PhInProj, APlain, BPlain, EpiInProj>(ph, ph.xt.loc, ph.xt.nloc, ph.xt.tiles, ND, lds);
        }
        xcd_barrier(gbar);
        {
            int* qh = ctl + CW_Q + (l * 4 + 0) * 64;
            int* ch = ctl + CW_Q + (l * 4 + 2) * 64;
            const int nconv = conv_queue_strips(2 * l);
            const PhCmp1 ph{wl, ws, l};
            bool conv_left = nconv > 0, att_left = true, first_att = true;
            for (int k = 0; conv_left || att_left; ++k) {
                const bool want_conv = conv_left && (!att_left || (k % 7) == 6);
                if (want_conv) {
                    const int c = wq_next(ch, lds);
                    if (c < nconv) conv_strip(p, 2 * l, c, (LAS float*)lds); else conv_left = false;
                } else {
                    const int it = first_att ? BID() : (int)gridDim.x + wq_next(qh, lds);
                    first_att = false;
                    if (it >= 64 + 1536) att_left = false;
                    else if (it < 64) { ACmp ap; BPlain bp; EpiCmp1 ep; ph.make(it, ap, bp, ep); gemm_tile(ap, bp, 2048, ep, lds, false, false, ap, bp); }
                    else { dil_item(ws, 2 * (it - 64), lds); __syncthreads(); dil_item(ws, 2 * (it - 64) + 1, lds); }
                }
            }
        }
        xcd_barrier(gbar);
        { const PhCmp2 ph{wl, ws}; gemm_stream<PhCmp2, APlain, BPlain, EpiCmp2>(ph, BID(), gridDim.x, 32, 256, lds); }
        dil_merge(ws, gtid, gthreads);
        if (l == 0) convert_p(p);
        xcd_barrier(gbar);
        {
            int* qh = ctl + CW_Q + (l * 4 + 1) * 64;
            int* ch = ctl + CW_Q + (l * 4 + 3) * 64;
            const int nconv = conv_queue_strips(2 * l + 1);
            bool conv_left = nconv > 0, att_left = true, first_att = true;
            for (int k = 0; conv_left || att_left; ++k) {
                const bool want_conv = conv_left && (!att_left || (k % 4) == 3);
                if (want_conv) {
                    const int c = wq_next(ch, lds);
                    if (c < nconv) conv_strip(p, 2 * l + 1, c, (LAS float*)lds); else conv_left = false;
                } else {
                    const int it = first_att ? BID() : (int)gridDim.x + wq_next(qh, lds);
                    first_att = false;
                    if (it >= 1024) att_left = false;
                    else nsa_item(ws, ((63 - (it >> 4)) << 4) | (it & 15), lds);
                }
            }
        }
        xcd_barrier(gbar);
        { const PhOutProj ph{wl, ws, xn, XcdTiles(128, 8)};
          gemm_stream<PhOutProj, APlain, BPlain, EpiResAdd>(ph, ph.xt.loc, ph.xt.nloc, ph.xt.tiles, ND, lds); }
        xcd_barrier(gbar);
        int* cnt = ctl + CW_CNTP + l * 1536;
        int* list = (int*)(ws + WS_LIST);
        float* route = (float*)(ws + WS_ROUTE);
        phase_route(xn, (const float*)(wl + WL_RT), p.in[12] + l * 4, p.in[14] + l * 16, cnt, list, route, rinv, lds);
        xcd_barrier(gbar);
        LAS int* sm = (LAS int*)(lds + LDS_SM);
        __syncthreads();
        if (tid < 24) sm[tid] = __hip_atomic_load(cnt + 64 * tid, __ATOMIC_RELAXED, __HIP_MEMORY_SCOPE_AGENT);
        __syncthreads();
        if (tid == 0) {
            int tp = 0, hb = 0;
            for (int k = 0; k < 24; ++k) {
                const int c = sm[k];
                sm[32 + k] = tp; sm[64 + k] = hb;
                const int nt_ = (c + 127) >> 7; tp += nt_; hb += nt_ * 128;
            }
            sm[32 + 24] = tp;
        }
        __syncthreads();
        const int total_mt = sm[32 + 24];
        { const PhMoeGU ph{PhMoe{sm, list}, xn, wl, ws, route, rinv, XcdTiles(total_mt, 16)};
          gemm_stream<PhMoeGU, AGather, BPlain, EpiMoeGU>(ph, ph.xt.loc, ph.xt.nloc, ph.xt.tiles, ND, lds); }
        xcd_barrier(gbar);
        { const PhMoeDown ph{PhMoe{sm, list}, wl, ws, xn, sspA, XcdTiles(total_mt, 8)};
          gemm_stream<PhMoeDown, APlain, BSplit, EpiMoeDown>(ph, ph.xt.loc, ph.xt.nloc, ph.xt.tiles, ND, lds); }
        xcd_barrier(gbar);
        ple_stream(xn, (const bf16_t*)(ws + WS_PBALL) + (size_t)l * NT * 256, wl, sspA, rnext, sspB, lds);
        xcd_barrier(gbar);
    }
    phase_final_norm((const bf16_t*)(ws + WS_XN), p.out, p.in[21]);
}

extern "C" void kernel_launch(void* const* d_in, const int* in_sizes, int n_in, void* d_out, int out_size, void* d_ws, size_t ws_size, hipStream_t stream) {
    static int grid = 0;
    if (grid == 0) {
        if (n_in != 22 || out_size != NT * ND || ws_size < WS_END) { fprintf(stderr, "kernel_launch: unexpected shapes (n_in %d out %d ws %zu)\n", n_in, out_size, ws_size); grid = -1; return; }
        int dev = 0, cus = 0, per_cu = 0;
        hipGetDevice(&dev);
        hipDeviceGetAttribute(&cus, hipDeviceAttributeMultiprocessorCount, dev);
        if (hipFuncSetAttribute((const void*)mega_fwd, hipFuncAttributeMaxDynamicSharedMemorySize, LDS_BYTES) != hipSuccess) { fprintf(stderr, "kernel_launch: hipFuncSetAttribute failed\n"); grid = -1; return; }
        hipOccupancyMaxActiveBlocksPerMultiprocessor(&per_cu, (const void*)mega_fwd, 256, LDS_BYTES);
        if (per_cu < 1) { fprintf(stderr, "kernel_launch: occupancy query says %d\n", per_cu); grid = -1; return; }
        if (per_cu > 2) per_cu = 2;
        grid = cus * per_cu;
    }
    if (grid < 0) return;
    hipMemsetAsync((char*)d_ws + WS_CTL, 0, 32768, stream);
    Params p{};
    for (int i = 0; i < 22; ++i) p.in[i] = (const float*)d_in[i];
    p.out = (float*)d_out; p.ws = (unsigned char*)d_ws;
    hipLaunchKernelGGL(mega_fwd, dim3(grid), dim3(256), LDS_BYTES, stream, p);
    const hipError_t e = hipPeekAtLastError();
    if (e != hipSuccess) fprintf(stderr, "launch failed: %s (grid %d)\n", hipGetErrorString(e), grid);
}
```

```cpp
#include <hip/hip_runtime.h>
#include <cstdio>
#include <cstdint>

#ifndef NAIVE_GEMM
#define NAIVE_GEMM 0
#endif
#ifndef NAIVE_ATTN
#define NAIVE_ATTN 0
#endif
#define REP_CONV 1
#define REP_INPROJ 1
#define REP_ATTN 1
#define REP_GU 1
#define REP_NORM 1
#define REP_ROUTE 1
#define REP_DOWN 1
#define REP_OUTPROJ 1
#define REP_PG 1
#define REP_CMP 1
#define REP_MISC 1

#define LAS __attribute__((address_space(3)))
typedef unsigned short bf16_t;
typedef short bf16x8 __attribute__((ext_vector_type(8)));
typedef float f32x4 __attribute__((ext_vector_type(4)));
typedef unsigned u32x4 __attribute__((ext_vector_type(4)));
typedef unsigned u32x2 __attribute__((ext_vector_type(2)));
typedef float f32x16 __attribute__((ext_vector_type(16)));
typedef short s16x4 __attribute__((ext_vector_type(4)));
typedef float f32x2_t __attribute__((ext_vector_type(2)));
typedef __bf16 bf16x2_t __attribute__((ext_vector_type(2)));

constexpr int NB = 8, NS = 2048, ND = 1024, NT = NB * NS;
constexpr int NIN = 2840, NINP = 2944;
constexpr size_t MiB = (size_t)1 << 20;
constexpr size_t WL_IN = 0;
constexpr size_t WL_OUT = WL_IN + (size_t)NINP * 1024 * 2;
constexpr size_t WL_C1 = WL_OUT + (size_t)1024 * 1024 * 2;
constexpr size_t WL_C2 = WL_C1 + (size_t)2 * 256 * 2048 * 2;
constexpr size_t WL_GU = WL_C2 + (size_t)2 * 128 * 256 * 2;
constexpr size_t WL_DN = WL_GU + (size_t)16 * 1024 * 1024 * 2;
constexpr size_t WL_PG = WL_DN + (size_t)16 * 1024 * 512 * 2;
constexpr size_t WL_PP = WL_PG + (size_t)1024 * 1024 * 2;
constexpr size_t WL_BC1 = WL_PP + (size_t)1024 * 256 * 2;
constexpr size_t WL_RT = WL_BC1 + 2048;
constexpr size_t WL_SIZE = 64 * MiB;
static_assert(WL_RT + 131072 <= WL_SIZE, "weight block");
constexpr size_t WS_CTL = 0;
constexpr size_t WS_W = 1 * MiB;
constexpr size_t WS_XN = WS_W + 2 * WL_SIZE;
constexpr size_t WS_PROJ = WS_XN + 32 * MiB;
constexpr size_t WS_QA = WS_PROJ, WS_KA = WS_QA + 16 * MiB, WS_VA = WS_KA + 16 * MiB, WS_QB = WS_VA + 16 * MiB;
constexpr size_t WS_KV6 = WS_QB + 16 * MiB;
constexpr size_t WS_GATES = WS_KV6 + 24 * MiB;
constexpr size_t WS_PROJ_END = WS_GATES + 2 * MiB;
constexpr size_t WS_HID = WS_PROJ;
constexpr size_t WS_P2 = WS_PROJ + 40 * MiB;
constexpr size_t WS_PB = WS_PROJ + 72 * MiB;
constexpr size_t WS_HC = WS_PROJ_END;
constexpr size_t WS_KCMP = WS_HC + 2 * MiB;
constexpr size_t WS_MASK = WS_KCMP + 512 * 1024;
constexpr size_t WS_ROUTE = WS_MASK + 128 * 1024;
constexpr size_t WS_LIST = WS_ROUTE + 128 * 1024;
constexpr size_t WS_O = WS_LIST + 1536 * 1024 + 256 * 1024;
constexpr size_t WS_IMPH = WS_O + 32 * MiB;
constexpr size_t WS_OPA01 = WS_XN;
constexpr size_t WS_OPA2 = WS_IMPH;
constexpr size_t WS_STA = WS_IMPH + 16 * MiB;
constexpr size_t WS_PBALL = WS_IMPH + 20 * MiB;
constexpr size_t WS_SSP = WS_PBALL + 16 * MiB;
constexpr size_t WS_RINV = WS_MASK;
constexpr size_t WS_BC1P = WS_SSP + 2 * MiB;
constexpr size_t WS_END = WS_BC1P + 64 * 1024;
static_assert(WS_PB + 8 * MiB <= WS_PROJ_END, "alias map");
static_assert(WS_END <= 330 * MiB, "workspace");
constexpr int HID_ROWS = NT + 24 * 128;
constexpr int CW_BAR = 1024;
constexpr int CW_Q = 256;
constexpr int CW_CNTP = 4608;
constexpr int CW_CNT = 64;

struct Params {
    const float* in[22];
    float* out;
    unsigned char* ws;
};

__device__ __forceinline__ unsigned f2bf(float f) { unsigned u = __float_as_uint(f); return (u + 0x7fffu + ((u >> 16) & 1u)) >> 16; }
__device__ __forceinline__ unsigned pk2(float lo, float hi) { return f2bf(lo) | (f2bf(hi) << 16); }
__device__ __forceinline__ float bflo(unsigned v) { return __uint_as_float(v << 16); }
__device__ __forceinline__ float bfhi(unsigned v) { return __uint_as_float(v & 0xffff0000u); }
__device__ __forceinline__ float wave_sum(float v) {
#pragma unroll
    for (int o = 1; o < 64; o <<= 1) v += __shfl_xor(v, o);
    return v;
}
__device__ __forceinline__ int TID() { int t = threadIdx.x; asm volatile("" : "+v"(t)); return t; }
__device__ __forceinline__ int BID() { int t = blockIdx.x; asm volatile("" : "+s"(t)); return t; }
__device__ __forceinline__ float sigmoidf_(float x) { return 1.0f / (1.0f + __expf(-x)); }
__device__ __forceinline__ float gelu_tanh(float x) {
    const float u = 0.7978845608028654f * (x + 0.044715f * x * x * x);
    const float e = __expf(2.0f * u);
    const float th = 1.0f - 2.0f / (e + 1.0f);
    return 0.5f * x * (1.0f + th);
}

struct ConvJob { const float* src; bf16_t* dst; const float* gain; int K, N, NP, map, per; size_t dst_bstride; };
__device__ __forceinline__ int conv_job_tiles(int j) { return j == 0 ? 736 : (j == 1 || j == 9) ? 256 : (j == 2 || j == 3) ? 128 : (j == 4 || j == 5) ? 8 : j == 10 ? 64 : 2048; }
__device__ __forceinline__ ConvJob conv_job(const Params& p, int l, int j) {
    unsigned char* wl = p.ws + WS_W + (size_t)l * WL_SIZE;
    ConvJob c; c.map = 0; c.dst_bstride = 0; c.gain = nullptr;
    switch (j) {
    case 0: c.src = p.in[3] + (size_t)l * 1024 * NIN; c.K = 1024; c.N = NIN; c.NP = NINP; c.dst = (bf16_t*)(wl + WL_IN); c.gain = p.in[2] + l * ND; break;
    case 1: c.src = p.in[4] + (size_t)l * 1024 * 1024; c.K = 1024; c.N = 1024; c.NP = 1024; c.dst = (bf16_t*)(wl + WL_OUT); break;
    case 2: c.src = p.in[5] + (size_t)l * 2048 * 256; c.K = 2048; c.N = 256; c.NP = 256; c.dst = (bf16_t*)(wl + WL_C1); break;
    case 3: c.src = p.in[7] + (size_t)l * 2048 * 256; c.K = 2048; c.N = 256; c.NP = 256; c.dst = (bf16_t*)(wl + WL_C1) + (size_t)256 * 2048; break;
    case 4: c.src = p.in[6] + (size_t)l * 256 * 64; c.K = 256; c.N = 64; c.NP = 128; c.dst = (bf16_t*)(wl + WL_C2); break;
    case 5: c.src = p.in[8] + (size_t)l * 256 * 64; c.K = 256; c.N = 64; c.NP = 128; c.dst = (bf16_t*)(wl + WL_C2) + (size_t)128 * 256; break;
    case 6: c.src = p.in[15] + (size_t)l * 16 * 1024 * 512; c.K = 1024; c.N = 512; c.NP = 512; c.dst = (bf16_t*)(wl + WL_GU); c.map = 1; c.dst_bstride = (size_t)1024 * 1024; c.gain = p.in[10] + l * ND; break;
    case 7: c.src = p.in[16] + (size_t)l * 16 * 1024 * 512; c.K = 1024; c.N = 512; c.NP = 512; c.dst = (bf16_t*)(wl + WL_GU); c.map = 2; c.dst_bstride = (size_t)1024 * 1024; c.gain = p.in[10] + l * ND; break;
    case 8: c.src = p.in[17] + (size_t)l * 16 * 512 * 1024; c.K = 512; c.N = 1024; c.NP = 1024; c.dst = (bf16_t*)(wl + WL_DN); c.dst_bstride = (size_t)1024 * 512; break;
    case 9: c.src = p.in[19] + (size_t)l * 1024 * 1024; c.K = 1024; c.N = 1024; c.NP = 1024; c.dst = (bf16_t*)(wl + WL_PG); c.gain = p.in[18] + l * ND; break;
    default: c.src = p.in[20] + (size_t)l * 256 * 1024; c.K = 256; c.N = 1024; c.NP = 1024; c.dst = (bf16_t*)(wl + WL_PP); break;
    }
    c.per = (c.K / 64) * (c.NP / 64);
    return c;
}
__device__ __forceinline__ void convert_tiles(const ConvJob& c, int t0, int t1, LAS float* tl) {
    const int tid = TID();
    const int ntiles = c.NP / 64;
    const int kr = tid >> 4, c4 = (tid & 15) * 4;
    f32x4 v[4]; float gv[4];
#define CT_LOAD(it_) do { const int _bi = (it_) / c.per, _r = (it_) - _bi * c.per, _kt = _r / ntiles, _nt = _r - _kt * ntiles; \
        const int _n = _nt * 64 + c4; const bool _ok = _n < c.N; \
        const float* _sp = c.src + (size_t)_bi * c.K * c.N + (size_t)(_kt * 64 + kr) * c.N + (_ok ? _n : 0); \
        _Pragma("unroll") for (int _i = 0; _i < 4; ++_i) v[_i] = *(const f32x4*)(_sp + (size_t)(16 * _i) * c.N); \
        if (c.gain) { _Pragma("unroll") for (int _i = 0; _i < 4; ++_i) gv[_i] = c.gain[_kt * 64 + kr + 16 * _i]; } \
        else { _Pragma("unroll") for (int _i = 0; _i < 4; ++_i) gv[_i] = 1.0f; } \
        if (!_ok) { _Pragma("unroll") for (int _i = 0; _i < 4; ++_i) gv[_i] = 0.f; } } while (0)
    CT_LOAD(t0);
    for (int it = t0; it < t1; ++it) {
        const int bi = it / c.per, r = it - bi * c.per, kt = r / ntiles, nt = r - kt * ntiles;
        bf16_t* d = c.dst + (size_t)bi * c.dst_bstride;
        const int k0 = kt * 64, n0 = nt * 64;
        __syncthreads();
#pragma unroll
        for (int i = 0; i < 4; ++i) {
            LAS float* tp = tl + (kr + 16 * i) * 65 + c4;
            tp[0] = v[i].x * gv[i]; tp[1] = v[i].y * gv[i]; tp[2] = v[i].z * gv[i]; tp[3] = v[i].w * gv[i];
        }
        if (it + 1 < t1) CT_LOAD(it + 1);
        __syncthreads();
        const int n = tid >> 2, kc = (tid & 3) * 16;
        const int nsrc = n0 + n;
        const int row = (c.map == 0) ? nsrc : ((nsrc >> 4) * 32 + (nsrc & 15) + (c.map == 2 ? 16 : 0));
        float w[16];
#pragma unroll
        for (int j = 0; j < 16; ++j) w[j] = tl[(kc + j) * 65 + n];
        u32x4 o0, o1;
        o0.x = pk2(w[0], w[1]); o0.y = pk2(w[2], w[3]); o0.z = pk2(w[4], w[5]); o0.w = pk2(w[6], w[7]);
        o1.x = pk2(w[8], w[9]); o1.y = pk2(w[10], w[11]); o1.z = pk2(w[12], w[13]); o1.w = pk2(w[14], w[15]);
        bf16_t* dp = d + (size_t)row * c.K + k0 + kc;
        *(u32x4*)dp = o0; *(u32x4*)(dp + 8) = o1;
    }
#undef CT_LOAD
}
__device__ __forceinline__ int conv_list(int q, int i) {
    if (q == 0) return i == 0 ? 6 : (i == 1 ? 7 : -1);
    if (q == 1) return i == 0 ? 8 : i == 1 ? 9 : i == 2 ? 10 : i == 3 ? 16 : i == 4 ? 18 : i == 5 ? 19 : i == 6 ? 20 : i == 7 ? 21 : -1;
    if (q == 2) return i == 0 ? 17 : i == 1 ? 22 : i == 2 ? 23 : -1;
    return i == 0 ? 24 : i == 1 ? 25 : i == 2 ? 26 : -1;
}
__device__ __forceinline__ int conv_queue_strips(int q) {
    int n = 0;
    for (int i = 0; i < 8; ++i) { const int e = conv_list(q, i); if (e < 0) break; n += conv_job_tiles(e & 15) >> 3; }
    return n;
}
__device__ __forceinline__ void conv_strip(const Params& p, int q, int c, LAS float* tl) {
    for (int i = 0; i < 8; ++i) {
        const int e = conv_list(q, i);
        if (e < 0) return;
        const int ns = conv_job_tiles(e & 15) >> 3;
        if (c < ns) { const ConvJob job = conv_job(p, e >> 4, e & 15); convert_tiles(job, c * 8, c * 8 + 8, tl); return; }
        c -= ns;
    }
}

__device__ __forceinline__ void convert_p(const Params& p) {
    const f32x4* pl = (const f32x4*)p.in[1]; u32x2* pb = (u32x2*)(p.ws + WS_PBALL);
    for (int i = BID() * 256 + TID(); i < 2 * NT * 256 / 4; i += gridDim.x * 256) {
        const f32x4 v = pl[i]; u32x2 w; w.x = pk2(v.x, v.y); w.y = pk2(v.z, v.w); pb[i] = w;
    }
}
__device__ __forceinline__ void phase_convert(const Params& p, LAS float* tl) {
    {
        int base = 0;
        for (int j = 0; j < 6; ++j) {
            const ConvJob job = conv_job(p, 0, j);
            const int nt = conv_job_tiles(j);
            const int g = gridDim.x, b = BID();
            int first = (b - base % g + g) % g;
            for (int s = first; s < nt; s += g) convert_tiles(job, s, s + 1, tl);
            base += nt;
        }
    }
    {
        const int skip = gridDim.x >= 128 ? 64 : 0;
        const int tid_ = TID(); const int lane = tid_ & 63, gw = (BID() - skip) * 4 + (tid_ >> 6), ngw = (gridDim.x - skip) * 4;
        for (int row = gw >= 0 ? gw : NT; row < NT; row += ngw) {
            const f32x4* xr = (const f32x4*)(p.in[0] + (size_t)row * ND) + lane;
            u32x2* o = (u32x2*)((bf16_t*)p.out + (size_t)row * ND) + lane;
            float ss = 0.f;
#pragma unroll
            for (int j = 0; j < 4; ++j) { const f32x4 v = xr[64 * j]; ss += (v.x * v.x + v.y * v.y) + (v.z * v.z + v.w * v.w); u32x2 w; w.x = pk2(v.x, v.y); w.y = pk2(v.z, v.w); o[64 * j] = w; }
            ss = wave_sum(ss);
            if (lane < 16) ((float*)(p.ws + WS_SSP) + (size_t)NT * 16)[(size_t)row * 16 + lane] = lane == 0 ? ss : 0.f;
        }
    }
    for (int i = BID() * 256 + TID(); i < 2 * 1024 * 32; i += gridDim.x * 256) {
        const int l = i >> 15, k = (i >> 5) & 1023, j = i & 31;
        const float gk = p.in[10][l * ND + k];
        const float wv = j < 4 ? p.in[11][(size_t)(l * ND + k) * 4 + j] : (j < 20 ? p.in[13][(size_t)(l * ND + k) * 16 + (j - 4)] : 0.f);
        ((float*)(p.ws + WS_W + (size_t)l * WL_SIZE + WL_RT))[k * 32 + j] = gk * wv;
    }
    for (int i = BID() * 256 + TID(); i < 16 * 1024; i += gridDim.x * 256) {
        const int part = i >> 10, o = i & 1023, l = o >> 9, kv = (o >> 8) & 1, n = o & 255;
        const float* pos = p.in[9] + (size_t)(l * 2 + kv) * 2048 + part * 128;
        const float* w1 = p.in[kv ? 7 : 5] + (size_t)l * 2048 * 256 + (size_t)part * 128 * 256 + n;
        float s = 0.f;
#pragma unroll 16
        for (int k = 0; k < 128; ++k) s += pos[k] * w1[(size_t)k * 256];
        ((float*)(p.ws + WS_BC1P))[i] = s;
    }
}

__device__ __forceinline__ void phase_norm(const float* x, const float* g, bf16_t* xn) {
    const int tid_ = TID(); const int lane = tid_ & 63, gw = BID() * 4 + (tid_ >> 6), ngw = gridDim.x * 4;
    for (int row = gw; row < NT; row += ngw) {
        const f32x4* xr = (const f32x4*)(x + (size_t)row * ND) + lane;
        f32x4 v[4]; float ss = 0.f;
#pragma unroll
        for (int j = 0; j < 4; ++j) { v[j] = xr[64 * j]; ss += (v[j].x * v[j].x + v[j].y * v[j].y) + (v[j].z * v[j].z + v[j].w * v[j].w); }
        ss = wave_sum(ss);
        const float r = 1.0f / sqrtf(ss * (1.0f / ND) + 1e-6f);
        u32x2* o = (u32x2*)(xn + (size_t)row * ND) + lane;
#pragma unroll
        for (int j = 0; j < 4; ++j) {
            const f32x4 gg = ((const f32x4*)g)[lane + 64 * j];
            u32x2 w; w.x = pk2(v[j].x * r * gg.x, v[j].y * r * gg.y); w.y = pk2(v[j].z * r * gg.z, v[j].w * r * gg.w);
            o[64 * j] = w;
        }
    }
}
__device__ __forceinline__ void phase_final_norm(const bf16_t* xb, float* out, const float* g) {
    const int tid_ = TID(); const int lane = tid_ & 63, gw = BID() * 4 + (tid_ >> 6), ngw = gridDim.x * 4;
    for (int row = gw; row < NT; row += ngw) {
        const u32x2* xr = (const u32x2*)(xb + (size_t)row * ND) + lane;
        f32x4* orow = (f32x4*)(out + (size_t)row * ND) + lane;
        f32x4 v[4]; float ss = 0.f;
#pragma unroll
        for (int j = 0; j < 4; ++j) { const u32x2 w = xr[64 * j]; v[j] = (f32x4){bflo(w.x), bfhi(w.x), bflo(w.y), bfhi(w.y)}; ss += (v[j].x * v[j].x + v[j].y * v[j].y) + (v[j].z * v[j].z + v[j].w * v[j].w); }
        ss = wave_sum(ss);
        const float r = 1.0f / sqrtf(ss * (1.0f / ND) + 1e-6f);
#pragma unroll
        for (int j = 0; j < 4; ++j) {
            const f32x4 gg = ((const f32x4*)g)[lane + 64 * j];
            f32x4 o; o.x = v[j].x * r * gg.x; o.y = v[j].y * r * gg.y; o.z = v[j].z * r * gg.z; o.w = v[j].w * r * gg.w;
            orow[64 * j] = o;
        }
    }
}
typedef float f32x16r __attribute__((ext_vector_type(16)));
__device__ __forceinline__ void phase_route(const bf16_t* x, const float* wr, const float* brg, const float* bre, int* cnt, int* list, float* route, float* rinv, LAS unsigned char* lds) {
    const int tid_ = TID(); const int lane = tid_ & 63, wv = tid_ >> 6;
    const int i = lane & 31, hk = lane >> 5;
    LAS float* tl = (LAS float*)lds + wv * (32 * 33);
    LAS float* ssl = (LAS float*)(lds + 4 * 32 * 33 * 4);
    for (int task = BID(); task < NT / 32; task += gridDim.x) {
        const int row0 = task * 32;
        const bf16_t* xr = x + (size_t)(row0 + i) * ND + wv * 256;
        const float* wp = wr + (size_t)(wv * 256) * 32 + hk * 32 + i;
        f32x16r acc;
#pragma unroll
        for (int q = 0; q < 16; ++q) acc[q] = 0.f;
        float ss = 0.f;
#pragma unroll 8
        for (int k8 = 0; k8 < 32; ++k8) {
            const u32x4 xa = *(const u32x4*)(xr + 8 * k8);
            const float a0 = hk ? bfhi(xa.x) : bflo(xa.x), a1 = hk ? bfhi(xa.y) : bflo(xa.y), a2 = hk ? bfhi(xa.z) : bflo(xa.z), a3 = hk ? bfhi(xa.w) : bflo(xa.w);
            const float* wq = wp + (size_t)(8 * k8) * 32;
            acc = __builtin_amdgcn_mfma_f32_32x32x2f32(a0, wq[0], acc, 0, 0, 0);
            acc = __builtin_amdgcn_mfma_f32_32x32x2f32(a1, wq[2 * 32], acc, 0, 0, 0);
            acc = __builtin_amdgcn_mfma_f32_32x32x2f32(a2, wq[4 * 32], acc, 0, 0, 0);
            acc = __builtin_amdgcn_mfma_f32_32x32x2f32(a3, wq[6 * 32], acc, 0, 0, 0);
            ss += (a0 * a0 + a1 * a1) + (a2 * a2 + a3 * a3);
        }
        ss += __shfl_xor(ss, 32);
#pragma unroll
        for (int q = 0; q < 16; ++q) tl[((q & 3) + 8 * (q >> 2) + 4 * hk) * 33 + i] = acc[q];
        if (hk == 0) ssl[wv * 32 + i] = ss;
        __syncthreads();
        if (wv == 0 && hk == 0) {
            LAS const float* tp0 = (LAS const float*)lds;
            const float sst = (ssl[i] + ssl[32 + i]) + (ssl[64 + i] + ssl[96 + i]);
            const float r = 1.0f / sqrtf(sst * (1.0f / ND) + 1e-6f);
#define RT_SUM(e_) ((tp0[i * 33 + (e_)] + tp0[32 * 33 + i * 33 + (e_)]) + (tp0[2 * 32 * 33 + i * 33 + (e_)] + tp0[3 * 32 * 33 + i * 33 + (e_)]))
            float gl[4], el[16];
#pragma unroll
            for (int e = 0; e < 4; ++e) gl[e] = RT_SUM(e) * r + brg[e];
#pragma unroll
            for (int e = 0; e < 16; ++e) el[e] = RT_SUM(4 + e) * r + bre[e];
#undef RT_SUM
            int gsel = 0; float gmax = gl[0];
#pragma unroll
            for (int e = 1; e < 4; ++e) if (gl[e] > gmax) { gmax = gl[e]; gsel = e; }
            float gden = 0.f;
#pragma unroll
            for (int e = 0; e < 4; ++e) gden += __expf(gl[e] - gmax);
            const float gw_ = 1.0f / gden;
            float wi[4];
#pragma unroll
            for (int e = 0; e < 4; ++e) wi[e] = gsel == 0 ? el[e] : (gsel == 1 ? el[4 + e] : (gsel == 2 ? el[8 + e] : el[12 + e]));
            int i0 = 0; float t0 = wi[0];
#pragma unroll
            for (int e = 1; e < 4; ++e) if (wi[e] > t0) { t0 = wi[e]; i0 = e; }
            int i1 = -1; float t1 = -3.0e38f;
#pragma unroll
            for (int e = 0; e < 4; ++e) if (e != i0 && wi[e] > t1) { t1 = wi[e]; i1 = e; }
            const float ex = __expf(t1 - t0);
            const float ew0 = gw_ / (1.0f + ex), ew1 = gw_ * ex / (1.0f + ex);
            const int lo = i0 < i1 ? i0 : i1, hi = i0 < i1 ? i1 : i0;
            const float wlo = i0 < i1 ? ew0 : ew1, whi = i0 < i1 ? ew1 : ew0;
            const int pidx = lo == 0 ? hi - 1 : (lo == 1 ? hi + 1 : 5);
            const int bucket = gsel * 6 + pidx;
            const int row = row0 + i;
            unsigned long long mymask = 0ull;
            for (int bb = 0; bb < 24; ++bb) { const unsigned long long mm = __ballot(bucket == bb); if (bucket == bb) mymask = mm; }
            const int leader = __builtin_ctzll(mymask);
            int base = 0;
            if (lane == leader) base = atomicAdd(cnt + 64 * bucket, __builtin_popcountll(mymask));
            base = __shfl(base, leader);
            const int pos = base + __builtin_popcountll(mymask & ((1ull << lane) - 1ull));
            list[(size_t)bucket * NT + pos] = row;
            route[2 * row] = wlo; route[2 * row + 1] = whi;
            rinv[row] = r;
        }
        __syncthreads();
    }
}

struct APlain { const bf16_t* base; int ld; __device__ __forceinline__ const bf16_t* operator()(int r) const { return base + (size_t)r * ld; } };
struct ACmp { const bf16_t* base; __device__ __forceinline__ const bf16_t* operator()(int r) const { return base + (size_t)(r < 126 ? r : 126) * 1024; } };
struct AGather { const bf16_t* xn; const int* list; int cnt; __device__ __forceinline__ const bf16_t* operator()(int r) const { return xn + (size_t)(r < cnt ? list[r] : 0) * ND; } };
struct BPlain { const bf16_t* base; int ld; __device__ __forceinline__ const bf16_t* operator()(int r, int k0) const { return base + (size_t)r * ld + k0; } };
struct BSplit { const bf16_t* b0; const bf16_t* b1; __device__ __forceinline__ const bf16_t* operator()(int r, int k0) const { return k0 < 512 ? b0 + (size_t)r * 512 + k0 : b1 + (size_t)r * 512 + (k0 - 512); } };

template <class AP, class BP, class APN, class BPN>
__device__ __forceinline__ void gemm_kloop(f32x4 (&acc)[4][4], const AP& ap, const BP& bp, int K, LAS unsigned char* lds, bool prefetched, bool has_next, const APN& apn, const BPN& bpn) {
    const int tid = TID(), wid = tid >> 6, lane = tid & 63, wr = wid >> 1, wc = wid & 1, fr = lane & 15, fq = lane >> 4;
#if NAIVE_GEMM
    for (int k0 = 0; k0 < K; k0 += 32) {
#pragma unroll
        for (int m = 0; m < 4; ++m) {
            const bf16_t* arow = ap(wr * 64 + m * 16 + fr) + k0;
            u32x4 av[4];
#pragma unroll
            for (int c = 0; c < 4; ++c) av[c] = ((const u32x4*)arow)[c];
#pragma unroll
            for (int n = 0; n < 4; ++n)
#pragma unroll
                for (int j = 0; j < 4; ++j) {
                    const bf16_t* brow = bp(wc * 64 + n * 16 + 4 * fq + j, k0);
                    float s = 0.f;
#pragma unroll
                    for (int c = 0; c < 4; ++c) {
                        const u32x4 bv = ((const u32x4*)brow)[c];
                        s += bflo(av[c].x) * bflo(bv.x) + bfhi(av[c].x) * bfhi(bv.x) + bflo(av[c].y) * bflo(bv.y) + bfhi(av[c].y) * bfhi(bv.y)
                           + bflo(av[c].z) * bflo(bv.z) + bfhi(av[c].z) * bfhi(bv.z) + bflo(av[c].w) * bflo(bv.w) + bfhi(av[c].w) * bfhi(bv.w);
                    }
                    acc[m][n][j] += s;
                }
        }
    }
#else
    const unsigned woff = (unsigned)wid * 1024u;
    const bf16_t* aptr[4]; int brow[4], bcol;
    {
        const int sb = lane * 16, swz = sb ^ (((sb >> 9) & 1) << 5);
        const int rl = swz >> 6, cc = (wid & 1) * 32 + ((swz & 63) >> 1);
        bcol = cc;
#pragma unroll
        for (int i = 0; i < 4; ++i) { const int R = ((wid >> 1) + 2 * i) * 16 + rl; aptr[i] = ap(R) + cc; brow[i] = R; }
    }
    int aoff[4], boff[4];
#pragma unroll
    for (int m = 0; m < 4; ++m) {
        { const int r = wr * 64 + m * 16 + fr, c = fq * 8, st = (r >> 4) * 2, ob = (r & 15) * 64 + c * 2; aoff[m] = st * 1024 + (ob ^ (((ob >> 9) & 1) << 5)); }
        { const int r = wc * 64 + m * 16 + fr, c = fq * 8, st = (r >> 4) * 2, ob = (r & 15) * 64 + c * 2; boff[m] = st * 1024 + (ob ^ (((ob >> 9) & 1) << 5)); }
    }
    const int nk = K / 64;
#define GT_STAGE(buf, t) do { const int _k0 = (t) * 64; LAS unsigned char* _ba = lds + (buf) * 32768 + woff; \
        _Pragma("unroll") for (int _i = 0; _i < 4; ++_i) { \
            __builtin_amdgcn_global_load_lds((const unsigned*)(aptr[_i] + _k0), (LAS unsigned*)(_ba + _i * 4096), 16, 0, 0); \
            __builtin_amdgcn_global_load_lds((const unsigned*)(bp(brow[_i], _k0) + bcol), (LAS unsigned*)(_ba + 16384 + _i * 4096), 16, 0, 0); } } while (0)
    if (!prefetched) GT_STAGE(0, 0);
#pragma unroll 1
    for (int t = 0; t < nk; ++t) {
        asm volatile("s_waitcnt vmcnt(0)" ::: "memory");
        __syncthreads();
        if (t + 1 < nk) GT_STAGE((t + 1) & 1, t + 1);
        else if (has_next) {
            LAS unsigned char* _ba = lds + woff;
#pragma unroll
            for (int _i = 0; _i < 4; ++_i) {
                __builtin_amdgcn_global_load_lds((const unsigned*)(apn(brow[_i]) + bcol), (LAS unsigned*)(_ba + _i * 4096), 16, 0, 0);
                __builtin_amdgcn_global_load_lds((const unsigned*)(bpn(brow[_i], 0) + bcol), (LAS unsigned*)(_ba + 16384 + _i * 4096), 16, 0, 0);
            }
        }
        LAS const unsigned char* la = lds + (t & 1) * 32768;
        LAS const unsigned char* lb = la + 16384;
        bf16x8 At[2][4], Bt[2][4];
#pragma unroll
        for (int kh = 0; kh < 2; ++kh) {
#pragma unroll
            for (int m = 0; m < 4; ++m) At[kh][m] = *(const LAS bf16x8*)(la + aoff[m] + kh * 1024);
#pragma unroll
            for (int n = 0; n < 4; ++n) Bt[kh][n] = *(const LAS bf16x8*)(lb + boff[n] + kh * 1024);
        }
#pragma unroll
        for (int kh = 0; kh < 2; ++kh)
#pragma unroll
            for (int m = 0; m < 4; ++m)
#pragma unroll
                for (int n = 0; n < 4; ++n) acc[m][n] = __builtin_amdgcn_mfma_f32_16x16x32_bf16(Bt[kh][n], At[kh][m], acc[m][n], 0, 0, 0);
    }
#undef GT_STAGE
#endif
}
__device__ __forceinline__ void zero_acc(f32x4 (&acc)[4][4]) {
#pragma unroll
    for (int m = 0; m < 4; ++m)
#pragma unroll
        for (int n = 0; n < 4; ++n) acc[m][n] = (f32x4){0.f, 0.f, 0.f, 0.f};
}
template <class AP, class BP, class EPI>
__device__ __forceinline__ void gemm_tile(const AP& ap, const BP& bp, int K, const EPI& epi, LAS unsigned char* lds, bool prefetched, bool has_next, const AP& apn, const BP& bpn) {
    const int tid = TID(), wid = tid >> 6, lane = tid & 63, wr = wid >> 1, wc = wid & 1, fr = lane & 15, fq = lane >> 4;
    f32x4 acc[4][4]; zero_acc(acc);
    gemm_kloop(acc, ap, bp, K, lds, prefetched, has_next, apn, bpn);
    epi(acc, wr, wc, fr, fq);
}

__device__ __forceinline__ float rinv_from_ssp(const float* ssp, int row) {
    const f32x4* q = (const f32x4*)(ssp + (size_t)row * 16);
    const f32x4 a = q[0], b = q[1], c = q[2], d = q[3];
    const float s = ((a.x + a.y) + (a.z + a.w)) + ((b.x + b.y) + (b.z + b.w)) + ((c.x + c.y) + (c.z + c.w)) + ((d.x + d.y) + (d.z + d.w));
    return 1.0f / sqrtf(s * (1.0f / ND) + 1e-6f);
}
__device__ __forceinline__ float row_ss64(const f32x4& a, const f32x4& b, const f32x4& c, const f32x4& d) {
    float s = ((a.x * a.x + a.y * a.y) + (a.z * a.z + a.w * a.w)) + ((b.x * b.x + b.y * b.y) + (b.z * b.z + b.w * b.w))
            + ((c.x * c.x + c.y * c.y) + (c.z * c.z + c.w * c.w)) + ((d.x * d.x + d.y * d.y) + (d.z * d.z + d.w * d.w));
    s += __shfl_xor(s, 16); s += __shfl_xor(s, 32);
    return s;
}
constexpr int EPS_OFF = 32768, EPS_RS = 272;
struct EpiInProj {
    int mt, nt; unsigned char* ws; const float* ssp; LAS unsigned char* lds;
    __device__ __forceinline__ void operator()(const f32x4 (&acc)[4][4], int wr, int wc, int fr, int fq) const {
        if (nt >= 22) {
#pragma unroll
            for (int m = 0; m < 4; ++m) {
                const int row = mt * 128 + wr * 64 + m * 16 + fr;
                const float rr = rinv_from_ssp(ssp, row);
#pragma unroll
                for (int n = 0; n < 4; ++n) {
                    const int col = wc * 64 + n * 16 + 4 * fq;
                    if (col < 24) {
                        const f32x4 v = acc[m][n] * rr;
                        f32x4 o; o.x = sigmoidf_(v.x); o.y = sigmoidf_(v.y); o.z = sigmoidf_(v.z); o.w = sigmoidf_(v.w);
                        *(f32x4*)((float*)(ws + WS_GATES) + (size_t)row * 24 + col) = o;
                    }
                }
            }
            return;
        }
        const int reg = nt >> 2;
        const float sc = (nt < 16 && (reg == 0 || reg == 3)) ? 0.125f * 1.4426950408889634f : 1.0f;
        LAS unsigned char* st = lds + EPS_OFF;
        __syncthreads();
#pragma unroll
        for (int m = 0; m < 4; ++m) {
            const int r = wr * 64 + m * 16 + fr;
            const float rs = rinv_from_ssp(ssp, mt * 128 + r) * sc;
#pragma unroll
            for (int n = 0; n < 4; ++n) {
                const f32x4 v = acc[m][n] * rs;
                u32x2 w; w.x = pk2(v.x, v.y); w.y = pk2(v.z, v.w);
                *(LAS u32x2*)(st + r * EPS_RS + (wc * 64 + n * 16 + 4 * fq) * 2) = w;
            }
        }
        __syncthreads();
        const int tid = (wr * 2 + wc) * 64 + fq * 16 + fr;
#pragma unroll
        for (int i = 0; i < 8; ++i) {
            const int q = tid + 256 * i, r = q >> 4, ch = q & 15, col = ch * 8;
            const u32x4 v = *(const LAS u32x4*)(st + r * EPS_RS + ch * 16);
            const int row = mt * 128 + r, b = row >> 11, s = row & 2047;
            bf16_t* dst;
            if (nt < 16) { const int c = (nt & 3) * 128 + col, head = c >> 6, d = c & 63; dst = (bf16_t*)(ws + WS_QA + (size_t)reg * 16 * MiB) + ((size_t)((b * 8 + head) * NS + s) * 64 + d); }
            else { const int g = col >> 6, d = col & 63; dst = (bf16_t*)(ws + WS_KV6 + (size_t)(nt - 16) * 4 * MiB) + ((size_t)((b * 2 + g) * NS + s) * 64 + d); }
            *(u32x4*)dst = v;
        }
    }
};
struct EpiCmp1 {
    bf16_t* hc; const float* bc1; int row0, col0;
    __device__ __forceinline__ void operator()(const f32x4 (&acc)[4][4], int wr, int wc, int fr, int fq) const {
#pragma unroll
        for (int m = 0; m < 4; ++m) {
            const int row = row0 + wr * 64 + m * 16 + fr;
#pragma unroll
            for (int n = 0; n < 4; ++n) {
                const int col = col0 + wc * 64 + n * 16 + 4 * fq;
                f32x4 bb = *(const f32x4*)(bc1 + col);
#pragma unroll
                for (int pp = 1; pp < 16; ++pp) bb += *(const f32x4*)(bc1 + pp * 1024 + col);
                const f32x4 v = acc[m][n];
                u32x2 w; w.x = pk2(gelu_tanh(v.x + bb.x), gelu_tanh(v.y + bb.y)); w.y = pk2(gelu_tanh(v.z + bb.z), gelu_tanh(v.w + bb.w));
                *(u32x2*)(hc + (size_t)row * 256 + col) = w;
            }
        }
    }
};
struct EpiCmp2 {
    bf16_t* dst; int row0;
    __device__ __forceinline__ void operator()(const f32x4 (&acc)[4][4], int wr, int wc, int fr, int fq) const {
        if (wc != 0) return;
#pragma unroll
        for (int m = 0; m < 4; ++m) {
            const int row = row0 + wr * 64 + m * 16 + fr;
#pragma unroll
            for (int n = 0; n < 4; ++n) {
                const int col = n * 16 + 4 * fq;
                const f32x4 v = acc[m][n];
                u32x2 w; w.x = pk2(v.x, v.y); w.y = pk2(v.z, v.w);
                *(u32x2*)(dst + (size_t)row * 64 + col) = w;
            }
        }
    }
};
struct EpiResAdd {
    bf16_t* res; int row0, col0;
    __device__ __forceinline__ void operator()(const f32x4 (&acc)[4][4], int wr, int wc, int fr, int fq) const {
#pragma unroll
        for (int m = 0; m < 4; ++m) {
            const int row = row0 + wr * 64 + m * 16 + fr;
#pragma unroll
            for (int n = 0; n < 4; ++n) {
                const int col = col0 + wc * 64 + n * 16 + 4 * fq;
                u32x2* pp = (u32x2*)(res + (size_t)row * ND + col);
                const u32x2 b = *pp; const f32x4 a = acc[m][n];
                u32x2 w; w.x = pk2(bflo(b.x) + a.x, bfhi(b.x) + a.y); w.y = pk2(bflo(b.y) + a.z, bfhi(b.y) + a.w);
                *pp = w;
            }
        }
    }
};
struct EpiMoeGU {
    bf16_t* hid; const int* list; const float* route; const float* rinv; int cnt, hrow0, nt16;
    __device__ __forceinline__ void operator()(const f32x4 (&acc)[4][4], int wr, int wc, int fr, int fq) const {
        const int half = nt16 >> 3, nte = nt16 & 7;
#pragma unroll
        for (int m = 0; m < 4; ++m) {
            const int r = wr * 64 + m * 16 + fr;
            const int tok = r < cnt ? list[r] : 0;
            const float w = r < cnt ? route[2 * tok + half] : 0.f;
            const float rt = rinv[tok];
#pragma unroll
            for (int pr = 0; pr < 2; ++pr) {
                const f32x4 gv = acc[m][2 * pr], uv = acc[m][2 * pr + 1];
                const int hc = half * 512 + (4 * nte + 2 * wc + pr) * 16 + 4 * fq;
                float h[4];
#pragma unroll
                for (int j = 0; j < 4; ++j) { const float gg = gv[j] * rt; h[j] = gg / (1.0f + __expf(-gg)) * (uv[j] * rt) * w; }
                u32x2 o; o.x = pk2(h[0], h[1]); o.y = pk2(h[2], h[3]);
                *(u32x2*)(hid + (size_t)(hrow0 + r) * 1024 + hc) = o;
            }
        }
    }
};
struct EpiMoeDown {
    bf16_t* res; const int* list; float* ssp; int cnt, col0;
    __device__ __forceinline__ void operator()(const f32x4 (&acc)[4][4], int wr, int wc, int fr, int fq) const {
#pragma unroll
        for (int m = 0; m < 4; ++m) {
            const int r = wr * 64 + m * 16 + fr;
            const bool ok = r < cnt;
            const int tok = ok ? list[r] : 0;
            f32x4 nv[4];
#pragma unroll
            for (int n = 0; n < 4; ++n) {
                const int col = col0 + wc * 64 + n * 16 + 4 * fq;
                u32x2* pp = (u32x2*)(res + (size_t)tok * ND + col);
                const u32x2 b = *pp; const f32x4 a = acc[m][n];
                nv[n] = (f32x4){bflo(b.x) + a.x, bfhi(b.x) + a.y, bflo(b.y) + a.z, bfhi(b.y) + a.w};
                if (ok) { u32x2 w; w.x = pk2(nv[n].x, nv[n].y); w.y = pk2(nv[n].z, nv[n].w); *pp = w; }
            }
            const float ps = row_ss64(nv[0], nv[1], nv[2], nv[3]);
            if (ok && fq == 0) ssp[(size_t)tok * 16 + (col0 >> 6) + wc] = ps;
        }
    }
};
struct EpiBf16 {
    bf16_t* dst; int ld, row0, col0;
    __device__ __forceinline__ void operator()(const f32x4 (&acc)[4][4], int wr, int wc, int fr, int fq) const {
#pragma unroll
        for (int m = 0; m < 4; ++m) {
            const int row = row0 + wr * 64 + m * 16 + fr;
#pragma unroll
            for (int n = 0; n < 4; ++n) {
                const int col = col0 + wc * 64 + n * 16 + 4 * fq;
                const f32x4 v = acc[m][n];
                u32x2 w; w.x = pk2(v.x, v.y); w.y = pk2(v.z, v.w);
                *(u32x2*)(dst + (size_t)row * ld + col) = w;
            }
        }
    }
};
struct EpiPleFused {
    const bf16_t* rin; const float* ssp_in; bf16_t* rout; float* ssp_out; int row0, col0;
    __device__ __forceinline__ void operator()(const f32x4 (&acc)[4][4], const f32x4 (&acc2)[4][4], int wr, int wc, int fr, int fq) const {
#pragma unroll
        for (int m = 0; m < 4; ++m) {
            const int row = row0 + wr * 64 + m * 16 + fr;
            const float rr = rinv_from_ssp(ssp_in, row);
            f32x4 nv[4];
#pragma unroll
            for (int n = 0; n < 4; ++n) {
                const int col = col0 + wc * 64 + n * 16 + 4 * fq;
                const size_t off = (size_t)row * ND + col;
                const f32x4 v = acc[m][n] * rr, q = acc2[m][n];
                const u32x2 b = *(const u32x2*)(rin + off);
                f32x4 o = (f32x4){bflo(b.x), bfhi(b.x), bflo(b.y), bfhi(b.y)};
                o.x += sigmoidf_(v.x) * q.x; o.y += sigmoidf_(v.y) * q.y; o.z += sigmoidf_(v.z) * q.z; o.w += sigmoidf_(v.w) * q.w;
                u32x2 w; w.x = pk2(o.x, o.y); w.y = pk2(o.z, o.w);
                *(u32x2*)(rout + off) = w;
                nv[n] = o;
            }
            const float ps = row_ss64(nv[0], nv[1], nv[2], nv[3]);
            if (fq == 0) ssp_out[(size_t)row * 16 + (col0 >> 6) + wc] = ps;
        }
    }
};
struct EpiPleGate {
    float* out; const bf16_t* p2; int row0, col0; float sc;
    __device__ __forceinline__ void operator()(const f32x4 (&acc)[4][4], int wr, int wc, int fr, int fq) const {
#pragma unroll
        for (int m = 0; m < 4; ++m) {
            const int row = row0 + wr * 64 + m * 16 + fr;
#pragma unroll
            for (int n = 0; n < 4; ++n) {
                const int col = col0 + wc * 64 + n * 16 + 4 * fq;
                const size_t off = (size_t)row * ND + col;
                const u32x2 pv = *(const u32x2*)(p2 + off);
                const f32x4 v = acc[m][n];
                f32x4 o = *(const f32x4*)(out + off);
                o.x += sc * sigmoidf_(v.x) * bflo(pv.x); o.y += sc * sigmoidf_(v.y) * bfhi(pv.x); o.z += sc * sigmoidf_(v.z) * bflo(pv.y); o.w += sc * sigmoidf_(v.w) * bfhi(pv.y);
                *(f32x4*)(out + off) = o;
            }
        }
    }
};

template <class PH, class AP, class BP, class EPI>
__device__ __forceinline__ void gemm_stream(const PH& ph, int first, int step, int count, int K, LAS unsigned char* lds) {
    int q = first;
    if (q >= count) return;
    AP ap, apn; BP bp, bpn; EPI ep, epn;
    ph.make(q, ap, bp, ep);
    bool pref = false;
    for (;;) {
        const int qn = q + step; const bool hn = qn < count;
        if (hn) ph.make(qn, apn, bpn, epn); else { apn = ap; bpn = bp; epn = ep; }
        gemm_tile(ap, bp, K, ep, lds, pref, hn, apn, bpn);
        if (!hn) break;
        ap = apn; bp = bpn; ep = epn; q = qn; pref = true;
    }
}

__device__ __forceinline__ void load_q32(const bf16_t* p, float* q) {
#pragma unroll
    for (int c = 0; c < 4; ++c) {
        const u32x4 v = ((const u32x4*)p)[c];
        q[8 * c] = bflo(v.x); q[8 * c + 1] = bfhi(v.x); q[8 * c + 2] = bflo(v.y); q[8 * c + 3] = bfhi(v.y);
        q[8 * c + 4] = bflo(v.z); q[8 * c + 5] = bfhi(v.z); q[8 * c + 6] = bflo(v.w); q[8 * c + 7] = bfhi(v.w);
    }
}
__device__ __forceinline__ float dot32p(const float* q, const bf16_t* k) {
    float s0 = 0.f, s1 = 0.f;
#pragma unroll
    for (int c = 0; c < 4; ++c) {
        const u32x4 v = ((const u32x4*)k)[c];
        s0 += q[8 * c] * bflo(v.x); s1 += q[8 * c + 1] * bfhi(v.x); s0 += q[8 * c + 2] * bflo(v.y); s1 += q[8 * c + 3] * bfhi(v.y);
        s0 += q[8 * c + 4] * bflo(v.z); s1 += q[8 * c + 5] * bfhi(v.z); s0 += q[8 * c + 6] * bflo(v.w); s1 += q[8 * c + 7] * bfhi(v.w);
    }
    const float s = s0 + s1;
    return s + __shfl_xor(s, 1);
}
__device__ __forceinline__ void axpy32(float* a, float p, const bf16_t* vr) {
#pragma unroll
    for (int c = 0; c < 4; ++c) {
        const u32x4 v = ((const u32x4*)vr)[c];
        a[8 * c] += p * bflo(v.x); a[8 * c + 1] += p * bfhi(v.x); a[8 * c + 2] += p * bflo(v.y); a[8 * c + 3] += p * bfhi(v.y);
        a[8 * c + 4] += p * bflo(v.z); a[8 * c + 5] += p * bfhi(v.z); a[8 * c + 6] += p * bflo(v.w); a[8 * c + 7] += p * bfhi(v.w);
    }
}
#define ONLINE_STEP(s_, vrow_) do { const float _s = (s_); if (_s > mx) { const float _c = __expf(mx - _s); l *= _c; _Pragma("unroll") for (int _i = 0; _i < 32; ++_i) acc[_i] *= _c; mx = _s; } \
    const float _p = __expf(_s - mx); l += _p; axpy32(acc, _p, (vrow_)); } while (0)

__device__ __forceinline__ void store_o32(bf16_t* dst, const float* a, float sc) {
#pragma unroll
    for (int c = 0; c < 4; ++c) {
        u32x4 w; w.x = pk2(a[8 * c] * sc, a[8 * c + 1] * sc); w.y = pk2(a[8 * c + 2] * sc, a[8 * c + 3] * sc);
        w.z = pk2(a[8 * c + 4] * sc, a[8 * c + 5] * sc); w.w = pk2(a[8 * c + 6] * sc, a[8 * c + 7] * sc);
        ((u32x4*)dst)[c] = w;
    }
}

__device__ __forceinline__ void attn_dilated_naive(const unsigned char* ws, int gtid, int gthreads) {
    asm volatile("" : "+v"(gtid));
    const bf16_t* qa = (const bf16_t*)(ws + WS_QA); const bf16_t* ka = (const bf16_t*)(ws + WS_KA); const bf16_t* va = (const bf16_t*)(ws + WS_VA);
    bf16_t* ob = (bf16_t*)(ws + WS_O);
    for (int id2 = gtid; id2 < NB * 8 * NS * 2; id2 += gthreads) {
        const int idx = id2 >> 1, hf = (id2 & 1) * 32;
        const int t = idx & 2047, bh = idx >> 11, h = bh & 7, b = bh >> 3;
        float q[32]; load_q32(qa + (size_t)idx * 64 + hf, q);
        const bf16_t* kb = ka + (size_t)bh * NS * 64 + hf; const bf16_t* vb = va + (size_t)bh * NS * 64 + hf;
        const float slope = exp2f(-((float)h + 0.5f));
        float mx = -1e30f, l = 0.f; float acc[32];
#pragma unroll
        for (int i = 0; i < 32; ++i) acc[i] = 0.f;
#pragma unroll 1
        for (int pat = 0; pat < 3; ++pat) {
            const int dil = pat == 0 ? 1 : (pat == 1 ? 4 : 16);
#pragma unroll 1
            for (int j = 0; j <= 128; ++j) {
                const int dist = j * dil, pos = t - dist;
                if (pos < 0) break;
                const float s = dot32p(q, kb + (size_t)pos * 64) - slope * (float)dist;
                ONLINE_STEP(s, vb + (size_t)pos * 64);
            }
        }
        store_o32(ob + ((size_t)(b * NS + t) * ND + h * 64 + hf), acc, 1.0f / l);
    }
}

__device__ __forceinline__ void nsa_imp_naive(const unsigned char* ws, int gtid, int gthreads) {
    asm volatile("" : "+v"(gtid));
    const bf16_t* qb = (const bf16_t*)(ws + WS_QB); const bf16_t* kcmp = (const bf16_t*)(ws + WS_KCMP);
    float* imph = (float*)(ws + WS_IMPH);
    for (int id2 = gtid; id2 < NB * 8 * NS * 2; id2 += gthreads) {
        const int idx = id2 >> 1, hf = (id2 & 1) * 32;
        const int t = idx & 2047, bh = idx >> 11, hb = bh & 7, b = bh >> 3, g = hb >> 2;
        float q[32]; load_q32(qb + (size_t)idx * 64 + hf, q);
        const bf16_t* kc = kcmp + (size_t)(b * 2 + g) * 128 * 64 + hf;
        const float slope = exp2f(-(float)(hb + 1));
        const int ncv = t >= 31 ? ((t - 31) >> 4) + 1 : 0;
        float mx = -1e30f;
#pragma unroll 1
        for (int c = 0; c < ncv; ++c) { const float s = dot32p(q, kc + c * 64) - slope * (float)(t - (16 * c + 31)); mx = fmaxf(mx, s); }
        float den = 0.f;
#pragma unroll 1
        for (int c = 0; c < ncv; ++c) { const float s = dot32p(q, kc + c * 64) - slope * (float)(t - (16 * c + 31)); den += __expf(s - mx); }
        const float inv = ncv > 0 ? 1.0f / den : 0.f;
#pragma unroll 1
        for (int n = 0; n < 32; ++n) {
            float imp = 0.f;
#pragma unroll 1
            for (int j = -1; j <= 3; ++j) {
                const int c = 4 * n + j;
                if (c >= 0 && c < ncv) {
                    const float s = dot32p(q, kc + c * 64) - slope * (float)(t - (16 * c + 31));
                    const float pp = __expf(s - mx) * inv;
                    imp += (j == -1 || j == 3) ? 0.5f * pp : pp;
                }
            }
            if (hf == 0) imph[(size_t)idx * 32 + n] = imp;
        }
    }
}
__device__ __forceinline__ void nsa_select(const unsigned char* ws, unsigned* maskbuf) {
    const float* imph = (const float*)(ws + WS_IMPH);
    const int tid_ = TID(); const int lane = tid_ & 63, gw = BID() * 4 + (tid_ >> 6), ngw = gridDim.x * 4;
    for (int it = gw; it < NB * 2 * NS / 2; it += ngw) {
        const int item = it * 2 + (lane >> 5), t = item & 2047, bg = item >> 11, n = lane & 31;
        float imp = 0.f;
#pragma unroll
        for (int r = 0; r < 4; ++r) imp += imph[((size_t)(bg * 4 + r) * NS + t) * 32 + n];
        const int cur = t >> 6;
        const bool valid = n <= cur;
        const bool forced = (n == 0) || (cur - n < 2);
        const float score = valid ? imp + (forced ? 1e4f : 0.f) : -1e30f;
        int rank = 0;
        for (int m = 0; m < 32; ++m) {
            const float sm = __shfl(score, (lane & 32) | m);
            rank += (sm > score || (sm == score && m < n)) ? 1 : 0;
        }
        const bool sel = valid && rank < 16;
        const unsigned long long bal = __ballot(sel);
        if (n == 0) maskbuf[item] = (lane >> 5) ? (unsigned)(bal >> 32) : (unsigned)bal;
    }
}
__device__ __forceinline__ void nsa_attn_naive(const unsigned char* ws, int gtid, int gthreads) {
    asm volatile("" : "+v"(gtid));
    const bf16_t* qb = (const bf16_t*)(ws + WS_QB);
    const bf16_t* kcmp = (const bf16_t*)(ws + WS_KCMP); const bf16_t* vcmp = kcmp + (size_t)16 * 128 * 64;
    const bf16_t* ksb = (const bf16_t*)(ws + WS_KV6 + 2 * 4 * MiB); const bf16_t* vsb = (const bf16_t*)(ws + WS_KV6 + 3 * 4 * MiB);
    const bf16_t* kwb = (const bf16_t*)(ws + WS_KV6 + 4 * 4 * MiB); const bf16_t* vwb = (const bf16_t*)(ws + WS_KV6 + 5 * 4 * MiB);
    const float* gates = (const float*)(ws + WS_GATES);
    const unsigned* maskbuf = (const unsigned*)(ws + WS_MASK);
    bf16_t* ob = (bf16_t*)(ws + WS_O);
    for (int id2 = gtid; id2 < NB * 8 * NS * 2; id2 += gthreads) {
        const int idx = id2 >> 1, hf = (id2 & 1) * 32;
        const int t = idx & 2047, bh = idx >> 11, hb = bh & 7, b = bh >> 3, g = hb >> 2, bg = b * 2 + g;
        float q[32]; load_q32(qb + (size_t)idx * 64 + hf, q);
        const float slope = exp2f(-(float)(hb + 1));
        const float* gt = gates + (size_t)(b * NS + t) * 24 + hb * 3;
        float tot[32], acc[32];
#pragma unroll
        for (int i = 0; i < 32; ++i) tot[i] = 0.f;
        {
            const bf16_t* kc = kcmp + (size_t)bg * 128 * 64 + hf; const bf16_t* vc = vcmp + (size_t)bg * 128 * 64 + hf;
            const int ncv = t >= 31 ? ((t - 31) >> 4) + 1 : 0;
            if (ncv > 0) {
                float mx = -1e30f, l = 0.f;
#pragma unroll
                for (int i = 0; i < 32; ++i) acc[i] = 0.f;
#pragma unroll 1
                for (int c = 0; c < ncv; ++c) { const float s = dot32p(q, kc + c * 64) - slope * (float)(t - (16 * c + 31)); ONLINE_STEP(s, vc + c * 64); }
                const float sc = gt[0] / l;
#pragma unroll
                for (int i = 0; i < 32; ++i) tot[i] += sc * acc[i];
            }
        }
        {
            const bf16_t* kb = ksb + (size_t)bg * NS * 64 + hf; const bf16_t* vb = vsb + (size_t)bg * NS * 64 + hf;
            const unsigned mask = maskbuf[bg * NS + t];
            float mx = -1e30f, l = 0.f;
#pragma unroll
            for (int i = 0; i < 32; ++i) acc[i] = 0.f;
#pragma unroll 1
            for (int n = 0; n < 32; ++n) {
                if (!((mask >> n) & 1u)) continue;
#pragma unroll 1
                for (int i = 0; i < 64; ++i) {
                    const int pos = n * 64 + i;
                    if (pos > t) break;
                    const float s = dot32p(q, kb + (size_t)pos * 64) - slope * (float)(t - pos);
                    ONLINE_STEP(s, vb + (size_t)pos * 64);
                }
            }
            const float sc = gt[1] / l;
#pragma unroll
            for (int i = 0; i < 32; ++i) tot[i] += sc * acc[i];
        }
        {
            const bf16_t* kb = kwb + (size_t)bg * NS * 64 + hf; const bf16_t* vb = vwb + (size_t)bg * NS * 64 + hf;
            float mx = -1e30f, l = 0.f;
#pragma unroll
            for (int i = 0; i < 32; ++i) acc[i] = 0.f;
#pragma unroll 1
            for (int dist = 0; dist < 512; ++dist) {
                const int pos = t - dist;
                if (pos < 0) break;
                const float s = dot32p(q, kb + (size_t)pos * 64) - slope * (float)dist;
                ONLINE_STEP(s, vb + (size_t)pos * 64);
            }
            const float sc = gt[2] / l;
#pragma unroll
            for (int i = 0; i < 32; ++i) tot[i] += sc * acc[i];
        }
        store_o32(ob + ((size_t)(b * NS + t) * ND + 512 + hb * 64 + hf), tot, 1.0f);
    }
}

constexpr int KVS = 144;
constexpr int KVT = 64 * KVS;
constexpr int VS = 128;
constexpr int VT = 64 * VS;
#define LOG2E_F 1.4426950408889634f
__device__ __forceinline__ unsigned cvtpk(float lo, float hi) { f32x2_t v = {lo, hi}; bf16x2_t b = __builtin_convertvector(v, bf16x2_t); return __builtin_bit_cast(unsigned, b); }
__device__ __forceinline__ s16x4 vtr(LAS const unsigned char* p) { return __builtin_bit_cast(s16x4, __builtin_amdgcn_ds_read_tr16_b64_v4i16((LAS s16x4*)p)); }
__device__ __forceinline__ f32x16 zero16() { f32x16 z;
#pragma unroll
    for (int i = 0; i < 16; ++i) z[i] = 0.f;
    return z; }

__device__ __forceinline__ void load_kv_tile(LAS unsigned char* Kt, LAS unsigned char* Vt, const bf16_t* kbase, const bf16_t* vbase, int row0, int rstride, int rmin, int rmax, int tid) {
    const int j = tid >> 2, ch = tid & 3;
    int tok = row0 + j * rstride; tok = tok < rmin ? rmin : (tok > rmax ? rmax : tok);
    const u32x4* kp = (const u32x4*)(kbase + (size_t)tok * 64);
    const u32x4* vp = (const u32x4*)(vbase + (size_t)tok * 64);
    const u32x4 k0 = kp[ch], k1 = kp[ch + 4], v0 = vp[ch], v1 = vp[ch + 4];
    *(LAS u32x4*)(Kt + j * KVS + ch * 16) = k0; *(LAS u32x4*)(Kt + j * KVS + (ch + 4) * 16) = k1;
    { const int sx = 2 * (j & 3); *(LAS u32x4*)(Vt + j * VS + ((ch ^ sx) * 16)) = v0; *(LAS u32x4*)(Vt + j * VS + (((ch + 4) ^ sx) * 16)) = v1; }
}

struct KVRegs { u32x4 k0, k1, v0, v1; };
__device__ __forceinline__ void kv_fetch(KVRegs& r, const bf16_t* kbase, const bf16_t* vbase, int row0, int rstride, int rmin, int rmax, int tid) {
    const int j = tid >> 2, ch = tid & 3;
    int tok = row0 + j * rstride; tok = tok < rmin ? rmin : (tok > rmax ? rmax : tok);
    const u32x4* kp = (const u32x4*)(kbase + (size_t)tok * 64);
    const u32x4* vp = (const u32x4*)(vbase + (size_t)tok * 64);
    r.k0 = kp[ch]; r.k1 = kp[ch + 4]; r.v0 = vp[ch]; r.v1 = vp[ch + 4];
}
__device__ __forceinline__ void kv_commit(const KVRegs& r, LAS unsigned char* Kt, LAS unsigned char* Vt, int tid) {
    const int j = tid >> 2, ch = tid & 3;
    *(LAS u32x4*)(Kt + j * KVS + ch * 16) = r.k0; *(LAS u32x4*)(Kt + j * KVS + (ch + 4) * 16) = r.k1;
    { const int sx = 2 * (j & 3); *(LAS u32x4*)(Vt + j * VS + ((ch ^ sx) * 16)) = r.v0; *(LAS u32x4*)(Vt + j * VS + (((ch + 4) ^ sx) * 16)) = r.v1; }
}
__device__ __forceinline__ void pv32(f32x16& o0, f32x16& o1, const f32x16& sv, LAS const unsigned char* vp0, LAS const unsigned char* vp1  ) {
#pragma unroll
    for (int s16 = 0; s16 < 2; ++s16) {
        u32x4 pw;
        pw.x = cvtpk(sv[8 * s16 + 0], sv[8 * s16 + 1]); pw.y = cvtpk(sv[8 * s16 + 2], sv[8 * s16 + 3]);
        pw.z = cvtpk(sv[8 * s16 + 4], sv[8 * s16 + 5]); pw.w = cvtpk(sv[8 * s16 + 6], sv[8 * s16 + 7]);
        const bf16x8 pf = __builtin_bit_cast(bf16x8, pw);
        const s16x4 a0 = vtr(vp0 + s16 * 16 * VS), b0 = vtr(vp0 + s16 * 16 * VS + 8 * VS), a1 = vtr(vp1 + s16 * 16 * VS), b1 = vtr(vp1 + s16 * 16 * VS + 8 * VS);
        const bf16x8 vf0 = {a0[0], a0[1], a0[2], a0[3], b0[0], b0[1], b0[2], b0[3]};
        const bf16x8 vf1 = {a1[0], a1[1], a1[2], a1[3], b1[0], b1[1], b1[2], b1[3]};
        o0 = __builtin_amdgcn_mfma_f32_32x32x16_bf16(vf0, pf, o0, 0, 0, 0);
        o1 = __builtin_amdgcn_mfma_f32_32x32x16_bf16(vf1, pf, o1, 0, 0, 0);
    }
}
__device__ __forceinline__ f32x16 qk32(const bf16x8* qf, LAS const unsigned char* kp  , f32x16 s  ) {
#pragma unroll
    for (int k = 0; k < 4; ++k) {
        const bf16x8 kf = *(const LAS bf16x8*)(kp + 32 * k);
        s = __builtin_amdgcn_mfma_f32_32x32x16_bf16(kf, qf[k], s, 0, 0, 0);
    }
    return s;
}
template <int KS, bool TRY_FULL>
__device__ __forceinline__ void fa_tile64(f32x16& o0, f32x16& o1, float& m, float& l, const bf16x8* qf, LAS const unsigned char* Kt, LAS const unsigned char* Vt, int lane, float dA, float wmax, float ns2) {
    const int r = lane & 31, h = lane >> 5;
    LAS const unsigned char* kp = Kt + r * KVS + 16 * h;
    const float dAh = dA - (float)(KS * 4 * h);
    const float hi = dAh, lo = dAh - wmax, base = ns2 * dAh;
    f32x16 s0, s1;
#pragma unroll
    for (int i = 0; i < 16; ++i) {
        const float c0 = (float)(KS * ((i & 3) + 8 * (i >> 2))), c1 = c0 + (float)(32 * KS);
        s0[i] = fmaf(-c0, ns2, base); s1[i] = fmaf(-c1, ns2, base);
    }
    s0 = qk32(qf, kp, s0); s1 = qk32(qf, kp + 32 * KVS, s1);
    float tmax = -1e30f;
    if (TRY_FULL && __all(lo <= 0.f && hi >= (float)(59 * KS))) {
#pragma unroll
        for (int i = 0; i < 16; ++i) tmax = fmaxf(tmax, fmaxf(s0[i], s1[i]));
    } else {
#pragma unroll
        for (int i = 0; i < 16; ++i) {
            const float c0 = (float)(KS * ((i & 3) + 8 * (i >> 2))), c1 = c0 + (float)(32 * KS);
            const float t0 = (c0 >= lo && c0 <= hi) ? s0[i] : -1e30f;
            const float t1 = (c1 >= lo && c1 <= hi) ? s1[i] : -1e30f;
            s0[i] = t0; s1[i] = t1;
            tmax = fmaxf(tmax, fmaxf(t0, t1));
        }
    }
    tmax = fmaxf(tmax, __shfl_xor(tmax, 32));
    const float mn = fmaxf(m, tmax);
    const float corr = __builtin_amdgcn_exp2f(m - mn);
    m = mn;
    const float mu = fmaxf(mn, -1e29f);
    float ps = 0.f;
#pragma unroll
    for (int i = 0; i < 16; ++i) {
        s0[i] = __builtin_amdgcn_exp2f(s0[i] - mu); s1[i] = __builtin_amdgcn_exp2f(s1[i] - mu);
        ps += s0[i] + s1[i];
    }
    l = l * corr + ps;
    if (!__all(corr == 1.0f)) {
#pragma unroll
        for (int i = 0; i < 16; ++i) { o0[i] *= corr; o1[i] *= corr; }
    }
    const int vq = (lane & 15) >> 2, vc0 = 2 * ((lane >> 4) & 1) + ((lane & 3) >> 1), vsx = 2 * vq;
    LAS const unsigned char* vp0 = Vt + (4 * h + vq) * VS + ((vc0 ^ vsx) * 16) + 8 * (lane & 1);
    LAS const unsigned char* vp1 = Vt + (4 * h + vq) * VS + (((vc0 + 4) ^ vsx) * 16) + 8 * (lane & 1);
    pv32(o0, o1, s0, vp0, vp1);
    pv32(o0, o1, s1, vp0 + 32 * VS, vp1 + 32 * VS);
}
__device__ __forceinline__ void acc_scaled(f32x16& t0, f32x16& t1, const f32x16& o0, const f32x16& o1, float sc) {
#pragma unroll
    for (int i = 0; i < 16; ++i) { t0[i] += sc * o0[i]; t1[i] += sc * o1[i]; }
}
__device__ __forceinline__ void store_ot(bf16_t* orow, const f32x16& o0, const f32x16& o1, float sc, int h) {
#pragma unroll
    for (int u = 0; u < 4; ++u) {
        u32x2 w0, w1;
        w0.x = cvtpk(o0[4 * u] * sc, o0[4 * u + 1] * sc); w0.y = cvtpk(o0[4 * u + 2] * sc, o0[4 * u + 3] * sc);
        w1.x = cvtpk(o1[4 * u] * sc, o1[4 * u + 1] * sc); w1.y = cvtpk(o1[4 * u + 2] * sc, o1[4 * u + 3] * sc);
        *(u32x2*)(orow + 8 * u + 4 * h) = w0;
        *(u32x2*)(orow + 32 + 8 * u + 4 * h) = w1;
    }
}
__device__ __forceinline__ void load_qf(bf16x8* qf, const bf16_t* qrow, int h) {
#pragma unroll
    for (int k = 0; k < 4; ++k) qf[k] = *(const bf16x8*)(qrow + 16 * k + 8 * h);
}

__device__ __forceinline__ void dil_item(unsigned char* ws, int item, LAS unsigned char* lds) {
    const int tid = TID(), lane = tid & 63, w = tid >> 6, c = lane & 31, h = lane >> 5;
    const int bh = item / 48, rem = item % 48, pat = rem >> 4, idx = rem & 15;
    const int dil = pat == 0 ? 1 : (pat == 1 ? 4 : 16), nqt = 16 / dil, res = idx / nqt, qt = idx % nqt;
    const int hd = bh & 7, b = bh >> 3;
    const int q0 = qt * 128 + 32 * w, iq = q0 + c, t = res + iq * dil;
    const bf16_t* qa = (const bf16_t*)(ws + WS_QA) + (size_t)bh * NS * 64;
    const bf16_t* ka = (const bf16_t*)(ws + WS_KA) + (size_t)bh * NS * 64;
    const bf16_t* va = (const bf16_t*)(ws + WS_VA) + (size_t)bh * NS * 64;
    bf16x8 qf[4]; load_qf(qf, qa + (size_t)t * 64, h);
    const float ns2 = -exp2f(-((float)hd + 0.5f)) * (float)dil * LOG2E_F;
    f32x16 o0 = zero16(), o1 = zero16(); float m = -1e30f, l = 0.f;
    {
        const int T0 = qt == 0 ? 2 : 0;
        KVRegs kr; kv_fetch(kr, ka, va, res + (qt * 128 - 128 + 64 * T0) * dil, dil, 0, NS - 1, tid);
        int buf = 0;
        for (int T = T0; T < 4; ++T) {
            const int kb = qt * 128 - 128 + 64 * T;
            LAS unsigned char* Kt = lds + buf * KVT; LAS unsigned char* Vt = lds + 2 * KVT + buf * VT;
            kv_commit(kr, Kt, Vt, tid);
            __syncthreads();
            if (T + 1 < 4) kv_fetch(kr, ka, va, res + (kb + 64) * dil, dil, 0, NS - 1, tid);
            if (kb <= q0 + 31 && kb + 63 >= q0 - 128)
                fa_tile64<1, true>(o0, o1, m, l, qf, Kt, Vt, lane, (float)(iq - kb), 128.f, ns2);
            buf ^= 1;
        }
    }
    const float lt = l + __shfl_xor(l, 32);
    bf16_t* op = (bf16_t*)(pat < 2 ? ws + WS_OPA01 + (size_t)pat * 16 * MiB : ws + WS_OPA2);
    store_ot(op + ((size_t)(b * NS + t) * 512 + hd * 64), o0, o1, 1.0f / lt, h);
    if (h == 0) { float* st = (float*)(ws + WS_STA) + ((size_t)pat * NB * 8 * NS + (size_t)bh * NS + t) * 2; st[0] = m; st[1] = lt; }
}
__device__ __forceinline__ void dil_merge(unsigned char* ws, int gtid, int gthreads) {
    asm volatile("" : "+v"(gtid));
    const float* sta = (const float*)(ws + WS_STA);
    bf16_t* ob = (bf16_t*)(ws + WS_O);
    for (int it = gtid; it < NT * 8 * 8; it += gthreads) {
        const int ch = it & 7, hd = (it >> 3) & 7, tk = it >> 6, b = tk >> 11, t = tk & 2047;
        float mm[3], ll[3];
#pragma unroll
        for (int p = 0; p < 3; ++p) { const float* s = sta + ((size_t)p * NB * 8 * NS + (size_t)(b * 8 + hd) * NS + t) * 2; mm[p] = s[0]; ll[p] = s[1]; }
        const float M = fmaxf(mm[0], fmaxf(mm[1], mm[2]));
        float wgt[3], den = 0.f;
#pragma unroll
        for (int p = 0; p < 3; ++p) { wgt[p] = __builtin_amdgcn_exp2f(mm[p] - M) * ll[p]; den += wgt[p]; }
        const float inv = 1.0f / den;
        float a[8];
#pragma unroll
        for (int i = 0; i < 8; ++i) a[i] = 0.f;
#pragma unroll
        for (int p = 0; p < 3; ++p) {
            const bf16_t* op = (const bf16_t*)(p < 2 ? ws + WS_OPA01 + (size_t)p * 16 * MiB : ws + WS_OPA2);
            const u32x4 v = *(const u32x4*)(op + (size_t)tk * 512 + hd * 64 + ch * 8);
            const float wp = wgt[p] * inv;
            a[0] += wp * bflo(v.x); a[1] += wp * bfhi(v.x); a[2] += wp * bflo(v.y); a[3] += wp * bfhi(v.y);
            a[4] += wp * bflo(v.z); a[5] += wp * bfhi(v.z); a[6] += wp * bflo(v.w); a[7] += wp * bfhi(v.w);
        }
        u32x4 o; o.x = pk2(a[0], a[1]); o.y = pk2(a[2], a[3]); o.z = pk2(a[4], a[5]); o.w = pk2(a[6], a[7]);
        *(u32x4*)(ob + (size_t)tk * ND + hd * 64 + ch * 8) = o;
    }
}

constexpr int LDS_IMP = 4 * KVT;
constexpr int LDS_UNI = LDS_IMP + 4096;
constexpr int LDS_TOT = 41088;
__device__ __forceinline__ void nsa_item(unsigned char* ws, int item, LAS unsigned char* lds) {
    const int tid = TID(), lane = tid & 63, w = tid >> 6, c = lane & 31, h = lane >> 5;
    const int bg = item & 15, tt = item >> 4, b = bg >> 1, g = bg & 1;
    const int t0 = tt * 32, tok8 = c & 7, hh = c >> 3, hb = g * 4 + hh, t = t0 + 8 * w + tok8;
    const bf16_t* qrow = (const bf16_t*)(ws + WS_QB) + ((size_t)(b * 8 + hb) * NS + t) * 64;
    bf16x8 qf[4]; load_qf(qf, qrow, h);
    const float ns2 = -exp2f(-(float)(hb + 1)) * LOG2E_F;
    const float* gt = (const float*)(ws + WS_GATES) + (size_t)(b * NS + t) * 24 + hb * 3;
    const float g0 = gt[0], g1 = gt[1], g2 = gt[2];
    LAS float* totL = (LAS float*)(lds + LDS_TOT) + tid;
    LAS unsigned char* Kt = lds; LAS unsigned char* Vt = lds + 2 * KVT;
    LAS float* impL = (LAS float*)(lds + LDS_IMP) + w * 256;
    LAS unsigned* uni = (LAS unsigned*)(lds + LDS_UNI);
    const int cur = t0 >> 6;
    unsigned selmask;
    {
        const bf16_t* kc = (const bf16_t*)(ws + WS_KCMP) + (size_t)bg * 128 * 64;
        const bf16_t* vc = kc + (size_t)16 * 128 * 64;
        __syncthreads();
        load_kv_tile(Kt, Vt, kc, vc, 0, 1, 0, 127, tid);
        load_kv_tile(Kt + KVT, Vt + VT, kc, vc, 64, 1, 0, 127, tid);
        if (tid == 0) uni[0] = 0u;
        __syncthreads();
        LAS const unsigned char* kp = Kt + c * KVS + 16 * h;
        f32x16 sT[4];
#pragma unroll
        for (int T = 0; T < 4; ++T) sT[T] = qk32(qf, kp + T * 32 * KVS, zero16());
        const float dAh = (float)(t - 31) - (float)(64 * h);
        float tmax = -1e30f;
#pragma unroll
        for (int T = 0; T < 4; ++T)
#pragma unroll
            for (int i = 0; i < 16; ++i) {
                const float d = dAh - (float)(16 * (32 * T + (i & 3) + 8 * (i >> 2)));
                float tv = sT[T][i] + ns2 * d;
                tv = d >= 0.f ? tv : -1e30f;
                sT[T][i] = tv; tmax = fmaxf(tmax, tv);
            }
        tmax = fmaxf(tmax, __shfl_xor(tmax, 32));
        const float mu = fmaxf(tmax, -1e29f);
        float ps = 0.f;
#pragma unroll
        for (int T = 0; T < 4; ++T)
#pragma unroll
            for (int i = 0; i < 16; ++i) { sT[T][i] = __builtin_amdgcn_exp2f(sT[T][i] - mu); ps += sT[T][i]; }
        ps += __shfl_xor(ps, 32);
        const float inv = ps > 0.f ? 1.0f / ps : 0.f;
#pragma unroll
        for (int T = 0; T < 4; ++T)
#pragma unroll
            for (int i = 0; i < 16; ++i) sT[T][i] *= inv;
        f32x16 o0 = zero16(), o1 = zero16();
        const int vq = (lane & 15) >> 2, vc0 = 2 * ((lane >> 4) & 1) + ((lane & 3) >> 1), vsx = 2 * vq;
        LAS const unsigned char* vp0 = Vt + (4 * h + vq) * VS + ((vc0 ^ vsx) * 16) + 8 * (lane & 1);
        LAS const unsigned char* vp1 = Vt + (4 * h + vq) * VS + (((vc0 + 4) ^ vsx) * 16) + 8 * (lane & 1);
#pragma unroll
        for (int T = 0; T < 4; ++T) pv32(o0, o1, sT[T], vp0 + T * 32 * VS, vp1 + T * 32 * VS);
#pragma unroll
        for (int i = 0; i < 16; ++i) { totL[i * 256] = g0 * o0[i]; totL[(16 + i) * 256] = g0 * o1[i]; }
        float mainv[16], spill[16];
#pragma unroll
        for (int T = 0; T < 4; ++T)
#pragma unroll
            for (int u = 0; u < 4; ++u) {
                const float p3 = 0.5f * sT[T][4 * u + 3];
                mainv[4 * T + u] = sT[T][4 * u] + sT[T][4 * u + 1] + sT[T][4 * u + 2] + p3;
                spill[4 * T + u] = p3;
            }
#pragma unroll
        for (int f = 0; f < 16; ++f) {
            mainv[f] += __shfl_xor(mainv[f], 8); mainv[f] += __shfl_xor(mainv[f], 16);
            spill[f] += __shfl_xor(spill[f], 8); spill[f] += __shfl_xor(spill[f], 16);
        }
#pragma unroll
        for (int f = 0; f < 16; ++f) {
            const float snd = h ? (f > 0 ? spill[f > 0 ? f - 1 : 0] : 0.f) : spill[f];
            const float rcv = __shfl_xor(snd, 32);
            mainv[f] += rcv;
        }
        if (hh == 0) {
#pragma unroll
            for (int f = 0; f < 16; ++f) impL[tok8 * 32 + 2 * f + h] = mainv[f];
        }
        asm volatile("s_waitcnt lgkmcnt(0)" ::: "memory");
        {
            const int tk = lane >> 3, tq = t0 + 8 * w + tk, cq = tq >> 6, n0 = 4 * (lane & 7);
            float sc[32];
#pragma unroll
            for (int q4 = 0; q4 < 8; ++q4) {
                const f32x4 v = *(const LAS f32x4*)(impL + tk * 32 + 4 * q4);
                sc[4 * q4] = v.x; sc[4 * q4 + 1] = v.y; sc[4 * q4 + 2] = v.z; sc[4 * q4 + 3] = v.w;
            }
#pragma unroll
            for (int n = 0; n < 32; ++n) {
                const bool valid = n <= cq, forced = (n == 0) || (cq - n < 2);
                sc[n] = valid ? sc[n] + (forced ? 1e4f : 0.f) : -1e30f;
            }
            unsigned bits = 0u;
#pragma unroll
            for (int k = 0; k < 4; ++k) {
                const int n = n0 + k;
                float mine = 0.f;
#pragma unroll
                for (int q = 0; q < 32; ++q) mine = (q == n) ? sc[q] : mine;
                int rank = 0;
#pragma unroll
                for (int q = 0; q < 32; ++q) rank += (sc[q] > mine || (sc[q] == mine && q < n)) ? 1 : 0;
                if (n <= cq && rank < 16) bits |= 1u << n;
            }
            bits |= __shfl_xor(bits, 1); bits |= __shfl_xor(bits, 2); bits |= __shfl_xor(bits, 4);
            selmask = __shfl(bits, tok8 * 8);
        }
        {
            unsigned um = selmask;
#pragma unroll
            for (int o = 1; o < 64; o <<= 1) um |= __shfl_xor(um, o);
            if (lane == 0) atomicOr((unsigned*)uni, um);
        }
        __syncthreads();
    }
    const unsigned ublk = uni[0];
    unsigned wsel = selmask;
#pragma unroll
    for (int o = 1; o < 64; o <<= 1) wsel |= __shfl_xor(wsel, o);
    int buf = 0;
    KVRegs kr;
    {
        const bf16_t* kb = (const bf16_t*)(ws + WS_KV6 + 2 * 4 * MiB) + (size_t)bg * NS * 64;
        const bf16_t* vb = (const bf16_t*)(ws + WS_KV6 + 3 * 4 * MiB) + (size_t)bg * NS * 64;
        f32x16 o0 = zero16(), o1 = zero16(); float m = -1e30f, l = 0.f;
        unsigned rem = ublk & (cur >= 31 ? 0xffffffffu : ((2u << cur) - 1u));
        int n = __builtin_ctz(rem);
        kv_fetch(kr, kb, vb, 64 * n, 1, 0, NS - 1, tid);
        while (rem) {
            rem &= rem - 1u;
            LAS unsigned char* Kc = lds + buf * KVT; LAS unsigned char* Vc = lds + 2 * KVT + buf * VT;
            kv_commit(kr, Kc, Vc, tid);
            __syncthreads();
            const int ncur = n;
            if (rem) { n = __builtin_ctz(rem); kv_fetch(kr, kb, vb, 64 * n, 1, 0, NS - 1, tid); }
            if ((wsel >> ncur) & 1u)
                fa_tile64<1, true>(o0, o1, m, l, qf, Kc, Vc, lane, (float)(t - 64 * ncur), ((selmask >> ncur) & 1u) ? 1e30f : -1.f, ns2);
            buf ^= 1;
        }
        const float lt = l + __shfl_xor(l, 32);
        { const float sc = g1 / lt;
#pragma unroll
          for (int i = 0; i < 16; ++i) { totL[i * 256] += sc * o0[i]; totL[(16 + i) * 256] += sc * o1[i]; } }
    }
    {
        const bf16_t* kb = (const bf16_t*)(ws + WS_KV6 + 4 * 4 * MiB) + (size_t)bg * NS * 64;
        const bf16_t* vb = (const bf16_t*)(ws + WS_KV6 + 5 * 4 * MiB) + (size_t)bg * NS * 64;
        f32x16 o0 = zero16(), o1 = zero16(); float m = -1e30f, l = 0.f;
        const int nlo = t0 >= 511 ? (t0 - 511) >> 6 : 0;
        kv_fetch(kr, kb, vb, 64 * nlo, 1, 0, NS - 1, tid);
        for (int n = nlo; n <= cur; ++n) {
            LAS unsigned char* Kc = lds + buf * KVT; LAS unsigned char* Vc = lds + 2 * KVT + buf * VT;
            kv_commit(kr, Kc, Vc, tid);
            __syncthreads();
            if (n < cur) kv_fetch(kr, kb, vb, 64 * (n + 1), 1, 0, NS - 1, tid);
            fa_tile64<1, true>(o0, o1, m, l, qf, Kc, Vc, lane, (float)(t - 64 * n), 511.f, ns2);
            buf ^= 1;
        }
        const float lt = l + __shfl_xor(l, 32);
        { const float sc = g2 / lt;
#pragma unroll
          for (int i = 0; i < 16; ++i) { o0[i] = totL[i * 256] + sc * o0[i]; o1[i] = totL[(16 + i) * 256] + sc * o1[i]; } }
        store_ot((bf16_t*)(ws + WS_O) + ((size_t)(b * NS + t) * ND + 512 + hb * 64), o0, o1, 1.0f, h);
    }
}

#define XB_TMO      128
#define XB_XCNT(j)  (256  + 64 * (j))
#define XB_XSUB(j)  (1280 + 64 * (j))
#define XB_XGEN(j)  (2304 + 64 * (j))
#define XB_TOP      3328
#define XB_TOPGEN   3392
#define XCD_BAR_WORDS 3456
#define XB_SPIN_CAP (1u << 18)
__device__ __forceinline__ unsigned xb_ld(unsigned* p)              { return __hip_atomic_load(p, __ATOMIC_RELAXED, __HIP_MEMORY_SCOPE_AGENT); }
__device__ __forceinline__ unsigned xb_add(unsigned* p, unsigned v) { return __hip_atomic_fetch_add(p, v, __ATOMIC_RELAXED, __HIP_MEMORY_SCOPE_AGENT); }
__device__ __forceinline__ unsigned xb_xcc_id() { return (unsigned)__builtin_amdgcn_s_getreg((3 << 11) | 20) & 0xFu; }
#define XB_SPIN(cond, bar) do { unsigned _sp = 0; while (cond) { __builtin_amdgcn_s_sleep(1); \
    if ((++_sp & 255u) == 0u) { if (xb_ld(&(bar)[XB_TMO])) break; if (_sp > XB_SPIN_CAP) { atomicAdd(&(bar)[XB_TMO], 1u); break; } } } } while (0)
struct XcdBarrier { unsigned* bar; unsigned x; volatile LAS unsigned* st; };
__device__ __forceinline__ XcdBarrier xcd_barrier_post(unsigned* bar, volatile LAS unsigned* st) {
    XcdBarrier b; b.bar = bar; b.x = xb_xcc_id(); b.st = st;
    if (threadIdx.x == 0) (void)xb_add(&bar[XB_XCNT(b.x)], 1u);
    return b;
}
__device__ __forceinline__ void xcd_barrier_complete(unsigned* bar, unsigned x, unsigned& nloc, unsigned& nx) {
    const unsigned G = gridDim.x * gridDim.y * gridDim.z;
    unsigned sum, cnt, mine, sp = 0u;
    for (;;) {
        sum = 0u; cnt = 0u; mine = 0u;
#pragma unroll
        for (unsigned j = 0; j < 16; ++j) { const unsigned c = xb_ld(&bar[XB_XCNT(j)]); sum += c; cnt += (c > 0u) ? 1u : 0u; mine = (j == x) ? c : mine; }
        if (sum == G) break;
        __builtin_amdgcn_s_sleep(1);
        if ((++sp & 255u) == 0u) { if (xb_ld(&bar[XB_TMO])) break; if (sp > XB_SPIN_CAP) { atomicAdd(&bar[XB_TMO], 1u); break; } }
    }
    nloc = mine > 0u ? mine : 1u; nx = cnt > 0u ? cnt : 1u;
}
__device__ __forceinline__ void xcd_barrier(const XcdBarrier& b) {
    asm volatile("s_waitcnt vmcnt(0)" ::: "memory");
    __syncthreads();
    if (threadIdx.x == 0) {
        unsigned* bar = b.bar;
        __builtin_amdgcn_s_waitcnt(0);
        unsigned nloc = b.st[0], nx = b.st[1];
        if (nloc == 0u) { xcd_barrier_complete(bar, b.x, nloc, nx); b.st[0] = nloc; b.st[1] = nx; }
        const unsigned old = xb_add(&bar[XB_XSUB(b.x)], 1u);
        const unsigned gen = old / nloc;
        if (old + 1u == (gen + 1u) * nloc) {
            __builtin_amdgcn_fence(__ATOMIC_RELEASE, "agent");
            asm volatile("s_waitcnt vmcnt(0)" ::: "memory");
            const unsigned og = xb_add(&bar[XB_TOP], 1u);
            const unsigned tg = og / nx;
            if (og + 1u == (tg + 1u) * nx) xb_add(&bar[XB_TOPGEN], 1u);
            else XB_SPIN(xb_ld(&bar[XB_TOPGEN]) == tg, bar);
            __builtin_amdgcn_fence(__ATOMIC_ACQUIRE, "agent");
            xb_add(&bar[XB_XGEN(b.x)], 1u);
            asm volatile("s_waitcnt vmcnt(0)" ::: "memory");
        } else {
            XB_SPIN(xb_ld(&bar[XB_XGEN(b.x)]) == gen, bar);
            __builtin_amdgcn_fence(__ATOMIC_ACQUIRE, "agent");
            asm volatile("s_waitcnt vmcnt(0)" ::: "memory");
        }
    }
    __syncthreads();
}

struct XcdTiles {
    int m_lo, cnt_m, nN, loc, nloc, tiles;
    __device__ __forceinline__ XcdTiles(int nM, int nN_) {
        const int b = BID(), g = gridDim.x;
        int x, nx;
        if ((g & 7) == 0) { x = b & 7; nx = 8; loc = b >> 3; nloc = g >> 3; } else { x = 0; nx = 1; loc = b; nloc = g; }
        m_lo = (int)((long)nM * x / nx); cnt_m = (int)((long)nM * (x + 1) / nx) - m_lo; nN = nN_; tiles = cnt_m * nN;
    }
    __device__ __forceinline__ void get(int q, int& mt, int& nt) const {
        const int mg = q / (8 * nN), rem_m = cnt_m - 8 * mg, mig = rem_m < 8 ? rem_m : 8, r = q - mg * 8 * nN;
        nt = r / mig; mt = m_lo + 8 * mg + (r - nt * mig);
    }
};
struct PhInProj { const bf16_t* xn; const unsigned char* wl; unsigned char* ws; const float* ssp; LAS unsigned char* lds; XcdTiles xt;
    __device__ __forceinline__ void make(int q, APlain& ap, BPlain& bp, EpiInProj& ep) const { int mt, nt; xt.get(q, mt, nt);
        ap = APlain{xn + (size_t)mt * 128 * ND, ND}; bp = BPlain{(const bf16_t*)(wl + WL_IN) + (size_t)nt * 128 * ND, ND}; ep = EpiInProj{mt, nt, ws, ssp, lds}; } };
struct PhCmp1 { const unsigned char* wl; unsigned char* ws; int l;
    __device__ __forceinline__ void make(int tile, ACmp& ap, BPlain& bp, EpiCmp1& ep) const { const int nt = tile & 1, bg = (tile >> 1) & 15, kv = tile >> 5;
        ap = ACmp{(const bf16_t*)(ws + WS_KV6 + (size_t)kv * 4 * MiB) + (size_t)bg * NS * 64};
        bp = BPlain{(const bf16_t*)(wl + WL_C1) + (size_t)kv * 256 * 2048 + (size_t)nt * 128 * 2048, 2048};
        ep = EpiCmp1{(bf16_t*)(ws + WS_HC) + (size_t)kv * 2048 * 256, (const float*)(ws + WS_BC1P) + l * 512 + kv * 256, bg * 128, nt * 128}; } };
struct PhCmp2 { const unsigned char* wl; unsigned char* ws;
    __device__ __forceinline__ void make(int tile, APlain& ap, BPlain& bp, EpiCmp2& ep) const { const int bg = tile & 15, kv = tile >> 4;
        ap = APlain{(const bf16_t*)(ws + WS_HC) + (size_t)kv * 2048 * 256 + (size_t)bg * 128 * 256, 256};
        bp = BPlain{(const bf16_t*)(wl + WL_C2) + (size_t)kv * 128 * 256, 256};
        ep = EpiCmp2{(bf16_t*)(ws + WS_KCMP) + (size_t)kv * 16 * 128 * 64, bg * 128}; } };
struct PhOutProj { const unsigned char* wl; unsigned char* ws; bf16_t* res; XcdTiles xt;
    __device__ __forceinline__ void make(int q, APlain& ap, BPlain& bp, EpiResAdd& ep) const { int mt, nt; xt.get(q, mt, nt);
        ap = APlain{(const bf16_t*)(ws + WS_O) + (size_t)mt * 128 * ND, ND}; bp = BPlain{(const bf16_t*)(wl + WL_OUT) + (size_t)nt * 128 * ND, ND};
        ep = EpiResAdd{res, mt * 128, nt * 128}; } };
struct PhMoe {
    LAS const int* sm; const int* list;
    __device__ __forceinline__ void decode(int gmt, int& bk, int& mt, int& rem, int& hrow0, int& elo, int& ehi) const {
        bk = 0;
        for (int k = 1; k < 24; ++k) if (gmt >= sm[32 + k]) bk = k;
        mt = gmt - sm[32 + bk]; rem = sm[bk] - mt * 128; hrow0 = sm[64 + bk] + mt * 128;
        const int grp = bk / 6, pi = bk % 6;
        elo = grp * 4 + (pi < 3 ? 0 : (pi < 5 ? 1 : 2)); ehi = grp * 4 + (pi < 3 ? pi + 1 : (pi < 5 ? pi - 1 : 3));
    } };
struct PhMoeGU { PhMoe m; const bf16_t* xn; const unsigned char* wl; unsigned char* ws; const float* route; const float* rinv; XcdTiles xt;
    __device__ __forceinline__ void make(int q, AGather& ap, BPlain& bp, EpiMoeGU& ep) const { int gmt, nt16; xt.get(q, gmt, nt16);
        int bk, mt, rem, hrow0, elo, ehi; m.decode(gmt, bk, mt, rem, hrow0, elo, ehi);
        const int* lst = m.list + (size_t)bk * NT + mt * 128; const int e = (nt16 >> 3) ? ehi : elo;
        ap = AGather{xn, lst, rem}; bp = BPlain{(const bf16_t*)(wl + WL_GU) + (size_t)e * 1024 * 1024 + (size_t)(nt16 & 7) * 128 * 1024, 1024};
        ep = EpiMoeGU{(bf16_t*)(ws + WS_HID), lst, route, rinv, rem, hrow0, nt16}; } };
struct PhMoeDown { PhMoe m; const unsigned char* wl; unsigned char* ws; bf16_t* res; float* ssp; XcdTiles xt;
    __device__ __forceinline__ void make(int q, APlain& ap, BSplit& bp, EpiMoeDown& ep) const { int gmt, nt; xt.get(q, gmt, nt);
        int bk, mt, rem, hrow0, elo, ehi; m.decode(gmt, bk, mt, rem, hrow0, elo, ehi);
        const int* lst = m.list + (size_t)bk * NT + mt * 128;
        ap = APlain{(const bf16_t*)(ws + WS_HID) + (size_t)hrow0 * 1024, 1024};
        bp = BSplit{(const bf16_t*)(wl + WL_DN) + (size_t)elo * 1024 * 512 + (size_t)nt * 128 * 512, (const bf16_t*)(wl + WL_DN) + (size_t)ehi * 1024 * 512 + (size_t)nt * 128 * 512};
        ep = EpiMoeDown{res, lst, ssp, rem, nt * 128}; } };
struct PhPleProj { const unsigned char* wl; unsigned char* ws; XcdTiles xt;
    __device__ __forceinline__ void make(int q, APlain& ap, BPlain& bp, EpiBf16& ep) const { int mt, nt; xt.get(q, mt, nt);
        ap = APlain{(const bf16_t*)(ws + WS_PB) + (size_t)mt * 128 * 256, 256}; bp = BPlain{(const bf16_t*)(wl + WL_PP) + (size_t)nt * 128 * 256, 256};
        ep = EpiBf16{(bf16_t*)(ws + WS_P2), ND, mt * 128, nt * 128}; } };
struct PhPleGate { const bf16_t* xn; const unsigned char* wl; unsigned char* ws; float* out; float sc; XcdTiles xt;
    __device__ __forceinline__ void make(int q, APlain& ap, BPlain& bp, EpiPleGate& ep) const { int mt, nt; xt.get(q, mt, nt);
        ap = APlain{xn + (size_t)mt * 128 * ND, ND}; bp = BPlain{(const bf16_t*)(wl + WL_PG) + (size_t)nt * 128 * ND, ND};
        ep = EpiPleGate{out, (const bf16_t*)(ws + WS_P2), mt * 128, nt * 128, sc}; } };

constexpr int LDS_QSLOT = 73856 + 16 + 448;
__device__ __forceinline__ int wq_next(int* head, LAS unsigned char* lds) {
    LAS int* slot = (LAS int*)(lds + LDS_QSLOT);
    __syncthreads();
    if (threadIdx.x == 0) *slot = atomicAdd(head, 1);
    __syncthreads();
    return *slot;
}
__device__ __forceinline__ void ple_stream(const bf16_t* xn, const bf16_t* pb, const unsigned char* wl, const float* ssp_in, bf16_t* rout, float* ssp_out, LAS unsigned char* lds) {
    const XcdTiles xt(128, 8);
    int q = xt.loc;
    if (q >= xt.tiles) return;
    const int tid = TID(), wid = tid >> 6, lane = tid & 63, wr = wid >> 1, wc = wid & 1, fr = lane & 15, fq = lane >> 4;
    int mt, nt; xt.get(q, mt, nt);
    bool pref = false;
    for (;;) {
        const int qn = q + xt.nloc; const bool hn = qn < xt.tiles;
        int mtn = mt, ntn = nt; if (hn) xt.get(qn, mtn, ntn);
        const APlain ap1{pb + (size_t)mt * 128 * 256, 256}; const BPlain bp1{(const bf16_t*)(wl + WL_PP) + (size_t)nt * 128 * 256, 256};
        const APlain ap2{xn + (size_t)mt * 128 * ND, ND};   const BPlain bp2{(const bf16_t*)(wl + WL_PG) + (size_t)nt * 128 * ND, ND};
        const APlain apn{pb + (size_t)mtn * 128 * 256, 256}; const BPlain bpn{(const bf16_t*)(wl + WL_PP) + (size_t)ntn * 128 * 256, 256};
        f32x4 acc[4][4], acc2[4][4]; zero_acc(acc); zero_acc(acc2);
        gemm_kloop(acc2, ap1, bp1, 256, lds, pref, true, ap2, bp2);
        gemm_kloop(acc, ap2, bp2, ND, lds, true, hn, apn, bpn);
        const EpiPleFused ep{xn, ssp_in, rout, ssp_out, mt * 128, nt * 128};
        ep(acc, acc2, wr, wc, fr, fq);
        if (!hn) break;
        q = qn; mt = mtn; nt = ntn; pref = true;
    }
}

constexpr int LDS_BAR = 73856;
constexpr int LDS_SM = LDS_BAR + 16;
constexpr int LDS_BYTES = LDS_SM + 512;
static_assert(LDS_QSLOT == LDS_SM + 448, "queue slot");
static_assert(4 * KVT + 4096 + 64 <= LDS_TOT && LDS_TOT + 32768 <= LDS_BAR && 65536 <= LDS_BAR, "LDS map");

__global__ void __launch_bounds__(256, 2) mega_fwd(Params p) {
    extern __shared__ __attribute__((aligned(16))) unsigned char lds_raw[];
    LAS unsigned char* lds = (LAS unsigned char*)lds_raw;
    unsigned char* ws = p.ws;
    const int tid = threadIdx.x;
    const int gtid = blockIdx.x * 256 + tid, gthreads = gridDim.x * 256;
    int* ctl = (int*)(ws + WS_CTL);
    {
        volatile LAS unsigned* st = (volatile LAS unsigned*)(lds + LDS_BAR);
        if (tid < 4) st[tid] = 0u;
        __syncthreads();
    }
    const XcdBarrier gbar = xcd_barrier_post((unsigned*)ctl + CW_BAR, (volatile LAS unsigned*)(lds + LDS_BAR));

    phase_convert(p, (LAS float*)lds);
    xcd_barrier(gbar);

    float* sspA = (float*)(ws + WS_SSP);
    float* sspB = sspA + (size_t)NT * 16;
    float* rinv = (float*)(ws + WS_RINV);
    for (int l = 0; l < 2; ++l) {
        const unsigned char* wl = ws + WS_W + (size_t)l * WL_SIZE;
        bf16_t* xn = (bf16_t*)p.out + (size_t)(l & 1) * NT * ND;
        bf16_t* rnext = l == 1 ? (bf16_t*)(ws + WS_XN) : (bf16_t*)p.out + (size_t)((l + 1) & 1) * NT * ND;
        const bf16_t* xb_in = xn;
        {
            const PhInProj ph{xb_in, wl, ws, sspB, lds, XcdTiles(128, 23)};
            gemm_stream<PhInProj, APlain, BPlain, EpiInProj>(ph, ph.xt.loc, ph.xt.nloc, ph.xt.tiles, ND, lds);
        }
        xcd_barrier(gbar);
        {
            int* qh = ctl + CW_Q + (l * 4 + 0) * 64;
            int* ch = ctl + CW_Q + (l * 4 + 2) * 64;
            const int nconv = conv_queue_strips(2 * l);
            const PhCmp1 ph{wl, ws, l};
            bool conv_left = nconv > 0, att_left = true, first_att = true;
            for (int k = 0; conv_left || att_left; ++k) {
                const bool want_conv = conv_left && (!att_left || (k % 7) == 6);
                if (want_conv) {
                    const int c = wq_next(ch, lds);
                    if (c < nconv) conv_strip(p, 2 * l, c, (LAS float*)lds); else conv_left = false;
                } else {
                    const int it = first_att ? BID() : (int)gridDim.x + wq_next(qh, lds);
                    first_att = false;
                    if (it >= 64 + 1536) att_left = false;
                    else if (it < 64) { ACmp ap; BPlain bp; EpiCmp1 ep; ph.make(it, ap, bp, ep); gemm_tile(ap, bp, 2048, ep, lds, false, false, ap, bp); }
                    else { dil_item(ws, 2 * (it - 64), lds); __syncthreads(); dil_item(ws, 2 * (it - 64) + 1, lds); }
                }
            }
        }
        xcd_barrier(gbar);
        { const PhCmp2 ph{wl, ws}; gemm_stream<PhCmp2, APlain, BPlain, EpiCmp2>(ph, BID(), gridDim.x, 32, 256, lds); }
        dil_merge(ws, gtid, gthreads);
        if (l == 0) convert_p(p);
        xcd_barrier(gbar);
        {
            int* qh = ctl + CW_Q + (l * 4 + 1) * 64;
            int* ch = ctl + CW_Q + (l * 4 + 3) * 64;
            const int nconv = conv_queue_strips(2 * l + 1);
            bool conv_left = nconv > 0, att_left = true, first_att = true;
            for (int k = 0; conv_left || att_left; ++k) {
                const bool want_conv = conv_left && (!att_left || (k % 4) == 3);
                if (want_conv) {
                    const int c = wq_next(ch, lds);
                    if (c < nconv) conv_strip(p, 2 * l + 1, c, (LAS float*)lds); else conv_left = false;
                } else {
                    const int it = first_att ? BID() : (int)gridDim.x + wq_next(qh, lds);
                    first_att = false;
                    if (it >= 1024) att_left = false;
                    else nsa_item(ws, ((63 - (it >> 4)) << 4) | (it & 15), lds);
                }
            }
        }
        xcd_barrier(gbar);
        { const PhOutProj ph{wl, ws, xn, XcdTiles(128, 8)};
          gemm_stream<PhOutProj, APlain, BPlain, EpiResAdd>(ph, ph.xt.loc, ph.xt.nloc, ph.xt.tiles, ND, lds); }
        xcd_barrier(gbar);
        int* cnt = ctl + CW_CNTP + l * 1536;
        int* list = (int*)(ws + WS_LIST);
        float* route = (float*)(ws + WS_ROUTE);
        phase_route(xn, (const float*)(wl + WL_RT), p.in[12] + l * 4, p.in[14] + l * 16, cnt, list, route, rinv, lds);
        xcd_barrier(gbar);
        LAS int* sm = (LAS int*)(lds + LDS_SM);
        __syncthreads();
        if (tid < 24) sm[tid] = __hip_atomic_load(cnt + 64 * tid, __ATOMIC_RELAXED, __HIP_MEMORY_SCOPE_AGENT);
        __syncthreads();
        if (tid == 0) {
            int tp = 0, hb = 0;
            for (int k = 0; k < 24; ++k) {
                const int c = sm[k];
                sm[32 + k] = tp; sm[64 + k] = hb;
                const int nt_ = (c + 127) >> 7; tp += nt_; hb += nt_ * 128;
            }
            sm[32 + 24] = tp;
        }
        __syncthreads();
        const int total_mt = sm[32 + 24];
        { const PhMoeGU ph{PhMoe{sm, list}, xn, wl, ws, route, rinv, XcdTiles(total_mt, 16)};
          gemm_stream<PhMoeGU, AGather, BPlain, EpiMoeGU>(ph, ph.xt.loc, ph.xt.nloc, ph.xt.tiles, ND, lds); }
        xcd_barrier(gbar);
        { const PhMoeDown ph{PhMoe{sm, list}, wl, ws, xn, sspA, XcdTiles(total_mt, 8)};
          gemm_stream<PhMoeDown, APlain, BSplit, EpiMoeDown>(ph, ph.xt.loc, ph.xt.nloc, ph.xt.tiles, ND, lds); }
        xcd_barrier(gbar);
        ple_stream(xn, (const bf16_t*)(ws + WS_PBALL) + (size_t)l * NT * 256, wl, sspA, rnext, sspB, lds);
        xcd_barrier(gbar);
    }
    phase_final_norm((const bf16_t*)(ws + WS_XN), p.out, p.in[21]);
}

extern "C" void kernel_launch(void* const* d_in, const int* in_sizes, int n_in, void* d_out, int out_size, void* d_ws, size_t ws_size, hipStream_t stream) {
    static int grid = 0;
    if (grid == 0) {
        if (n_in != 22 || out_size != NT * ND || ws_size < WS_END) { fprintf(stderr, "kernel_launch: unexpected shapes (n_in %d out %d ws %zu)\n", n_in, out_size, ws_size); grid = -1; return; }
        int dev = 0, cus = 0, per_cu = 0;
        hipGetDevice(&dev);
        hipDeviceGetAttribute(&cus, hipDeviceAttributeMultiprocessorCount, dev);
        if (hipFuncSetAttribute((const void*)mega_fwd, hipFuncAttributeMaxDynamicSharedMemorySize, LDS_BYTES) != hipSuccess) { fprintf(stderr, "kernel_launch: hipFuncSetAttribute failed\n"); grid = -1; return; }
        hipOccupancyMaxActiveBlocksPerMultiprocessor(&per_cu, (const void*)mega_fwd, 256, LDS_BYTES);
        if (per_cu < 1) { fprintf(stderr, "kernel_launch: occupancy query says %d\n", per_cu); grid = -1; return; }
        if (per_cu > 2) per_cu = 2;
        grid = cus * per_cu;
    }
    if (grid < 0) return;
    hipMemsetAsync((char*)d_ws + WS_CTL, 0, 32768, stream);
    Params p{};
    for (int i = 0; i < 22; ++i) p.in[i] = (const float*)d_in[i];
    p.out = (float*)d_out; p.ws = (unsigned char*)d_ws;
    hipLaunchKernelGGL(mega_fwd, dim3(grid), dim3(256), LDS_BYTES, stream, p);
    const hipError_t e = hipPeekAtLastError();
    if (e != hipSuccess) fprintf(stderr, "launch failed: %s (grid %d)\n", hipGetErrorString(e), grid);
}
```

```cpp
#include <hip/hip_runtime.h>
#include <cstdio>
#include <cstdint>

#ifndef NAIVE_GEMM
#define NAIVE_GEMM 0
#endif
#ifndef NAIVE_ATTN
#define NAIVE_ATTN 0
#endif
#define REP_CONV 1
#define REP_INPROJ 1
#define REP_ATTN 1
#define REP_GU 1
#define REP_NORM 1
#define REP_ROUTE 1
#define REP_DOWN 1
#define REP_OUTPROJ 1
#define REP_PG 1
#define REP_CMP 1
#define REP_MISC 1

#define LAS __attribute__((address_space(3)))
typedef unsigned short bf16_t;
typedef short bf16x8 __attribute__((ext_vector_type(8)));
typedef float f32x4 __attribute__((ext_vector_type(4)));
typedef unsigned u32x4 __attribute__((ext_vector_type(4)));
typedef unsigned u32x2 __attribute__((ext_vector_type(2)));
typedef float f32x16 __attribute__((ext_vector_type(16)));
typedef short s16x4 __attribute__((ext_vector_type(4)));
typedef float f32x2_t __attribute__((ext_vector_type(2)));
typedef __bf16 bf16x2_t __attribute__((ext_vector_type(2)));

constexpr int NB = 8, NS = 2048, ND = 1024, NT = NB * NS;
constexpr int NIN = 2840, NINP = 2944;
constexpr size_t MiB = (size_t)1 << 20;
constexpr size_t WL_IN = 0;
constexpr size_t WL_OUT = WL_IN + (size_t)NINP * 1024 * 2;
constexpr size_t WL_C1 = WL_OUT + (size_t)1024 * 1024 * 2;
constexpr size_t WL_C2 = WL_C1 + (size_t)2 * 256 * 2048 * 2;
constexpr size_t WL_GU = WL_C2 + (size_t)2 * 128 * 256 * 2;
constexpr size_t WL_DN = WL_GU + (size_t)16 * 1024 * 1024 * 2;
constexpr size_t WL_PG = WL_DN + (size_t)16 * 1024 * 512 * 2;
constexpr size_t WL_PP = WL_PG + (size_t)1024 * 1024 * 2;
constexpr size_t WL_BC1 = WL_PP + (size_t)1024 * 256 * 2;
constexpr size_t WL_RT = WL_BC1 + 2048;
constexpr size_t WL_SIZE = 64 * MiB;
static_assert(WL_RT + 131072 <= WL_SIZE, "weight block");
constexpr size_t WS_CTL = 0;
constexpr size_t WS_W = 1 * MiB;
constexpr size_t WS_XN = WS_W + 2 * WL_SIZE;
constexpr size_t WS_PROJ = WS_XN + 32 * MiB;
constexpr size_t WS_QA = WS_PROJ, WS_KA = WS_QA + 16 * MiB, WS_VA = WS_KA + 16 * MiB, WS_QB = WS_VA + 16 * MiB;
constexpr size_t WS_KV6 = WS_QB + 16 * MiB;
constexpr size_t WS_GATES = WS_KV6 + 24 * MiB;
constexpr size_t WS_PROJ_END = WS_GATES + 2 * MiB;
constexpr size_t WS_HID = WS_PROJ;
constexpr size_t WS_P2 = WS_PROJ + 40 * MiB;
constexpr size_t WS_PB = WS_PROJ + 72 * MiB;
constexpr size_t WS_HC = WS_PROJ_END;
constexpr size_t WS_KCMP = WS_HC + 2 * MiB;
constexpr size_t WS_MASK = WS_KCMP + 512 * 1024;
constexpr size_t WS_ROUTE = WS_MASK + 128 * 1024;
constexpr size_t WS_LIST = WS_ROUTE + 128 * 1024;
constexpr size_t WS_O = WS_LIST + 1536 * 1024 + 256 * 1024;
constexpr size_t WS_IMPH = WS_O + 32 * MiB;
constexpr size_t WS_OPA01 = WS_XN;
constexpr size_t WS_OPA2 = WS_IMPH;
constexpr size_t WS_STA = WS_IMPH + 16 * MiB;
constexpr size_t WS_PBALL = WS_IMPH + 20 * MiB;
constexpr size_t WS_SSP = WS_PBALL + 16 * MiB;
constexpr size_t WS_RINV = WS_MASK;
constexpr size_t WS_BC1P = WS_SSP + 2 * MiB;
constexpr size_t WS_END = WS_BC1P + 64 * 1024;
static_assert(WS_PB + 8 * MiB <= WS_PROJ_END, "alias map");
static_assert(WS_END <= 330 * MiB, "workspace");
constexpr int HID_ROWS = NT + 24 * 128;
constexpr int CW_BAR = 1024;
constexpr int CW_Q = 256;
constexpr int CW_CNTP = 4608;
constexpr int CW_CNT = 64;

struct Params {
    const float* in[22];
    float* out;
    unsigned char* ws;
};

__device__ __forceinline__ unsigned f2bf(float f) { unsigned u = __float_as_uint(f); return (u + 0x7fffu + ((u >> 16) & 1u)) >> 16; }
__device__ __forceinline__ unsigned pk2(float lo, float hi) { return f2bf(lo) | (f2bf(hi) << 16); }
__device__ __forceinline__ float bflo(unsigned v) { return __uint_as_float(v << 16); }
__device__ __forceinline__ float bfhi(unsigned v) { return __uint_as_float(v & 0xffff0000u); }
__device__ __forceinline__ float wave_sum(float v) {
#pragma unroll
    for (int o = 1; o < 64; o <<= 1) v += __shfl_xor(v, o);
    return v;
}
__device__ __forceinline__ int TID() { int t = threadIdx.x; asm volatile("" : "+v"(t)); return t; }
__device__ __forceinline__ int BID() { int t = blockIdx.x; asm volatile("" : "+s"(t)); return t; }
__device__ __forceinline__ float sigmoidf_(float x) { return 1.0f / (1.0f + __expf(-x)); }
__device__ __forceinline__ float gelu_tanh(float x) {
    const float u = 0.7978845608028654f * (x + 0.044715f * x * x * x);
    const float e = __expf(2.0f * u);
    const float th = 1.0f - 2.0f / (e + 1.0f);
    return 0.5f * x * (1.0f + th);
}

struct ConvJob { const float* src; bf16_t* dst; const float* gain; int K, N, NP, map, per; size_t dst_bstride; };
__device__ __forceinline__ int conv_job_tiles(int j) { return j == 0 ? 736 : (j == 1 || j == 9) ? 256 : (j == 2 || j == 3) ? 128 : (j == 4 || j == 5) ? 8 : j == 10 ? 64 : 2048; }
__device__ __forceinline__ ConvJob conv_job(const Params& p, int l, int j) {
    unsigned char* wl = p.ws + WS_W + (size_t)l * WL_SIZE;
    ConvJob c; c.map = 0; c.dst_bstride = 0; c.gain = nullptr;
    switch (j) {
    case 0: c.src = p.in[3] + (size_t)l * 1024 * NIN; c.K = 1024; c.N = NIN; c.NP = NINP; c.dst = (bf16_t*)(wl + WL_IN); c.gain = p.in[2] + l * ND; break;
    case 1: c.src = p.in[4] + (size_t)l * 1024 * 1024; c.K = 1024; c.N = 1024; c.NP = 1024; c.dst = (bf16_t*)(wl + WL_OUT); break;
    case 2: c.src = p.in[5] + (size_t)l * 2048 * 256; c.K = 2048; c.N = 256; c.NP = 256; c.dst = (bf16_t*)(wl + WL_C1); break;
    case 3: c.src = p.in[7] + (size_t)l * 2048 * 256; c.K = 2048; c.N = 256; c.NP = 256; c.dst = (bf16_t*)(wl + WL_C1) + (size_t)256 * 2048; break;
    case 4: c.src = p.in[6] + (size_t)l * 256 * 64; c.K = 256; c.N = 64; c.NP = 128; c.dst = (bf16_t*)(wl + WL_C2); break;
    case 5: c.src = p.in[8] + (size_t)l * 256 * 64; c.K = 256; c.N = 64; c.NP = 128; c.dst = (bf16_t*)(wl + WL_C2) + (size_t)128 * 256; break;
    case 6: c.src = p.in[15] + (size_t)l * 16 * 1024 * 512; c.K = 1024; c.N = 512; c.NP = 512; c.dst = (bf16_t*)(wl + WL_GU); c.map = 1; c.dst_bstride = (size_t)1024 * 1024; c.gain = p.in[10] + l * ND; break;
    case 7: c.src = p.in[16] + (size_t)l * 16 * 1024 * 512; c.K = 1024; c.N = 512; c.NP = 512; c.dst = (bf16_t*)(wl + WL_GU); c.map = 2; c.dst_bstride = (size_t)1024 * 1024; c.gain = p.in[10] + l * ND; break;
    case 8: c.src = p.in[17] + (size_t)l * 16 * 512 * 1024; c.K = 512; c.N = 1024; c.NP = 1024; c.dst = (bf16_t*)(wl + WL_DN); c.dst_bstride = (size_t)1024 * 512; break;
    case 9: c.src = p.in[19] + (size_t)l * 1024 * 1024; c.K = 1024; c.N = 1024; c.NP = 1024; c.dst = (bf16_t*)(wl + WL_PG); c.gain = p.in[18] + l * ND; break;
    default: c.src = p.in[20] + (size_t)l * 256 * 1024; c.K = 256; c.N = 1024; c.NP = 1024; c.dst = (bf16_t*)(wl + WL_PP); break;
    }
    c.per = (c.K / 64) * (c.NP / 64);
    return c;
}
__device__ __forceinline__ void convert_tiles(const ConvJob& c, int t0, int t1, LAS float* tl) {
    const int tid = TID();
    const int ntiles = c.NP / 64;
    const int kr = tid >> 4, c4 = (tid & 15) * 4;
    f32x4 v[4]; float gv[4];
#define CT_LOAD(it_) do { const int _bi = (it_) / c.per, _r = (it_) - _bi * c.per, _kt = _r / ntiles, _nt = _r - _kt * ntiles; \
        const int _n = _nt * 64 + c4; const bool _ok = _n < c.N; \
        const float* _sp = c.src + (size_t)_bi * c.K * c.N + (size_t)(_kt * 64 + kr) * c.N + (_ok ? _n : 0); \
        _Pragma("unroll") for (int _i = 0; _i < 4; ++_i) v[_i] = *(const f32x4*)(_sp + (size_t)(16 * _i) * c.N); \
        if (c.gain) { _Pragma("unroll") for (int _i = 0; _i < 4; ++_i) gv[_i] = c.gain[_kt * 64 + kr + 16 * _i]; } \
        else { _Pragma("unroll") for (int _i = 0; _i < 4; ++_i) gv[_i] = 1.0f; } \
        if (!_ok) { _Pragma("unroll") for (int _i = 0; _i < 4; ++_i) gv[_i] = 0.f; } } while (0)
    CT_LOAD(t0);
    for (int it = t0; it < t1; ++it) {
        const int bi = it / c.per, r = it - bi * c.per, kt = r / ntiles, nt = r - kt * ntiles;
        bf16_t* d = c.dst + (size_t)bi * c.dst_bstride;
        const int k0 = kt * 64, n0 = nt * 64;
        __syncthreads();
#pragma unroll
        for (int i = 0; i < 4; ++i) {
            LAS float* tp = tl + (kr + 16 * i) * 65 + c4;
            tp[0] = v[i].x * gv[i]; tp[1] = v[i].y * gv[i]; tp[2] = v[i].z * gv[i]; tp[3] = v[i].w * gv[i];
        }
        if (it + 1 < t1) CT_LOAD(it + 1);
        __syncthreads();
        const int n = tid >> 2, kc = (tid & 3) * 16;
        const int nsrc = n0 + n;
        const int row = (c.map == 0) ? nsrc : ((nsrc >> 4) * 32 + (nsrc & 15) + (c.map == 2 ? 16 : 0));
        float w[16];
#pragma unroll
        for (int j = 0; j < 16; ++j) w[j] = tl[(kc + j) * 65 + n];
        u32x4 o0, o1;
        o0.x = pk2(w[0], w[1]); o0.y = pk2(w[2], w[3]); o0.z = pk2(w[4], w[5]); o0.w = pk2(w[6], w[7]);
        o1.x = pk2(w[8], w[9]); o1.y = pk2(w[10], w[11]); o1.z = pk2(w[12], w[13]); o1.w = pk2(w[14], w[15]);
        bf16_t* dp = d + (size_t)row * c.K + k0 + kc;
        *(u32x4*)dp = o0; *(u32x4*)(dp + 8) = o1;
    }
#undef CT_LOAD
}
__device__ __forceinline__ int conv_list(int q, int i) {
    if (q == 0) return i == 0 ? 6 : (i == 1 ? 7 : -1);
    if (q == 1) return i == 0 ? 8 : i == 1 ? 9 : i == 2 ? 10 : i == 3 ? 16 : i == 4 ? 18 : i == 5 ? 19 : i == 6 ? 20 : i == 7 ? 21 : -1;
    if (q == 2) return i == 0 ? 17 : i == 1 ? 22 : i == 2 ? 23 : -1;
    return i == 0 ? 24 : i == 1 ? 25 : i == 2 ? 26 : -1;
}
__device__ __forceinline__ int conv_queue_strips(int q) {
    int n = 0;
    for (int i = 0; i < 8; ++i) { const int e = conv_list(q, i); if (e < 0) break; n += conv_job_tiles(e & 15) >> 3; }
    return n;
}
__device__ __forceinline__ void conv_strip(const Params& p, int q, int c, LAS float* tl) {
    for (int i = 0; i < 8; ++i) {
        const int e = conv_list(q, i);
        if (e < 0) return;
        const int ns = conv_job_tiles(e & 15) >> 3;
        if (c < ns) { const ConvJob job = conv_job(p, e >> 4, e & 15); convert_tiles(job, c * 8, c * 8 + 8, tl); return; }
        c -= ns;
    }
}

__device__ __forceinline__ void convert_p(const Params& p) {
    const f32x4* pl = (const f32x4*)p.in[1]; u32x2* pb = (u32x2*)(p.ws + WS_PBALL);
    for (int i = BID() * 256 + TID(); i < 2 * NT * 256 / 4; i += gridDim.x * 256) {
        const f32x4 v = pl[i]; u32x2 w; w.x = pk2(v.x, v.y); w.y = pk2(v.z, v.w); pb[i] = w;
    }
}
__device__ __forceinline__ void phase_convert(const Params& p, LAS float* tl) {
    {
        int base = 0;
        for (int j = 0; j < 6; ++j) {
            const ConvJob job = conv_job(p, 0, j);
            const int nt = conv_job_tiles(j);
            const int g = gridDim.x, b = BID();
            int first = (b - base % g + g) % g;
            for (int s = first; s < nt; s += g) convert_tiles(job, s, s + 1, tl);
            base += nt;
        }
    }
    {
        const int skip = gridDim.x >= 128 ? 64 : 0;
        const int tid_ = TID(); const int lane = tid_ & 63, gw = (BID() - skip) * 4 + (tid_ >> 6), ngw = (gridDim.x - skip) * 4;
        for (int row = gw >= 0 ? gw : NT; row < NT; row += ngw) {
            const f32x4* xr = (const f32x4*)(p.in[0] + (size_t)row * ND) + lane;
            u32x2* o = (u32x2*)((bf16_t*)p.out + (size_t)row * ND) + lane;
            float ss = 0.f;
#pragma unroll
            for (int j = 0; j < 4; ++j) { const f32x4 v = xr[64 * j]; ss += (v.x * v.x + v.y * v.y) + (v.z * v.z + v.w * v.w); u32x2 w; w.x = pk2(v.x, v.y); w.y = pk2(v.z, v.w); o[64 * j] = w; }
            ss = wave_sum(ss);
            if (lane < 16) ((float*)(p.ws + WS_SSP) + (size_t)NT * 16)[(size_t)row * 16 + lane] = lane == 0 ? ss : 0.f;
        }
    }
    for (int i = BID() * 256 + TID(); i < 2 * 1024 * 32; i += gridDim.x * 256) {
        const int l = i >> 15, k = (i >> 5) & 1023, j = i & 31;
        const float gk = p.in[10][l * ND + k];
        const float wv = j < 4 ? p.in[11][(size_t)(l * ND + k) * 4 + j] : (j < 20 ? p.in[13][(size_t)(l * ND + k) * 16 + (j - 4)] : 0.f);
        ((float*)(p.ws + WS_W + (size_t)l * WL_SIZE + WL_RT))[k * 32 + j] = gk * wv;
    }
    for (int i = BID() * 256 + TID(); i < 16 * 1024; i += gridDim.x * 256) {
        const int part = i >> 10, o = i & 1023, l = o >> 9, kv = (o >> 8) & 1, n = o & 255;
        const float* pos = p.in[9] + (size_t)(l * 2 + kv) * 2048 + part * 128;
        const float* w1 = p.in[kv ? 7 : 5] + (size_t)l * 2048 * 256 + (size_t)part * 128 * 256 + n;
        float s = 0.f;
#pragma unroll 16
        for (int k = 0; k < 128; ++k) s += pos[k] * w1[(size_t)k * 256];
        ((float*)(p.ws + WS_BC1P))[i] = s;
    }
}

__device__ __forceinline__ void phase_norm(const float* x, const float* g, bf16_t* xn) {
    const int tid_ = TID(); const int lane = tid_ & 63, gw = BID() * 4 + (tid_ >> 6), ngw = gridDim.x * 4;
    for (int row = gw; row < NT; row += ngw) {
        const f32x4* xr = (const f32x4*)(x + (size_t)row * ND) + lane;
        f32x4 v[4]; float ss = 0.f;
#pragma unroll
        for (int j = 0; j < 4; ++j) { v[j] = xr[64 * j]; ss += (v[j].x * v[j].x + v[j].y * v[j].y) + (v[j].z * v[j].z + v[j].w * v[j].w); }
        ss = wave_sum(ss);
        const float r = 1.0f / sqrtf(ss * (1.0f / ND) + 1e-6f);
        u32x2* o = (u32x2*)(xn + (size_t)row * ND) + lane;
#pragma unroll
        for (int j = 0; j < 4; ++j) {
            const f32x4 gg = ((const f32x4*)g)[lane + 64 * j];
            u32x2 w; w.x = pk2(v[j].x * r * gg.x, v[j].y * r * gg.y); w.y = pk2(v[j].z * r * gg.z, v[j].w * r * gg.w);
            o[64 * j] = w;
        }
    }
}
__device__ __forceinline__ void phase_final_norm(const bf16_t* xb, float* out, const float* g) {
    const int tid_ = TID(); const int lane = tid_ & 63, gw = BID() * 4 + (tid_ >> 6), ngw = gridDim.x * 4;
    for (int row = gw; row < NT; row += ngw) {
        const u32x2* xr = (const u32x2*)(xb + (size_t)row * ND) + lane;
        f32x4* orow = (f32x4*)(out + (size_t)row * ND) + lane;
        f32x4 v[4]; float ss = 0.f;
#pragma unroll
        for (int j = 0; j < 4; ++j) { const u32x2 w = xr[64 * j]; v[j] = (f32x4){bflo(w.x), bfhi(w.x), bflo(w.y), bfhi(w.y)}; ss += (v[j].x * v[j].x + v[j].y * v[j].y) + (v[j].z * v[j].z + v[j].w * v[j].w); }
        ss = wave_sum(ss);
        const float r = 1.0f / sqrtf(ss * (1.0f / ND) + 1e-6f);
#pragma unroll
        for (int j = 0; j < 4; ++j) {
            const f32x4 gg = ((const f32x4*)g)[lane + 64 * j];
            f32x4 o; o.x = v[j].x * r * gg.x; o.y = v[j].y * r * gg.y; o.z = v[j].z * r * gg.z; o.w = v[j].w * r * gg.w;
            orow[64 * j] = o;
        }
    }
}
typedef float f32x16r __attribute__((ext_vector_type(16)));
__device__ __forceinline__ void phase_route(const bf16_t* x, const float* wr, const float* brg, const float* bre, int* cnt, int* list, float* route, float* rinv, LAS unsigned char* lds) {
    const int tid_ = TID(); const int lane = tid_ & 63, wv = tid_ >> 6;
    const int i = lane & 31, hk = lane >> 5;
    LAS float* tl = (LAS float*)lds + wv * (32 * 33);
    LAS float* ssl = (LAS float*)(lds + 4 * 32 * 33 * 4);
    for (int task = BID(); task < NT / 32; task += gridDim.x) {
        const int row0 = task * 32;
        const bf16_t* xr = x + (size_t)(row0 + i) * ND + wv * 256;
        const float* wp = wr + (size_t)(wv * 256) * 32 + hk * 32 + i;
        f32x16r acc;
#pragma unroll
        for (int q = 0; q < 16; ++q) acc[q] = 0.f;
        float ss = 0.f;
#pragma unroll 8
        for (int k8 = 0; k8 < 32; ++k8) {
            const u32x4 xa = *(const u32x4*)(xr + 8 * k8);
            const float a0 = hk ? bfhi(xa.x) : bflo(xa.x), a1 = hk ? bfhi(xa.y) : bflo(xa.y), a2 = hk ? bfhi(xa.z) : bflo(xa.z), a3 = hk ? bfhi(xa.w) : bflo(xa.w);
            const float* wq = wp + (size_t)(8 * k8) * 32;
            acc = __builtin_amdgcn_mfma_f32_32x32x2f32(a0, wq[0], acc, 0, 0, 0);
            acc = __builtin_amdgcn_mfma_f32_32x32x2f32(a1, wq[2 * 32], acc, 0, 0, 0);
            acc = __builtin_amdgcn_mfma_f32_32x32x2f32(a2, wq[4 * 32], acc, 0, 0, 0);
            acc = __builtin_amdgcn_mfma_f32_32x32x2f32(a3, wq[6 * 32], acc, 0, 0, 0);
            ss += (a0 * a0 + a1 * a1) + (a2 * a2 + a3 * a3);
        }
        ss += __shfl_xor(ss, 32);
#pragma unroll
        for (int q = 0; q < 16; ++q) tl[((q & 3) + 8 * (q >> 2) + 4 * hk) * 33 + i] = acc[q];
        if (hk == 0) ssl[wv * 32 + i] = ss;
        __syncthreads();
        if (wv == 0 && hk == 0) {
            LAS const float* tp0 = (LAS const float*)lds;
            const float sst = (ssl[i] + ssl[32 + i]) + (ssl[64 + i] + ssl[96 + i]);
            const float r = 1.0f / sqrtf(sst * (1.0f / ND) + 1e-6f);
#define RT_SUM(e_) ((tp0[i * 33 + (e_)] + tp0[32 * 33 + i * 33 + (e_)]) + (tp0[2 * 32 * 33 + i * 33 + (e_)] + tp0[3 * 32 * 33 + i * 33 + (e_)]))
            float gl[4], el[16];
#pragma unroll
            for (int e = 0; e < 4; ++e) gl[e] = RT_SUM(e) * r + brg[e];
#pragma unroll
            for (int e = 0; e < 16; ++e) el[e] = RT_SUM(4 + e) * r + bre[e];
#undef RT_SUM
            int gsel = 0; float gmax = gl[0];
#pragma unroll
            for (int e = 1; e < 4; ++e) if (gl[e] > gmax) { gmax = gl[e]; gsel = e; }
            float gden = 0.f;
#pragma unroll
            for (int e = 0; e < 4; ++e) gden += __expf(gl[e] - gmax);
            const float gw_ = 1.0f / gden;
            float wi[4];
#pragma unroll
            for (int e = 0; e < 4; ++e) wi[e] = gsel == 0 ? el[e] : (gsel == 1 ? el[4 + e] : (gsel == 2 ? el[8 + e] : el[12 + e]));
            int i0 = 0; float t0 = wi[0];
#pragma unroll
            for (int e = 1; e < 4; ++e) if (wi[e] > t0) { t0 = wi[e]; i0 = e; }
            int i1 = -1; float t1 = -3.0e38f;
#pragma unroll
            for (int e = 0; e < 4; ++e) if (e != i0 && wi[e] > t1) { t1 = wi[e]; i1 = e; }
            const float ex = __expf(t1 - t0);
            const float ew0 = gw_ / (1.0f + ex), ew1 = gw_ * ex / (1.0f + ex);
            const int lo = i0 < i1 ? i0 : i1, hi = i0 < i1 ? i1 : i0;
            const float wlo = i0 < i1 ? ew0 : ew1, whi = i0 < i1 ? ew1 : ew0;
            const int pidx = lo == 0 ? hi - 1 : (lo == 1 ? hi + 1 : 5);
            const int bucket = gsel * 6 + pidx;
            const int row = row0 + i;
            unsigned long long mymask = 0ull;
            for (int bb = 0; bb < 24; ++bb) { const unsigned long long mm = __ballot(bucket == bb); if (bucket == bb) mymask = mm; }
            const int leader = __builtin_ctzll(mymask);
            int base = 0;
            if (lane == leader) base = atomicAdd(cnt + 64 * bucket, __builtin_popcountll(mymask));
            base = __shfl(base, leader);
            const int pos = base + __builtin_popcountll(mymask & ((1ull << lane) - 1ull));
            list[(size_t)bucket * NT + pos] = row;
            route[2 * row] = wlo; route[2 * row + 1] = whi;
            rinv[row] = r;
        }
        __syncthreads();
    }
}

struct APlain { const bf16_t* base; int ld; __device__ __forceinline__ const bf16_t* operator()(int r) const { return base + (size_t)r * ld; } };
struct ACmp { const bf16_t* base; __device__ __forceinline__ const bf16_t* operator()(int r) const { return base + (size_t)(r < 126 ? r : 126) * 1024; } };
struct AGather { const bf16_t* xn; const int* list; int cnt; __device__ __forceinline__ const bf16_t* operator()(int r) const { return xn + (size_t)(r < cnt ? list[r] : 0) * ND; } };
struct BPlain { const bf16_t* base; int ld; __device__ __forceinline__ const bf16_t* operator()(int r, int k0) const { return base + (size_t)r * ld + k0; } };
struct BSplit { const bf16_t* b0; const bf16_t* b1; __device__ __forceinline__ const bf16_t* operator()(int r, int k0) const { return k0 < 512 ? b0 + (size_t)r * 512 + k0 : b1 + (size_t)r * 512 + (k0 - 512); } };

template <class AP, class BP, class APN, class BPN>
__device__ __forceinline__ void gemm_kloop(f32x4 (&acc)[4][4], const AP& ap, const BP& bp, int K, LAS unsigned char* lds, bool prefetched, bool has_next, const APN& apn, const BPN& bpn) {
    const int tid = TID(), wid = tid >> 6, lane = tid & 63, wr = wid >> 1, wc = wid & 1, fr = lane & 15, fq = lane >> 4;
#if NAIVE_GEMM
    for (int k0 = 0; k0 < K; k0 += 32) {
#pragma unroll
        for (int m = 0; m < 4; ++m) {
            const bf16_t* arow = ap(wr * 64 + m * 16 + fr) + k0;
            u32x4 av[4];
#pragma unroll
            for (int c = 0; c < 4; ++c) av[c] = ((const u32x4*)arow)[c];
#pragma unroll
            for (int n = 0; n < 4; ++n)
#pragma unroll
                for (int j = 0; j < 4; ++j) {
                    const bf16_t* brow = bp(wc * 64 + n * 16 + 4 * fq + j, k0);
                    float s = 0.f;
#pragma unroll
                    for (int c = 0; c < 4; ++c) {
                        const u32x4 bv = ((const u32x4*)brow)[c];
                        s += bflo(av[c].x) * bflo(bv.x) + bfhi(av[c].x) * bfhi(bv.x) + bflo(av[c].y) * bflo(bv.y) + bfhi(av[c].y) * bfhi(bv.y)
                           + bflo(av[c].z) * bflo(bv.z) + bfhi(av[c].z) * bfhi(bv.z) + bflo(av[c].w) * bflo(bv.w) + bfhi(av[c].w) * bfhi(bv.w);
                    }
                    acc[m][n][j] += s;
                }
        }
    }
#else
    const unsigned woff = (unsigned)wid * 1024u;
    const bf16_t* aptr[4]; int brow[4], bcol;
    {
        const int sb = lane * 16, swz = sb ^ (((sb >> 9) & 1) << 5);
        const int rl = swz >> 6, cc = (wid & 1) * 32 + ((swz & 63) >> 1);
        bcol = cc;
#pragma unroll
        for (int i = 0; i < 4; ++i) { const int R = ((wid >> 1) + 2 * i) * 16 + rl; aptr[i] = ap(R) + cc; brow[i] = R; }
    }
    int aoff[4], boff[4];
#pragma unroll
    for (int m = 0; m < 4; ++m) {
        { const int r = wr * 64 + m * 16 + fr, c = fq * 8, st = (r >> 4) * 2, ob = (r & 15) * 64 + c * 2; aoff[m] = st * 1024 + (ob ^ (((ob >> 9) & 1) << 5)); }
        { const int r = wc * 64 + m * 16 + fr, c = fq * 8, st = (r >> 4) * 2, ob = (r & 15) * 64 + c * 2; boff[m] = st * 1024 + (ob ^ (((ob >> 9) & 1) << 5)); }
    }
    const int nk = K / 64;
#define GT_STAGE(buf, t) do { const int _k0 = (t) * 64; LAS unsigned char* _ba = lds + (buf) * 32768 + woff; \
        _Pragma("unroll") for (int _i = 0; _i < 4; ++_i) { \
            __builtin_amdgcn_global_load_lds((const unsigned*)(aptr[_i] + _k0), (LAS unsigned*)(_ba + _i * 4096), 16, 0, 0); \
            __builtin_amdgcn_global_load_lds((const unsigned*)(bp(brow[_i], _k0) + bcol), (LAS unsigned*)(_ba + 16384 + _i * 4096), 16, 0, 0); } } while (0)
    if (!prefetched) GT_STAGE(0, 0);
#pragma unroll 1
    for (int t = 0; t < nk; ++t) {
        asm volatile("s_waitcnt vmcnt(0)" ::: "memory");
        __syncthreads();
        if (t + 1 < nk) GT_STAGE((t + 1) & 1, t + 1);
        else if (has_next) {
            LAS unsigned char* _ba = lds + woff;
#pragma unroll
            for (int _i = 0; _i < 4; ++_i) {
                __builtin_amdgcn_global_load_lds((const unsigned*)(apn(brow[_i]) + bcol), (LAS unsigned*)(_ba + _i * 4096), 16, 0, 0);
                __builtin_amdgcn_global_load_lds((const unsigned*)(bpn(brow[_i], 0) + bcol), (LAS unsigned*)(_ba + 16384 + _i * 4096), 16, 0, 0);
            }
        }
        LAS const unsigned char* la = lds + (t & 1) * 32768;
        LAS const unsigned char* lb = la + 16384;
        bf16x8 At[2][4], Bt[2][4];
#pragma unroll
        for (int kh = 0; kh < 2; ++kh) {
#pragma unroll
            for (int m = 0; m < 4; ++m) At[kh][m] = *(const LAS bf16x8*)(la + aoff[m] + kh * 1024);
#pragma unroll
            for (int n = 0; n < 4; ++n) Bt[kh][n] = *(const LAS bf16x8*)(lb + boff[n] + kh * 1024);
        }
#pragma unroll
        for (int kh = 0; kh < 2; ++kh)
#pragma unroll
            for (int m = 0; m < 4; ++m)
#pragma unroll
                for (int n = 0; n < 4; ++n) acc[m][n] = __builtin_amdgcn_mfma_f32_16x16x32_bf16(Bt[kh][n], At[kh][m], acc[m][n], 0, 0, 0);
    }
#undef GT_STAGE
#endif
}
__device__ __forceinline__ void zero_acc(f32x4 (&acc)[4][4]) {
#pragma unroll
    for (int m = 0; m < 4; ++m)
#pragma unroll
        for (int n = 0; n < 4; ++n) acc[m][n] = (f32x4){0.f, 0.f, 0.f, 0.f};
}
template <class AP, class BP, class EPI>
__device__ __forceinline__ void gemm_tile(const AP& ap, const BP& bp, int K, const EPI& epi, LAS unsigned char* lds, bool prefetched, bool has_next, const AP& apn, const BP& bpn) {
    const int tid = TID(), wid = tid >> 6, lane = tid & 63, wr = wid >> 1, wc = wid & 1, fr = lane & 15, fq = lane >> 4;
    f32x4 acc[4][4]; zero_acc(acc);
    gemm_kloop(acc, ap, bp, K, lds, prefetched, has_next, apn, bpn);
    epi(acc, wr, wc, fr, fq);
}

__device__ __forceinline__ float rinv_from_ssp(const float* ssp, int row) {
    const f32x4* q = (const f32x4*)(ssp + (size_t)row * 16);
    const f32x4 a = q[0], b = q[1], c = q[2], d = q[3];
    const float s = ((a.x + a.y) + (a.z + a.w)) + ((b.x + b.y) + (b.z + b.w)) + ((c.x + c.y) + (c.z + c.w)) + ((d.x + d.y) + (d.z + d.w));
    return 1.0f / sqrtf(s * (1.0f / ND) + 1e-6f);
}
__device__ __forceinline__ float row_ss64(const f32x4& a, const f32x4& b, const f32x4& c, const f32x4& d) {
    float s = ((a.x * a.x + a.y * a.y) + (a.z * a.z + a.w * a.w)) + ((b.x * b.x + b.y * b.y) + (b.z * b.z + b.w * b.w))
            + ((c.x * c.x + c.y * c.y) + (c.z * c.z + c.w * c.w)) + ((d.x * d.x + d.y * d.y) + (d.z * d.z + d.w * d.w));
    s += __shfl_xor(s, 16); s += __shfl_xor(s, 32);
    return s;
}
constexpr int EPS_OFF = 32768, EPS_RS = 272;
struct EpiInProj {
    int mt, nt; unsigned char* ws; const float* ssp; LAS unsigned char* lds;
    __device__ __forceinline__ void operator()(const f32x4 (&acc)[4][4], int wr, int wc, int fr, int fq) const {
        if (nt >= 22) {
#pragma unroll
            for (int m = 0; m < 4; ++m) {
                const int row = mt * 128 + wr * 64 + m * 16 + fr;
                const float rr = rinv_from_ssp(ssp, row);
#pragma unroll
                for (int n = 0; n < 4; ++n) {
                    const int col = wc * 64 + n * 16 + 4 * fq;
                    if (col < 24) {
                        const f32x4 v = acc[m][n] * rr;
                        f32x4 o; o.x = sigmoidf_(v.x); o.y = sigmoidf_(v.y); o.z = sigmoidf_(v.z); o.w = sigmoidf_(v.w);
                        *(f32x4*)((float*)(ws + WS_GATES) + (size_t)row * 24 + col) = o;
                    }
                }
            }
            return;
        }
        const int reg = nt >> 2;
        const float sc = (nt < 16 && (reg == 0 || reg == 3)) ? 0.125f * 1.4426950408889634f : 1.0f;
        LAS unsigned char* st = lds + EPS_OFF;
        __syncthreads();
#pragma unroll
        for (int m = 0; m < 4; ++m) {
            const int r = wr * 64 + m * 16 + fr;
            const float rs = rinv_from_ssp(ssp, mt * 128 + r) * sc;
#pragma unroll
            for (int n = 0; n < 4; ++n) {
                const f32x4 v = acc[m][n] * rs;
                u32x2 w; w.x = pk2(v.x, v.y); w.y = pk2(v.z, v.w);
                *(LAS u32x2*)(st + r * EPS_RS + (wc * 64 + n * 16 + 4 * fq) * 2) = w;
            }
        }
        __syncthreads();
        const int tid = (wr * 2 + wc) * 64 + fq * 16 + fr;
#pragma unroll
        for (int i = 0; i < 8; ++i) {
            const int q = tid + 256 * i, r = q >> 4, ch = q & 15, col = ch * 8;
            const u32x4 v = *(const LAS u32x4*)(st + r * EPS_RS + ch * 16);
            const int row = mt * 128 + r, b = row >> 11, s = row & 2047;
            bf16_t* dst;
            if (nt < 16) { const int c = (nt & 3) * 128 + col, head = c >> 6, d = c & 63; dst = (bf16_t*)(ws + WS_QA + (size_t)reg * 16 * MiB) + ((size_t)((b * 8 + head) * NS + s) * 64 + d); }
            else { const int g = col >> 6, d = col & 63; dst = (bf16_t*)(ws + WS_KV6 + (size_t)(nt - 16) * 4 * MiB) + ((size_t)((b * 2 + g) * NS + s) * 64 + d); }
            *(u32x4*)dst = v;
        }
    }
};
struct EpiCmp1 {
    bf16_t* hc; const float* bc1; int row0, col0;
    __device__ __forceinline__ void operator()(const f32x4 (&acc)[4][4], int wr, int wc, int fr, int fq) const {
#pragma unroll
        for (int m = 0; m < 4; ++m) {
            const int row = row0 + wr * 64 + m * 16 + fr;
#pragma unroll
            for (int n = 0; n < 4; ++n) {
                const int col = col0 + wc * 64 + n * 16 + 4 * fq;
                f32x4 bb = *(const f32x4*)(bc1 + col);
#pragma unroll
                for (int pp = 1; pp < 16; ++pp) bb += *(const f32x4*)(bc1 + pp * 1024 + col);
                const f32x4 v = acc[m][n];
                u32x2 w; w.x = pk2(gelu_tanh(v.x + bb.x), gelu_tanh(v.y + bb.y)); w.y = pk2(gelu_tanh(v.z + bb.z), gelu_tanh(v.w + bb.w));
                *(u32x2*)(hc + (size_t)row * 256 + col) = w;
            }
        }
    }
};
struct EpiCmp2 {
    bf16_t* dst; int row0;
    __device__ __forceinline__ void operator()(const f32x4 (&acc)[4][4], int wr, int wc, int fr, int fq) const {
        if (wc != 0) return;
#pragma unroll
        for (int m = 0; m < 4; ++m) {
            const int row = row0 + wr * 64 + m * 16 + fr;
#pragma unroll
            for (int n = 0; n < 4; ++n) {
                const int col = n * 16 + 4 * fq;
                const f32x4 v = acc[m][n];
                u32x2 w; w.x = pk2(v.x, v.y); w.y = pk2(v.z, v.w);
                *(u32x2*)(dst + (size_t)row * 64 + col) = w;
            }
        }
    }
};
struct EpiResAdd {
    bf16_t* res; int row0, col0;
    __device__ __forceinline__ void operator()(const f32x4 (&acc)[4][4], int wr, int wc, int fr, int fq) const {
#pragma unroll
        for (int m = 0; m < 4; ++m) {
            const int row = row0 + wr * 64 + m * 16 + fr;
#pragma unroll
            for (int n = 0; n < 4; ++n) {
                const int col = col0 + wc * 64 + n * 16 + 4 * fq;
                u32x2* pp = (u32x2*)(res + (size_t)row * ND + col);
                const u32x2 b = *pp; const f32x4 a = acc[m][n];
                u32x2 w; w.x = pk2(bflo(b.x) + a.x, bfhi(b.x) + a.y); w.y = pk2(bflo(b.y) + a.z, bfhi(b.y) + a.w);
                *pp = w;
            }
        }
    }
};
struct EpiMoeGU {
    bf16_t* hid; const int* list; const float* route; const float* rinv; int cnt, hrow0, nt16;
    __device__ __forceinline__ void operator()(const f32x4 (&acc)[4][4], int wr, int wc, int fr, int fq) const {
        const int half = nt16 >> 3, nte = nt16 & 7;
#pragma unroll
        for (int m = 0; m < 4; ++m) {
            const int r = wr * 64 + m * 16 + fr;
            const int tok = r < cnt ? list[r] : 0;
            const float w = r < cnt ? route[2 * tok + half] : 0.f;
            const float rt = rinv[tok];
#pragma unroll
            for (int pr = 0; pr < 2; ++pr) {
                const f32x4 gv = acc[m][2 * pr], uv = acc[m][2 * pr + 1];
                const int hc = half * 512 + (4 * nte + 2 * wc + pr) * 16 + 4 * fq;
                float h[4];
#pragma unroll
                for (int j = 0; j < 4; ++j) { const float gg = gv[j] * rt; h[j] = gg / (1.0f + __expf(-gg)) * (uv[j] * rt) * w; }
                u32x2 o; o.x = pk2(h[0], h[1]); o.y = pk2(h[2], h[3]);
                *(u32x2*)(hid + (size_t)(hrow0 + r) * 1024 + hc) = o;
            }
        }
    }
};
struct EpiMoeDown {
    bf16_t* res; const int* list; float* ssp; int cnt, col0;
    __device__ __forceinline__ void operator()(const f32x4 (&acc)[4][4], int wr, int wc, int fr, int fq) const {
#pragma unroll
        for (int m = 0; m < 4; ++m) {
            const int r = wr * 64 + m * 16 + fr;
            const bool ok = r < cnt;
            const int tok = ok ? list[r] : 0;
            f32x4 nv[4];
#pragma unroll
            for (int n = 0; n < 4; ++n) {
                const int col = col0 + wc * 64 + n * 16 + 4 * fq;
                u32x2* pp = (u32x2*)(res + (size_t)tok * ND + col);
                const u32x2 b = *pp; const f32x4 a = acc[m][n];
                nv[n] = (f32x4){bflo(b.x) + a.x, bfhi(b.x) + a.y, bflo(b.y) + a.z, bfhi(b.y) + a.w};
                if (ok) { u32x2 w; w.x = pk2(nv[n].x, nv[n].y); w.y = pk2(nv[n].z, nv[n].w); *pp = w; }
            }
            const float ps = row_ss64(nv[0], nv[1], nv[2], nv[3]);
            if (ok && fq == 0) ssp[(size_t)tok * 16 + (col0 >> 6) + wc] = ps;
        }
    }
};
struct EpiBf16 {
    bf16_t* dst; int ld, row0, col0;
    __device__ __forceinline__ void operator()(const f32x4 (&acc)[4][4], int wr, int wc, int fr, int fq) const {
#pragma unroll
        for (int m = 0; m < 4; ++m) {
            const int row = row0 + wr * 64 + m * 16 + fr;
#pragma unroll
            for (int n = 0; n < 4; ++n) {
                const int col = col0 + wc * 64 + n * 16 + 4 * fq;
                const f32x4 v = acc[m][n];
                u32x2 w; w.x = pk2(v.x, v.y); w.y = pk2(v.z, v.w);
                *(u32x2*)(dst + (size_t)row * ld + col) = w;
            }
        }
    }
};
struct EpiPleFused {
    const bf16_t* rin; const float* ssp_in; bf16_t* rout; float* ssp_out; int row0, col0;
    __device__ __forceinline__ void operator()(const f32x4 (&acc)[4][4], const f32x4 (&acc2)[4][4], int wr, int wc, int fr, int fq) const {
#pragma unroll
        for (int m = 0; m < 4; ++m) {
            const int row = row0 + wr * 64 + m * 16 + fr;
            const float rr = rinv_from_ssp(ssp_in, row);
            f32x4 nv[4];
#pragma unroll
            for (int n = 0; n < 4; ++n) {
                const int col = col0 + wc * 64 + n * 16 + 4 * fq;
                const size_t off = (size_t)row * ND + col;
                const f32x4 v = acc[m][n] * rr, q = acc2[m][n];
                const u32x2 b = *(const u32x2*)(rin + off);
                f32x4 o = (f32x4){bflo(b.x), bfhi(b.x), bflo(b.y), bfhi(b.y)};
                o.x += sigmoidf_(v.x) * q.x; o.y += sigmoidf_(v.y) * q.y; o.z += sigmoidf_(v.z) * q.z; o.w += sigmoidf_(v.w) * q.w;
                u32x2 w; w.x = pk2(o.x, o.y); w.y = pk2(o.z, o.w);
                *(u32x2*)(rout + off) = w;
                nv[n] = o;
            }
            const float ps = row_ss64(nv[0], nv[1], nv[2], nv[3]);
            if (fq == 0) ssp_out[(size_t)row * 16 + (col0 >> 6) + wc] = ps;
        }
    }
};
struct EpiPleGate {
    float* out; const bf16_t* p2; int row0, col0; float sc;
    __device__ __forceinline__ void operator()(const f32x4 (&acc)[4][4], int wr, int wc, int fr, int fq) const {
#pragma unroll
        for (int m = 0; m < 4; ++m) {
            const int row = row0 + wr * 64 + m * 16 + fr;
#pragma unroll
            for (int n = 0; n < 4; ++n) {
                const int col = col0 + wc * 64 + n * 16 + 4 * fq;
                const size_t off = (size_t)row * ND + col;
                const u32x2 pv = *(const u32x2*)(p2 + off);
                const f32x4 v = acc[m][n];
                f32x4 o = *(const f32x4*)(out + off);
                o.x += sc * sigmoidf_(v.x) * bflo(pv.x); o.y += sc * sigmoidf_(v.y) * bfhi(pv.x); o.z += sc * sigmoidf_(v.z) * bflo(pv.y); o.w += sc * sigmoidf_(v.w) * bfhi(pv.y);
                *(f32x4*)(out + off) = o;
            }
        }
    }
};

template <class PH, class AP, class BP, class EPI>
__device__ __forceinline__ void gemm_stream(const PH& ph, int first, int step, int count, int K, LAS unsigned char* lds) {
    int q = first;
    if (q >= count) return;
    AP ap, apn; BP bp, bpn; EPI ep, epn;
    ph.make(q, ap, bp, ep);
    bool pref = false;
    for (;;) {
        const int qn = q + step; const bool hn = qn < count;
        if (hn) ph.make(qn, apn, bpn, epn); else { apn = ap; bpn = bp; epn = ep; }
        gemm_tile(ap, bp, K, ep, lds, pref, hn, apn, bpn);
        if (!hn) break;
        ap = apn; bp = bpn; ep = epn; q = qn; pref = true;
    }
}

__device__ __forceinline__ void load_q32(const bf16_t* p, float* q) {
#pragma unroll
    for (int c = 0; c < 4; ++c) {
        const u32x4 v = ((const u32x4*)p)[c];
        q[8 * c] = bflo(v.x); q[8 * c + 1] = bfhi(v.x); q[8 * c + 2] = bflo(v.y); q[8 * c + 3] = bfhi(v.y);
        q[8 * c + 4] = bflo(v.z); q[8 * c + 5] = bfhi(v.z); q[8 * c + 6] = bflo(v.w); q[8 * c + 7] = bfhi(v.w);
    }
}
__device__ __forceinline__ float dot32p(const float* q, const bf16_t* k) {
    float s0 = 0.f, s1 = 0.f;
#pragma unroll
    for (int c = 0; c < 4; ++c) {
        const u32x4 v = ((const u32x4*)k)[c];
        s0 += q[8 * c] * bflo(v.x); s1 += q[8 * c + 1] * bfhi(v.x); s0 += q[8 * c + 2] * bflo(v.y); s1 += q[8 * c + 3] * bfhi(v.y);
        s0 += q[8 * c + 4] * bflo(v.z); s1 += q[8 * c + 5] * bfhi(v.z); s0 += q[8 * c + 6] * bflo(v.w); s1 += q[8 * c + 7] * bfhi(v.w);
    }
    const float s = s0 + s1;
    return s + __shfl_xor(s, 1);
}
__device__ __forceinline__ void axpy32(float* a, float p, const bf16_t* vr) {
#pragma unroll
    for (int c = 0; c < 4; ++c) {
        const u32x4 v = ((const u32x4*)vr)[c];
        a[8 * c] += p * bflo(v.x); a[8 * c + 1] += p * bfhi(v.x); a[8 * c + 2] += p * bflo(v.y); a[8 * c + 3] += p * bfhi(v.y);
        a[8 * c + 4] += p * bflo(v.z); a[8 * c + 5] += p * bfhi(v.z); a[8 * c + 6] += p * bflo(v.w); a[8 * c + 7] += p * bfhi(v.w);
    }
}
#define ONLINE_STEP(s_, vrow_) do { const float _s = (s_); if (_s > mx) { const float _c = __expf(mx - _s); l *= _c; _Pragma("unroll") for (int _i = 0; _i < 32; ++_i) acc[_i] *= _c; mx = _s; } \
    const float _p = __expf(_s - mx); l += _p; axpy32(acc, _p, (vrow_)); } while (0)

__device__ __forceinline__ void store_o32(bf16_t* dst, const float* a, float sc) {
#pragma unroll
    for (int c = 0; c < 4; ++c) {
        u32x4 w; w.x = pk2(a[8 * c] * sc, a[8 * c + 1] * sc); w.y = pk2(a[8 * c + 2] * sc, a[8 * c + 3] * sc);
        w.z = pk2(a[8 * c + 4] * sc, a[8 * c + 5] * sc); w.w = pk2(a[8 * c + 6] * sc, a[8 * c + 7] * sc);
        ((u32x4*)dst)[c] = w;
    }
}

__device__ __forceinline__ void attn_dilated_naive(const unsigned char* ws, int gtid, int gthreads) {
    asm volatile("" : "+v"(gtid));
    const bf16_t* qa = (const bf16_t*)(ws + WS_QA); const bf16_t* ka = (const bf16_t*)(ws + WS_KA); const bf16_t* va = (const bf16_t*)(ws + WS_VA);
    bf16_t* ob = (bf16_t*)(ws + WS_O);
    for (int id2 = gtid; id2 < NB * 8 * NS * 2; id2 += gthreads) {
        const int idx = id2 >> 1, hf = (id2 & 1) * 32;
        const int t = idx & 2047, bh = idx >> 11, h = bh & 7, b = bh >> 3;
        float q[32]; load_q32(qa + (size_t)idx * 64 + hf, q);
        const bf16_t* kb = ka + (size_t)bh * NS * 64 + hf; const bf16_t* vb = va + (size_t)bh * NS * 64 + hf;
        const float slope = exp2f(-((float)h + 0.5f));
        float mx = -1e30f, l = 0.f; float acc[32];
#pragma unroll
        for (int i = 0; i < 32; ++i) acc[i] = 0.f;
#pragma unroll 1
        for (int pat = 0; pat < 3; ++pat) {
            const int dil = pat == 0 ? 1 : (pat == 1 ? 4 : 16);
#pragma unroll 1
            for (int j = 0; j <= 128; ++j) {
                const int dist = j * dil, pos = t - dist;
                if (pos < 0) break;
                const float s = dot32p(q, kb + (size_t)pos * 64) - slope * (float)dist;
                ONLINE_STEP(s, vb + (size_t)pos * 64);
            }
        }
        store_o32(ob + ((size_t)(b * NS + t) * ND + h * 64 + hf), acc, 1.0f / l);
    }
}

__device__ __forceinline__ void nsa_imp_naive(const unsigned char* ws, int gtid, int gthreads) {
    asm volatile("" : "+v"(gtid));
    const bf16_t* qb = (const bf16_t*)(ws + WS_QB); const bf16_t* kcmp = (const bf16_t*)(ws + WS_KCMP);
    float* imph = (float*)(ws + WS_IMPH);
    for (int id2 = gtid; id2 < NB * 8 * NS * 2; id2 += gthreads) {
        const int idx = id2 >> 1, hf = (id2 & 1) * 32;
        const int t = idx & 2047, bh = idx >> 11, hb = bh & 7, b = bh >> 3, g = hb >> 2;
        float q[32]; load_q32(qb + (size_t)idx * 64 + hf, q);
        const bf16_t* kc = kcmp + (size_t)(b * 2 + g) * 128 * 64 + hf;
        const float slope = exp2f(-(float)(hb + 1));
        const int ncv = t >= 31 ? ((t - 31) >> 4) + 1 : 0;
        float mx = -1e30f;
#pragma unroll 1
        for (int c = 0; c < ncv; ++c) { const float s = dot32p(q, kc + c * 64) - slope * (float)(t - (16 * c + 31)); mx = fmaxf(mx, s); }
        float den = 0.f;
#pragma unroll 1
        for (int c = 0; c < ncv; ++c) { const float s = dot32p(q, kc + c * 64) - slope * (float)(t - (16 * c + 31)); den += __expf(s - mx); }
        const float inv = ncv > 0 ? 1.0f / den : 0.f;
#pragma unroll 1
        for (int n = 0; n < 32; ++n) {
            float imp = 0.f;
#pragma unroll 1
            for (int j = -1; j <= 3; ++j) {
                const int c = 4 * n + j;
                if (c >= 0 && c < ncv) {
                    const float s = dot32p(q, kc + c * 64) - slope * (float)(t - (16 * c + 31));
                    const float pp = __expf(s - mx) * inv;
                    imp += (j == -1 || j == 3) ? 0.5f * pp : pp;
                }
            }
            if (hf == 0) imph[(size_t)idx * 32 + n] = imp;
        }
    }
}
__device__ __forceinline__ void nsa_select(const unsigned char* ws, unsigned* maskbuf) {
    const float* imph = (const float*)(ws + WS_IMPH);
    const int tid_ = TID(); const int lane = tid_ & 63, gw = BID() * 4 + (tid_ >> 6), ngw = gridDim.x * 4;
    for (int it = gw; it < NB * 2 * NS / 2; it += ngw) {
        const int item = it * 2 + (lane >> 5), t = item & 2047, bg = item >> 11, n = lane & 31;
        float imp = 0.f;
#pragma unroll
        for (int r = 0; r < 4; ++r) imp += imph[((size_t)(bg * 4 + r) * NS + t) * 32 + n];
        const int cur = t >> 6;
        const bool valid = n <= cur;
        const bool forced = (n == 0) || (cur - n < 2);
        const float score = valid ? imp + (forced ? 1e4f : 0.f) : -1e30f;
        int rank = 0;
        for (int m = 0; m < 32; ++m) {
            const float sm = __shfl(score, (lane & 32) | m);
            rank += (sm > score || (sm == score && m < n)) ? 1 : 0;
        }
        const bool sel = valid && rank < 16;
        const unsigned long long bal = __ballot(sel);
        if (n == 0) maskbuf[item] = (lane >> 5) ? (unsigned)(bal >> 32) : (unsigned)bal;
    }
}
__device__ __forceinline__ void nsa_attn_naive(const unsigned char* ws, int gtid, int gthreads) {
    asm volatile("" : "+v"(gtid));
    const bf16_t* qb = (const bf16_t*)(ws + WS_QB);
    const bf16_t* kcmp = (const bf16_t*)(ws + WS_KCMP); const bf16_t* vcmp = kcmp + (size_t)16 * 128 * 64;
    const bf16_t* ksb = (const bf16_t*)(ws + WS_KV6 + 2 * 4 * MiB); const bf16_t* vsb = (const bf16_t*)(ws + WS_KV6 + 3 * 4 * MiB);
    const bf16_t* kwb = (const bf16_t*)(ws + WS_KV6 + 4 * 4 * MiB); const bf16_t* vwb = (const bf16_t*)(ws + WS_KV6 + 5 * 4 * MiB);
    const float* gates = (const float*)(ws + WS_GATES);
    const unsigned* maskbuf = (const unsigned*)(ws + WS_MASK);
    bf16_t* ob = (bf16_t*)(ws + WS_O);
    for (int id2 = gtid; id2 < NB * 8 * NS * 2; id2 += gthreads) {
        const int idx = id2 >> 1, hf = (id2 & 1) * 32;
        const int t = idx & 2047, bh = idx >> 11, hb = bh & 7, b = bh >> 3, g = hb >> 2, bg = b * 2 + g;
        float q[32]; load_q32(qb + (size_t)idx * 64 + hf, q);
        const float slope = exp2f(-(float)(hb + 1));
        const float* gt = gates + (size_t)(b * NS + t) * 24 + hb * 3;
        float tot[32], acc[32];
#pragma unroll
        for (int i = 0; i < 32; ++i) tot[i] = 0.f;
        {
            const bf16_t* kc = kcmp + (size_t)bg * 128 * 64 + hf; const bf16_t* vc = vcmp + (size_t)bg * 128 * 64 + hf;
            const int ncv = t >= 31 ? ((t - 31) >> 4) + 1 : 0;
            if (ncv > 0) {
                float mx = -1e30f, l = 0.f;
#pragma unroll
                for (int i = 0; i < 32; ++i) acc[i] = 0.f;
#pragma unroll 1
                for (int c = 0; c < ncv; ++c) { const float s = dot32p(q, kc + c * 64) - slope * (float)(t - (16 * c + 31)); ONLINE_STEP(s, vc + c * 64); }
                const float sc = gt[0] / l;
#pragma unroll
                for (int i = 0; i < 32; ++i) tot[i] += sc * acc[i];
            }
        }
        {
            const bf16_t* kb = ksb + (size_t)bg * NS * 64 + hf; const bf16_t* vb = vsb + (size_t)bg * NS * 64 + hf;
            const unsigned mask = maskbuf[bg * NS + t];
            float mx = -1e30f, l = 0.f;
#pragma unroll
            for (int i = 0; i < 32; ++i) acc[i] = 0.f;
#pragma unroll 1
            for (int n = 0; n < 32; ++n) {
                if (!((mask >> n) & 1u)) continue;
#pragma unroll 1
                for (int i = 0; i < 64; ++i) {
                    const int pos = n * 64 + i;
                    if (pos > t) break;
                    const float s = dot32p(q, kb + (size_t)pos * 64) - slope * (float)(t - pos);
                    ONLINE_STEP(s, vb + (size_t)pos * 64);
                }
            }
            const float sc = gt[1] / l;
#pragma unroll
            for (int i = 0; i < 32; ++i) tot[i] += sc * acc[i];
        }
        {
            const bf16_t* kb = kwb + (size_t)bg * NS * 64 + hf; const bf16_t* vb = vwb + (size_t)bg * NS * 64 + hf;
            float mx = -1e30f, l = 0.f;
#pragma unroll
            for (int i = 0; i < 32; ++i) acc[i] = 0.f;
#pragma unroll 1
            for (int dist = 0; dist < 512; ++dist) {
                const int pos = t - dist;
                if (pos < 0) break;
                const float s = dot32p(q, kb + (size_t)pos * 64) - slope * (float)dist;
                ONLINE_STEP(s, vb + (size_t)pos * 64);
            }
            const float sc = gt[2] / l;
#pragma unroll
            for (int i = 0; i < 32; ++i) tot[i] += sc * acc[i];
        }
        store_o32(ob + ((size_t)(b * NS + t) * ND + 512 + hb * 64 + hf), tot, 1.0f);
    }
}

constexpr int KVS = 144;
constexpr int KVT = 64 * KVS;
constexpr int VS = 128;
constexpr int VT = 64 * VS;
#define LOG2E_F 1.4426950408889634f
__device__ __forceinline__ unsigned cvtpk(float lo, float hi) { f32x2_t v = {lo, hi}; bf16x2_t b = __builtin_convertvector(v, bf16x2_t); return __builtin_bit_cast(unsigned, b); }
__device__ __forceinline__ s16x4 vtr(LAS const unsigned char* p) { return __builtin_bit_cast(s16x4, __builtin_amdgcn_ds_read_tr16_b64_v4i16((LAS s16x4*)p)); }
__device__ __forceinline__ f32x16 zero16() { f32x16 z;
#pragma unroll
    for (int i = 0; i < 16; ++i) z[i] = 0.f;
    return z; }

__device__ __forceinline__ void load_kv_tile(LAS unsigned char* Kt, LAS unsigned char* Vt, const bf16_t* kbase, const bf16_t* vbase, int row0, int rstride, int rmin, int rmax, int tid) {
    const int j = tid >> 2, ch = tid & 3;
    int tok = row0 + j * rstride; tok = tok < rmin ? rmin : (tok > rmax ? rmax : tok);
    const u32x4* kp = (const u32x4*)(kbase + (size_t)tok * 64);
    const u32x4* vp = (const u32x4*)(vbase + (size_t)tok * 64);
    const u32x4 k0 = kp[ch], k1 = kp[ch + 4], v0 = vp[ch], v1 = vp[ch + 4];
    *(LAS u32x4*)(Kt + j * KVS + ch * 16) = k0; *(LAS u32x4*)(Kt + j * KVS + (ch + 4) * 16) = k1;
    { const int sx = 2 * (j & 3); *(LAS u32x4*)(Vt + j * VS + ((ch ^ sx) * 16)) = v0; *(LAS u32x4*)(Vt + j * VS + (((ch + 4) ^ sx) * 16)) = v1; }
}

struct KVRegs { u32x4 k0, k1, v0, v1; };
__device__ __forceinline__ void kv_fetch(KVRegs& r, const bf16_t* kbase, const bf16_t* vbase, int row0, int rstride, int rmin, int rmax, int tid) {
    const int j = tid >> 2, ch = tid & 3;
    int tok = row0 + j * rstride; tok = tok < rmin ? rmin : (tok > rmax ? rmax : tok);
    const u32x4* kp = (const u32x4*)(kbase + (size_t)tok * 64);
    const u32x4* vp = (const u32x4*)(vbase + (size_t)tok * 64);
    r.k0 = kp[ch]; r.k1 = kp[ch + 4]; r.v0 = vp[ch]; r.v1 = vp[ch + 4];
}
__device__ __forceinline__ void kv_commit(const KVRegs& r, LAS unsigned char* Kt, LAS unsigned char* Vt, int tid) {
    const int j = tid >> 2, ch = tid & 3;
    *(LAS u32x4*)(Kt + j * KVS + ch * 16) = r.k0; *(LAS u32x4*)(Kt + j * KVS + (ch + 4) * 16) = r.k1;
    { const int sx = 2 * (j & 3); *(LAS u32x4*)(Vt + j * VS + ((ch ^ sx) * 16)) = r.v0; *(LAS u32x4*)(Vt + j * VS + (((ch + 4) ^ sx) * 16)) = r.v1; }
}
__device__ __forceinline__ void pv32(f32x16& o0, f32x16& o1, const f32x16& sv, LAS const unsigned char* vp0, LAS const unsigned char* vp1  ) {
#pragma unroll
    for (int s16 = 0; s16 < 2; ++s16) {
        u32x4 pw;
        pw.x = cvtpk(sv[8 * s16 + 0], sv[8 * s16 + 1]); pw.y = cvtpk(sv[8 * s16 + 2], sv[8 * s16 + 3]);
        pw.z = cvtpk(sv[8 * s16 + 4], sv[8 * s16 + 5]); pw.w = cvtpk(sv[8 * s16 + 6], sv[8 * s16 + 7]);
        const bf16x8 pf = __builtin_bit_cast(bf16x8, pw);
        const s16x4 a0 = vtr(vp0 + s16 * 16 * VS), b0 = vtr(vp0 + s16 * 16 * VS + 8 * VS), a1 = vtr(vp1 + s16 * 16 * VS), b1 = vtr(vp1 + s16 * 16 * VS + 8 * VS);
        const bf16x8 vf0 = {a0[0], a0[1], a0[2], a0[3], b0[0], b0[1], b0[2], b0[3]};
        const bf16x8 vf1 = {a1[0], a1[1], a1[2], a1[3], b1[0], b1[1], b1[2], b1[3]};
        o0 = __builtin_amdgcn_mfma_f32_32x32x16_bf16(vf0, pf, o0, 0, 0, 0);
        o1 = __builtin_amdgcn_mfma_f32_32x32x16_bf16(vf1, pf, o1, 0, 0, 0);
    }
}
__device__ __forceinline__ f32x16 qk32(const bf16x8* qf, LAS const unsigned char* kp  , f32x16 s  ) {
#pragma unroll
    for (int k = 0; k < 4; ++k) {
        const bf16x8 kf = *(const LAS bf16x8*)(kp + 32 * k);
        s = __builtin_amdgcn_mfma_f32_32x32x16_bf16(kf, qf[k], s, 0, 0, 0);
    }
    return s;
}
__device__ __forceinline__ float vmax3(float a, float b, float c) { float d; asm("v_max3_f32 %0, %1, %2, %3" : "=v"(d) : "v"(a), "v"(b), "v"(c)); return d; }
__device__ __forceinline__ float vsub(float a, float b) { float d; asm("v_sub_f32 %0, %1, %2" : "=v"(d) : "v"(a), "v"(b)); return d; }
__device__ __forceinline__ float vadd(float a, float b) { float d; asm("v_add_f32 %0, %1, %2" : "=v"(d) : "v"(a), "v"(b)); return d; }
__device__ __forceinline__ float vmul(float a, float b) { float d; asm("v_mul_f32 %0, %1, %2" : "=v"(d) : "v"(a), "v"(b)); return d; }
struct FaState { float mref, l; int started; };
template <bool TRY_FULL>
__device__ __forceinline__ void fa_tile64(f32x16& o0, f32x16& o1, FaState& st, const bf16x8* qf, LAS const unsigned char* Kt, LAS const unsigned char* Vt, int lane, float dA, float wmax, float ns2) {
    const int r = lane & 31, h = lane >> 5;
    LAS const unsigned char* kp = Kt + r * KVS + 16 * h;
    const float dAh = dA - (float)(4 * h);
    const float hi = dAh, lo = dAh - wmax;
    const float n8 = 8.f * ns2, n32 = 32.f * ns2;
    f32x16 s0, s1;
    s0[0] = fmaf(ns2, dAh, -st.mref);
#pragma unroll
    for (int u = 0; u < 4; ++u) {
        if (u) s0[4 * u] = vsub(s0[4 * u - 4], n8);
#pragma unroll
        for (int k = 1; k < 4; ++k) s0[4 * u + k] = vsub(s0[4 * u + k - 1], ns2);
    }
#pragma unroll
    for (int i = 0; i < 16; ++i) s1[i] = vsub(s0[i], n32);
    if (!(TRY_FULL && __all(lo <= 0.f && hi >= 59.f))) {
#pragma unroll
        for (int i = 0; i < 16; ++i) {
            const float c0 = (float)((i & 3) + 8 * (i >> 2)), c1 = c0 + 32.f;
            s0[i] = (c0 >= lo && c0 <= hi) ? s0[i] : -1e30f;
            s1[i] = (c1 >= lo && c1 <= hi) ? s1[i] : -1e30f;
        }
    }
    s0 = qk32(qf, kp, s0); s1 = qk32(qf, kp + 32 * KVS, s1);
    asm volatile("s_nop 15" : "+v"(s0), "+v"(s1));
    float tmax;
    {
        const float a0 = vmax3(s0[0], s0[1], s0[2]), a1 = vmax3(s0[3], s0[4], s0[5]), a2 = vmax3(s0[6], s0[7], s0[8]), a3 = vmax3(s0[9], s0[10], s0[11]), a4 = vmax3(s0[12], s0[13], s0[14]);
        const float a5 = vmax3(s0[15], s1[0], s1[1]), a6 = vmax3(s1[2], s1[3], s1[4]), a7 = vmax3(s1[5], s1[6], s1[7]), a8 = vmax3(s1[8], s1[9], s1[10]), a9 = vmax3(s1[11], s1[12], s1[13]);
        const float b0 = vmax3(a0, a1, a2), b1 = vmax3(a3, a4, a5), b2 = vmax3(a6, a7, a8), b3 = vmax3(a9, s1[14], s1[15]);
        tmax = vmax3(b0, b1, b2);
        tmax = vmax3(tmax, b3, b3);
    }
    { const float ot = __shfl_xor(tmax, 32); tmax = vmax3(tmax, ot, ot); }
    const bool valid = tmax > -1e29f;
    const bool need = valid & ((tmax > 8.f) | (st.started == 0));
    if (__any(need)) {
        const float delta = need ? tmax : 0.f;
        const float corr = need ? __builtin_amdgcn_exp2f(-delta) : 1.0f;
        st.mref += delta; st.l *= corr;
        if (__any(st.started)) {
#pragma unroll
            for (int i = 0; i < 16; ++i) { o0[i] = vmul(o0[i], corr); o1[i] = vmul(o1[i], corr); }
        }
#pragma unroll
        for (int i = 0; i < 16; ++i) { s0[i] = vsub(s0[i], delta); s1[i] = vsub(s1[i], delta); }
        st.started |= valid ? 1 : 0;
    }
#pragma unroll
    for (int i = 0; i < 16; ++i) { s0[i] = __builtin_amdgcn_exp2f(s0[i]); s1[i] = __builtin_amdgcn_exp2f(s1[i]); }
    {
        float ps0 = 0.f, ps1 = 0.f;
#pragma unroll
        for (int i = 0; i < 16; ++i) { ps0 += s0[i]; ps1 += s1[i]; }
        st.l += ps0 + ps1;
    }
    const int vq = (lane & 15) >> 2, vc0 = 2 * ((lane >> 4) & 1) + ((lane & 3) >> 1), vsx = 2 * vq;
    LAS const unsigned char* vp0 = Vt + (4 * h + vq) * VS + ((vc0 ^ vsx) * 16) + 8 * (lane & 1);
    LAS const unsigned char* vp1 = Vt + (4 * h + vq) * VS + (((vc0 + 4) ^ vsx) * 16) + 8 * (lane & 1);
    pv32(o0, o1, s0, vp0, vp1);
    pv32(o0, o1, s1, vp0 + 32 * VS, vp1 + 32 * VS);
}
__device__ __forceinline__ void acc_scaled(f32x16& t0, f32x16& t1, const f32x16& o0, const f32x16& o1, float sc) {
#pragma unroll
    for (int i = 0; i < 16; ++i) { t0[i] += sc * o0[i]; t1[i] += sc * o1[i]; }
}
__device__ __forceinline__ void store_ot(bf16_t* orow, const f32x16& o0, const f32x16& o1, float sc, int h) {
#pragma unroll
    for (int u = 0; u < 4; ++u) {
        u32x2 w0, w1;
        w0.x = cvtpk(o0[4 * u] * sc, o0[4 * u + 1] * sc); w0.y = cvtpk(o0[4 * u + 2] * sc, o0[4 * u + 3] * sc);
        w1.x = cvtpk(o1[4 * u] * sc, o1[4 * u + 1] * sc); w1.y = cvtpk(o1[4 * u + 2] * sc, o1[4 * u + 3] * sc);
        *(u32x2*)(orow + 8 * u + 4 * h) = w0;
        *(u32x2*)(orow + 32 + 8 * u + 4 * h) = w1;
    }
}
__device__ __forceinline__ void load_qf(bf16x8* qf, const bf16_t* qrow, int h) {
#pragma unroll
    for (int k = 0; k < 4; ++k) qf[k] = *(const bf16x8*)(qrow + 16 * k + 8 * h);
}

__device__ __forceinline__ void dil_item(unsigned char* ws, int item, LAS unsigned char* lds) {
    const int tid = TID(), lane = tid & 63, w = tid >> 6, c = lane & 31, h = lane >> 5;
    const int bh = item / 48, rem = item % 48, pat = rem >> 4, idx = rem & 15;
    const int dil = pat == 0 ? 1 : (pat == 1 ? 4 : 16), nqt = 16 / dil, res = idx / nqt, qt = idx % nqt;
    const int hd = bh & 7, b = bh >> 3;
    const int q0 = qt * 128 + 32 * w, iq = q0 + c, t = res + iq * dil;
    const bf16_t* qa = (const bf16_t*)(ws + WS_QA) + (size_t)bh * NS * 64;
    const bf16_t* ka = (const bf16_t*)(ws + WS_KA) + (size_t)bh * NS * 64;
    const bf16_t* va = (const bf16_t*)(ws + WS_VA) + (size_t)bh * NS * 64;
    bf16x8 qf[4]; load_qf(qf, qa + (size_t)t * 64, h);
    const float ns2 = -exp2f(-((float)hd + 0.5f)) * (float)dil * LOG2E_F;
    f32x16 o0 = zero16(), o1 = zero16(); FaState st = {0.f, 0.f, 0};
    {
        const int T0 = qt == 0 ? 2 : 0;
        KVRegs kr; kv_fetch(kr, ka, va, res + (qt * 128 - 128 + 64 * 3) * dil, dil, 0, NS - 1, tid);
        int buf = 0;
        for (int T = 3; T >= T0; --T) {
            const int kb = qt * 128 - 128 + 64 * T;
            LAS unsigned char* Kt = lds + buf * KVT; LAS unsigned char* Vt = lds + 2 * KVT + buf * VT;
            kv_commit(kr, Kt, Vt, tid);
            __syncthreads();
            if (T > T0) kv_fetch(kr, ka, va, res + (kb - 64) * dil, dil, 0, NS - 1, tid);
            if (kb <= q0 + 31 && kb + 63 >= q0 - 128)
                fa_tile64<true>(o0, o1, st, qf, Kt, Vt, lane, (float)(iq - kb), 128.f, ns2);
            buf ^= 1;
        }
    }
    const float lt = st.l + __shfl_xor(st.l, 32);
    bf16_t* op = (bf16_t*)(pat < 2 ? ws + WS_OPA01 + (size_t)pat * 16 * MiB : ws + WS_OPA2);
    store_ot(op + ((size_t)(b * NS + t) * 512 + hd * 64), o0, o1, 1.0f / lt, h);
    if (h == 0) { float* sp = (float*)(ws + WS_STA) + ((size_t)pat * NB * 8 * NS + (size_t)bh * NS + t) * 2; sp[0] = st.started ? st.mref : -1e30f; sp[1] = lt; }
}
__device__ __forceinline__ void dil_merge(unsigned char* ws, int gtid, int gthreads) {
    asm volatile("" : "+v"(gtid));
    const float* sta = (const float*)(ws + WS_STA);
    bf16_t* ob = (bf16_t*)(ws + WS_O);
    for (int it = gtid; it < NT * 8 * 8; it += gthreads) {
        const int ch = it & 7, hd = (it >> 3) & 7, tk = it >> 6, b = tk >> 11, t = tk & 2047;
        float mm[3], ll[3];
#pragma unroll
        for (int p = 0; p < 3; ++p) { const float* s = sta + ((size_t)p * NB * 8 * NS + (size_t)(b * 8 + hd) * NS + t) * 2; mm[p] = s[0]; ll[p] = s[1]; }
        const float M = fmaxf(mm[0], fmaxf(mm[1], mm[2]));
        float wgt[3], den = 0.f;
#pragma unroll
        for (int p = 0; p < 3; ++p) { wgt[p] = __builtin_amdgcn_exp2f(mm[p] - M) * ll[p]; den += wgt[p]; }
        const float inv = 1.0f / den;
        float a[8];
#pragma unroll
        for (int i = 0; i < 8; ++i) a[i] = 0.f;
#pragma unroll
        for (int p = 0; p < 3; ++p) {
            const bf16_t* op = (const bf16_t*)(p < 2 ? ws + WS_OPA01 + (size_t)p * 16 * MiB : ws + WS_OPA2);
            const u32x4 v = *(const u32x4*)(op + (size_t)tk * 512 + hd * 64 + ch * 8);
            const float wp = wgt[p] * inv;
            a[0] += wp * bflo(v.x); a[1] += wp * bfhi(v.x); a[2] += wp * bflo(v.y); a[3] += wp * bfhi(v.y);
            a[4] += wp * bflo(v.z); a[5] += wp * bfhi(v.z); a[6] += wp * bflo(v.w); a[7] += wp * bfhi(v.w);
        }
        u32x4 o; o.x = pk2(a[0], a[1]); o.y = pk2(a[2], a[3]); o.z = pk2(a[4], a[5]); o.w = pk2(a[6], a[7]);
        *(u32x4*)(ob + (size_t)tk * ND + hd * 64 + ch * 8) = o;
    }
}

constexpr int LDS_IMP = 4 * KVT;
constexpr int LDS_UNI = LDS_IMP + 4096;
constexpr int LDS_TOT = 41088;
__device__ __forceinline__ void nsa_item(unsigned char* ws, int item, LAS unsigned char* lds) {
    const int tid = TID(), lane = tid & 63, w = tid >> 6, c = lane & 31, h = lane >> 5;
    const int bg = item & 15, tt = item >> 4, b = bg >> 1, g = bg & 1;
    const int t0 = tt * 32, tok8 = c & 7, hh = c >> 3, hb = g * 4 + hh, t = t0 + 8 * w + tok8;
    const bf16_t* qrow = (const bf16_t*)(ws + WS_QB) + ((size_t)(b * 8 + hb) * NS + t) * 64;
    bf16x8 qf[4]; load_qf(qf, qrow, h);
    const float ns2 = -exp2f(-(float)(hb + 1)) * LOG2E_F;
    const float* gt = (const float*)(ws + WS_GATES) + (size_t)(b * NS + t) * 24 + hb * 3;
    const float g0 = gt[0], g1 = gt[1], g2 = gt[2];
    LAS float* totL = (LAS float*)(lds + LDS_TOT) + tid;
    LAS unsigned char* Kt = lds; LAS unsigned char* Vt = lds + 2 * KVT;
    LAS float* impL = (LAS float*)(lds + LDS_IMP) + w * 256;
    LAS unsigned* uni = (LAS unsigned*)(lds + LDS_UNI);
    const int cur = t0 >> 6;
    unsigned selmask;
    {
        const bf16_t* kc = (const bf16_t*)(ws + WS_KCMP) + (size_t)bg * 128 * 64;
        const bf16_t* vc = kc + (size_t)16 * 128 * 64;
        __syncthreads();
        load_kv_tile(Kt, Vt, kc, vc, 0, 1, 0, 127, tid);
        load_kv_tile(Kt + KVT, Vt + VT, kc, vc, 64, 1, 0, 127, tid);
        if (tid == 0) uni[0] = 0u;
        __syncthreads();
        LAS const unsigned char* kp = Kt + c * KVS + 16 * h;
        f32x16 sT[4];
#pragma unroll
        for (int T = 0; T < 4; ++T) sT[T] = qk32(qf, kp + T * 32 * KVS, zero16());
        const float dAh = (float)(t - 31) - (float)(64 * h);
        float tmax = -1e30f;
#pragma unroll
        for (int T = 0; T < 4; ++T)
#pragma unroll
            for (int i = 0; i < 16; ++i) {
                const float d = dAh - (float)(16 * (32 * T + (i & 3) + 8 * (i >> 2)));
                float tv = sT[T][i] + ns2 * d;
                tv = d >= 0.f ? tv : -1e30f;
                sT[T][i] = tv; tmax = fmaxf(tmax, tv);
            }
        tmax = fmaxf(tmax, __shfl_xor(tmax, 32));
        const float mu = fmaxf(tmax, -1e29f);
        float ps = 0.f;
#pragma unroll
        for (int T = 0; T < 4; ++T)
#pragma unroll
            for (int i = 0; i < 16; ++i) { sT[T][i] = __builtin_amdgcn_exp2f(sT[T][i] - mu); ps += sT[T][i]; }
        ps += __shfl_xor(ps, 32);
        const float inv = ps > 0.f ? 1.0f / ps : 0.f;
#pragma unroll
        for (int T = 0; T < 4; ++T)
#pragma unroll
            for (int i = 0; i < 16; ++i) sT[T][i] *= inv;
        f32x16 o0 = zero16(), o1 = zero16();
        const int vq = (lane & 15) >> 2, vc0 = 2 * ((lane >> 4) & 1) + ((lane & 3) >> 1), vsx = 2 * vq;
        LAS const unsigned char* vp0 = Vt + (4 * h + vq) * VS + ((vc0 ^ vsx) * 16) + 8 * (lane & 1);
        LAS const unsigned char* vp1 = Vt + (4 * h + vq) * VS + (((vc0 + 4) ^ vsx) * 16) + 8 * (lane & 1);
#pragma unroll
        for (int T = 0; T < 4; ++T) pv32(o0, o1, sT[T], vp0 + T * 32 * VS, vp1 + T * 32 * VS);
#pragma unroll
        for (int i = 0; i < 16; ++i) { totL[i * 256] = g0 * o0[i]; totL[(16 + i) * 256] = g0 * o1[i]; }
        float mainv[16], spill[16];
#pragma unroll
        for (int T = 0; T < 4; ++T)
#pragma unroll
            for (int u = 0; u < 4; ++u) {
                const float p3 = 0.5f * sT[T][4 * u + 3];
                mainv[4 * T + u] = sT[T][4 * u] + sT[T][4 * u + 1] + sT[T][4 * u + 2] + p3;
                spill[4 * T + u] = p3;
            }
#pragma unroll
        for (int f = 0; f < 16; ++f) {
            mainv[f] += __shfl_xor(mainv[f], 8); mainv[f] += __shfl_xor(mainv[f], 16);
            spill[f] += __shfl_xor(spill[f], 8); spill[f] += __shfl_xor(spill[f], 16);
        }
#pragma unroll
        for (int f = 0; f < 16; ++f) {
            const float snd = h ? (f > 0 ? spill[f > 0 ? f - 1 : 0] : 0.f) : spill[f];
            const float rcv = __shfl_xor(snd, 32);
            mainv[f] += rcv;
        }
        if (hh == 0) {
#pragma unroll
            for (int f = 0; f < 16; ++f) impL[tok8 * 32 + 2 * f + h] = mainv[f];
        }
        asm volatile("s_waitcnt lgkmcnt(0)" ::: "memory");
        {
            const int tk = lane >> 3, tq = t0 + 8 * w + tk, cq = tq >> 6, n0 = 4 * (lane & 7);
            float sc[32];
#pragma unroll
            for (int q4 = 0; q4 < 8; ++q4) {
                const f32x4 v = *(const LAS f32x4*)(impL + tk * 32 + 4 * q4);
                sc[4 * q4] = v.x; sc[4 * q4 + 1] = v.y; sc[4 * q4 + 2] = v.z; sc[4 * q4 + 3] = v.w;
            }
#pragma unroll
            for (int n = 0; n < 32; ++n) {
                const bool valid = n <= cq, forced = (n == 0) || (cq - n < 2);
                sc[n] = valid ? sc[n] + (forced ? 1e4f : 0.f) : -1e30f;
            }
            unsigned bits = 0u;
#pragma unroll
            for (int k = 0; k < 4; ++k) {
                const int n = n0 + k;
                float mine = 0.f;
#pragma unroll
                for (int q = 0; q < 32; ++q) mine = (q == n) ? sc[q] : mine;
                int rank = 0;
#pragma unroll
                for (int q = 0; q < 32; ++q) rank += (sc[q] > mine || (sc[q] == mine && q < n)) ? 1 : 0;
                if (n <= cq && rank < 16) bits |= 1u << n;
            }
            bits |= __shfl_xor(bits, 1); bits |= __shfl_xor(bits, 2); bits |= __shfl_xor(bits, 4);
            selmask = __shfl(bits, tok8 * 8);
        }
        {
            unsigned um = selmask;
#pragma unroll
            for (int o = 1; o < 64; o <<= 1) um |= __shfl_xor(um, o);
            if (lane == 0) atomicOr((unsigned*)uni, um);
        }
        __syncthreads();
    }
    const unsigned ublk = uni[0];
    unsigned wsel = selmask;
#pragma unroll
    for (int o = 1; o < 64; o <<= 1) wsel |= __shfl_xor(wsel, o);
    int buf = 0;
    KVRegs kr;
    {
        const bf16_t* kb = (const bf16_t*)(ws + WS_KV6 + 2 * 4 * MiB) + (size_t)bg * NS * 64;
        const bf16_t* vb = (const bf16_t*)(ws + WS_KV6 + 3 * 4 * MiB) + (size_t)bg * NS * 64;
        f32x16 o0 = zero16(), o1 = zero16(); FaState st = {0.f, 0.f, 0};
        unsigned rem = ublk & (cur >= 31 ? 0xffffffffu : ((2u << cur) - 1u));
        int n = 31 - __builtin_clz(rem);
        kv_fetch(kr, kb, vb, 64 * n, 1, 0, NS - 1, tid);
        while (rem) {
            rem &= ~(1u << n);
            LAS unsigned char* Kc = lds + buf * KVT; LAS unsigned char* Vc = lds + 2 * KVT + buf * VT;
            kv_commit(kr, Kc, Vc, tid);
            __syncthreads();
            const int ncur = n;
            if (rem) { n = 31 - __builtin_clz(rem); kv_fetch(kr, kb, vb, 64 * n, 1, 0, NS - 1, tid); }
            if ((wsel >> ncur) & 1u)
                fa_tile64<true>(o0, o1, st, qf, Kc, Vc, lane, (float)(t - 64 * ncur), ((selmask >> ncur) & 1u) ? 1e30f : -1.f, ns2);
            buf ^= 1;
        }
        const float lt = st.l + __shfl_xor(st.l, 32);
        { const float sc = g1 / lt;
#pragma unroll
          for (int i = 0; i < 16; ++i) { totL[i * 256] += sc * o0[i]; totL[(16 + i) * 256] += sc * o1[i]; } }
    }
    {
        const bf16_t* kb = (const bf16_t*)(ws + WS_KV6 + 4 * 4 * MiB) + (size_t)bg * NS * 64;
        const bf16_t* vb = (const bf16_t*)(ws + WS_KV6 + 5 * 4 * MiB) + (size_t)bg * NS * 64;
        f32x16 o0 = zero16(), o1 = zero16(); FaState st = {0.f, 0.f, 0};
        const int nlo = t0 >= 511 ? (t0 - 511) >> 6 : 0;
        kv_fetch(kr, kb, vb, 64 * cur, 1, 0, NS - 1, tid);
        for (int n = cur; n >= nlo; --n) {
            LAS unsigned char* Kc = lds + buf * KVT; LAS unsigned char* Vc = lds + 2 * KVT + buf * VT;
            kv_commit(kr, Kc, Vc, tid);
            __syncthreads();
            if (n > nlo) kv_fetch(kr, kb, vb, 64 * (n - 1), 1, 0, NS - 1, tid);
            fa_tile64<true>(o0, o1, st, qf, Kc, Vc, lane, (float)(t - 64 * n), 511.f, ns2);
            buf ^= 1;
        }
        const float lt = st.l + __shfl_xor(st.l, 32);
        { const float sc = g2 / lt;
#pragma unroll
          for (int i = 0; i < 16; ++i) { o0[i] = totL[i * 256] + sc * o0[i]; o1[i] = totL[(16 + i) * 256] + sc * o1[i]; } }
        store_ot((bf16_t*)(ws + WS_O) + ((size_t)(b * NS + t) * ND + 512 + hb * 64), o0, o1, 1.0f, h);
    }
}

#define XB_TMO      128
#define XB_XCNT(j)  (256  + 64 * (j))
#define XB_XSUB(j)  (1280 + 64 * (j))
#define XB_XGEN(j)  (2304 + 64 * (j))
#define XB_TOP      3328
#define XB_TOPGEN   3392
#define XCD_BAR_WORDS 3456
#define XB_SPIN_CAP (1u << 18)
__device__ __forceinline__ unsigned xb_ld(unsigned* p)              { return __hip_atomic_load(p, __ATOMIC_RELAXED, __HIP_MEMORY_SCOPE_AGENT); }
__device__ __forceinline__ unsigned xb_add(unsigned* p, unsigned v) { return __hip_atomic_fetch_add(p, v, __ATOMIC_RELAXED, __HIP_MEMORY_SCOPE_AGENT); }
__device__ __forceinline__ unsigned xb_xcc_id() { return (unsigned)__builtin_amdgcn_s_getreg((3 << 11) | 20) & 0xFu; }
#define XB_SPIN(cond, bar) do { unsigned _sp = 0; while (cond) { __builtin_amdgcn_s_sleep(1); \
    if ((++_sp & 255u) == 0u) { if (xb_ld(&(bar)[XB_TMO])) break; if (_sp > XB_SPIN_CAP) { atomicAdd(&(bar)[XB_TMO], 1u); break; } } } } while (0)
struct XcdBarrier { unsigned* bar; unsigned x; volatile LAS unsigned* st; };
__device__ __forceinline__ XcdBarrier xcd_barrier_post(unsigned* bar, volatile LAS unsigned* st) {
    XcdBarrier b; b.bar = bar; b.x = xb_xcc_id(); b.st = st;
    if (threadIdx.x == 0) (void)xb_add(&bar[XB_XCNT(b.x)], 1u);
    return b;
}
__device__ __forceinline__ void xcd_barrier_complete(unsigned* bar, unsigned x, unsigned& nloc, unsigned& nx) {
    const unsigned G = gridDim.x * gridDim.y * gridDim.z;
    unsigned sum, cnt, mine, sp = 0u;
    for (;;) {
        sum = 0u; cnt = 0u; mine = 0u;
#pragma unroll
        for (unsigned j = 0; j < 16; ++j) { const unsigned c = xb_ld(&bar[XB_XCNT(j)]); sum += c; cnt += (c > 0u) ? 1u : 0u; mine = (j == x) ? c : mine; }
        if (sum == G) break;
        __builtin_amdgcn_s_sleep(1);
        if ((++sp & 255u) == 0u) { if (xb_ld(&bar[XB_TMO])) break; if (sp > XB_SPIN_CAP) { atomicAdd(&bar[XB_TMO], 1u); break; } }
    }
    nloc = mine > 0u ? mine : 1u; nx = cnt > 0u ? cnt : 1u;
}
__device__ __forceinline__ void xcd_barrier(const XcdBarrier& b) {
    asm volatile("s_waitcnt vmcnt(0)" ::: "memory");
    __syncthreads();
    if (threadIdx.x == 0) {
        unsigned* bar = b.bar;
        __builtin_amdgcn_s_waitcnt(0);
        unsigned nloc = b.st[0], nx = b.st[1];
        if (nloc == 0u) { xcd_barrier_complete(bar, b.x, nloc, nx); b.st[0] = nloc; b.st[1] = nx; }
        const unsigned old = xb_add(&bar[XB_XSUB(b.x)], 1u);
        const unsigned gen = old / nloc;
        if (old + 1u == (gen + 1u) * nloc) {
            __builtin_amdgcn_fence(__ATOMIC_RELEASE, "agent");
            asm volatile("s_waitcnt vmcnt(0)" ::: "memory");
            const unsigned og = xb_add(&bar[XB_TOP], 1u);
            const unsigned tg = og / nx;
            if (og + 1u == (tg + 1u) * nx) xb_add(&bar[XB_TOPGEN], 1u);
            else XB_SPIN(xb_ld(&bar[XB_TOPGEN]) == tg, bar);
            __builtin_amdgcn_fence(__ATOMIC_ACQUIRE, "agent");
            xb_add(&bar[XB_XGEN(b.x)], 1u);
            asm volatile("s_waitcnt vmcnt(0)" ::: "memory");
        } else {
            XB_SPIN(xb_ld(&bar[XB_XGEN(b.x)]) == gen, bar);
            __builtin_amdgcn_fence(__ATOMIC_ACQUIRE, "agent");
            asm volatile("s_waitcnt vmcnt(0)" ::: "memory");
        }
    }
    __syncthreads();
}

struct XcdTiles {
    int m_lo, cnt_m, nN, loc, nloc, tiles;
    __device__ __forceinline__ XcdTiles(int nM, int nN_) {
        const int b = BID(), g = gridDim.x;
        int x, nx;
        if ((g & 7) == 0) { x = b & 7; nx = 8; loc = b >> 3; nloc = g >> 3; } else { x = 0; nx = 1; loc = b; nloc = g; }
        m_lo = (int)((long)nM * x / nx); cnt_m = (int)((long)nM * (x + 1) / nx) - m_lo; nN = nN_; tiles = cnt_m * nN;
    }
    __device__ __forceinline__ void get(int q, int& mt, int& nt) const {
        const int mg = q / (8 * nN), rem_m = cnt_m - 8 * mg, mig = rem_m < 8 ? rem_m : 8, r = q - mg * 8 * nN;
        nt = r / mig; mt = m_lo + 8 * mg + (r - nt * mig);
    }
};
struct PhInProj { const bf16_t* xn; const unsigned char* wl; unsigned char* ws; const float* ssp; LAS unsigned char* lds; XcdTiles xt;
    __device__ __forceinline__ void make(int q, APlain& ap, BPlain& bp, EpiInProj& ep) const { int mt, nt; xt.get(q, mt, nt);
        ap = APlain{xn + (size_t)mt * 128 * ND, ND}; bp = BPlain{(const bf16_t*)(wl + WL_IN) + (size_t)nt * 128 * ND, ND}; ep = EpiInProj{mt, nt, ws, ssp, lds}; } };
struct PhCmp1 { const unsigned char* wl; unsigned char* ws; int l;
    __device__ __forceinline__ void make(int tile, ACmp& ap, BPlain& bp, EpiCmp1& ep) const { const int nt = tile & 1, bg = (tile >> 1) & 15, kv = tile >> 5;
        ap = ACmp{(const bf16_t*)(ws + WS_KV6 + (size_t)kv * 4 * MiB) + (size_t)bg * NS * 64};
        bp = BPlain{(const bf16_t*)(wl + WL_C1) + (size_t)kv * 256 * 2048 + (size_t)nt * 128 * 2048, 2048};
        ep = EpiCmp1{(bf16_t*)(ws + WS_HC) + (size_t)kv * 2048 * 256, (const float*)(ws + WS_BC1P) + l * 512 + kv * 256, bg * 128, nt * 128}; } };
struct PhCmp2 { const unsigned char* wl; unsigned char* ws;
    __device__ __forceinline__ void make(int tile, APlain& ap, BPlain& bp, EpiCmp2& ep) const { const int bg = tile & 15, kv = tile >> 4;
        ap = APlain{(const bf16_t*)(ws + WS_HC) + (size_t)kv * 2048 * 256 + (size_t)bg * 128 * 256, 256};
        bp = BPlain{(const bf16_t*)(wl + WL_C2) + (size_t)kv * 128 * 256, 256};
        ep = EpiCmp2{(bf16_t*)(ws + WS_KCMP) + (size_t)kv * 16 * 128 * 64, bg * 128}; } };
struct PhOutProj { const unsigned char* wl; unsigned char* ws; bf16_t* res; XcdTiles xt;
    __device__ __forceinline__ void make(int q, APlain& ap, BPlain& bp, EpiResAdd& ep) const { int mt, nt; xt.get(q, mt, nt);
        ap = APlain{(const bf16_t*)(ws + WS_O) + (size_t)mt * 128 * ND, ND}; bp = BPlain{(const bf16_t*)(wl + WL_OUT) + (size_t)nt * 128 * ND, ND};
        ep = EpiResAdd{res, mt * 128, nt * 128}; } };
struct PhMoe {
    LAS const int* sm; const int* list;
    __device__ __forceinline__ void decode(int gmt, int& bk, int& mt, int& rem, int& hrow0, int& elo, int& ehi) const {
        bk = 0;
        for (int k = 1; k < 24; ++k) if (gmt >= sm[32 + k]) bk = k;
        mt = gmt - sm[32 + bk]; rem = sm[bk] - mt * 128; hrow0 = sm[64 + bk] + mt * 128;
        const int grp = bk / 6, pi = bk % 6;
        elo = grp * 4 + (pi < 3 ? 0 : (pi < 5 ? 1 : 2)); ehi = grp * 4 + (pi < 3 ? pi + 1 : (pi < 5 ? pi - 1 : 3));
    } };
struct PhMoeGU { PhMoe m; const bf16_t* xn; const unsigned char* wl; unsigned char* ws; const float* route; const float* rinv; XcdTiles xt;
    __device__ __forceinline__ void make(int q, AGather& ap, BPlain& bp, EpiMoeGU& ep) const { int gmt, nt16; xt.get(q, gmt, nt16);
        int bk, mt, rem, hrow0, elo, ehi; m.decode(gmt, bk, mt, rem, hrow0, elo, ehi);
        const int* lst = m.list + (size_t)bk * NT + mt * 128; const int e = (nt16 >> 3) ? ehi : elo;
        ap = AGather{xn, lst, rem}; bp = BPlain{(const bf16_t*)(wl + WL_GU) + (size_t)e * 1024 * 1024 + (size_t)(nt16 & 7) * 128 * 1024, 1024};
        ep = EpiMoeGU{(bf16_t*)(ws + WS_HID), lst, route, rinv, rem, hrow0, nt16}; } };
struct PhMoeDown { PhMoe m; const unsigned char* wl; unsigned char* ws; bf16_t* res; float* ssp; XcdTiles xt;
    __device__ __forceinline__ void make(int q, APlain& ap, BSplit& bp, EpiMoeDown& ep) const { int gmt, nt; xt.get(q, gmt, nt);
        int bk, mt, rem, hrow0, elo, ehi; m.decode(gmt, bk, mt, rem, hrow0, elo, ehi);
        const int* lst = m.list + (size_t)bk * NT + mt * 128;
        ap = APlain{(const bf16_t*)(ws + WS_HID) + (size_t)hrow0 * 1024, 1024};
        bp = BSplit{(const bf16_t*)(wl + WL_DN) + (size_t)elo * 1024 * 512 + (size_t)nt * 128 * 512, (const bf16_t*)(wl + WL_DN) + (size_t)ehi * 1024 * 512 + (size_t)nt * 128 * 512};
        ep = EpiMoeDown{res, lst, ssp, rem, nt * 128}; } };
struct PhPleProj { const unsigned char* wl; unsigned char* ws; XcdTiles xt;
    __device__ __forceinline__ void make(int q, APlain& ap, BPlain& bp, EpiBf16& ep) const { int mt, nt; xt.get(q, mt, nt);
        ap = APlain{(const bf16_t*)(ws + WS_PB) + (size_t)mt * 128 * 256, 256}; bp = BPlain{(const bf16_t*)(wl + WL_PP) + (size_t)nt * 128 * 256, 256};
        ep = EpiBf16{(bf16_t*)(ws + WS_P2), ND, mt * 128, nt * 128}; } };
struct PhPleGate { const bf16_t* xn; const unsigned char* wl; unsigned char* ws; float* out; float sc; XcdTiles xt;
    __device__ __forceinline__ void make(int q, APlain& ap, BPlain& bp, EpiPleGate& ep) const { int mt, nt; xt.get(q, mt, nt);
        ap = APlain{xn + (size_t)mt * 128 * ND, ND}; bp = BPlain{(const bf16_t*)(wl + WL_PG) + (size_t)nt * 128 * ND, ND};
        ep = EpiPleGate{out, (const bf16_t*)(ws + WS_P2), mt * 128, nt * 128, sc}; } };

constexpr int LDS_QSLOT = 73856 + 16 + 448;
__device__ __forceinline__ int wq_next(int* head, LAS unsigned char* lds) {
    LAS int* slot = (LAS int*)(lds + LDS_QSLOT);
    __syncthreads();
    if (threadIdx.x == 0) *slot = atomicAdd(head, 1);
    __syncthreads();
    return *slot;
}
__device__ __forceinline__ void ple_stream(const bf16_t* xn, const bf16_t* pb, const unsigned char* wl, const float* ssp_in, bf16_t* rout, float* ssp_out, LAS unsigned char* lds) {
    const XcdTiles xt(128, 8);
    int q = xt.loc;
    if (q >= xt.tiles) return;
    const int tid = TID(), wid = tid >> 6, lane = tid & 63, wr = wid >> 1, wc = wid & 1, fr = lane & 15, fq = lane >> 4;
    int mt, nt; xt.get(q, mt, nt);
    bool pref = false;
    for (;;) {
        const int qn = q + xt.nloc; const bool hn = qn < xt.tiles;
        int mtn = mt, ntn = nt; if (hn) xt.get(qn, mtn, ntn);
        const APlain ap1{pb + (size_t)mt * 128 * 256, 256}; const BPlain bp1{(const bf16_t*)(wl + WL_PP) + (size_t)nt * 128 * 256, 256};
        const APlain ap2{xn + (size_t)mt * 128 * ND, ND};   const BPlain bp2{(const bf16_t*)(wl + WL_PG) + (size_t)nt * 128 * ND, ND};
        const APlain apn{pb + (size_t)mtn * 128 * 256, 256}; const BPlain bpn{(const bf16_t*)(wl + WL_PP) + (size_t)ntn * 128 * 256, 256};
        f32x4 acc[4][4], acc2[4][4]; zero_acc(acc); zero_acc(acc2);
        gemm_kloop(acc2, ap1, bp1, 256, lds, pref, true, ap2, bp2);
        gemm_kloop(acc, ap2, bp2, ND, lds, true, hn, apn, bpn);
        const EpiPleFused ep{xn, ssp_in, rout, ssp_out, mt * 128, nt * 128};
        ep(acc, acc2, wr, wc, fr, fq);
        if (!hn) break;
        q = qn; mt = mtn; nt = ntn; pref = true;
    }
}

constexpr int LDS_BAR = 73856;
constexpr int LDS_SM = LDS_BAR + 16;
constexpr int LDS_BYTES = LDS_SM + 512;
static_assert(LDS_QSLOT == LDS_SM + 448, "queue slot");
static_assert(4 * KVT + 4096 + 64 <= LDS_TOT && LDS_TOT + 32768 <= LDS_BAR && 65536 <= LDS_BAR, "LDS map");

__global__ void __launch_bounds__(256, 2) mega_fwd(Params p) {
    extern __shared__ __attribute__((aligned(16))) unsigned char lds_raw[];
    LAS unsigned char* lds = (LAS unsigned char*)lds_raw;
    unsigned char* ws = p.ws;
    const int tid = threadIdx.x;
    const int gtid = blockIdx.x * 256 + tid, gthreads = gridDim.x * 256;
    int* ctl = (int*)(ws + WS_CTL);
    {
        volatile LAS unsigned* st = (volatile LAS unsigned*)(lds + LDS_BAR);
        if (tid < 4) st[tid] = 0u;
        __syncthreads();
    }
    const XcdBarrier gbar = xcd_barrier_post((unsigned*)ctl + CW_BAR, (volatile LAS unsigned*)(lds + LDS_BAR));

    phase_convert(p, (LAS float*)lds);
    xcd_barrier(gbar);

    float* sspA = (float*)(ws + WS_SSP);
    float* sspB = sspA + (size_t)NT * 16;
    float* rinv = (float*)(ws + WS_RINV);
    for (int l = 0; l < 2; ++l) {
        const unsigned char* wl = ws + WS_W + (size_t)l * WL_SIZE;
        bf16_t* xn = (bf16_t*)p.out + (size_t)(l & 1) * NT * ND;
        bf16_t* rnext = l == 1 ? (bf16_t*)(ws + WS_XN) : (bf16_t*)p.out + (size_t)((l + 1) & 1) * NT * ND;
        const bf16_t* xb_in = xn;
        {
            const PhInProj ph{xb_in, wl, ws, sspB, lds, XcdTiles(128, 23)};
            gemm_stream<PhInProj, APlain, BPlain, EpiInProj>(ph, ph.xt.loc, ph.xt.nloc, ph.xt.tiles, ND, lds);
        }
        xcd_barrier(gbar);
        {
            int* qh = ctl + CW_Q + (l * 4 + 0) * 64;
            int* ch = ctl + CW_Q + (l * 4 + 2) * 64;
            const int nconv = conv_queue_strips(2 * l);
            const PhCmp1 ph{wl, ws, l};
            bool conv_left = nconv > 0, att_left = true, first_att = true;
            for (int k = 0; conv_left || att_left; ++k) {
                const bool want_conv = conv_left && (!att_left || (k % 7) == 6);
                if (want_conv) {
                    const int c = wq_next(ch, lds);
                    if (c < nconv) conv_strip(p, 2 * l, c, (LAS float*)lds); else conv_left = false;
                } else {
                    const int it = first_att ? BID() : (int)gridDim.x + wq_next(qh, lds);
                    first_att = false;
                    if (it >= 64 + 1536) att_left = false;
                    else if (it < 64) { ACmp ap; BPlain bp; EpiCmp1 ep; ph.make(it, ap, bp, ep); gemm_tile(ap, bp, 2048, ep, lds, false, false, ap, bp); }
                    else { dil_item(ws, 2 * (it - 64), lds); __syncthreads(); dil_item(ws, 2 * (it - 64) + 1, lds); }
                }
            }
        }
        xcd_barrier(gbar);
        { const PhCmp2 ph{wl, ws}; gemm_stream<PhCmp2, APlain, BPlain, EpiCmp2>(ph, BID(), gridDim.x, 32, 256, lds); }
        dil_merge(ws, gtid, gthreads);
        if (l == 0) convert_p(p);
        xcd_barrier(gbar);
        {
            int* qh = ctl + CW_Q + (l * 4 + 1) * 64;
            int* ch = ctl + CW_Q + (l * 4 + 3) * 64;
            const int nconv = conv_queue_strips(2 * l + 1);
            bool conv_left = nconv > 0, att_left = true, first_att = true;
            for (int k = 0; conv_left || att_left; ++k) {
                const bool want_conv = conv_left && (!att_left || (k % 4) == 3);
                if (want_conv) {
                    const int c = wq_next(ch, lds);
                    if (c < nconv) conv_strip(p, 2 * l + 1, c, (LAS float*)lds); else conv_left = false;
                } else {
                    const int it = first_att ? BID() : (int)gridDim.x + wq_next(qh, lds);
                    first_att = false;
                    if (it >= 1024) att_left = false;
                    else nsa_item(ws, ((63 - (it >> 4)) << 4) | (it & 15), lds);
                }
            }
        }
        xcd_barrier(gbar);
        { const PhOutProj ph{wl, ws, xn, XcdTiles(128, 8)};
          gemm_stream<PhOutProj, APlain, BPlain, EpiResAdd>(ph, ph.xt.loc, ph.xt.nloc, ph.xt.tiles, ND, lds); }
        xcd_barrier(gbar);
        int* cnt = ctl + CW_CNTP + l * 1536;
        int* list = (int*)(ws + WS_LIST);
        float* route = (float*)(ws + WS_ROUTE);
        phase_route(xn, (const float*)(wl + WL_RT), p.in[12] + l * 4, p.in[14] + l * 16, cnt, list, route, rinv, lds);
        xcd_barrier(gbar);
        LAS int* sm = (LAS int*)(lds + LDS_SM);
        __syncthreads();
        if (tid < 24) sm[tid] = __hip_atomic_load(cnt + 64 * tid, __ATOMIC_RELAXED, __HIP_MEMORY_SCOPE_AGENT);
        __syncthreads();
        if (tid == 0) {
            int tp = 0, hb = 0;
            for (int k = 0; k < 24; ++k) {
                const int c = sm[k];
                sm[32 + k] = tp; sm[64 + k] = hb;
                const int nt_ = (c + 127) >> 7; tp += nt_; hb += nt_ * 128;
            }
            sm[32 + 24] = tp;
        }
        __syncthreads();
        const int total_mt = sm[32 + 24];
        { const PhMoeGU ph{PhMoe{sm, list}, xn, wl, ws, route, rinv, XcdTiles(total_mt, 16)};
          gemm_stream<PhMoeGU, AGather, BPlain, EpiMoeGU>(ph, ph.xt.loc, ph.xt.nloc, ph.xt.tiles, ND, lds); }
        xcd_barrier(gbar);
        { const PhMoeDown ph{PhMoe{sm, list}, wl, ws, xn, sspA, XcdTiles(total_mt, 8)};
          gemm_stream<PhMoeDown, APlain, BSplit, EpiMoeDown>(ph, ph.xt.loc, ph.xt.nloc, ph.xt.tiles, ND, lds); }
        xcd_barrier(gbar);
        ple_stream(xn, (const bf16_t*)(ws + WS_PBALL) + (size_t)l * NT * 256, wl, sspA, rnext, sspB, lds);
        xcd_barrier(gbar);
    }
    phase_final_norm((const bf16_t*)(ws + WS_XN), p.out, p.in[21]);
}

extern "C" void kernel_launch(void* const* d_in, const int* in_sizes, int n_in, void* d_out, int out_size, void* d_ws, size_t ws_size, hipStream_t stream) {
    static int grid = 0;
    if (grid == 0) {
        if (n_in != 22 || out_size != NT * ND || ws_size < WS_END) { fprintf(stderr, "kernel_launch: unexpected shapes (n_in %d out %d ws %zu)\n", n_in, out_size, ws_size); grid = -1; return; }
        int dev = 0, cus = 0, per_cu = 0;
        hipGetDevice(&dev);
        hipDeviceGetAttribute(&cus, hipDeviceAttributeMultiprocessorCount, dev);
        if (hipFuncSetAttribute((const void*)mega_fwd, hipFuncAttributeMaxDynamicSharedMemorySize, LDS_BYTES) != hipSuccess) { fprintf(stderr, "kernel_launch: hipFuncSetAttribute failed\n"); grid = -1; return; }
        hipOccupancyMaxActiveBlocksPerMultiprocessor(&per_cu, (const void*)mega_fwd, 256, LDS_BYTES);
        if (per_cu < 1) { fprintf(stderr, "kernel_launch: occupancy query says %d\n", per_cu); grid = -1; return; }
        if (per_cu > 2) per_cu = 2;
        grid = cus * per_cu;
    }
    if (grid < 0) return;
    hipMemsetAsync((char*)d_ws + WS_CTL, 0, 32768, stream);
    Params p{};
    for (int i = 0; i < 22; ++i) p.in[i] = (const float*)d_in[i];
    p.out = (float*)d_out; p.ws = (unsigned char*)d_ws;
    hipLaunchKernelGGL(mega_fwd, dim3(grid), dim3(256), LDS_BYTES, stream, p);
    const hipError_t e = hipPeekAtLastError();
    if (e != hipSuccess) fprintf(stderr, "launch failed: %s (grid %d)\n", hipGetErrorString(e), grid);
}
```

```cpp
#include <hip/hip_runtime.h>
#include <cstdio>
#include <cstdint>

#ifndef NAIVE_GEMM
#define NAIVE_GEMM 0
#endif
#ifndef NAIVE_ATTN
#define NAIVE_ATTN 0
#endif
#define REP_CONV 1
#define REP_INPROJ 1
#define REP_ATTN 1
#define REP_GU 1
#define REP_NORM 1
#define REP_ROUTE 1
#define REP_DOWN 1
#define REP_OUTPROJ 1
#define REP_PG 1
#define REP_CMP 1
#define REP_MISC 1

#define LAS __attribute__((address_space(3)))
typedef unsigned short bf16_t;
typedef short bf16x8 __attribute__((ext_vector_type(8)));
typedef float f32x4 __attribute__((ext_vector_type(4)));
typedef unsigned u32x4 __attribute__((ext_vector_type(4)));
typedef unsigned u32x2 __attribute__((ext_vector_type(2)));
typedef float f32x16 __attribute__((ext_vector_type(16)));
typedef short s16x4 __attribute__((ext_vector_type(4)));
typedef float f32x2_t __attribute__((ext_vector_type(2)));
typedef __bf16 bf16x2_t __attribute__((ext_vector_type(2)));

constexpr int NB = 8, NS = 2048, ND = 1024, NT = NB * NS;
constexpr int NIN = 2840, NINP = 2944;
constexpr size_t MiB = (size_t)1 << 20;
constexpr size_t WL_IN = 0;
constexpr size_t WL_OUT = WL_IN + (size_t)NINP * 1024 * 2;
constexpr size_t WL_C1 = WL_OUT + (size_t)1024 * 1024 * 2;
constexpr size_t WL_C2 = WL_C1 + (size_t)2 * 256 * 2048 * 2;
constexpr size_t WL_GU = WL_C2 + (size_t)2 * 128 * 256 * 2;
constexpr size_t WL_DN = WL_GU + (size_t)16 * 1024 * 1024 * 2;
constexpr size_t WL_PG = WL_DN + (size_t)16 * 1024 * 512 * 2;
constexpr size_t WL_PP = WL_PG + (size_t)1024 * 1024 * 2;
constexpr size_t WL_BC1 = WL_PP + (size_t)1024 * 256 * 2;
constexpr size_t WL_RT = WL_BC1 + 2048;
constexpr size_t WL_SIZE = 64 * MiB;
static_assert(WL_RT + 131072 <= WL_SIZE, "weight block");
constexpr size_t WS_CTL = 0;
constexpr size_t WS_W = 1 * MiB;
constexpr size_t WS_XN = WS_W + 2 * WL_SIZE;
constexpr size_t WS_PROJ = WS_XN + 32 * MiB;
constexpr size_t WS_QA = WS_PROJ, WS_KA = WS_QA + 16 * MiB, WS_VA = WS_KA + 16 * MiB, WS_QB = WS_VA + 16 * MiB;
constexpr size_t WS_KV6 = WS_QB + 16 * MiB;
constexpr size_t WS_GATES = WS_KV6 + 24 * MiB;
constexpr size_t WS_PROJ_END = WS_GATES + 2 * MiB;
constexpr size_t WS_HID = WS_PROJ;
constexpr size_t WS_P2 = WS_PROJ + 40 * MiB;
constexpr size_t WS_PB = WS_PROJ + 72 * MiB;
constexpr size_t WS_HC = WS_PROJ_END;
constexpr size_t WS_KCMP = WS_HC + 2 * MiB;
constexpr size_t WS_MASK = WS_KCMP + 512 * 1024;
constexpr size_t WS_ROUTE = WS_MASK + 128 * 1024;
constexpr size_t WS_LIST = WS_ROUTE + 128 * 1024;
constexpr size_t WS_O = WS_LIST + 1536 * 1024 + 256 * 1024;
constexpr size_t WS_IMPH = WS_O + 32 * MiB;
constexpr size_t WS_OPA01 = WS_XN;
constexpr size_t WS_OPA2 = WS_IMPH;
constexpr size_t WS_STA = WS_IMPH + 16 * MiB;
constexpr size_t WS_PBALL = WS_IMPH + 20 * MiB;
constexpr size_t WS_SSP = WS_PBALL + 16 * MiB;
constexpr size_t WS_RINV = WS_MASK;
constexpr size_t WS_BC1P = WS_SSP + 2 * MiB;
constexpr size_t WS_END = WS_BC1P + 64 * 1024;
static_assert(WS_PB + 8 * MiB <= WS_PROJ_END, "alias map");
static_assert(WS_END <= 330 * MiB, "workspace");
constexpr int HID_ROWS = NT + 24 * 128;
constexpr int CW_BAR = 1024;
constexpr int CW_Q = 256;
constexpr int CW_CNTP = 4608;
constexpr int CW_CNT = 64;

struct Params {
    const float* in[22];
    float* out;
    unsigned char* ws;
};

__device__ __forceinline__ unsigned f2bf(float f) { unsigned u = __float_as_uint(f); return (u + 0x7fffu + ((u >> 16) & 1u)) >> 16; }
__device__ __forceinline__ unsigned pk2(float lo, float hi) { return f2bf(lo) | (f2bf(hi) << 16); }
__device__ __forceinline__ float bflo(unsigned v) { return __uint_as_float(v << 16); }
__device__ __forceinline__ float bfhi(unsigned v) { return __uint_as_float(v & 0xffff0000u); }
__device__ __forceinline__ float wave_sum(float v) {
#pragma unroll
    for (int o = 1; o < 64; o <<= 1) v += __shfl_xor(v, o);
    return v;
}
__device__ __forceinline__ int TID() { int t = threadIdx.x; asm volatile("" : "+v"(t)); return t; }
__device__ __forceinline__ int BID() { int t = blockIdx.x; asm volatile("" : "+s"(t)); return t; }
__device__ __forceinline__ float sigmoidf_(float x) { return 1.0f / (1.0f + __expf(-x)); }
__device__ __forceinline__ float gelu_tanh(float x) {
    const float u = 0.7978845608028654f * (x + 0.044715f * x * x * x);
    const float e = __expf(2.0f * u);
    const float th = 1.0f - 2.0f / (e + 1.0f);
    return 0.5f * x * (1.0f + th);
}

struct ConvJob { const float* src; bf16_t* dst; const float* gain; int K, N, NP, map, per; size_t dst_bstride; };
__device__ __forceinline__ int conv_job_tiles(int j) { return j == 0 ? 736 : (j == 1 || j == 9) ? 256 : (j == 2 || j == 3) ? 128 : (j == 4 || j == 5) ? 8 : j == 10 ? 64 : 2048; }
__device__ __forceinline__ ConvJob conv_job(const Params& p, int l, int j) {
    unsigned char* wl = p.ws + WS_W + (size_t)l * WL_SIZE;
    ConvJob c; c.map = 0; c.dst_bstride = 0; c.gain = nullptr;
    switch (j) {
    case 0: c.src = p.in[3] + (size_t)l * 1024 * NIN; c.K = 1024; c.N = NIN; c.NP = NINP; c.dst = (bf16_t*)(wl + WL_IN); c.gain = p.in[2] + l * ND; break;
    case 1: c.src = p.in[4] + (size_t)l * 1024 * 1024; c.K = 1024; c.N = 1024; c.NP = 1024; c.dst = (bf16_t*)(wl + WL_OUT); break;
    case 2: c.src = p.in[5] + (size_t)l * 2048 * 256; c.K = 2048; c.N = 256; c.NP = 256; c.dst = (bf16_t*)(wl + WL_C1); break;
    case 3: c.src = p.in[7] + (size_t)l * 2048 * 256; c.K = 2048; c.N = 256; c.NP = 256; c.dst = (bf16_t*)(wl + WL_C1) + (size_t)256 * 2048; break;
    case 4: c.src = p.in[6] + (size_t)l * 256 * 64; c.K = 256; c.N = 64; c.NP = 128; c.dst = (bf16_t*)(wl + WL_C2); break;
    case 5: c.src = p.in[8] + (size_t)l * 256 * 64; c.K = 256; c.N = 64; c.NP = 128; c.dst = (bf16_t*)(wl + WL_C2) + (size_t)128 * 256; break;
    case 6: c.src = p.in[15] + (size_t)l * 16 * 1024 * 512; c.K = 1024; c.N = 512; c.NP = 512; c.dst = (bf16_t*)(wl + WL_GU); c.map = 1; c.dst_bstride = (size_t)1024 * 1024; c.gain = p.in[10] + l * ND; break;
    case 7: c.src = p.in[16] + (size_t)l * 16 * 1024 * 512; c.K = 1024; c.N = 512; c.NP = 512; c.dst = (bf16_t*)(wl + WL_GU); c.map = 2; c.dst_bstride = (size_t)1024 * 1024; c.gain = p.in[10] + l * ND; break;
    case 8: c.src = p.in[17] + (size_t)l * 16 * 512 * 1024; c.K = 512; c.N = 1024; c.NP = 1024; c.dst = (bf16_t*)(wl + WL_DN); c.dst_bstride = (size_t)1024 * 512; break;
    case 9: c.src = p.in[19] + (size_t)l * 1024 * 1024; c.K = 1024; c.N = 1024; c.NP = 1024; c.dst = (bf16_t*)(wl + WL_PG); c.gain = p.in[18] + l * ND; break;
    default: c.src = p.in[20] + (size_t)l * 256 * 1024; c.K = 256; c.N = 1024; c.NP = 1024; c.dst = (bf16_t*)(wl + WL_PP); break;
    }
    c.per = (c.K / 64) * (c.NP / 64);
    return c;
}
__device__ __forceinline__ void convert_tiles(const ConvJob& c, int t0, int t1, LAS float* tl) {
    const int tid = TID();
    const int ntiles = c.NP / 64;
    const int kr = tid >> 4, c4 = (tid & 15) * 4;
    f32x4 v[4]; float gv[4];
#define CT_LOAD(it_) do { const int _bi = (it_) / c.per, _r = (it_) - _bi * c.per, _kt = _r / ntiles, _nt = _r - _kt * ntiles; \
        const int _n = _nt * 64 + c4; const bool _ok = _n < c.N; \
        const float* _sp = c.src + (size_t)_bi * c.K * c.N + (size_t)(_kt * 64 + kr) * c.N + (_ok ? _n : 0); \
        _Pragma("unroll") for (int _i = 0; _i < 4; ++_i) v[_i] = *(const f32x4*)(_sp + (size_t)(16 * _i) * c.N); \
        if (c.gain) { _Pragma("unroll") for (int _i = 0; _i < 4; ++_i) gv[_i] = c.gain[_kt * 64 + kr + 16 * _i]; } \
        else { _Pragma("unroll") for (int _i = 0; _i < 4; ++_i) gv[_i] = 1.0f; } \
        if (!_ok) { _Pragma("unroll") for (int _i = 0; _i < 4; ++_i) gv[_i] = 0.f; } } while (0)
    CT_LOAD(t0);
    for (int it = t0; it < t1; ++it) {
        const int bi = it / c.per, r = it - bi * c.per, kt = r / ntiles, nt = r - kt * ntiles;
        bf16_t* d = c.dst + (size_t)bi * c.dst_bstride;
        const int k0 = kt * 64, n0 = nt * 64;
        __syncthreads();
#pragma unroll
        for (int i = 0; i < 4; ++i) {
            LAS float* tp = tl + (kr + 16 * i) * 65 + c4;
            tp[0] = v[i].x * gv[i]; tp[1] = v[i].y * gv[i]; tp[2] = v[i].z * gv[i]; tp[3] = v[i].w * gv[i];
        }
        if (it + 1 < t1) CT_LOAD(it + 1);
        __syncthreads();
        const int n = tid >> 2, kc = (tid & 3) * 16;
        const int nsrc = n0 + n;
        const int row = (c.map == 0) ? nsrc : ((nsrc >> 4) * 32 + (nsrc & 15) + (c.map == 2 ? 16 : 0));
        float w[16];
#pragma unroll
        for (int j = 0; j < 16; ++j) w[j] = tl[(kc + j) * 65 + n];
        u32x4 o0, o1;
        o0.x = pk2(w[0], w[1]); o0.y = pk2(w[2], w[3]); o0.z = pk2(w[4], w[5]); o0.w = pk2(w[6], w[7]);
        o1.x = pk2(w[8], w[9]); o1.y = pk2(w[10], w[11]); o1.z = pk2(w[12], w[13]); o1.w = pk2(w[14], w[15]);
        bf16_t* dp = d + (size_t)row * c.K + k0 + kc;
        *(u32x4*)dp = o0; *(u32x4*)(dp + 8) = o1;
    }
#undef CT_LOAD
}
__device__ __forceinline__ int conv_list(int q, int i) {
    if (q == 0) return i == 0 ? 6 : (i == 1 ? 7 : -1);
    if (q == 1) return i == 0 ? 8 : i == 1 ? 9 : i == 2 ? 10 : i == 3 ? 16 : i == 4 ? 18 : i == 5 ? 19 : i == 6 ? 20 : i == 7 ? 21 : -1;
    if (q == 2) return i == 0 ? 17 : i == 1 ? 22 : i == 2 ? 23 : -1;
    return i == 0 ? 24 : i == 1 ? 25 : i == 2 ? 26 : -1;
}
__device__ __forceinline__ int conv_queue_strips(int q) {
    int n = 0;
    for (int i = 0; i < 8; ++i) { const int e = conv_list(q, i); if (e < 0) break; n += conv_job_tiles(e & 15) >> 3; }
    return n;
}
__device__ __forceinline__ void conv_strip(const Params& p, int q, int c, LAS float* tl) {
    for (int i = 0; i < 8; ++i) {
        const int e = conv_list(q, i);
        if (e < 0) return;
        const int ns = conv_job_tiles(e & 15) >> 3;
        if (c < ns) { const ConvJob job = conv_job(p, e >> 4, e & 15); convert_tiles(job, c * 8, c * 8 + 8, tl); return; }
        c -= ns;
    }
}

__device__ __forceinline__ void convert_p(const Params& p) {
    const f32x4* pl = (const f32x4*)p.in[1]; u32x2* pb = (u32x2*)(p.ws + WS_PBALL);
    for (int i = BID() * 256 + TID(); i < 2 * NT * 256 / 4; i += gridDim.x * 256) {
        const f32x4 v = pl[i]; u32x2 w; w.x = pk2(v.x, v.y); w.y = pk2(v.z, v.w); pb[i] = w;
    }
}
__device__ __forceinline__ void phase_convert(const Params& p, LAS float* tl) {
    {
        int base = 0;
        for (int j = 0; j < 6; ++j) {
            const ConvJob job = conv_job(p, 0, j);
            const int nt = conv_job_tiles(j);
            const int g = gridDim.x, b = BID();
            int first = (b - base % g + g) % g;
            for (int s = first; s < nt; s += g) convert_tiles(job, s, s + 1, tl);
            base += nt;
        }
    }
    {
        const int skip = gridDim.x >= 128 ? 64 : 0;
        const int tid_ = TID(); const int lane = tid_ & 63, gw = (BID() - skip) * 4 + (tid_ >> 6), ngw = (gridDim.x - skip) * 4;
        for (int row = gw >= 0 ? gw : NT; row < NT; row += ngw) {
            const f32x4* xr = (const f32x4*)(p.in[0] + (size_t)row * ND) + lane;
            u32x2* o = (u32x2*)((bf16_t*)p.out + (size_t)row * ND) + lane;
            float ss = 0.f;
#pragma unroll
            for (int j = 0; j < 4; ++j) { const f32x4 v = xr[64 * j]; ss += (v.x * v.x + v.y * v.y) + (v.z * v.z + v.w * v.w); u32x2 w; w.x = pk2(v.x, v.y); w.y = pk2(v.z, v.w); o[64 * j] = w; }
            ss = wave_sum(ss);
            if (lane < 16) ((float*)(p.ws + WS_SSP) + (size_t)NT * 16)[(size_t)row * 16 + lane] = lane == 0 ? ss : 0.f;
        }
    }
    for (int i = BID() * 256 + TID(); i < 2 * 1024 * 32; i += gridDim.x * 256) {
        const int l = i >> 15, k = (i >> 5) & 1023, j = i & 31;
        const float gk = p.in[10][l * ND + k];
        const float wv = j < 4 ? p.in[11][(size_t)(l * ND + k) * 4 + j] : (j < 20 ? p.in[13][(size_t)(l * ND + k) * 16 + (j - 4)] : 0.f);
        ((float*)(p.ws + WS_W + (size_t)l * WL_SIZE + WL_RT))[k * 32 + j] = gk * wv;
    }
    for (int i = BID() * 256 + TID(); i < 16 * 1024; i += gridDim.x * 256) {
        const int part = i >> 10, o = i & 1023, l = o >> 9, kv = (o >> 8) & 1, n = o & 255;
        const float* pos = p.in[9] + (size_t)(l * 2 + kv) * 2048 + part * 128;
        const float* w1 = p.in[kv ? 7 : 5] + (size_t)l * 2048 * 256 + (size_t)part * 128 * 256 + n;
        float s = 0.f;
#pragma unroll 16
        for (int k = 0; k < 128; ++k) s += pos[k] * w1[(size_t)k * 256];
        ((float*)(p.ws + WS_BC1P))[i] = s;
    }
}

__device__ __forceinline__ void phase_norm(const float* x, const float* g, bf16_t* xn) {
    const int tid_ = TID(); const int lane = tid_ & 63, gw = BID() * 4 + (tid_ >> 6), ngw = gridDim.x * 4;
    for (int row = gw; row < NT; row += ngw) {
        const f32x4* xr = (const f32x4*)(x + (size_t)row * ND) + lane;
        f32x4 v[4]; float ss = 0.f;
#pragma unroll
        for (int j = 0; j < 4; ++j) { v[j] = xr[64 * j]; ss += (v[j].x * v[j].x + v[j].y * v[j].y) + (v[j].z * v[j].z + v[j].w * v[j].w); }
        ss = wave_sum(ss);
        const float r = 1.0f / sqrtf(ss * (1.0f / ND) + 1e-6f);
        u32x2* o = (u32x2*)(xn + (size_t)row * ND) + lane;
#pragma unroll
        for (int j = 0; j < 4; ++j) {
            const f32x4 gg = ((const f32x4*)g)[lane + 64 * j];
            u32x2 w; w.x = pk2(v[j].x * r * gg.x, v[j].y * r * gg.y); w.y = pk2(v[j].z * r * gg.z, v[j].w * r * gg.w);
            o[64 * j] = w;
        }
    }
}
__device__ __forceinline__ void phase_final_norm(const bf16_t* xb, float* out, const float* g) {
    const int tid_ = TID(); const int lane = tid_ & 63, gw = BID() * 4 + (tid_ >> 6), ngw = gridDim.x * 4;
    for (int row = gw; row < NT; row += ngw) {
        const u32x2* xr = (const u32x2*)(xb + (size_t)row * ND) + lane;
        f32x4* orow = (f32x4*)(out + (size_t)row * ND) + lane;
        f32x4 v[4]; float ss = 0.f;
#pragma unroll
        for (int j = 0; j < 4; ++j) { const u32x2 w = xr[64 * j]; v[j] = (f32x4){bflo(w.x), bfhi(w.x), bflo(w.y), bfhi(w.y)}; ss += (v[j].x * v[j].x + v[j].y * v[j].y) + (v[j].z * v[j].z + v[j].w * v[j].w); }
        ss = wave_sum(ss);
        const float r = 1.0f / sqrtf(ss * (1.0f / ND) + 1e-6f);
#pragma unroll
        for (int j = 0; j < 4; ++j) {
            const f32x4 gg = ((const f32x4*)g)[lane + 64 * j];
            f32x4 o; o.x = v[j].x * r * gg.x; o.y = v[j].y * r * gg.y; o.z = v[j].z * r * gg.z; o.w = v[j].w * r * gg.w;
            orow[64 * j] = o;
        }
    }
}
typedef float f32x16r __attribute__((ext_vector_type(16)));
__device__ __forceinline__ void phase_route(const bf16_t* x, const float* wr, const float* brg, const float* bre, int* cnt, int* list, float* route, float* rinv, LAS unsigned char* lds) {
    const int tid_ = TID(); const int lane = tid_ & 63, wv = tid_ >> 6;
    const int i = lane & 31, hk = lane >> 5;
    LAS float* tl = (LAS float*)lds + wv * (32 * 33);
    LAS float* ssl = (LAS float*)(lds + 4 * 32 * 33 * 4);
    for (int task = BID(); task < NT / 32; task += gridDim.x) {
        const int row0 = task * 32;
        const bf16_t* xr = x + (size_t)(row0 + i) * ND + wv * 256;
        const float* wp = wr + (size_t)(wv * 256) * 32 + hk * 32 + i;
        f32x16r acc;
#pragma unroll
        for (int q = 0; q < 16; ++q) acc[q] = 0.f;
        float ss = 0.f;
#pragma unroll 8
        for (int k8 = 0; k8 < 32; ++k8) {
            const u32x4 xa = *(const u32x4*)(xr + 8 * k8);
            const float a0 = hk ? bfhi(xa.x) : bflo(xa.x), a1 = hk ? bfhi(xa.y) : bflo(xa.y), a2 = hk ? bfhi(xa.z) : bflo(xa.z), a3 = hk ? bfhi(xa.w) : bflo(xa.w);
            const float* wq = wp + (size_t)(8 * k8) * 32;
            acc = __builtin_amdgcn_mfma_f32_32x32x2f32(a0, wq[0], acc, 0, 0, 0);
            acc = __builtin_amdgcn_mfma_f32_32x32x2f32(a1, wq[2 * 32], acc, 0, 0, 0);
            acc = __builtin_amdgcn_mfma_f32_32x32x2f32(a2, wq[4 * 32], acc, 0, 0, 0);
            acc = __builtin_amdgcn_mfma_f32_32x32x2f32(a3, wq[6 * 32], acc, 0, 0, 0);
            ss += (a0 * a0 + a1 * a1) + (a2 * a2 + a3 * a3);
        }
        ss += __shfl_xor(ss, 32);
#pragma unroll
        for (int q = 0; q < 16; ++q) tl[((q & 3) + 8 * (q >> 2) + 4 * hk) * 33 + i] = acc[q];
        if (hk == 0) ssl[wv * 32 + i] = ss;
        __syncthreads();
        if (wv == 0 && hk == 0) {
            LAS const float* tp0 = (LAS const float*)lds;
            const float sst = (ssl[i] + ssl[32 + i]) + (ssl[64 + i] + ssl[96 + i]);
            const float r = 1.0f / sqrtf(sst * (1.0f / ND) + 1e-6f);
#define RT_SUM(e_) ((tp0[i * 33 + (e_)] + tp0[32 * 33 + i * 33 + (e_)]) + (tp0[2 * 32 * 33 + i * 33 + (e_)] + tp0[3 * 32 * 33 + i * 33 + (e_)]))
            float gl[4], el[16];
#pragma unroll
            for (int e = 0; e < 4; ++e) gl[e] = RT_SUM(e) * r + brg[e];
#pragma unroll
            for (int e = 0; e < 16; ++e) el[e] = RT_SUM(4 + e) * r + bre[e];
#undef RT_SUM
            int gsel = 0; float gmax = gl[0];
#pragma unroll
            for (int e = 1; e < 4; ++e) if (gl[e] > gmax) { gmax = gl[e]; gsel = e; }
            float gden = 0.f;
#pragma unroll
            for (int e = 0; e < 4; ++e) gden += __expf(gl[e] - gmax);
            const float gw_ = 1.0f / gden;
            float wi[4];
#pragma unroll
            for (int e = 0; e < 4; ++e) wi[e] = gsel == 0 ? el[e] : (gsel == 1 ? el[4 + e] : (gsel == 2 ? el[8 + e] : el[12 + e]));
            int i0 = 0; float t0 = wi[0];
#pragma unroll
            for (int e = 1; e < 4; ++e) if (wi[e] > t0) { t0 = wi[e]; i0 = e; }
            int i1 = -1; float t1 = -3.0e38f;
#pragma unroll
            for (int e = 0; e < 4; ++e) if (e != i0 && wi[e] > t1) { t1 = wi[e]; i1 = e; }
            const float ex = __expf(t1 - t0);
            const float ew0 = gw_ / (1.0f + ex), ew1 = gw_ * ex / (1.0f + ex);
            const int lo = i0 < i1 ? i0 : i1, hi = i0 < i1 ? i1 : i0;
            const float wlo = i0 < i1 ? ew0 : ew1, whi = i0 < i1 ? ew1 : ew0;
            const int pidx = lo == 0 ? hi - 1 : (lo == 1 ? hi + 1 : 5);
            const int bucket = gsel * 6 + pidx;
            const int row = row0 + i;
            unsigned long long mymask = 0ull;
            for (int bb = 0; bb < 24; ++bb) { const unsigned long long mm = __ballot(bucket == bb); if (bucket == bb) mymask = mm; }
            const int leader = __builtin_ctzll(mymask);
            int base = 0;
            if (lane == leader) base = atomicAdd(cnt + 64 * bucket, __builtin_popcountll(mymask));
            base = __shfl(base, leader);
            const int pos = base + __builtin_popcountll(mymask & ((1ull << lane) - 1ull));
            list[(size_t)bucket * NT + pos] = row;
            route[2 * row] = wlo; route[2 * row + 1] = whi;
            rinv[row] = r;
        }
        __syncthreads();
    }
}

struct APlain { const bf16_t* base; int ld; __device__ __forceinline__ const bf16_t* operator()(int r) const { return base + (size_t)r * ld; } };
struct ACmp { const bf16_t* base; __device__ __forceinline__ const bf16_t* operator()(int r) const { return base + (size_t)(r < 126 ? r : 126) * 1024; } };
struct AGather { const bf16_t* xn; const int* list; int cnt; __device__ __forceinline__ const bf16_t* operator()(int r) const { return xn + (size_t)(r < cnt ? list[r] : 0) * ND; } };
struct BPlain { const bf16_t* base; int ld; __device__ __forceinline__ const bf16_t* operator()(int r, int k0) const { return base + (size_t)r * ld + k0; } };
struct BSplit { const bf16_t* b0; const bf16_t* b1; __device__ __forceinline__ const bf16_t* operator()(int r, int k0) const { return k0 < 512 ? b0 + (size_t)r * 512 + k0 : b1 + (size_t)r * 512 + (k0 - 512); } };

template <class AP, class BP, class APN, class BPN>
__device__ __forceinline__ void gemm_kloop(f32x4 (&acc)[4][4], const AP& ap, const BP& bp, int K, LAS unsigned char* lds, bool prefetched, bool has_next, const APN& apn, const BPN& bpn) {
    const int tid = TID(), wid = tid >> 6, lane = tid & 63, wr = wid >> 1, wc = wid & 1, fr = lane & 15, fq = lane >> 4;
#if NAIVE_GEMM
    for (int k0 = 0; k0 < K; k0 += 32) {
#pragma unroll
        for (int m = 0; m < 4; ++m) {
            const bf16_t* arow = ap(wr * 64 + m * 16 + fr) + k0;
            u32x4 av[4];
#pragma unroll
            for (int c = 0; c < 4; ++c) av[c] = ((const u32x4*)arow)[c];
#pragma unroll
            for (int n = 0; n < 4; ++n)
#pragma unroll
                for (int j = 0; j < 4; ++j) {
                    const bf16_t* brow = bp(wc * 64 + n * 16 + 4 * fq + j, k0);
                    float s = 0.f;
#pragma unroll
                    for (int c = 0; c < 4; ++c) {
                        const u32x4 bv = ((const u32x4*)brow)[c];
                        s += bflo(av[c].x) * bflo(bv.x) + bfhi(av[c].x) * bfhi(bv.x) + bflo(av[c].y) * bflo(bv.y) + bfhi(av[c].y) * bfhi(bv.y)
                           + bflo(av[c].z) * bflo(bv.z) + bfhi(av[c].z) * bfhi(bv.z) + bflo(av[c].w) * bflo(bv.w) + bfhi(av[c].w) * bfhi(bv.w);
                    }
                    acc[m][n][j] += s;
                }
        }
    }
#else
    const unsigned woff = (unsigned)wid * 1024u;
    const bf16_t* aptr[4]; int brow[4], bcol;
    {
        const int sb = lane * 16, swz = sb ^ (((sb >> 9) & 1) << 5);
        const int rl = swz >> 6, cc = (wid & 1) * 32 + ((swz & 63) >> 1);
        bcol = cc;
#pragma unroll
        for (int i = 0; i < 4; ++i) { const int R = ((wid >> 1) + 2 * i) * 16 + rl; aptr[i] = ap(R) + cc; brow[i] = R; }
    }
    int aoff[4], boff[4];
#pragma unroll
    for (int m = 0; m < 4; ++m) {
        { const int r = wr * 64 + m * 16 + fr, c = fq * 8, st = (r >> 4) * 2, ob = (r & 15) * 64 + c * 2; aoff[m] = st * 1024 + (ob ^ (((ob >> 9) & 1) << 5)); }
        { const int r = wc * 64 + m * 16 + fr, c = fq * 8, st = (r >> 4) * 2, ob = (r & 15) * 64 + c * 2; boff[m] = st * 1024 + (ob ^ (((ob >> 9) & 1) << 5)); }
    }
    const int nk = K / 64;
#define GT_STAGE(buf, t) do { const int _k0 = (t) * 64; LAS unsigned char* _ba = lds + (buf) * 32768 + woff; \
        _Pragma("unroll") for (int _i = 0; _i < 4; ++_i) { \
            __builtin_amdgcn_global_load_lds((const unsigned*)(aptr[_i] + _k0), (LAS unsigned*)(_ba + _i * 4096), 16, 0, 0); \
            __builtin_amdgcn_global_load_lds((const unsigned*)(bp(brow[_i], _k0) + bcol), (LAS unsigned*)(_ba + 16384 + _i * 4096), 16, 0, 0); } } while (0)
    if (!prefetched) GT_STAGE(0, 0);
#pragma unroll 1
    for (int t = 0; t < nk; ++t) {
        asm volatile("s_waitcnt vmcnt(0)" ::: "memory");
        __syncthreads();
        if (t + 1 < nk) GT_STAGE((t + 1) & 1, t + 1);
        else if (has_next) {
            LAS unsigned char* _ba = lds + woff;
#pragma unroll
            for (int _i = 0; _i < 4; ++_i) {
                __builtin_amdgcn_global_load_lds((const unsigned*)(apn(brow[_i]) + bcol), (LAS unsigned*)(_ba + _i * 4096), 16, 0, 0);
                __builtin_amdgcn_global_load_lds((const unsigned*)(bpn(brow[_i], 0) + bcol), (LAS unsigned*)(_ba + 16384 + _i * 4096), 16, 0, 0);
            }
        }
        LAS const unsigned char* la = lds + (t & 1) * 32768;
        LAS const unsigned char* lb = la + 16384;
        bf16x8 At[2][4], Bt[2][4];
#pragma unroll
        for (int kh = 0; kh < 2; ++kh) {
#pragma unroll
            for (int m = 0; m < 4; ++m) At[kh][m] = *(const LAS bf16x8*)(la + aoff[m] + kh * 1024);
#pragma unroll
            for (int n = 0; n < 4; ++n) Bt[kh][n] = *(const LAS bf16x8*)(lb + boff[n] + kh * 1024);
        }
#pragma unroll
        for (int kh = 0; kh < 2; ++kh)
#pragma unroll
            for (int m = 0; m < 4; ++m)
#pragma unroll
                for (int n = 0; n < 4; ++n) acc[m][n] = __builtin_amdgcn_mfma_f32_16x16x32_bf16(Bt[kh][n], At[kh][m], acc[m][n], 0, 0, 0);
    }
#undef GT_STAGE
#endif
}
__device__ __forceinline__ void zero_acc(f32x4 (&acc)[4][4]) {
#pragma unroll
    for (int m = 0; m < 4; ++m)
#pragma unroll
        for (int n = 0; n < 4; ++n) acc[m][n] = (f32x4){0.f, 0.f, 0.f, 0.f};
}
template <class AP, class BP, class EPI>
__device__ __forceinline__ void gemm_tile(const AP& ap, const BP& bp, int K, const EPI& epi, LAS unsigned char* lds, bool prefetched, bool has_next, const AP& apn, const BP& bpn) {
    const int tid = TID(), wid = tid >> 6, lane = tid & 63, wr = wid >> 1, wc = wid & 1, fr = lane & 15, fq = lane >> 4;
    f32x4 acc[4][4]; zero_acc(acc);
    gemm_kloop(acc, ap, bp, K, lds, prefetched, has_next, apn, bpn);
    epi(acc, wr, wc, fr, fq);
}

__device__ __forceinline__ float rinv_from_ssp(const float* ssp, int row) {
    const f32x4* q = (const f32x4*)(ssp + (size_t)row * 16);
    const f32x4 a = q[0], b = q[1], c = q[2], d = q[3];
    const float s = ((a.x + a.y) + (a.z + a.w)) + ((b.x + b.y) + (b.z + b.w)) + ((c.x + c.y) + (c.z + c.w)) + ((d.x + d.y) + (d.z + d.w));
    return 1.0f / sqrtf(s * (1.0f / ND) + 1e-6f);
}
__device__ __forceinline__ float row_ss64(const f32x4& a, const f32x4& b, const f32x4& c, const f32x4& d) {
    float s = ((a.x * a.x + a.y * a.y) + (a.z * a.z + a.w * a.w)) + ((b.x * b.x + b.y * b.y) + (b.z * b.z + b.w * b.w))
            + ((c.x * c.x + c.y * c.y) + (c.z * c.z + c.w * c.w)) + ((d.x * d.x + d.y * d.y) + (d.z * d.z + d.w * d.w));
    s += __shfl_xor(s, 16); s += __shfl_xor(s, 32);
    return s;
}
constexpr int EPS_OFF = 32768, EPS_RS = 272;
struct EpiInProj {
    int mt, nt; unsigned char* ws; const float* ssp; LAS unsigned char* lds;
    __device__ __forceinline__ void operator()(const f32x4 (&acc)[4][4], int wr, int wc, int fr, int fq) const {
        if (nt >= 22) {
#pragma unroll
            for (int m = 0; m < 4; ++m) {
                const int row = mt * 128 + wr * 64 + m * 16 + fr;
                const float rr = rinv_from_ssp(ssp, row);
#pragma unroll
                for (int n = 0; n < 4; ++n) {
                    const int col = wc * 64 + n * 16 + 4 * fq;
                    if (col < 24) {
                        const f32x4 v = acc[m][n] * rr;
                        f32x4 o; o.x = sigmoidf_(v.x); o.y = sigmoidf_(v.y); o.z = sigmoidf_(v.z); o.w = sigmoidf_(v.w);
                        *(f32x4*)((float*)(ws + WS_GATES) + (size_t)row * 24 + col) = o;
                    }
                }
            }
            return;
        }
        const int reg = nt >> 2;
        const float sc = (nt < 16 && (reg == 0 || reg == 3)) ? 0.125f * 1.4426950408889634f : 1.0f;
        LAS unsigned char* st = lds + EPS_OFF;
        __syncthreads();
#pragma unroll
        for (int m = 0; m < 4; ++m) {
            const int r = wr * 64 + m * 16 + fr;
            const float rs = rinv_from_ssp(ssp, mt * 128 + r) * sc;
#pragma unroll
            for (int n = 0; n < 4; ++n) {
                const f32x4 v = acc[m][n] * rs;
                u32x2 w; w.x = pk2(v.x, v.y); w.y = pk2(v.z, v.w);
                *(LAS u32x2*)(st + r * EPS_RS + (wc * 64 + n * 16 + 4 * fq) * 2) = w;
            }
        }
        __syncthreads();
        const int tid = (wr * 2 + wc) * 64 + fq * 16 + fr;
#pragma unroll
        for (int i = 0; i < 8; ++i) {
            const int q = tid + 256 * i, r = q >> 4, ch = q & 15, col = ch * 8;
            const u32x4 v = *(const LAS u32x4*)(st + r * EPS_RS + ch * 16);
            const int row = mt * 128 + r, b = row >> 11, s = row & 2047;
            bf16_t* dst;
            if (nt < 16) { const int c = (nt & 3) * 128 + col, head = c >> 6, d = c & 63; dst = (bf16_t*)(ws + WS_QA + (size_t)reg * 16 * MiB) + ((size_t)((b * 8 + head) * NS + s) * 64 + d); }
            else { const int g = col >> 6, d = col & 63; dst = (bf16_t*)(ws + WS_KV6 + (size_t)(nt - 16) * 4 * MiB) + ((size_t)((b * 2 + g) * NS + s) * 64 + d); }
            *(u32x4*)dst = v;
        }
    }
};
struct EpiCmp1 {
    bf16_t* hc; const float* bc1; int row0, col0;
    __device__ __forceinline__ void operator()(const f32x4 (&acc)[4][4], int wr, int wc, int fr, int fq) const {
#pragma unroll
        for (int m = 0; m < 4; ++m) {
            const int row = row0 + wr * 64 + m * 16 + fr;
#pragma unroll
            for (int n = 0; n < 4; ++n) {
                const int col = col0 + wc * 64 + n * 16 + 4 * fq;
                f32x4 bb = *(const f32x4*)(bc1 + col);
#pragma unroll
                for (int pp = 1; pp < 16; ++pp) bb += *(const f32x4*)(bc1 + pp * 1024 + col);
                const f32x4 v = acc[m][n];
                u32x2 w; w.x = pk2(gelu_tanh(v.x + bb.x), gelu_tanh(v.y + bb.y)); w.y = pk2(gelu_tanh(v.z + bb.z), gelu_tanh(v.w + bb.w));
                *(u32x2*)(hc + (size_t)row * 256 + col) = w;
            }
        }
    }
};
struct EpiCmp2 {
    bf16_t* dst; int row0;
    __device__ __forceinline__ void operator()(const f32x4 (&acc)[4][4], int wr, int wc, int fr, int fq) const {
        if (wc != 0) return;
#pragma unroll
        for (int m = 0; m < 4; ++m) {
            const int row = row0 + wr * 64 + m * 16 + fr;
#pragma unroll
            for (int n = 0; n < 4; ++n) {
                const int col = n * 16 + 4 * fq;
                const f32x4 v = acc[m][n];
                u32x2 w; w.x = pk2(v.x, v.y); w.y = pk2(v.z, v.w);
                *(u32x2*)(dst + (size_t)row * 64 + col) = w;
            }
        }
    }
};
struct EpiResAdd {
    bf16_t* res; int row0, col0;
    __device__ __forceinline__ void operator()(const f32x4 (&acc)[4][4], int wr, int wc, int fr, int fq) const {
#pragma unroll
        for (int m = 0; m < 4; ++m) {
            const int row = row0 + wr * 64 + m * 16 + fr;
#pragma unroll
            for (int n = 0; n < 4; ++n) {
                const int col = col0 + wc * 64 + n * 16 + 4 * fq;
                u32x2* pp = (u32x2*)(res + (size_t)row * ND + col);
                const u32x2 b = *pp; const f32x4 a = acc[m][n];
                u32x2 w; w.x = pk2(bflo(b.x) + a.x, bfhi(b.x) + a.y); w.y = pk2(bflo(b.y) + a.z, bfhi(b.y) + a.w);
                *pp = w;
            }
        }
    }
};
struct EpiMoeGU {
    bf16_t* hid; const int* list; const float* route; const float* rinv; int cnt, hrow0, nt16;
    __device__ __forceinline__ void operator()(const f32x4 (&acc)[4][4], int wr, int wc, int fr, int fq) const {
        const int half = nt16 >> 3, nte = nt16 & 7;
#pragma unroll
        for (int m = 0; m < 4; ++m) {
            const int r = wr * 64 + m * 16 + fr;
            const int tok = r < cnt ? list[r] : 0;
            const float w = r < cnt ? route[2 * tok + half] : 0.f;
            const float rt = rinv[tok];
#pragma unroll
            for (int pr = 0; pr < 2; ++pr) {
                const f32x4 gv = acc[m][2 * pr], uv = acc[m][2 * pr + 1];
                const int hc = half * 512 + (4 * nte + 2 * wc + pr) * 16 + 4 * fq;
                float h[4];
#pragma unroll
                for (int j = 0; j < 4; ++j) { const float gg = gv[j] * rt; h[j] = gg / (1.0f + __expf(-gg)) * (uv[j] * rt) * w; }
                u32x2 o; o.x = pk2(h[0], h[1]); o.y = pk2(h[2], h[3]);
                *(u32x2*)(hid + (size_t)(hrow0 + r) * 1024 + hc) = o;
            }
        }
    }
};
struct EpiMoeDown {
    bf16_t* res; const int* list; float* ssp; int cnt, col0;
    __device__ __forceinline__ void operator()(const f32x4 (&acc)[4][4], int wr, int wc, int fr, int fq) const {
#pragma unroll
        for (int m = 0; m < 4; ++m) {
            const int r = wr * 64 + m * 16 + fr;
            const bool ok = r < cnt;
            const int tok = ok ? list[r] : 0;
            f32x4 nv[4];
#pragma unroll
            for (int n = 0; n < 4; ++n) {
                const int col = col0 + wc * 64 + n * 16 + 4 * fq;
                u32x2* pp = (u32x2*)(res + (size_t)tok * ND + col);
                const u32x2 b = *pp; const f32x4 a = acc[m][n];
                nv[n] = (f32x4){bflo(b.x) + a.x, bfhi(b.x) + a.y, bflo(b.y) + a.z, bfhi(b.y) + a.w};
                if (ok) { u32x2 w; w.x = pk2(nv[n].x, nv[n].y); w.y = pk2(nv[n].z, nv[n].w); *pp = w; }
            }
            const float ps = row_ss64(nv[0], nv[1], nv[2], nv[3]);
            if (ok && fq == 0) ssp[(size_t)tok * 16 + (col0 >> 6) + wc] = ps;
        }
    }
};
struct EpiBf16 {
    bf16_t* dst; int ld, row0, col0;
    __device__ __forceinline__ void operator()(const f32x4 (&acc)[4][4], int wr, int wc, int fr, int fq) const {
#pragma unroll
        for (int m = 0; m < 4; ++m) {
            const int row = row0 + wr * 64 + m * 16 + fr;
#pragma unroll
            for (int n = 0; n < 4; ++n) {
                const int col = col0 + wc * 64 + n * 16 + 4 * fq;
                const f32x4 v = acc[m][n];
                u32x2 w; w.x = pk2(v.x, v.y); w.y = pk2(v.z, v.w);
                *(u32x2*)(dst + (size_t)row * ld + col) = w;
            }
        }
    }
};
struct EpiPleFused {
    const bf16_t* rin; const float* ssp_in; bf16_t* rout; float* ssp_out; int row0, col0;
    __device__ __forceinline__ void operator()(const f32x4 (&acc)[4][4], const f32x4 (&acc2)[4][4], int wr, int wc, int fr, int fq) const {
#pragma unroll
        for (int m = 0; m < 4; ++m) {
            const int row = row0 + wr * 64 + m * 16 + fr;
            const float rr = rinv_from_ssp(ssp_in, row);
            f32x4 nv[4];
#pragma unroll
            for (int n = 0; n < 4; ++n) {
                const int col = col0 + wc * 64 + n * 16 + 4 * fq;
                const size_t off = (size_t)row * ND + col;
                const f32x4 v = acc[m][n] * rr, q = acc2[m][n];
                const u32x2 b = *(const u32x2*)(rin + off);
                f32x4 o = (f32x4){bflo(b.x), bfhi(b.x), bflo(b.y), bfhi(b.y)};
                o.x += sigmoidf_(v.x) * q.x; o.y += sigmoidf_(v.y) * q.y; o.z += sigmoidf_(v.z) * q.z; o.w += sigmoidf_(v.w) * q.w;
                u32x2 w; w.x = pk2(o.x, o.y); w.y = pk2(o.z, o.w);
                *(u32x2*)(rout + off) = w;
                nv[n] = o;
            }
            const float ps = row_ss64(nv[0], nv[1], nv[2], nv[3]);
            if (fq == 0) ssp_out[(size_t)row * 16 + (col0 >> 6) + wc] = ps;
        }
    }
};
struct EpiPleGate {
    float* out; const bf16_t* p2; int row0, col0; float sc;
    __device__ __forceinline__ void operator()(const f32x4 (&acc)[4][4], int wr, int wc, int fr, int fq) const {
#pragma unroll
        for (int m = 0; m < 4; ++m) {
            const int row = row0 + wr * 64 + m * 16 + fr;
#pragma unroll
            for (int n = 0; n < 4; ++n) {
                const int col = col0 + wc * 64 + n * 16 + 4 * fq;
                const size_t off = (size_t)row * ND + col;
                const u32x2 pv = *(const u32x2*)(p2 + off);
                const f32x4 v = acc[m][n];
                f32x4 o = *(const f32x4*)(out + off);
                o.x += sc * sigmoidf_(v.x) * bflo(pv.x); o.y += sc * sigmoidf_(v.y) * bfhi(pv.x); o.z += sc * sigmoidf_(v.z) * bflo(pv.y); o.w += sc * sigmoidf_(v.w) * bfhi(pv.y);
                *(f32x4*)(out + off) = o;
            }
        }
    }
};

template <class PH, class AP, class BP, class EPI>
__device__ __forceinline__ void gemm_stream(const PH& ph, int first, int step, int count, int K, LAS unsigned char* lds) {
    int q = first;
    if (q >= count) return;
    AP ap, apn; BP bp, bpn; EPI ep, epn;
    ph.make(q, ap, bp, ep);
    bool pref = false;
    for (;;) {
        const int qn = q + step; const bool hn = qn < count;
        if (hn) ph.make(qn, apn, bpn, epn); else { apn = ap; bpn = bp; epn = ep; }
        gemm_tile(ap, bp, K, ep, lds, pref, hn, apn, bpn);
        if (!hn) break;
        ap = apn; bp = bpn; ep = epn; q = qn; pref = true;
    }
}

__device__ __forceinline__ void load_q32(const bf16_t* p, float* q) {
#pragma unroll
    for (int c = 0; c < 4; ++c) {
        const u32x4 v = ((const u32x4*)p)[c];
        q[8 * c] = bflo(v.x); q[8 * c + 1] = bfhi(v.x); q[8 * c + 2] = bflo(v.y); q[8 * c + 3] = bfhi(v.y);
        q[8 * c + 4] = bflo(v.z); q[8 * c + 5] = bfhi(v.z); q[8 * c + 6] = bflo(v.w); q[8 * c + 7] = bfhi(v.w);
    }
}
__device__ __forceinline__ float dot32p(const float* q, const bf16_t* k) {
    float s0 = 0.f, s1 = 0.f;
#pragma unroll
    for (int c = 0; c < 4; ++c) {
        const u32x4 v = ((const u32x4*)k)[c];
        s0 += q[8 * c] * bflo(v.x); s1 += q[8 * c + 1] * bfhi(v.x); s0 += q[8 * c + 2] * bflo(v.y); s1 += q[8 * c + 3] * bfhi(v.y);
        s0 += q[8 * c + 4] * bflo(v.z); s1 += q[8 * c + 5] * bfhi(v.z); s0 += q[8 * c + 6] * bflo(v.w); s1 += q[8 * c + 7] * bfhi(v.w);
    }
    const float s = s0 + s1;
    return s + __shfl_xor(s, 1);
}
__device__ __forceinline__ void axpy32(float* a, float p, const bf16_t* vr) {
#pragma unroll
    for (int c = 0; c < 4; ++c) {
        const u32x4 v = ((const u32x4*)vr)[c];
        a[8 * c] += p * bflo(v.x); a[8 * c + 1] += p * bfhi(v.x); a[8 * c + 2] += p * bflo(v.y); a[8 * c + 3] += p * bfhi(v.y);
        a[8 * c + 4] += p * bflo(v.z); a[8 * c + 5] += p * bfhi(v.z); a[8 * c + 6] += p * bflo(v.w); a[8 * c + 7] += p * bfhi(v.w);
    }
}
#define ONLINE_STEP(s_, vrow_) do { const float _s = (s_); if (_s > mx) { const float _c = __expf(mx - _s); l *= _c; _Pragma("unroll") for (int _i = 0; _i < 32; ++_i) acc[_i] *= _c; mx = _s; } \
    const float _p = __expf(_s - mx); l += _p; axpy32(acc, _p, (vrow_)); } while (0)

__device__ __forceinline__ void store_o32(bf16_t* dst, const float* a, float sc) {
#pragma unroll
    for (int c = 0; c < 4; ++c) {
        u32x4 w; w.x = pk2(a[8 * c] * sc, a[8 * c + 1] * sc); w.y = pk2(a[8 * c + 2] * sc, a[8 * c + 3] * sc);
        w.z = pk2(a[8 * c + 4] * sc, a[8 * c + 5] * sc); w.w = pk2(a[8 * c + 6] * sc, a[8 * c + 7] * sc);
        ((u32x4*)dst)[c] = w;
    }
}

__device__ __forceinline__ void attn_dilated_naive(const unsigned char* ws, int gtid, int gthreads) {
    asm volatile("" : "+v"(gtid));
    const bf16_t* qa = (const bf16_t*)(ws + WS_QA); const bf16_t* ka = (const bf16_t*)(ws + WS_KA); const bf16_t* va = (const bf16_t*)(ws + WS_VA);
    bf16_t* ob = (bf16_t*)(ws + WS_O);
    for (int id2 = gtid; id2 < NB * 8 * NS * 2; id2 += gthreads) {
        const int idx = id2 >> 1, hf = (id2 & 1) * 32;
        const int t = idx & 2047, bh = idx >> 11, h = bh & 7, b = bh >> 3;
        float q[32]; load_q32(qa + (size_t)idx * 64 + hf, q);
        const bf16_t* kb = ka + (size_t)bh * NS * 64 + hf; const bf16_t* vb = va + (size_t)bh * NS * 64 + hf;
        const float slope = exp2f(-((float)h + 0.5f));
        float mx = -1e30f, l = 0.f; float acc[32];
#pragma unroll
        for (int i = 0; i < 32; ++i) acc[i] = 0.f;
#pragma unroll 1
        for (int pat = 0; pat < 3; ++pat) {
            const int dil = pat == 0 ? 1 : (pat == 1 ? 4 : 16);
#pragma unroll 1
            for (int j = 0; j <= 128; ++j) {
                const int dist = j * dil, pos = t - dist;
                if (pos < 0) break;
                const float s = dot32p(q, kb + (size_t)pos * 64) - slope * (float)dist;
                ONLINE_STEP(s, vb + (size_t)pos * 64);
            }
        }
        store_o32(ob + ((size_t)(b * NS + t) * ND + h * 64 + hf), acc, 1.0f / l);
    }
}

__device__ __forceinline__ void nsa_imp_naive(const unsigned char* ws, int gtid, int gthreads) {
    asm volatile("" : "+v"(gtid));
    const bf16_t* qb = (const bf16_t*)(ws + WS_QB); const bf16_t* kcmp = (const bf16_t*)(ws + WS_KCMP);
    float* imph = (float*)(ws + WS_IMPH);
    for (int id2 = gtid; id2 < NB * 8 * NS * 2; id2 += gthreads) {
        const int idx = id2 >> 1, hf = (id2 & 1) * 32;
        const int t = idx & 2047, bh = idx >> 11, hb = bh & 7, b = bh >> 3, g = hb >> 2;
        float q[32]; load_q32(qb + (size_t)idx * 64 + hf, q);
        const bf16_t* kc = kcmp + (size_t)(b * 2 + g) * 128 * 64 + hf;
        const float slope = exp2f(-(float)(hb + 1));
        const int ncv = t >= 31 ? ((t - 31) >> 4) + 1 : 0;
        float mx = -1e30f;
#pragma unroll 1
        for (int c = 0; c < ncv; ++c) { const float s = dot32p(q, kc + c * 64) - slope * (float)(t - (16 * c + 31)); mx = fmaxf(mx, s); }
        float den = 0.f;
#pragma unroll 1
        for (int c = 0; c < ncv; ++c) { const float s = dot32p(q, kc + c * 64) - slope * (float)(t - (16 * c + 31)); den += __expf(s - mx); }
        const float inv = ncv > 0 ? 1.0f / den : 0.f;
#pragma unroll 1
        for (int n = 0; n < 32; ++n) {
            float imp = 0.f;
#pragma unroll 1
            for (int j = -1; j <= 3; ++j) {
                const int c = 4 * n + j;
                if (c >= 0 && c < ncv) {
                    const float s = dot32p(q, kc + c * 64) - slope * (float)(t - (16 * c + 31));
                    const float pp = __expf(s - mx) * inv;
                    imp += (j == -1 || j == 3) ? 0.5f * pp : pp;
                }
            }
            if (hf == 0) imph[(size_t)idx * 32 + n] = imp;
        }
    }
}
__device__ __forceinline__ void nsa_select(const unsigned char* ws, unsigned* maskbuf) {
    const float* imph = (const float*)(ws + WS_IMPH);
    const int tid_ = TID(); const int lane = tid_ & 63, gw = BID() * 4 + (tid_ >> 6), ngw = gridDim.x * 4;
    for (int it = gw; it < NB * 2 * NS / 2; it += ngw) {
        const int item = it * 2 + (lane >> 5), t = item & 2047, bg = item >> 11, n = lane & 31;
        float imp = 0.f;
#pragma unroll
        for (int r = 0; r < 4; ++r) imp += imph[((size_t)(bg * 4 + r) * NS + t) * 32 + n];
        const int cur = t >> 6;
        const bool valid = n <= cur;
        const bool forced = (n == 0) || (cur - n < 2);
        const float score = valid ? imp + (forced ? 1e4f : 0.f) : -1e30f;
        int rank = 0;
        for (int m = 0; m < 32; ++m) {
            const float sm = __shfl(score, (lane & 32) | m);
            rank += (sm > score || (sm == score && m < n)) ? 1 : 0;
        }
        const bool sel = valid && rank < 16;
        const unsigned long long bal = __ballot(sel);
        if (n == 0) maskbuf[item] = (lane >> 5) ? (unsigned)(bal >> 32) : (unsigned)bal;
    }
}
__device__ __forceinline__ void nsa_attn_naive(const unsigned char* ws, int gtid, int gthreads) {
    asm volatile("" : "+v"(gtid));
    const bf16_t* qb = (const bf16_t*)(ws + WS_QB);
    const bf16_t* kcmp = (const bf16_t*)(ws + WS_KCMP); const bf16_t* vcmp = kcmp + (size_t)16 * 128 * 64;
    const bf16_t* ksb = (const bf16_t*)(ws + WS_KV6 + 2 * 4 * MiB); const bf16_t* vsb = (const bf16_t*)(ws + WS_KV6 + 3 * 4 * MiB);
    const bf16_t* kwb = (const bf16_t*)(ws + WS_KV6 + 4 * 4 * MiB); const bf16_t* vwb = (const bf16_t*)(ws + WS_KV6 + 5 * 4 * MiB);
    const float* gates = (const float*)(ws + WS_GATES);
    const unsigned* maskbuf = (const unsigned*)(ws + WS_MASK);
    bf16_t* ob = (bf16_t*)(ws + WS_O);
    for (int id2 = gtid; id2 < NB * 8 * NS * 2; id2 += gthreads) {
        const int idx = id2 >> 1, hf = (id2 & 1) * 32;
        const int t = idx & 2047, bh = idx >> 11, hb = bh & 7, b = bh >> 3, g = hb >> 2, bg = b * 2 + g;
        float q[32]; load_q32(qb + (size_t)idx * 64 + hf, q);
        const float slope = exp2f(-(float)(hb + 1));
        const float* gt = gates + (size_t)(b * NS + t) * 24 + hb * 3;
        float tot[32], acc[32];
#pragma unroll
        for (int i = 0; i < 32; ++i) tot[i] = 0.f;
        {
            const bf16_t* kc = kcmp + (size_t)bg * 128 * 64 + hf; const bf16_t* vc = vcmp + (size_t)bg * 128 * 64 + hf;
            const int ncv = t >= 31 ? ((t - 31) >> 4) + 1 : 0;
            if (ncv > 0) {
                float mx = -1e30f, l = 0.f;
#pragma unroll
                for (int i = 0; i < 32; ++i) acc[i] = 0.f;
#pragma unroll 1
                for (int c = 0; c < ncv; ++c) { const float s = dot32p(q, kc + c * 64) - slope * (float)(t - (16 * c + 31)); ONLINE_STEP(s, vc + c * 64); }
                const float sc = gt[0] / l;
#pragma unroll
                for (int i = 0; i < 32; ++i) tot[i] += sc * acc[i];
            }
        }
        {
            const bf16_t* kb = ksb + (size_t)bg * NS * 64 + hf; const bf16_t* vb = vsb + (size_t)bg * NS * 64 + hf;
            const unsigned mask = maskbuf[bg * NS + t];
            float mx = -1e30f, l = 0.f;
#pragma unroll
            for (int i = 0; i < 32; ++i) acc[i] = 0.f;
#pragma unroll 1
            for (int n = 0; n < 32; ++n) {
                if (!((mask >> n) & 1u)) continue;
#pragma unroll 1
                for (int i = 0; i < 64; ++i) {
                    const int pos = n * 64 + i;
                    if (pos > t) break;
                    const float s = dot32p(q, kb + (size_t)pos * 64) - slope * (float)(t - pos);
                    ONLINE_STEP(s, vb + (size_t)pos * 64);
                }
            }
            const float sc = gt[1] / l;
#pragma unroll
            for (int i = 0; i < 32; ++i) tot[i] += sc * acc[i];
        }
        {
            const bf16_t* kb = kwb + (size_t)bg * NS * 64 + hf; const bf16_t* vb = vwb + (size_t)bg * NS * 64 + hf;
            float mx = -1e30f, l = 0.f;
#pragma unroll
            for (int i = 0; i < 32; ++i) acc[i] = 0.f;
#pragma unroll 1
            for (int dist = 0; dist < 512; ++dist) {
                const int pos = t - dist;
                if (pos < 0) break;
                const float s = dot32p(q, kb + (size_t)pos * 64) - slope * (float)dist;
                ONLINE_STEP(s, vb + (size_t)pos * 64);
            }
            const float sc = gt[2] / l;
#pragma unroll
            for (int i = 0; i < 32; ++i) tot[i] += sc * acc[i];
        }
        store_o32(ob + ((size_t)(b * NS + t) * ND + 512 + hb * 64 + hf), tot, 1.0f);
    }
}

constexpr int KVS = 144;
constexpr int KVT = 64 * KVS;
constexpr int VS = 128;
constexpr int VT = 64 * VS;
#define LOG2E_F 1.4426950408889634f
__device__ __forceinline__ unsigned cvtpk(float lo, float hi) { f32x2_t v = {lo, hi}; bf16x2_t b = __builtin_convertvector(v, bf16x2_t); return __builtin_bit_cast(unsigned, b); }
__device__ __forceinline__ s16x4 vtr(LAS const unsigned char* p) { return __builtin_bit_cast(s16x4, __builtin_amdgcn_ds_read_tr16_b64_v4i16((LAS s16x4*)p)); }
__device__ __forceinline__ f32x16 zero16() { f32x16 z;
#pragma unroll
    for (int i = 0; i < 16; ++i) z[i] = 0.f;
    return z; }

__device__ __forceinline__ void load_kv_tile(LAS unsigned char* Kt, LAS unsigned char* Vt, const bf16_t* kbase, const bf16_t* vbase, int row0, int rstride, int rmin, int rmax, int tid) {
    const int j = tid >> 2, ch = tid & 3;
    int tok = row0 + j * rstride; tok = tok < rmin ? rmin : (tok > rmax ? rmax : tok);
    const u32x4* kp = (const u32x4*)(kbase + (size_t)tok * 64);
    const u32x4* vp = (const u32x4*)(vbase + (size_t)tok * 64);
    const u32x4 k0 = kp[ch], k1 = kp[ch + 4], v0 = vp[ch], v1 = vp[ch + 4];
    *(LAS u32x4*)(Kt + j * KVS + ch * 16) = k0; *(LAS u32x4*)(Kt + j * KVS + (ch + 4) * 16) = k1;
    { const int sx = 2 * (j & 3); *(LAS u32x4*)(Vt + j * VS + ((ch ^ sx) * 16)) = v0; *(LAS u32x4*)(Vt + j * VS + (((ch + 4) ^ sx) * 16)) = v1; }
}

struct KVRegs { u32x4 k0, k1, v0, v1; };
__device__ __forceinline__ void kv_fetch(KVRegs& r, const bf16_t* kbase, const bf16_t* vbase, int row0, int rstride, int rmin, int rmax, int tid) {
    const int j = tid >> 2, ch = tid & 3;
    int tok = row0 + j * rstride; tok = tok < rmin ? rmin : (tok > rmax ? rmax : tok);
    const u32x4* kp = (const u32x4*)(kbase + (size_t)tok * 64);
    const u32x4* vp = (const u32x4*)(vbase + (size_t)tok * 64);
    r.k0 = kp[ch]; r.k1 = kp[ch + 4]; r.v0 = vp[ch]; r.v1 = vp[ch + 4];
}
__device__ __forceinline__ void kv_commit(const KVRegs& r, LAS unsigned char* Kt, LAS unsigned char* Vt, int tid) {
    const int j = tid >> 2, ch = tid & 3;
    *(LAS u32x4*)(Kt + j * KVS + ch * 16) = r.k0; *(LAS u32x4*)(Kt + j * KVS + (ch + 4) * 16) = r.k1;
    { const int sx = 2 * (j & 3); *(LAS u32x4*)(Vt + j * VS + ((ch ^ sx) * 16)) = r.v0; *(LAS u32x4*)(Vt + j * VS + (((ch + 4) ^ sx) * 16)) = r.v1; }
}
__device__ __forceinline__ void pv32(f32x16& o0, f32x16& o1, const f32x16& sv, LAS const unsigned char* vp0, LAS const unsigned char* vp1  ) {
#pragma unroll
    for (int s16 = 0; s16 < 2; ++s16) {
        u32x4 pw;
        pw.x = cvtpk(sv[8 * s16 + 0], sv[8 * s16 + 1]); pw.y = cvtpk(sv[8 * s16 + 2], sv[8 * s16 + 3]);
        pw.z = cvtpk(sv[8 * s16 + 4], sv[8 * s16 + 5]); pw.w = cvtpk(sv[8 * s16 + 6], sv[8 * s16 + 7]);
        const bf16x8 pf = __builtin_bit_cast(bf16x8, pw);
        const s16x4 a0 = vtr(vp0 + s16 * 16 * VS), b0 = vtr(vp0 + s16 * 16 * VS + 8 * VS), a1 = vtr(vp1 + s16 * 16 * VS), b1 = vtr(vp1 + s16 * 16 * VS + 8 * VS);
        const bf16x8 vf0 = {a0[0], a0[1], a0[2], a0[3], b0[0], b0[1], b0[2], b0[3]};
        const bf16x8 vf1 = {a1[0], a1[1], a1[2], a1[3], b1[0], b1[1], b1[2], b1[3]};
        o0 = __builtin_amdgcn_mfma_f32_32x32x16_bf16(vf0, pf, o0, 0, 0, 0);
        o1 = __builtin_amdgcn_mfma_f32_32x32x16_bf16(vf1, pf, o1, 0, 0, 0);
    }
}
__device__ __forceinline__ f32x16 qk32(const bf16x8* qf, LAS const unsigned char* kp  , f32x16 s  ) {
#pragma unroll
    for (int k = 0; k < 4; ++k) {
        const bf16x8 kf = *(const LAS bf16x8*)(kp + 32 * k);
        s = __builtin_amdgcn_mfma_f32_32x32x16_bf16(kf, qf[k], s, 0, 0, 0);
    }
    return s;
}
__device__ __forceinline__ float vmax3(float a, float b, float c) { float d; asm("v_max3_f32 %0, %1, %2, %3" : "=v"(d) : "v"(a), "v"(b), "v"(c)); return d; }
__device__ __forceinline__ float vsub(float a, float b) { float d; asm("v_sub_f32 %0, %1, %2" : "=v"(d) : "v"(a), "v"(b)); return d; }
__device__ __forceinline__ float vadd(float a, float b) { float d; asm("v_add_f32 %0, %1, %2" : "=v"(d) : "v"(a), "v"(b)); return d; }
__device__ __forceinline__ float vmul(float a, float b) { float d; asm("v_mul_f32 %0, %1, %2" : "=v"(d) : "v"(a), "v"(b)); return d; }
struct FaState { float mref, l; int started; };
template <bool TRY_FULL>
__device__ __forceinline__ void fa_tile64(f32x16& o0, f32x16& o1, FaState& st, const bf16x8* qf, LAS const unsigned char* Kt, LAS const unsigned char* Vt, int lane, float dA, float wmax, float ns2, bool lane_on = true) {
    const int r = lane & 31, h = lane >> 5;
    LAS const unsigned char* kp = Kt + r * KVS + 16 * h;
    const float dAh = dA - (float)(4 * h);
    const float hi = dAh, lo = dAh - wmax;
    const float n8 = 8.f * ns2, n32 = 32.f * ns2;
    f32x16 s0, s1;
    s0[0] = lane_on ? fmaf(ns2, dAh, -st.mref) : -1e30f;
#pragma unroll
    for (int u = 0; u < 4; ++u) {
        if (u) s0[4 * u] = vsub(s0[4 * u - 4], n8);
#pragma unroll
        for (int k = 1; k < 4; ++k) s0[4 * u + k] = vsub(s0[4 * u + k - 1], ns2);
    }
#pragma unroll
    for (int i = 0; i < 16; ++i) s1[i] = vsub(s0[i], n32);
    if (!(TRY_FULL && __all(lo <= 0.f && hi >= 59.f))) {
#pragma unroll
        for (int i = 0; i < 16; ++i) {
            const float c0 = (float)((i & 3) + 8 * (i >> 2)), c1 = c0 + 32.f;
            s0[i] = (c0 >= lo && c0 <= hi) ? s0[i] : -1e30f;
            s1[i] = (c1 >= lo && c1 <= hi) ? s1[i] : -1e30f;
        }
    }
    s0 = qk32(qf, kp, s0); s1 = qk32(qf, kp + 32 * KVS, s1);
    asm volatile("s_nop 15" : "+v"(s0), "+v"(s1));
    float tmax;
    {
        const float a0 = vmax3(s0[0], s0[1], s0[2]), a1 = vmax3(s0[3], s0[4], s0[5]), a2 = vmax3(s0[6], s0[7], s0[8]), a3 = vmax3(s0[9], s0[10], s0[11]), a4 = vmax3(s0[12], s0[13], s0[14]);
        const float a5 = vmax3(s0[15], s1[0], s1[1]), a6 = vmax3(s1[2], s1[3], s1[4]), a7 = vmax3(s1[5], s1[6], s1[7]), a8 = vmax3(s1[8], s1[9], s1[10]), a9 = vmax3(s1[11], s1[12], s1[13]);
        const float b0 = vmax3(a0, a1, a2), b1 = vmax3(a3, a4, a5), b2 = vmax3(a6, a7, a8), b3 = vmax3(a9, s1[14], s1[15]);
        tmax = vmax3(b0, b1, b2);
        tmax = vmax3(tmax, b3, b3);
    }
    { const float ot = __shfl_xor(tmax, 32); tmax = vmax3(tmax, ot, ot); }
    const bool valid = tmax > -1e29f;
    const bool need = valid & ((tmax > 8.f) | (st.started == 0));
    if (__any(need)) {
        const float delta = need ? tmax : 0.f;
        const float corr = need ? __builtin_amdgcn_exp2f(-delta) : 1.0f;
        st.mref += delta; st.l *= corr;
        if (__any(st.started)) {
#pragma unroll
            for (int i = 0; i < 16; ++i) { o0[i] = vmul(o0[i], corr); o1[i] = vmul(o1[i], corr); }
        }
#pragma unroll
        for (int i = 0; i < 16; ++i) { s0[i] = vsub(s0[i], delta); s1[i] = vsub(s1[i], delta); }
        st.started |= valid ? 1 : 0;
    }
#pragma unroll
    for (int i = 0; i < 16; ++i) { s0[i] = __builtin_amdgcn_exp2f(s0[i]); s1[i] = __builtin_amdgcn_exp2f(s1[i]); }
    {
        float ps0 = 0.f, ps1 = 0.f;
#pragma unroll
        for (int i = 0; i < 16; ++i) { ps0 += s0[i]; ps1 += s1[i]; }
        st.l += ps0 + ps1;
    }
    const int vq = (lane & 15) >> 2, vc0 = 2 * ((lane >> 4) & 1) + ((lane & 3) >> 1), vsx = 2 * vq;
    LAS const unsigned char* vp0 = Vt + (4 * h + vq) * VS + ((vc0 ^ vsx) * 16) + 8 * (lane & 1);
    LAS const unsigned char* vp1 = Vt + (4 * h + vq) * VS + (((vc0 + 4) ^ vsx) * 16) + 8 * (lane & 1);
    pv32(o0, o1, s0, vp0, vp1);
    pv32(o0, o1, s1, vp0 + 32 * VS, vp1 + 32 * VS);
}
__device__ __forceinline__ void acc_scaled(f32x16& t0, f32x16& t1, const f32x16& o0, const f32x16& o1, float sc) {
#pragma unroll
    for (int i = 0; i < 16; ++i) { t0[i] += sc * o0[i]; t1[i] += sc * o1[i]; }
}
__device__ __forceinline__ void store_ot(bf16_t* orow, const f32x16& o0, const f32x16& o1, float sc, int h) {
#pragma unroll
    for (int u = 0; u < 4; ++u) {
        u32x2 w0, w1;
        w0.x = cvtpk(o0[4 * u] * sc, o0[4 * u + 1] * sc); w0.y = cvtpk(o0[4 * u + 2] * sc, o0[4 * u + 3] * sc);
        w1.x = cvtpk(o1[4 * u] * sc, o1[4 * u + 1] * sc); w1.y = cvtpk(o1[4 * u + 2] * sc, o1[4 * u + 3] * sc);
        *(u32x2*)(orow + 8 * u + 4 * h) = w0;
        *(u32x2*)(orow + 32 + 8 * u + 4 * h) = w1;
    }
}
__device__ __forceinline__ void load_qf(bf16x8* qf, const bf16_t* qrow, int h) {
#pragma unroll
    for (int k = 0; k < 4; ++k) qf[k] = *(const bf16x8*)(qrow + 16 * k + 8 * h);
}

__device__ __forceinline__ void dil_item(unsigned char* ws, int item, LAS unsigned char* lds) {
    const int tid = TID(), lane = tid & 63, w = tid >> 6, c = lane & 31, h = lane >> 5;
    const int bh = item / 48, rem = item % 48, pat = rem >> 4, idx = rem & 15;
    const int dil = pat == 0 ? 1 : (pat == 1 ? 4 : 16), nqt = 16 / dil, res = idx / nqt, qt = idx % nqt;
    const int hd = bh & 7, b = bh >> 3;
    const int q0 = qt * 128 + 32 * w, iq = q0 + c, t = res + iq * dil;
    const bf16_t* qa = (const bf16_t*)(ws + WS_QA) + (size_t)bh * NS * 64;
    const bf16_t* ka = (const bf16_t*)(ws + WS_KA) + (size_t)bh * NS * 64;
    const bf16_t* va = (const bf16_t*)(ws + WS_VA) + (size_t)bh * NS * 64;
    bf16x8 qf[4]; load_qf(qf, qa + (size_t)t * 64, h);
    const float ns2 = -exp2f(-((float)hd + 0.5f)) * (float)dil * LOG2E_F;
    f32x16 o0 = zero16(), o1 = zero16(); FaState st = {0.f, 0.f, 0};
    {
        const int T0 = qt == 0 ? 2 : 0;
        KVRegs kr; kv_fetch(kr, ka, va, res + (qt * 128 - 128 + 64 * 3) * dil, dil, 0, NS - 1, tid);
        int buf = 0;
        for (int T = 3; T >= T0; --T) {
            const int kb = qt * 128 - 128 + 64 * T;
            LAS unsigned char* Kt = lds + buf * KVT; LAS unsigned char* Vt = lds + 2 * KVT + buf * VT;
            kv_commit(kr, Kt, Vt, tid);
            __syncthreads();
            if (T > T0) kv_fetch(kr, ka, va, res + (kb - 64) * dil, dil, 0, NS - 1, tid);
            if (kb <= q0 + 31 && kb + 63 >= q0 - 128)
                fa_tile64<true>(o0, o1, st, qf, Kt, Vt, lane, (float)(iq - kb), 128.f, ns2);
            buf ^= 1;
        }
    }
    const float lt = st.l + __shfl_xor(st.l, 32);
    bf16_t* op = (bf16_t*)(pat < 2 ? ws + WS_OPA01 + (size_t)pat * 16 * MiB : ws + WS_OPA2);
    store_ot(op + ((size_t)(b * NS + t) * 512 + hd * 64), o0, o1, 1.0f / lt, h);
    if (h == 0) { float* sp = (float*)(ws + WS_STA) + ((size_t)pat * NB * 8 * NS + (size_t)bh * NS + t) * 2; sp[0] = st.started ? st.mref : -1e30f; sp[1] = lt; }
}
__device__ __forceinline__ void dil_merge(unsigned char* ws, int gtid, int gthreads) {
    asm volatile("" : "+v"(gtid));
    const float* sta = (const float*)(ws + WS_STA);
    bf16_t* ob = (bf16_t*)(ws + WS_O);
    for (int it = gtid; it < NT * 8 * 8; it += gthreads) {
        const int ch = it & 7, hd = (it >> 3) & 7, tk = it >> 6, b = tk >> 11, t = tk & 2047;
        float mm[3], ll[3];
#pragma unroll
        for (int p = 0; p < 3; ++p) { const float* s = sta + ((size_t)p * NB * 8 * NS + (size_t)(b * 8 + hd) * NS + t) * 2; mm[p] = s[0]; ll[p] = s[1]; }
        const float M = fmaxf(mm[0], fmaxf(mm[1], mm[2]));
        float wgt[3], den = 0.f;
#pragma unroll
        for (int p = 0; p < 3; ++p) { wgt[p] = __builtin_amdgcn_exp2f(mm[p] - M) * ll[p]; den += wgt[p]; }
        const float inv = 1.0f / den;
        float a[8];
#pragma unroll
        for (int i = 0; i < 8; ++i) a[i] = 0.f;
#pragma unroll
        for (int p = 0; p < 3; ++p) {
            const bf16_t* op = (const bf16_t*)(p < 2 ? ws + WS_OPA01 + (size_t)p * 16 * MiB : ws + WS_OPA2);
            const u32x4 v = *(const u32x4*)(op + (size_t)tk * 512 + hd * 64 + ch * 8);
            const float wp = wgt[p] * inv;
            a[0] += wp * bflo(v.x); a[1] += wp * bfhi(v.x); a[2] += wp * bflo(v.y); a[3] += wp * bfhi(v.y);
            a[4] += wp * bflo(v.z); a[5] += wp * bfhi(v.z); a[6] += wp * bflo(v.w); a[7] += wp * bfhi(v.w);
        }
        u32x4 o; o.x = pk2(a[0], a[1]); o.y = pk2(a[2], a[3]); o.z = pk2(a[4], a[5]); o.w = pk2(a[6], a[7]);
        *(u32x4*)(ob + (size_t)tk * ND + hd * 64 + ch * 8) = o;
    }
}

constexpr int LDS_IMP = 4 * KVT;
constexpr int LDS_UNI = LDS_IMP + 4096;
constexpr int LDS_TOT = 41088;
__device__ __forceinline__ void nsa_item(unsigned char* ws, int item, LAS unsigned char* lds) {
    const int tid = TID(), lane = tid & 63, w = tid >> 6, c = lane & 31, h = lane >> 5;
    const int bg = item & 15, tt = item >> 4, b = bg >> 1, g = bg & 1;
    const int t0 = tt * 32, tok8 = c & 7, hh = c >> 3, hb = g * 4 + hh, t = t0 + 8 * w + tok8;
    const bf16_t* qrow = (const bf16_t*)(ws + WS_QB) + ((size_t)(b * 8 + hb) * NS + t) * 64;
    bf16x8 qf[4]; load_qf(qf, qrow, h);
    const float ns2 = -exp2f(-(float)(hb + 1)) * LOG2E_F;
    const float* gt = (const float*)(ws + WS_GATES) + (size_t)(b * NS + t) * 24 + hb * 3;
    const float g0 = gt[0], g1 = gt[1], g2 = gt[2];
    LAS float* totL = (LAS float*)(lds + LDS_TOT) + tid;
    LAS unsigned char* Kt = lds; LAS unsigned char* Vt = lds + 2 * KVT;
    LAS float* impL = (LAS float*)(lds + LDS_IMP) + w * 256;
    LAS unsigned* uni = (LAS unsigned*)(lds + LDS_UNI);
    const int cur = t0 >> 6;
    unsigned selmask;
    {
        const bf16_t* kc = (const bf16_t*)(ws + WS_KCMP) + (size_t)bg * 128 * 64;
        const bf16_t* vc = kc + (size_t)16 * 128 * 64;
        __syncthreads();
        load_kv_tile(Kt, Vt, kc, vc, 0, 1, 0, 127, tid);
        load_kv_tile(Kt + KVT, Vt + VT, kc, vc, 64, 1, 0, 127, tid);
        if (tid == 0) uni[0] = 0u;
        __syncthreads();
        LAS const unsigned char* kp = Kt + c * KVS + 16 * h;
        f32x16 sT[4];
#pragma unroll
        for (int T = 0; T < 4; ++T) sT[T] = qk32(qf, kp + T * 32 * KVS, zero16());
        const float dAh = (float)(t - 31) - (float)(64 * h);
        float tmax = -1e30f;
#pragma unroll
        for (int T = 0; T < 4; ++T)
#pragma unroll
            for (int i = 0; i < 16; ++i) {
                const float d = dAh - (float)(16 * (32 * T + (i & 3) + 8 * (i >> 2)));
                float tv = sT[T][i] + ns2 * d;
                tv = d >= 0.f ? tv : -1e30f;
                sT[T][i] = tv; tmax = fmaxf(tmax, tv);
            }
        tmax = fmaxf(tmax, __shfl_xor(tmax, 32));
        const float mu = fmaxf(tmax, -1e29f);
        float ps = 0.f;
#pragma unroll
        for (int T = 0; T < 4; ++T)
#pragma unroll
            for (int i = 0; i < 16; ++i) { sT[T][i] = __builtin_amdgcn_exp2f(sT[T][i] - mu); ps += sT[T][i]; }
        ps += __shfl_xor(ps, 32);
        const float inv = ps > 0.f ? 1.0f / ps : 0.f;
#pragma unroll
        for (int T = 0; T < 4; ++T)
#pragma unroll
            for (int i = 0; i < 16; ++i) sT[T][i] *= inv;
        f32x16 o0 = zero16(), o1 = zero16();
        const int vq = (lane & 15) >> 2, vc0 = 2 * ((lane >> 4) & 1) + ((lane & 3) >> 1), vsx = 2 * vq;
        LAS const unsigned char* vp0 = Vt + (4 * h + vq) * VS + ((vc0 ^ vsx) * 16) + 8 * (lane & 1);
        LAS const unsigned char* vp1 = Vt + (4 * h + vq) * VS + (((vc0 + 4) ^ vsx) * 16) + 8 * (lane & 1);
#pragma unroll
        for (int T = 0; T < 4; ++T) pv32(o0, o1, sT[T], vp0 + T * 32 * VS, vp1 + T * 32 * VS);
#pragma unroll
        for (int i = 0; i < 16; ++i) { totL[i * 256] = g0 * o0[i]; totL[(16 + i) * 256] = g0 * o1[i]; }
        float mainv[16], spill[16];
#pragma unroll
        for (int T = 0; T < 4; ++T)
#pragma unroll
            for (int u = 0; u < 4; ++u) {
                const float p3 = 0.5f * sT[T][4 * u + 3];
                mainv[4 * T + u] = sT[T][4 * u] + sT[T][4 * u + 1] + sT[T][4 * u + 2] + p3;
                spill[4 * T + u] = p3;
            }
#pragma unroll
        for (int f = 0; f < 16; ++f) {
            mainv[f] += __shfl_xor(mainv[f], 8); mainv[f] += __shfl_xor(mainv[f], 16);
            spill[f] += __shfl_xor(spill[f], 8); spill[f] += __shfl_xor(spill[f], 16);
        }
#pragma unroll
        for (int f = 0; f < 16; ++f) {
            const float snd = h ? (f > 0 ? spill[f > 0 ? f - 1 : 0] : 0.f) : spill[f];
            const float rcv = __shfl_xor(snd, 32);
            mainv[f] += rcv;
        }
        if (hh == 0) {
#pragma unroll
            for (int f = 0; f < 16; ++f) impL[tok8 * 32 + 2 * f + h] = mainv[f];
        }
        asm volatile("s_waitcnt lgkmcnt(0)" ::: "memory");
        {
            const int tk = lane >> 3, tq = t0 + 8 * w + tk, cq = tq >> 6, n0 = 4 * (lane & 7);
            float sc[32];
#pragma unroll
            for (int q4 = 0; q4 < 8; ++q4) {
                const f32x4 v = *(const LAS f32x4*)(impL + tk * 32 + 4 * q4);
                sc[4 * q4] = v.x; sc[4 * q4 + 1] = v.y; sc[4 * q4 + 2] = v.z; sc[4 * q4 + 3] = v.w;
            }
#pragma unroll
            for (int n = 0; n < 32; ++n) {
                const bool valid = n <= cq, forced = (n == 0) || (cq - n < 2);
                sc[n] = valid ? sc[n] + (forced ? 1e4f : 0.f) : -1e30f;
            }
            unsigned bits = 0u;
#pragma unroll
            for (int k = 0; k < 4; ++k) {
                const int n = n0 + k;
                float mine = 0.f;
#pragma unroll
                for (int q = 0; q < 32; ++q) mine = (q == n) ? sc[q] : mine;
                int rank = 0;
#pragma unroll
                for (int q = 0; q < 32; ++q) rank += (sc[q] > mine || (sc[q] == mine && q < n)) ? 1 : 0;
                if (n <= cq && rank < 16) bits |= 1u << n;
            }
            bits |= __shfl_xor(bits, 1); bits |= __shfl_xor(bits, 2); bits |= __shfl_xor(bits, 4);
            selmask = __shfl(bits, tok8 * 8);
        }
        {
            unsigned um = selmask;
#pragma unroll
            for (int o = 1; o < 64; o <<= 1) um |= __shfl_xor(um, o);
            if (lane == 0) atomicOr((unsigned*)uni, um);
        }
        __syncthreads();
    }
    const unsigned ublk = uni[0];
    unsigned wsel = selmask;
#pragma unroll
    for (int o = 1; o < 64; o <<= 1) wsel |= __shfl_xor(wsel, o);
    int buf = 0;
    KVRegs kr;
    {
        const bf16_t* kb = (const bf16_t*)(ws + WS_KV6 + 2 * 4 * MiB) + (size_t)bg * NS * 64;
        const bf16_t* vb = (const bf16_t*)(ws + WS_KV6 + 3 * 4 * MiB) + (size_t)bg * NS * 64;
        f32x16 o0 = zero16(), o1 = zero16(); FaState st = {0.f, 0.f, 0};
        unsigned rem = ublk & (cur >= 31 ? 0xffffffffu : ((2u << cur) - 1u));
        int n = 31 - __builtin_clz(rem);
        kv_fetch(kr, kb, vb, 64 * n, 1, 0, NS - 1, tid);
        while (rem) {
            rem &= ~(1u << n);
            LAS unsigned char* Kc = lds + buf * KVT; LAS unsigned char* Vc = lds + 2 * KVT + buf * VT;
            kv_commit(kr, Kc, Vc, tid);
            __syncthreads();
            const int ncur = n;
            if (rem) { n = 31 - __builtin_clz(rem); kv_fetch(kr, kb, vb, 64 * n, 1, 0, NS - 1, tid); }
            if ((wsel >> ncur) & 1u)
                fa_tile64<true>(o0, o1, st, qf, Kc, Vc, lane, (float)(t - 64 * ncur), 1e30f, ns2, ((selmask >> ncur) & 1u) != 0u);
            buf ^= 1;
        }
        const float lt = st.l + __shfl_xor(st.l, 32);
        { const float sc = g1 / lt;
#pragma unroll
          for (int i = 0; i < 16; ++i) { totL[i * 256] += sc * o0[i]; totL[(16 + i) * 256] += sc * o1[i]; } }
    }
    {
        const bf16_t* kb = (const bf16_t*)(ws + WS_KV6 + 4 * 4 * MiB) + (size_t)bg * NS * 64;
        const bf16_t* vb = (const bf16_t*)(ws + WS_KV6 + 5 * 4 * MiB) + (size_t)bg * NS * 64;
        f32x16 o0 = zero16(), o1 = zero16(); FaState st = {0.f, 0.f, 0};
        const int nlo = t0 >= 511 ? (t0 - 511) >> 6 : 0;
        kv_fetch(kr, kb, vb, 64 * cur, 1, 0, NS - 1, tid);
        for (int n = cur; n >= nlo; --n) {
            LAS unsigned char* Kc = lds + buf * KVT; LAS unsigned char* Vc = lds + 2 * KVT + buf * VT;
            kv_commit(kr, Kc, Vc, tid);
            __syncthreads();
            if (n > nlo) kv_fetch(kr, kb, vb, 64 * (n - 1), 1, 0, NS - 1, tid);
            fa_tile64<true>(o0, o1, st, qf, Kc, Vc, lane, (float)(t - 64 * n), 511.f, ns2);
            buf ^= 1;
        }
        const float lt = st.l + __shfl_xor(st.l, 32);
        { const float sc = g2 / lt;
#pragma unroll
          for (int i = 0; i < 16; ++i) { o0[i] = totL[i * 256] + sc * o0[i]; o1[i] = totL[(16 + i) * 256] + sc * o1[i]; } }
        store_ot((bf16_t*)(ws + WS_O) + ((size_t)(b * NS + t) * ND + 512 + hb * 64), o0, o1, 1.0f, h);
    }
}

#define XB_TMO      128
#define XB_XCNT(j)  (256  + 64 * (j))
#define XB_XSUB(j)  (1280 + 64 * (j))
#define XB_XGEN(j)  (2304 + 64 * (j))
#define XB_TOP      3328
#define XB_TOPGEN   3392
#define XCD_BAR_WORDS 3456
#define XB_SPIN_CAP (1u << 18)
__device__ __forceinline__ unsigned xb_ld(unsigned* p)              { return __hip_atomic_load(p, __ATOMIC_RELAXED, __HIP_MEMORY_SCOPE_AGENT); }
__device__ __forceinline__ unsigned xb_add(unsigned* p, unsigned v) { return __hip_atomic_fetch_add(p, v, __ATOMIC_RELAXED, __HIP_MEMORY_SCOPE_AGENT); }
__device__ __forceinline__ unsigned xb_xcc_id() { return (unsigned)__builtin_amdgcn_s_getreg((3 << 11) | 20) & 0xFu; }
#define XB_SPIN(cond, bar) do { unsigned _sp = 0; while (cond) { __builtin_amdgcn_s_sleep(1); \
    if ((++_sp & 255u) == 0u) { if (xb_ld(&(bar)[XB_TMO])) break; if (_sp > XB_SPIN_CAP) { atomicAdd(&(bar)[XB_TMO], 1u); break; } } } } while (0)
struct XcdBarrier { unsigned* bar; unsigned x; volatile LAS unsigned* st; };
__device__ __forceinline__ XcdBarrier xcd_barrier_post(unsigned* bar, volatile LAS unsigned* st) {
    XcdBarrier b; b.bar = bar; b.x = xb_xcc_id(); b.st = st;
    if (threadIdx.x == 0) (void)xb_add(&bar[XB_XCNT(b.x)], 1u);
    return b;
}
__device__ __forceinline__ void xcd_barrier_complete(unsigned* bar, unsigned x, unsigned& nloc, unsigned& nx) {
    const unsigned G = gridDim.x * gridDim.y * gridDim.z;
    unsigned sum, cnt, mine, sp = 0u;
    for (;;) {
        sum = 0u; cnt = 0u; mine = 0u;
#pragma unroll
        for (unsigned j = 0; j < 16; ++j) { const unsigned c = xb_ld(&bar[XB_XCNT(j)]); sum += c; cnt += (c > 0u) ? 1u : 0u; mine = (j == x) ? c : mine; }
        if (sum == G) break;
        __builtin_amdgcn_s_sleep(1);
        if ((++sp & 255u) == 0u) { if (xb_ld(&bar[XB_TMO])) break; if (sp > XB_SPIN_CAP) { atomicAdd(&bar[XB_TMO], 1u); break; } }
    }
    nloc = mine > 0u ? mine : 1u; nx = cnt > 0u ? cnt : 1u;
}
__device__ __forceinline__ void xcd_barrier(const XcdBarrier& b) {
    asm volatile("s_waitcnt vmcnt(0)" ::: "memory");
    __syncthreads();
    if (threadIdx.x == 0) {
        unsigned* bar = b.bar;
        __builtin_amdgcn_s_waitcnt(0);
        unsigned nloc = b.st[0], nx = b.st[1];
        if (nloc == 0u) { xcd_barrier_complete(bar, b.x, nloc, nx); b.st[0] = nloc; b.st[1] = nx; }
        const unsigned old = xb_add(&bar[XB_XSUB(b.x)], 1u);
        const unsigned gen = old / nloc;
        if (old + 1u == (gen + 1u) * nloc) {
            __builtin_amdgcn_fence(__ATOMIC_RELEASE, "agent");
            asm volatile("s_waitcnt vmcnt(0)" ::: "memory");
            const unsigned og = xb_add(&bar[XB_TOP], 1u);
            const unsigned tg = og / nx;
            if (og + 1u == (tg + 1u) * nx) xb_add(&bar[XB_TOPGEN], 1u);
            else XB_SPIN(xb_ld(&bar[XB_TOPGEN]) == tg, bar);
            __builtin_amdgcn_fence(__ATOMIC_ACQUIRE, "agent");
            xb_add(&bar[XB_XGEN(b.x)], 1u);
            asm volatile("s_waitcnt vmcnt(0)" ::: "memory");
        } else {
            XB_SPIN(xb_ld(&bar[XB_XGEN(b.x)]) == gen, bar);
            __builtin_amdgcn_fence(__ATOMIC_ACQUIRE, "agent");
            asm volatile("s_waitcnt vmcnt(0)" ::: "memory");
        }
    }
    __syncthreads();
}

struct XcdTiles {
    int m_lo, cnt_m, nN, loc, nloc, tiles;
    __device__ __forceinline__ XcdTiles(int nM, int nN_) {
        const int b = BID(), g = gridDim.x;
        int x, nx;
        if ((g & 7) == 0) { x = b & 7; nx = 8; loc = b >> 3; nloc = g >> 3; } else { x = 0; nx = 1; loc = b; nloc = g; }
        m_lo = (int)((long)nM * x / nx); cnt_m = (int)((long)nM * (x + 1) / nx) - m_lo; nN = nN_; tiles = cnt_m * nN;
    }
    __device__ __forceinline__ void get(int q, int& mt, int& nt) const {
        const int mg = q / (8 * nN), rem_m = cnt_m - 8 * mg, mig = rem_m < 8 ? rem_m : 8, r = q - mg * 8 * nN;
        nt = r / mig; mt = m_lo + 8 * mg + (r - nt * mig);
    }
};
struct PhInProj { const bf16_t* xn; const unsigned char* wl; unsigned char* ws; const float* ssp; LAS unsigned char* lds; XcdTiles xt;
    __device__ __forceinline__ void make(int q, APlain& ap, BPlain& bp, EpiInProj& ep) const { int mt, nt; xt.get(q, mt, nt);
        ap = APlain{xn + (size_t)mt * 128 * ND, ND}; bp = BPlain{(const bf16_t*)(wl + WL_IN) + (size_t)nt * 128 * ND, ND}; ep = EpiInProj{mt, nt, ws, ssp, lds}; } };
struct PhCmp1 { const unsigned char* wl; unsigned char* ws; int l;
    __device__ __forceinline__ void make(int tile, ACmp& ap, BPlain& bp, EpiCmp1& ep) const { const int nt = tile & 1, bg = (tile >> 1) & 15, kv = tile >> 5;
        ap = ACmp{(const bf16_t*)(ws + WS_KV6 + (size_t)kv * 4 * MiB) + (size_t)bg * NS * 64};
        bp = BPlain{(const bf16_t*)(wl + WL_C1) + (size_t)kv * 256 * 2048 + (size_t)nt * 128 * 2048, 2048};
        ep = EpiCmp1{(bf16_t*)(ws + WS_HC) + (size_t)kv * 2048 * 256, (const float*)(ws + WS_BC1P) + l * 512 + kv * 256, bg * 128, nt * 128}; } };
struct PhCmp2 { const unsigned char* wl; unsigned char* ws;
    __device__ __forceinline__ void make(int tile, APlain& ap, BPlain& bp, EpiCmp2& ep) const { const int bg = tile & 15, kv = tile >> 4;
        ap = APlain{(const bf16_t*)(ws + WS_HC) + (size_t)kv * 2048 * 256 + (size_t)bg * 128 * 256, 256};
        bp = BPlain{(const bf16_t*)(wl + WL_C2) + (size_t)kv * 128 * 256, 256};
        ep = EpiCmp2{(bf16_t*)(ws + WS_KCMP) + (size_t)kv * 16 * 128 * 64, bg * 128}; } };
struct PhOutProj { const unsigned char* wl; unsigned char* ws; bf16_t* res; XcdTiles xt;
    __device__ __forceinline__ void make(int q, APlain& ap, BPlain& bp, EpiResAdd& ep) const { int mt, nt; xt.get(q, mt, nt);
        ap = APlain{(const bf16_t*)(ws + WS_O) + (size_t)mt * 128 * ND, ND}; bp = BPlain{(const bf16_t*)(wl + WL_OUT) + (size_t)nt * 128 * ND, ND};
        ep = EpiResAdd{res, mt * 128, nt * 128}; } };
struct PhMoe {
    LAS const int* sm; const int* list;
    __device__ __forceinline__ void decode(int gmt, int& bk, int& mt, int& rem, int& hrow0, int& elo, int& ehi) const {
        bk = 0;
        for (int k = 1; k < 24; ++k) if (gmt >= sm[32 + k]) bk = k;
        mt = gmt - sm[32 + bk]; rem = sm[bk] - mt * 128; hrow0 = sm[64 + bk] + mt * 128;
        const int grp = bk / 6, pi = bk % 6;
        elo = grp * 4 + (pi < 3 ? 0 : (pi < 5 ? 1 : 2)); ehi = grp * 4 + (pi < 3 ? pi + 1 : (pi < 5 ? pi - 1 : 3));
    } };
struct PhMoeGU { PhMoe m; const bf16_t* xn; const unsigned char* wl; unsigned char* ws; const float* route; const float* rinv; XcdTiles xt;
    __device__ __forceinline__ void make(int q, AGather& ap, BPlain& bp, EpiMoeGU& ep) const { int gmt, nt16; xt.get(q, gmt, nt16);
        int bk, mt, rem, hrow0, elo, ehi; m.decode(gmt, bk, mt, rem, hrow0, elo, ehi);
        const int* lst = m.list + (size_t)bk * NT + mt * 128; const int e = (nt16 >> 3) ? ehi : elo;
        ap = AGather{xn, lst, rem}; bp = BPlain{(const bf16_t*)(wl + WL_GU) + (size_t)e * 1024 * 1024 + (size_t)(nt16 & 7) * 128 * 1024, 1024};
        ep = EpiMoeGU{(bf16_t*)(ws + WS_HID), lst, route, rinv, rem, hrow0, nt16}; } };
struct PhMoeDown { PhMoe m; const unsigned char* wl; unsigned char* ws; bf16_t* res; float* ssp; XcdTiles xt;
    __device__ __forceinline__ void make(int q, APlain& ap, BSplit& bp, EpiMoeDown& ep) const { int gmt, nt; xt.get(q, gmt, nt);
        int bk, mt, rem, hrow0, elo, ehi; m.decode(gmt, bk, mt, rem, hrow0, elo, ehi);
        const int* lst = m.list + (size_t)bk * NT + mt * 128;
        ap = APlain{(const bf16_t*)(ws + WS_HID) + (size_t)hrow0 * 1024, 1024};
        bp = BSplit{(const bf16_t*)(wl + WL_DN) + (size_t)elo * 1024 * 512 + (size_t)nt * 128 * 512, (const bf16_t*)(wl + WL_DN) + (size_t)ehi * 1024 * 512 + (size_t)nt * 128 * 512};
        ep = EpiMoeDown{res, lst, ssp, rem, nt * 128}; } };
struct PhPleProj { const unsigned char* wl; unsigned char* ws; XcdTiles xt;
    __device__ __forceinline__ void make(int q, APlain& ap, BPlain& bp, EpiBf16& ep) const { int mt, nt; xt.get(q, mt, nt);
        ap = APlain{(const bf16_t*)(ws + WS_PB) + (size_t)mt * 128 * 256, 256}; bp = BPlain{(const bf16_t*)(wl + WL_PP) + (size_t)nt * 128 * 256, 256};
        ep = EpiBf16{(bf16_t*)(ws + WS_P2), ND, mt * 128, nt * 128}; } };
struct PhPleGate { const bf16_t* xn; const unsigned char* wl; unsigned char* ws; float* out; float sc; XcdTiles xt;
    __device__ __forceinline__ void make(int q, APlain& ap, BPlain& bp, EpiPleGate& ep) const { int mt, nt; xt.get(q, mt, nt);
        ap = APlain{xn + (size_t)mt * 128 * ND, ND}; bp = BPlain{(const bf16_t*)(wl + WL_PG) + (size_t)nt * 128 * ND, ND};
        ep = EpiPleGate{out, (const bf16_t*)(ws + WS_P2), mt * 128, nt * 128, sc}; } };

constexpr int LDS_QSLOT = 73856 + 16 + 448;
__device__ __forceinline__ int wq_next(int* head, LAS unsigned char* lds) {
    LAS int* slot = (LAS int*)(lds + LDS_QSLOT);
    __syncthreads();
    if (threadIdx.x == 0) *slot = atomicAdd(head, 1);
    __syncthreads();
    return *slot;
}
__device__ __forceinline__ void ple_stream(const bf16_t* xn, const bf16_t* pb, const unsigned char* wl, const float* ssp_in, bf16_t* rout, float* ssp_out, LAS unsigned char* lds) {
    const XcdTiles xt(128, 8);
    int q = xt.loc;
    if (q >= xt.tiles) return;
    const int tid = TID(), wid = tid >> 6, lane = tid & 63, wr = wid >> 1, wc = wid & 1, fr = lane & 15, fq = lane >> 4;
    int mt, nt; xt.get(q, mt, nt);
    bool pref = false;
    for (;;) {
        const int qn = q + xt.nloc; const bool hn = qn < xt.tiles;
        int mtn = mt, ntn = nt; if (hn) xt.get(qn, mtn, ntn);
        const APlain ap1{pb + (size_t)mt * 128 * 256, 256}; const BPlain bp1{(const bf16_t*)(wl + WL_PP) + (size_t)nt * 128 * 256, 256};
        const APlain ap2{xn + (size_t)mt * 128 * ND, ND};   const BPlain bp2{(const bf16_t*)(wl + WL_PG) + (size_t)nt * 128 * ND, ND};
        const APlain apn{pb + (size_t)mtn * 128 * 256, 256}; const BPlain bpn{(const bf16_t*)(wl + WL_PP) + (size_t)ntn * 128 * 256, 256};
        f32x4 acc[4][4], acc2[4][4]; zero_acc(acc); zero_acc(acc2);
        gemm_kloop(acc2, ap1, bp1, 256, lds, pref, true, ap2, bp2);
        gemm_kloop(acc, ap2, bp2, ND, lds, true, hn, apn, bpn);
        const EpiPleFused ep{xn, ssp_in, rout, ssp_out, mt * 128, nt * 128};
        ep(acc, acc2, wr, wc, fr, fq);
        if (!hn) break;
        q = qn; mt = mtn; nt = ntn; pref = true;
    }
}

constexpr int LDS_BAR = 73856;
constexpr int LDS_SM = LDS_BAR + 16;
constexpr int LDS_BYTES = LDS_SM + 512;
static_assert(LDS_QSLOT == LDS_SM + 448, "queue slot");
static_assert(4 * KVT + 4096 + 64 <= LDS_TOT && LDS_TOT + 32768 <= LDS_BAR && 65536 <= LDS_BAR, "LDS map");

__global__ void __launch_bounds__(256, 2) mega_fwd(Params p) {
    extern __shared__ __attribute__((aligned(16))) unsigned char lds_raw[];
    LAS unsigned char* lds = (LAS unsigned char*)lds_raw;
    unsigned char* ws = p.ws;
    const int tid = threadIdx.x;
    const int gtid = blockIdx.x * 256 + tid, gthreads = gridDim.x * 256;
    int* ctl = (int*)(ws + WS_CTL);
    {
        volatile LAS unsigned* st = (volatile LAS unsigned*)(lds + LDS_BAR);
        if (tid < 4) st[tid] = 0u;
        __syncthreads();
    }
    const XcdBarrier gbar = xcd_barrier_post((unsigned*)ctl + CW_BAR, (volatile LAS unsigned*)(lds + LDS_BAR));

    phase_convert(p, (LAS float*)lds);
    xcd_barrier(gbar);

    float* sspA = (float*)(ws + WS_SSP);
    float* sspB = sspA + (size_t)NT * 16;
    float* rinv = (float*)(ws + WS_RINV);
    for (int l = 0; l < 2; ++l) {
        const unsigned char* wl = ws + WS_W + (size_t)l * WL_SIZE;
        bf16_t* xn = (bf16_t*)p.out + (size_t)(l & 1) * NT * ND;
        bf16_t* rnext = l == 1 ? (bf16_t*)(ws + WS_XN) : (bf16_t*)p.out + (size_t)((l + 1) & 1) * NT * ND;
        const bf16_t* xb_in = xn;
        {
            const PhInProj ph{xb_in, wl, ws, sspB, lds, XcdTiles(128, 23)};
            gemm_stream<PhInProj, APlain, BPlain, EpiInProj>(ph, ph.xt.loc, ph.xt.nloc, ph.xt.tiles, ND, lds);
        }
        xcd_barrier(gbar);
        {
            int* qh = ctl + CW_Q + (l * 4 + 0) * 64;
            int* ch = ctl + CW_Q + (l * 4 + 2) * 64;
            const int nconv = conv_queue_strips(2 * l);
            const PhCmp1 ph{wl, ws, l};
            bool conv_left = nconv > 0, att_left = true, first_att = true;
            for (int k = 0; conv_left || att_left; ++k) {
                const bool want_conv = conv_left && (!att_left || (k % 7) == 6);
                if (want_conv) {
                    const int c = wq_next(ch, lds);
                    if (c < nconv) conv_strip(p, 2 * l, c, (LAS float*)lds); else conv_left = false;
                } else {
                    const int it = first_att ? BID() : (int)gridDim.x + wq_next(qh, lds);
                    first_att = false;
                    if (it >= 64 + 1536) att_left = false;
                    else if (it < 64) { ACmp ap; BPlain bp; EpiCmp1 ep; ph.make(it, ap, bp, ep); gemm_tile(ap, bp, 2048, ep, lds, false, false, ap, bp); }
                    else { dil_item(ws, 2 * (it - 64), lds); __syncthreads(); dil_item(ws, 2 * (it - 64) + 1, lds); }
                }
            }
        }
        xcd_barrier(gbar);
        { const PhCmp2 ph{wl, ws}; gemm_stream<PhCmp2, APlain, BPlain, EpiCmp2>(ph, BID(), gridDim.x, 32, 256, lds); }
        dil_merge(ws, gtid, gthreads);
        if (l == 0) convert_p(p);
        xcd_barrier(gbar);
        {
            int* qh = ctl + CW_Q + (l * 4 + 1) * 64;
            int* ch = ctl + CW_Q + (l * 4 + 3) * 64;
            const int nconv = conv_queue_strips(2 * l + 1);
            bool conv_left = nconv > 0, att_left = true, first_att = true;
            for (int k = 0; conv_left || att_left; ++k) {
                const bool want_conv = conv_left && (!att_left || (k % 4) == 3);
                if (want_conv) {
                    const int c = wq_next(ch, lds);
                    if (c < nconv) conv_strip(p, 2 * l + 1, c, (LAS float*)lds); else conv_left = false;
                } else {
                    const int it = first_att ? BID() : (int)gridDim.x + wq_next(qh, lds);
                    first_att = false;
                    if (it >= 1024) att_left = false;
                    else nsa_item(ws, ((63 - (it >> 4)) << 4) | (it & 15), lds);
                }
            }
        }
        xcd_barrier(gbar);
        { const PhOutProj ph{wl, ws, xn, XcdTiles(128, 8)};
          gemm_stream<PhOutProj, APlain, BPlain, EpiResAdd>(ph, ph.xt.loc, ph.xt.nloc, ph.xt.tiles, ND, lds); }
        xcd_barrier(gbar);
        int* cnt = ctl + CW_CNTP + l * 1536;
        int* list = (int*)(ws + WS_LIST);
        float* route = (float*)(ws + WS_ROUTE);
        phase_route(xn, (const float*)(wl + WL_RT), p.in[12] + l * 4, p.in[14] + l * 16, cnt, list, route, rinv, lds);
        xcd_barrier(gbar);
        LAS int* sm = (LAS int*)(lds + LDS_SM);
        __syncthreads();
        if (tid < 24) sm[tid] = __hip_atomic_load(cnt + 64 * tid, __ATOMIC_RELAXED, __HIP_MEMORY_SCOPE_AGENT);
        __syncthreads();
        if (tid == 0) {
            int tp = 0, hb = 0;
            for (int k = 0; k < 24; ++k) {
                const int c = sm[k];
                sm[32 + k] = tp; sm[64 + k] = hb;
                const int nt_ = (c + 127) >> 7; tp += nt_; hb += nt_ * 128;
            }
            sm[32 + 24] = tp;
        }
        __syncthreads();
        const int total_mt = sm[32 + 24];
        { const PhMoeGU ph{PhMoe{sm, list}, xn, wl, ws, route, rinv, XcdTiles(total_mt, 16)};
          gemm_stream<PhMoeGU, AGather, BPlain, EpiMoeGU>(ph, ph.xt.loc, ph.xt.nloc, ph.xt.tiles, ND, lds); }
        xcd_barrier(gbar);
        { const PhMoeDown ph{PhMoe{sm, list}, wl, ws, xn, sspA, XcdTiles(total_mt, 8)};
          gemm_stream<PhMoeDown, APlain, BSplit, EpiMoeDown>(ph, ph.xt.loc, ph.xt.nloc, ph.xt.tiles, ND, lds); }
        xcd_barrier(gbar);
        ple_stream(xn, (const bf16_t*)(ws + WS_PBALL) + (size_t)l * NT * 256, wl, sspA, rnext, sspB, lds);
        xcd_barrier(gbar);
    }
    phase_final_norm((const bf16_t*)(ws + WS_XN), p.out, p.in[21]);
}

extern "C" void kernel_launch(void* const* d_in, const int* in_sizes, int n_in, void* d_out, int out_size, void* d_ws, size_t ws_size, hipStream_t stream) {
    static int grid = 0;
    if (grid == 0) {
        if (n_in != 22 || out_size != NT * ND || ws_size < WS_END) { fprintf(stderr, "kernel_launch: unexpected shapes (n_in %d out %d ws %zu)\n", n_in, out_size, ws_size); grid = -1; return; }
        int dev = 0, cus = 0, per_cu = 0;
        hipGetDevice(&dev);
        hipDeviceGetAttribute(&cus, hipDeviceAttributeMultiprocessorCount, dev);
        if (hipFuncSetAttribute((const void*)mega_fwd, hipFuncAttributeMaxDynamicSharedMemorySize, LDS_BYTES) != hipSuccess) { fprintf(stderr, "kernel_launch: hipFuncSetAttribute failed\n"); grid = -1; return; }
        hipOccupancyMaxActiveBlocksPerMultiprocessor(&per_cu, (const void*)mega_fwd, 256, LDS_BYTES);
        if (per_cu < 1) { fprintf(stderr, "kernel_launch: occupancy query says %d\n", per_cu); grid = -1; return; }
        if (per_cu > 2) per_cu = 2;
        grid = cus * per_cu;
    }
    if (grid < 0) return;
    hipMemsetAsync((char*)d_ws + WS_CTL, 0, 32768, stream);
    Params p{};
    for (int i = 0; i < 22; ++i) p.in[i] = (const float*)d_in[i];
    p.out = (float*)d_out; p.ws = (unsigned char*)d_ws;
    hipLaunchKernelGGL(mega_fwd, dim3(grid), dim3(256), LDS_BYTES, stream, p);
    const hipError_t e = hipPeekAtLastError();
    if (e != hipSuccess) fprintf(stderr, "launch failed: %s (grid %d)\n", hipGetErrorString(e), grid);
}
```

```cpp
#include <hip/hip_runtime.h>
#include <cstdio>
#include <cstdint>

#ifndef NAIVE_GEMM
#define NAIVE_GEMM 0
#endif
#ifndef NAIVE_ATTN
#define NAIVE_ATTN 0
#endif
#define REP_CONV 1
#define REP_INPROJ 1
#define REP_ATTN 1
#define REP_GU 1
#define REP_NORM 1
#define REP_ROUTE 1
#define REP_DOWN 1
#define REP_OUTPROJ 1
#define REP_PG 1
#define REP_CMP 1
#define REP_MISC 1

#define LAS __attribute__((address_space(3)))
typedef unsigned short bf16_t;
typedef short bf16x8 __attribute__((ext_vector_type(8)));
typedef float f32x4 __attribute__((ext_vector_type(4)));
typedef unsigned u32x4 __attribute__((ext_vector_type(4)));
typedef unsigned u32x2 __attribute__((ext_vector_type(2)));
typedef float f32x16 __attribute__((ext_vector_type(16)));
typedef short s16x4 __attribute__((ext_vector_type(4)));
typedef float f32x2_t __attribute__((ext_vector_type(2)));
typedef __bf16 bf16x2_t __attribute__((ext_vector_type(2)));

constexpr int NB = 8, NS = 2048, ND = 1024, NT = NB * NS;
constexpr int NIN = 2840, NINP = 2944;
constexpr size_t MiB = (size_t)1 << 20;
constexpr size_t WL_IN = 0;
constexpr size_t WL_OUT = WL_IN + (size_t)NINP * 1024 * 2;
constexpr size_t WL_C1 = WL_OUT + (size_t)1024 * 1024 * 2;
constexpr size_t WL_C2 = WL_C1 + (size_t)2 * 256 * 2048 * 2;
constexpr size_t WL_GU = WL_C2 + (size_t)2 * 128 * 256 * 2;
constexpr size_t WL_DN = WL_GU + (size_t)16 * 1024 * 1024 * 2;
constexpr size_t WL_PG = WL_DN + (size_t)16 * 1024 * 512 * 2;
constexpr size_t WL_PP = WL_PG + (size_t)1024 * 1024 * 2;
constexpr size_t WL_BC1 = WL_PP + (size_t)1024 * 256 * 2;
constexpr size_t WL_RT = WL_BC1 + 2048;
constexpr size_t WL_SIZE = 64 * MiB;
static_assert(WL_RT + 131072 <= WL_SIZE, "weight block");
constexpr size_t WS_CTL = 0;
constexpr size_t WS_W = 1 * MiB;
constexpr size_t WS_XN = WS_W + 2 * WL_SIZE;
constexpr size_t WS_PROJ = WS_XN + 32 * MiB;
constexpr size_t WS_QA = WS_PROJ, WS_KA = WS_QA + 16 * MiB, WS_VA = WS_KA + 16 * MiB, WS_QB = WS_VA + 16 * MiB;
constexpr size_t WS_KV6 = WS_QB + 16 * MiB;
constexpr size_t WS_GATES = WS_KV6 + 24 * MiB;
constexpr size_t WS_PROJ_END = WS_GATES + 2 * MiB;
constexpr size_t WS_HID = WS_PROJ;
constexpr size_t WS_P2 = WS_PROJ + 40 * MiB;
constexpr size_t WS_PB = WS_PROJ + 72 * MiB;
constexpr size_t WS_HC = WS_PROJ_END;
constexpr size_t WS_KCMP = WS_HC + 2 * MiB;
constexpr size_t WS_MASK = WS_KCMP + 512 * 1024;
constexpr size_t WS_ROUTE = WS_MASK + 128 * 1024;
constexpr size_t WS_LIST = WS_ROUTE + 128 * 1024;
constexpr size_t WS_O = WS_LIST + 1536 * 1024 + 256 * 1024;
constexpr size_t WS_IMPH = WS_O + 32 * MiB;
constexpr size_t WS_OPA01 = WS_XN;
constexpr size_t WS_OPA2 = WS_IMPH;
constexpr size_t WS_STA = WS_IMPH + 16 * MiB;
constexpr size_t WS_PBALL = WS_IMPH + 20 * MiB;
constexpr size_t WS_SSP = WS_PBALL + 16 * MiB;
constexpr size_t WS_RINV = WS_MASK;
constexpr size_t WS_BC1P = WS_SSP + 2 * MiB;
constexpr size_t WS_END = WS_BC1P + 64 * 1024;
static_assert(WS_PB + 8 * MiB <= WS_PROJ_END, "alias map");
static_assert(WS_END <= 330 * MiB, "workspace");
constexpr int HID_ROWS = NT + 24 * 128;
constexpr int CW_BAR = 1024;
constexpr int CW_Q = 256;
constexpr int CW_CNTP = 4608;
constexpr int CW_CNT = 64;

struct Params {
    const float* in[22];
    float* out;
    unsigned char* ws;
};

__device__ __forceinline__ unsigned f2bf(float f) { unsigned u = __float_as_uint(f); return (u + 0x7fffu + ((u >> 16) & 1u)) >> 16; }
__device__ __forceinline__ unsigned pk2(float lo, float hi) { return f2bf(lo) | (f2bf(hi) << 16); }
__device__ __forceinline__ unsigned cvtpk(float lo, float hi) { f32x2_t v = {lo, hi}; bf16x2_t b = __builtin_convertvector(v, bf16x2_t); return __builtin_bit_cast(unsigned, b); }
__device__ __forceinline__ float bflo(unsigned v) { return __uint_as_float(v << 16); }
__device__ __forceinline__ float bfhi(unsigned v) { return __uint_as_float(v & 0xffff0000u); }
__device__ __forceinline__ float wave_sum(float v) {
#pragma unroll
    for (int o = 1; o < 64; o <<= 1) v += __shfl_xor(v, o);
    return v;
}
__device__ __forceinline__ int TID() { int t = threadIdx.x; asm volatile("" : "+v"(t)); return t; }
__device__ __forceinline__ int BID() { int t = blockIdx.x; asm volatile("" : "+s"(t)); return t; }
__device__ __forceinline__ float sigmoidf_(float x) { return 1.0f / (1.0f + __expf(-x)); }
__device__ __forceinline__ float gelu_tanh(float x) {
    const float u = 0.7978845608028654f * (x + 0.044715f * x * x * x);
    const float e = __expf(2.0f * u);
    const float th = 1.0f - 2.0f / (e + 1.0f);
    return 0.5f * x * (1.0f + th);
}

struct ConvJob { const float* src; bf16_t* dst; const float* gain; int K, N, NP, map, per; size_t dst_bstride; };
__device__ __forceinline__ int conv_job_tiles(int j) { return j == 0 ? 736 : (j == 1 || j == 9) ? 256 : (j == 2 || j == 3) ? 128 : (j == 4 || j == 5) ? 8 : j == 10 ? 64 : 2048; }
__device__ __forceinline__ ConvJob conv_job(const Params& p, int l, int j) {
    unsigned char* wl = p.ws + WS_W + (size_t)l * WL_SIZE;
    ConvJob c; c.map = 0; c.dst_bstride = 0; c.gain = nullptr;
    switch (j) {
    case 0: c.src = p.in[3] + (size_t)l * 1024 * NIN; c.K = 1024; c.N = NIN; c.NP = NINP; c.dst = (bf16_t*)(wl + WL_IN); c.gain = p.in[2] + l * ND; break;
    case 1: c.src = p.in[4] + (size_t)l * 1024 * 1024; c.K = 1024; c.N = 1024; c.NP = 1024; c.dst = (bf16_t*)(wl + WL_OUT); break;
    case 2: c.src = p.in[5] + (size_t)l * 2048 * 256; c.K = 2048; c.N = 256; c.NP = 256; c.dst = (bf16_t*)(wl + WL_C1); break;
    case 3: c.src = p.in[7] + (size_t)l * 2048 * 256; c.K = 2048; c.N = 256; c.NP = 256; c.dst = (bf16_t*)(wl + WL_C1) + (size_t)256 * 2048; break;
    case 4: c.src = p.in[6] + (size_t)l * 256 * 64; c.K = 256; c.N = 64; c.NP = 128; c.dst = (bf16_t*)(wl + WL_C2); break;
    case 5: c.src = p.in[8] + (size_t)l * 256 * 64; c.K = 256; c.N = 64; c.NP = 128; c.dst = (bf16_t*)(wl + WL_C2) + (size_t)128 * 256; break;
    case 6: c.src = p.in[15] + (size_t)l * 16 * 1024 * 512; c.K = 1024; c.N = 512; c.NP = 512; c.dst = (bf16_t*)(wl + WL_GU); c.map = 1; c.dst_bstride = (size_t)1024 * 1024; c.gain = p.in[10] + l * ND; break;
    case 7: c.src = p.in[16] + (size_t)l * 16 * 1024 * 512; c.K = 1024; c.N = 512; c.NP = 512; c.dst = (bf16_t*)(wl + WL_GU); c.map = 2; c.dst_bstride = (size_t)1024 * 1024; c.gain = p.in[10] + l * ND; break;
    case 8: c.src = p.in[17] + (size_t)l * 16 * 512 * 1024; c.K = 512; c.N = 1024; c.NP = 1024; c.dst = (bf16_t*)(wl + WL_DN); c.dst_bstride = (size_t)1024 * 512; break;
    case 9: c.src = p.in[19] + (size_t)l * 1024 * 1024; c.K = 1024; c.N = 1024; c.NP = 1024; c.dst = (bf16_t*)(wl + WL_PG); c.gain = p.in[18] + l * ND; break;
    default: c.src = p.in[20] + (size_t)l * 256 * 1024; c.K = 256; c.N = 1024; c.NP = 1024; c.dst = (bf16_t*)(wl + WL_PP); break;
    }
    c.per = (c.K / 64) * (c.NP / 64);
    return c;
}
__device__ __forceinline__ void convert_tiles(const ConvJob& c, int t0, int t1, LAS float*  ) {
    const int tid = TID();
    const int ntiles = c.NP / 64;
    const int half = tid >> 7, nl = tid & 15, kg = (tid >> 4) & 7;
    f32x4 va[8], vb[8], ga[2], gb[2];
#define CT_LOAD(v, g, it_) do { const int _bi = (it_) / c.per, _r = (it_) - _bi * c.per, _kt = _r / ntiles, _nt = _r - _kt * ntiles; \
        const int _n = _nt * 64 + 4 * nl; const bool _ok = _n < c.N; \
        const float* _sp = c.src + (size_t)_bi * c.K * c.N + (size_t)(_kt * 64 + 8 * kg) * c.N + (_ok ? _n : 0); \
        _Pragma("unroll") for (int _i = 0; _i < 8; ++_i) v[_i] = *(const f32x4*)(_sp + (size_t)_i * c.N); \
        if (c.gain) { g[0] = *(const f32x4*)(c.gain + _kt * 64 + 8 * kg); g[1] = *(const f32x4*)(c.gain + _kt * 64 + 8 * kg + 4); } \
        else { _Pragma("unroll") for (int _i = 0; _i < 2; ++_i) { g[_i].x = 1.0f; g[_i].y = 1.0f; g[_i].z = 1.0f; g[_i].w = 1.0f; } } \
        if (!_ok) { _Pragma("unroll") for (int _i = 0; _i < 2; ++_i) { g[_i].x = 0.f; g[_i].y = 0.f; g[_i].z = 0.f; g[_i].w = 0.f; } } } while (0)
#define CT_PROC(v, g, it_) do { const int _it = (it_); \
        const int bi = _it / c.per, r = _it - bi * c.per, kt = r / ntiles, nt = r - kt * ntiles; \
        bf16_t* d = c.dst + (size_t)bi * c.dst_bstride + kt * 64 + 8 * kg; \
        _Pragma("unroll") for (int j = 0; j < 4; ++j) { \
            const int nsrc = nt * 64 + 4 * nl + j; \
            const int row = (c.map == 0) ? nsrc : ((nsrc >> 4) * 32 + (nsrc & 15) + (c.map == 2 ? 16 : 0)); \
            u32x4 o; o.x = cvtpk(v[0][j] * g[0].x, v[1][j] * g[0].y); o.y = cvtpk(v[2][j] * g[0].z, v[3][j] * g[0].w); \
            o.z = cvtpk(v[4][j] * g[1].x, v[5][j] * g[1].y); o.w = cvtpk(v[6][j] * g[1].z, v[7][j] * g[1].w); \
            *(u32x4*)(d + (size_t)row * c.K) = o; } \
        if (_it + 4 < t1) CT_LOAD(v, g, _it + 4); } while (0)
    const int first = t0 + half;
    if (first < t1) CT_LOAD(va, ga, first);
    if (first + 2 < t1) CT_LOAD(vb, gb, first + 2);
    for (int it = first; it < t1; it += 4) {
        CT_PROC(va, ga, it);
        if (it + 2 < t1) CT_PROC(vb, gb, it + 2);
    }
#undef CT_LOAD
#undef CT_PROC
}
__device__ __forceinline__ int conv_list(int q, int i) {
    if (q == 0) return i == 0 ? 6 : (i == 1 ? 7 : -1);
    if (q == 1) return i == 0 ? 8 : i == 1 ? 9 : i == 2 ? 10 : i == 3 ? 16 : i == 4 ? 18 : i == 5 ? 19 : i == 6 ? 20 : i == 7 ? 21 : -1;
    if (q == 2) return i == 0 ? 17 : i == 1 ? 22 : i == 2 ? 23 : -1;
    return i == 0 ? 24 : i == 1 ? 25 : i == 2 ? 26 : -1;
}
__device__ __forceinline__ int conv_queue_strips(int q) {
    int n = 0;
    for (int i = 0; i < 8; ++i) { const int e = conv_list(q, i); if (e < 0) break; n += conv_job_tiles(e & 15) >> 3; }
    return n;
}
__device__ __forceinline__ void conv_strip(const Params& p, int q, int c, LAS float* tl) {
    for (int i = 0; i < 8; ++i) {
        const int e = conv_list(q, i);
        if (e < 0) return;
        const int ns = conv_job_tiles(e & 15) >> 3;
        if (c < ns) { const ConvJob job = conv_job(p, e >> 4, e & 15); convert_tiles(job, c * 8, c * 8 + 8, tl); return; }
        c -= ns;
    }
}

__device__ __forceinline__ void convert_p(const Params& p) {
    const f32x4* pl = (const f32x4*)p.in[1]; u32x2* pb = (u32x2*)(p.ws + WS_PBALL);
    for (int i = BID() * 256 + TID(); i < 2 * NT * 256 / 4; i += gridDim.x * 256) {
        const f32x4 v = pl[i]; u32x2 w; w.x = pk2(v.x, v.y); w.y = pk2(v.z, v.w); pb[i] = w;
    }
}
__device__ __forceinline__ void phase_convert(const Params& p, LAS float* tl) {
    {
        int base = 0;
        for (int j = 0; j < 6; ++j) {
            const ConvJob job = conv_job(p, 0, j);
            const int nt = conv_job_tiles(j);
            const int g = gridDim.x, b = BID();
            int first = (b - base % g + g) % g;
            for (int s = 2 * first; s < nt; s += 2 * g) convert_tiles(job, s, s + 2 < nt ? s + 2 : nt, tl);
            base += nt >> 1;
        }
    }
    {
        const int skip = gridDim.x >= 128 ? 64 : 0;
        const int tid_ = TID(); const int lane = tid_ & 63, gw = (BID() - skip) * 4 + (tid_ >> 6), ngw = (gridDim.x - skip) * 4;
        for (int row = gw >= 0 ? gw : NT; row < NT; row += ngw) {
            const f32x4* xr = (const f32x4*)(p.in[0] + (size_t)row * ND) + lane;
            u32x2* o = (u32x2*)((bf16_t*)p.out + (size_t)row * ND) + lane;
            float ss = 0.f;
#pragma unroll
            for (int j = 0; j < 4; ++j) { const f32x4 v = xr[64 * j]; ss += (v.x * v.x + v.y * v.y) + (v.z * v.z + v.w * v.w); u32x2 w; w.x = pk2(v.x, v.y); w.y = pk2(v.z, v.w); o[64 * j] = w; }
            ss = wave_sum(ss);
            if (lane < 16) ((float*)(p.ws + WS_SSP) + (size_t)NT * 16)[(size_t)row * 16 + lane] = lane == 0 ? ss : 0.f;
        }
    }
    for (int i = BID() * 256 + TID(); i < 2 * 1024 * 32; i += gridDim.x * 256) {
        const int l = i >> 15, k = (i >> 5) & 1023, j = i & 31;
        const float gk = p.in[10][l * ND + k];
        const float wv = j < 4 ? p.in[11][(size_t)(l * ND + k) * 4 + j] : (j < 20 ? p.in[13][(size_t)(l * ND + k) * 16 + (j - 4)] : 0.f);
        ((float*)(p.ws + WS_W + (size_t)l * WL_SIZE + WL_RT))[k * 32 + j] = gk * wv;
    }
    for (int i = BID() * 256 + TID(); i < 16 * 1024; i += gridDim.x * 256) {
        const int part = i >> 10, o = i & 1023, l = o >> 9, kv = (o >> 8) & 1, n = o & 255;
        const float* pos = p.in[9] + (size_t)(l * 2 + kv) * 2048 + part * 128;
        const float* w1 = p.in[kv ? 7 : 5] + (size_t)l * 2048 * 256 + (size_t)part * 128 * 256 + n;
        float s = 0.f;
#pragma unroll 16
        for (int k = 0; k < 128; ++k) s += pos[k] * w1[(size_t)k * 256];
        ((float*)(p.ws + WS_BC1P))[i] = s;
    }
}

__device__ __forceinline__ void phase_norm(const float* x, const float* g, bf16_t* xn) {
    const int tid_ = TID(); const int lane = tid_ & 63, gw = BID() * 4 + (tid_ >> 6), ngw = gridDim.x * 4;
    for (int row = gw; row < NT; row += ngw) {
        const f32x4* xr = (const f32x4*)(x + (size_t)row * ND) + lane;
        f32x4 v[4]; float ss = 0.f;
#pragma unroll
        for (int j = 0; j < 4; ++j) { v[j] = xr[64 * j]; ss += (v[j].x * v[j].x + v[j].y * v[j].y) + (v[j].z * v[j].z + v[j].w * v[j].w); }
        ss = wave_sum(ss);
        const float r = 1.0f / sqrtf(ss * (1.0f / ND) + 1e-6f);
        u32x2* o = (u32x2*)(xn + (size_t)row * ND) + lane;
#pragma unroll
        for (int j = 0; j < 4; ++j) {
            const f32x4 gg = ((const f32x4*)g)[lane + 64 * j];
            u32x2 w; w.x = pk2(v[j].x * r * gg.x, v[j].y * r * gg.y); w.y = pk2(v[j].z * r * gg.z, v[j].w * r * gg.w);
            o[64 * j] = w;
        }
    }
}
__device__ __forceinline__ void phase_final_norm(const bf16_t* xb, float* out, const float* g) {
    const int tid_ = TID(); const int lane = tid_ & 63, gw = BID() * 4 + (tid_ >> 6), ngw = gridDim.x * 4;
    for (int row = gw; row < NT; row += ngw) {
        const u32x2* xr = (const u32x2*)(xb + (size_t)row * ND) + lane;
        f32x4* orow = (f32x4*)(out + (size_t)row * ND) + lane;
        f32x4 v[4]; float ss = 0.f;
#pragma unroll
        for (int j = 0; j < 4; ++j) { const u32x2 w = xr[64 * j]; v[j] = (f32x4){bflo(w.x), bfhi(w.x), bflo(w.y), bfhi(w.y)}; ss += (v[j].x * v[j].x + v[j].y * v[j].y) + (v[j].z * v[j].z + v[j].w * v[j].w); }
        ss = wave_sum(ss);
        const float r = 1.0f / sqrtf(ss * (1.0f / ND) + 1e-6f);
#pragma unroll
        for (int j = 0; j < 4; ++j) {
            const f32x4 gg = ((const f32x4*)g)[lane + 64 * j];
            f32x4 o; o.x = v[j].x * r * gg.x; o.y = v[j].y * r * gg.y; o.z = v[j].z * r * gg.z; o.w = v[j].w * r * gg.w;
            orow[64 * j] = o;
        }
    }
}
typedef float f32x16r __attribute__((ext_vector_type(16)));
__device__ __forceinline__ void phase_route(const bf16_t* x, const float* wr, const float* brg, const float* bre, int* cnt, int* list, float* route, float* rinv, LAS unsigned char* lds) {
    const int tid_ = TID(); const int lane = tid_ & 63, wv = tid_ >> 6;
    const int i = lane & 31, hk = lane >> 5;
    LAS float* tl = (LAS float*)lds + wv * (32 * 33);
    LAS float* ssl = (LAS float*)(lds + 4 * 32 * 33 * 4);
    for (int task = BID(); task < NT / 32; task += gridDim.x) {
        const int row0 = task * 32;
        const bf16_t* xr = x + (size_t)(row0 + i) * ND + wv * 256;
        const float* wp = wr + (size_t)(wv * 256) * 32 + hk * 32 + i;
        f32x16r acc;
#pragma unroll
        for (int q = 0; q < 16; ++q) acc[q] = 0.f;
        float ss = 0.f;
#pragma unroll 8
        for (int k8 = 0; k8 < 32; ++k8) {
            const u32x4 xa = *(const u32x4*)(xr + 8 * k8);
            const float a0 = hk ? bfhi(xa.x) : bflo(xa.x), a1 = hk ? bfhi(xa.y) : bflo(xa.y), a2 = hk ? bfhi(xa.z) : bflo(xa.z), a3 = hk ? bfhi(xa.w) : bflo(xa.w);
            const float* wq = wp + (size_t)(8 * k8) * 32;
            acc = __builtin_amdgcn_mfma_f32_32x32x2f32(a0, wq[0], acc, 0, 0, 0);
            acc = __builtin_amdgcn_mfma_f32_32x32x2f32(a1, wq[2 * 32], acc, 0, 0, 0);
            acc = __builtin_amdgcn_mfma_f32_32x32x2f32(a2, wq[4 * 32], acc, 0, 0, 0);
            acc = __builtin_amdgcn_mfma_f32_32x32x2f32(a3, wq[6 * 32], acc, 0, 0, 0);
            ss += (a0 * a0 + a1 * a1) + (a2 * a2 + a3 * a3);
        }
        ss += __shfl_xor(ss, 32);
#pragma unroll
        for (int q = 0; q < 16; ++q) tl[((q & 3) + 8 * (q >> 2) + 4 * hk) * 33 + i] = acc[q];
        if (hk == 0) ssl[wv * 32 + i] = ss;
        __syncthreads();
        if (wv == 0 && hk == 0) {
            LAS const float* tp0 = (LAS const float*)lds;
            const float sst = (ssl[i] + ssl[32 + i]) + (ssl[64 + i] + ssl[96 + i]);
            const float r = 1.0f / sqrtf(sst * (1.0f / ND) + 1e-6f);
#define RT_SUM(e_) ((tp0[i * 33 + (e_)] + tp0[32 * 33 + i * 33 + (e_)]) + (tp0[2 * 32 * 33 + i * 33 + (e_)] + tp0[3 * 32 * 33 + i * 33 + (e_)]))
            float gl[4], el[16];
#pragma unroll
            for (int e = 0; e < 4; ++e) gl[e] = RT_SUM(e) * r + brg[e];
#pragma unroll
            for (int e = 0; e < 16; ++e) el[e] = RT_SUM(4 + e) * r + bre[e];
#undef RT_SUM
            int gsel = 0; float gmax = gl[0];
#pragma unroll
            for (int e = 1; e < 4; ++e) if (gl[e] > gmax) { gmax = gl[e]; gsel = e; }
            float gden = 0.f;
#pragma unroll
            for (int e = 0; e < 4; ++e) gden += __expf(gl[e] - gmax);
            const float gw_ = 1.0f / gden;
            float wi[4];
#pragma unroll
            for (int e = 0; e < 4; ++e) wi[e] = gsel == 0 ? el[e] : (gsel == 1 ? el[4 + e] : (gsel == 2 ? el[8 + e] : el[12 + e]));
            int i0 = 0; float t0 = wi[0];
#pragma unroll
            for (int e = 1; e < 4; ++e) if (wi[e] > t0) { t0 = wi[e]; i0 = e; }
            int i1 = -1; float t1 = -3.0e38f;
#pragma unroll
            for (int e = 0; e < 4; ++e) if (e != i0 && wi[e] > t1) { t1 = wi[e]; i1 = e; }
            const float ex = __expf(t1 - t0);
            const float ew0 = gw_ / (1.0f + ex), ew1 = gw_ * ex / (1.0f + ex);
            const int lo = i0 < i1 ? i0 : i1, hi = i0 < i1 ? i1 : i0;
            const float wlo = i0 < i1 ? ew0 : ew1, whi = i0 < i1 ? ew1 : ew0;
            const int pidx = lo == 0 ? hi - 1 : (lo == 1 ? hi + 1 : 5);
            const int bucket = gsel * 6 + pidx;
            const int row = row0 + i;
            unsigned long long mymask = 0ull;
            for (int bb = 0; bb < 24; ++bb) { const unsigned long long mm = __ballot(bucket == bb); if (bucket == bb) mymask = mm; }
            const int leader = __builtin_ctzll(mymask);
            int base = 0;
            if (lane == leader) base = atomicAdd(cnt + 64 * bucket, __builtin_popcountll(mymask));
            base = __shfl(base, leader);
            const int pos = base + __builtin_popcountll(mymask & ((1ull << lane) - 1ull));
            list[(size_t)bucket * NT + pos] = row;
            route[2 * row] = wlo; route[2 * row + 1] = whi;
            rinv[row] = r;
        }
        __syncthreads();
    }
}

struct APlain { const bf16_t* base; int ld; __device__ __forceinline__ const bf16_t* operator()(int r) const { return base + (size_t)r * ld; } };
struct ACmp { const bf16_t* base; __device__ __forceinline__ const bf16_t* operator()(int r) const { return base + (size_t)(r < 126 ? r : 126) * 1024; } };
struct AGather { const bf16_t* xn; const int* list; int cnt; __device__ __forceinline__ const bf16_t* operator()(int r) const { return xn + (size_t)(r < cnt ? list[r] : 0) * ND; } };
struct BPlain { const bf16_t* base; int ld; __device__ __forceinline__ const bf16_t* operator()(int r, int k0) const { return base + (size_t)r * ld + k0; } };
struct BSplit { const bf16_t* b0; const bf16_t* b1; __device__ __forceinline__ const bf16_t* operator()(int r, int k0) const { return k0 < 512 ? b0 + (size_t)r * 512 + k0 : b1 + (size_t)r * 512 + (k0 - 512); } };

template <bool PERM, class AP, class BP, class APN, class BPN>
__device__ __forceinline__ void gemm_kloop(f32x4 (&acc)[4][4], const AP& ap, const BP& bp, int K, LAS unsigned char* lds, bool prefetched, bool has_next, const APN& apn, const BPN& bpn) {
    const int tid = TID(), wid = tid >> 6, lane = tid & 63, wr = wid >> 1, wc = wid & 1, fr = lane & 15, fq = lane >> 4;
#if NAIVE_GEMM
    for (int k0 = 0; k0 < K; k0 += 32) {
#pragma unroll
        for (int m = 0; m < 4; ++m) {
            const bf16_t* arow = ap(wr * 64 + m * 16 + fr) + k0;
            u32x4 av[4];
#pragma unroll
            for (int c = 0; c < 4; ++c) av[c] = ((const u32x4*)arow)[c];
#pragma unroll
            for (int n = 0; n < 4; ++n)
#pragma unroll
                for (int j = 0; j < 4; ++j) {
                    const bf16_t* brow = bp(wc * 64 + n * 16 + 4 * fq + j, k0);
                    float s = 0.f;
#pragma unroll
                    for (int c = 0; c < 4; ++c) {
                        const u32x4 bv = ((const u32x4*)brow)[c];
                        s += bflo(av[c].x) * bflo(bv.x) + bfhi(av[c].x) * bfhi(bv.x) + bflo(av[c].y) * bflo(bv.y) + bfhi(av[c].y) * bfhi(bv.y)
                           + bflo(av[c].z) * bflo(bv.z) + bfhi(av[c].z) * bfhi(bv.z) + bflo(av[c].w) * bflo(bv.w) + bfhi(av[c].w) * bfhi(bv.w);
                    }
                    acc[m][n][j] += s;
                }
        }
    }
#else
    const unsigned woff = (unsigned)wid * 1024u;
    const bf16_t* aptr[4]; int brow[4], bcol;
    {
        const int sb = lane * 16, swz = sb ^ (((sb >> 9) & 1) << 5);
        const int rl = swz >> 6, cc = (wid & 1) * 32 + ((swz & 63) >> 1);
        bcol = cc;
#pragma unroll
        for (int i = 0; i < 4; ++i) { const int R = ((wid >> 1) + 2 * i) * 16 + rl; aptr[i] = ap(R) + cc; brow[i] = R; }
    }
    int aoff[4], boff[4];
#pragma unroll
    for (int m = 0; m < 4; ++m) {
        { const int r = wr * 64 + m * 16 + fr, c = fq * 8, st = (r >> 4) * 2, ob = (r & 15) * 64 + c * 2; aoff[m] = st * 1024 + (ob ^ (((ob >> 9) & 1) << 5)); }
        { const int r = PERM ? wc * 64 + 32 * (m >> 1) + 8 * (fr >> 2) + 4 * (m & 1) + (fr & 3) : wc * 64 + m * 16 + fr;
          const int c = fq * 8, st = (r >> 4) * 2, ob = (r & 15) * 64 + c * 2; boff[m] = st * 1024 + (ob ^ (((ob >> 9) & 1) << 5)); }
    }
    const int nk = K / 64;
#define GT_STAGE(buf, t) do { const int _k0 = (t) * 64; LAS unsigned char* _ba = lds + (buf) * 32768 + woff; \
        _Pragma("unroll") for (int _i = 0; _i < 4; ++_i) { \
            __builtin_amdgcn_global_load_lds((const unsigned*)(aptr[_i] + _k0), (LAS unsigned*)(_ba + _i * 4096), 16, 0, 0); \
            __builtin_amdgcn_global_load_lds((const unsigned*)(bp(brow[_i], _k0) + bcol), (LAS unsigned*)(_ba + 16384 + _i * 4096), 16, 0, 0); } } while (0)
    if (!prefetched) GT_STAGE(0, 0);
#pragma unroll 1
    for (int t = 0; t < nk; ++t) {
        asm volatile("s_waitcnt vmcnt(0)" ::: "memory");
        __syncthreads();
        if (t + 1 < nk) GT_STAGE((t + 1) & 1, t + 1);
        else if (has_next) {
            LAS unsigned char* _ba = lds + woff;
#pragma unroll
            for (int _i = 0; _i < 4; ++_i) {
                __builtin_amdgcn_global_load_lds((const unsigned*)(apn(brow[_i]) + bcol), (LAS unsigned*)(_ba + _i * 4096), 16, 0, 0);
                __builtin_amdgcn_global_load_lds((const unsigned*)(bpn(brow[_i], 0) + bcol), (LAS unsigned*)(_ba + 16384 + _i * 4096), 16, 0, 0);
            }
        }
        LAS const unsigned char* la = lds + (t & 1) * 32768;
        LAS const unsigned char* lb = la + 16384;
        bf16x8 At[2][4], Bt[2][4];
#pragma unroll
        for (int kh = 0; kh < 2; ++kh) {
#pragma unroll
            for (int m = 0; m < 4; ++m) At[kh][m] = *(const LAS bf16x8*)(la + aoff[m] + kh * 1024);
#pragma unroll
            for (int n = 0; n < 4; ++n) Bt[kh][n] = *(const LAS bf16x8*)(lb + boff[n] + kh * 1024);
        }
#pragma unroll
        for (int kh = 0; kh < 2; ++kh)
#pragma unroll
            for (int m = 0; m < 4; ++m)
#pragma unroll
                for (int n = 0; n < 4; ++n) acc[m][n] = __builtin_amdgcn_mfma_f32_16x16x32_bf16(Bt[kh][n], At[kh][m], acc[m][n], 0, 0, 0);
    }
#undef GT_STAGE
#endif
}
__device__ __forceinline__ void zero_acc(f32x4 (&acc)[4][4]) {
#pragma unroll
    for (int m = 0; m < 4; ++m)
#pragma unroll
        for (int n = 0; n < 4; ++n) acc[m][n] = (f32x4){0.f, 0.f, 0.f, 0.f};
}
template <class AP, class BP, class EPI>
__device__ __forceinline__ void gemm_tile(const AP& ap, const BP& bp, int K, const EPI& epi, LAS unsigned char* lds, bool prefetched, bool has_next, const AP& apn, const BP& bpn) {
    const int tid = TID(), wid = tid >> 6, lane = tid & 63, wr = wid >> 1, wc = wid & 1, fr = lane & 15, fq = lane >> 4;
    f32x4 acc[4][4]; zero_acc(acc);
    gemm_kloop<EPI::PERM>(acc, ap, bp, K, lds, prefetched, has_next, apn, bpn);
    epi(acc, wr, wc, fr, fq);
}

__device__ __forceinline__ float rinv_from_ssp(const float* ssp, int row) {
    const f32x4* q = (const f32x4*)(ssp + (size_t)row * 16);
    const f32x4 a = q[0], b = q[1], c = q[2], d = q[3];
    const float s = ((a.x + a.y) + (a.z + a.w)) + ((b.x + b.y) + (b.z + b.w)) + ((c.x + c.y) + (c.z + c.w)) + ((d.x + d.y) + (d.z + d.w));
    return 1.0f / sqrtf(s * (1.0f / ND) + 1e-6f);
}
__device__ __forceinline__ float row_ss64(const f32x4& a, const f32x4& b, const f32x4& c, const f32x4& d) {
    float s = ((a.x * a.x + a.y * a.y) + (a.z * a.z + a.w * a.w)) + ((b.x * b.x + b.y * b.y) + (b.z * b.z + b.w * b.w))
            + ((c.x * c.x + c.y * c.y) + (c.z * c.z + c.w * c.w)) + ((d.x * d.x + d.y * d.y) + (d.z * d.z + d.w * d.w));
    s += __shfl_xor(s, 16); s += __shfl_xor(s, 32);
    return s;
}
constexpr int EPS_OFF = 32768, EPS_RS = 272;
struct EpiInProj {
    static constexpr bool PERM = false;
    int mt, nt; unsigned char* ws; const float* ssp; LAS unsigned char* lds;
    __device__ __forceinline__ void operator()(const f32x4 (&acc)[4][4], int wr, int wc, int fr, int fq) const {
        if (nt >= 22) {
#pragma unroll
            for (int m = 0; m < 4; ++m) {
                const int row = mt * 128 + wr * 64 + m * 16 + fr;
                const float rr = rinv_from_ssp(ssp, row);
#pragma unroll
                for (int n = 0; n < 4; ++n) {
                    const int col = wc * 64 + n * 16 + 4 * fq;
                    if (col < 24) {
                        const f32x4 v = acc[m][n] * rr;
                        f32x4 o; o.x = sigmoidf_(v.x); o.y = sigmoidf_(v.y); o.z = sigmoidf_(v.z); o.w = sigmoidf_(v.w);
                        *(f32x4*)((float*)(ws + WS_GATES) + (size_t)row * 24 + col) = o;
                    }
                }
            }
            return;
        }
        const int reg = nt >> 2;
        const float sc = (nt < 16 && (reg == 0 || reg == 3)) ? 0.125f * 1.4426950408889634f : 1.0f;
        LAS unsigned char* st = lds + EPS_OFF;
        __syncthreads();
#pragma unroll
        for (int m = 0; m < 4; ++m) {
            const int r = wr * 64 + m * 16 + fr;
            const float rs = rinv_from_ssp(ssp, mt * 128 + r) * sc;
#pragma unroll
            for (int n = 0; n < 4; ++n) {
                const f32x4 v = acc[m][n] * rs;
                u32x2 w; w.x = pk2(v.x, v.y); w.y = pk2(v.z, v.w);
                *(LAS u32x2*)(st + r * EPS_RS + (wc * 64 + n * 16 + 4 * fq) * 2) = w;
            }
        }
        __syncthreads();
        const int tid = (wr * 2 + wc) * 64 + fq * 16 + fr;
#pragma unroll
        for (int i = 0; i < 8; ++i) {
            const int q = tid + 256 * i, r = q >> 4, ch = q & 15, col = ch * 8;
            const u32x4 v = *(const LAS u32x4*)(st + r * EPS_RS + ch * 16);
            const int row = mt * 128 + r, b = row >> 11, s = row & 2047;
            bf16_t* dst;
            if (nt < 16) { const int c = (nt & 3) * 128 + col, head = c >> 6, d = c & 63; dst = (bf16_t*)(ws + WS_QA + (size_t)reg * 16 * MiB) + ((size_t)((b * 8 + head) * NS + s) * 64 + d); }
            else { const int g = col >> 6, d = col & 63; dst = (bf16_t*)(ws + WS_KV6 + (size_t)(nt - 16) * 4 * MiB) + ((size_t)((b * 2 + g) * NS + s) * 64 + d); }
            *(u32x4*)dst = v;
        }
    }
};
struct EpiCmp1 {
    static constexpr bool PERM = false;
    bf16_t* hc; const float* bc1; int row0, col0;
    __device__ __forceinline__ void operator()(const f32x4 (&acc)[4][4], int wr, int wc, int fr, int fq) const {
#pragma unroll
        for (int m = 0; m < 4; ++m) {
            const int row = row0 + wr * 64 + m * 16 + fr;
#pragma unroll
            for (int n = 0; n < 4; ++n) {
                const int col = col0 + wc * 64 + n * 16 + 4 * fq;
                f32x4 bb = *(const f32x4*)(bc1 + col);
#pragma unroll
                for (int pp = 1; pp < 16; ++pp) bb += *(const f32x4*)(bc1 + pp * 1024 + col);
                const f32x4 v = acc[m][n];
                u32x2 w; w.x = pk2(gelu_tanh(v.x + bb.x), gelu_tanh(v.y + bb.y)); w.y = pk2(gelu_tanh(v.z + bb.z), gelu_tanh(v.w + bb.w));
                *(u32x2*)(hc + (size_t)row * 256 + col) = w;
            }
        }
    }
};
struct EpiCmp2 {
    static constexpr bool PERM = false;
    bf16_t* dst; int row0;
    __device__ __forceinline__ void operator()(const f32x4 (&acc)[4][4], int wr, int wc, int fr, int fq) const {
        if (wc != 0) return;
#pragma unroll
        for (int m = 0; m < 4; ++m) {
            const int row = row0 + wr * 64 + m * 16 + fr;
#pragma unroll
            for (int n = 0; n < 4; ++n) {
                const int col = n * 16 + 4 * fq;
                const f32x4 v = acc[m][n];
                u32x2 w; w.x = pk2(v.x, v.y); w.y = pk2(v.z, v.w);
                *(u32x2*)(dst + (size_t)row * 64 + col) = w;
            }
        }
    }
};
struct EpiResAdd {
    static constexpr bool PERM = true;
    bf16_t* res; int row0, col0;
    __device__ __forceinline__ void operator()(const f32x4 (&acc)[4][4], int wr, int wc, int fr, int fq) const {
#pragma unroll
        for (int m = 0; m < 4; ++m) {
            const int row = row0 + wr * 64 + m * 16 + fr;
#pragma unroll
            for (int pp = 0; pp < 2; ++pp) {
                const int col = col0 + wc * 64 + 32 * pp + 8 * fq;
                u32x4* q = (u32x4*)(res + (size_t)row * ND + col);
                const u32x4 b = *q; const f32x4 a = acc[m][2 * pp], c = acc[m][2 * pp + 1];
                u32x4 w; w.x = pk2(bflo(b.x) + a.x, bfhi(b.x) + a.y); w.y = pk2(bflo(b.y) + a.z, bfhi(b.y) + a.w);
                w.z = pk2(bflo(b.z) + c.x, bfhi(b.z) + c.y); w.w = pk2(bflo(b.w) + c.z, bfhi(b.w) + c.w);
                *q = w;
            }
        }
    }
};
struct EpiMoeGU {
    static constexpr bool PERM = false;
    bf16_t* hid; const int* list; const float* route; const float* rinv; int cnt, hrow0, nt16;
    __device__ __forceinline__ void operator()(const f32x4 (&acc)[4][4], int wr, int wc, int fr, int fq) const {
        const int half = nt16 >> 3, nte = nt16 & 7;
#pragma unroll
        for (int m = 0; m < 4; ++m) {
            const int r = wr * 64 + m * 16 + fr;
            const int tok = r < cnt ? list[r] : 0;
            const float w = r < cnt ? route[2 * tok + half] : 0.f;
            const float rt = rinv[tok];
#pragma unroll
            for (int pr = 0; pr < 2; ++pr) {
                const f32x4 gv = acc[m][2 * pr], uv = acc[m][2 * pr + 1];
                const int hc = half * 512 + (4 * nte + 2 * wc + pr) * 16 + 4 * fq;
                float h[4];
#pragma unroll
                for (int j = 0; j < 4; ++j) { const float gg = gv[j] * rt; h[j] = gg / (1.0f + __expf(-gg)) * (uv[j] * rt) * w; }
                u32x2 o; o.x = pk2(h[0], h[1]); o.y = pk2(h[2], h[3]);
                *(u32x2*)(hid + (size_t)(hrow0 + r) * 1024 + hc) = o;
            }
        }
    }
};
struct EpiMoeDown {
    static constexpr bool PERM = true;
    bf16_t* res; const int* list; float* ssp; int cnt, col0;
    __device__ __forceinline__ void operator()(const f32x4 (&acc)[4][4], int wr, int wc, int fr, int fq) const {
#pragma unroll
        for (int m = 0; m < 4; ++m) {
            const int r = wr * 64 + m * 16 + fr;
            const bool ok = r < cnt;
            const int tok = ok ? list[r] : 0;
            f32x4 nv[4];
#pragma unroll
            for (int pp = 0; pp < 2; ++pp) {
                const int col = col0 + wc * 64 + 32 * pp + 8 * fq;
                u32x4* q = (u32x4*)(res + (size_t)tok * ND + col);
                const u32x4 b = *q; const f32x4 a = acc[m][2 * pp], c = acc[m][2 * pp + 1];
                nv[2 * pp] = (f32x4){bflo(b.x) + a.x, bfhi(b.x) + a.y, bflo(b.y) + a.z, bfhi(b.y) + a.w};
                nv[2 * pp + 1] = (f32x4){bflo(b.z) + c.x, bfhi(b.z) + c.y, bflo(b.w) + c.z, bfhi(b.w) + c.w};
                if (ok) { u32x4 w; w.x = pk2(nv[2 * pp].x, nv[2 * pp].y); w.y = pk2(nv[2 * pp].z, nv[2 * pp].w); w.z = pk2(nv[2 * pp + 1].x, nv[2 * pp + 1].y); w.w = pk2(nv[2 * pp + 1].z, nv[2 * pp + 1].w); *q = w; }
            }
            const float ps = row_ss64(nv[0], nv[1], nv[2], nv[3]);
            if (ok && fq == 0) ssp[(size_t)tok * 16 + (col0 >> 6) + wc] = ps;
        }
    }
};
struct EpiBf16 {
    static constexpr bool PERM = false;
    bf16_t* dst; int ld, row0, col0;
    __device__ __forceinline__ void operator()(const f32x4 (&acc)[4][4], int wr, int wc, int fr, int fq) const {
#pragma unroll
        for (int m = 0; m < 4; ++m) {
            const int row = row0 + wr * 64 + m * 16 + fr;
#pragma unroll
            for (int n = 0; n < 4; ++n) {
                const int col = col0 + wc * 64 + n * 16 + 4 * fq;
                const f32x4 v = acc[m][n];
                u32x2 w; w.x = pk2(v.x, v.y); w.y = pk2(v.z, v.w);
                *(u32x2*)(dst + (size_t)row * ld + col) = w;
            }
        }
    }
};
struct EpiPleFused {
    const bf16_t* rin; const float* ssp_in; bf16_t* rout; float* ssp_out; int row0, col0;
    __device__ __forceinline__ void operator()(const f32x4 (&acc)[4][4], const f32x4 (&acc2)[4][4], int wr, int wc, int fr, int fq) const {
#pragma unroll
        for (int m = 0; m < 4; ++m) {
            const int row = row0 + wr * 64 + m * 16 + fr;
            const float rr = rinv_from_ssp(ssp_in, row);
            f32x4 nv[4];
#pragma unroll
            for (int pp = 0; pp < 2; ++pp) {
                const int col = col0 + wc * 64 + 32 * pp + 8 * fq;
                const size_t off = (size_t)row * ND + col;
                const u32x4 b = *(const u32x4*)(rin + off);
                const f32x4 v0 = acc[m][2 * pp] * rr, q0 = acc2[m][2 * pp], v1 = acc[m][2 * pp + 1] * rr, q1 = acc2[m][2 * pp + 1];
                f32x4 o0 = (f32x4){bflo(b.x), bfhi(b.x), bflo(b.y), bfhi(b.y)}, o1 = (f32x4){bflo(b.z), bfhi(b.z), bflo(b.w), bfhi(b.w)};
                o0.x += sigmoidf_(v0.x) * q0.x; o0.y += sigmoidf_(v0.y) * q0.y; o0.z += sigmoidf_(v0.z) * q0.z; o0.w += sigmoidf_(v0.w) * q0.w;
                o1.x += sigmoidf_(v1.x) * q1.x; o1.y += sigmoidf_(v1.y) * q1.y; o1.z += sigmoidf_(v1.z) * q1.z; o1.w += sigmoidf_(v1.w) * q1.w;
                u32x4 w; w.x = pk2(o0.x, o0.y); w.y = pk2(o0.z, o0.w); w.z = pk2(o1.x, o1.y); w.w = pk2(o1.z, o1.w);
                *(u32x4*)(rout + off) = w;
                nv[2 * pp] = o0; nv[2 * pp + 1] = o1;
            }
            const float ps = row_ss64(nv[0], nv[1], nv[2], nv[3]);
            if (fq == 0) ssp_out[(size_t)row * 16 + (col0 >> 6) + wc] = ps;
        }
    }
};
struct EpiPleGate {
    static constexpr bool PERM = false;
    float* out; const bf16_t* p2; int row0, col0; float sc;
    __device__ __forceinline__ void operator()(const f32x4 (&acc)[4][4], int wr, int wc, int fr, int fq) const {
#pragma unroll
        for (int m = 0; m < 4; ++m) {
            const int row = row0 + wr * 64 + m * 16 + fr;
#pragma unroll
            for (int n = 0; n < 4; ++n) {
                const int col = col0 + wc * 64 + n * 16 + 4 * fq;
                const size_t off = (size_t)row * ND + col;
                const u32x2 pv = *(const u32x2*)(p2 + off);
                const f32x4 v = acc[m][n];
                f32x4 o = *(const f32x4*)(out + off);
                o.x += sc * sigmoidf_(v.x) * bflo(pv.x); o.y += sc * sigmoidf_(v.y) * bfhi(pv.x); o.z += sc * sigmoidf_(v.z) * bflo(pv.y); o.w += sc * sigmoidf_(v.w) * bfhi(pv.y);
                *(f32x4*)(out + off) = o;
            }
        }
    }
};

template <class PH, class AP, class BP, class EPI>
__device__ __forceinline__ void gemm_stream(const PH& ph, int first, int step, int count, int K, LAS unsigned char* lds) {
    int q = first;
    if (q >= count) return;
    AP ap, apn; BP bp, bpn; EPI ep, epn;
    ph.make(q, ap, bp, ep);
    bool pref = false;
    for (;;) {
        const int qn = q + step; const bool hn = qn < count;
        if (hn) ph.make(qn, apn, bpn, epn); else { apn = ap; bpn = bp; epn = ep; }
        gemm_tile(ap, bp, K, ep, lds, pref, hn, apn, bpn);
        if (!hn) break;
        ap = apn; bp = bpn; ep = epn; q = qn; pref = true;
    }
}

__device__ __forceinline__ void load_q32(const bf16_t* p, float* q) {
#pragma unroll
    for (int c = 0; c < 4; ++c) {
        const u32x4 v = ((const u32x4*)p)[c];
        q[8 * c] = bflo(v.x); q[8 * c + 1] = bfhi(v.x); q[8 * c + 2] = bflo(v.y); q[8 * c + 3] = bfhi(v.y);
        q[8 * c + 4] = bflo(v.z); q[8 * c + 5] = bfhi(v.z); q[8 * c + 6] = bflo(v.w); q[8 * c + 7] = bfhi(v.w);
    }
}
__device__ __forceinline__ float dot32p(const float* q, const bf16_t* k) {
    float s0 = 0.f, s1 = 0.f;
#pragma unroll
    for (int c = 0; c < 4; ++c) {
        const u32x4 v = ((const u32x4*)k)[c];
        s0 += q[8 * c] * bflo(v.x); s1 += q[8 * c + 1] * bfhi(v.x); s0 += q[8 * c + 2] * bflo(v.y); s1 += q[8 * c + 3] * bfhi(v.y);
        s0 += q[8 * c + 4] * bflo(v.z); s1 += q[8 * c + 5] * bfhi(v.z); s0 += q[8 * c + 6] * bflo(v.w); s1 += q[8 * c + 7] * bfhi(v.w);
    }
    const float s = s0 + s1;
    return s + __shfl_xor(s, 1);
}
__device__ __forceinline__ void axpy32(float* a, float p, const bf16_t* vr) {
#pragma unroll
    for (int c = 0; c < 4; ++c) {
        const u32x4 v = ((const u32x4*)vr)[c];
        a[8 * c] += p * bflo(v.x); a[8 * c + 1] += p * bfhi(v.x); a[8 * c + 2] += p * bflo(v.y); a[8 * c + 3] += p * bfhi(v.y);
        a[8 * c + 4] += p * bflo(v.z); a[8 * c + 5] += p * bfhi(v.z); a[8 * c + 6] += p * bflo(v.w); a[8 * c + 7] += p * bfhi(v.w);
    }
}
#define ONLINE_STEP(s_, vrow_) do { const float _s = (s_); if (_s > mx) { const float _c = __expf(mx - _s); l *= _c; _Pragma("unroll") for (int _i = 0; _i < 32; ++_i) acc[_i] *= _c; mx = _s; } \
    const float _p = __expf(_s - mx); l += _p; axpy32(acc, _p, (vrow_)); } while (0)

__device__ __forceinline__ void store_o32(bf16_t* dst, const float* a, float sc) {
#pragma unroll
    for (int c = 0; c < 4; ++c) {
        u32x4 w; w.x = pk2(a[8 * c] * sc, a[8 * c + 1] * sc); w.y = pk2(a[8 * c + 2] * sc, a[8 * c + 3] * sc);
        w.z = pk2(a[8 * c + 4] * sc, a[8 * c + 5] * sc); w.w = pk2(a[8 * c + 6] * sc, a[8 * c + 7] * sc);
        ((u32x4*)dst)[c] = w;
    }
}

__device__ __forceinline__ void attn_dilated_naive(const unsigned char* ws, int gtid, int gthreads) {
    asm volatile("" : "+v"(gtid));
    const bf16_t* qa = (const bf16_t*)(ws + WS_QA); const bf16_t* ka = (const bf16_t*)(ws + WS_KA); const bf16_t* va = (const bf16_t*)(ws + WS_VA);
    bf16_t* ob = (bf16_t*)(ws + WS_O);
    for (int id2 = gtid; id2 < NB * 8 * NS * 2; id2 += gthreads) {
        const int idx = id2 >> 1, hf = (id2 & 1) * 32;
        const int t = idx & 2047, bh = idx >> 11, h = bh & 7, b = bh >> 3;
        float q[32]; load_q32(qa + (size_t)idx * 64 + hf, q);
        const bf16_t* kb = ka + (size_t)bh * NS * 64 + hf; const bf16_t* vb = va + (size_t)bh * NS * 64 + hf;
        const float slope = exp2f(-((float)h + 0.5f));
        float mx = -1e30f, l = 0.f; float acc[32];
#pragma unroll
        for (int i = 0; i < 32; ++i) acc[i] = 0.f;
#pragma unroll 1
        for (int pat = 0; pat < 3; ++pat) {
            const int dil = pat == 0 ? 1 : (pat == 1 ? 4 : 16);
#pragma unroll 1
            for (int j = 0; j <= 128; ++j) {
                const int dist = j * dil, pos = t - dist;
                if (pos < 0) break;
                const float s = dot32p(q, kb + (size_t)pos * 64) - slope * (float)dist;
                ONLINE_STEP(s, vb + (size_t)pos * 64);
            }
        }
        store_o32(ob + ((size_t)(b * NS + t) * ND + h * 64 + hf), acc, 1.0f / l);
    }
}

__device__ __forceinline__ void nsa_imp_naive(const unsigned char* ws, int gtid, int gthreads) {
    asm volatile("" : "+v"(gtid));
    const bf16_t* qb = (const bf16_t*)(ws + WS_QB); const bf16_t* kcmp = (const bf16_t*)(ws + WS_KCMP);
    float* imph = (float*)(ws + WS_IMPH);
    for (int id2 = gtid; id2 < NB * 8 * NS * 2; id2 += gthreads) {
        const int idx = id2 >> 1, hf = (id2 & 1) * 32;
        const int t = idx & 2047, bh = idx >> 11, hb = bh & 7, b = bh >> 3, g = hb >> 2;
        float q[32]; load_q32(qb + (size_t)idx * 64 + hf, q);
        const bf16_t* kc = kcmp + (size_t)(b * 2 + g) * 128 * 64 + hf;
        const float slope = exp2f(-(float)(hb + 1));
        const int ncv = t >= 31 ? ((t - 31) >> 4) + 1 : 0;
        float mx = -1e30f;
#pragma unroll 1
        for (int c = 0; c < ncv; ++c) { const float s = dot32p(q, kc + c * 64) - slope * (float)(t - (16 * c + 31)); mx = fmaxf(mx, s); }
        float den = 0.f;
#pragma unroll 1
        for (int c = 0; c < ncv; ++c) { const float s = dot32p(q, kc + c * 64) - slope * (float)(t - (16 * c + 31)); den += __expf(s - mx); }
        const float inv = ncv > 0 ? 1.0f / den : 0.f;
#pragma unroll 1
        for (int n = 0; n < 32; ++n) {
            float imp = 0.f;
#pragma unroll 1
            for (int j = -1; j <= 3; ++j) {
                const int c = 4 * n + j;
                if (c >= 0 && c < ncv) {
                    const float s = dot32p(q, kc + c * 64) - slope * (float)(t - (16 * c + 31));
                    const float pp = __expf(s - mx) * inv;
                    imp += (j == -1 || j == 3) ? 0.5f * pp : pp;
                }
            }
            if (hf == 0) imph[(size_t)idx * 32 + n] = imp;
        }
    }
}
__device__ __forceinline__ void nsa_select(const unsigned char* ws, unsigned* maskbuf) {
    const float* imph = (const float*)(ws + WS_IMPH);
    const int tid_ = TID(); const int lane = tid_ & 63, gw = BID() * 4 + (tid_ >> 6), ngw = gridDim.x * 4;
    for (int it = gw; it < NB * 2 * NS / 2; it += ngw) {
        const int item = it * 2 + (lane >> 5), t = item & 2047, bg = item >> 11, n = lane & 31;
        float imp = 0.f;
#pragma unroll
        for (int r = 0; r < 4; ++r) imp += imph[((size_t)(bg * 4 + r) * NS + t) * 32 + n];
        const int cur = t >> 6;
        const bool valid = n <= cur;
        const bool forced = (n == 0) || (cur - n < 2);
        const float score = valid ? imp + (forced ? 1e4f : 0.f) : -1e30f;
        int rank = 0;
        for (int m = 0; m < 32; ++m) {
            const float sm = __shfl(score, (lane & 32) | m);
            rank += (sm > score || (sm == score && m < n)) ? 1 : 0;
        }
        const bool sel = valid && rank < 16;
        const unsigned long long bal = __ballot(sel);
        if (n == 0) maskbuf[item] = (lane >> 5) ? (unsigned)(bal >> 32) : (unsigned)bal;
    }
}
__device__ __forceinline__ void nsa_attn_naive(const unsigned char* ws, int gtid, int gthreads) {
    asm volatile("" : "+v"(gtid));
    const bf16_t* qb = (const bf16_t*)(ws + WS_QB);
    const bf16_t* kcmp = (const bf16_t*)(ws + WS_KCMP); const bf16_t* vcmp = kcmp + (size_t)16 * 128 * 64;
    const bf16_t* ksb = (const bf16_t*)(ws + WS_KV6 + 2 * 4 * MiB); const bf16_t* vsb = (const bf16_t*)(ws + WS_KV6 + 3 * 4 * MiB);
    const bf16_t* kwb = (const bf16_t*)(ws + WS_KV6 + 4 * 4 * MiB); const bf16_t* vwb = (const bf16_t*)(ws + WS_KV6 + 5 * 4 * MiB);
    const float* gates = (const float*)(ws + WS_GATES);
    const unsigned* maskbuf = (const unsigned*)(ws + WS_MASK);
    bf16_t* ob = (bf16_t*)(ws + WS_O);
    for (int id2 = gtid; id2 < NB * 8 * NS * 2; id2 += gthreads) {
        const int idx = id2 >> 1, hf = (id2 & 1) * 32;
        const int t = idx & 2047, bh = idx >> 11, hb = bh & 7, b = bh >> 3, g = hb >> 2, bg = b * 2 + g;
        float q[32]; load_q32(qb + (size_t)idx * 64 + hf, q);
        const float slope = exp2f(-(float)(hb + 1));
        const float* gt = gates + (size_t)(b * NS + t) * 24 + hb * 3;
        float tot[32], acc[32];
#pragma unroll
        for (int i = 0; i < 32; ++i) tot[i] = 0.f;
        {
            const bf16_t* kc = kcmp + (size_t)bg * 128 * 64 + hf; const bf16_t* vc = vcmp + (size_t)bg * 128 * 64 + hf;
            const int ncv = t >= 31 ? ((t - 31) >> 4) + 1 : 0;
            if (ncv > 0) {
                float mx = -1e30f, l = 0.f;
#pragma unroll
                for (int i = 0; i < 32; ++i) acc[i] = 0.f;
#pragma unroll 1
                for (int c = 0; c < ncv; ++c) { const float s = dot32p(q, kc + c * 64) - slope * (float)(t - (16 * c + 31)); ONLINE_STEP(s, vc + c * 64); }
                const float sc = gt[0] / l;
#pragma unroll
                for (int i = 0; i < 32; ++i) tot[i] += sc * acc[i];
            }
        }
        {
            const bf16_t* kb = ksb + (size_t)bg * NS * 64 + hf; const bf16_t* vb = vsb + (size_t)bg * NS * 64 + hf;
            const unsigned mask = maskbuf[bg * NS + t];
            float mx = -1e30f, l = 0.f;
#pragma unroll
            for (int i = 0; i < 32; ++i) acc[i] = 0.f;
#pragma unroll 1
            for (int n = 0; n < 32; ++n) {
                if (!((mask >> n) & 1u)) continue;
#pragma unroll 1
                for (int i = 0; i < 64; ++i) {
                    const int pos = n * 64 + i;
                    if (pos > t) break;
                    const float s = dot32p(q, kb + (size_t)pos * 64) - slope * (float)(t - pos);
                    ONLINE_STEP(s, vb + (size_t)pos * 64);
                }
            }
            const float sc = gt[1] / l;
#pragma unroll
            for (int i = 0; i < 32; ++i) tot[i] += sc * acc[i];
        }
        {
            const bf16_t* kb = kwb + (size_t)bg * NS * 64 + hf; const bf16_t* vb = vwb + (size_t)bg * NS * 64 + hf;
            float mx = -1e30f, l = 0.f;
#pragma unroll
            for (int i = 0; i < 32; ++i) acc[i] = 0.f;
#pragma unroll 1
            for (int dist = 0; dist < 512; ++dist) {
                const int pos = t - dist;
                if (pos < 0) break;
                const float s = dot32p(q, kb + (size_t)pos * 64) - slope * (float)dist;
                ONLINE_STEP(s, vb + (size_t)pos * 64);
            }
            const float sc = gt[2] / l;
#pragma unroll
            for (int i = 0; i < 32; ++i) tot[i] += sc * acc[i];
        }
        store_o32(ob + ((size_t)(b * NS + t) * ND + 512 + hb * 64 + hf), tot, 1.0f);
    }
}

constexpr int KVS = 144;
constexpr int KVT = 64 * KVS;
constexpr int VS = 128;
constexpr int VT = 64 * VS;
#define LOG2E_F 1.4426950408889634f
__device__ __forceinline__ s16x4 vtr(LAS const unsigned char* p) { return __builtin_bit_cast(s16x4, __builtin_amdgcn_ds_read_tr16_b64_v4i16((LAS s16x4*)p)); }
__device__ __forceinline__ f32x16 zero16() { f32x16 z;
#pragma unroll
    for (int i = 0; i < 16; ++i) z[i] = 0.f;
    return z; }

__device__ __forceinline__ void load_kv_tile(LAS unsigned char* Kt, LAS unsigned char* Vt, const bf16_t* kbase, const bf16_t* vbase, int row0, int rstride, int rmin, int rmax, int tid) {
    const int j = tid >> 2, ch = tid & 3;
    int tok = row0 + j * rstride; tok = tok < rmin ? rmin : (tok > rmax ? rmax : tok);
    const u32x4* kp = (const u32x4*)(kbase + (size_t)tok * 64);
    const u32x4* vp = (const u32x4*)(vbase + (size_t)tok * 64);
    const u32x4 k0 = kp[ch], k1 = kp[ch + 4], v0 = vp[ch], v1 = vp[ch + 4];
    *(LAS u32x4*)(Kt + j * KVS + ch * 16) = k0; *(LAS u32x4*)(Kt + j * KVS + (ch + 4) * 16) = k1;
    { const int sx = 2 * (j & 3); *(LAS u32x4*)(Vt + j * VS + ((ch ^ sx) * 16)) = v0; *(LAS u32x4*)(Vt + j * VS + (((ch + 4) ^ sx) * 16)) = v1; }
}

struct KVRegs { u32x4 k0, k1, v0, v1; };
__device__ __forceinline__ void kv_fetch(KVRegs& r, const bf16_t* kbase, const bf16_t* vbase, int row0, int rstride, int rmin, int rmax, int tid) {
    const int j = tid >> 2, ch = tid & 3;
    int tok = row0 + j * rstride; tok = tok < rmin ? rmin : (tok > rmax ? rmax : tok);
    const u32x4* kp = (const u32x4*)(kbase + (size_t)tok * 64);
    const u32x4* vp = (const u32x4*)(vbase + (size_t)tok * 64);
    r.k0 = kp[ch]; r.k1 = kp[ch + 4]; r.v0 = vp[ch]; r.v1 = vp[ch + 4];
}
__device__ __forceinline__ void kv_commit(const KVRegs& r, LAS unsigned char* Kt, LAS unsigned char* Vt, int tid) {
    const int j = tid >> 2, ch = tid & 3;
    *(LAS u32x4*)(Kt + j * KVS + ch * 16) = r.k0; *(LAS u32x4*)(Kt + j * KVS + (ch + 4) * 16) = r.k1;
    { const int sx = 2 * (j & 3); *(LAS u32x4*)(Vt + j * VS + ((ch ^ sx) * 16)) = r.v0; *(LAS u32x4*)(Vt + j * VS + (((ch + 4) ^ sx) * 16)) = r.v1; }
}
__device__ __forceinline__ void pv32(f32x16& o0, f32x16& o1, const f32x16& sv, LAS const unsigned char* vp0, LAS const unsigned char* vp1  ) {
#pragma unroll
    for (int s16 = 0; s16 < 2; ++s16) {
        u32x4 pw;
        pw.x = cvtpk(sv[8 * s16 + 0], sv[8 * s16 + 1]); pw.y = cvtpk(sv[8 * s16 + 2], sv[8 * s16 + 3]);
        pw.z = cvtpk(sv[8 * s16 + 4], sv[8 * s16 + 5]); pw.w = cvtpk(sv[8 * s16 + 6], sv[8 * s16 + 7]);
        const bf16x8 pf = __builtin_bit_cast(bf16x8, pw);
        const s16x4 a0 = vtr(vp0 + s16 * 16 * VS), b0 = vtr(vp0 + s16 * 16 * VS + 8 * VS), a1 = vtr(vp1 + s16 * 16 * VS), b1 = vtr(vp1 + s16 * 16 * VS + 8 * VS);
        const bf16x8 vf0 = {a0[0], a0[1], a0[2], a0[3], b0[0], b0[1], b0[2], b0[3]};
        const bf16x8 vf1 = {a1[0], a1[1], a1[2], a1[3], b1[0], b1[1], b1[2], b1[3]};
        o0 = __builtin_amdgcn_mfma_f32_32x32x16_bf16(vf0, pf, o0, 0, 0, 0);
        o1 = __builtin_amdgcn_mfma_f32_32x32x16_bf16(vf1, pf, o1, 0, 0, 0);
    }
}
__device__ __forceinline__ f32x16 qk32(const bf16x8* qf, LAS const unsigned char* kp  , f32x16 s  ) {
#pragma unroll
    for (int k = 0; k < 4; ++k) {
        const bf16x8 kf = *(const LAS bf16x8*)(kp + 32 * k);
        s = __builtin_amdgcn_mfma_f32_32x32x16_bf16(kf, qf[k], s, 0, 0, 0);
    }
    return s;
}
__device__ __forceinline__ float vmax3(float a, float b, float c) { float d; asm("v_max3_f32 %0, %1, %2, %3" : "=v"(d) : "v"(a), "v"(b), "v"(c)); return d; }
__device__ __forceinline__ float vsub(float a, float b) { float d; asm("v_sub_f32 %0, %1, %2" : "=v"(d) : "v"(a), "v"(b)); return d; }
__device__ __forceinline__ float vadd(float a, float b) { float d; asm("v_add_f32 %0, %1, %2" : "=v"(d) : "v"(a), "v"(b)); return d; }
__device__ __forceinline__ float vmul(float a, float b) { float d; asm("v_mul_f32 %0, %1, %2" : "=v"(d) : "v"(a), "v"(b)); return d; }
struct FaState { float mref, l; int started; };
template <bool TRY_FULL>
__device__ __forceinline__ void fa_tile64(f32x16& o0, f32x16& o1, FaState& st, const bf16x8* qf, LAS const unsigned char* Kt, LAS const unsigned char* Vt, int lane, float dA, float wmax, float ns2, bool lane_on = true) {
    const int r = lane & 31, h = lane >> 5;
    LAS const unsigned char* kp = Kt + r * KVS + 16 * h;
    const float dAh = dA - (float)(4 * h);
    const float hi = dAh, lo = dAh - wmax;
    const float n8 = 8.f * ns2, n32 = 32.f * ns2;
    f32x16 s0, s1;
    s0[0] = lane_on ? fmaf(ns2, dAh, -st.mref) : -1e30f;
#pragma unroll
    for (int u = 0; u < 4; ++u) {
        if (u) s0[4 * u] = vsub(s0[4 * u - 4], n8);
#pragma unroll
        for (int k = 1; k < 4; ++k) s0[4 * u + k] = vsub(s0[4 * u + k - 1], ns2);
    }
#pragma unroll
    for (int i = 0; i < 16; ++i) s1[i] = vsub(s0[i], n32);
    if (!(TRY_FULL && __all(lo <= 0.f && hi >= 59.f))) {
#pragma unroll
        for (int i = 0; i < 16; ++i) {
            const float c0 = (float)((i & 3) + 8 * (i >> 2)), c1 = c0 + 32.f;
            s0[i] = (c0 >= lo && c0 <= hi) ? s0[i] : -1e30f;
            s1[i] = (c1 >= lo && c1 <= hi) ? s1[i] : -1e30f;
        }
    }
    s0 = qk32(qf, kp, s0); s1 = qk32(qf, kp + 32 * KVS, s1);
    asm volatile("s_nop 15" : "+v"(s0), "+v"(s1));
    float tmax;
    {
        const float a0 = vmax3(s0[0], s0[1], s0[2]), a1 = vmax3(s0[3], s0[4], s0[5]), a2 = vmax3(s0[6], s0[7], s0[8]), a3 = vmax3(s0[9], s0[10], s0[11]), a4 = vmax3(s0[12], s0[13], s0[14]);
        const float a5 = vmax3(s0[15], s1[0], s1[1]), a6 = vmax3(s1[2], s1[3], s1[4]), a7 = vmax3(s1[5], s1[6], s1[7]), a8 = vmax3(s1[8], s1[9], s1[10]), a9 = vmax3(s1[11], s1[12], s1[13]);
        const float b0 = vmax3(a0, a1, a2), b1 = vmax3(a3, a4, a5), b2 = vmax3(a6, a7, a8), b3 = vmax3(a9, s1[14], s1[15]);
        tmax = vmax3(b0, b1, b2);
        tmax = vmax3(tmax, b3, b3);
    }
    { const float ot = __shfl_xor(tmax, 32); tmax = vmax3(tmax, ot, ot); }
    const bool valid = tmax > -1e29f;
    const bool need = valid & ((tmax > 8.f) | (st.started == 0));
    if (__any(need)) {
        const float delta = need ? tmax : 0.f;
        const float corr = need ? __builtin_amdgcn_exp2f(-delta) : 1.0f;
        st.mref += delta; st.l *= corr;
        if (__any(st.started)) {
#pragma unroll
            for (int i = 0; i < 16; ++i) { o0[i] = vmul(o0[i], corr); o1[i] = vmul(o1[i], corr); }
        }
#pragma unroll
        for (int i = 0; i < 16; ++i) { s0[i] = vsub(s0[i], delta); s1[i] = vsub(s1[i], delta); }
        st.started |= valid ? 1 : 0;
    }
#pragma unroll
    for (int i = 0; i < 16; ++i) { s0[i] = __builtin_amdgcn_exp2f(s0[i]); s1[i] = __builtin_amdgcn_exp2f(s1[i]); }
    {
        float ps0 = 0.f, ps1 = 0.f;
#pragma unroll
        for (int i = 0; i < 16; ++i) { ps0 += s0[i]; ps1 += s1[i]; }
        st.l += ps0 + ps1;
    }
    const int vq = (lane & 15) >> 2, vc0 = 2 * ((lane >> 4) & 1) + ((lane & 3) >> 1), vsx = 2 * vq;
    LAS const unsigned char* vp0 = Vt + (4 * h + vq) * VS + ((vc0 ^ vsx) * 16) + 8 * (lane & 1);
    LAS const unsigned char* vp1 = Vt + (4 * h + vq) * VS + (((vc0 + 4) ^ vsx) * 16) + 8 * (lane & 1);
    pv32(o0, o1, s0, vp0, vp1);
    pv32(o0, o1, s1, vp0 + 32 * VS, vp1 + 32 * VS);
}
__device__ __forceinline__ void acc_scaled(f32x16& t0, f32x16& t1, const f32x16& o0, const f32x16& o1, float sc) {
#pragma unroll
    for (int i = 0; i < 16; ++i) { t0[i] += sc * o0[i]; t1[i] += sc * o1[i]; }
}
__device__ __forceinline__ void store_ot(bf16_t* orow, const f32x16& o0, const f32x16& o1, float sc, int h) {
#pragma unroll
    for (int u = 0; u < 4; ++u) {
        u32x2 w0, w1;
        w0.x = cvtpk(o0[4 * u] * sc, o0[4 * u + 1] * sc); w0.y = cvtpk(o0[4 * u + 2] * sc, o0[4 * u + 3] * sc);
        w1.x = cvtpk(o1[4 * u] * sc, o1[4 * u + 1] * sc); w1.y = cvtpk(o1[4 * u + 2] * sc, o1[4 * u + 3] * sc);
        *(u32x2*)(orow + 8 * u + 4 * h) = w0;
        *(u32x2*)(orow + 32 + 8 * u + 4 * h) = w1;
    }
}
__device__ __forceinline__ void load_qf(bf16x8* qf, const bf16_t* qrow, int h) {
#pragma unroll
    for (int k = 0; k < 4; ++k) qf[k] = *(const bf16x8*)(qrow + 16 * k + 8 * h);
}

__device__ __forceinline__ void dil_item(unsigned char* ws, int item, LAS unsigned char* lds) {
    const int tid = TID(), lane = tid & 63, w = tid >> 6, c = lane & 31, h = lane >> 5;
    const int bh = item / 48, rem = item % 48, pat = rem >> 4, idx = rem & 15;
    const int dil = pat == 0 ? 1 : (pat == 1 ? 4 : 16), nqt = 16 / dil, res = idx / nqt, qt = idx % nqt;
    const int hd = bh & 7, b = bh >> 3;
    const int q0 = qt * 128 + 32 * w, iq = q0 + c, t = res + iq * dil;
    const bf16_t* qa = (const bf16_t*)(ws + WS_QA) + (size_t)bh * NS * 64;
    const bf16_t* ka = (const bf16_t*)(ws + WS_KA) + (size_t)bh * NS * 64;
    const bf16_t* va = (const bf16_t*)(ws + WS_VA) + (size_t)bh * NS * 64;
    bf16x8 qf[4]; load_qf(qf, qa + (size_t)t * 64, h);
    const float ns2 = -exp2f(-((float)hd + 0.5f)) * (float)dil * LOG2E_F;
    f32x16 o0 = zero16(), o1 = zero16(); FaState st = {0.f, 0.f, 0};
    {
        const int T0 = qt == 0 ? 2 : 0;
        KVRegs kr; kv_fetch(kr, ka, va, res + (qt * 128 - 128 + 64 * 3) * dil, dil, 0, NS - 1, tid);
        int buf = 0;
        for (int T = 3; T >= T0; --T) {
            const int kb = qt * 128 - 128 + 64 * T;
            LAS unsigned char* Kt = lds + buf * KVT; LAS unsigned char* Vt = lds + 2 * KVT + buf * VT;
            kv_commit(kr, Kt, Vt, tid);
            __syncthreads();
            if (T > T0) kv_fetch(kr, ka, va, res + (kb - 64) * dil, dil, 0, NS - 1, tid);
            if (kb <= q0 + 31 && kb + 63 >= q0 - 128)
                fa_tile64<true>(o0, o1, st, qf, Kt, Vt, lane, (float)(iq - kb), 128.f, ns2);
            buf ^= 1;
        }
    }
    const float lt = st.l + __shfl_xor(st.l, 32);
    bf16_t* op = (bf16_t*)(pat < 2 ? ws + WS_OPA01 + (size_t)pat * 16 * MiB : ws + WS_OPA2);
    store_ot(op + ((size_t)(b * NS + t) * 512 + hd * 64), o0, o1, 1.0f / lt, h);
    if (h == 0) { float* sp = (float*)(ws + WS_STA) + ((size_t)pat * NB * 8 * NS + (size_t)bh * NS + t) * 2; sp[0] = st.started ? st.mref : -1e30f; sp[1] = lt; }
}
__device__ __forceinline__ void dil_merge(unsigned char* ws, int gtid, int gthreads) {
    asm volatile("" : "+v"(gtid));
    const float* sta = (const float*)(ws + WS_STA);
    bf16_t* ob = (bf16_t*)(ws + WS_O);
    for (int it = gtid; it < NT * 8 * 8; it += gthreads) {
        const int ch = it & 7, hd = (it >> 3) & 7, tk = it >> 6, b = tk >> 11, t = tk & 2047;
        float mm[3], ll[3];
#pragma unroll
        for (int p = 0; p < 3; ++p) { const float* s = sta + ((size_t)p * NB * 8 * NS + (size_t)(b * 8 + hd) * NS + t) * 2; mm[p] = s[0]; ll[p] = s[1]; }
        const float M = fmaxf(mm[0], fmaxf(mm[1], mm[2]));
        float wgt[3], den = 0.f;
#pragma unroll
        for (int p = 0; p < 3; ++p) { wgt[p] = __builtin_amdgcn_exp2f(mm[p] - M) * ll[p]; den += wgt[p]; }
        const float inv = 1.0f / den;
        float a[8];
#pragma unroll
        for (int i = 0; i < 8; ++i) a[i] = 0.f;
#pragma unroll
        for (int p = 0; p < 3; ++p) {
            const bf16_t* op = (const bf16_t*)(p < 2 ? ws + WS_OPA01 + (size_t)p * 16 * MiB : ws + WS_OPA2);
            const u32x4 v = *(const u32x4*)(op + (size_t)tk * 512 + hd * 64 + ch * 8);
            const float wp = wgt[p] * inv;
            a[0] += wp * bflo(v.x); a[1] += wp * bfhi(v.x); a[2] += wp * bflo(v.y); a[3] += wp * bfhi(v.y);
            a[4] += wp * bflo(v.z); a[5] += wp * bfhi(v.z); a[6] += wp * bflo(v.w); a[7] += wp * bfhi(v.w);
        }
        u32x4 o; o.x = pk2(a[0], a[1]); o.y = pk2(a[2], a[3]); o.z = pk2(a[4], a[5]); o.w = pk2(a[6], a[7]);
        *(u32x4*)(ob + (size_t)tk * ND + hd * 64 + ch * 8) = o;
    }
}

constexpr int LDS_IMP = 4 * KVT;
constexpr int LDS_UNI = LDS_IMP + 4096;
constexpr int LDS_TOT = 41088;
__device__ __forceinline__ void nsa_item(unsigned char* ws, int item, LAS unsigned char* lds) {
    const int tid = TID(), lane = tid & 63, w = tid >> 6, c = lane & 31, h = lane >> 5;
    const int bg = item & 15, tt = item >> 4, b = bg >> 1, g = bg & 1;
    const int t0 = tt * 32, tok8 = c & 7, hh = c >> 3, hb = g * 4 + hh, t = t0 + 8 * w + tok8;
    const bf16_t* qrow = (const bf16_t*)(ws + WS_QB) + ((size_t)(b * 8 + hb) * NS + t) * 64;
    bf16x8 qf[4]; load_qf(qf, qrow, h);
    const float ns2 = -exp2f(-(float)(hb + 1)) * LOG2E_F;
    const float* gt = (const float*)(ws + WS_GATES) + (size_t)(b * NS + t) * 24 + hb * 3;
    const float g0 = gt[0], g1 = gt[1], g2 = gt[2];
    LAS float* totL = (LAS float*)(lds + LDS_TOT) + tid;
    LAS unsigned char* Kt = lds; LAS unsigned char* Vt = lds + 2 * KVT;
    LAS float* impL = (LAS float*)(lds + LDS_IMP) + w * 256;
    LAS unsigned* uni = (LAS unsigned*)(lds + LDS_UNI);
    const int cur = t0 >> 6;
    unsigned selmask;
    {
        const bf16_t* kc = (const bf16_t*)(ws + WS_KCMP) + (size_t)bg * 128 * 64;
        const bf16_t* vc = kc + (size_t)16 * 128 * 64;
        __syncthreads();
        load_kv_tile(Kt, Vt, kc, vc, 0, 1, 0, 127, tid);
        load_kv_tile(Kt + KVT, Vt + VT, kc, vc, 64, 1, 0, 127, tid);
        if (tid == 0) uni[0] = 0u;
        __syncthreads();
        LAS const unsigned char* kp = Kt + c * KVS + 16 * h;
        f32x16 sT[4];
#pragma unroll
        for (int T = 0; T < 4; ++T) sT[T] = qk32(qf, kp + T * 32 * KVS, zero16());
        const float dAh = (float)(t - 31) - (float)(64 * h);
        float tmax = -1e30f;
#pragma unroll
        for (int T = 0; T < 4; ++T)
#pragma unroll
            for (int i = 0; i < 16; ++i) {
                const float d = dAh - (float)(16 * (32 * T + (i & 3) + 8 * (i >> 2)));
                float tv = sT[T][i] + ns2 * d;
                tv = d >= 0.f ? tv : -1e30f;
                sT[T][i] = tv; tmax = fmaxf(tmax, tv);
            }
        tmax = fmaxf(tmax, __shfl_xor(tmax, 32));
        const float mu = fmaxf(tmax, -1e29f);
        float ps = 0.f;
#pragma unroll
        for (int T = 0; T < 4; ++T)
#pragma unroll
            for (int i = 0; i < 16; ++i) { sT[T][i] = __builtin_amdgcn_exp2f(sT[T][i] - mu); ps += sT[T][i]; }
        ps += __shfl_xor(ps, 32);
        const float inv = ps > 0.f ? 1.0f / ps : 0.f;
#pragma unroll
        for (int T = 0; T < 4; ++T)
#pragma unroll
            for (int i = 0; i < 16; ++i) sT[T][i] *= inv;
        f32x16 o0 = zero16(), o1 = zero16();
        const int vq = (lane & 15) >> 2, vc0 = 2 * ((lane >> 4) & 1) + ((lane & 3) >> 1), vsx = 2 * vq;
        LAS const unsigned char* vp0 = Vt + (4 * h + vq) * VS + ((vc0 ^ vsx) * 16) + 8 * (lane & 1);
        LAS const unsigned char* vp1 = Vt + (4 * h + vq) * VS + (((vc0 + 4) ^ vsx) * 16) + 8 * (lane & 1);
#pragma unroll
        for (int T = 0; T < 4; ++T) pv32(o0, o1, sT[T], vp0 + T * 32 * VS, vp1 + T * 32 * VS);
#pragma unroll
        for (int i = 0; i < 16; ++i) { totL[i * 256] = g0 * o0[i]; totL[(16 + i) * 256] = g0 * o1[i]; }
        float mainv[16], spill[16];
#pragma unroll
        for (int T = 0; T < 4; ++T)
#pragma unroll
            for (int u = 0; u < 4; ++u) {
                const float p3 = 0.5f * sT[T][4 * u + 3];
                mainv[4 * T + u] = sT[T][4 * u] + sT[T][4 * u + 1] + sT[T][4 * u + 2] + p3;
                spill[4 * T + u] = p3;
            }
#pragma unroll
        for (int f = 0; f < 16; ++f) {
            mainv[f] += __shfl_xor(mainv[f], 8); mainv[f] += __shfl_xor(mainv[f], 16);
            spill[f] += __shfl_xor(spill[f], 8); spill[f] += __shfl_xor(spill[f], 16);
        }
#pragma unroll
        for (int f = 0; f < 16; ++f) {
            const float snd = h ? (f > 0 ? spill[f > 0 ? f - 1 : 0] : 0.f) : spill[f];
            const float rcv = __shfl_xor(snd, 32);
            mainv[f] += rcv;
        }
        if (hh == 0) {
#pragma unroll
            for (int f = 0; f < 16; ++f) impL[tok8 * 32 + 2 * f + h] = mainv[f];
        }
        asm volatile("s_waitcnt lgkmcnt(0)" ::: "memory");
        {
            const int tk = lane >> 3, tq = t0 + 8 * w + tk, cq = tq >> 6, n0 = 4 * (lane & 7);
            float sc[32];
#pragma unroll
            for (int q4 = 0; q4 < 8; ++q4) {
                const f32x4 v = *(const LAS f32x4*)(impL + tk * 32 + 4 * q4);
                sc[4 * q4] = v.x; sc[4 * q4 + 1] = v.y; sc[4 * q4 + 2] = v.z; sc[4 * q4 + 3] = v.w;
            }
#pragma unroll
            for (int n = 0; n < 32; ++n) {
                const bool valid = n <= cq, forced = (n == 0) || (cq - n < 2);
                sc[n] = valid ? sc[n] + (forced ? 1e4f : 0.f) : -1e30f;
            }
            unsigned bits = 0u;
#pragma unroll
            for (int k = 0; k < 4; ++k) {
                const int n = n0 + k;
                float mine = 0.f;
#pragma unroll
                for (int q = 0; q < 32; ++q) mine = (q == n) ? sc[q] : mine;
                int rank = 0;
#pragma unroll
                for (int q = 0; q < 32; ++q) rank += (sc[q] > mine || (sc[q] == mine && q < n)) ? 1 : 0;
                if (n <= cq && rank < 16) bits |= 1u << n;
            }
            bits |= __shfl_xor(bits, 1); bits |= __shfl_xor(bits, 2); bits |= __shfl_xor(bits, 4);
            selmask = __shfl(bits, tok8 * 8);
        }
        {
            unsigned um = selmask;
#pragma unroll
            for (int o = 1; o < 64; o <<= 1) um |= __shfl_xor(um, o);
            if (lane == 0) atomicOr((unsigned*)uni, um);
        }
        __syncthreads();
    }
    const unsigned ublk = uni[0];
    unsigned wsel = selmask;
#pragma unroll
    for (int o = 1; o < 64; o <<= 1) wsel |= __shfl_xor(wsel, o);
    int buf = 0;
    KVRegs kr;
    {
        const bf16_t* kb = (const bf16_t*)(ws + WS_KV6 + 2 * 4 * MiB) + (size_t)bg * NS * 64;
        const bf16_t* vb = (const bf16_t*)(ws + WS_KV6 + 3 * 4 * MiB) + (size_t)bg * NS * 64;
        f32x16 o0 = zero16(), o1 = zero16(); FaState st = {0.f, 0.f, 0};
        unsigned rem = ublk & (cur >= 31 ? 0xffffffffu : ((2u << cur) - 1u));
        int n = 31 - __builtin_clz(rem);
        kv_fetch(kr, kb, vb, 64 * n, 1, 0, NS - 1, tid);
        while (rem) {
            rem &= ~(1u << n);
            LAS unsigned char* Kc = lds + buf * KVT; LAS unsigned char* Vc = lds + 2 * KVT + buf * VT;
            kv_commit(kr, Kc, Vc, tid);
            __syncthreads();
            const int ncur = n;
            if (rem) { n = 31 - __builtin_clz(rem); kv_fetch(kr, kb, vb, 64 * n, 1, 0, NS - 1, tid); }
            if ((wsel >> ncur) & 1u)
                fa_tile64<true>(o0, o1, st, qf, Kc, Vc, lane, (float)(t - 64 * ncur), 1e30f, ns2, ((selmask >> ncur) & 1u) != 0u);
            buf ^= 1;
        }
        const float lt = st.l + __shfl_xor(st.l, 32);
        { const float sc = g1 / lt;
#pragma unroll
          for (int i = 0; i < 16; ++i) { totL[i * 256] += sc * o0[i]; totL[(16 + i) * 256] += sc * o1[i]; } }
    }
    {
        const bf16_t* kb = (const bf16_t*)(ws + WS_KV6 + 4 * 4 * MiB) + (size_t)bg * NS * 64;
        const bf16_t* vb = (const bf16_t*)(ws + WS_KV6 + 5 * 4 * MiB) + (size_t)bg * NS * 64;
        f32x16 o0 = zero16(), o1 = zero16(); FaState st = {0.f, 0.f, 0};
        const int nlo = t0 >= 511 ? (t0 - 511) >> 6 : 0;
        kv_fetch(kr, kb, vb, 64 * cur, 1, 0, NS - 1, tid);
        for (int n = cur; n >= nlo; --n) {
            LAS unsigned char* Kc = lds + buf * KVT; LAS unsigned char* Vc = lds + 2 * KVT + buf * VT;
            kv_commit(kr, Kc, Vc, tid);
            __syncthreads();
            if (n > nlo) kv_fetch(kr, kb, vb, 64 * (n - 1), 1, 0, NS - 1, tid);
            fa_tile64<true>(o0, o1, st, qf, Kc, Vc, lane, (float)(t - 64 * n), 511.f, ns2);
            buf ^= 1;
        }
        const float lt = st.l + __shfl_xor(st.l, 32);
        { const float sc = g2 / lt;
#pragma unroll
          for (int i = 0; i < 16; ++i) { o0[i] = totL[i * 256] + sc * o0[i]; o1[i] = totL[(16 + i) * 256] + sc * o1[i]; } }
        store_ot((bf16_t*)(ws + WS_O) + ((size_t)(b * NS + t) * ND + 512 + hb * 64), o0, o1, 1.0f, h);
    }
}

#define XB_TMO      128
#define XB_XCNT(j)  (256  + 64 * (j))
#define XB_XSUB(j)  (1280 + 64 * (j))
#define XB_XGEN(j)  (2304 + 64 * (j))
#define XB_TOP      3328
#define XB_TOPGEN   3392
#define XCD_BAR_WORDS 3456
#define XB_SPIN_CAP (1u << 18)
__device__ __forceinline__ unsigned xb_ld(unsigned* p)              { return __hip_atomic_load(p, __ATOMIC_RELAXED, __HIP_MEMORY_SCOPE_AGENT); }
__device__ __forceinline__ unsigned xb_add(unsigned* p, unsigned v) { return __hip_atomic_fetch_add(p, v, __ATOMIC_RELAXED, __HIP_MEMORY_SCOPE_AGENT); }
__device__ __forceinline__ unsigned xb_xcc_id() { return (unsigned)__builtin_amdgcn_s_getreg((3 << 11) | 20) & 0xFu; }
#define XB_SPIN(cond, bar) do { unsigned _sp = 0; while (cond) { __builtin_amdgcn_s_sleep(1); \
    if ((++_sp & 255u) == 0u) { if (xb_ld(&(bar)[XB_TMO])) break; if (_sp > XB_SPIN_CAP) { atomicAdd(&(bar)[XB_TMO], 1u); break; } } } } while (0)
struct XcdBarrier { unsigned* bar; unsigned x; volatile LAS unsigned* st; };
__device__ __forceinline__ XcdBarrier xcd_barrier_post(unsigned* bar, volatile LAS unsigned* st) {
    XcdBarrier b; b.bar = bar; b.x = xb_xcc_id(); b.st = st;
    if (threadIdx.x == 0) (void)xb_add(&bar[XB_XCNT(b.x)], 1u);
    return b;
}
__device__ __forceinline__ void xcd_barrier_complete(unsigned* bar, unsigned x, unsigned& nloc, unsigned& nx) {
    const unsigned G = gridDim.x * gridDim.y * gridDim.z;
    unsigned sum, cnt, mine, sp = 0u;
    for (;;) {
        sum = 0u; cnt = 0u; mine = 0u;
#pragma unroll
        for (unsigned j = 0; j < 16; ++j) { const unsigned c = xb_ld(&bar[XB_XCNT(j)]); sum += c; cnt += (c > 0u) ? 1u : 0u; mine = (j == x) ? c : mine; }
        if (sum == G) break;
        __builtin_amdgcn_s_sleep(1);
        if ((++sp & 255u) == 0u) { if (xb_ld(&bar[XB_TMO])) break; if (sp > XB_SPIN_CAP) { atomicAdd(&bar[XB_TMO], 1u); break; } }
    }
    nloc = mine > 0u ? mine : 1u; nx = cnt > 0u ? cnt : 1u;
}
__device__ __forceinline__ void xcd_barrier(const XcdBarrier& b) {
    asm volatile("s_waitcnt vmcnt(0)" ::: "memory");
    __syncthreads();
    if (threadIdx.x == 0) {
        unsigned* bar = b.bar;
        __builtin_amdgcn_s_waitcnt(0);
        unsigned nloc = b.st[0], nx = b.st[1];
        if (nloc == 0u) { xcd_barrier_complete(bar, b.x, nloc, nx); b.st[0] = nloc; b.st[1] = nx; }
        const unsigned old = xb_add(&bar[XB_XSUB(b.x)], 1u);
        const unsigned gen = old / nloc;
        if (old + 1u == (gen + 1u) * nloc) {
            __builtin_amdgcn_fence(__ATOMIC_RELEASE, "agent");
            asm volatile("s_waitcnt vmcnt(0)" ::: "memory");
            const unsigned og = xb_add(&bar[XB_TOP], 1u);
            const unsigned tg = og / nx;
            if (og + 1u == (tg + 1u) * nx) xb_add(&bar[XB_TOPGEN], 1u);
            else XB_SPIN(xb_ld(&bar[XB_TOPGEN]) == tg, bar);
            __builtin_amdgcn_fence(__ATOMIC_ACQUIRE, "agent");
            xb_add(&bar[XB_XGEN(b.x)], 1u);
            asm volatile("s_waitcnt vmcnt(0)" ::: "memory");
        } else {
            XB_SPIN(xb_ld(&bar[XB_XGEN(b.x)]) == gen, bar);
            __builtin_amdgcn_fence(__ATOMIC_ACQUIRE, "agent");
            asm volatile("s_waitcnt vmcnt(0)" ::: "memory");
        }
    }
    __syncthreads();
}

struct XcdTiles {
    int m_lo, cnt_m, nN, loc, nloc, tiles;
    __device__ __forceinline__ XcdTiles(int nM, int nN_) {
        const int b = BID(), g = gridDim.x;
        int x, nx;
        if ((g & 7) == 0) { x = b & 7; nx = 8; loc = b >> 3; nloc = g >> 3; } else { x = 0; nx = 1; loc = b; nloc = g; }
        m_lo = (int)((long)nM * x / nx); cnt_m = (int)((long)nM * (x + 1) / nx) - m_lo; nN = nN_; tiles = cnt_m * nN;
    }
    __device__ __forceinline__ void get(int q, int& mt, int& nt) const {
        const int mg = q / (8 * nN), rem_m = cnt_m - 8 * mg, mig = rem_m < 8 ? rem_m : 8, r = q - mg * 8 * nN;
        nt = r / mig; mt = m_lo + 8 * mg + (r - nt * mig);
    }
};
struct PhInProj { const bf16_t* xn; const unsigned char* wl; unsigned char* ws; const float* ssp; LAS unsigned char* lds; XcdTiles xt;
    __device__ __forceinline__ void make(int q, APlain& ap, BPlain& bp, EpiInProj& ep) const { int mt, nt; xt.get(q, mt, nt);
        ap = APlain{xn + (size_t)mt * 128 * ND, ND}; bp = BPlain{(const bf16_t*)(wl + WL_IN) + (size_t)nt * 128 * ND, ND}; ep = EpiInProj{mt, nt, ws, ssp, lds}; } };
struct PhCmp1 { const unsigned char* wl; unsigned char* ws; int l;
    __device__ __forceinline__ void make(int tile, ACmp& ap, BPlain& bp, EpiCmp1& ep) const { const int nt = tile & 1, bg = (tile >> 1) & 15, kv = tile >> 5;
        ap = ACmp{(const bf16_t*)(ws + WS_KV6 + (size_t)kv * 4 * MiB) + (size_t)bg * NS * 64};
        bp = BPlain{(const bf16_t*)(wl + WL_C1) + (size_t)kv * 256 * 2048 + (size_t)nt * 128 * 2048, 2048};
        ep = EpiCmp1{(bf16_t*)(ws + WS_HC) + (size_t)kv * 2048 * 256, (const float*)(ws + WS_BC1P) + l * 512 + kv * 256, bg * 128, nt * 128}; } };
struct PhCmp2 { const unsigned char* wl; unsigned char* ws;
    __device__ __forceinline__ void make(int tile, APlain& ap, BPlain& bp, EpiCmp2& ep) const { const int bg = tile & 15, kv = tile >> 4;
        ap = APlain{(const bf16_t*)(ws + WS_HC) + (size_t)kv * 2048 * 256 + (size_t)bg * 128 * 256, 256};
        bp = BPlain{(const bf16_t*)(wl + WL_C2) + (size_t)kv * 128 * 256, 256};
        ep = EpiCmp2{(bf16_t*)(ws + WS_KCMP) + (size_t)kv * 16 * 128 * 64, bg * 128}; } };
struct PhOutProj { const unsigned char* wl; unsigned char* ws; bf16_t* res; XcdTiles xt;
    __device__ __forceinline__ void make(int q, APlain& ap, BPlain& bp, EpiResAdd& ep) const { int mt, nt; xt.get(q, mt, nt);
        ap = APlain{(const bf16_t*)(ws + WS_O) + (size_t)mt * 128 * ND, ND}; bp = BPlain{(const bf16_t*)(wl + WL_OUT) + (size_t)nt * 128 * ND, ND};
        ep = EpiResAdd{res, mt * 128, nt * 128}; } };
struct PhMoe {
    LAS const int* sm; const int* list;
    __device__ __forceinline__ void decode(int gmt, int& bk, int& mt, int& rem, int& hrow0, int& elo, int& ehi) const {
        bk = 0;
        for (int k = 1; k < 24; ++k) if (gmt >= sm[32 + k]) bk = k;
        mt = gmt - sm[32 + bk]; rem = sm[bk] - mt * 128; hrow0 = sm[64 + bk] + mt * 128;
        const int grp = bk / 6, pi = bk % 6;
        elo = grp * 4 + (pi < 3 ? 0 : (pi < 5 ? 1 : 2)); ehi = grp * 4 + (pi < 3 ? pi + 1 : (pi < 5 ? pi - 1 : 3));
    } };
struct PhMoeGU { PhMoe m; const bf16_t* xn; const unsigned char* wl; unsigned char* ws; const float* route; const float* rinv; XcdTiles xt;
    __device__ __forceinline__ void make(int q, AGather& ap, BPlain& bp, EpiMoeGU& ep) const { int gmt, nt16; xt.get(q, gmt, nt16);
        int bk, mt, rem, hrow0, elo, ehi; m.decode(gmt, bk, mt, rem, hrow0, elo, ehi);
        const int* lst = m.list + (size_t)bk * NT + mt * 128; const int e = (nt16 >> 3) ? ehi : elo;
        ap = AGather{xn, lst, rem}; bp = BPlain{(const bf16_t*)(wl + WL_GU) + (size_t)e * 1024 * 1024 + (size_t)(nt16 & 7) * 128 * 1024, 1024};
        ep = EpiMoeGU{(bf16_t*)(ws + WS_HID), lst, route, rinv, rem, hrow0, nt16}; } };
struct PhMoeDown { PhMoe m; const unsigned char* wl; unsigned char* ws; bf16_t* res; float* ssp; XcdTiles xt;
    __device__ __forceinline__ void make(int q, APlain& ap, BSplit& bp, EpiMoeDown& ep) const { int gmt, nt; xt.get(q, gmt, nt);
        int bk, mt, rem, hrow0, elo, ehi; m.decode(gmt, bk, mt, rem, hrow0, elo, ehi);
        const int* lst = m.list + (size_t)bk * NT + mt * 128;
        ap = APlain{(const bf16_t*)(ws + WS_HID) + (size_t)hrow0 * 1024, 1024};
        bp = BSplit{(const bf16_t*)(wl + WL_DN) + (size_t)elo * 1024 * 512 + (size_t)nt * 128 * 512, (const bf16_t*)(wl + WL_DN) + (size_t)ehi * 1024 * 512 + (size_t)nt * 128 * 512};
        ep = EpiMoeDown{res, lst, ssp, rem, nt * 128}; } };
struct PhPleProj { const unsigned char* wl; unsigned char* ws; XcdTiles xt;
    __device__ __forceinline__ void make(int q, APlain& ap, BPlain& bp, EpiBf16& ep) const { int mt, nt; xt.get(q, mt, nt);
        ap = APlain{(const bf16_t*)(ws + WS_PB) + (size_t)mt * 128 * 256, 256}; bp = BPlain{(const bf16_t*)(wl + WL_PP) + (size_t)nt * 128 * 256, 256};
        ep = EpiBf16{(bf16_t*)(ws + WS_P2), ND, mt * 128, nt * 128}; } };
struct PhPleGate { const bf16_t* xn; const unsigned char* wl; unsigned char* ws; float* out; float sc; XcdTiles xt;
    __device__ __forceinline__ void make(int q, APlain& ap, BPlain& bp, EpiPleGate& ep) const { int mt, nt; xt.get(q, mt, nt);
        ap = APlain{xn + (size_t)mt * 128 * ND, ND}; bp = BPlain{(const bf16_t*)(wl + WL_PG) + (size_t)nt * 128 * ND, ND};
        ep = EpiPleGate{out, (const bf16_t*)(ws + WS_P2), mt * 128, nt * 128, sc}; } };

constexpr int LDS_QSLOT = 73856 + 16 + 448;
__device__ __forceinline__ int wq_next(int* head, LAS unsigned char* lds) {
    LAS int* slot = (LAS int*)(lds + LDS_QSLOT);
    __syncthreads();
    if (threadIdx.x == 0) *slot = atomicAdd(head, 1);
    __syncthreads();
    return *slot;
}
__device__ __forceinline__ void ple_stream(const bf16_t* xn, const bf16_t* pb, const unsigned char* wl, const float* ssp_in, bf16_t* rout, float* ssp_out, LAS unsigned char* lds) {
    const XcdTiles xt(128, 8);
    int q = xt.loc;
    if (q >= xt.tiles) return;
    const int tid = TID(), wid = tid >> 6, lane = tid & 63, wr = wid >> 1, wc = wid & 1, fr = lane & 15, fq = lane >> 4;
    int mt, nt; xt.get(q, mt, nt);
    bool pref = false;
    for (;;) {
        const int qn = q + xt.nloc; const bool hn = qn < xt.tiles;
        int mtn = mt, ntn = nt; if (hn) xt.get(qn, mtn, ntn);
        const APlain ap1{pb + (size_t)mt * 128 * 256, 256}; const BPlain bp1{(const bf16_t*)(wl + WL_PP) + (size_t)nt * 128 * 256, 256};
        const APlain ap2{xn + (size_t)mt * 128 * ND, ND};   const BPlain bp2{(const bf16_t*)(wl + WL_PG) + (size_t)nt * 128 * ND, ND};
        const APlain apn{pb + (size_t)mtn * 128 * 256, 256}; const BPlain bpn{(const bf16_t*)(wl + WL_PP) + (size_t)ntn * 128 * 256, 256};
        f32x4 acc[4][4], acc2[4][4]; zero_acc(acc); zero_acc(acc2);
        gemm_kloop<true>(acc2, ap1, bp1, 256, lds, pref, true, ap2, bp2);
        gemm_kloop<true>(acc, ap2, bp2, ND, lds, true, hn, apn, bpn);
        const EpiPleFused ep{xn, ssp_in, rout, ssp_out, mt * 128, nt * 128};
        ep(acc, acc2, wr, wc, fr, fq);
        if (!hn) break;
        q = qn; mt = mtn; nt = ntn; pref = true;
    }
}

constexpr int LDS_BAR = 73856;
constexpr int LDS_SM = LDS_BAR + 16;
constexpr int LDS_BYTES = LDS_SM + 512;
static_assert(LDS_QSLOT == LDS_SM + 448, "queue slot");
static_assert(4 * KVT + 4096 + 64 <= LDS_TOT && LDS_TOT + 32768 <= LDS_BAR && 65536 <= LDS_BAR, "LDS map");

__global__ void __launch_bounds__(256, 2) mega_fwd(Params p) {
    extern __shared__ __attribute__((aligned(16))) unsigned char lds_raw[];
    LAS unsigned char* lds = (LAS unsigned char*)lds_raw;
    unsigned char* ws = p.ws;
    const int tid = threadIdx.x;
    const int gtid = blockIdx.x * 256 + tid, gthreads = gridDim.x * 256;
    int* ctl = (int*)(ws + WS_CTL);
    {
        volatile LAS unsigned* st = (volatile LAS unsigned*)(lds + LDS_BAR);
        if (tid < 4) st[tid] = 0u;
        __syncthreads();
    }
    const XcdBarrier gbar = xcd_barrier_post((unsigned*)ctl + CW_BAR, (volatile LAS unsigned*)(lds + LDS_BAR));

    phase_convert(p, (LAS float*)lds);
    xcd_barrier(gbar);

    float* sspA = (float*)(ws + WS_SSP);
    float* sspB = sspA + (size_t)NT * 16;
    float* rinv = (float*)(ws + WS_RINV);
    for (int l = 0; l < 2; ++l) {
        const unsigned char* wl = ws + WS_W + (size_t)l * WL_SIZE;
        bf16_t* xn = (bf16_t*)p.out + (size_t)(l & 1) * NT * ND;
        bf16_t* rnext = l == 1 ? (bf16_t*)(ws + WS_XN) : (bf16_t*)p.out + (size_t)((l + 1) & 1) * NT * ND;
        const bf16_t* xb_in = xn;
        {
            const PhInProj ph{xb_in, wl, ws, sspB, lds, XcdTiles(128, 23)};
            gemm_stream<PhInProj, APlain, BPlain, EpiInProj>(ph, ph.xt.loc, ph.xt.nloc, ph.xt.tiles, ND, lds);
        }
        xcd_barrier(gbar);
        {
            int* qh = ctl + CW_Q + (l * 4 + 0) * 64;
            int* ch = ctl + CW_Q + (l * 4 + 2) * 64;
            const int nconv = conv_queue_strips(2 * l);
            const PhCmp1 ph{wl, ws, l};
            bool conv_left = nconv > 0, att_left = true, first_att = true;
            for (int k = 0; conv_left || att_left; ++k) {
                const bool want_conv = conv_left && (!att_left || (k % 7) == 6);
                if (want_conv) {
                    const int c = wq_next(ch, lds);
                    if (c < nconv) conv_strip(p, 2 * l, c, (LAS float*)lds); else conv_left = false;
                } else {
                    const int it = first_att ? BID() : (int)gridDim.x + wq_next(qh, lds);
                    first_att = false;
                    if (it >= 64 + 1536) att_left = false;
                    else if (it < 64) { ACmp ap; BPlain bp; EpiCmp1 ep; ph.make(it, ap, bp, ep); gemm_tile(ap, bp, 2048, ep, lds, false, false, ap, bp); }
                    else { dil_item(ws, 2 * (it - 64), lds); __syncthreads(); dil_item(ws, 2 * (it - 64) + 1, lds); }
                }
            }
        }
        xcd_barrier(gbar);
        { const PhCmp2 ph{wl, ws}; gemm_stream<PhCmp2, APlain, BPlain, EpiCmp2>(ph, BID(), gridDim.x, 32, 256, lds); }
        dil_merge(ws, gtid, gthreads);
        if (l == 0) convert_p(p);
        xcd_barrier(gbar);
        {
            int* qh = ctl + CW_Q + (l * 4 + 1) * 64;
            int* ch = ctl + CW_Q + (l * 4 + 3) * 64;
            const int nconv = conv_queue_strips(2 * l + 1);
            bool conv_left = nconv > 0, att_left = true, first_att = true;
            for (int k = 0; conv_left || att_left; ++k) {
                const bool want_conv = conv_left && (!att_left || (k % 4) == 3);
                if (want_conv) {
                    const int c = wq_next(ch, lds);
                    if (c < nconv) conv_strip(p, 2 * l + 1, c, (LAS float*)lds); else conv_left = false;
                } else {
                    const int it = first_att ? BID() : (int)gridDim.x + wq_next(qh, lds);
                    first_att = false;
                    if (it >= 1024) att_left = false;
                    else nsa_item(ws, ((63 - (it >> 4)) << 4) | (it & 15), lds);
                }
            }
        }
        xcd_barrier(gbar);
        { const PhOutProj ph{wl, ws, xn, XcdTiles(128, 8)};
          gemm_stream<PhOutProj, APlain, BPlain, EpiResAdd>(ph, ph.xt.loc, ph.xt.nloc, ph.xt.tiles, ND, lds); }
        xcd_barrier(gbar);
        int* cnt = ctl + CW_CNTP + l * 1536;
        int* list = (int*)(ws + WS_LIST);
        float* route = (float*)(ws + WS_ROUTE);
        phase_route(xn, (const float*)(wl + WL_RT), p.in[12] + l * 4, p.in[14] + l * 16, cnt, list, route, rinv, lds);
        xcd_barrier(gbar);
        LAS int* sm = (LAS int*)(lds + LDS_SM);
        __syncthreads();
        if (tid < 24) sm[tid] = __hip_atomic_load(cnt + 64 * tid, __ATOMIC_RELAXED, __HIP_MEMORY_SCOPE_AGENT);
        __syncthreads();
        if (tid == 0) {
            int tp = 0, hb = 0;
            for (int k = 0; k < 24; ++k) {
                const int c = sm[k];
                sm[32 + k] = tp; sm[64 + k] = hb;
                const int nt_ = (c + 127) >> 7; tp += nt_; hb += nt_ * 128;
            }
            sm[32 + 24] = tp;
        }
        __syncthreads();
        const int total_mt = sm[32 + 24];
        { const PhMoeGU ph{PhMoe{sm, list}, xn, wl, ws, route, rinv, XcdTiles(total_mt, 16)};
          gemm_stream<PhMoeGU, AGather, BPlain, EpiMoeGU>(ph, ph.xt.loc, ph.xt.nloc, ph.xt.tiles, ND, lds); }
        xcd_barrier(gbar);
        { const PhMoeDown ph{PhMoe{sm, list}, wl, ws, xn, sspA, XcdTiles(total_mt, 8)};
          gemm_stream<PhMoeDown, APlain, BSplit, EpiMoeDown>(ph, ph.xt.loc, ph.xt.nloc, ph.xt.tiles, ND, lds); }
        xcd_barrier(gbar);
        ple_stream(xn, (const bf16_t*)(ws + WS_PBALL) + (size_t)l * NT * 256, wl, sspA, rnext, sspB, lds);
        xcd_barrier(gbar);
    }
    phase_final_norm((const bf16_t*)(ws + WS_XN), p.out, p.in[21]);
}

extern "C" void kernel_launch(void* const* d_in, const int* in_sizes, int n_in, void* d_out, int out_size, void* d_ws, size_t ws_size, hipStream_t stream) {
    static int grid = 0;
    if (grid == 0) {
        if (n_in != 22 || out_size != NT * ND || ws_size < WS_END) { fprintf(stderr, "kernel_launch: unexpected shapes (n_in %d out %d ws %zu)\n", n_in, out_size, ws_size); grid = -1; return; }
        int dev = 0, cus = 0, per_cu = 0;
        hipGetDevice(&dev);
        hipDeviceGetAttribute(&cus, hipDeviceAttributeMultiprocessorCount, dev);
        if (hipFuncSetAttribute((const void*)mega_fwd, hipFuncAttributeMaxDynamicSharedMemorySize, LDS_BYTES) != hipSuccess) { fprintf(stderr, "kernel_launch: hipFuncSetAttribute failed\n"); grid = -1; return; }
        hipOccupancyMaxActiveBlocksPerMultiprocessor(&per_cu, (const void*)mega_fwd, 256, LDS_BYTES);
        if (per_cu < 1) { fprintf(stderr, "kernel_launch: occupancy query says %d\n", per_cu); grid = -1; return; }
        if (per_cu > 2) per_cu = 2;
        grid = cus * per_cu;
    }
    if (grid < 0) return;
    hipMemsetAsync((char*)d_ws + WS_CTL, 0, 32768, stream);
    Params p{};
    for (int i = 0; i < 22; ++i) p.in[i] = (const float*)d_in[i];
    p.out = (float*)d_out; p.ws = (unsigned char*)d_ws;
    hipLaunchKernelGGL(mega_fwd, dim3(grid), dim3(256), LDS_BYTES, stream, p);
    const hipError_t e = hipPeekAtLastError();
    if (e != hipSuccess) fprintf(stderr, "launch failed: %s (grid %d)\n", hipGetErrorString(e), grid);
}
```
